# Optimizing an MI355X kernel written in HIP

```python
import jax, jax.numpy as jnp
from jax import lax
import numpy as np

D_MODEL = 1024
BATCH = 8
SEQ = 4096
DEPTH = 2

HEAD_DIM = 64
ROPE_THETA = 500000.0
PARTIAL_ROT = HEAD_DIM // 4
NORM_EPS = 1e-6
Q_BLOCK = 128

NSA_HEADS = 8
NSA_GROUPS = 2
NSA_REP = NSA_HEADS // NSA_GROUPS
CMP_LEN = 32
CMP_STRIDE = 16
CMP_HID = 4 * HEAD_DIM
SLC_LEN = 64
SLC_TOPK = 16
WIN = 512
NSA_Q_BLOCK = 32

FOX_HEADS = 8

MLA_HEADS = 8
MLA_Q_LORA = 384
MLA_KV_LORA = 256
MLA_NOPE = 64
MLA_ROPE = 32
MLA_V = 64

D_FF = 2816
CONV_W = 3

NSA_W = NSA_HEADS * HEAD_DIM
NSA_KV_W = NSA_GROUPS * HEAD_DIM
FOX_W = FOX_HEADS * HEAD_DIM
MLA_W = MLA_HEADS * MLA_V

IN_SIZES = (
    NSA_W,
    6 * NSA_KV_W,
    3 * NSA_HEADS,
    3 * FOX_W,
    FOX_HEADS,
    MLA_Q_LORA,
    MLA_KV_LORA,
    MLA_ROPE,
    3 * D_MODEL,
)
N_IN = NSA_W + 6 * NSA_KV_W + 3 * NSA_HEADS + 3 * FOX_W + FOX_HEADS + MLA_Q_LORA + MLA_KV_LORA + MLA_ROPE + 3 * D_MODEL

kernel_name = "hybrid_nsa_fox_mla_gated_convffn"


def rms_norm(x, g):
    xf = x.astype(jnp.float32)
    y = xf * lax.rsqrt(jnp.mean(xf * xf, axis=-1, keepdims=True) + NORM_EPS)
    return (y * g.astype(jnp.float32)).astype(x.dtype)


def rotary(x, positions, rot_dim):
    half = rot_dim // 2
    inv_freq = ROPE_THETA ** (-jnp.arange(half, dtype=jnp.float32) / half)
    ang = positions.astype(jnp.float32)[..., None] * inv_freq
    ang = ang.reshape(ang.shape[:2] + (1,) * (x.ndim - 3) + (half,))
    cos, sin = jnp.cos(ang), jnp.sin(ang)
    xr = x[..., :rot_dim].astype(jnp.float32)
    x1, x2 = xr[..., :half], xr[..., half:]
    rot = jnp.concatenate([x1 * cos - x2 * sin, x2 * cos + x1 * sin], axis=-1).astype(x.dtype)
    return jnp.concatenate([rot, x[..., rot_dim:]], axis=-1)


def masked_softmax(s, mask):
    s = jnp.where(mask, s.astype(jnp.float32), -jnp.inf)
    m = jnp.max(s, axis=-1, keepdims=True)
    m = jnp.where(jnp.isfinite(m), m, 0.0)
    p = jnp.exp(s - m)
    return p / jnp.maximum(jnp.sum(p, axis=-1, keepdims=True), 1e-30)


def causal_attention_blocked(q, k, v, scale, log_decay=None):
    B, S, H, _ = q.shape
    dv = v.shape[-1]
    k_pos = jnp.arange(S)
    F = None if log_decay is None else jnp.transpose(log_decay, (0, 2, 1))

    def block(i):
        t0 = i * Q_BLOCK
        qb = lax.dynamic_slice_in_dim(q, t0, Q_BLOCK, axis=1)
        s = jnp.einsum('bqhd,bshd->bhqs', qb, k).astype(jnp.float32) * scale
        if F is not None:
            fq = lax.dynamic_slice_in_dim(F, t0, Q_BLOCK, axis=2)
            s = s + fq[..., None] - F[:, :, None, :]
        q_pos = t0 + jnp.arange(Q_BLOCK)
        p = masked_softmax(s, k_pos[None, :] <= q_pos[:, None])
        return jnp.einsum('bhqs,bshd->bqhd', p.astype(v.dtype), v)

    out = lax.map(block, jnp.arange(S // Q_BLOCK))
    return jnp.moveaxis(out, 0, 1).reshape(B, S, H, dv)


def nsa_mixer(q, kv, gate_logits, positions, pe_k, w1_k, w2_k, pe_v, w1_v, w2_v):
    B, S, _ = q.shape
    G, R, Dh = NSA_GROUPS, NSA_REP, HEAD_DIM
    scale = Dh ** -0.5
    q = q.reshape(B, S, G, R, Dh)
    k_cmp, v_cmp, k_slc, v_slc, k_win, v_win = [t.reshape(B, S, G, Dh) for t in jnp.split(kv, 6, axis=-1)]

    n_cmp = (S - CMP_LEN) // CMP_STRIDE + 1
    blk_idx = CMP_STRIDE * np.arange(n_cmp)[:, None] + np.arange(CMP_LEN)[None, :]

    def compress(t, pe, w1, w2):
        blocks = t[:, blk_idx] + pe[:, None, :]
        blocks = jnp.transpose(blocks, (0, 1, 3, 2, 4)).reshape(B, n_cmp, G, CMP_LEN * Dh)
        return jax.nn.gelu(blocks @ w1) @ w2

    kc = compress(k_cmp, pe_k, w1_k, w2_k)
    vc = compress(v_cmp, pe_v, w1_v, w2_v)
    t_np = np.arange(S)
    cmp_end = CMP_STRIDE * np.arange(n_cmp) + CMP_LEN - 1
    s_cmp = jnp.einsum('bsgrd,bngd->bgrsn', q, kc).astype(jnp.float32) * scale
    p_cmp = masked_softmax(s_cmp, cmp_end[None, :] <= t_np[:, None])
    o_cmp = jnp.einsum('bgrsn,bngd->bsgrd', p_cmp.astype(vc.dtype), vc)

    n_slc = S // SLC_LEN
    c0 = CMP_STRIDE * np.arange(n_cmp)[:, None]
    s0 = SLC_LEN * np.arange(n_slc)[None, :]
    overlap = np.clip(np.minimum(c0 + CMP_LEN, s0 + SLC_LEN) - np.maximum(c0, s0), 0, None) / CMP_LEN
    imp = jnp.einsum('bgrsn,nj->bgsj', p_cmp, jnp.asarray(overlap, jnp.float32))
    cur = t_np // SLC_LEN
    j = np.arange(n_slc)
    forced = (j[None, :] == 0) | (j[None, :] == cur[:, None]) | (j[None, :] == cur[:, None] - 1)
    future = j[None, :] > cur[:, None]
    imp = jnp.where(forced, 1e9, jnp.where(future, -1e9, imp))
    n_top = min(SLC_TOPK, n_slc)
    _, sel = lax.top_k(imp, n_top)

    q_r = rotary(q, positions, PARTIAL_ROT)
    k_slc = rotary(k_slc, positions, PARTIAL_ROT)
    k_win = rotary(k_win, positions, PARTIAL_ROT)
    k_slc_b = jnp.transpose(k_slc.reshape(B, n_slc, SLC_LEN, G, Dh), (0, 3, 1, 2, 4))
    v_slc_b = jnp.transpose(v_slc.reshape(B, n_slc, SLC_LEN, G, Dh), (0, 3, 1, 2, 4))
    pad = ((0, 0), (WIN, 0), (0, 0), (0, 0))
    k_win_p = jnp.pad(k_win, pad)
    v_win_p = jnp.pad(v_win, pad)
    b_ix = jnp.arange(B)[:, None, None, None]
    g_ix = jnp.arange(G)[None, :, None, None]
    QB = NSA_Q_BLOCK

    def block(i):
        t0 = i * QB
        qb = lax.dynamic_slice_in_dim(q_r, t0, QB, axis=1)
        tq = t0 + jnp.arange(QB)
        idx = lax.dynamic_slice_in_dim(sel, t0, QB, axis=2)
        kg = k_slc_b[b_ix, g_ix, idx]
        vg = v_slc_b[b_ix, g_ix, idx]
        s = jnp.einsum('bqgrd,bgqnld->bgrqnl', qb, kg).astype(jnp.float32) * scale
        s_pos = idx[..., None] * SLC_LEN + jnp.arange(SLC_LEN)
        m_sel = (s_pos <= tq[None, None, :, None, None]).reshape(B, G, 1, QB, n_top * SLC_LEN)
        p = masked_softmax(s.reshape(B, G, R, QB, n_top * SLC_LEN), m_sel)
        o_s = jnp.einsum('bgrqk,bgqkd->bqgrd', p.astype(vg.dtype), vg.reshape(B, G, QB, n_top * SLC_LEN, Dh))
        kw = lax.dynamic_slice_in_dim(k_win_p, t0, QB + WIN, axis=1)
        vw = lax.dynamic_slice_in_dim(v_win_p, t0, QB + WIN, axis=1)
        s_w = jnp.einsum('bqgrd,bkgd->bgrqk', qb, kw).astype(jnp.float32) * scale
        kpos = t0 - WIN + jnp.arange(QB + WIN)
        diff = tq[:, None] - kpos[None, :]
        m_win = (kpos[None, :] >= 0) & (diff >= 0) & (diff < WIN)
        p_w = masked_softmax(s_w, m_win)
        o_w = jnp.einsum('bgrqk,bkgd->bqgrd', p_w.astype(vw.dtype), vw)
        return o_s, o_w

    o_slc, o_win = lax.map(block, jnp.arange(S // QB))
    o_slc = jnp.moveaxis(o_slc, 0, 1).reshape(B, S, G, R, Dh)
    o_win = jnp.moveaxis(o_win, 0, 1).reshape(B, S, G, R, Dh)
    g = jax.nn.sigmoid(gate_logits.astype(jnp.float32)).astype(q.dtype).reshape(B, S, G, R, 3)
    o = g[..., 0:1] * o_cmp + g[..., 1:2] * o_slc + g[..., 2:3] * o_win
    return o.reshape(B, S, NSA_W)


def fox_mixer(qkv, f_logits, b_forget):
    B, S, _ = qkv.shape
    q, k, v = [t.reshape(B, S, FOX_HEADS, HEAD_DIM) for t in jnp.split(qkv, 3, axis=-1)]
    log_f = jax.nn.log_sigmoid(f_logits.astype(jnp.float32) + b_forget.astype(jnp.float32))
    F = jnp.cumsum(log_f, axis=1)
    o = causal_attention_blocked(q, k, v, HEAD_DIM ** -0.5, F)
    return o.reshape(B, S, FOX_W)


def mla_mixer(c_q, c_kv, k_rope, positions, q_norm, w_uq, kv_norm, w_ukv):
    B, S, _ = c_q.shape
    H = MLA_HEADS
    q = (rms_norm(c_q, q_norm) @ w_uq).reshape(B, S, H, MLA_NOPE + MLA_ROPE)
    kv = (rms_norm(c_kv, kv_norm) @ w_ukv).reshape(B, S, H, MLA_NOPE + MLA_V)
    q_nope, q_pe = q[..., :MLA_NOPE], rotary(q[..., MLA_NOPE:], positions, MLA_ROPE)
    k_nope, v = kv[..., :MLA_NOPE], kv[..., MLA_NOPE:]
    k_pe = rotary(k_rope, positions, MLA_ROPE)
    qf = jnp.concatenate([q_nope, q_pe], axis=-1)
    kf = jnp.concatenate([k_nope, jnp.broadcast_to(k_pe[:, :, None, :], (B, S, H, MLA_ROPE))], axis=-1)
    o = causal_attention_blocked(qf, kf, v, (MLA_NOPE + MLA_ROPE) ** -0.5)
    return o.reshape(B, S, MLA_W)


def hybrid_mixer(x, positions, norm, w_in, b_forget, pe_k, w1_k, w2_k, pe_v, w1_v, w2_v,
                 q_norm, w_uq, kv_norm, w_ukv, w_br_nsa, w_br_fox, w_br_mla, w_out):
    B, S, D = x.shape
    h = rms_norm(x, norm)
    proj = h @ w_in
    (nsa_q, nsa_kv, nsa_g, fox_qkv, fox_f, mla_cq, mla_ckv, mla_kr, merge_g) = jnp.split(
        proj, np.cumsum(IN_SIZES)[:-1].tolist(), axis=-1)
    o_nsa = nsa_mixer(nsa_q, nsa_kv, nsa_g, positions, pe_k, w1_k, w2_k, pe_v, w1_v, w2_v)
    o_fox = fox_mixer(fox_qkv, fox_f, b_forget)
    o_mla = mla_mixer(mla_cq, mla_ckv, mla_kr, positions, q_norm, w_uq, kv_norm, w_ukv)
    gates = jax.nn.sigmoid(merge_g.astype(jnp.float32)).astype(x.dtype).reshape(B, S, 3, D)
    merged = (gates[:, :, 0] * (o_nsa @ w_br_nsa)
              + gates[:, :, 1] * (o_fox @ w_br_fox)
              + gates[:, :, 2] * (o_mla @ w_br_mla))
    return merged @ w_out


def conv_ffn(x, norm, w_up, conv_w, conv_b, w_down):
    S = x.shape[1]
    h = rms_norm(x, norm)
    u, v = jnp.split(h @ w_up, 2, axis=-1)
    up = jnp.pad(u, ((0, 0), (CONV_W - 1, 0), (0, 0)))
    uc = sum(conv_w[k] * up[:, k:k + S] for k in range(CONV_W)) + conv_b
    return (jax.nn.silu(uc) * v) @ w_down


def setup_inputs(seed: int = 0) -> dict:
    key = jax.random.key(seed)
    ks = jax.random.split(key, 32)
    f32 = jnp.float32
    L = DEPTH

    def nrm(i, shape, scale):
        return jax.random.normal(ks[i], shape, f32) * scale

    x = nrm(0, (BATCH, SEQ, D_MODEL), 1.0)
    positions = (jax.random.randint(ks[1], (BATCH, 1), 0, 1024, dtype=jnp.int32)
                 + jnp.arange(SEQ, dtype=jnp.int32)[None, :])
    return {
        "x": x,
        "positions": positions,
        "mix_norm": 1.0 + nrm(2, (L, D_MODEL), 0.02),
        "w_in": nrm(3, (L, D_MODEL, N_IN), D_MODEL ** -0.5),
        "b_forget": jax.random.uniform(ks[4], (L, FOX_HEADS), f32, 2.0, 6.0),
        "cmp_pe_k": nrm(5, (L, CMP_LEN, HEAD_DIM), 0.1),
        "cmp_w1_k": nrm(6, (L, CMP_LEN * HEAD_DIM, CMP_HID), (CMP_LEN * HEAD_DIM) ** -0.5),
        "cmp_w2_k": nrm(7, (L, CMP_HID, HEAD_DIM), CMP_HID ** -0.5),
        "cmp_pe_v": nrm(8, (L, CMP_LEN, HEAD_DIM), 0.1),
        "cmp_w1_v": nrm(9, (L, CMP_LEN * HEAD_DIM, CMP_HID), (CMP_LEN * HEAD_DIM) ** -0.5),
        "cmp_w2_v": nrm(10, (L, CMP_HID, HEAD_DIM), CMP_HID ** -0.5),
        "mla_q_norm": 1.0 + nrm(11, (L, MLA_Q_LORA), 0.02),
        "mla_w_uq": nrm(12, (L, MLA_Q_LORA, MLA_HEADS * (MLA_NOPE + MLA_ROPE)), MLA_Q_LORA ** -0.5),
        "mla_kv_norm": 1.0 + nrm(13, (L, MLA_KV_LORA), 0.02),
        "mla_w_ukv": nrm(14, (L, MLA_KV_LORA, MLA_HEADS * (MLA_NOPE + MLA_V)), MLA_KV_LORA ** -0.5),
        "w_br_nsa": nrm(15, (L, NSA_W, D_MODEL), NSA_W ** -0.5),
        "w_br_fox": nrm(16, (L, FOX_W, D_MODEL), FOX_W ** -0.5),
        "w_br_mla": nrm(17, (L, MLA_W, D_MODEL), MLA_W ** -0.5),
        "w_out": nrm(18, (L, D_MODEL, D_MODEL), D_MODEL ** -0.5),
        "ffn_norm": 1.0 + nrm(19, (L, D_MODEL), 0.02),
        "w_up": nrm(20, (L, D_MODEL, 2 * D_FF), D_MODEL ** -0.5),
        "conv_w": nrm(21, (L, CONV_W, D_FF), CONV_W ** -0.5),
        "conv_b": nrm(22, (L, D_FF), 0.02),
        "w_down": nrm(23, (L, D_FF, D_MODEL), D_FF ** -0.5),
        "final_norm": 1.0 + nrm(24, (D_MODEL,), 0.02),
    }


def reference(x, positions, mix_norm, w_in, b_forget, cmp_pe_k, cmp_w1_k, cmp_w2_k,
              cmp_pe_v, cmp_w1_v, cmp_w2_v, mla_q_norm, mla_w_uq, mla_kv_norm, mla_w_ukv,
              w_br_nsa, w_br_fox, w_br_mla, w_out, ffn_norm, w_up, conv_w, conv_b, w_down,
              final_norm):
    h = x
    for l in range(DEPTH):
        h = h + hybrid_mixer(h, positions, mix_norm[l], w_in[l], b_forget[l],
                             cmp_pe_k[l], cmp_w1_k[l], cmp_w2_k[l],
                             cmp_pe_v[l], cmp_w1_v[l], cmp_w2_v[l],
                             mla_q_norm[l], mla_w_uq[l], mla_kv_norm[l], mla_w_ukv[l],
                             w_br_nsa[l], w_br_fox[l], w_br_mla[l], w_out[l])
        h = h + conv_ffn(h, ffn_norm[l], w_up[l], conv_w[l], conv_b[l], w_down[l])
    return rms_norm(h, final_norm)
```

```cpp
#include <hip/hip_runtime.h>
#include <hip/hip_cooperative_groups.h>
#include <stdint.h>
#include <stdio.h>
namespace cg = cooperative_groups;

#ifndef ONE_LAUNCH
#define ONE_LAUNCH 1
#endif

#define DI __device__ __forceinline__
typedef unsigned short bf16_t;
typedef short bf16x8 __attribute__((ext_vector_type(8)));
typedef float f32x4 __attribute__((ext_vector_type(4)));
typedef float f32x16 __attribute__((ext_vector_type(16)));
typedef float f32x2 __attribute__((ext_vector_type(2)));
typedef __bf16 bfx2 __attribute__((ext_vector_type(2)));
typedef unsigned u32x4 __attribute__((ext_vector_type(4)));
typedef unsigned u32x2 __attribute__((ext_vector_type(2)));
typedef unsigned long long u64;

constexpr int T_ = 32768, S_ = 4096, NB_ = 8, D_ = 1024, DFF_ = 2816, NIN_ = 6592;
constexpr float EPS_ = 1e-6f;
constexpr float LOG2E_ = 1.4426950408889634f;
constexpr float QS64_ = 0.125f * LOG2E_;
constexpr float QS96_ = 0.10206207261596577f * LOG2E_;

constexpr size_t W_IN = 0;
constexpr size_t W_G = W_IN + (size_t)3584 * 1024;
constexpr size_t W_1K = W_G + (size_t)3072 * 1024;
constexpr size_t W_1V = W_1K + (size_t)256 * 2048;
constexpr size_t W_2K = W_1V + (size_t)256 * 2048;
constexpr size_t W_2V = W_2K + (size_t)64 * 256;
constexpr size_t W_UQ = W_2V + (size_t)64 * 256;
constexpr size_t W_UKV = W_UQ + (size_t)768 * 384;
constexpr size_t W_BN = W_UKV + (size_t)1024 * 256;
constexpr size_t W_BF = W_BN + (size_t)1024 * 512;
constexpr size_t W_BM = W_BF + (size_t)1024 * 512;
constexpr size_t W_OUT = W_BM + (size_t)1024 * 512;
constexpr size_t W_UP = W_OUT + (size_t)1024 * 1024;
constexpr size_t W_DN = W_UP + (size_t)5632 * 1024;
constexpr size_t W_LAYER = W_DN + (size_t)1024 * 2816;

constexpr size_t al256(size_t x) { return (x + 255) & ~(size_t)255; }
constexpr size_t O_BAR = 0;
constexpr size_t O_W = 4096;
constexpr size_t O_BIAS1 = al256(O_W + 2 * W_LAYER * 2);
constexpr size_t O_ROPE8 = al256(O_BIAS1 + 2 * 2 * 256 * 4);
constexpr size_t O_ROPE16 = al256(O_ROPE8 + (size_t)T_ * 16 * 4);
constexpr size_t O_XG = al256(O_ROPE16 + (size_t)T_ * 32 * 4);
constexpr size_t O_SSQ = al256(O_XG + (size_t)T_ * 1024 * 2);
constexpr size_t O_CSSQ = al256(O_SSQ + (size_t)T_ * 16 * 4);
constexpr size_t O_NSAQ = al256(O_CSSQ + (size_t)T_ * 16 * 4);
constexpr size_t O_KVCMP = O_NSAQ + (size_t)T_ * 512 * 2;
constexpr size_t O_KSLC = O_KVCMP + (size_t)T_ * 256 * 2;
constexpr size_t O_KWIN = O_KSLC + (size_t)T_ * 128 * 2;
constexpr size_t O_MERGED = O_NSAQ;
constexpr size_t O_VSLCT = O_KWIN + (size_t)T_ * 128 * 2;
constexpr size_t O_VWINT = O_VSLCT + (size_t)T_ * 128 * 2;
constexpr size_t O_FOXQ = O_VWINT + (size_t)T_ * 128 * 2;
constexpr size_t O_FOXK = O_FOXQ + (size_t)T_ * 512 * 2;
constexpr size_t O_FOXVT = O_FOXK + (size_t)T_ * 512 * 2;
constexpr size_t O_MLAQ = O_FOXVT + (size_t)T_ * 512 * 2;
constexpr size_t O_MLAKN = O_MLAQ + (size_t)T_ * 768 * 2;
constexpr size_t O_ACT = O_FOXQ;
constexpr size_t O_MLAVT = O_MLAKN + (size_t)T_ * 512 * 2;
constexpr size_t O_MLAKPE = O_MLAVT + (size_t)T_ * 512 * 2;
constexpr size_t O_ONSA = O_MLAKPE + (size_t)T_ * 32 * 2;
constexpr size_t O_CQ = O_ONSA;
constexpr size_t O_CKV = O_CQ + (size_t)T_ * 384 * 2;
constexpr size_t O_CEND = O_CKV + (size_t)T_ * 256 * 2;
constexpr size_t O_GATES = al256(O_CEND > O_ONSA + (size_t)T_ * 512 * 2 ? O_CEND : O_ONSA + (size_t)T_ * 512 * 2);
constexpr size_t O_LOGF = al256(O_GATES + (size_t)T_ * 24 * 4);
constexpr size_t O_F2 = al256(O_LOGF + (size_t)T_ * 8 * 4);
constexpr size_t O_KCP = al256(O_F2 + (size_t)T_ * 8 * 4);
constexpr size_t O_SEL = al256(O_KCP + (size_t)2 * 2 * 4096 * 64 * 4);
constexpr size_t O_END = al256(O_SEL + (size_t)NB_ * 2 * S_ * 8);

struct Params {
  const float* x; const int* pos; const float* mix_norm; const float* w_in; const float* b_forget;
  const float* pe_k; const float* w1_k; const float* w2_k; const float* pe_v; const float* w1_v; const float* w2_v;
  const float* q_norm; const float* w_uq; const float* kv_norm; const float* w_ukv;
  const float* wbr_nsa; const float* wbr_fox; const float* wbr_mla; const float* w_out;
  const float* ffn_norm; const float* w_up; const float* conv_w; const float* conv_b; const float* w_down; const float* final_norm;
  float* out; unsigned char* ws;
};

constexpr int SMEM_BYTES = 73728;

DI int TIDX() { int t = (int)threadIdx.x; asm volatile("" : "+v"(t)); return t; }
DI unsigned pk2(float lo, float hi) { f32x2 v = {lo, hi}; return __builtin_bit_cast(unsigned, __builtin_convertvector(v, bfx2)); }
DI bf16_t f2bf(float x) { return (bf16_t)(pk2(x, 0.f) & 0xffffu); }
DI float bf2f(bf16_t h) { return __uint_as_float(((unsigned)h) << 16); }
DI float sigmoidf_(float x) { return 1.f / (1.f + __expf(-x)); }
DI float gelu_tanh(float x) { const float u = 0.7978845608028654f * (x + 0.044715f * x * x * x); return x / (1.f + __expf(-2.f * u)); }
DI float ex2(float x) { return __builtin_amdgcn_exp2f(x); }
DI f32x16 mfma32(bf16x8 a, bf16x8 b, f32x16 c) { return __builtin_amdgcn_mfma_f32_32x32x16_bf16(a, b, c, 0, 0, 0); }
DI f32x4 mfma16(bf16x8 a, bf16x8 b, f32x4 c) { return __builtin_amdgcn_mfma_f32_16x16x32_bf16(a, b, c, 0, 0, 0); }
DI float rstd_from16(const float* p, float inv_n) {
  const f32x4 a = *(const f32x4*)p, b = *(const f32x4*)(p + 4), c = *(const f32x4*)(p + 8), d = *(const f32x4*)(p + 12);
  const float s = ((a[0] + a[1]) + (a[2] + a[3])) + ((b[0] + b[1]) + (b[2] + b[3])) + ((c[0] + c[1]) + (c[2] + c[3])) + ((d[0] + d[1]) + (d[2] + d[3]));
  return rsqrtf(s * inv_n + EPS_);
}

constexpr int LDT = 72;
template <int NJ> struct GemmLds { static constexpr int BN = 32 * NJ; static constexpr int A_ELEMS = 128 * LDT, B_ELEMS = BN * LDT, STAGE = A_ELEMS + B_ELEMS; };

template <int NJ, bool SWAP, class AP, class BP>
DI void gemm_main(f32x4 (&acc)[4][NJ], const AP& ap, int a_kstep, const BP& bp, int b_kstep, int nk, bf16_t* smem) {
  typedef GemmLds<NJ> L;
  constexpr int CB = L::BN / 32;
  const int tid = TIDX(), lane = tid & 63, wid = tid >> 6, wm = wid >> 1, wn = wid & 1, l15 = lane & 15, quad = lane >> 4;
  unsigned pa[4], pb[CB]; bool oka[4];
#pragma unroll
  for (int i = 0; i < 4; ++i) { const int c = tid + 256 * i; pa[i] = ap(c >> 3) + (c & 7) * 8; oka[i] = ap.ok(c >> 3); }
#pragma unroll
  for (int i = 0; i < CB; ++i) { const int c = tid + 256 * i; pb[i] = bp(c >> 3) + (c & 7) * 8; }
  u32x4 ra[4], rb[CB];
  auto gload = [&](int kt) {
    const bf16_t* ab = ap.base + (size_t)kt * a_kstep; const bf16_t* bb = bp.base + (size_t)kt * b_kstep;
#pragma unroll
    for (int i = 0; i < 4; ++i) ra[i] = *(const u32x4*)(ab + pa[i]);
#pragma unroll
    for (int i = 0; i < CB; ++i) rb[i] = *(const u32x4*)(bb + pb[i]);
  };
  auto sstore = [&](int buf) {
    bf16_t* As = smem + buf * L::STAGE; bf16_t* Bs = As + L::A_ELEMS;
#pragma unroll
    for (int i = 0; i < 4; ++i) { const int c = tid + 256 * i; *(u32x4*)(As + (c >> 3) * LDT + (c & 7) * 8) = oka[i] ? ra[i] : (u32x4){0u, 0u, 0u, 0u}; }
#pragma unroll
    for (int i = 0; i < CB; ++i) { const int c = tid + 256 * i; *(u32x4*)(Bs + (c >> 3) * LDT + (c & 7) * 8) = rb[i]; }
  };
  gload(0); sstore(0); __syncthreads();
  for (int kt = 0; kt < nk; ++kt) {
    const int buf = kt & 1;
    if (kt + 1 < nk) gload(kt + 1);
    const bf16_t* As = smem + buf * L::STAGE + (wm * 64 + l15) * LDT + quad * 8;
    const bf16_t* Bs = smem + buf * L::STAGE + L::A_ELEMS + (wn * 16 * NJ + l15) * LDT + quad * 8;
#pragma unroll
    for (int ks = 0; ks < 2; ++ks) {
      bf16x8 a[4];
#pragma unroll
      for (int i = 0; i < 4; ++i) a[i] = *(const bf16x8*)(As + i * 16 * LDT + ks * 32);
#pragma unroll
      for (int j = 0; j < NJ; ++j) {
        const bf16x8 b = *(const bf16x8*)(Bs + j * 16 * LDT + ks * 32);
#pragma unroll
        for (int i = 0; i < 4; ++i) acc[i][j] = SWAP ? mfma16(b, a[i], acc[i][j]) : mfma16(a[i], b, acc[i][j]);
      }
    }
    if (kt + 1 < nk) sstore(buf ^ 1);
    __syncthreads();
  }
}
template <int NJ> DI void zero_acc(f32x4 (&acc)[4][NJ]) {
#pragma unroll
  for (int i = 0; i < 4; ++i)
#pragma unroll
    for (int j = 0; j < NJ; ++j) acc[i][j] = (f32x4){0.f, 0.f, 0.f, 0.f};
}
struct RowPtr { const bf16_t* base; size_t ld; DI unsigned operator()(int r) const { return (unsigned)r * (unsigned)ld; } DI bool ok(int) const { return true; } };


DI int map_col(int map, int n) {
  if (map == 0) return n;
  if (map == 1) {
    if (n < 1280) return n;
    if (n < 2816) return 1304 + (n - 1280);
    if (n < 3200) return 2848 + (n - 2816);
    if (n < 3456) return 3232 + (n - 3200);
    const int c = n - 3456;
    if (c < 24) return 1280 + c;
    if (c < 32) return 2840 + (c - 24);
    if (c < 64) return 3488 + (c - 32);
    return -1;
  }
  if (map == 2) { const int j = n >> 7, c = n & 127; return c < 64 ? j * 64 + c : DFF_ + j * 64 + (c - 64); }
  if (map == 3) { return n < 512 ? (n >> 6) * 128 + (n & 63) : ((n - 512) >> 6) * 128 + 64 + ((n - 512) & 63); }
  return n;
}
struct WJob { const float* src; const float* scale; bf16_t* dst; int K, N, ld, map, off; };
DI void prep_weight_tile(const WJob& j, int tile, float* lds) {
  const int ntn = j.N >> 6, tk = tile / ntn, tn = tile % ntn, tid = TIDX();
  const int n = tn * 64 + (tid & 63); const int sc = map_col(j.map, n);
#pragma unroll 4
  for (int i = 0; i < 16; ++i) {
    const int kk = (tid >> 6) + 4 * i, k = tk * 64 + kk;
    float v = sc >= 0 ? j.src[(size_t)k * j.ld + j.off + sc] : 0.f;
    if (j.scale) v *= j.scale[k];
    lds[kk * 65 + (tid & 63)] = v;
  }
  __syncthreads();
  const int nn = tid >> 2, k0 = (tid & 3) * 16;
  unsigned w[8];
#pragma unroll
  for (int e = 0; e < 8; ++e) w[e] = pk2(lds[(k0 + 2 * e) * 65 + nn], lds[(k0 + 2 * e + 1) * 65 + nn]);
  bf16_t* d = j.dst + (size_t)(tn * 64 + nn) * j.K + tk * 64 + k0;
  *(u32x4*)d = (u32x4){w[0], w[1], w[2], w[3]}; *(u32x4*)(d + 8) = (u32x4){w[4], w[5], w[6], w[7]};
  __syncthreads();
}
DI WJob get_wjob(const Params& p, int layer, int id) {
  bf16_t* wl = (bf16_t*)(p.ws + O_W) + (size_t)layer * W_LAYER; WJob j; j.scale = nullptr; j.map = 0; j.off = 0;
  switch (id) {
    case 0: j.src = p.w_in + (size_t)layer * 1024 * NIN_; j.dst = wl + W_IN; j.K = 1024; j.N = 3584; j.ld = NIN_; j.map = 1; break;
    case 1: j.src = p.w_in + (size_t)layer * 1024 * NIN_; j.dst = wl + W_G; j.K = 1024; j.N = 3072; j.ld = NIN_; j.off = 3520; break;
    case 2: j.src = p.w1_k + (size_t)layer * 2048 * 256; j.dst = wl + W_1K; j.K = 2048; j.N = 256; j.ld = 256; break;
    case 3: j.src = p.w1_v + (size_t)layer * 2048 * 256; j.dst = wl + W_1V; j.K = 2048; j.N = 256; j.ld = 256; break;
    case 4: j.src = p.w2_k + (size_t)layer * 256 * 64; j.dst = wl + W_2K; j.K = 256; j.N = 64; j.ld = 64; break;
    case 5: j.src = p.w2_v + (size_t)layer * 256 * 64; j.dst = wl + W_2V; j.K = 256; j.N = 64; j.ld = 64; break;
    case 6: j.src = p.w_uq + (size_t)layer * 384 * 768; j.dst = wl + W_UQ; j.K = 384; j.N = 768; j.ld = 768; j.scale = p.q_norm + layer * 384; break;
    case 7: j.src = p.w_ukv + (size_t)layer * 256 * 1024; j.dst = wl + W_UKV; j.K = 256; j.N = 1024; j.ld = 1024; j.scale = p.kv_norm + layer * 256; j.map = 3; break;
    case 8: j.src = p.wbr_nsa + (size_t)layer * 512 * 1024; j.dst = wl + W_BN; j.K = 512; j.N = 1024; j.ld = 1024; break;
    case 9: j.src = p.wbr_fox + (size_t)layer * 512 * 1024; j.dst = wl + W_BF; j.K = 512; j.N = 1024; j.ld = 1024; break;
    case 10: j.src = p.wbr_mla + (size_t)layer * 512 * 1024; j.dst = wl + W_BM; j.K = 512; j.N = 1024; j.ld = 1024; break;
    case 11: j.src = p.w_out + (size_t)layer * 1024 * 1024; j.dst = wl + W_OUT; j.K = 1024; j.N = 1024; j.ld = 1024; break;
    case 12: j.src = p.w_up + (size_t)layer * 1024 * 5632; j.dst = wl + W_UP; j.K = 1024; j.N = 5632; j.ld = 5632; j.map = 2; break;
    default: j.src = p.w_down + (size_t)layer * 2816 * 1024; j.dst = wl + W_DN; j.K = 2816; j.N = 1024; j.ld = 1024; break;
  }
  return j;
}
constexpr int WTILES_LAYER = (int)(W_LAYER / 4096);
constexpr int P0_XITEMS = T_ / 32;
constexpr int P0_ROPE_ITEMS = T_ / 256;
constexpr int P0_ITEMS = 2 * WTILES_LAYER + 4 + P0_ROPE_ITEMS + P0_XITEMS;

DI void xg_rows(const float* x, const float* g, bf16_t* xg, float* ssq, int row0) {
  const int lane = TIDX() & 63, wid = TIDX() >> 6;
  for (int rr = 0; rr < 8; ++rr) {
    const int t = row0 + wid * 8 + rr; const float* xr = x + (size_t)t * D_; float s = 0.f;
#pragma unroll
    for (int c = 0; c < 4; ++c) {
      const int k = c * 256 + lane * 4; const f32x4 v = *(const f32x4*)(xr + k), gv = *(const f32x4*)(g + k);
      s += v[0] * v[0] + v[1] * v[1] + v[2] * v[2] + v[3] * v[3];
      *(u32x2*)(xg + (size_t)t * D_ + k) = (u32x2){pk2(v[0] * gv[0], v[1] * gv[1]), pk2(v[2] * gv[2], v[3] * gv[3])};
    }
#pragma unroll
    for (int o = 32; o >= 1; o >>= 1) s += __shfl_xor(s, o);
    if (lane < 16) ssq[(size_t)t * 16 + lane] = lane == 0 ? s : 0.f;
  }
}
DI void phase_prep(const Params& p, unsigned char* smem) {
  for (int it = blockIdx.x; it < P0_ITEMS; it += gridDim.x) {
    int i = it;
    if (i < 2 * WTILES_LAYER) {
      const int layer = i / WTILES_LAYER; int t = i % WTILES_LAYER; int id = 0;
      for (;; ++id) { const WJob j = get_wjob(p, layer, id); const int nt = (j.K >> 6) * (j.N >> 6); if (t < nt) { prep_weight_tile(j, t, (float*)smem); break; } t -= nt; }
      continue;
    }
    i -= 2 * WTILES_LAYER;
    if (i < 4) {
      const int layer = i >> 1, kv = i & 1, c = TIDX();
      const float* pe = (kv ? p.pe_v : p.pe_k) + (size_t)layer * 2048; const float* w1 = (kv ? p.w1_v : p.w1_k) + (size_t)layer * 2048 * 256;
      float s = 0.f;
      for (int kk = 0; kk < 2048; ++kk) s += pe[kk] * w1[(size_t)kk * 256 + c];
      ((float*)(p.ws + O_BIAS1))[(layer * 2 + kv) * 256 + c] = s;
      continue;
    }
    i -= 4;
    if (i < P0_ROPE_ITEMS) {
      const int t = i * 256 + TIDX(); const float fp = (float)p.pos[t];
      float* r8 = (float*)(p.ws + O_ROPE8) + (size_t)t * 16; float* r16 = (float*)(p.ws + O_ROPE16) + (size_t)t * 32;
      for (int f = 0; f < 24; ++f) {
        const int half = f < 8 ? 8 : 16, idx = f < 8 ? f : f - 8;
        const float inv = exp2f(-(float)idx / (float)half * 18.931568569324174f);
        const float ang = fp * inv;
        const double rev = (double)ang * 0.15915494309189535; const float fr = (float)(rev - floor(rev));
        const float sn = __builtin_amdgcn_sinf(fr), cs = __builtin_amdgcn_cosf(fr);
        if (f < 8) { r8[2 * idx] = cs; r8[2 * idx + 1] = sn; } else { r16[2 * idx] = cs; r16[2 * idx + 1] = sn; }
      }
      continue;
    }
    i -= P0_ROPE_ITEMS;
    xg_rows(p.x, p.mix_norm, (bf16_t*)(p.ws + O_XG), (float*)(p.ws + O_SSQ), i * 32);
  }
}

template <bool SWAP> DI void inproj_tile(const Params& p, int layer, int tm, int tn, bf16_t* smem) {
  const bf16_t* wl = (const bf16_t*)(p.ws + O_W) + (size_t)layer * W_LAYER;
  f32x4 acc[4][4]; zero_acc<4>(acc);
  RowPtr ap{(const bf16_t*)(p.ws + O_XG) + (size_t)tm * 128 * D_, (size_t)D_}, bp{wl + W_IN + (size_t)tn * 128 * D_, (size_t)D_};
  gemm_main<4, SWAP>(acc, ap, 64, bp, 64, 16, smem);
  const int lane = TIDX() & 63, wid = TIDX() >> 6, wm = wid >> 1, wn = wid & 1, l15 = lane & 15, quad = lane >> 4;
  const float* ssq = (const float*)(p.ws + O_SSQ);
  if constexpr (!SWAP) {
    bf16_t* dst; int hh;
    if (tn == 7) { dst = (bf16_t*)(p.ws + O_VSLCT); hh = 2; } else if (tn == 9) { dst = (bf16_t*)(p.ws + O_VWINT); hh = 2; } else { dst = (bf16_t*)(p.ws + O_FOXVT); hh = 8; }
    const int hbase = (tn >= 18 ? (tn - 18) * 2 : 0) + wn;
#pragma unroll
    for (int i = 0; i < 4; ++i) {
      const int t0 = tm * 128 + wm * 64 + i * 16 + quad * 4; const int b = t0 >> 12, s = t0 & 4095;
      float rs[4];
#pragma unroll
      for (int r = 0; r < 4; ++r) rs[r] = rstd_from16(ssq + (size_t)(t0 + r) * 16, 1.f / 1024.f);
#pragma unroll
      for (int j = 0; j < 4; ++j) {
        const int d = j * 16 + l15;
        *(u32x2*)(dst + ((size_t)(b * hh + hbase) * 64 + d) * S_ + s) = (u32x2){pk2(acc[i][j][0] * rs[0], acc[i][j][1] * rs[1]), pk2(acc[i][j][2] * rs[2], acc[i][j][3] * rs[3])};
      }
    }
    return;
  } else {
#pragma unroll
    for (int i = 0; i < 4; ++i) {
      const int t = tm * 128 + wm * 64 + i * 16 + l15; const float rs = rstd_from16(ssq + (size_t)t * 16, 1.f / 1024.f);
      const int cw = wn * 64 + quad * 4;
      if (tn < 4 || (tn >= 10 && tn < 14)) {
        bf16_t* dst = (bf16_t*)(p.ws + (tn < 4 ? O_NSAQ : O_FOXQ)) + (size_t)t * 512 + (tn < 4 ? tn : tn - 10) * 128 + cw; const float sc = rs * QS64_;
#pragma unroll
        for (int j = 0; j < 4; ++j) *(u32x2*)(dst + j * 16) = (u32x2){pk2(acc[i][j][0] * sc, acc[i][j][1] * sc), pk2(acc[i][j][2] * sc, acc[i][j][3] * sc)};
      } else if (tn == 4 || tn == 5) {
        bf16_t* dst = (bf16_t*)(p.ws + O_KVCMP) + (size_t)t * 256 + (tn - 4) * 128 + cw;
#pragma unroll
        for (int j = 0; j < 4; ++j) *(u32x2*)(dst + j * 16) = (u32x2){pk2(acc[i][j][0] * rs, acc[i][j][1] * rs), pk2(acc[i][j][2] * rs, acc[i][j][3] * rs)};
      } else if (tn == 6 || tn == 8) {
        bf16_t* dst = (bf16_t*)(p.ws + (tn == 6 ? O_KSLC : O_KWIN)) + (size_t)t * 128 + cw;
        const float* rp = (const float*)(p.ws + O_ROPE8) + (size_t)t * 16 + (quad & 1) * 8;
        float v[4], o[4];
#pragma unroll
        for (int r = 0; r < 4; ++r) { v[r] = acc[i][0][r] * rs; o[r] = __shfl_xor(v[r], 32); }
#pragma unroll
        for (int r = 0; r < 4; ++r) { const float cs = rp[2 * r], sn = rp[2 * r + 1]; v[r] = quad < 2 ? v[r] * cs - o[r] * sn : v[r] * cs + o[r] * sn; }
        *(u32x2*)(dst) = (u32x2){pk2(v[0], v[1]), pk2(v[2], v[3])};
#pragma unroll
        for (int j = 1; j < 4; ++j) *(u32x2*)(dst + j * 16) = (u32x2){pk2(acc[i][j][0] * rs, acc[i][j][1] * rs), pk2(acc[i][j][2] * rs, acc[i][j][3] * rs)};
      } else if (tn >= 14 && tn < 18) {
        bf16_t* dst = (bf16_t*)(p.ws + O_FOXK) + (size_t)t * 512 + (tn - 14) * 128 + cw;
#pragma unroll
        for (int j = 0; j < 4; ++j) *(u32x2*)(dst + j * 16) = (u32x2){pk2(acc[i][j][0] * rs, acc[i][j][1] * rs), pk2(acc[i][j][2] * rs, acc[i][j][3] * rs)};
      } else if (tn >= 22 && tn < 27) {
        const bool isq = tn < 25; const int ct = isq ? tn - 22 : tn - 25;
        bf16_t* dst = isq ? (bf16_t*)(p.ws + O_CQ) + (size_t)t * 384 + ct * 128 + cw : (bf16_t*)(p.ws + O_CKV) + (size_t)t * 256 + ct * 128 + cw;
        float s = 0.f;
#pragma unroll
        for (int j = 0; j < 4; ++j) {
          const float a0 = acc[i][j][0] * rs, a1 = acc[i][j][1] * rs, a2 = acc[i][j][2] * rs, a3 = acc[i][j][3] * rs;
          s += a0 * a0 + a1 * a1 + a2 * a2 + a3 * a3;
          *(u32x2*)(dst + j * 16) = (u32x2){pk2(a0, a1), pk2(a2, a3)};
        }
        s += __shfl_xor(s, 16); s += __shfl_xor(s, 32);
        if (quad == 0) ((float*)(p.ws + O_CSSQ))[(size_t)t * 16 + (isq ? 0 : 8) + ct * 2 + wn] = s;
      } else if (tn == 27) {
        if (wn == 0) {
          float* gt = (float*)(p.ws + O_GATES) + (size_t)t * 24; float* lf = (float*)(p.ws + O_LOGF) + (size_t)t * 8;
#pragma unroll
          for (int r = 0; r < 4; ++r) gt[quad * 4 + r] = sigmoidf_(acc[i][0][r] * rs);
          if (quad < 2) {
#pragma unroll
            for (int r = 0; r < 4; ++r) gt[16 + quad * 4 + r] = sigmoidf_(acc[i][1][r] * rs);
          } else {
#pragma unroll
            for (int r = 0; r < 4; ++r) { const int h = (quad - 2) * 4 + r; const float xx = acc[i][1][r] * rs + p.b_forget[layer * 8 + h]; lf[h] = fminf(xx, 0.f) - log1pf(__expf(-fabsf(xx))); }
          }
          const float* rp = (const float*)(p.ws + O_ROPE16) + (size_t)t * 32 + quad * 8; float o1[4], o2[4];
#pragma unroll
          for (int r = 0; r < 4; ++r) { const float cs = rp[2 * r], sn = rp[2 * r + 1], x1 = acc[i][2][r] * rs, x2 = acc[i][3][r] * rs; o1[r] = x1 * cs - x2 * sn; o2[r] = x2 * cs + x1 * sn; }
          bf16_t* kp = (bf16_t*)(p.ws + O_MLAKPE) + (size_t)t * 32 + quad * 4;
          *(u32x2*)kp = (u32x2){pk2(o1[0], o1[1]), pk2(o1[2], o1[3])}; *(u32x2*)(kp + 16) = (u32x2){pk2(o2[0], o2[1]), pk2(o2[2], o2[3])};
        }
      }
    }
  }
}
constexpr int PA_ITEMS = 256 * 28;
DI void phase_inproj(const Params& p, int layer, unsigned char* smem) {
  for (int it = blockIdx.x; it < PA_ITEMS; it += gridDim.x) {
    const int tn = it / 256, tm = it % 256;
    const bool vt = (tn == 7 || tn == 9 || (tn >= 18 && tn < 22));
    if (vt) inproj_tile<false>(p, layer, tm, tn, (bf16_t*)smem); else inproj_tile<true>(p, layer, tm, tn, (bf16_t*)smem);
  }
}

template <bool SWAP> DI void mlaup_tile(const Params& p, int layer, int tm, int tn, bf16_t* smem) {
  const bf16_t* wl = (const bf16_t*)(p.ws + O_W) + (size_t)layer * W_LAYER;
  f32x4 acc[4][4]; zero_acc<4>(acc);
  const bool isq = tn < 6; const int K = isq ? 384 : 256;
  RowPtr ap{isq ? (const bf16_t*)(p.ws + O_CQ) + (size_t)tm * 128 * 384 : (const bf16_t*)(p.ws + O_CKV) + (size_t)tm * 128 * 256, (size_t)K};
  RowPtr bp{isq ? wl + W_UQ + (size_t)tn * 128 * 384 : wl + W_UKV + (size_t)(tn - 6) * 128 * 256, (size_t)K};
  gemm_main<4, SWAP>(acc, ap, 64, bp, 64, K / 64, smem);
  const int lane = TIDX() & 63, wid = TIDX() >> 6, wm = wid >> 1, wn = wid & 1, l15 = lane & 15, quad = lane >> 4;
  const float* cssq = (const float*)(p.ws + O_CSSQ);
  if constexpr (!SWAP) {
    bf16_t* dst = (bf16_t*)(p.ws + O_MLAVT); const int h = (tn - 10) * 2 + wn;
#pragma unroll
    for (int i = 0; i < 4; ++i) {
      const int t0 = tm * 128 + wm * 64 + i * 16 + quad * 4; const int b = t0 >> 12, s = t0 & 4095; float rs[4];
#pragma unroll
      for (int r = 0; r < 4; ++r) { const float* c = cssq + (size_t)(t0 + r) * 16 + 8; rs[r] = rsqrtf((c[0] + c[1] + c[2] + c[3]) * (1.f / 256.f) + EPS_); }
#pragma unroll
      for (int j = 0; j < 4; ++j) {
        const int d = j * 16 + l15;
        *(u32x2*)(dst + ((size_t)(b * 8 + h) * 64 + d) * S_ + s) = (u32x2){pk2(acc[i][j][0] * rs[0], acc[i][j][1] * rs[1]), pk2(acc[i][j][2] * rs[2], acc[i][j][3] * rs[3])};
      }
    }
  } else {
#pragma unroll
    for (int i = 0; i < 4; ++i) {
      const int t = tm * 128 + wm * 64 + i * 16 + l15; const float* c = cssq + (size_t)t * 16;
      if (isq) {
        const float rs = rsqrtf((c[0] + c[1] + c[2] + c[3] + c[4] + c[5]) * (1.f / 384.f) + EPS_) * QS96_;
        const int n0 = tn * 128 + wn * 64; bf16_t* dst = (bf16_t*)(p.ws + O_MLAQ) + (size_t)t * 768 + n0 + quad * 4;
        const float* rp = (const float*)(p.ws + O_ROPE16) + (size_t)t * 32 + quad * 8;
#pragma unroll
        for (int j = 0; j < 4; ++j) {
          const int c0 = (n0 + j * 16) % 96;
          if (c0 < 64) { *(u32x2*)(dst + j * 16) = (u32x2){pk2(acc[i][j][0] * rs, acc[i][j][1] * rs), pk2(acc[i][j][2] * rs, acc[i][j][3] * rs)}; }
          else if (c0 == 64 && j < 3) {
            float o1[4], o2[4];
#pragma unroll
            for (int r = 0; r < 4; ++r) { const float cs = rp[2 * r], sn = rp[2 * r + 1], x1 = acc[i][j][r] * rs, x2 = acc[i][j < 3 ? j + 1 : j][r] * rs; o1[r] = x1 * cs - x2 * sn; o2[r] = x2 * cs + x1 * sn; }
            *(u32x2*)(dst + j * 16) = (u32x2){pk2(o1[0], o1[1]), pk2(o1[2], o1[3])}; *(u32x2*)(dst + j * 16 + 16) = (u32x2){pk2(o2[0], o2[1]), pk2(o2[2], o2[3])};
          }
        }
      } else {
        const float rs = rsqrtf((c[8] + c[9] + c[10] + c[11]) * (1.f / 256.f) + EPS_);
        bf16_t* dst = (bf16_t*)(p.ws + O_MLAKN) + (size_t)t * 512 + (tn - 6) * 128 + wn * 64 + quad * 4;
#pragma unroll
        for (int j = 0; j < 4; ++j) *(u32x2*)(dst + j * 16) = (u32x2){pk2(acc[i][j][0] * rs, acc[i][j][1] * rs), pk2(acc[i][j][2] * rs, acc[i][j][3] * rs)};
      }
    }
  }
}
struct CmpRowPtr { const bf16_t* base; int r0;
  DI unsigned operator()(int r) const { int R = r0 + r; if (R >= 4080) R = 0; const int b = R / 510, rem = R - b * 510, n = rem >> 1, g = rem & 1; return (unsigned)(b * S_ + 16 * n) * 256u + g * 64; }
  DI bool ok(int r) const { return r0 + r < 4080; } };
DI void compress_item(const Params& p, int layer, int item, bf16_t* smem) {
  const int kv = item >> 6, nh = (item >> 5) & 1, tm = item & 31;
  const bf16_t* wl = (const bf16_t*)(p.ws + O_W) + (size_t)layer * W_LAYER;
  f32x4 acc[4][4]; zero_acc<4>(acc);
  CmpRowPtr ap{(const bf16_t*)(p.ws + O_KVCMP) + kv * 128, tm * 128};
  RowPtr bp{wl + (kv ? W_1V : W_1K) + (size_t)nh * 128 * 2048, (size_t)2048};
  gemm_main<4, true>(acc, ap, 256, bp, 64, 32, smem);
  const int lane = TIDX() & 63, wid = TIDX() >> 6, wm = wid >> 1, wn = wid & 1, l15 = lane & 15, quad = lane >> 4;
  constexpr int LDH = 136; bf16_t* H = smem;
  const float* b1 = (const float*)(p.ws + O_BIAS1) + (layer * 2 + kv) * 256 + nh * 128;
#pragma unroll
  for (int i = 0; i < 4; ++i)
#pragma unroll
    for (int j = 0; j < 4; ++j) {
      const int row = wm * 64 + i * 16 + l15, col = wn * 64 + j * 16 + quad * 4; const f32x4 bv = *(const f32x4*)(b1 + col);
      *(u32x2*)(H + row * LDH + col) = (u32x2){pk2(gelu_tanh(acc[i][j][0] + bv[0]), gelu_tanh(acc[i][j][1] + bv[1])), pk2(gelu_tanh(acc[i][j][2] + bv[2]), gelu_tanh(acc[i][j][3] + bv[3]))};
    }
  __syncthreads();
  f32x4 a2[2][4];
#pragma unroll
  for (int i = 0; i < 2; ++i)
#pragma unroll
    for (int j = 0; j < 4; ++j) a2[i][j] = (f32x4){0.f, 0.f, 0.f, 0.f};
  const bf16_t* w2 = wl + (kv ? W_2V : W_2K) + nh * 128;
#pragma unroll
  for (int ks = 0; ks < 4; ++ks) {
    bf16x8 a[2], b[4];
#pragma unroll
    for (int i = 0; i < 2; ++i) a[i] = *(const bf16x8*)(H + (wid * 32 + i * 16 + l15) * LDH + ks * 32 + quad * 8);
#pragma unroll
    for (int j = 0; j < 4; ++j) b[j] = *(const bf16x8*)(w2 + (size_t)(j * 16 + l15) * 256 + ks * 32 + quad * 8);
#pragma unroll
    for (int i = 0; i < 2; ++i)
#pragma unroll
      for (int j = 0; j < 4; ++j) a2[i][j] = mfma16(a[i], b[j], a2[i][j]);
  }
  float* kcp = (float*)(p.ws + O_KCP) + (size_t)(kv * 2 + nh) * 4096 * 64;
#pragma unroll
  for (int i = 0; i < 2; ++i)
#pragma unroll
    for (int j = 0; j < 4; ++j)
#pragma unroll
      for (int r = 0; r < 4; ++r) { const int R = tm * 128 + wid * 32 + i * 16 + quad * 4 + r; kcp[(size_t)R * 64 + j * 16 + l15] = a2[i][j][r]; }
  __syncthreads();
}
DI void foxscan_item(const Params& p, int item, float* lds) {
  const int b = item >> 3, h = item & 7, tid = TIDX();
  const float* lf = (const float*)(p.ws + O_LOGF) + (size_t)b * S_ * 8 + h; float v[16]; float s = 0.f;
#pragma unroll
  for (int i = 0; i < 16; ++i) { s += lf[(size_t)(tid * 16 + i) * 8]; v[i] = s; }
  lds[tid] = s; __syncthreads();
  float off = 0.f;
  for (int i = 0; i < tid; ++i) off += lds[i];
  float* F2 = (float*)(p.ws + O_F2) + (size_t)(b * 8 + h) * S_ + tid * 16;
#pragma unroll
  for (int i = 0; i < 16; ++i) F2[i] = -(off + v[i]) * LOG2E_;
  __syncthreads();
}
constexpr int PB_ITEMS = 128 + 64 + 256 * 14;
DI void phase_b(const Params& p, int layer, unsigned char* smem) {
  for (int it = blockIdx.x; it < PB_ITEMS; it += gridDim.x) {
    if (it < 128) compress_item(p, layer, it, (bf16_t*)smem);
    else if (it < 192) foxscan_item(p, it - 128, (float*)smem);
    else { const int i = it - 192, tn = i / 256, tm = i % 256; if (tn >= 10) mlaup_tile<false>(p, layer, tm, tn, (bf16_t*)smem); else mlaup_tile<true>(p, layer, tm, tn, (bf16_t*)smem); }
  }
}

constexpr int KC_LD = 72, VC_LD = 264;
DI void cmp_item(const Params& p, int item, unsigned char* smem_) {
  const int b = item >> 7, g = (item >> 6) & 1, tt = item & 63, t0 = tt * 64;
  const int tid = TIDX(), lane = tid & 63, wid = tid >> 6, l15 = lane & 15, quad = lane >> 4;
  bf16_t* kcs = (bf16_t*)smem_;
  bf16_t* vcs = kcs + 256 * KC_LD;
  float* imps = (float*)smem_;
  const int nmax = (t0 + 32) >> 4;
  const int nsub = t0 == 0 && false ? 0 : ((nmax >> 4) + 1);
  {
    const float* k0 = (const float*)(p.ws + O_KCP), *k1 = k0 + (size_t)4096 * 64, *v0 = k0 + (size_t)2 * 4096 * 64, *v1 = k0 + (size_t)3 * 4096 * 64;
    const int nrows = ((nsub + 1) & ~1) * 16;
    for (int e = tid; e < nrows * 16; e += 256) {
      const int n = e >> 4, d4 = (e & 15) * 4;
      f32x4 kk = {0.f, 0.f, 0.f, 0.f}, vv = {0.f, 0.f, 0.f, 0.f};
      if (n < 255) { const size_t R = (size_t)(b * 510 + n * 2 + g) * 64 + d4; kk = *(const f32x4*)(k0 + R) + *(const f32x4*)(k1 + R); vv = *(const f32x4*)(v0 + R) + *(const f32x4*)(v1 + R); }
      *(u32x2*)(kcs + n * KC_LD + d4) = (u32x2){pk2(kk[0], kk[1]), pk2(kk[2], kk[3])};
#pragma unroll
      for (int r = 0; r < 4; ++r) vcs[(d4 + r) * VC_LD + n] = f2bf(vv[r]);
    }
  }
  __syncthreads();
  const int tq = t0 + wid * 16 + l15;
  const size_t trow = (size_t)b * S_ + tq;
  float impa[16], p3a[16];
#pragma unroll
  for (int s = 0; s < 16; ++s) { impa[s] = 0.f; p3a[s] = 0.f; }
  const float* gts = (const float*)(p.ws + O_GATES) + trow * 24;
#pragma unroll 1
  for (int r4 = 0; r4 < 4; ++r4) {
    const int head = g * 4 + r4;
    const bf16_t* qp = (const bf16_t*)(p.ws + O_NSAQ) + trow * 512 + head * 64 + quad * 8;
    const bf16x8 q0 = *(const bf16x8*)qp, q1 = *(const bf16x8*)(qp + 32);
    auto score = [&](int s) -> f32x4 {
      const bf16_t* kr = kcs + (s * 16 + l15) * KC_LD + quad * 8;
      f32x4 a = {0.f, 0.f, 0.f, 0.f};
      a = mfma16(*(const bf16x8*)kr, q0, a); a = mfma16(*(const bf16x8*)(kr + 32), q1, a);
#pragma unroll
      for (int r = 0; r < 4; ++r) { const int n = s * 16 + quad * 4 + r; a[r] = (16 * n + 31 <= tq) ? a[r] : -INFINITY; }
      return a;
    };
    float mx = -INFINITY;
#pragma unroll 1
    for (int s = 0; s < nsub; ++s) { const f32x4 a = score(s); mx = fmaxf(mx, fmaxf(fmaxf(a[0], a[1]), fmaxf(a[2], a[3]))); }
    mx = fmaxf(mx, __shfl_xor(mx, 16)); mx = fmaxf(mx, __shfl_xor(mx, 32));
    if (mx == -INFINITY) mx = 0.f;
    float sum = 0.f;
#pragma unroll 1
    for (int s = 0; s < nsub; ++s) { const f32x4 a = score(s); sum += (ex2(a[0] - mx) + ex2(a[1] - mx)) + (ex2(a[2] - mx) + ex2(a[3] - mx)); }
    sum += __shfl_xor(sum, 16); sum += __shfl_xor(sum, 32);
    const float inv = 1.f / fmaxf(sum, 1e-30f);
    f32x4 oacc[4];
#pragma unroll
    for (int j = 0; j < 4; ++j) oacc[j] = (f32x4){0.f, 0.f, 0.f, 0.f};
#pragma unroll
    for (int c = 0; c < 8; ++c) {
      asm volatile("" ::: "memory");
      if (2 * c < nsub) {
        f32x4 pa = score(2 * c), pb = {-INFINITY, -INFINITY, -INFINITY, -INFINITY};
        if (2 * c + 1 < nsub) pb = score(2 * c + 1);
#pragma unroll
        for (int r = 0; r < 4; ++r) { pa[r] = ex2(pa[r] - mx) * inv; pb[r] = ex2(pb[r] - mx) * inv; }
        impa[2 * c] += pa[0] + pa[1] + pa[2] + 0.5f * pa[3]; p3a[2 * c] += pa[3];
        impa[2 * c + 1] += pb[0] + pb[1] + pb[2] + 0.5f * pb[3]; p3a[2 * c + 1] += pb[3];
        const u32x4 pw = {pk2(pa[0], pa[1]), pk2(pa[2], pa[3]), pk2(pb[0], pb[1]), pk2(pb[2], pb[3])};
        const bf16x8 pf = __builtin_bit_cast(bf16x8, pw);
#pragma unroll
        for (int j = 0; j < 4; ++j) {
          const bf16_t* vr = vcs + (j * 16 + l15) * VC_LD + c * 32 + quad * 4;
          const u32x2 lo = *(const u32x2*)vr, hi = *(const u32x2*)(vr + 16);
          const u32x4 vw = {lo[0], lo[1], hi[0], hi[1]};
          oacc[j] = mfma16(__builtin_bit_cast(bf16x8, vw), pf, oacc[j]);
        }
      }
    }
    const float g0 = gts[head * 3 + 0];
    bf16_t* op = (bf16_t*)(p.ws + O_ONSA) + trow * 512 + head * 64 + quad * 4;
#pragma unroll
    for (int j = 0; j < 4; ++j) *(u32x2*)(op + j * 16) = (u32x2){pk2(oacc[j][0] * g0, oacc[j][1] * g0), pk2(oacc[j][2] * g0, oacc[j][3] * g0)};
  }
  __syncthreads();
  float* myimp = imps + wid * 1024 + l15 * 64;
  const int cur = tq >> 6;
#pragma unroll
  for (int s = 0; s < 16; ++s) {
    const float up = __shfl(p3a[s], (lane + 48) & 63);
    const float up0 = s ? __shfl(p3a[s ? s - 1 : 0], (lane + 48) & 63) : 0.f;
    const float prev = quad ? up : up0;
    float v = impa[s] + 0.5f * prev;
    const int j = 4 * s + quad;
    if (j == 0 || j == cur || j == cur - 1) v = 1e9f; else if (j > cur) v = -1e9f;
    myimp[j] = v;
  }
  __syncthreads();
  u64* sel = (u64*)(p.ws + O_SEL) + (size_t)(b * 2 + g) * S_ + t0 + wid * 16;
#pragma unroll 1
  for (int q = 0; q < 16; ++q) {
    const float mine = imps[wid * 1024 + q * 64 + lane]; int rank = 0;
#pragma unroll
    for (int i = 0; i < 64; ++i) { const float v = __uint_as_float(__builtin_amdgcn_readlane(__float_as_uint(mine), i)); rank += (v > mine || (v == mine && i < lane)) ? 1 : 0; }
    const u64 m = __ballot(rank < 16);
    if (lane == 0) sel[q] = m;
  }
  __syncthreads();
}
constexpr int PC_ITEMS = NB_ * 2 * 64;
DI void phase_c(const Params& p, unsigned char* smem) { for (int it = blockIdx.x; it < PC_ITEMS; it += gridDim.x) cmp_item(p, it, smem); }

enum { M_FOX = 0, M_MLA = 1, M_WIN = 2, M_SLC = 3 };
template <int MODE> struct ACfg { static constexpr int DQK = MODE == M_MLA ? 96 : 64, KLD = DQK + 8, KCH = DQK / 8 * 64 / 256, K_ELEMS = 64 * KLD, V_ELEMS = 64 * 72, STAGE = K_ELEMS + V_ELEMS + 128; };
struct AState { f32x16 o[2]; float m, l; };

template <int MODE>
DI void flash_pass(AState& st, const bf16x8* qf, u64 tmask, u64 wmask,
                   const bf16_t* kbase, size_t kld, const bf16_t* kpe, const bf16_t* vtbase, const float* fbias,
                   int tq, u64 mysel, bf16_t* smem) {
  typedef ACfg<MODE> C;
  const int tid = TIDX(), lane = tid & 63, l31 = lane & 31, half = lane >> 5;
  u32x4 rk[C::KCH], rv[2]; float rf = 0.f;
  auto gload = [&](int j) {
    const int k0 = j * 64;
#pragma unroll
    for (int i = 0; i < C::KCH; ++i) {
      const int c = tid + 256 * i;
      if constexpr (MODE == M_MLA) { const int key = c / 12, dc = c % 12; rk[i] = dc < 8 ? *(const u32x4*)(kbase + (size_t)(k0 + key) * kld + dc * 8) : *(const u32x4*)(kpe + (size_t)(k0 + key) * 32 + (dc - 8) * 8); }
      else { const int key = c >> 3, dc = c & 7; rk[i] = *(const u32x4*)(kbase + (size_t)(k0 + key) * kld + dc * 8); }
    }
#pragma unroll
    for (int i = 0; i < 2; ++i) { const int c = tid + 256 * i, d = c >> 3, kc = c & 7; rv[i] = *(const u32x4*)(vtbase + (size_t)d * S_ + k0 + kc * 8); }
    if constexpr (MODE == M_FOX) { if (tid < 64) rf = fbias[k0 + tid]; }
  };
  auto sstore = [&](int buf) {
    bf16_t* Ks = smem + buf * C::STAGE; bf16_t* Vs = Ks + C::K_ELEMS;
#pragma unroll
    for (int i = 0; i < C::KCH; ++i) {
      const int c = tid + 256 * i;
      if constexpr (MODE == M_MLA) { const int key = c / 12, dc = c % 12; *(u32x4*)(Ks + key * C::KLD + dc * 8) = rk[i]; }
      else { const int key = c >> 3, dc = c & 7; *(u32x4*)(Ks + key * C::KLD + dc * 8) = rk[i]; }
    }
#pragma unroll
    for (int i = 0; i < 2; ++i) {
      const int c = tid + 256 * i, d = c >> 3, kc = c & 7, cgp = kc >> 1, a = kc & 1;
      bf16_t* dst = Vs + d * 72 + cgp * 16 + 4 * a;
      *(u32x2*)dst = (u32x2){rv[i][0], rv[i][1]}; *(u32x2*)(dst + 8) = (u32x2){rv[i][2], rv[i][3]};
    }
    if constexpr (MODE == M_FOX) { if (tid < 64) ((float*)(Vs + C::V_ELEMS))[tid] = rf; }
  };
  u64 tm = tmask;
  if (tm == 0) return;
  int j = __builtin_ctzll(tm); tm &= tm - 1;
  gload(j); sstore(0); __syncthreads();
  int buf = 0;
  const int tmin = __builtin_amdgcn_readfirstlane(tq - l31), tmax = tmin + 31;
  while (true) {
    const int jn = tm ? __builtin_ctzll(tm) : -1; if (tm) tm &= tm - 1;
    if (jn >= 0) gload(jn);
    if ((wmask >> j) & 1) {
      const bf16_t* Ks = smem + buf * C::STAGE; const bf16_t* Vs = Ks + C::K_ELEMS;
      f32x16 s0, s1;
#pragma unroll
      for (int r = 0; r < 16; ++r) { s0[r] = 0.f; s1[r] = 0.f; }
      const bf16_t* kr = Ks + l31 * C::KLD + half * 8;
#pragma unroll
      for (int ks = 0; ks < C::DQK / 16; ++ks) {
        s0 = mfma32(*(const bf16x8*)(kr + ks * 16), qf[ks], s0);
        s1 = mfma32(*(const bf16x8*)(kr + 32 * C::KLD + ks * 16), qf[ks], s1);
      }
      const int k0 = j * 64;
      if constexpr (MODE == M_FOX) {
        const float* fb = (const float*)(Vs + C::V_ELEMS) + 4 * half;
#pragma unroll
        for (int g4 = 0; g4 < 4; ++g4) {
          const f32x4 b0 = *(const f32x4*)(fb + 8 * g4), b1 = *(const f32x4*)(fb + 32 + 8 * g4);
#pragma unroll
          for (int r = 0; r < 4; ++r) { s0[4 * g4 + r] += b0[r]; s1[4 * g4 + r] += b1[r]; }
        }
      }
      bool need = k0 + 63 > tmin;
      if constexpr (MODE == M_WIN) need = need || (k0 <= tmax - 512);
      if constexpr (MODE == M_SLC) need = true;
      if (need) {
        const bool rowok = MODE == M_SLC ? ((mysel >> j) & 1) != 0 : true;
#pragma unroll
        for (int r = 0; r < 16; ++r) {
          const int key = k0 + (r & 3) + 8 * (r >> 2) + 4 * half;
          bool ok0 = rowok && key <= tq, ok1 = rowok && key + 32 <= tq;
          if constexpr (MODE == M_WIN) { ok0 = ok0 && (tq - key < 512); ok1 = ok1 && (tq - key - 32 < 512); }
          s0[r] = ok0 ? s0[r] : -INFINITY; s1[r] = ok1 ? s1[r] : -INFINITY;
        }
      }
      float mx = -INFINITY;
#pragma unroll
      for (int r = 0; r < 16; ++r) mx = fmaxf(mx, fmaxf(s0[r], s1[r]));
      mx = fmaxf(mx, __shfl_xor(mx, 32));
      const float mn = fmaxf(st.m, mx), alpha = ex2(st.m - mn);
      st.m = mn;
      float sum = 0.f;
#pragma unroll
      for (int r = 0; r < 16; ++r) { s0[r] = ex2(s0[r] - mn); s1[r] = ex2(s1[r] - mn); sum += s0[r] + s1[r]; }
      st.l = st.l * alpha + sum;
#pragma unroll
      for (int r = 0; r < 16; ++r) { st.o[0][r] *= alpha; st.o[1][r] *= alpha; }
      const bf16_t* vr = Vs + l31 * 72 + half * 8;
#pragma unroll
      for (int c = 0; c < 4; ++c) {
        u32x4 pw;
        if (c < 2) pw = (u32x4){pk2(s0[8 * c + 0], s0[8 * c + 1]), pk2(s0[8 * c + 2], s0[8 * c + 3]), pk2(s0[8 * c + 4], s0[8 * c + 5]), pk2(s0[8 * c + 6], s0[8 * c + 7])};
        else pw = (u32x4){pk2(s1[8 * (c - 2) + 0], s1[8 * (c - 2) + 1]), pk2(s1[8 * (c - 2) + 2], s1[8 * (c - 2) + 3]), pk2(s1[8 * (c - 2) + 4], s1[8 * (c - 2) + 5]), pk2(s1[8 * (c - 2) + 6], s1[8 * (c - 2) + 7])};
        const bf16x8 pf = __builtin_bit_cast(bf16x8, pw);
        st.o[0] = mfma32(*(const bf16x8*)(vr + c * 16), pf, st.o[0]);
        st.o[1] = mfma32(*(const bf16x8*)(vr + 32 * 72 + c * 16), pf, st.o[1]);
      }
    }
    if (jn >= 0) sstore(buf ^ 1);
    __syncthreads();
    if (jn < 0) break;
    j = jn; buf ^= 1;
  }
}
DI void astate_init(AState& s) {
#pragma unroll
  for (int r = 0; r < 16; ++r) { s.o[0][r] = 0.f; s.o[1][r] = 0.f; }
  s.m = -1e30f; s.l = 0.f;
}
DI u64 lowbits(int n) { return n >= 64 ? ~0ull : ((1ull << n) - 1ull); }

template <int MODE> DI void dense_attn_item(const Params& p, int b, int h, int qt, bf16_t* smem) {
  const int lane = TIDX() & 63, wid = TIDX() >> 6, l31 = lane & 31, half = lane >> 5;
  const int t0 = qt * 128, tq = t0 + wid * 32 + l31; const size_t trow = (size_t)b * S_ + tq;
  constexpr int NQ = ACfg<MODE>::DQK / 16;
  bf16x8 qf[NQ];
  const bf16_t* qp = MODE == M_FOX ? (const bf16_t*)(p.ws + O_FOXQ) + trow * 512 + h * 64 : (const bf16_t*)(p.ws + O_MLAQ) + trow * 768 + h * 96;
#pragma unroll
  for (int ks = 0; ks < NQ; ++ks) qf[ks] = *(const bf16x8*)(qp + ks * 16 + half * 8);
  AState st; astate_init(st);
  const u64 tmask = lowbits(2 * qt + 2), wmask = lowbits(((t0 + wid * 32 + 31) >> 6) + 1);
  if constexpr (MODE == M_FOX)
    flash_pass<M_FOX>(st, qf, tmask, wmask, (const bf16_t*)(p.ws + O_FOXK) + (size_t)b * S_ * 512 + h * 64, 512, nullptr,
                      (const bf16_t*)(p.ws + O_FOXVT) + (size_t)(b * 8 + h) * 64 * S_, (const float*)(p.ws + O_F2) + (size_t)(b * 8 + h) * S_, tq, 0ull, smem);
  else
    flash_pass<M_MLA>(st, qf, tmask, wmask, (const bf16_t*)(p.ws + O_MLAKN) + (size_t)b * S_ * 512 + h * 64, 512, (const bf16_t*)(p.ws + O_MLAKPE) + (size_t)b * S_ * 32,
                      (const bf16_t*)(p.ws + O_MLAVT) + (size_t)(b * 8 + h) * 64 * S_, nullptr, tq, 0ull, smem);
  const float l = st.l + __shfl_xor(st.l, 32), inv = 1.f / fmaxf(l, 1e-30f);
  bf16_t* op = (bf16_t*)qp;
#pragma unroll
  for (int dt = 0; dt < 2; ++dt)
#pragma unroll
    for (int g4 = 0; g4 < 4; ++g4) {
      const int d = dt * 32 + g4 * 8 + half * 4;
      *(u32x2*)(op + d) = (u32x2){pk2(st.o[dt][4 * g4] * inv, st.o[dt][4 * g4 + 1] * inv), pk2(st.o[dt][4 * g4 + 2] * inv, st.o[dt][4 * g4 + 3] * inv)};
    }
}
DI void nsa_attn_item(const Params& p, int b, int g, int qt, bf16_t* smem) {
  const int lane = TIDX() & 63, wid = TIDX() >> 6, l31 = lane & 31, half = lane >> 5;
  const int t0 = qt * 32, tq = t0 + l31, head = g * 4 + wid; const size_t trow = (size_t)b * S_ + tq;
  bf16x8 qf[4];
  const bf16_t* qp = (const bf16_t*)(p.ws + O_NSAQ) + trow * 512 + head * 64;
#pragma unroll
  for (int ks = 0; ks < 4; ++ks) qf[ks] = *(const bf16x8*)(qp + ks * 16 + half * 8);
  {
    const float* rp = (const float*)(p.ws + O_ROPE8) + trow * 16;
    u32x4 me = __builtin_bit_cast(u32x4, qf[0]), ot;
#pragma unroll
    for (int e = 0; e < 4; ++e) ot[e] = __shfl_xor(me[e], 32);
    unsigned res[4];
#pragma unroll
    for (int e = 0; e < 4; ++e) {
      float o2[2];
#pragma unroll
      for (int u = 0; u < 2; ++u) {
        const int f = 2 * e + u; const float cs = rp[2 * f], sn = rp[2 * f + 1];
        const float a = bf2f((bf16_t)(u ? me[e] >> 16 : me[e] & 0xffffu)), o = bf2f((bf16_t)(u ? ot[e] >> 16 : ot[e] & 0xffffu));
        o2[u] = half == 0 ? a * cs - o * sn : a * cs + o * sn;
      }
      res[e] = pk2(o2[0], o2[1]);
    }
    qf[0] = __builtin_bit_cast(bf16x8, (u32x4){res[0], res[1], res[2], res[3]});
  }
  const float* gts = (const float*)(p.ws + O_GATES) + trow * 24 + head * 3;
  const int cur = t0 >> 6;
  f32x16 res[2];
  {
    AState st; astate_init(st);
    const int first = t0 >= 511 ? (t0 - 511) >> 6 : 0;
    const u64 tmask = lowbits(cur + 1) & ~lowbits(first);
    flash_pass<M_WIN>(st, qf, tmask, tmask, (const bf16_t*)(p.ws + O_KWIN) + (size_t)b * S_ * 128 + g * 64, 128, nullptr,
                      (const bf16_t*)(p.ws + O_VWINT) + (size_t)(b * 2 + g) * 64 * S_, nullptr, tq, 0ull, smem);
    const float l = st.l + __shfl_xor(st.l, 32), sc = gts[2] / fmaxf(l, 1e-30f);
#pragma unroll
    for (int r = 0; r < 16; ++r) { res[0][r] = st.o[0][r] * sc; res[1][r] = st.o[1][r] * sc; }
  }
  {
    AState st; astate_init(st);
    const u64 mysel = ((const u64*)(p.ws + O_SEL))[(size_t)(b * 2 + g) * S_ + tq];
    unsigned lo = (unsigned)mysel, hi = (unsigned)(mysel >> 32);
#pragma unroll
    for (int o = 16; o >= 1; o >>= 1) { lo |= __shfl_xor(lo, o); hi |= __shfl_xor(hi, o); }
    const u64 um = (((u64)(unsigned)__builtin_amdgcn_readfirstlane(hi) << 32) | (u64)(unsigned)__builtin_amdgcn_readfirstlane(lo)) & lowbits(cur + 1);
    flash_pass<M_SLC>(st, qf, um, um, (const bf16_t*)(p.ws + O_KSLC) + (size_t)b * S_ * 128 + g * 64, 128, nullptr,
                      (const bf16_t*)(p.ws + O_VSLCT) + (size_t)(b * 2 + g) * 64 * S_, nullptr, tq, mysel, smem);
    const float l = st.l + __shfl_xor(st.l, 32), sc = gts[1] / fmaxf(l, 1e-30f);
#pragma unroll
    for (int r = 0; r < 16; ++r) { res[0][r] += st.o[0][r] * sc; res[1][r] += st.o[1][r] * sc; }
  }
  bf16_t* op = (bf16_t*)(p.ws + O_ONSA) + trow * 512 + head * 64;
#pragma unroll
  for (int dt = 0; dt < 2; ++dt)
#pragma unroll
    for (int g4 = 0; g4 < 4; ++g4) {
      const int d = dt * 32 + g4 * 8 + half * 4;
      const u32x2 oc = *(const u32x2*)(op + d);
      const float c0 = bf2f((bf16_t)(oc[0] & 0xffffu)), c1 = bf2f((bf16_t)(oc[0] >> 16)), c2 = bf2f((bf16_t)(oc[1] & 0xffffu)), c3 = bf2f((bf16_t)(oc[1] >> 16));
      *(u32x2*)(op + d) = (u32x2){pk2(res[dt][4 * g4] + c0, res[dt][4 * g4 + 1] + c1), pk2(res[dt][4 * g4 + 2] + c2, res[dt][4 * g4 + 3] + c3)};
    }
}
constexpr int PD_ITEMS = 32 * 192;
DI void phase_d(const Params& p, unsigned char* smem) {
  for (int it = blockIdx.x; it < PD_ITEMS; it += gridDim.x) {
    const int r = it / 192, w = it % 192, qt = 31 - r;
    if (w < 64) dense_attn_item<M_MLA>(p, w >> 3, w & 7, qt, (bf16_t*)smem);
    else if (w < 128) dense_attn_item<M_FOX>(p, (w - 64) >> 3, (w - 64) & 7, qt, (bf16_t*)smem);
    else { const int i = w - 128, bg = i & 15, q4 = i >> 4; nsa_attn_item(p, bg >> 1, bg & 1, qt * 4 + q4, (bf16_t*)smem); }
  }
}

constexpr int PE_ITEMS = 256 * 16;
DI void merge_tile(const Params& p, int layer, int tm, int tn, bf16_t* smem) {
  const bf16_t* wl = (const bf16_t*)(p.ws + O_W) + (size_t)layer * W_LAYER;
  const int lane = TIDX() & 63, wid = TIDX() >> 6, wm = wid >> 1, wn = wid & 1, l15 = lane & 15, quad = lane >> 4;
  f32x4 mg[4][2]; zero_acc<2>(mg);
  unsigned* gsp = (unsigned*)((unsigned char*)smem + 2 * GemmLds<2>::STAGE * 2) + TIDX();
#pragma unroll 1
  for (int br = 0; br < 3; ++br) {
    {
      f32x4 ga[4][2]; zero_acc<2>(ga);
      RowPtr ap{(const bf16_t*)(p.ws + O_XG) + (size_t)tm * 128 * D_, (size_t)D_}, bp{wl + W_G + ((size_t)br * 1024 + tn * 64) * D_, (size_t)D_};
      gemm_main<2, true>(ga, ap, 64, bp, 64, 16, smem);
#pragma unroll
      for (int i = 0; i < 4; ++i) {
        const float rs = rstd_from16((const float*)(p.ws + O_SSQ) + (size_t)(tm * 128 + wm * 64 + i * 16 + l15) * 16, 1.f / 1024.f);
#pragma unroll
        for (int j = 0; j < 2; ++j) {
          gsp[((i * 2 + j) * 2 + 0) * 256] = pk2(sigmoidf_(ga[i][j][0] * rs), sigmoidf_(ga[i][j][1] * rs));
          gsp[((i * 2 + j) * 2 + 1) * 256] = pk2(sigmoidf_(ga[i][j][2] * rs), sigmoidf_(ga[i][j][3] * rs));
        }
      }
    }
    f32x4 ba[4][2]; zero_acc<2>(ba);
    RowPtr bp2{wl + (br == 0 ? W_BN : br == 1 ? W_BF : W_BM) + (size_t)tn * 64 * 512, (size_t)512};
    const bf16_t* abase = (const bf16_t*)(p.ws + (br == 0 ? O_ONSA : br == 1 ? O_FOXQ : O_MLAQ));
    const int ald = br == 2 ? 768 : 512;
    RowPtr ap2{abase + (size_t)tm * 128 * ald, (size_t)ald};
    gemm_main<2, true>(ba, ap2, br == 2 ? 96 : 64, bp2, 64, 8, smem);
#pragma unroll
    for (int i = 0; i < 4; ++i)
#pragma unroll
      for (int j = 0; j < 2; ++j) {
        const unsigned w0 = gsp[((i * 2 + j) * 2 + 0) * 256], w1 = gsp[((i * 2 + j) * 2 + 1) * 256];
        mg[i][j][0] += bf2f((bf16_t)(w0 & 0xffffu)) * ba[i][j][0];
        mg[i][j][1] += bf2f((bf16_t)(w0 >> 16)) * ba[i][j][1];
        mg[i][j][2] += bf2f((bf16_t)(w1 & 0xffffu)) * ba[i][j][2];
        mg[i][j][3] += bf2f((bf16_t)(w1 >> 16)) * ba[i][j][3];
      }
  }
#pragma unroll
  for (int i = 0; i < 4; ++i) {
    bf16_t* dst = (bf16_t*)(p.ws + O_MERGED) + (size_t)(tm * 128 + wm * 64 + i * 16 + l15) * D_ + tn * 64 + wn * 32 + quad * 4;
#pragma unroll
    for (int j = 0; j < 2; ++j) *(u32x2*)(dst + j * 16) = (u32x2){pk2(mg[i][j][0], mg[i][j][1]), pk2(mg[i][j][2], mg[i][j][3])};
  }
}
DI void phase_e(const Params& p, int layer, unsigned char* smem) {
  for (int it = blockIdx.x; it < PE_ITEMS; it += gridDim.x) merge_tile(p, layer, it % 256, it / 256, (bf16_t*)smem);
}

DI void resid_tile(const Params& p, const bf16_t* A, int K, const bf16_t* W, const float* xold, const float* gnext, int tm, int tn, bf16_t* smem) {
  f32x4 acc[4][4]; zero_acc<4>(acc);
  RowPtr ap{A + (size_t)tm * 128 * K, (size_t)K}, bp{W + (size_t)tn * 128 * K, (size_t)K};
  gemm_main<4, true>(acc, ap, 64, bp, 64, K / 64, smem);
  const int lane = TIDX() & 63, wid = TIDX() >> 6, wm = wid >> 1, wn = wid & 1, l15 = lane & 15, quad = lane >> 4;
#pragma unroll
  for (int i = 0; i < 4; ++i) {
    const int t = tm * 128 + wm * 64 + i * 16 + l15, c0 = tn * 128 + wn * 64 + quad * 4; float s = 0.f;
#pragma unroll
    for (int j = 0; j < 4; ++j) {
      const size_t off = (size_t)t * D_ + c0 + j * 16;
      const f32x4 xn = *(const f32x4*)(xold + off) + acc[i][j];
      *(f32x4*)(p.out + off) = xn;
      s += xn[0] * xn[0] + xn[1] * xn[1] + xn[2] * xn[2] + xn[3] * xn[3];
      if (gnext) { const f32x4 gv = *(const f32x4*)(gnext + c0 + j * 16); *(u32x2*)((bf16_t*)(p.ws + O_XG) + off) = (u32x2){pk2(xn[0] * gv[0], xn[1] * gv[1]), pk2(xn[2] * gv[2], xn[3] * gv[3])}; }
    }
    s += __shfl_xor(s, 16); s += __shfl_xor(s, 32);
    if (quad == 0) ((float*)(p.ws + O_SSQ))[(size_t)t * 16 + tn * 2 + wn] = s;
  }
}
constexpr int PF_ITEMS = 256 * 8;
DI void phase_f(const Params& p, int layer, unsigned char* smem) {
  const bf16_t* wl = (const bf16_t*)(p.ws + O_W) + (size_t)layer * W_LAYER;
  for (int it = blockIdx.x; it < PF_ITEMS; it += gridDim.x)
    resid_tile(p, (const bf16_t*)(p.ws + O_MERGED), 1024, wl + W_OUT, layer == 0 ? p.x : p.out, p.ffn_norm + layer * D_, it % 256, it / 256, (bf16_t*)smem);
}
DI void phase_h(const Params& p, int layer, unsigned char* smem) {
  const bf16_t* wl = (const bf16_t*)(p.ws + O_W) + (size_t)layer * W_LAYER;
  for (int it = blockIdx.x; it < PF_ITEMS; it += gridDim.x)
    resid_tile(p, (const bf16_t*)(p.ws + O_ACT), DFF_, wl + W_DN, p.out, layer == 0 ? p.mix_norm + D_ : nullptr, it % 256, it / 256, (bf16_t*)smem);
}

struct UpRowPtr { const bf16_t* base; int s0;
  DI unsigned operator()(int r) const { const int s = s0 + r; return (unsigned)((s < 0 || s >= S_) ? 0 : s) * (unsigned)D_; }
  DI bool ok(int r) const { const int s = s0 + r; return s >= 0 && s < S_; } };
constexpr int PG_MT = 33, PG_ITEMS = NB_ * PG_MT * 44;
DI void ffnup_tile(const Params& p, int layer, int b, int mt, int tn, bf16_t* smem) {
  const bf16_t* wl = (const bf16_t*)(p.ws + O_W) + (size_t)layer * W_LAYER;
  f32x4 acc[4][4]; zero_acc<4>(acc);
  const int s0 = 126 * mt - 2;
  UpRowPtr ap{(const bf16_t*)(p.ws + O_XG) + (size_t)b * S_ * D_, s0}; RowPtr bp{wl + W_UP + (size_t)tn * 128 * D_, (size_t)D_};
  gemm_main<4, true>(acc, ap, 64, bp, 64, 16, smem);
  const int tid = TIDX(), lane = tid & 63, wid = tid >> 6, wm = wid >> 1, wn = wid & 1, l15 = lane & 15, quad = lane >> 4;
  constexpr int LDU = 68; float* U = (float*)smem; float* V = U + 128 * LDU;
#pragma unroll
  for (int i = 0; i < 4; ++i) {
    const int row = wm * 64 + i * 16 + l15, s = s0 + row;
    const float rs = (s >= 0 && s < S_) ? rstd_from16((const float*)(p.ws + O_SSQ) + ((size_t)b * S_ + s) * 16, 1.f / 1024.f) : 0.f;
    float* dst = (wn ? V : U) + row * LDU + quad * 4;
#pragma unroll
    for (int j = 0; j < 4; ++j) *(f32x4*)(dst + j * 16) = acc[i][j] * rs;
  }
  __syncthreads();
  const int c4 = (tid & 15) * 4, cg0 = tn * 64 + c4;
  const float* cw = p.conv_w + (size_t)layer * 3 * DFF_ + cg0; const f32x4 w0 = *(const f32x4*)cw, w1 = *(const f32x4*)(cw + DFF_), w2 = *(const f32x4*)(cw + 2 * DFF_);
  const f32x4 cb = *(const f32x4*)(p.conv_b + (size_t)layer * DFF_ + cg0);
  bf16_t* act = (bf16_t*)(p.ws + O_ACT);
#pragma unroll 2
  for (int itr = 0; itr < 8; ++itr) {
    const int i = (tid >> 4) + 16 * itr, s = s0 + i;
    if (i >= 2 && s < S_) {
      const f32x4 u0 = *(const f32x4*)(U + (i - 2) * LDU + c4), u1 = *(const f32x4*)(U + (i - 1) * LDU + c4), u2 = *(const f32x4*)(U + i * LDU + c4), vv = *(const f32x4*)(V + i * LDU + c4);
      float o[4];
#pragma unroll
      for (int r = 0; r < 4; ++r) { const float uc = w0[r] * u0[r] + w1[r] * u1[r] + w2[r] * u2[r] + cb[r]; o[r] = uc * sigmoidf_(uc) * vv[r]; }
      *(u32x2*)(act + ((size_t)b * S_ + s) * DFF_ + cg0) = (u32x2){pk2(o[0], o[1]), pk2(o[2], o[3])};
    }
  }
  __syncthreads();
}
DI void phase_g(const Params& p, int layer, unsigned char* smem) {
  for (int it = blockIdx.x; it < PG_ITEMS; it += gridDim.x) { const int tn = it / (NB_ * PG_MT), r = it % (NB_ * PG_MT); ffnup_tile(p, layer, r / PG_MT, r % PG_MT, tn, (bf16_t*)smem); }
}

DI void phase_final(const Params& p) {
  const int lane = TIDX() & 63, wid = TIDX() >> 6;
  for (int it = blockIdx.x; it < T_ / 4; it += gridDim.x) {
    const int t = it * 4 + wid; const float rs = rstd_from16((const float*)(p.ws + O_SSQ) + (size_t)t * 16, 1.f / 1024.f);
    float* xr = p.out + (size_t)t * D_;
#pragma unroll
    for (int c = 0; c < 4; ++c) { const int k = c * 256 + lane * 4; const f32x4 v = *(const f32x4*)(xr + k), gv = *(const f32x4*)(p.final_norm + k); *(f32x4*)(xr + k) = v * rs * gv; }
  }
}

DI void run_phase(const Params& p, int ph, unsigned char* smem) {
  if (ph == 0) { phase_prep(p, smem); return; }
  if (ph == 17) { phase_final(p); return; }
  const int layer = (ph - 1) >> 3, s = (ph - 1) & 7;
  switch (s) {
    case 0: phase_inproj(p, layer, smem); break;
    case 1: phase_b(p, layer, smem); break;
    case 2: phase_c(p, smem); break;
    case 3: phase_d(p, smem); break;
    case 4: phase_e(p, layer, smem); break;
    case 5: phase_f(p, layer, smem); break;
    case 6: phase_g(p, layer, smem); break;
    default: phase_h(p, layer, smem); break;
  }
}
constexpr int N_PHASES = 18;

#if ONE_LAUNCH
template <int PH> DI void run_all(const Params& p, unsigned char* smem, cg::grid_group& grid) {
  run_phase(p, PH, smem);
  if constexpr (PH + 1 < N_PHASES) { grid.sync(); run_all<PH + 1>(p, smem, grid); }
}
__global__ void __launch_bounds__(256, 2) mega_kernel(Params p) {
  __shared__ __attribute__((aligned(16))) unsigned char smem[SMEM_BYTES];
  cg::grid_group grid = cg::this_grid();
  run_all<0>(p, smem, grid);
}
#else
template <int PH> __global__ void __launch_bounds__(256, 2) phase_kernel(Params p) {
  __shared__ __attribute__((aligned(16))) unsigned char smem[SMEM_BYTES];
  run_phase(p, PH, smem);
}
template <int PH> static void launch_phases(const Params& p, hipStream_t stream) {
  hipLaunchKernelGGL((phase_kernel<PH>), dim3(1024), dim3(256), 0, stream, p);
  if constexpr (PH + 1 < N_PHASES) launch_phases<PH + 1>(p, stream);
}
#endif

extern "C" void kernel_launch(void* const* d_in, const int* in_sizes, int n_in, void* d_out, int out_size, void* d_ws, size_t ws_size, hipStream_t stream) {
  if (ws_size < O_END || n_in < 25) { fprintf(stderr, "workspace too small: %zu < %zu\n", ws_size, (size_t)O_END); return; }
  Params p{};
  p.x = (const float*)d_in[0]; p.pos = (const int*)d_in[1]; p.mix_norm = (const float*)d_in[2]; p.w_in = (const float*)d_in[3]; p.b_forget = (const float*)d_in[4];
  p.pe_k = (const float*)d_in[5]; p.w1_k = (const float*)d_in[6]; p.w2_k = (const float*)d_in[7]; p.pe_v = (const float*)d_in[8]; p.w1_v = (const float*)d_in[9]; p.w2_v = (const float*)d_in[10];
  p.q_norm = (const float*)d_in[11]; p.w_uq = (const float*)d_in[12]; p.kv_norm = (const float*)d_in[13]; p.w_ukv = (const float*)d_in[14];
  p.wbr_nsa = (const float*)d_in[15]; p.wbr_fox = (const float*)d_in[16]; p.wbr_mla = (const float*)d_in[17]; p.w_out = (const float*)d_in[18];
  p.ffn_norm = (const float*)d_in[19]; p.w_up = (const float*)d_in[20]; p.conv_w = (const float*)d_in[21]; p.conv_b = (const float*)d_in[22]; p.w_down = (const float*)d_in[23]; p.final_norm = (const float*)d_in[24];
  p.out = (float*)d_out; p.ws = (unsigned char*)d_ws;
#if ONE_LAUNCH
  static int grid_blocks = 0;
  if (!grid_blocks) {
    int dev = 0, cus = 0, per_cu = 0;
    hipGetDevice(&dev); hipDeviceGetAttribute(&cus, hipDeviceAttributeMultiprocessorCount, dev);
    hipOccupancyMaxActiveBlocksPerMultiprocessor(&per_cu, mega_kernel, 256, 0);
    if (per_cu > 2) per_cu = 2;
    grid_blocks = cus * per_cu;
  }
  void* args[] = {&p};
  hipError_t e = hipLaunchCooperativeKernel((void*)mega_kernel, dim3(grid_blocks), dim3(256), args, 0, stream);
  if (e != hipSuccess) fprintf(stderr, "cooperative launch failed: %s (grid %d)\n", hipGetErrorString(e), grid_blocks);
#else
  launch_phases<0>(p, stream);
#endif
}
```

```cpp
#include <hip/hip_runtime.h>
#include <hip/hip_cooperative_groups.h>
#include <stdint.h>
#include <stdio.h>
namespace cg = cooperative_groups;

#ifndef ONE_LAUNCH
#define ONE_LAUNCH 1
#endif

#define DI __device__ __forceinline__
typedef unsigned short bf16_t;
typedef short bf16x8 __attribute__((ext_vector_type(8)));
typedef float f32x4 __attribute__((ext_vector_type(4)));
typedef float f32x16 __attribute__((ext_vector_type(16)));
typedef float f32x2 __attribute__((ext_vector_type(2)));
typedef __bf16 bfx2 __attribute__((ext_vector_type(2)));
typedef unsigned u32x4 __attribute__((ext_vector_type(4)));
typedef unsigned u32x2 __attribute__((ext_vector_type(2)));
typedef unsigned long long u64;

constexpr int T_ = 32768, S_ = 4096, NB_ = 8, D_ = 1024, DFF_ = 2816, NIN_ = 6592;
constexpr float EPS_ = 1e-6f;
constexpr float LOG2E_ = 1.4426950408889634f;
constexpr float QS64_ = 0.125f * LOG2E_;
constexpr float QS96_ = 0.10206207261596577f * LOG2E_;

constexpr size_t W_IN = 0;
constexpr size_t W_G = W_IN + (size_t)3584 * 1024;
constexpr size_t W_1K = W_G + (size_t)3072 * 1024;
constexpr size_t W_1V = W_1K + (size_t)256 * 2048;
constexpr size_t W_2K = W_1V + (size_t)256 * 2048;
constexpr size_t W_2V = W_2K + (size_t)64 * 256;
constexpr size_t W_UQ = W_2V + (size_t)64 * 256;
constexpr size_t W_UKV = W_UQ + (size_t)768 * 384;
constexpr size_t W_BN = W_UKV + (size_t)1024 * 256;
constexpr size_t W_BF = W_BN + (size_t)1024 * 512;
constexpr size_t W_BM = W_BF + (size_t)1024 * 512;
constexpr size_t W_OUT = W_BM + (size_t)1024 * 512;
constexpr size_t W_UP = W_OUT + (size_t)1024 * 1024;
constexpr size_t W_DN = W_UP + (size_t)5632 * 1024;
constexpr size_t W_LAYER = W_DN + (size_t)1024 * 2816;

constexpr size_t al256(size_t x) { return (x + 255) & ~(size_t)255; }
constexpr size_t O_BAR = 0;
constexpr size_t O_W = 16384;
constexpr size_t O_BIAS1 = al256(O_W + 2 * W_LAYER * 2);
constexpr size_t O_ROPE8 = al256(O_BIAS1 + 2 * 2 * 256 * 4);
constexpr size_t O_ROPE16 = al256(O_ROPE8 + (size_t)T_ * 16 * 4);
constexpr size_t O_XG = al256(O_ROPE16 + (size_t)T_ * 32 * 4);
constexpr size_t O_SSQ = al256(O_XG + (size_t)T_ * 1024 * 2);
constexpr size_t O_CSSQ = al256(O_SSQ + (size_t)T_ * 16 * 4);
constexpr size_t O_NSAQ = al256(O_CSSQ + (size_t)T_ * 16 * 4);
constexpr size_t O_KVCMP = O_NSAQ + (size_t)T_ * 512 * 2;
constexpr size_t O_KSLC = O_KVCMP + (size_t)T_ * 256 * 2;
constexpr size_t O_KWIN = O_KSLC + (size_t)T_ * 128 * 2;
constexpr size_t O_MERGED = O_NSAQ;
constexpr size_t O_VSLCT = O_KWIN + (size_t)T_ * 128 * 2;
constexpr size_t O_VWINT = O_VSLCT + (size_t)T_ * 128 * 2;
constexpr size_t O_FOXQ = O_VWINT + (size_t)T_ * 128 * 2;
constexpr size_t O_FOXK = O_FOXQ + (size_t)T_ * 512 * 2;
constexpr size_t O_FOXVT = O_FOXK + (size_t)T_ * 512 * 2;
constexpr size_t O_MLAQ = O_FOXVT + (size_t)T_ * 512 * 2;
constexpr size_t O_MLAKN = O_MLAQ + (size_t)T_ * 768 * 2;
constexpr size_t O_ACT = O_FOXQ;
constexpr size_t O_MLAVT = O_MLAKN + (size_t)T_ * 512 * 2;
constexpr size_t O_MLAKPE = O_MLAVT + (size_t)T_ * 512 * 2;
constexpr size_t O_ONSA = O_MLAKPE + (size_t)T_ * 32 * 2;
constexpr size_t O_CQ = O_ONSA;
constexpr size_t O_CKV = O_CQ + (size_t)T_ * 384 * 2;
constexpr size_t O_CEND = O_CKV + (size_t)T_ * 256 * 2;
constexpr size_t O_GATES = al256(O_CEND > O_ONSA + (size_t)T_ * 512 * 2 ? O_CEND : O_ONSA + (size_t)T_ * 512 * 2);
constexpr size_t O_LOGF = al256(O_GATES + (size_t)T_ * 24 * 4);
constexpr size_t O_F2 = al256(O_LOGF + (size_t)T_ * 8 * 4);
constexpr size_t O_KCP = al256(O_F2 + (size_t)T_ * 8 * 4);
constexpr size_t O_SEL = al256(O_KCP + (size_t)2 * 2 * 4096 * 64 * 4);
constexpr size_t O_END = al256(O_SEL + (size_t)NB_ * 2 * S_ * 8);

struct Params {
  const float* x; const int* pos; const float* mix_norm; const float* w_in; const float* b_forget;
  const float* pe_k; const float* w1_k; const float* w2_k; const float* pe_v; const float* w1_v; const float* w2_v;
  const float* q_norm; const float* w_uq; const float* kv_norm; const float* w_ukv;
  const float* wbr_nsa; const float* wbr_fox; const float* wbr_mla; const float* w_out;
  const float* ffn_norm; const float* w_up; const float* conv_w; const float* conv_b; const float* w_down; const float* final_norm;
  float* out; unsigned char* ws;
};

constexpr int SMEM_BYTES = 73728;

DI int TIDX() { int t = (int)threadIdx.x; asm volatile("" : "+v"(t)); return t; }
DI unsigned pk2(float lo, float hi) { f32x2 v = {lo, hi}; return __builtin_bit_cast(unsigned, __builtin_convertvector(v, bfx2)); }
DI bf16_t f2bf(float x) { return (bf16_t)(pk2(x, 0.f) & 0xffffu); }
DI float bf2f(bf16_t h) { return __uint_as_float(((unsigned)h) << 16); }
DI float sigmoidf_(float x) { return 1.f / (1.f + __expf(-x)); }
DI float gelu_tanh(float x) { const float u = 0.7978845608028654f * (x + 0.044715f * x * x * x); return x / (1.f + __expf(-2.f * u)); }
DI float ex2(float x) { return __builtin_amdgcn_exp2f(x); }
DI f32x16 mfma32(bf16x8 a, bf16x8 b, f32x16 c) { return __builtin_amdgcn_mfma_f32_32x32x16_bf16(a, b, c, 0, 0, 0); }
DI f32x4 mfma16(bf16x8 a, bf16x8 b, f32x4 c) { return __builtin_amdgcn_mfma_f32_16x16x32_bf16(a, b, c, 0, 0, 0); }
DI float rstd_from16(const float* p, float inv_n) {
  const f32x4 a = *(const f32x4*)p, b = *(const f32x4*)(p + 4), c = *(const f32x4*)(p + 8), d = *(const f32x4*)(p + 12);
  const float s = ((a[0] + a[1]) + (a[2] + a[3])) + ((b[0] + b[1]) + (b[2] + b[3])) + ((c[0] + c[1]) + (c[2] + c[3])) + ((d[0] + d[1]) + (d[2] + d[3]));
  return rsqrtf(s * inv_n + EPS_);
}

constexpr int LDT = 72;
template <int NJ> struct GemmLds { static constexpr int BN = 32 * NJ; static constexpr int A_ELEMS = 128 * LDT, B_ELEMS = BN * LDT, STAGE = A_ELEMS + B_ELEMS; };

template <int NJ, bool SWAP, class AP, class BP>
DI void gemm_main(f32x4 (&acc)[4][NJ], const AP& ap, int a_kstep, const BP& bp, int b_kstep, int nk, bf16_t* smem) {
  typedef GemmLds<NJ> L;
  constexpr int CB = L::BN / 32;
  const int tid = TIDX(), lane = tid & 63, wid = tid >> 6, wm = wid >> 1, wn = wid & 1, l15 = lane & 15, quad = lane >> 4;
  unsigned pa[4], pb[CB]; bool oka[4];
#pragma unroll
  for (int i = 0; i < 4; ++i) { const int c = tid + 256 * i; pa[i] = ap(c >> 3) + (c & 7) * 8; oka[i] = ap.ok(c >> 3); }
#pragma unroll
  for (int i = 0; i < CB; ++i) { const int c = tid + 256 * i; pb[i] = bp(c >> 3) + (c & 7) * 8; }
  u32x4 ra[4], rb[CB];
  auto gload = [&](int kt) {
    const bf16_t* ab = ap.base + (size_t)kt * a_kstep; const bf16_t* bb = bp.base + (size_t)kt * b_kstep;
#pragma unroll
    for (int i = 0; i < 4; ++i) ra[i] = *(const u32x4*)(ab + pa[i]);
#pragma unroll
    for (int i = 0; i < CB; ++i) rb[i] = *(const u32x4*)(bb + pb[i]);
  };
  auto sstore = [&](int buf) {
    bf16_t* As = smem + buf * L::STAGE; bf16_t* Bs = As + L::A_ELEMS;
#pragma unroll
    for (int i = 0; i < 4; ++i) { const int c = tid + 256 * i; *(u32x4*)(As + (c >> 3) * LDT + (c & 7) * 8) = oka[i] ? ra[i] : (u32x4){0u, 0u, 0u, 0u}; }
#pragma unroll
    for (int i = 0; i < CB; ++i) { const int c = tid + 256 * i; *(u32x4*)(Bs + (c >> 3) * LDT + (c & 7) * 8) = rb[i]; }
  };
  gload(0); sstore(0); __syncthreads();
  for (int kt = 0; kt < nk; ++kt) {
    const int buf = kt & 1;
    if (kt + 1 < nk) gload(kt + 1);
    const bf16_t* As = smem + buf * L::STAGE + (wm * 64 + l15) * LDT + quad * 8;
    const bf16_t* Bs = smem + buf * L::STAGE + L::A_ELEMS + (wn * 16 * NJ + l15) * LDT + quad * 8;
#pragma unroll
    for (int ks = 0; ks < 2; ++ks) {
      bf16x8 a[4];
#pragma unroll
      for (int i = 0; i < 4; ++i) a[i] = *(const bf16x8*)(As + i * 16 * LDT + ks * 32);
#pragma unroll
      for (int j = 0; j < NJ; ++j) {
        const bf16x8 b = *(const bf16x8*)(Bs + j * 16 * LDT + ks * 32);
#pragma unroll
        for (int i = 0; i < 4; ++i) acc[i][j] = SWAP ? mfma16(b, a[i], acc[i][j]) : mfma16(a[i], b, acc[i][j]);
      }
    }
    if (kt + 1 < nk) sstore(buf ^ 1);
    __syncthreads();
  }
}
template <int NJ> DI void zero_acc(f32x4 (&acc)[4][NJ]) {
#pragma unroll
  for (int i = 0; i < 4; ++i)
#pragma unroll
    for (int j = 0; j < NJ; ++j) acc[i][j] = (f32x4){0.f, 0.f, 0.f, 0.f};
}
struct RowPtr { const bf16_t* base; size_t ld; DI unsigned operator()(int r) const { return (unsigned)r * (unsigned)ld; } DI bool ok(int) const { return true; } };


DI int map_col(int map, int n) {
  if (map == 0) return n;
  if (map == 1) {
    if (n < 1280) return n;
    if (n < 2816) return 1304 + (n - 1280);
    if (n < 3200) return 2848 + (n - 2816);
    if (n < 3456) return 3232 + (n - 3200);
    const int c = n - 3456;
    if (c < 24) return 1280 + c;
    if (c < 32) return 2840 + (c - 24);
    if (c < 64) return 3488 + (c - 32);
    return -1;
  }
  if (map == 2) { const int j = n >> 7, c = n & 127; return c < 64 ? j * 64 + c : DFF_ + j * 64 + (c - 64); }
  if (map == 3) { return n < 512 ? (n >> 6) * 128 + (n & 63) : ((n - 512) >> 6) * 128 + 64 + ((n - 512) & 63); }
  return n;
}
struct WJob { const float* src; const float* scale; bf16_t* dst; int K, N, ld, map, off; };
DI void prep_weight_tile(const WJob& j, int tile, float* lds) {
  const int ntn = j.N >> 6, tk = tile / ntn, tn = tile % ntn, tid = TIDX();
  const int n = tn * 64 + (tid & 63); const int sc = map_col(j.map, n);
#pragma unroll 4
  for (int i = 0; i < 16; ++i) {
    const int kk = (tid >> 6) + 4 * i, k = tk * 64 + kk;
    float v = sc >= 0 ? j.src[(size_t)k * j.ld + j.off + sc] : 0.f;
    if (j.scale) v *= j.scale[k];
    lds[kk * 65 + (tid & 63)] = v;
  }
  __syncthreads();
  const int nn = tid >> 2, k0 = (tid & 3) * 16;
  unsigned w[8];
#pragma unroll
  for (int e = 0; e < 8; ++e) w[e] = pk2(lds[(k0 + 2 * e) * 65 + nn], lds[(k0 + 2 * e + 1) * 65 + nn]);
  bf16_t* d = j.dst + (size_t)(tn * 64 + nn) * j.K + tk * 64 + k0;
  *(u32x4*)d = (u32x4){w[0], w[1], w[2], w[3]}; *(u32x4*)(d + 8) = (u32x4){w[4], w[5], w[6], w[7]};
  __syncthreads();
}
DI WJob get_wjob(const Params& p, int layer, int id) {
  bf16_t* wl = (bf16_t*)(p.ws + O_W) + (size_t)layer * W_LAYER; WJob j; j.scale = nullptr; j.map = 0; j.off = 0;
  switch (id) {
    case 0: j.src = p.w_in + (size_t)layer * 1024 * NIN_; j.dst = wl + W_IN; j.K = 1024; j.N = 3584; j.ld = NIN_; j.map = 1; break;
    case 1: j.src = p.w_in + (size_t)layer * 1024 * NIN_; j.dst = wl + W_G; j.K = 1024; j.N = 3072; j.ld = NIN_; j.off = 3520; break;
    case 2: j.src = p.w1_k + (size_t)layer * 2048 * 256; j.dst = wl + W_1K; j.K = 2048; j.N = 256; j.ld = 256; break;
    case 3: j.src = p.w1_v + (size_t)layer * 2048 * 256; j.dst = wl + W_1V; j.K = 2048; j.N = 256; j.ld = 256; break;
    case 4: j.src = p.w2_k + (size_t)layer * 256 * 64; j.dst = wl + W_2K; j.K = 256; j.N = 64; j.ld = 64; break;
    case 5: j.src = p.w2_v + (size_t)layer * 256 * 64; j.dst = wl + W_2V; j.K = 256; j.N = 64; j.ld = 64; break;
    case 6: j.src = p.w_uq + (size_t)layer * 384 * 768; j.dst = wl + W_UQ; j.K = 384; j.N = 768; j.ld = 768; j.scale = p.q_norm + layer * 384; break;
    case 7: j.src = p.w_ukv + (size_t)layer * 256 * 1024; j.dst = wl + W_UKV; j.K = 256; j.N = 1024; j.ld = 1024; j.scale = p.kv_norm + layer * 256; j.map = 3; break;
    case 8: j.src = p.wbr_nsa + (size_t)layer * 512 * 1024; j.dst = wl + W_BN; j.K = 512; j.N = 1024; j.ld = 1024; break;
    case 9: j.src = p.wbr_fox + (size_t)layer * 512 * 1024; j.dst = wl + W_BF; j.K = 512; j.N = 1024; j.ld = 1024; break;
    case 10: j.src = p.wbr_mla + (size_t)layer * 512 * 1024; j.dst = wl + W_BM; j.K = 512; j.N = 1024; j.ld = 1024; break;
    case 11: j.src = p.w_out + (size_t)layer * 1024 * 1024; j.dst = wl + W_OUT; j.K = 1024; j.N = 1024; j.ld = 1024; break;
    case 12: j.src = p.w_up + (size_t)layer * 1024 * 5632; j.dst = wl + W_UP; j.K = 1024; j.N = 5632; j.ld = 5632; j.map = 2; break;
    default: j.src = p.w_down + (size_t)layer * 2816 * 1024; j.dst = wl + W_DN; j.K = 2816; j.N = 1024; j.ld = 1024; break;
  }
  return j;
}
constexpr int WTILES_LAYER = (int)(W_LAYER / 4096);
constexpr int P0_XITEMS = T_ / 32;
constexpr int P0_ROPE_ITEMS = T_ / 256;
constexpr int P0_ITEMS = 2 * WTILES_LAYER + 4 + P0_ROPE_ITEMS + P0_XITEMS;

DI void xg_rows(const float* x, const float* g, bf16_t* xg, float* ssq, int row0) {
  const int lane = TIDX() & 63, wid = TIDX() >> 6;
  for (int rr = 0; rr < 8; ++rr) {
    const int t = row0 + wid * 8 + rr; const float* xr = x + (size_t)t * D_; float s = 0.f;
#pragma unroll
    for (int c = 0; c < 4; ++c) {
      const int k = c * 256 + lane * 4; const f32x4 v = *(const f32x4*)(xr + k), gv = *(const f32x4*)(g + k);
      s += v[0] * v[0] + v[1] * v[1] + v[2] * v[2] + v[3] * v[3];
      *(u32x2*)(xg + (size_t)t * D_ + k) = (u32x2){pk2(v[0] * gv[0], v[1] * gv[1]), pk2(v[2] * gv[2], v[3] * gv[3])};
    }
#pragma unroll
    for (int o = 32; o >= 1; o >>= 1) s += __shfl_xor(s, o);
    if (lane < 16) ssq[(size_t)t * 16 + lane] = lane == 0 ? s : 0.f;
  }
}
DI void phase_prep(const Params& p, unsigned char* smem) {
  for (int it = blockIdx.x; it < P0_ITEMS; it += gridDim.x) {
    int i = it;
    if (i < 2 * WTILES_LAYER) {
      const int layer = i / WTILES_LAYER; int t = i % WTILES_LAYER; int id = 0;
      for (;; ++id) { const WJob j = get_wjob(p, layer, id); const int nt = (j.K >> 6) * (j.N >> 6); if (t < nt) { prep_weight_tile(j, t, (float*)smem); break; } t -= nt; }
      continue;
    }
    i -= 2 * WTILES_LAYER;
    if (i < 4) {
      const int layer = i >> 1, kv = i & 1, c = TIDX();
      const float* pe = (kv ? p.pe_v : p.pe_k) + (size_t)layer * 2048; const float* w1 = (kv ? p.w1_v : p.w1_k) + (size_t)layer * 2048 * 256;
      float s = 0.f;
      for (int kk = 0; kk < 2048; ++kk) s += pe[kk] * w1[(size_t)kk * 256 + c];
      ((float*)(p.ws + O_BIAS1))[(layer * 2 + kv) * 256 + c] = s;
      continue;
    }
    i -= 4;
    if (i < P0_ROPE_ITEMS) {
      const int t = i * 256 + TIDX(); const float fp = (float)p.pos[t];
      float* r8 = (float*)(p.ws + O_ROPE8) + (size_t)t * 16; float* r16 = (float*)(p.ws + O_ROPE16) + (size_t)t * 32;
      for (int f = 0; f < 24; ++f) {
        const int half = f < 8 ? 8 : 16, idx = f < 8 ? f : f - 8;
        const float inv = exp2f(-(float)idx / (float)half * 18.931568569324174f);
        const float ang = fp * inv;
        const double rev = (double)ang * 0.15915494309189535; const float fr = (float)(rev - floor(rev));
        const float sn = __builtin_amdgcn_sinf(fr), cs = __builtin_amdgcn_cosf(fr);
        if (f < 8) { r8[2 * idx] = cs; r8[2 * idx + 1] = sn; } else { r16[2 * idx] = cs; r16[2 * idx + 1] = sn; }
      }
      continue;
    }
    i -= P0_ROPE_ITEMS;
    xg_rows(p.x, p.mix_norm, (bf16_t*)(p.ws + O_XG), (float*)(p.ws + O_SSQ), i * 32);
  }
}

template <bool SWAP> DI void inproj_tile(const Params& p, int layer, int tm, int tn, bf16_t* smem) {
  const bf16_t* wl = (const bf16_t*)(p.ws + O_W) + (size_t)layer * W_LAYER;
  f32x4 acc[4][4]; zero_acc<4>(acc);
  RowPtr ap{(const bf16_t*)(p.ws + O_XG) + (size_t)tm * 128 * D_, (size_t)D_}, bp{wl + W_IN + (size_t)tn * 128 * D_, (size_t)D_};
  gemm_main<4, SWAP>(acc, ap, 64, bp, 64, 16, smem);
  const int lane = TIDX() & 63, wid = TIDX() >> 6, wm = wid >> 1, wn = wid & 1, l15 = lane & 15, quad = lane >> 4;
  const float* ssq = (const float*)(p.ws + O_SSQ);
  if constexpr (!SWAP) {
    bf16_t* dst; int hh;
    if (tn == 7) { dst = (bf16_t*)(p.ws + O_VSLCT); hh = 2; } else if (tn == 9) { dst = (bf16_t*)(p.ws + O_VWINT); hh = 2; } else { dst = (bf16_t*)(p.ws + O_FOXVT); hh = 8; }
    const int hbase = (tn >= 18 ? (tn - 18) * 2 : 0) + wn;
#pragma unroll
    for (int i = 0; i < 4; ++i) {
      const int t0 = tm * 128 + wm * 64 + i * 16 + quad * 4; const int b = t0 >> 12, s = t0 & 4095;
      float rs[4];
#pragma unroll
      for (int r = 0; r < 4; ++r) rs[r] = rstd_from16(ssq + (size_t)(t0 + r) * 16, 1.f / 1024.f);
#pragma unroll
      for (int j = 0; j < 4; ++j) {
        const int d = j * 16 + l15;
        *(u32x2*)(dst + ((size_t)(b * hh + hbase) * 64 + d) * S_ + s) = (u32x2){pk2(acc[i][j][0] * rs[0], acc[i][j][1] * rs[1]), pk2(acc[i][j][2] * rs[2], acc[i][j][3] * rs[3])};
      }
    }
    return;
  } else {
#pragma unroll
    for (int i = 0; i < 4; ++i) {
      const int t = tm * 128 + wm * 64 + i * 16 + l15; const float rs = rstd_from16(ssq + (size_t)t * 16, 1.f / 1024.f);
      const int cw = wn * 64 + quad * 4;
      if (tn < 4 || (tn >= 10 && tn < 14)) {
        bf16_t* dst = (bf16_t*)(p.ws + (tn < 4 ? O_NSAQ : O_FOXQ)) + (size_t)t * 512 + (tn < 4 ? tn : tn - 10) * 128 + cw; const float sc = rs * QS64_;
#pragma unroll
        for (int j = 0; j < 4; ++j) *(u32x2*)(dst + j * 16) = (u32x2){pk2(acc[i][j][0] * sc, acc[i][j][1] * sc), pk2(acc[i][j][2] * sc, acc[i][j][3] * sc)};
      } else if (tn == 4 || tn == 5) {
        bf16_t* dst = (bf16_t*)(p.ws + O_KVCMP) + (size_t)t * 256 + (tn - 4) * 128 + cw;
#pragma unroll
        for (int j = 0; j < 4; ++j) *(u32x2*)(dst + j * 16) = (u32x2){pk2(acc[i][j][0] * rs, acc[i][j][1] * rs), pk2(acc[i][j][2] * rs, acc[i][j][3] * rs)};
      } else if (tn == 6 || tn == 8) {
        bf16_t* dst = (bf16_t*)(p.ws + (tn == 6 ? O_KSLC : O_KWIN)) + (size_t)t * 128 + cw;
        const float* rp = (const float*)(p.ws + O_ROPE8) + (size_t)t * 16 + (quad & 1) * 8;
        float v[4], o[4];
#pragma unroll
        for (int r = 0; r < 4; ++r) { v[r] = acc[i][0][r] * rs; o[r] = __shfl_xor(v[r], 32); }
#pragma unroll
        for (int r = 0; r < 4; ++r) { const float cs = rp[2 * r], sn = rp[2 * r + 1]; v[r] = quad < 2 ? v[r] * cs - o[r] * sn : v[r] * cs + o[r] * sn; }
        *(u32x2*)(dst) = (u32x2){pk2(v[0], v[1]), pk2(v[2], v[3])};
#pragma unroll
        for (int j = 1; j < 4; ++j) *(u32x2*)(dst + j * 16) = (u32x2){pk2(acc[i][j][0] * rs, acc[i][j][1] * rs), pk2(acc[i][j][2] * rs, acc[i][j][3] * rs)};
      } else if (tn >= 14 && tn < 18) {
        bf16_t* dst = (bf16_t*)(p.ws + O_FOXK) + (size_t)t * 512 + (tn - 14) * 128 + cw;
#pragma unroll
        for (int j = 0; j < 4; ++j) *(u32x2*)(dst + j * 16) = (u32x2){pk2(acc[i][j][0] * rs, acc[i][j][1] * rs), pk2(acc[i][j][2] * rs, acc[i][j][3] * rs)};
      } else if (tn >= 22 && tn < 27) {
        const bool isq = tn < 25; const int ct = isq ? tn - 22 : tn - 25;
        bf16_t* dst = isq ? (bf16_t*)(p.ws + O_CQ) + (size_t)t * 384 + ct * 128 + cw : (bf16_t*)(p.ws + O_CKV) + (size_t)t * 256 + ct * 128 + cw;
        float s = 0.f;
#pragma unroll
        for (int j = 0; j < 4; ++j) {
          const float a0 = acc[i][j][0] * rs, a1 = acc[i][j][1] * rs, a2 = acc[i][j][2] * rs, a3 = acc[i][j][3] * rs;
          s += a0 * a0 + a1 * a1 + a2 * a2 + a3 * a3;
          *(u32x2*)(dst + j * 16) = (u32x2){pk2(a0, a1), pk2(a2, a3)};
        }
        s += __shfl_xor(s, 16); s += __shfl_xor(s, 32);
        if (quad == 0) ((float*)(p.ws + O_CSSQ))[(size_t)t * 16 + (isq ? 0 : 8) + ct * 2 + wn] = s;
      } else if (tn == 27) {
        if (wn == 0) {
          float* gt = (float*)(p.ws + O_GATES) + (size_t)t * 24; float* lf = (float*)(p.ws + O_LOGF) + (size_t)t * 8;
#pragma unroll
          for (int r = 0; r < 4; ++r) gt[quad * 4 + r] = sigmoidf_(acc[i][0][r] * rs);
          if (quad < 2) {
#pragma unroll
            for (int r = 0; r < 4; ++r) gt[16 + quad * 4 + r] = sigmoidf_(acc[i][1][r] * rs);
          } else {
#pragma unroll
            for (int r = 0; r < 4; ++r) { const int h = (quad - 2) * 4 + r; const float xx = acc[i][1][r] * rs + p.b_forget[layer * 8 + h]; lf[h] = fminf(xx, 0.f) - log1pf(__expf(-fabsf(xx))); }
          }
          const float* rp = (const float*)(p.ws + O_ROPE16) + (size_t)t * 32 + quad * 8; float o1[4], o2[4];
#pragma unroll
          for (int r = 0; r < 4; ++r) { const float cs = rp[2 * r], sn = rp[2 * r + 1], x1 = acc[i][2][r] * rs, x2 = acc[i][3][r] * rs; o1[r] = x1 * cs - x2 * sn; o2[r] = x2 * cs + x1 * sn; }
          bf16_t* kp = (bf16_t*)(p.ws + O_MLAKPE) + (size_t)t * 32 + quad * 4;
          *(u32x2*)kp = (u32x2){pk2(o1[0], o1[1]), pk2(o1[2], o1[3])}; *(u32x2*)(kp + 16) = (u32x2){pk2(o2[0], o2[1]), pk2(o2[2], o2[3])};
        }
      }
    }
  }
}
constexpr int PA_ITEMS = 256 * 28;
DI void phase_inproj(const Params& p, int layer, unsigned char* smem) {
  for (int it = blockIdx.x; it < PA_ITEMS; it += gridDim.x) {
    const int tn = it / 256, tm = it % 256;
    const bool vt = (tn == 7 || tn == 9 || (tn >= 18 && tn < 22));
    if (vt) inproj_tile<false>(p, layer, tm, tn, (bf16_t*)smem); else inproj_tile<true>(p, layer, tm, tn, (bf16_t*)smem);
  }
}

template <bool SWAP> DI void mlaup_tile(const Params& p, int layer, int tm, int tn, bf16_t* smem) {
  const bf16_t* wl = (const bf16_t*)(p.ws + O_W) + (size_t)layer * W_LAYER;
  f32x4 acc[4][4]; zero_acc<4>(acc);
  const bool isq = tn < 6; const int K = isq ? 384 : 256;
  RowPtr ap{isq ? (const bf16_t*)(p.ws + O_CQ) + (size_t)tm * 128 * 384 : (const bf16_t*)(p.ws + O_CKV) + (size_t)tm * 128 * 256, (size_t)K};
  RowPtr bp{isq ? wl + W_UQ + (size_t)tn * 128 * 384 : wl + W_UKV + (size_t)(tn - 6) * 128 * 256, (size_t)K};
  gemm_main<4, SWAP>(acc, ap, 64, bp, 64, K / 64, smem);
  const int lane = TIDX() & 63, wid = TIDX() >> 6, wm = wid >> 1, wn = wid & 1, l15 = lane & 15, quad = lane >> 4;
  const float* cssq = (const float*)(p.ws + O_CSSQ);
  if constexpr (!SWAP) {
    bf16_t* dst = (bf16_t*)(p.ws + O_MLAVT); const int h = (tn - 10) * 2 + wn;
#pragma unroll
    for (int i = 0; i < 4; ++i) {
      const int t0 = tm * 128 + wm * 64 + i * 16 + quad * 4; const int b = t0 >> 12, s = t0 & 4095; float rs[4];
#pragma unroll
      for (int r = 0; r < 4; ++r) { const float* c = cssq + (size_t)(t0 + r) * 16 + 8; rs[r] = rsqrtf((c[0] + c[1] + c[2] + c[3]) * (1.f / 256.f) + EPS_); }
#pragma unroll
      for (int j = 0; j < 4; ++j) {
        const int d = j * 16 + l15;
        *(u32x2*)(dst + ((size_t)(b * 8 + h) * 64 + d) * S_ + s) = (u32x2){pk2(acc[i][j][0] * rs[0], acc[i][j][1] * rs[1]), pk2(acc[i][j][2] * rs[2], acc[i][j][3] * rs[3])};
      }
    }
  } else {
#pragma unroll
    for (int i = 0; i < 4; ++i) {
      const int t = tm * 128 + wm * 64 + i * 16 + l15; const float* c = cssq + (size_t)t * 16;
      if (isq) {
        const float rs = rsqrtf((c[0] + c[1] + c[2] + c[3] + c[4] + c[5]) * (1.f / 384.f) + EPS_) * QS96_;
        const int n0 = tn * 128 + wn * 64; bf16_t* dst = (bf16_t*)(p.ws + O_MLAQ) + (size_t)t * 768 + n0 + quad * 4;
        const float* rp = (const float*)(p.ws + O_ROPE16) + (size_t)t * 32 + quad * 8;
#pragma unroll
        for (int j = 0; j < 4; ++j) {
          const int c0 = (n0 + j * 16) % 96;
          if (c0 < 64) { *(u32x2*)(dst + j * 16) = (u32x2){pk2(acc[i][j][0] * rs, acc[i][j][1] * rs), pk2(acc[i][j][2] * rs, acc[i][j][3] * rs)}; }
          else if (c0 == 64 && j < 3) {
            float o1[4], o2[4];
#pragma unroll
            for (int r = 0; r < 4; ++r) { const float cs = rp[2 * r], sn = rp[2 * r + 1], x1 = acc[i][j][r] * rs, x2 = acc[i][j < 3 ? j + 1 : j][r] * rs; o1[r] = x1 * cs - x2 * sn; o2[r] = x2 * cs + x1 * sn; }
            *(u32x2*)(dst + j * 16) = (u32x2){pk2(o1[0], o1[1]), pk2(o1[2], o1[3])}; *(u32x2*)(dst + j * 16 + 16) = (u32x2){pk2(o2[0], o2[1]), pk2(o2[2], o2[3])};
          }
        }
      } else {
        const float rs = rsqrtf((c[8] + c[9] + c[10] + c[11]) * (1.f / 256.f) + EPS_);
        bf16_t* dst = (bf16_t*)(p.ws + O_MLAKN) + (size_t)t * 512 + (tn - 6) * 128 + wn * 64 + quad * 4;
#pragma unroll
        for (int j = 0; j < 4; ++j) *(u32x2*)(dst + j * 16) = (u32x2){pk2(acc[i][j][0] * rs, acc[i][j][1] * rs), pk2(acc[i][j][2] * rs, acc[i][j][3] * rs)};
      }
    }
  }
}
struct CmpRowPtr { const bf16_t* base; int r0;
  DI unsigned operator()(int r) const { int R = r0 + r; if (R >= 4080) R = 0; const int b = R / 510, rem = R - b * 510, n = rem >> 1, g = rem & 1; return (unsigned)(b * S_ + 16 * n) * 256u + g * 64; }
  DI bool ok(int r) const { return r0 + r < 4080; } };
DI void compress_item(const Params& p, int layer, int item, bf16_t* smem) {
  const int kv = item >> 6, nh = (item >> 5) & 1, tm = item & 31;
  const bf16_t* wl = (const bf16_t*)(p.ws + O_W) + (size_t)layer * W_LAYER;
  f32x4 acc[4][4]; zero_acc<4>(acc);
  CmpRowPtr ap{(const bf16_t*)(p.ws + O_KVCMP) + kv * 128, tm * 128};
  RowPtr bp{wl + (kv ? W_1V : W_1K) + (size_t)nh * 128 * 2048, (size_t)2048};
  gemm_main<4, true>(acc, ap, 256, bp, 64, 32, smem);
  const int lane = TIDX() & 63, wid = TIDX() >> 6, wm = wid >> 1, wn = wid & 1, l15 = lane & 15, quad = lane >> 4;
  constexpr int LDH = 136; bf16_t* H = smem;
  const float* b1 = (const float*)(p.ws + O_BIAS1) + (layer * 2 + kv) * 256 + nh * 128;
#pragma unroll
  for (int i = 0; i < 4; ++i)
#pragma unroll
    for (int j = 0; j < 4; ++j) {
      const int row = wm * 64 + i * 16 + l15, col = wn * 64 + j * 16 + quad * 4; const f32x4 bv = *(const f32x4*)(b1 + col);
      *(u32x2*)(H + row * LDH + col) = (u32x2){pk2(gelu_tanh(acc[i][j][0] + bv[0]), gelu_tanh(acc[i][j][1] + bv[1])), pk2(gelu_tanh(acc[i][j][2] + bv[2]), gelu_tanh(acc[i][j][3] + bv[3]))};
    }
  __syncthreads();
  f32x4 a2[2][4];
#pragma unroll
  for (int i = 0; i < 2; ++i)
#pragma unroll
    for (int j = 0; j < 4; ++j) a2[i][j] = (f32x4){0.f, 0.f, 0.f, 0.f};
  const bf16_t* w2 = wl + (kv ? W_2V : W_2K) + nh * 128;
#pragma unroll
  for (int ks = 0; ks < 4; ++ks) {
    bf16x8 a[2], b[4];
#pragma unroll
    for (int i = 0; i < 2; ++i) a[i] = *(const bf16x8*)(H + (wid * 32 + i * 16 + l15) * LDH + ks * 32 + quad * 8);
#pragma unroll
    for (int j = 0; j < 4; ++j) b[j] = *(const bf16x8*)(w2 + (size_t)(j * 16 + l15) * 256 + ks * 32 + quad * 8);
#pragma unroll
    for (int i = 0; i < 2; ++i)
#pragma unroll
      for (int j = 0; j < 4; ++j) a2[i][j] = mfma16(a[i], b[j], a2[i][j]);
  }
  float* kcp = (float*)(p.ws + O_KCP) + (size_t)(kv * 2 + nh) * 4096 * 64;
#pragma unroll
  for (int i = 0; i < 2; ++i)
#pragma unroll
    for (int j = 0; j < 4; ++j)
#pragma unroll
      for (int r = 0; r < 4; ++r) { const int R = tm * 128 + wid * 32 + i * 16 + quad * 4 + r; kcp[(size_t)R * 64 + j * 16 + l15] = a2[i][j][r]; }
  __syncthreads();
}
DI void foxscan_item(const Params& p, int item, float* lds) {
  const int b = item >> 3, h = item & 7, tid = TIDX();
  const float* lf = (const float*)(p.ws + O_LOGF) + (size_t)b * S_ * 8 + h; float v[16]; float s = 0.f;
#pragma unroll
  for (int i = 0; i < 16; ++i) { s += lf[(size_t)(tid * 16 + i) * 8]; v[i] = s; }
  lds[tid] = s; __syncthreads();
  float off = 0.f;
  for (int i = 0; i < tid; ++i) off += lds[i];
  float* F2 = (float*)(p.ws + O_F2) + (size_t)(b * 8 + h) * S_ + tid * 16;
#pragma unroll
  for (int i = 0; i < 16; ++i) F2[i] = -(off + v[i]) * LOG2E_;
  __syncthreads();
}
constexpr int PB_ITEMS = 128 + 64 + 256 * 14;
DI void phase_b(const Params& p, int layer, unsigned char* smem) {
  for (int it = blockIdx.x; it < PB_ITEMS; it += gridDim.x) {
    if (it < 128) compress_item(p, layer, it, (bf16_t*)smem);
    else if (it < 192) foxscan_item(p, it - 128, (float*)smem);
    else { const int i = it - 192, tn = i / 256, tm = i % 256; if (tn >= 10) mlaup_tile<false>(p, layer, tm, tn, (bf16_t*)smem); else mlaup_tile<true>(p, layer, tm, tn, (bf16_t*)smem); }
  }
}

constexpr int KC_LD = 72, VC_LD = 264;
DI void cmp_item(const Params& p, int item, unsigned char* smem_) {
  const int b = item >> 7, g = (item >> 6) & 1, tt = item & 63, t0 = tt * 64;
  const int tid = TIDX(), lane = tid & 63, wid = tid >> 6, l15 = lane & 15, quad = lane >> 4;
  bf16_t* kcs = (bf16_t*)smem_;
  bf16_t* vcs = kcs + 256 * KC_LD;
  float* imps = (float*)smem_;
  const int nmax = (t0 + 32) >> 4;
  const int nsub = t0 == 0 && false ? 0 : ((nmax >> 4) + 1);
  {
    const float* k0 = (const float*)(p.ws + O_KCP), *k1 = k0 + (size_t)4096 * 64, *v0 = k0 + (size_t)2 * 4096 * 64, *v1 = k0 + (size_t)3 * 4096 * 64;
    const int nrows = ((nsub + 1) & ~1) * 16;
    for (int e = tid; e < nrows * 16; e += 256) {
      const int n = e >> 4, d4 = (e & 15) * 4;
      f32x4 kk = {0.f, 0.f, 0.f, 0.f}, vv = {0.f, 0.f, 0.f, 0.f};
      if (n < 255) { const size_t R = (size_t)(b * 510 + n * 2 + g) * 64 + d4; kk = *(const f32x4*)(k0 + R) + *(const f32x4*)(k1 + R); vv = *(const f32x4*)(v0 + R) + *(const f32x4*)(v1 + R); }
      *(u32x2*)(kcs + n * KC_LD + d4) = (u32x2){pk2(kk[0], kk[1]), pk2(kk[2], kk[3])};
#pragma unroll
      for (int r = 0; r < 4; ++r) vcs[(d4 + r) * VC_LD + n] = f2bf(vv[r]);
    }
  }
  __syncthreads();
  const int tq = t0 + wid * 16 + l15;
  const size_t trow = (size_t)b * S_ + tq;
  float impa[16], p3a[16];
#pragma unroll
  for (int s = 0; s < 16; ++s) { impa[s] = 0.f; p3a[s] = 0.f; }
  const float* gts = (const float*)(p.ws + O_GATES) + trow * 24;
#pragma unroll 1
  for (int r4 = 0; r4 < 4; ++r4) {
    const int head = g * 4 + r4;
    const bf16_t* qp = (const bf16_t*)(p.ws + O_NSAQ) + trow * 512 + head * 64 + quad * 8;
    const bf16x8 q0 = *(const bf16x8*)qp, q1 = *(const bf16x8*)(qp + 32);
    auto score = [&](int s) -> f32x4 {
      const bf16_t* kr = kcs + (s * 16 + l15) * KC_LD + quad * 8;
      f32x4 a = {0.f, 0.f, 0.f, 0.f};
      a = mfma16(*(const bf16x8*)kr, q0, a); a = mfma16(*(const bf16x8*)(kr + 32), q1, a);
#pragma unroll
      for (int r = 0; r < 4; ++r) { const int n = s * 16 + quad * 4 + r; a[r] = (16 * n + 31 <= tq) ? a[r] : -INFINITY; }
      return a;
    };
    float mx = -INFINITY;
#pragma unroll 1
    for (int s = 0; s < nsub; ++s) { const f32x4 a = score(s); mx = fmaxf(mx, fmaxf(fmaxf(a[0], a[1]), fmaxf(a[2], a[3]))); }
    mx = fmaxf(mx, __shfl_xor(mx, 16)); mx = fmaxf(mx, __shfl_xor(mx, 32));
    if (mx == -INFINITY) mx = 0.f;
    float sum = 0.f;
#pragma unroll 1
    for (int s = 0; s < nsub; ++s) { const f32x4 a = score(s); sum += (ex2(a[0] - mx) + ex2(a[1] - mx)) + (ex2(a[2] - mx) + ex2(a[3] - mx)); }
    sum += __shfl_xor(sum, 16); sum += __shfl_xor(sum, 32);
    const float inv = 1.f / fmaxf(sum, 1e-30f);
    f32x4 oacc[4];
#pragma unroll
    for (int j = 0; j < 4; ++j) oacc[j] = (f32x4){0.f, 0.f, 0.f, 0.f};
#pragma unroll
    for (int c = 0; c < 8; ++c) {
      asm volatile("" ::: "memory");
      if (2 * c < nsub) {
        f32x4 pa = score(2 * c), pb = {-INFINITY, -INFINITY, -INFINITY, -INFINITY};
        if (2 * c + 1 < nsub) pb = score(2 * c + 1);
#pragma unroll
        for (int r = 0; r < 4; ++r) { pa[r] = ex2(pa[r] - mx) * inv; pb[r] = ex2(pb[r] - mx) * inv; }
        impa[2 * c] += pa[0] + pa[1] + pa[2] + 0.5f * pa[3]; p3a[2 * c] += pa[3];
        impa[2 * c + 1] += pb[0] + pb[1] + pb[2] + 0.5f * pb[3]; p3a[2 * c + 1] += pb[3];
        const u32x4 pw = {pk2(pa[0], pa[1]), pk2(pa[2], pa[3]), pk2(pb[0], pb[1]), pk2(pb[2], pb[3])};
        const bf16x8 pf = __builtin_bit_cast(bf16x8, pw);
#pragma unroll
        for (int j = 0; j < 4; ++j) {
          const bf16_t* vr = vcs + (j * 16 + l15) * VC_LD + c * 32 + quad * 4;
          const u32x2 lo = *(const u32x2*)vr, hi = *(const u32x2*)(vr + 16);
          const u32x4 vw = {lo[0], lo[1], hi[0], hi[1]};
          oacc[j] = mfma16(__builtin_bit_cast(bf16x8, vw), pf, oacc[j]);
        }
      }
    }
    const float g0 = gts[head * 3 + 0];
    bf16_t* op = (bf16_t*)(p.ws + O_ONSA) + trow * 512 + head * 64 + quad * 4;
#pragma unroll
    for (int j = 0; j < 4; ++j) *(u32x2*)(op + j * 16) = (u32x2){pk2(oacc[j][0] * g0, oacc[j][1] * g0), pk2(oacc[j][2] * g0, oacc[j][3] * g0)};
  }
  __syncthreads();
  float* myimp = imps + wid * 1024 + l15 * 64;
  const int cur = tq >> 6;
#pragma unroll
  for (int s = 0; s < 16; ++s) {
    const float up = __shfl(p3a[s], (lane + 48) & 63);
    const float up0 = s ? __shfl(p3a[s ? s - 1 : 0], (lane + 48) & 63) : 0.f;
    const float prev = quad ? up : up0;
    float v = impa[s] + 0.5f * prev;
    const int j = 4 * s + quad;
    if (j == 0 || j == cur || j == cur - 1) v = 1e9f; else if (j > cur) v = -1e9f;
    myimp[j] = v;
  }
  __syncthreads();
  u64* sel = (u64*)(p.ws + O_SEL) + (size_t)(b * 2 + g) * S_ + t0 + wid * 16;
#pragma unroll 1
  for (int q = 0; q < 16; ++q) {
    const float mine = imps[wid * 1024 + q * 64 + lane]; int rank = 0;
#pragma unroll
    for (int i = 0; i < 64; ++i) { const float v = __uint_as_float(__builtin_amdgcn_readlane(__float_as_uint(mine), i)); rank += (v > mine || (v == mine && i < lane)) ? 1 : 0; }
    const u64 m = __ballot(rank < 16);
    if (lane == 0) sel[q] = m;
  }
  __syncthreads();
}
constexpr int PC_ITEMS = NB_ * 2 * 64;
DI void phase_c(const Params& p, unsigned char* smem) { for (int it = blockIdx.x; it < PC_ITEMS; it += gridDim.x) cmp_item(p, it, smem); }

enum { M_FOX = 0, M_MLA = 1, M_WIN = 2, M_SLC = 3 };
template <int MODE> struct ACfg { static constexpr int DQK = MODE == M_MLA ? 96 : 64, KLD = DQK + 8, KCH = DQK / 8 * 64 / 256, K_ELEMS = 64 * KLD, V_ELEMS = 64 * 72, STAGE = K_ELEMS + V_ELEMS + 128; };
struct AState { f32x16 o[2]; float m, l; };

template <int MODE>
DI void flash_pass(AState& st, const bf16x8* qf, u64 tmask, u64 wmask,
                   const bf16_t* kbase, size_t kld, const bf16_t* kpe, const bf16_t* vtbase, const float* fbias,
                   int tq, u64 mysel, bf16_t* smem) {
  typedef ACfg<MODE> C;
  const int tid = TIDX(), lane = tid & 63, l31 = lane & 31, half = lane >> 5;
  u32x4 rk[C::KCH], rv[2]; float rf = 0.f;
  auto gload = [&](int j) {
    const int k0 = j * 64;
#pragma unroll
    for (int i = 0; i < C::KCH; ++i) {
      const int c = tid + 256 * i;
      if constexpr (MODE == M_MLA) { const int key = c / 12, dc = c % 12; rk[i] = dc < 8 ? *(const u32x4*)(kbase + (size_t)(k0 + key) * kld + dc * 8) : *(const u32x4*)(kpe + (size_t)(k0 + key) * 32 + (dc - 8) * 8); }
      else { const int key = c >> 3, dc = c & 7; rk[i] = *(const u32x4*)(kbase + (size_t)(k0 + key) * kld + dc * 8); }
    }
#pragma unroll
    for (int i = 0; i < 2; ++i) { const int c = tid + 256 * i, d = c >> 3, kc = c & 7; rv[i] = *(const u32x4*)(vtbase + (size_t)d * S_ + k0 + kc * 8); }
    if constexpr (MODE == M_FOX) { if (tid < 64) rf = fbias[k0 + tid]; }
  };
  auto sstore = [&](int buf) {
    bf16_t* Ks = smem + buf * C::STAGE; bf16_t* Vs = Ks + C::K_ELEMS;
#pragma unroll
    for (int i = 0; i < C::KCH; ++i) {
      const int c = tid + 256 * i;
      if constexpr (MODE == M_MLA) { const int key = c / 12, dc = c % 12; *(u32x4*)(Ks + key * C::KLD + dc * 8) = rk[i]; }
      else { const int key = c >> 3, dc = c & 7; *(u32x4*)(Ks + key * C::KLD + dc * 8) = rk[i]; }
    }
#pragma unroll
    for (int i = 0; i < 2; ++i) {
      const int c = tid + 256 * i, d = c >> 3, kc = c & 7, cgp = kc >> 1, a = kc & 1;
      bf16_t* dst = Vs + d * 72 + cgp * 16 + 4 * a;
      *(u32x2*)dst = (u32x2){rv[i][0], rv[i][1]}; *(u32x2*)(dst + 8) = (u32x2){rv[i][2], rv[i][3]};
    }
    if constexpr (MODE == M_FOX) { if (tid < 64) ((float*)(Vs + C::V_ELEMS))[tid] = rf; }
  };
  u64 tm = tmask;
  if (tm == 0) return;
  int j = __builtin_ctzll(tm); tm &= tm - 1;
  gload(j); sstore(0); __syncthreads();
  int buf = 0;
  const int tmin = __builtin_amdgcn_readfirstlane(tq - l31), tmax = tmin + 31;
  while (true) {
    const int jn = tm ? __builtin_ctzll(tm) : -1; if (tm) tm &= tm - 1;
    if (jn >= 0) gload(jn);
    if ((wmask >> j) & 1) {
      const bf16_t* Ks = smem + buf * C::STAGE; const bf16_t* Vs = Ks + C::K_ELEMS;
      f32x16 s0, s1;
#pragma unroll
      for (int r = 0; r < 16; ++r) { s0[r] = 0.f; s1[r] = 0.f; }
      const bf16_t* kr = Ks + l31 * C::KLD + half * 8;
#pragma unroll
      for (int ks = 0; ks < C::DQK / 16; ++ks) {
        s0 = mfma32(*(const bf16x8*)(kr + ks * 16), qf[ks], s0);
        s1 = mfma32(*(const bf16x8*)(kr + 32 * C::KLD + ks * 16), qf[ks], s1);
      }
      const int k0 = j * 64;
      if constexpr (MODE == M_FOX) {
        const float* fb = (const float*)(Vs + C::V_ELEMS) + 4 * half;
#pragma unroll
        for (int g4 = 0; g4 < 4; ++g4) {
          const f32x4 b0 = *(const f32x4*)(fb + 8 * g4), b1 = *(const f32x4*)(fb + 32 + 8 * g4);
#pragma unroll
          for (int r = 0; r < 4; ++r) { s0[4 * g4 + r] += b0[r]; s1[4 * g4 + r] += b1[r]; }
        }
      }
      bool need = k0 + 63 > tmin;
      if constexpr (MODE == M_WIN) need = need || (k0 <= tmax - 512);
      if constexpr (MODE == M_SLC) need = true;
      if (need) {
        const bool rowok = MODE == M_SLC ? ((mysel >> j) & 1) != 0 : true;
#pragma unroll
        for (int r = 0; r < 16; ++r) {
          const int key = k0 + (r & 3) + 8 * (r >> 2) + 4 * half;
          bool ok0 = rowok && key <= tq, ok1 = rowok && key + 32 <= tq;
          if constexpr (MODE == M_WIN) { ok0 = ok0 && (tq - key < 512); ok1 = ok1 && (tq - key - 32 < 512); }
          s0[r] = ok0 ? s0[r] : -INFINITY; s1[r] = ok1 ? s1[r] : -INFINITY;
        }
      }
      float mx = -INFINITY;
#pragma unroll
      for (int r = 0; r < 16; ++r) mx = fmaxf(mx, fmaxf(s0[r], s1[r]));
      mx = fmaxf(mx, __shfl_xor(mx, 32));
      const float mn = fmaxf(st.m, mx), alpha = ex2(st.m - mn);
      st.m = mn;
      float sum = 0.f;
#pragma unroll
      for (int r = 0; r < 16; ++r) { s0[r] = ex2(s0[r] - mn); s1[r] = ex2(s1[r] - mn); sum += s0[r] + s1[r]; }
      st.l = st.l * alpha + sum;
#pragma unroll
      for (int r = 0; r < 16; ++r) { st.o[0][r] *= alpha; st.o[1][r] *= alpha; }
      const bf16_t* vr = Vs + l31 * 72 + half * 8;
#pragma unroll
      for (int c = 0; c < 4; ++c) {
        u32x4 pw;
        if (c < 2) pw = (u32x4){pk2(s0[8 * c + 0], s0[8 * c + 1]), pk2(s0[8 * c + 2], s0[8 * c + 3]), pk2(s0[8 * c + 4], s0[8 * c + 5]), pk2(s0[8 * c + 6], s0[8 * c + 7])};
        else pw = (u32x4){pk2(s1[8 * (c - 2) + 0], s1[8 * (c - 2) + 1]), pk2(s1[8 * (c - 2) + 2], s1[8 * (c - 2) + 3]), pk2(s1[8 * (c - 2) + 4], s1[8 * (c - 2) + 5]), pk2(s1[8 * (c - 2) + 6], s1[8 * (c - 2) + 7])};
        const bf16x8 pf = __builtin_bit_cast(bf16x8, pw);
        st.o[0] = mfma32(*(const bf16x8*)(vr + c * 16), pf, st.o[0]);
        st.o[1] = mfma32(*(const bf16x8*)(vr + 32 * 72 + c * 16), pf, st.o[1]);
      }
    }
    if (jn >= 0) sstore(buf ^ 1);
    __syncthreads();
    if (jn < 0) break;
    j = jn; buf ^= 1;
  }
}
DI void astate_init(AState& s) {
#pragma unroll
  for (int r = 0; r < 16; ++r) { s.o[0][r] = 0.f; s.o[1][r] = 0.f; }
  s.m = -1e30f; s.l = 0.f;
}
DI u64 lowbits(int n) { return n >= 64 ? ~0ull : ((1ull << n) - 1ull); }

template <int MODE> DI void dense_attn_item(const Params& p, int b, int h, int qt, bf16_t* smem) {
  const int lane = TIDX() & 63, wid = TIDX() >> 6, l31 = lane & 31, half = lane >> 5;
  const int t0 = qt * 128, tq = t0 + wid * 32 + l31; const size_t trow = (size_t)b * S_ + tq;
  constexpr int NQ = ACfg<MODE>::DQK / 16;
  bf16x8 qf[NQ];
  const bf16_t* qp = MODE == M_FOX ? (const bf16_t*)(p.ws + O_FOXQ) + trow * 512 + h * 64 : (const bf16_t*)(p.ws + O_MLAQ) + trow * 768 + h * 96;
#pragma unroll
  for (int ks = 0; ks < NQ; ++ks) qf[ks] = *(const bf16x8*)(qp + ks * 16 + half * 8);
  AState st; astate_init(st);
  const u64 tmask = lowbits(2 * qt + 2), wmask = lowbits(((t0 + wid * 32 + 31) >> 6) + 1);
  if constexpr (MODE == M_FOX)
    flash_pass<M_FOX>(st, qf, tmask, wmask, (const bf16_t*)(p.ws + O_FOXK) + (size_t)b * S_ * 512 + h * 64, 512, nullptr,
                      (const bf16_t*)(p.ws + O_FOXVT) + (size_t)(b * 8 + h) * 64 * S_, (const float*)(p.ws + O_F2) + (size_t)(b * 8 + h) * S_, tq, 0ull, smem);
  else
    flash_pass<M_MLA>(st, qf, tmask, wmask, (const bf16_t*)(p.ws + O_MLAKN) + (size_t)b * S_ * 512 + h * 64, 512, (const bf16_t*)(p.ws + O_MLAKPE) + (size_t)b * S_ * 32,
                      (const bf16_t*)(p.ws + O_MLAVT) + (size_t)(b * 8 + h) * 64 * S_, nullptr, tq, 0ull, smem);
  const float l = st.l + __shfl_xor(st.l, 32), inv = 1.f / fmaxf(l, 1e-30f);
  bf16_t* op = (bf16_t*)qp;
#pragma unroll
  for (int dt = 0; dt < 2; ++dt)
#pragma unroll
    for (int g4 = 0; g4 < 4; ++g4) {
      const int d = dt * 32 + g4 * 8 + half * 4;
      *(u32x2*)(op + d) = (u32x2){pk2(st.o[dt][4 * g4] * inv, st.o[dt][4 * g4 + 1] * inv), pk2(st.o[dt][4 * g4 + 2] * inv, st.o[dt][4 * g4 + 3] * inv)};
    }
}
DI void nsa_attn_item(const Params& p, int b, int g, int qt, bf16_t* smem) {
  const int lane = TIDX() & 63, wid = TIDX() >> 6, l31 = lane & 31, half = lane >> 5;
  const int t0 = qt * 32, tq = t0 + l31, head = g * 4 + wid; const size_t trow = (size_t)b * S_ + tq;
  bf16x8 qf[4];
  const bf16_t* qp = (const bf16_t*)(p.ws + O_NSAQ) + trow * 512 + head * 64;
#pragma unroll
  for (int ks = 0; ks < 4; ++ks) qf[ks] = *(const bf16x8*)(qp + ks * 16 + half * 8);
  {
    const float* rp = (const float*)(p.ws + O_ROPE8) + trow * 16;
    u32x4 me = __builtin_bit_cast(u32x4, qf[0]), ot;
#pragma unroll
    for (int e = 0; e < 4; ++e) ot[e] = __shfl_xor(me[e], 32);
    unsigned res[4];
#pragma unroll
    for (int e = 0; e < 4; ++e) {
      float o2[2];
#pragma unroll
      for (int u = 0; u < 2; ++u) {
        const int f = 2 * e + u; const float cs = rp[2 * f], sn = rp[2 * f + 1];
        const float a = bf2f((bf16_t)(u ? me[e] >> 16 : me[e] & 0xffffu)), o = bf2f((bf16_t)(u ? ot[e] >> 16 : ot[e] & 0xffffu));
        o2[u] = half == 0 ? a * cs - o * sn : a * cs + o * sn;
      }
      res[e] = pk2(o2[0], o2[1]);
    }
    qf[0] = __builtin_bit_cast(bf16x8, (u32x4){res[0], res[1], res[2], res[3]});
  }
  const float* gts = (const float*)(p.ws + O_GATES) + trow * 24 + head * 3;
  const int cur = t0 >> 6;
  f32x16 res[2];
  {
    AState st; astate_init(st);
    const int first = t0 >= 511 ? (t0 - 511) >> 6 : 0;
    const u64 tmask = lowbits(cur + 1) & ~lowbits(first);
    flash_pass<M_WIN>(st, qf, tmask, tmask, (const bf16_t*)(p.ws + O_KWIN) + (size_t)b * S_ * 128 + g * 64, 128, nullptr,
                      (const bf16_t*)(p.ws + O_VWINT) + (size_t)(b * 2 + g) * 64 * S_, nullptr, tq, 0ull, smem);
    const float l = st.l + __shfl_xor(st.l, 32), sc = gts[2] / fmaxf(l, 1e-30f);
#pragma unroll
    for (int r = 0; r < 16; ++r) { res[0][r] = st.o[0][r] * sc; res[1][r] = st.o[1][r] * sc; }
  }
  {
    AState st; astate_init(st);
    const u64 mysel = ((const u64*)(p.ws + O_SEL))[(size_t)(b * 2 + g) * S_ + tq];
    unsigned lo = (unsigned)mysel, hi = (unsigned)(mysel >> 32);
#pragma unroll
    for (int o = 16; o >= 1; o >>= 1) { lo |= __shfl_xor(lo, o); hi |= __shfl_xor(hi, o); }
    const u64 um = (((u64)(unsigned)__builtin_amdgcn_readfirstlane(hi) << 32) | (u64)(unsigned)__builtin_amdgcn_readfirstlane(lo)) & lowbits(cur + 1);
    flash_pass<M_SLC>(st, qf, um, um, (const bf16_t*)(p.ws + O_KSLC) + (size_t)b * S_ * 128 + g * 64, 128, nullptr,
                      (const bf16_t*)(p.ws + O_VSLCT) + (size_t)(b * 2 + g) * 64 * S_, nullptr, tq, mysel, smem);
    const float l = st.l + __shfl_xor(st.l, 32), sc = gts[1] / fmaxf(l, 1e-30f);
#pragma unroll
    for (int r = 0; r < 16; ++r) { res[0][r] += st.o[0][r] * sc; res[1][r] += st.o[1][r] * sc; }
  }
  bf16_t* op = (bf16_t*)(p.ws + O_ONSA) + trow * 512 + head * 64;
#pragma unroll
  for (int dt = 0; dt < 2; ++dt)
#pragma unroll
    for (int g4 = 0; g4 < 4; ++g4) {
      const int d = dt * 32 + g4 * 8 + half * 4;
      const u32x2 oc = *(const u32x2*)(op + d);
      const float c0 = bf2f((bf16_t)(oc[0] & 0xffffu)), c1 = bf2f((bf16_t)(oc[0] >> 16)), c2 = bf2f((bf16_t)(oc[1] & 0xffffu)), c3 = bf2f((bf16_t)(oc[1] >> 16));
      *(u32x2*)(op + d) = (u32x2){pk2(res[dt][4 * g4] + c0, res[dt][4 * g4 + 1] + c1), pk2(res[dt][4 * g4 + 2] + c2, res[dt][4 * g4 + 3] + c3)};
    }
}
constexpr int PD_ITEMS = 32 * 192;
DI void phase_d(const Params& p, unsigned char* smem) {
  for (int it = blockIdx.x; it < PD_ITEMS; it += gridDim.x) {
    const int r = it / 192, w = it % 192, qt = 31 - r;
    if (w < 64) dense_attn_item<M_MLA>(p, w >> 3, w & 7, qt, (bf16_t*)smem);
    else if (w < 128) dense_attn_item<M_FOX>(p, (w - 64) >> 3, (w - 64) & 7, qt, (bf16_t*)smem);
    else { const int i = w - 128, bg = i & 15, q4 = i >> 4; nsa_attn_item(p, bg >> 1, bg & 1, qt * 4 + q4, (bf16_t*)smem); }
  }
}

constexpr int PE_ITEMS = 256 * 16;
DI void merge_tile(const Params& p, int layer, int tm, int tn, bf16_t* smem) {
  const bf16_t* wl = (const bf16_t*)(p.ws + O_W) + (size_t)layer * W_LAYER;
  const int lane = TIDX() & 63, wid = TIDX() >> 6, wm = wid >> 1, wn = wid & 1, l15 = lane & 15, quad = lane >> 4;
  f32x4 mg[4][2]; zero_acc<2>(mg);
  unsigned* gsp = (unsigned*)((unsigned char*)smem + 2 * GemmLds<2>::STAGE * 2) + TIDX();
#pragma unroll 1
  for (int br = 0; br < 3; ++br) {
    {
      f32x4 ga[4][2]; zero_acc<2>(ga);
      RowPtr ap{(const bf16_t*)(p.ws + O_XG) + (size_t)tm * 128 * D_, (size_t)D_}, bp{wl + W_G + ((size_t)br * 1024 + tn * 64) * D_, (size_t)D_};
      gemm_main<2, true>(ga, ap, 64, bp, 64, 16, smem);
#pragma unroll
      for (int i = 0; i < 4; ++i) {
        const float rs = rstd_from16((const float*)(p.ws + O_SSQ) + (size_t)(tm * 128 + wm * 64 + i * 16 + l15) * 16, 1.f / 1024.f);
#pragma unroll
        for (int j = 0; j < 2; ++j) {
          gsp[((i * 2 + j) * 2 + 0) * 256] = pk2(sigmoidf_(ga[i][j][0] * rs), sigmoidf_(ga[i][j][1] * rs));
          gsp[((i * 2 + j) * 2 + 1) * 256] = pk2(sigmoidf_(ga[i][j][2] * rs), sigmoidf_(ga[i][j][3] * rs));
        }
      }
    }
    f32x4 ba[4][2]; zero_acc<2>(ba);
    RowPtr bp2{wl + (br == 0 ? W_BN : br == 1 ? W_BF : W_BM) + (size_t)tn * 64 * 512, (size_t)512};
    const bf16_t* abase = (const bf16_t*)(p.ws + (br == 0 ? O_ONSA : br == 1 ? O_FOXQ : O_MLAQ));
    const int ald = br == 2 ? 768 : 512;
    RowPtr ap2{abase + (size_t)tm * 128 * ald, (size_t)ald};
    gemm_main<2, true>(ba, ap2, br == 2 ? 96 : 64, bp2, 64, 8, smem);
#pragma unroll
    for (int i = 0; i < 4; ++i)
#pragma unroll
      for (int j = 0; j < 2; ++j) {
        const unsigned w0 = gsp[((i * 2 + j) * 2 + 0) * 256], w1 = gsp[((i * 2 + j) * 2 + 1) * 256];
        mg[i][j][0] += bf2f((bf16_t)(w0 & 0xffffu)) * ba[i][j][0];
        mg[i][j][1] += bf2f((bf16_t)(w0 >> 16)) * ba[i][j][1];
        mg[i][j][2] += bf2f((bf16_t)(w1 & 0xffffu)) * ba[i][j][2];
        mg[i][j][3] += bf2f((bf16_t)(w1 >> 16)) * ba[i][j][3];
      }
  }
#pragma unroll
  for (int i = 0; i < 4; ++i) {
    bf16_t* dst = (bf16_t*)(p.ws + O_MERGED) + (size_t)(tm * 128 + wm * 64 + i * 16 + l15) * D_ + tn * 64 + wn * 32 + quad * 4;
#pragma unroll
    for (int j = 0; j < 2; ++j) *(u32x2*)(dst + j * 16) = (u32x2){pk2(mg[i][j][0], mg[i][j][1]), pk2(mg[i][j][2], mg[i][j][3])};
  }
}
DI void phase_e(const Params& p, int layer, unsigned char* smem) {
  for (int it = blockIdx.x; it < PE_ITEMS; it += gridDim.x) merge_tile(p, layer, it % 256, it / 256, (bf16_t*)smem);
}

DI void resid_tile(const Params& p, const bf16_t* A, int K, const bf16_t* W, const float* xold, const float* gnext, int tm, int tn, bf16_t* smem) {
  f32x4 acc[4][4]; zero_acc<4>(acc);
  RowPtr ap{A + (size_t)tm * 128 * K, (size_t)K}, bp{W + (size_t)tn * 128 * K, (size_t)K};
  gemm_main<4, true>(acc, ap, 64, bp, 64, K / 64, smem);
  const int lane = TIDX() & 63, wid = TIDX() >> 6, wm = wid >> 1, wn = wid & 1, l15 = lane & 15, quad = lane >> 4;
#pragma unroll
  for (int i = 0; i < 4; ++i) {
    const int t = tm * 128 + wm * 64 + i * 16 + l15, c0 = tn * 128 + wn * 64 + quad * 4; float s = 0.f;
#pragma unroll
    for (int j = 0; j < 4; ++j) {
      const size_t off = (size_t)t * D_ + c0 + j * 16;
      const f32x4 xn = *(const f32x4*)(xold + off) + acc[i][j];
      *(f32x4*)(p.out + off) = xn;
      s += xn[0] * xn[0] + xn[1] * xn[1] + xn[2] * xn[2] + xn[3] * xn[3];
      if (gnext) { const f32x4 gv = *(const f32x4*)(gnext + c0 + j * 16); *(u32x2*)((bf16_t*)(p.ws + O_XG) + off) = (u32x2){pk2(xn[0] * gv[0], xn[1] * gv[1]), pk2(xn[2] * gv[2], xn[3] * gv[3])}; }
    }
    s += __shfl_xor(s, 16); s += __shfl_xor(s, 32);
    if (quad == 0) ((float*)(p.ws + O_SSQ))[(size_t)t * 16 + tn * 2 + wn] = s;
  }
}
constexpr int PF_ITEMS = 256 * 8;
DI void phase_f(const Params& p, int layer, unsigned char* smem) {
  const bf16_t* wl = (const bf16_t*)(p.ws + O_W) + (size_t)layer * W_LAYER;
  for (int it = blockIdx.x; it < PF_ITEMS; it += gridDim.x)
    resid_tile(p, (const bf16_t*)(p.ws + O_MERGED), 1024, wl + W_OUT, layer == 0 ? p.x : p.out, p.ffn_norm + layer * D_, it % 256, it / 256, (bf16_t*)smem);
}
DI void phase_h(const Params& p, int layer, unsigned char* smem) {
  const bf16_t* wl = (const bf16_t*)(p.ws + O_W) + (size_t)layer * W_LAYER;
  for (int it = blockIdx.x; it < PF_ITEMS; it += gridDim.x)
    resid_tile(p, (const bf16_t*)(p.ws + O_ACT), DFF_, wl + W_DN, p.out, layer == 0 ? p.mix_norm + D_ : nullptr, it % 256, it / 256, (bf16_t*)smem);
}

struct UpRowPtr { const bf16_t* base; int s0;
  DI unsigned operator()(int r) const { const int s = s0 + r; return (unsigned)((s < 0 || s >= S_) ? 0 : s) * (unsigned)D_; }
  DI bool ok(int r) const { const int s = s0 + r; return s >= 0 && s < S_; } };
constexpr int PG_MT = 33, PG_ITEMS = NB_ * PG_MT * 44;
DI void ffnup_tile(const Params& p, int layer, int b, int mt, int tn, bf16_t* smem) {
  const bf16_t* wl = (const bf16_t*)(p.ws + O_W) + (size_t)layer * W_LAYER;
  f32x4 acc[4][4]; zero_acc<4>(acc);
  const int s0 = 126 * mt - 2;
  UpRowPtr ap{(const bf16_t*)(p.ws + O_XG) + (size_t)b * S_ * D_, s0}; RowPtr bp{wl + W_UP + (size_t)tn * 128 * D_, (size_t)D_};
  gemm_main<4, true>(acc, ap, 64, bp, 64, 16, smem);
  const int tid = TIDX(), lane = tid & 63, wid = tid >> 6, wm = wid >> 1, wn = wid & 1, l15 = lane & 15, quad = lane >> 4;
  constexpr int LDU = 68; float* U = (float*)smem; float* V = U + 128 * LDU;
#pragma unroll
  for (int i = 0; i < 4; ++i) {
    const int row = wm * 64 + i * 16 + l15, s = s0 + row;
    const float rs = (s >= 0 && s < S_) ? rstd_from16((const float*)(p.ws + O_SSQ) + ((size_t)b * S_ + s) * 16, 1.f / 1024.f) : 0.f;
    float* dst = (wn ? V : U) + row * LDU + quad * 4;
#pragma unroll
    for (int j = 0; j < 4; ++j) *(f32x4*)(dst + j * 16) = acc[i][j] * rs;
  }
  __syncthreads();
  const int c4 = (tid & 15) * 4, cg0 = tn * 64 + c4;
  const float* cw = p.conv_w + (size_t)layer * 3 * DFF_ + cg0; const f32x4 w0 = *(const f32x4*)cw, w1 = *(const f32x4*)(cw + DFF_), w2 = *(const f32x4*)(cw + 2 * DFF_);
  const f32x4 cb = *(const f32x4*)(p.conv_b + (size_t)layer * DFF_ + cg0);
  bf16_t* act = (bf16_t*)(p.ws + O_ACT);
#pragma unroll 2
  for (int itr = 0; itr < 8; ++itr) {
    const int i = (tid >> 4) + 16 * itr, s = s0 + i;
    if (i >= 2 && s < S_) {
      const f32x4 u0 = *(const f32x4*)(U + (i - 2) * LDU + c4), u1 = *(const f32x4*)(U + (i - 1) * LDU + c4), u2 = *(const f32x4*)(U + i * LDU + c4), vv = *(const f32x4*)(V + i * LDU + c4);
      float o[4];
#pragma unroll
      for (int r = 0; r < 4; ++r) { const float uc = w0[r] * u0[r] + w1[r] * u1[r] + w2[r] * u2[r] + cb[r]; o[r] = uc * sigmoidf_(uc) * vv[r]; }
      *(u32x2*)(act + ((size_t)b * S_ + s) * DFF_ + cg0) = (u32x2){pk2(o[0], o[1]), pk2(o[2], o[3])};
    }
  }
  __syncthreads();
}
DI void phase_g(const Params& p, int layer, unsigned char* smem) {
  for (int it = blockIdx.x; it < PG_ITEMS; it += gridDim.x) { const int tn = it / (NB_ * PG_MT), r = it % (NB_ * PG_MT); ffnup_tile(p, layer, r / PG_MT, r % PG_MT, tn, (bf16_t*)smem); }
}

DI void phase_final(const Params& p) {
  const int lane = TIDX() & 63, wid = TIDX() >> 6;
  for (int it = blockIdx.x; it < T_ / 4; it += gridDim.x) {
    const int t = it * 4 + wid; const float rs = rstd_from16((const float*)(p.ws + O_SSQ) + (size_t)t * 16, 1.f / 1024.f);
    float* xr = p.out + (size_t)t * D_;
#pragma unroll
    for (int c = 0; c < 4; ++c) { const int k = c * 256 + lane * 4; const f32x4 v = *(const f32x4*)(xr + k), gv = *(const f32x4*)(p.final_norm + k); *(f32x4*)(xr + k) = v * rs * gv; }
  }
}


#define XB_TMO      128
#define XB_XCNT(j)  (256  + 64 * (j))
#define XB_XSUB(j)  (1280 + 64 * (j))
#define XB_XGEN(j)  (2304 + 64 * (j))
#define XB_TOP      3328
#define XB_TOPGEN   3392
#define XCD_BAR_WORDS 3456
#define XB_SPIN_CAP (1u << 22)
#define LAS __attribute__((address_space(3)))
DI unsigned xb_ld(unsigned* p)              { return __hip_atomic_load(p, __ATOMIC_RELAXED, __HIP_MEMORY_SCOPE_AGENT); }
DI unsigned xb_add(unsigned* p, unsigned v) { return __hip_atomic_fetch_add(p, v, __ATOMIC_RELAXED, __HIP_MEMORY_SCOPE_AGENT); }
DI unsigned xb_xcc_id() { return (unsigned)__builtin_amdgcn_s_getreg((3 << 11) | 20) & 0xFu; }
#define XB_SPIN(cond, bar) do { unsigned _sp = 0; while (cond) { __builtin_amdgcn_s_sleep(1); \
    if ((++_sp & 255u) == 0u) { if (xb_ld(&(bar)[XB_TMO])) break; if (_sp > XB_SPIN_CAP) { atomicAdd(&(bar)[XB_TMO], 1u); break; } } } } while (0)
struct XcdBarrier { unsigned* bar; unsigned x; volatile LAS unsigned* st; };
DI XcdBarrier xcd_barrier_post(unsigned* bar, volatile LAS unsigned* st) {
  XcdBarrier b; b.bar = bar; b.x = xb_xcc_id(); b.st = st;
  if (threadIdx.x == 0) (void)xb_add(&bar[XB_XCNT(b.x)], 1u);
  return b;
}
DI void xcd_barrier_complete(unsigned* bar, unsigned x, unsigned& nloc, unsigned& nx) {
  const unsigned G = gridDim.x * gridDim.y * gridDim.z;
  unsigned sum, cnt, mine, sp = 0u;
  for (;;) {
    sum = 0u; cnt = 0u; mine = 0u;
#pragma unroll
    for (unsigned j = 0; j < 16; ++j) { const unsigned c = xb_ld(&bar[XB_XCNT(j)]); sum += c; cnt += (c > 0u) ? 1u : 0u; mine = (j == x) ? c : mine; }
    if (sum == G) break;
    __builtin_amdgcn_s_sleep(1);
    if ((++sp & 255u) == 0u) { if (xb_ld(&bar[XB_TMO])) break; if (sp > XB_SPIN_CAP) { atomicAdd(&bar[XB_TMO], 1u); break; } }
  }
  nloc = mine > 0u ? mine : 1u; nx = cnt > 0u ? cnt : 1u;
}
DI void xcd_barrier(const XcdBarrier& b) {
  asm volatile("s_waitcnt vmcnt(0)" ::: "memory");
  __syncthreads();
  if (threadIdx.x == 0) {
    unsigned* bar = b.bar;
    __builtin_amdgcn_s_waitcnt(0);
    unsigned nloc = b.st[0], nx = b.st[1];
    if (nloc == 0u) { xcd_barrier_complete(bar, b.x, nloc, nx); b.st[0] = nloc; b.st[1] = nx; }
    const unsigned old = xb_add(&bar[XB_XSUB(b.x)], 1u);
    const unsigned gen = old / nloc;
    if (old + 1u == (gen + 1u) * nloc) {
      __builtin_amdgcn_fence(__ATOMIC_RELEASE, "agent");
      asm volatile("s_waitcnt vmcnt(0)" ::: "memory");
      const unsigned og = xb_add(&bar[XB_TOP], 1u);
      const unsigned tg = og / nx;
      if (og + 1u == (tg + 1u) * nx) xb_add(&bar[XB_TOPGEN], 1u);
      else XB_SPIN(xb_ld(&bar[XB_TOPGEN]) == tg, bar);
      __builtin_amdgcn_fence(__ATOMIC_ACQUIRE, "agent");
      xb_add(&bar[XB_XGEN(b.x)], 1u);
      asm volatile("s_waitcnt vmcnt(0)" ::: "memory");
    } else {
      XB_SPIN(xb_ld(&bar[XB_XGEN(b.x)]) == gen, bar);
      __builtin_amdgcn_fence(__ATOMIC_ACQUIRE, "agent");
      asm volatile("s_waitcnt vmcnt(0)" ::: "memory");
    }
  }
  __syncthreads();
}
DI void run_phase(const Params& p, int ph, unsigned char* smem) {
  if (ph == 0) { phase_prep(p, smem); return; }
  if (ph == 17) { phase_final(p); return; }
  const int layer = (ph - 1) >> 3, s = (ph - 1) & 7;
  switch (s) {
    case 0: phase_inproj(p, layer, smem); break;
    case 1: phase_b(p, layer, smem); break;
    case 2: phase_c(p, smem); break;
    case 3: phase_d(p, smem); break;
    case 4: phase_e(p, layer, smem); break;
    case 5: phase_f(p, layer, smem); break;
    case 6: phase_g(p, layer, smem); break;
    default: phase_h(p, layer, smem); break;
  }
}
constexpr int N_PHASES = 18;

#if ONE_LAUNCH
template <int PH> DI void run_all(const Params& p, unsigned char* smem, cg::grid_group& grid, const XcdBarrier& xb) {
  run_phase(p, PH, smem);
  if constexpr (PH + 1 < N_PHASES) {
    if constexpr (PH == 0) grid.sync(); else xcd_barrier(xb);
    run_all<PH + 1>(p, smem, grid, xb);
  }
}
__global__ void __launch_bounds__(256, 2) mega_kernel(Params p) {
  __shared__ __attribute__((aligned(16))) unsigned char smem[SMEM_BYTES];
  __shared__ uint4 xb_words;
  if (threadIdx.x == 0) xb_words = make_uint4(0u, 0u, 0u, 0u);
  __syncthreads();
  const XcdBarrier xb = xcd_barrier_post((unsigned*)(p.ws + O_BAR), (volatile LAS unsigned*)&xb_words);
  cg::grid_group grid = cg::this_grid();
  run_all<0>(p, smem, grid, xb);
}
#else
template <int PH> __global__ void __launch_bounds__(256, 2) phase_kernel(Params p) {
  __shared__ __attribute__((aligned(16))) unsigned char smem[SMEM_BYTES];
  run_phase(p, PH, smem);
}
template <int PH> static void launch_phases(const Params& p, hipStream_t stream) {
  hipLaunchKernelGGL((phase_kernel<PH>), dim3(1024), dim3(256), 0, stream, p);
  if constexpr (PH + 1 < N_PHASES) launch_phases<PH + 1>(p, stream);
}
#endif

extern "C" void kernel_launch(void* const* d_in, const int* in_sizes, int n_in, void* d_out, int out_size, void* d_ws, size_t ws_size, hipStream_t stream) {
  if (ws_size < O_END || n_in < 25) { fprintf(stderr, "workspace too small: %zu < %zu\n", ws_size, (size_t)O_END); return; }
  Params p{};
  p.x = (const float*)d_in[0]; p.pos = (const int*)d_in[1]; p.mix_norm = (const float*)d_in[2]; p.w_in = (const float*)d_in[3]; p.b_forget = (const float*)d_in[4];
  p.pe_k = (const float*)d_in[5]; p.w1_k = (const float*)d_in[6]; p.w2_k = (const float*)d_in[7]; p.pe_v = (const float*)d_in[8]; p.w1_v = (const float*)d_in[9]; p.w2_v = (const float*)d_in[10];
  p.q_norm = (const float*)d_in[11]; p.w_uq = (const float*)d_in[12]; p.kv_norm = (const float*)d_in[13]; p.w_ukv = (const float*)d_in[14];
  p.wbr_nsa = (const float*)d_in[15]; p.wbr_fox = (const float*)d_in[16]; p.wbr_mla = (const float*)d_in[17]; p.w_out = (const float*)d_in[18];
  p.ffn_norm = (const float*)d_in[19]; p.w_up = (const float*)d_in[20]; p.conv_w = (const float*)d_in[21]; p.conv_b = (const float*)d_in[22]; p.w_down = (const float*)d_in[23]; p.final_norm = (const float*)d_in[24];
  p.out = (float*)d_out; p.ws = (unsigned char*)d_ws;
#if ONE_LAUNCH
  static int grid_blocks = 0;
  if (!grid_blocks) {
    int dev = 0, cus = 0, per_cu = 0;
    hipGetDevice(&dev); hipDeviceGetAttribute(&cus, hipDeviceAttributeMultiprocessorCount, dev);
    hipOccupancyMaxActiveBlocksPerMultiprocessor(&per_cu, mega_kernel, 256, 0);
    if (per_cu > 2) per_cu = 2;
    grid_blocks = cus * per_cu;
  }
  hipMemsetAsync(p.ws + O_BAR, 0, XCD_BAR_WORDS * 4, stream);
  void* args[] = {&p};
  hipError_t e = hipLaunchCooperativeKernel((void*)mega_kernel, dim3(grid_blocks), dim3(256), args, 0, stream);
  if (e != hipSuccess) fprintf(stderr, "cooperative launch failed: %s (grid %d)\n", hipGetErrorString(e), grid_blocks);
#else
  launch_phases<0>(p, stream);
#endif
}
```

```cpp
#include <hip/hip_runtime.h>
#include <hip/hip_cooperative_groups.h>
#include <stdint.h>
#include <stdio.h>
#include <type_traits>
namespace cg = cooperative_groups;

#ifndef ONE_LAUNCH
#define ONE_LAUNCH 1
#endif

#define DI __device__ __forceinline__
typedef unsigned short bf16_t;
typedef short bf16x8 __attribute__((ext_vector_type(8)));
typedef float f32x4 __attribute__((ext_vector_type(4)));
typedef float f32x16 __attribute__((ext_vector_type(16)));
typedef float f32x2 __attribute__((ext_vector_type(2)));
typedef __bf16 bfx2 __attribute__((ext_vector_type(2)));
typedef unsigned u32x4 __attribute__((ext_vector_type(4)));
typedef unsigned u32x2 __attribute__((ext_vector_type(2)));
typedef unsigned long long u64;

constexpr int T_ = 32768, S_ = 4096, NB_ = 8, D_ = 1024, DFF_ = 2816, NIN_ = 6592;
constexpr float EPS_ = 1e-6f;
constexpr float LOG2E_ = 1.4426950408889634f;
constexpr float QS64_ = 0.125f * LOG2E_;
constexpr float QS96_ = 0.10206207261596577f * LOG2E_;

constexpr size_t W_IN = 0;
constexpr size_t W_G = W_IN + (size_t)3584 * 1024;
constexpr size_t W_1K = W_G + (size_t)3072 * 1024;
constexpr size_t W_1V = W_1K + (size_t)256 * 2048;
constexpr size_t W_2K = W_1V + (size_t)256 * 2048;
constexpr size_t W_2V = W_2K + (size_t)64 * 256;
constexpr size_t W_UQ = W_2V + (size_t)64 * 256;
constexpr size_t W_UKV = W_UQ + (size_t)768 * 384;
constexpr size_t W_BN = W_UKV + (size_t)1024 * 256;
constexpr size_t W_BF = W_BN + (size_t)1024 * 512;
constexpr size_t W_BM = W_BF + (size_t)1024 * 512;
constexpr size_t W_OUT = W_BM + (size_t)1024 * 512;
constexpr size_t W_UP = W_OUT + (size_t)1024 * 1024;
constexpr size_t W_DN = W_UP + (size_t)5632 * 1024;
constexpr size_t W_LAYER = W_DN + (size_t)1024 * 2816;

constexpr size_t al256(size_t x) { return (x + 255) & ~(size_t)255; }
constexpr size_t O_BAR = 0;
constexpr size_t O_W = 16384;
constexpr size_t O_BIAS1 = al256(O_W + 2 * W_LAYER * 2);
constexpr size_t O_ROPE8 = al256(O_BIAS1 + 2 * 2 * 256 * 4);
constexpr size_t O_ROPE16 = al256(O_ROPE8 + (size_t)T_ * 16 * 4);
constexpr size_t O_XG = al256(O_ROPE16 + (size_t)T_ * 32 * 4);
constexpr size_t O_SSQ = al256(O_XG + (size_t)T_ * 1024 * 2);
constexpr size_t O_CSSQ = al256(O_SSQ + (size_t)T_ * 16 * 4);
constexpr size_t O_NSAQ = al256(O_CSSQ + (size_t)T_ * 16 * 4);
constexpr size_t O_KVCMP = O_NSAQ + (size_t)T_ * 512 * 2;
constexpr size_t O_KSLC = O_KVCMP + (size_t)T_ * 256 * 2;
constexpr size_t O_KWIN = O_KSLC + (size_t)T_ * 128 * 2;
constexpr size_t O_MERGED = O_NSAQ;
constexpr size_t O_VSLCT = O_KWIN + (size_t)T_ * 128 * 2;
constexpr size_t O_VWINT = O_VSLCT + (size_t)T_ * 128 * 2;
constexpr size_t O_FOXQ = O_VWINT + (size_t)T_ * 128 * 2;
constexpr size_t O_FOXK = O_FOXQ + (size_t)T_ * 512 * 2;
constexpr size_t O_FOXVT = O_FOXK + (size_t)T_ * 512 * 2;
constexpr size_t O_MLAQ = O_FOXVT + (size_t)T_ * 512 * 2;
constexpr size_t O_MLAKN = O_MLAQ + (size_t)T_ * 768 * 2;
constexpr size_t O_ACT = O_FOXQ;
constexpr size_t O_MLAVT = O_MLAKN + (size_t)T_ * 512 * 2;
constexpr size_t O_MLAKPE = O_MLAVT + (size_t)T_ * 512 * 2;
constexpr size_t O_ONSA = O_MLAKPE + (size_t)T_ * 32 * 2;
constexpr size_t O_CQ = O_ONSA;
constexpr size_t O_CKV = O_CQ + (size_t)T_ * 384 * 2;
constexpr size_t O_CEND = O_CKV + (size_t)T_ * 256 * 2;
constexpr size_t O_GATES = al256(O_CEND > O_ONSA + (size_t)T_ * 512 * 2 ? O_CEND : O_ONSA + (size_t)T_ * 512 * 2);
constexpr size_t O_LOGF = al256(O_GATES + (size_t)T_ * 24 * 4);
constexpr size_t O_F2 = al256(O_LOGF + (size_t)T_ * 8 * 4);
constexpr size_t O_KCP = al256(O_F2 + (size_t)T_ * 8 * 4);
constexpr size_t O_SEL = al256(O_KCP + (size_t)2 * 2 * 4096 * 64 * 4);
constexpr size_t O_END = al256(O_SEL + (size_t)NB_ * 2 * S_ * 8);

struct Params {
  const float* x; const int* pos; const float* mix_norm; const float* w_in; const float* b_forget;
  const float* pe_k; const float* w1_k; const float* w2_k; const float* pe_v; const float* w1_v; const float* w2_v;
  const float* q_norm; const float* w_uq; const float* kv_norm; const float* w_ukv;
  const float* wbr_nsa; const float* wbr_fox; const float* wbr_mla; const float* w_out;
  const float* ffn_norm; const float* w_up; const float* conv_w; const float* conv_b; const float* w_down; const float* final_norm;
  float* out; unsigned char* ws;
};

constexpr int SMEM_BYTES = 73728;

DI int TIDX() { int t = (int)threadIdx.x; asm volatile("" : "+v"(t)); return t; }
DI unsigned pk2(float lo, float hi) { f32x2 v = {lo, hi}; return __builtin_bit_cast(unsigned, __builtin_convertvector(v, bfx2)); }
DI bf16_t f2bf(float x) { return (bf16_t)(pk2(x, 0.f) & 0xffffu); }
DI float bf2f(bf16_t h) { return __uint_as_float(((unsigned)h) << 16); }
DI float sigmoidf_(float x) { return 1.f / (1.f + __expf(-x)); }
DI float gelu_tanh(float x) { const float u = 0.7978845608028654f * (x + 0.044715f * x * x * x); return x / (1.f + __expf(-2.f * u)); }
DI float ex2(float x) { return __builtin_amdgcn_exp2f(x); }
DI f32x16 mfma32(bf16x8 a, bf16x8 b, f32x16 c) { return __builtin_amdgcn_mfma_f32_32x32x16_bf16(a, b, c, 0, 0, 0); }
DI f32x4 mfma16(bf16x8 a, bf16x8 b, f32x4 c) { return __builtin_amdgcn_mfma_f32_16x16x32_bf16(a, b, c, 0, 0, 0); }
DI float rstd_from16(const float* p, float inv_n) {
  const f32x4 a = *(const f32x4*)p, b = *(const f32x4*)(p + 4), c = *(const f32x4*)(p + 8), d = *(const f32x4*)(p + 12);
  const float s = ((a[0] + a[1]) + (a[2] + a[3])) + ((b[0] + b[1]) + (b[2] + b[3])) + ((c[0] + c[1]) + (c[2] + c[3])) + ((d[0] + d[1]) + (d[2] + d[3]));
  return rsqrtf(s * inv_n + EPS_);
}

constexpr int LDT = 72;
template <int NJ> struct GemmLds { static constexpr int BN = 32 * NJ; static constexpr int A_ELEMS = 128 * LDT, B_ELEMS = BN * LDT, STAGE = A_ELEMS + B_ELEMS; };

template <int NJ, bool SWAP, class AP, class BP>
DI void gemm_main(f32x4 (&acc)[4][NJ], const AP& ap, int a_kstep, const BP& bp, int b_kstep, int nk, bf16_t* smem) {
  typedef GemmLds<NJ> L;
  constexpr int CB = L::BN / 32;
  const int tid = TIDX(), lane = tid & 63, wid = tid >> 6, wm = wid >> 1, wn = wid & 1, l15 = lane & 15, quad = lane >> 4;
  unsigned pa[4], pb[CB]; bool oka[4];
#pragma unroll
  for (int i = 0; i < 4; ++i) { const int c = tid + 256 * i; pa[i] = ap(c >> 3) + (c & 7) * 8; oka[i] = ap.ok(c >> 3); }
#pragma unroll
  for (int i = 0; i < CB; ++i) { const int c = tid + 256 * i; pb[i] = bp(c >> 3) + (c & 7) * 8; }
  u32x4 ra[2][4], rb[2][CB];
  auto gload = [&](int kt, auto setc) {
    constexpr int st = decltype(setc)::value;
    const bf16_t* ab = ap.base + (size_t)kt * a_kstep; const bf16_t* bb = bp.base + (size_t)kt * b_kstep;
#pragma unroll
    for (int i = 0; i < 4; ++i) ra[st][i] = *(const u32x4*)(ab + pa[i]);
#pragma unroll
    for (int i = 0; i < CB; ++i) rb[st][i] = *(const u32x4*)(bb + pb[i]);
  };
  auto sstore = [&](int buf, auto setc) {
    constexpr int st = decltype(setc)::value;
    bf16_t* As = smem + buf * L::STAGE; bf16_t* Bs = As + L::A_ELEMS;
#pragma unroll
    for (int i = 0; i < 4; ++i) { const int c = tid + 256 * i; *(u32x4*)(As + (c >> 3) * LDT + (c & 7) * 8) = oka[i] ? ra[st][i] : (u32x4){0u, 0u, 0u, 0u}; }
#pragma unroll
    for (int i = 0; i < CB; ++i) { const int c = tid + 256 * i; *(u32x4*)(Bs + (c >> 3) * LDT + (c & 7) * 8) = rb[st][i]; }
  };
  auto compute = [&](int buf) {
    const bf16_t* As = smem + buf * L::STAGE + (wm * 64 + l15) * LDT + quad * 8;
    const bf16_t* Bs = smem + buf * L::STAGE + L::A_ELEMS + (wn * 16 * NJ + l15) * LDT + quad * 8;
#pragma unroll
    for (int ks = 0; ks < 2; ++ks) {
      bf16x8 a[4];
#pragma unroll
      for (int i = 0; i < 4; ++i) a[i] = *(const bf16x8*)(As + i * 16 * LDT + ks * 32);
#pragma unroll
      for (int j = 0; j < NJ; ++j) {
        const bf16x8 b = *(const bf16x8*)(Bs + j * 16 * LDT + ks * 32);
#pragma unroll
        for (int i = 0; i < 4; ++i) acc[i][j] = SWAP ? mfma16(b, a[i], acc[i][j]) : mfma16(a[i], b, acc[i][j]);
      }
    }
  };
  typedef std::integral_constant<int, 0> S0; typedef std::integral_constant<int, 1> S1;
  gload(0, S0{}); gload(1, S1{});
  sstore(0, S0{}); __syncthreads();
  for (int kt = 0; kt < nk; kt += 2) {
    if (kt + 2 < nk) gload(kt + 2, S0{});
    __builtin_amdgcn_sched_barrier(0);
    compute(0);
    sstore(1, S1{});
    __syncthreads();
    if (kt + 3 < nk) gload(kt + 3, S1{});
    __builtin_amdgcn_sched_barrier(0);
    compute(1);
    if (kt + 2 < nk) sstore(0, S0{});
    __syncthreads();
  }
}
template <int NJ> DI void zero_acc(f32x4 (&acc)[4][NJ]) {
#pragma unroll
  for (int i = 0; i < 4; ++i)
#pragma unroll
    for (int j = 0; j < NJ; ++j) acc[i][j] = (f32x4){0.f, 0.f, 0.f, 0.f};
}
struct RowPtr { const bf16_t* base; size_t ld; DI unsigned operator()(int r) const { return (unsigned)r * (unsigned)ld; } DI bool ok(int) const { return true; } };


template <class F> DI void xcd_tiles(int MPX, int NT, F&& body) {
  const int xcd = blockIdx.x & 7, slot = blockIdx.x >> 3, nslots = gridDim.x >> 3, total = MPX * NT;
  for (int li = slot; li < total; li += nslots) {
    const int mg = li / (8 * NT), rem = li - mg * 8 * NT;
    const int gsz = (MPX - mg * 8) < 8 ? (MPX - mg * 8) : 8;
    const int tn = rem / gsz, mi = rem - tn * gsz;
    body(xcd * MPX + mg * 8 + mi, tn);
  }
}
DI int map_col(int map, int n) {
  if (map == 0) return n;
  if (map == 1) {
    if (n < 1280) return n;
    if (n < 2816) return 1304 + (n - 1280);
    if (n < 3200) return 2848 + (n - 2816);
    if (n < 3456) return 3232 + (n - 3200);
    const int c = n - 3456;
    if (c < 24) return 1280 + c;
    if (c < 32) return 2840 + (c - 24);
    if (c < 64) return 3488 + (c - 32);
    return -1;
  }
  if (map == 2) { const int j = n >> 7, c = n & 127; return c < 64 ? j * 64 + c : DFF_ + j * 64 + (c - 64); }
  if (map == 3) { return n < 512 ? (n >> 6) * 128 + (n & 63) : ((n - 512) >> 6) * 128 + 64 + ((n - 512) & 63); }
  return n;
}
struct WJob { const float* src; const float* scale; bf16_t* dst; int K, N, ld, map, off; };
DI void prep_weight_tile(const WJob& j, int tile, float* lds) {
  const int ntn = j.N >> 6, tk = tile / ntn, tn = tile % ntn, tid = TIDX();
  const int n = tn * 64 + (tid & 63); const int sc = map_col(j.map, n);
#pragma unroll 4
  for (int i = 0; i < 16; ++i) {
    const int kk = (tid >> 6) + 4 * i, k = tk * 64 + kk;
    float v = sc >= 0 ? j.src[(size_t)k * j.ld + j.off + sc] : 0.f;
    if (j.scale) v *= j.scale[k];
    lds[kk * 65 + (tid & 63)] = v;
  }
  __syncthreads();
  const int nn = tid >> 2, k0 = (tid & 3) * 16;
  unsigned w[8];
#pragma unroll
  for (int e = 0; e < 8; ++e) w[e] = pk2(lds[(k0 + 2 * e) * 65 + nn], lds[(k0 + 2 * e + 1) * 65 + nn]);
  bf16_t* d = j.dst + (size_t)(tn * 64 + nn) * j.K + tk * 64 + k0;
  *(u32x4*)d = (u32x4){w[0], w[1], w[2], w[3]}; *(u32x4*)(d + 8) = (u32x4){w[4], w[5], w[6], w[7]};
  __syncthreads();
}
DI WJob get_wjob(const Params& p, int layer, int id) {
  bf16_t* wl = (bf16_t*)(p.ws + O_W) + (size_t)layer * W_LAYER; WJob j; j.scale = nullptr; j.map = 0; j.off = 0;
  switch (id) {
    case 0: j.src = p.w_in + (size_t)layer * 1024 * NIN_; j.dst = wl + W_IN; j.K = 1024; j.N = 3584; j.ld = NIN_; j.map = 1; break;
    case 1: j.src = p.w_in + (size_t)layer * 1024 * NIN_; j.dst = wl + W_G; j.K = 1024; j.N = 3072; j.ld = NIN_; j.off = 3520; break;
    case 2: j.src = p.w1_k + (size_t)layer * 2048 * 256; j.dst = wl + W_1K; j.K = 2048; j.N = 256; j.ld = 256; break;
    case 3: j.src = p.w1_v + (size_t)layer * 2048 * 256; j.dst = wl + W_1V; j.K = 2048; j.N = 256; j.ld = 256; break;
    case 4: j.src = p.w2_k + (size_t)layer * 256 * 64; j.dst = wl + W_2K; j.K = 256; j.N = 64; j.ld = 64; break;
    case 5: j.src = p.w2_v + (size_t)layer * 256 * 64; j.dst = wl + W_2V; j.K = 256; j.N = 64; j.ld = 64; break;
    case 6: j.src = p.w_uq + (size_t)layer * 384 * 768; j.dst = wl + W_UQ; j.K = 384; j.N = 768; j.ld = 768; j.scale = p.q_norm + layer * 384; break;
    case 7: j.src = p.w_ukv + (size_t)layer * 256 * 1024; j.dst = wl + W_UKV; j.K = 256; j.N = 1024; j.ld = 1024; j.scale = p.kv_norm + layer * 256; j.map = 3; break;
    case 8: j.src = p.wbr_nsa + (size_t)layer * 512 * 1024; j.dst = wl + W_BN; j.K = 512; j.N = 1024; j.ld = 1024; break;
    case 9: j.src = p.wbr_fox + (size_t)layer * 512 * 1024; j.dst = wl + W_BF; j.K = 512; j.N = 1024; j.ld = 1024; break;
    case 10: j.src = p.wbr_mla + (size_t)layer * 512 * 1024; j.dst = wl + W_BM; j.K = 512; j.N = 1024; j.ld = 1024; break;
    case 11: j.src = p.w_out + (size_t)layer * 1024 * 1024; j.dst = wl + W_OUT; j.K = 1024; j.N = 1024; j.ld = 1024; break;
    case 12: j.src = p.w_up + (size_t)layer * 1024 * 5632; j.dst = wl + W_UP; j.K = 1024; j.N = 5632; j.ld = 5632; j.map = 2; break;
    default: j.src = p.w_down + (size_t)layer * 2816 * 1024; j.dst = wl + W_DN; j.K = 2816; j.N = 1024; j.ld = 1024; break;
  }
  return j;
}
constexpr int WTILES_LAYER = (int)(W_LAYER / 4096);
constexpr int P0_XITEMS = T_ / 32;
constexpr int P0_ROPE_ITEMS = T_ / 256;
constexpr int P0_ITEMS = 2 * WTILES_LAYER + 4 + P0_ROPE_ITEMS + P0_XITEMS;

DI void xg_rows(const float* x, const float* g, bf16_t* xg, float* ssq, int row0) {
  const int lane = TIDX() & 63, wid = TIDX() >> 6;
  for (int rr = 0; rr < 8; ++rr) {
    const int t = row0 + wid * 8 + rr; const float* xr = x + (size_t)t * D_; float s = 0.f;
#pragma unroll
    for (int c = 0; c < 4; ++c) {
      const int k = c * 256 + lane * 4; const f32x4 v = *(const f32x4*)(xr + k), gv = *(const f32x4*)(g + k);
      s += v[0] * v[0] + v[1] * v[1] + v[2] * v[2] + v[3] * v[3];
      *(u32x2*)(xg + (size_t)t * D_ + k) = (u32x2){pk2(v[0] * gv[0], v[1] * gv[1]), pk2(v[2] * gv[2], v[3] * gv[3])};
    }
#pragma unroll
    for (int o = 32; o >= 1; o >>= 1) s += __shfl_xor(s, o);
    if (lane < 16) ssq[(size_t)t * 16 + lane] = lane == 0 ? s : 0.f;
  }
}
DI void phase_prep(const Params& p, unsigned char* smem) {
  for (int it = blockIdx.x; it < P0_ITEMS; it += gridDim.x) {
    int i = it;
    if (i < 2 * WTILES_LAYER) {
      const int layer = i / WTILES_LAYER; int t = i % WTILES_LAYER; int id = 0;
      for (;; ++id) { const WJob j = get_wjob(p, layer, id); const int nt = (j.K >> 6) * (j.N >> 6); if (t < nt) { prep_weight_tile(j, t, (float*)smem); break; } t -= nt; }
      continue;
    }
    i -= 2 * WTILES_LAYER;
    if (i < 4) {
      const int layer = i >> 1, kv = i & 1, c = TIDX();
      const float* pe = (kv ? p.pe_v : p.pe_k) + (size_t)layer * 2048; const float* w1 = (kv ? p.w1_v : p.w1_k) + (size_t)layer * 2048 * 256;
      float s = 0.f;
      for (int kk = 0; kk < 2048; ++kk) s += pe[kk] * w1[(size_t)kk * 256 + c];
      ((float*)(p.ws + O_BIAS1))[(layer * 2 + kv) * 256 + c] = s;
      continue;
    }
    i -= 4;
    if (i < P0_ROPE_ITEMS) {
      const int t = i * 256 + TIDX(); const float fp = (float)p.pos[t];
      float* r8 = (float*)(p.ws + O_ROPE8) + (size_t)t * 16; float* r16 = (float*)(p.ws + O_ROPE16) + (size_t)t * 32;
      for (int f = 0; f < 24; ++f) {
        const int half = f < 8 ? 8 : 16, idx = f < 8 ? f : f - 8;
        const float inv = exp2f(-(float)idx / (float)half * 18.931568569324174f);
        const float ang = fp * inv;
        const double rev = (double)ang * 0.15915494309189535; const float fr = (float)(rev - floor(rev));
        const float sn = __builtin_amdgcn_sinf(fr), cs = __builtin_amdgcn_cosf(fr);
        if (f < 8) { r8[2 * idx] = cs; r8[2 * idx + 1] = sn; } else { r16[2 * idx] = cs; r16[2 * idx + 1] = sn; }
      }
      continue;
    }
    i -= P0_ROPE_ITEMS;
    xg_rows(p.x, p.mix_norm, (bf16_t*)(p.ws + O_XG), (float*)(p.ws + O_SSQ), i * 32);
  }
}

template <bool SWAP> DI void inproj_tile(const Params& p, int layer, int tm, int tn, bf16_t* smem) {
  const bf16_t* wl = (const bf16_t*)(p.ws + O_W) + (size_t)layer * W_LAYER;
  f32x4 acc[4][4]; zero_acc<4>(acc);
  RowPtr ap{(const bf16_t*)(p.ws + O_XG) + (size_t)tm * 128 * D_, (size_t)D_}, bp{wl + W_IN + (size_t)tn * 128 * D_, (size_t)D_};
  gemm_main<4, SWAP>(acc, ap, 64, bp, 64, 16, smem);
  const int lane = TIDX() & 63, wid = TIDX() >> 6, wm = wid >> 1, wn = wid & 1, l15 = lane & 15, quad = lane >> 4;
  const float* ssq = (const float*)(p.ws + O_SSQ);
  if constexpr (!SWAP) {
    bf16_t* dst; int hh;
    if (tn == 7) { dst = (bf16_t*)(p.ws + O_VSLCT); hh = 2; } else if (tn == 9) { dst = (bf16_t*)(p.ws + O_VWINT); hh = 2; } else { dst = (bf16_t*)(p.ws + O_FOXVT); hh = 8; }
    const int hbase = (tn >= 18 ? (tn - 18) * 2 : 0) + wn;
#pragma unroll
    for (int i = 0; i < 4; ++i) {
      const int t0 = tm * 128 + wm * 64 + i * 16 + quad * 4; const int b = t0 >> 12, s = t0 & 4095;
      float rs[4];
#pragma unroll
      for (int r = 0; r < 4; ++r) rs[r] = rstd_from16(ssq + (size_t)(t0 + r) * 16, 1.f / 1024.f);
#pragma unroll
      for (int j = 0; j < 4; ++j) {
        const int d = j * 16 + l15;
        *(u32x2*)(dst + ((size_t)(b * hh + hbase) * 64 + d) * S_ + s) = (u32x2){pk2(acc[i][j][0] * rs[0], acc[i][j][1] * rs[1]), pk2(acc[i][j][2] * rs[2], acc[i][j][3] * rs[3])};
      }
    }
    return;
  } else {
#pragma unroll
    for (int i = 0; i < 4; ++i) {
      const int t = tm * 128 + wm * 64 + i * 16 + l15; const float rs = rstd_from16(ssq + (size_t)t * 16, 1.f / 1024.f);
      const int cw = wn * 64 + quad * 4;
      if (tn < 4 || (tn >= 10 && tn < 14)) {
        bf16_t* dst = (bf16_t*)(p.ws + (tn < 4 ? O_NSAQ : O_FOXQ)) + (size_t)t * 512 + (tn < 4 ? tn : tn - 10) * 128 + cw; const float sc = rs * QS64_;
#pragma unroll
        for (int j = 0; j < 4; ++j) *(u32x2*)(dst + j * 16) = (u32x2){pk2(acc[i][j][0] * sc, acc[i][j][1] * sc), pk2(acc[i][j][2] * sc, acc[i][j][3] * sc)};
      } else if (tn == 4 || tn == 5) {
        bf16_t* dst = (bf16_t*)(p.ws + O_KVCMP) + (size_t)t * 256 + (tn - 4) * 128 + cw;
#pragma unroll
        for (int j = 0; j < 4; ++j) *(u32x2*)(dst + j * 16) = (u32x2){pk2(acc[i][j][0] * rs, acc[i][j][1] * rs), pk2(acc[i][j][2] * rs, acc[i][j][3] * rs)};
      } else if (tn == 6 || tn == 8) {
        bf16_t* dst = (bf16_t*)(p.ws + (tn == 6 ? O_KSLC : O_KWIN)) + (size_t)t * 128 + cw;
        const float* rp = (const float*)(p.ws + O_ROPE8) + (size_t)t * 16 + (quad & 1) * 8;
        float v[4], o[4];
#pragma unroll
        for (int r = 0; r < 4; ++r) { v[r] = acc[i][0][r] * rs; o[r] = __shfl_xor(v[r], 32); }
#pragma unroll
        for (int r = 0; r < 4; ++r) { const float cs = rp[2 * r], sn = rp[2 * r + 1]; v[r] = quad < 2 ? v[r] * cs - o[r] * sn : v[r] * cs + o[r] * sn; }
        *(u32x2*)(dst) = (u32x2){pk2(v[0], v[1]), pk2(v[2], v[3])};
#pragma unroll
        for (int j = 1; j < 4; ++j) *(u32x2*)(dst + j * 16) = (u32x2){pk2(acc[i][j][0] * rs, acc[i][j][1] * rs), pk2(acc[i][j][2] * rs, acc[i][j][3] * rs)};
      } else if (tn >= 14 && tn < 18) {
        bf16_t* dst = (bf16_t*)(p.ws + O_FOXK) + (size_t)t * 512 + (tn - 14) * 128 + cw;
#pragma unroll
        for (int j = 0; j < 4; ++j) *(u32x2*)(dst + j * 16) = (u32x2){pk2(acc[i][j][0] * rs, acc[i][j][1] * rs), pk2(acc[i][j][2] * rs, acc[i][j][3] * rs)};
      } else if (tn >= 22 && tn < 27) {
        const bool isq = tn < 25; const int ct = isq ? tn - 22 : tn - 25;
        bf16_t* dst = isq ? (bf16_t*)(p.ws + O_CQ) + (size_t)t * 384 + ct * 128 + cw : (bf16_t*)(p.ws + O_CKV) + (size_t)t * 256 + ct * 128 + cw;
        float s = 0.f;
#pragma unroll
        for (int j = 0; j < 4; ++j) {
          const float a0 = acc[i][j][0] * rs, a1 = acc[i][j][1] * rs, a2 = acc[i][j][2] * rs, a3 = acc[i][j][3] * rs;
          s += a0 * a0 + a1 * a1 + a2 * a2 + a3 * a3;
          *(u32x2*)(dst + j * 16) = (u32x2){pk2(a0, a1), pk2(a2, a3)};
        }
        s += __shfl_xor(s, 16); s += __shfl_xor(s, 32);
        if (quad == 0) ((float*)(p.ws + O_CSSQ))[(size_t)t * 16 + (isq ? 0 : 8) + ct * 2 + wn] = s;
      } else if (tn == 27) {
        if (wn == 0) {
          float* gt = (float*)(p.ws + O_GATES) + (size_t)t * 24; float* lf = (float*)(p.ws + O_LOGF) + (size_t)t * 8;
#pragma unroll
          for (int r = 0; r < 4; ++r) gt[quad * 4 + r] = sigmoidf_(acc[i][0][r] * rs);
          if (quad < 2) {
#pragma unroll
            for (int r = 0; r < 4; ++r) gt[16 + quad * 4 + r] = sigmoidf_(acc[i][1][r] * rs);
          } else {
#pragma unroll
            for (int r = 0; r < 4; ++r) { const int h = (quad - 2) * 4 + r; const float xx = acc[i][1][r] * rs + p.b_forget[layer * 8 + h]; lf[h] = fminf(xx, 0.f) - log1pf(__expf(-fabsf(xx))); }
          }
          const float* rp = (const float*)(p.ws + O_ROPE16) + (size_t)t * 32 + quad * 8; float o1[4], o2[4];
#pragma unroll
          for (int r = 0; r < 4; ++r) { const float cs = rp[2 * r], sn = rp[2 * r + 1], x1 = acc[i][2][r] * rs, x2 = acc[i][3][r] * rs; o1[r] = x1 * cs - x2 * sn; o2[r] = x2 * cs + x1 * sn; }
          bf16_t* kp = (bf16_t*)(p.ws + O_MLAKPE) + (size_t)t * 32 + quad * 4;
          *(u32x2*)kp = (u32x2){pk2(o1[0], o1[1]), pk2(o1[2], o1[3])}; *(u32x2*)(kp + 16) = (u32x2){pk2(o2[0], o2[1]), pk2(o2[2], o2[3])};
        }
      }
    }
  }
}
constexpr int PA_ITEMS = 256 * 28;
DI void phase_inproj(const Params& p, int layer, unsigned char* smem) {
  xcd_tiles(32, 28, [&](int tm, int tn) {
    const bool vt = (tn == 7 || tn == 9 || (tn >= 18 && tn < 22));
    if (vt) inproj_tile<false>(p, layer, tm, tn, (bf16_t*)smem); else inproj_tile<true>(p, layer, tm, tn, (bf16_t*)smem);
  });
}

template <bool SWAP> DI void mlaup_tile(const Params& p, int layer, int tm, int tn, bf16_t* smem) {
  const bf16_t* wl = (const bf16_t*)(p.ws + O_W) + (size_t)layer * W_LAYER;
  f32x4 acc[4][4]; zero_acc<4>(acc);
  const bool isq = tn < 6; const int K = isq ? 384 : 256;
  RowPtr ap{isq ? (const bf16_t*)(p.ws + O_CQ) + (size_t)tm * 128 * 384 : (const bf16_t*)(p.ws + O_CKV) + (size_t)tm * 128 * 256, (size_t)K};
  RowPtr bp{isq ? wl + W_UQ + (size_t)tn * 128 * 384 : wl + W_UKV + (size_t)(tn - 6) * 128 * 256, (size_t)K};
  gemm_main<4, SWAP>(acc, ap, 64, bp, 64, K / 64, smem);
  const int lane = TIDX() & 63, wid = TIDX() >> 6, wm = wid >> 1, wn = wid & 1, l15 = lane & 15, quad = lane >> 4;
  const float* cssq = (const float*)(p.ws + O_CSSQ);
  if constexpr (!SWAP) {
    bf16_t* dst = (bf16_t*)(p.ws + O_MLAVT); const int h = (tn - 10) * 2 + wn;
#pragma unroll
    for (int i = 0; i < 4; ++i) {
      const int t0 = tm * 128 + wm * 64 + i * 16 + quad * 4; const int b = t0 >> 12, s = t0 & 4095; float rs[4];
#pragma unroll
      for (int r = 0; r < 4; ++r) { const float* c = cssq + (size_t)(t0 + r) * 16 + 8; rs[r] = rsqrtf((c[0] + c[1] + c[2] + c[3]) * (1.f / 256.f) + EPS_); }
#pragma unroll
      for (int j = 0; j < 4; ++j) {
        const int d = j * 16 + l15;
        *(u32x2*)(dst + ((size_t)(b * 8 + h) * 64 + d) * S_ + s) = (u32x2){pk2(acc[i][j][0] * rs[0], acc[i][j][1] * rs[1]), pk2(acc[i][j][2] * rs[2], acc[i][j][3] * rs[3])};
      }
    }
  } else {
#pragma unroll
    for (int i = 0; i < 4; ++i) {
      const int t = tm * 128 + wm * 64 + i * 16 + l15; const float* c = cssq + (size_t)t * 16;
      if (isq) {
        const float rs = rsqrtf((c[0] + c[1] + c[2] + c[3] + c[4] + c[5]) * (1.f / 384.f) + EPS_) * QS96_;
        const int n0 = tn * 128 + wn * 64; bf16_t* dst = (bf16_t*)(p.ws + O_MLAQ) + (size_t)t * 768 + n0 + quad * 4;
        const float* rp = (const float*)(p.ws + O_ROPE16) + (size_t)t * 32 + quad * 8;
#pragma unroll
        for (int j = 0; j < 4; ++j) {
          const int c0 = (n0 + j * 16) % 96;
          if (c0 < 64) { *(u32x2*)(dst + j * 16) = (u32x2){pk2(acc[i][j][0] * rs, acc[i][j][1] * rs), pk2(acc[i][j][2] * rs, acc[i][j][3] * rs)}; }
          else if (c0 == 64 && j < 3) {
            float o1[4], o2[4];
#pragma unroll
            for (int r = 0; r < 4; ++r) { const float cs = rp[2 * r], sn = rp[2 * r + 1], x1 = acc[i][j][r] * rs, x2 = acc[i][j < 3 ? j + 1 : j][r] * rs; o1[r] = x1 * cs - x2 * sn; o2[r] = x2 * cs + x1 * sn; }
            *(u32x2*)(dst + j * 16) = (u32x2){pk2(o1[0], o1[1]), pk2(o1[2], o1[3])}; *(u32x2*)(dst + j * 16 + 16) = (u32x2){pk2(o2[0], o2[1]), pk2(o2[2], o2[3])};
          }
        }
      } else {
        const float rs = rsqrtf((c[8] + c[9] + c[10] + c[11]) * (1.f / 256.f) + EPS_);
        bf16_t* dst = (bf16_t*)(p.ws + O_MLAKN) + (size_t)t * 512 + (tn - 6) * 128 + wn * 64 + quad * 4;
#pragma unroll
        for (int j = 0; j < 4; ++j) *(u32x2*)(dst + j * 16) = (u32x2){pk2(acc[i][j][0] * rs, acc[i][j][1] * rs), pk2(acc[i][j][2] * rs, acc[i][j][3] * rs)};
      }
    }
  }
}
struct CmpRowPtr { const bf16_t* base; int r0;
  DI unsigned operator()(int r) const { int R = r0 + r; if (R >= 4080) R = 0; const int b = R / 510, rem = R - b * 510, n = rem >> 1, g = rem & 1; return (unsigned)(b * S_ + 16 * n) * 256u + g * 64; }
  DI bool ok(int r) const { return r0 + r < 4080; } };
DI void compress_item(const Params& p, int layer, int item, bf16_t* smem) {
  const int kv = item >> 6, nh = (item >> 5) & 1, tm = item & 31;
  const bf16_t* wl = (const bf16_t*)(p.ws + O_W) + (size_t)layer * W_LAYER;
  f32x4 acc[4][4]; zero_acc<4>(acc);
  CmpRowPtr ap{(const bf16_t*)(p.ws + O_KVCMP) + kv * 128, tm * 128};
  RowPtr bp{wl + (kv ? W_1V : W_1K) + (size_t)nh * 128 * 2048, (size_t)2048};
  gemm_main<4, true>(acc, ap, 256, bp, 64, 32, smem);
  const int lane = TIDX() & 63, wid = TIDX() >> 6, wm = wid >> 1, wn = wid & 1, l15 = lane & 15, quad = lane >> 4;
  constexpr int LDH = 136; bf16_t* H = smem;
  const float* b1 = (const float*)(p.ws + O_BIAS1) + (layer * 2 + kv) * 256 + nh * 128;
#pragma unroll
  for (int i = 0; i < 4; ++i)
#pragma unroll
    for (int j = 0; j < 4; ++j) {
      const int row = wm * 64 + i * 16 + l15, col = wn * 64 + j * 16 + quad * 4; const f32x4 bv = *(const f32x4*)(b1 + col);
      *(u32x2*)(H + row * LDH + col) = (u32x2){pk2(gelu_tanh(acc[i][j][0] + bv[0]), gelu_tanh(acc[i][j][1] + bv[1])), pk2(gelu_tanh(acc[i][j][2] + bv[2]), gelu_tanh(acc[i][j][3] + bv[3]))};
    }
  __syncthreads();
  f32x4 a2[2][4];
#pragma unroll
  for (int i = 0; i < 2; ++i)
#pragma unroll
    for (int j = 0; j < 4; ++j) a2[i][j] = (f32x4){0.f, 0.f, 0.f, 0.f};
  const bf16_t* w2 = wl + (kv ? W_2V : W_2K) + nh * 128;
#pragma unroll
  for (int ks = 0; ks < 4; ++ks) {
    bf16x8 a[2], b[4];
#pragma unroll
    for (int i = 0; i < 2; ++i) a[i] = *(const bf16x8*)(H + (wid * 32 + i * 16 + l15) * LDH + ks * 32 + quad * 8);
#pragma unroll
    for (int j = 0; j < 4; ++j) b[j] = *(const bf16x8*)(w2 + (size_t)(j * 16 + l15) * 256 + ks * 32 + quad * 8);
#pragma unroll
    for (int i = 0; i < 2; ++i)
#pragma unroll
      for (int j = 0; j < 4; ++j) a2[i][j] = mfma16(a[i], b[j], a2[i][j]);
  }
  float* kcp = (float*)(p.ws + O_KCP) + (size_t)(kv * 2 + nh) * 4096 * 64;
#pragma unroll
  for (int i = 0; i < 2; ++i)
#pragma unroll
    for (int j = 0; j < 4; ++j)
#pragma unroll
      for (int r = 0; r < 4; ++r) { const int R = tm * 128 + wid * 32 + i * 16 + quad * 4 + r; kcp[(size_t)R * 64 + j * 16 + l15] = a2[i][j][r]; }
  __syncthreads();
}
DI void foxscan_item(const Params& p, int item, float* lds) {
  const int b = item >> 3, h = item & 7, tid = TIDX();
  const float* lf = (const float*)(p.ws + O_LOGF) + (size_t)b * S_ * 8 + h; float v[16]; float s = 0.f;
#pragma unroll
  for (int i = 0; i < 16; ++i) { s += lf[(size_t)(tid * 16 + i) * 8]; v[i] = s; }
  lds[tid] = s; __syncthreads();
  float off = 0.f;
  for (int i = 0; i < tid; ++i) off += lds[i];
  float* F2 = (float*)(p.ws + O_F2) + (size_t)(b * 8 + h) * S_ + tid * 16;
#pragma unroll
  for (int i = 0; i < 16; ++i) F2[i] = -(off + v[i]) * LOG2E_;
  __syncthreads();
}
constexpr int PB_ITEMS = 128 + 64 + 256 * 14;
DI void phase_b(const Params& p, int layer, unsigned char* smem) {
  for (int it = blockIdx.x; it < 192; it += gridDim.x) {
    if (it < 128) compress_item(p, layer, it, (bf16_t*)smem);
    else foxscan_item(p, it - 128, (float*)smem);
  }
  xcd_tiles(32, 14, [&](int tm, int tn) { if (tn >= 10) mlaup_tile<false>(p, layer, tm, tn, (bf16_t*)smem); else mlaup_tile<true>(p, layer, tm, tn, (bf16_t*)smem); });
}

constexpr int KC_LD = 72, VC_LD = 264;
DI void cmp_item(const Params& p, int item, unsigned char* smem_) {
  const int b = item >> 7, g = (item >> 6) & 1, tt = item & 63, t0 = tt * 64;
  const int tid = TIDX(), lane = tid & 63, wid = tid >> 6, l15 = lane & 15, quad = lane >> 4;
  bf16_t* kcs = (bf16_t*)smem_;
  bf16_t* vcs = kcs + 256 * KC_LD;
  float* imps = (float*)smem_;
  const int nmax = (t0 + 32) >> 4;
  const int nsub = t0 == 0 && false ? 0 : ((nmax >> 4) + 1);
  {
    const float* k0 = (const float*)(p.ws + O_KCP), *k1 = k0 + (size_t)4096 * 64, *v0 = k0 + (size_t)2 * 4096 * 64, *v1 = k0 + (size_t)3 * 4096 * 64;
    const int nrows = ((nsub + 1) & ~1) * 16;
    for (int e = tid; e < nrows * 16; e += 256) {
      const int n = e >> 4, d4 = (e & 15) * 4;
      f32x4 kk = {0.f, 0.f, 0.f, 0.f}, vv = {0.f, 0.f, 0.f, 0.f};
      if (n < 255) { const size_t R = (size_t)(b * 510 + n * 2 + g) * 64 + d4; kk = *(const f32x4*)(k0 + R) + *(const f32x4*)(k1 + R); vv = *(const f32x4*)(v0 + R) + *(const f32x4*)(v1 + R); }
      *(u32x2*)(kcs + n * KC_LD + d4) = (u32x2){pk2(kk[0], kk[1]), pk2(kk[2], kk[3])};
#pragma unroll
      for (int r = 0; r < 4; ++r) vcs[(d4 + r) * VC_LD + n] = f2bf(vv[r]);
    }
  }
  __syncthreads();
  const int tq = t0 + wid * 16 + l15;
  const size_t trow = (size_t)b * S_ + tq;
  float impa[16], p3a[16];
#pragma unroll
  for (int s = 0; s < 16; ++s) { impa[s] = 0.f; p3a[s] = 0.f; }
  const float* gts = (const float*)(p.ws + O_GATES) + trow * 24;
#pragma unroll 1
  for (int r4 = 0; r4 < 4; ++r4) {
    const int head = g * 4 + r4;
    const bf16_t* qp = (const bf16_t*)(p.ws + O_NSAQ) + trow * 512 + head * 64 + quad * 8;
    const bf16x8 q0 = *(const bf16x8*)qp, q1 = *(const bf16x8*)(qp + 32);
    auto score = [&](int s) -> f32x4 {
      const bf16_t* kr = kcs + (s * 16 + l15) * KC_LD + quad * 8;
      f32x4 a = {0.f, 0.f, 0.f, 0.f};
      a = mfma16(*(const bf16x8*)kr, q0, a); a = mfma16(*(const bf16x8*)(kr + 32), q1, a);
#pragma unroll
      for (int r = 0; r < 4; ++r) { const int n = s * 16 + quad * 4 + r; a[r] = (16 * n + 31 <= tq) ? a[r] : -INFINITY; }
      return a;
    };
    float mx = -INFINITY;
#pragma unroll 1
    for (int s = 0; s < nsub; ++s) { const f32x4 a = score(s); mx = fmaxf(mx, fmaxf(fmaxf(a[0], a[1]), fmaxf(a[2], a[3]))); }
    mx = fmaxf(mx, __shfl_xor(mx, 16)); mx = fmaxf(mx, __shfl_xor(mx, 32));
    if (mx == -INFINITY) mx = 0.f;
    float sum = 0.f;
#pragma unroll 1
    for (int s = 0; s < nsub; ++s) { const f32x4 a = score(s); sum += (ex2(a[0] - mx) + ex2(a[1] - mx)) + (ex2(a[2] - mx) + ex2(a[3] - mx)); }
    sum += __shfl_xor(sum, 16); sum += __shfl_xor(sum, 32);
    const float inv = 1.f / fmaxf(sum, 1e-30f);
    f32x4 oacc[4];
#pragma unroll
    for (int j = 0; j < 4; ++j) oacc[j] = (f32x4){0.f, 0.f, 0.f, 0.f};
#pragma unroll
    for (int c = 0; c < 8; ++c) {
      asm volatile("" ::: "memory");
      if (2 * c < nsub) {
        f32x4 pa = score(2 * c), pb = {-INFINITY, -INFINITY, -INFINITY, -INFINITY};
        if (2 * c + 1 < nsub) pb = score(2 * c + 1);
#pragma unroll
        for (int r = 0; r < 4; ++r) { pa[r] = ex2(pa[r] - mx) * inv; pb[r] = ex2(pb[r] - mx) * inv; }
        impa[2 * c] += pa[0] + pa[1] + pa[2] + 0.5f * pa[3]; p3a[2 * c] += pa[3];
        impa[2 * c + 1] += pb[0] + pb[1] + pb[2] + 0.5f * pb[3]; p3a[2 * c + 1] += pb[3];
        const u32x4 pw = {pk2(pa[0], pa[1]), pk2(pa[2], pa[3]), pk2(pb[0], pb[1]), pk2(pb[2], pb[3])};
        const bf16x8 pf = __builtin_bit_cast(bf16x8, pw);
#pragma unroll
        for (int j = 0; j < 4; ++j) {
          const bf16_t* vr = vcs + (j * 16 + l15) * VC_LD + c * 32 + quad * 4;
          const u32x2 lo = *(const u32x2*)vr, hi = *(const u32x2*)(vr + 16);
          const u32x4 vw = {lo[0], lo[1], hi[0], hi[1]};
          oacc[j] = mfma16(__builtin_bit_cast(bf16x8, vw), pf, oacc[j]);
        }
      }
    }
    const float g0 = gts[head * 3 + 0];
    bf16_t* op = (bf16_t*)(p.ws + O_ONSA) + trow * 512 + head * 64 + quad * 4;
#pragma unroll
    for (int j = 0; j < 4; ++j) *(u32x2*)(op + j * 16) = (u32x2){pk2(oacc[j][0] * g0, oacc[j][1] * g0), pk2(oacc[j][2] * g0, oacc[j][3] * g0)};
  }
  __syncthreads();
  float* myimp = imps + wid * 1024 + l15 * 64;
  const int cur = tq >> 6;
#pragma unroll
  for (int s = 0; s < 16; ++s) {
    const float up = __shfl(p3a[s], (lane + 48) & 63);
    const float up0 = s ? __shfl(p3a[s ? s - 1 : 0], (lane + 48) & 63) : 0.f;
    const float prev = quad ? up : up0;
    float v = impa[s] + 0.5f * prev;
    const int j = 4 * s + quad;
    if (j == 0 || j == cur || j == cur - 1) v = 1e9f; else if (j > cur) v = -1e9f;
    myimp[j] = v;
  }
  __syncthreads();
  u64* sel = (u64*)(p.ws + O_SEL) + (size_t)(b * 2 + g) * S_ + t0 + wid * 16;
#pragma unroll 1
  for (int q = 0; q < 16; ++q) {
    const float mine = imps[wid * 1024 + q * 64 + lane]; int rank = 0;
#pragma unroll
    for (int i = 0; i < 64; ++i) { const float v = __uint_as_float(__builtin_amdgcn_readlane(__float_as_uint(mine), i)); rank += (v > mine || (v == mine && i < lane)) ? 1 : 0; }
    const u64 m = __ballot(rank < 16);
    if (lane == 0) sel[q] = m;
  }
  __syncthreads();
}
constexpr int PC_ITEMS = NB_ * 2 * 64;
DI void phase_c(const Params& p, unsigned char* smem) { for (int it = blockIdx.x; it < PC_ITEMS; it += gridDim.x) cmp_item(p, it, smem); }

enum { M_FOX = 0, M_MLA = 1, M_WIN = 2, M_SLC = 3 };
template <int MODE> struct ACfg { static constexpr int DQK = MODE == M_MLA ? 96 : 64, KLD = DQK + 8, KCH = DQK / 8 * 64 / 256, K_ELEMS = 64 * KLD, V_ELEMS = 64 * 72, STAGE = K_ELEMS + V_ELEMS + 128; };
struct AState { f32x16 o[2]; float m, l; };

template <int MODE>
DI void flash_pass(AState& st, const bf16x8* qf, u64 tmask, u64 wmask,
                   const bf16_t* kbase, size_t kld, const bf16_t* kpe, const bf16_t* vtbase, const float* fbias,
                   int tq, u64 mysel, bf16_t* smem) {
  typedef ACfg<MODE> C;
  const int tid = TIDX(), lane = tid & 63, l31 = lane & 31, half = lane >> 5;
  u32x4 rk[C::KCH], rv[2]; float rf = 0.f;
  auto gload = [&](int j) {
    const int k0 = j * 64;
#pragma unroll
    for (int i = 0; i < C::KCH; ++i) {
      const int c = tid + 256 * i;
      if constexpr (MODE == M_MLA) { const int key = c / 12, dc = c % 12; rk[i] = dc < 8 ? *(const u32x4*)(kbase + (size_t)(k0 + key) * kld + dc * 8) : *(const u32x4*)(kpe + (size_t)(k0 + key) * 32 + (dc - 8) * 8); }
      else { const int key = c >> 3, dc = c & 7; rk[i] = *(const u32x4*)(kbase + (size_t)(k0 + key) * kld + dc * 8); }
    }
#pragma unroll
    for (int i = 0; i < 2; ++i) { const int c = tid + 256 * i, d = c >> 3, kc = c & 7; rv[i] = *(const u32x4*)(vtbase + (size_t)d * S_ + k0 + kc * 8); }
    if constexpr (MODE == M_FOX) { if (tid < 64) rf = fbias[k0 + tid]; }
  };
  auto sstore = [&](int buf) {
    bf16_t* Ks = smem + buf * C::STAGE; bf16_t* Vs = Ks + C::K_ELEMS;
#pragma unroll
    for (int i = 0; i < C::KCH; ++i) {
      const int c = tid + 256 * i;
      if constexpr (MODE == M_MLA) { const int key = c / 12, dc = c % 12; *(u32x4*)(Ks + key * C::KLD + dc * 8) = rk[i]; }
      else { const int key = c >> 3, dc = c & 7; *(u32x4*)(Ks + key * C::KLD + dc * 8) = rk[i]; }
    }
#pragma unroll
    for (int i = 0; i < 2; ++i) {
      const int c = tid + 256 * i, d = c >> 3, kc = c & 7, cgp = kc >> 1, a = kc & 1;
      bf16_t* dst = Vs + d * 72 + cgp * 16 + 4 * a;
      *(u32x2*)dst = (u32x2){rv[i][0], rv[i][1]}; *(u32x2*)(dst + 8) = (u32x2){rv[i][2], rv[i][3]};
    }
    if constexpr (MODE == M_FOX) { if (tid < 64) ((float*)(Vs + C::V_ELEMS))[tid] = rf; }
  };
  u64 tm = tmask;
  if (tm == 0) return;
  int j = __builtin_ctzll(tm); tm &= tm - 1;
  gload(j); sstore(0); __syncthreads();
  int buf = 0;
  const int tmin = __builtin_amdgcn_readfirstlane(tq - l31), tmax = tmin + 31;
  while (true) {
    const int jn = tm ? __builtin_ctzll(tm) : -1; if (tm) tm &= tm - 1;
    if (jn >= 0) gload(jn);
    if ((wmask >> j) & 1) {
      const bf16_t* Ks = smem + buf * C::STAGE; const bf16_t* Vs = Ks + C::K_ELEMS;
      f32x16 s0, s1;
#pragma unroll
      for (int r = 0; r < 16; ++r) { s0[r] = 0.f; s1[r] = 0.f; }
      const bf16_t* kr = Ks + l31 * C::KLD + half * 8;
#pragma unroll
      for (int ks = 0; ks < C::DQK / 16; ++ks) {
        s0 = mfma32(*(const bf16x8*)(kr + ks * 16), qf[ks], s0);
        s1 = mfma32(*(const bf16x8*)(kr + 32 * C::KLD + ks * 16), qf[ks], s1);
      }
      const int k0 = j * 64;
      if constexpr (MODE == M_FOX) {
        const float* fb = (const float*)(Vs + C::V_ELEMS) + 4 * half;
#pragma unroll
        for (int g4 = 0; g4 < 4; ++g4) {
          const f32x4 b0 = *(const f32x4*)(fb + 8 * g4), b1 = *(const f32x4*)(fb + 32 + 8 * g4);
#pragma unroll
          for (int r = 0; r < 4; ++r) { s0[4 * g4 + r] += b0[r]; s1[4 * g4 + r] += b1[r]; }
        }
      }
      bool need = k0 + 63 > tmin;
      if constexpr (MODE == M_WIN) need = need || (k0 <= tmax - 512);
      if constexpr (MODE == M_SLC) need = true;
      if (need) {
        const bool rowok = MODE == M_SLC ? ((mysel >> j) & 1) != 0 : true;
#pragma unroll
        for (int r = 0; r < 16; ++r) {
          const int key = k0 + (r & 3) + 8 * (r >> 2) + 4 * half;
          bool ok0 = rowok && key <= tq, ok1 = rowok && key + 32 <= tq;
          if constexpr (MODE == M_WIN) { ok0 = ok0 && (tq - key < 512); ok1 = ok1 && (tq - key - 32 < 512); }
          s0[r] = ok0 ? s0[r] : -INFINITY; s1[r] = ok1 ? s1[r] : -INFINITY;
        }
      }
      float mx = -INFINITY;
#pragma unroll
      for (int r = 0; r < 16; ++r) mx = fmaxf(mx, fmaxf(s0[r], s1[r]));
      mx = fmaxf(mx, __shfl_xor(mx, 32));
      const float mn = fmaxf(st.m, mx), alpha = ex2(st.m - mn);
      st.m = mn;
      float sum = 0.f;
#pragma unroll
      for (int r = 0; r < 16; ++r) { s0[r] = ex2(s0[r] - mn); s1[r] = ex2(s1[r] - mn); sum += s0[r] + s1[r]; }
      st.l = st.l * alpha + sum;
#pragma unroll
      for (int r = 0; r < 16; ++r) { st.o[0][r] *= alpha; st.o[1][r] *= alpha; }
      const bf16_t* vr = Vs + l31 * 72 + half * 8;
#pragma unroll
      for (int c = 0; c < 4; ++c) {
        u32x4 pw;
        if (c < 2) pw = (u32x4){pk2(s0[8 * c + 0], s0[8 * c + 1]), pk2(s0[8 * c + 2], s0[8 * c + 3]), pk2(s0[8 * c + 4], s0[8 * c + 5]), pk2(s0[8 * c + 6], s0[8 * c + 7])};
        else pw = (u32x4){pk2(s1[8 * (c - 2) + 0], s1[8 * (c - 2) + 1]), pk2(s1[8 * (c - 2) + 2], s1[8 * (c - 2) + 3]), pk2(s1[8 * (c - 2) + 4], s1[8 * (c - 2) + 5]), pk2(s1[8 * (c - 2) + 6], s1[8 * (c - 2) + 7])};
        const bf16x8 pf = __builtin_bit_cast(bf16x8, pw);
        st.o[0] = mfma32(*(const bf16x8*)(vr + c * 16), pf, st.o[0]);
        st.o[1] = mfma32(*(const bf16x8*)(vr + 32 * 72 + c * 16), pf, st.o[1]);
      }
    }
    if (jn >= 0) sstore(buf ^ 1);
    __syncthreads();
    if (jn < 0) break;
    j = jn; buf ^= 1;
  }
}
DI void astate_init(AState& s) {
#pragma unroll
  for (int r = 0; r < 16; ++r) { s.o[0][r] = 0.f; s.o[1][r] = 0.f; }
  s.m = -1e30f; s.l = 0.f;
}
DI u64 lowbits(int n) { return n >= 64 ? ~0ull : ((1ull << n) - 1ull); }

template <int MODE> DI void dense_attn_item(const Params& p, int b, int h, int qt, bf16_t* smem) {
  const int lane = TIDX() & 63, wid = TIDX() >> 6, l31 = lane & 31, half = lane >> 5;
  const int t0 = qt * 128, tq = t0 + wid * 32 + l31; const size_t trow = (size_t)b * S_ + tq;
  constexpr int NQ = ACfg<MODE>::DQK / 16;
  bf16x8 qf[NQ];
  const bf16_t* qp = MODE == M_FOX ? (const bf16_t*)(p.ws + O_FOXQ) + trow * 512 + h * 64 : (const bf16_t*)(p.ws + O_MLAQ) + trow * 768 + h * 96;
#pragma unroll
  for (int ks = 0; ks < NQ; ++ks) qf[ks] = *(const bf16x8*)(qp + ks * 16 + half * 8);
  AState st; astate_init(st);
  const u64 tmask = lowbits(2 * qt + 2), wmask = lowbits(((t0 + wid * 32 + 31) >> 6) + 1);
  if constexpr (MODE == M_FOX)
    flash_pass<M_FOX>(st, qf, tmask, wmask, (const bf16_t*)(p.ws + O_FOXK) + (size_t)b * S_ * 512 + h * 64, 512, nullptr,
                      (const bf16_t*)(p.ws + O_FOXVT) + (size_t)(b * 8 + h) * 64 * S_, (const float*)(p.ws + O_F2) + (size_t)(b * 8 + h) * S_, tq, 0ull, smem);
  else
    flash_pass<M_MLA>(st, qf, tmask, wmask, (const bf16_t*)(p.ws + O_MLAKN) + (size_t)b * S_ * 512 + h * 64, 512, (const bf16_t*)(p.ws + O_MLAKPE) + (size_t)b * S_ * 32,
                      (const bf16_t*)(p.ws + O_MLAVT) + (size_t)(b * 8 + h) * 64 * S_, nullptr, tq, 0ull, smem);
  const float l = st.l + __shfl_xor(st.l, 32), inv = 1.f / fmaxf(l, 1e-30f);
  bf16_t* op = (bf16_t*)qp;
#pragma unroll
  for (int dt = 0; dt < 2; ++dt)
#pragma unroll
    for (int g4 = 0; g4 < 4; ++g4) {
      const int d = dt * 32 + g4 * 8 + half * 4;
      *(u32x2*)(op + d) = (u32x2){pk2(st.o[dt][4 * g4] * inv, st.o[dt][4 * g4 + 1] * inv), pk2(st.o[dt][4 * g4 + 2] * inv, st.o[dt][4 * g4 + 3] * inv)};
    }
}
DI void nsa_attn_item(const Params& p, int b, int g, int qt, bf16_t* smem) {
  const int lane = TIDX() & 63, wid = TIDX() >> 6, l31 = lane & 31, half = lane >> 5;
  const int t0 = qt * 32, tq = t0 + l31, head = g * 4 + wid; const size_t trow = (size_t)b * S_ + tq;
  bf16x8 qf[4];
  const bf16_t* qp = (const bf16_t*)(p.ws + O_NSAQ) + trow * 512 + head * 64;
#pragma unroll
  for (int ks = 0; ks < 4; ++ks) qf[ks] = *(const bf16x8*)(qp + ks * 16 + half * 8);
  {
    const float* rp = (const float*)(p.ws + O_ROPE8) + trow * 16;
    u32x4 me = __builtin_bit_cast(u32x4, qf[0]), ot;
#pragma unroll
    for (int e = 0; e < 4; ++e) ot[e] = __shfl_xor(me[e], 32);
    unsigned res[4];
#pragma unroll
    for (int e = 0; e < 4; ++e) {
      float o2[2];
#pragma unroll
      for (int u = 0; u < 2; ++u) {
        const int f = 2 * e + u; const float cs = rp[2 * f], sn = rp[2 * f + 1];
        const float a = bf2f((bf16_t)(u ? me[e] >> 16 : me[e] & 0xffffu)), o = bf2f((bf16_t)(u ? ot[e] >> 16 : ot[e] & 0xffffu));
        o2[u] = half == 0 ? a * cs - o * sn : a * cs + o * sn;
      }
      res[e] = pk2(o2[0], o2[1]);
    }
    qf[0] = __builtin_bit_cast(bf16x8, (u32x4){res[0], res[1], res[2], res[3]});
  }
  const float* gts = (const float*)(p.ws + O_GATES) + trow * 24 + head * 3;
  const int cur = t0 >> 6;
  f32x16 res[2];
  {
    AState st; astate_init(st);
    const int first = t0 >= 511 ? (t0 - 511) >> 6 : 0;
    const u64 tmask = lowbits(cur + 1) & ~lowbits(first);
    flash_pass<M_WIN>(st, qf, tmask, tmask, (const bf16_t*)(p.ws + O_KWIN) + (size_t)b * S_ * 128 + g * 64, 128, nullptr,
                      (const bf16_t*)(p.ws + O_VWINT) + (size_t)(b * 2 + g) * 64 * S_, nullptr, tq, 0ull, smem);
    const float l = st.l + __shfl_xor(st.l, 32), sc = gts[2] / fmaxf(l, 1e-30f);
#pragma unroll
    for (int r = 0; r < 16; ++r) { res[0][r] = st.o[0][r] * sc; res[1][r] = st.o[1][r] * sc; }
  }
  {
    AState st; astate_init(st);
    const u64 mysel = ((const u64*)(p.ws + O_SEL))[(size_t)(b * 2 + g) * S_ + tq];
    unsigned lo = (unsigned)mysel, hi = (unsigned)(mysel >> 32);
#pragma unroll
    for (int o = 16; o >= 1; o >>= 1) { lo |= __shfl_xor(lo, o); hi |= __shfl_xor(hi, o); }
    const u64 um = (((u64)(unsigned)__builtin_amdgcn_readfirstlane(hi) << 32) | (u64)(unsigned)__builtin_amdgcn_readfirstlane(lo)) & lowbits(cur + 1);
    flash_pass<M_SLC>(st, qf, um, um, (const bf16_t*)(p.ws + O_KSLC) + (size_t)b * S_ * 128 + g * 64, 128, nullptr,
                      (const bf16_t*)(p.ws + O_VSLCT) + (size_t)(b * 2 + g) * 64 * S_, nullptr, tq, mysel, smem);
    const float l = st.l + __shfl_xor(st.l, 32), sc = gts[1] / fmaxf(l, 1e-30f);
#pragma unroll
    for (int r = 0; r < 16; ++r) { res[0][r] += st.o[0][r] * sc; res[1][r] += st.o[1][r] * sc; }
  }
  bf16_t* op = (bf16_t*)(p.ws + O_ONSA) + trow * 512 + head * 64;
#pragma unroll
  for (int dt = 0; dt < 2; ++dt)
#pragma unroll
    for (int g4 = 0; g4 < 4; ++g4) {
      const int d = dt * 32 + g4 * 8 + half * 4;
      const u32x2 oc = *(const u32x2*)(op + d);
      const float c0 = bf2f((bf16_t)(oc[0] & 0xffffu)), c1 = bf2f((bf16_t)(oc[0] >> 16)), c2 = bf2f((bf16_t)(oc[1] & 0xffffu)), c3 = bf2f((bf16_t)(oc[1] >> 16));
      *(u32x2*)(op + d) = (u32x2){pk2(res[dt][4 * g4] + c0, res[dt][4 * g4 + 1] + c1), pk2(res[dt][4 * g4 + 2] + c2, res[dt][4 * g4 + 3] + c3)};
    }
}
constexpr int PD_ITEMS = 32 * 192;
DI void phase_d(const Params& p, unsigned char* smem) {
  for (int it = blockIdx.x; it < PD_ITEMS; it += gridDim.x) {
    const int r = it / 192, w = it % 192, qt = 31 - r;
    if (w < 64) dense_attn_item<M_MLA>(p, w >> 3, w & 7, qt, (bf16_t*)smem);
    else if (w < 128) dense_attn_item<M_FOX>(p, (w - 64) >> 3, (w - 64) & 7, qt, (bf16_t*)smem);
    else { const int i = w - 128, bg = i & 15, q4 = i >> 4; nsa_attn_item(p, bg >> 1, bg & 1, qt * 4 + q4, (bf16_t*)smem); }
  }
}

constexpr int PE_ITEMS = 256 * 16;
DI void merge_tile(const Params& p, int layer, int tm, int tn, bf16_t* smem) {
  const bf16_t* wl = (const bf16_t*)(p.ws + O_W) + (size_t)layer * W_LAYER;
  const int lane = TIDX() & 63, wid = TIDX() >> 6, wm = wid >> 1, wn = wid & 1, l15 = lane & 15, quad = lane >> 4;
  f32x4 mg[4][2]; zero_acc<2>(mg);
  unsigned* gsp = (unsigned*)((unsigned char*)smem + 2 * GemmLds<2>::STAGE * 2) + TIDX();
#pragma unroll 1
  for (int br = 0; br < 3; ++br) {
    {
      f32x4 ga[4][2]; zero_acc<2>(ga);
      RowPtr ap{(const bf16_t*)(p.ws + O_XG) + (size_t)tm * 128 * D_, (size_t)D_}, bp{wl + W_G + ((size_t)br * 1024 + tn * 64) * D_, (size_t)D_};
      gemm_main<2, true>(ga, ap, 64, bp, 64, 16, smem);
#pragma unroll
      for (int i = 0; i < 4; ++i) {
        const float rs = rstd_from16((const float*)(p.ws + O_SSQ) + (size_t)(tm * 128 + wm * 64 + i * 16 + l15) * 16, 1.f / 1024.f);
#pragma unroll
        for (int j = 0; j < 2; ++j) {
          gsp[((i * 2 + j) * 2 + 0) * 256] = pk2(sigmoidf_(ga[i][j][0] * rs), sigmoidf_(ga[i][j][1] * rs));
          gsp[((i * 2 + j) * 2 + 1) * 256] = pk2(sigmoidf_(ga[i][j][2] * rs), sigmoidf_(ga[i][j][3] * rs));
        }
      }
    }
    f32x4 ba[4][2]; zero_acc<2>(ba);
    RowPtr bp2{wl + (br == 0 ? W_BN : br == 1 ? W_BF : W_BM) + (size_t)tn * 64 * 512, (size_t)512};
    const bf16_t* abase = (const bf16_t*)(p.ws + (br == 0 ? O_ONSA : br == 1 ? O_FOXQ : O_MLAQ));
    const int ald = br == 2 ? 768 : 512;
    RowPtr ap2{abase + (size_t)tm * 128 * ald, (size_t)ald};
    gemm_main<2, true>(ba, ap2, br == 2 ? 96 : 64, bp2, 64, 8, smem);
#pragma unroll
    for (int i = 0; i < 4; ++i)
#pragma unroll
      for (int j = 0; j < 2; ++j) {
        const unsigned w0 = gsp[((i * 2 + j) * 2 + 0) * 256], w1 = gsp[((i * 2 + j) * 2 + 1) * 256];
        mg[i][j][0] += bf2f((bf16_t)(w0 & 0xffffu)) * ba[i][j][0];
        mg[i][j][1] += bf2f((bf16_t)(w0 >> 16)) * ba[i][j][1];
        mg[i][j][2] += bf2f((bf16_t)(w1 & 0xffffu)) * ba[i][j][2];
        mg[i][j][3] += bf2f((bf16_t)(w1 >> 16)) * ba[i][j][3];
      }
  }
#pragma unroll
  for (int i = 0; i < 4; ++i) {
    bf16_t* dst = (bf16_t*)(p.ws + O_MERGED) + (size_t)(tm * 128 + wm * 64 + i * 16 + l15) * D_ + tn * 64 + wn * 32 + quad * 4;
#pragma unroll
    for (int j = 0; j < 2; ++j) *(u32x2*)(dst + j * 16) = (u32x2){pk2(mg[i][j][0], mg[i][j][1]), pk2(mg[i][j][2], mg[i][j][3])};
  }
}
DI void phase_e(const Params& p, int layer, unsigned char* smem) {
  xcd_tiles(32, 16, [&](int tm, int tn) { merge_tile(p, layer, tm, tn, (bf16_t*)smem); });
}

DI void resid_tile(const Params& p, const bf16_t* A, int K, const bf16_t* W, const float* xold, const float* gnext, int tm, int tn, bf16_t* smem) {
  f32x4 acc[4][4]; zero_acc<4>(acc);
  RowPtr ap{A + (size_t)tm * 128 * K, (size_t)K}, bp{W + (size_t)tn * 128 * K, (size_t)K};
  gemm_main<4, true>(acc, ap, 64, bp, 64, K / 64, smem);
  const int lane = TIDX() & 63, wid = TIDX() >> 6, wm = wid >> 1, wn = wid & 1, l15 = lane & 15, quad = lane >> 4;
#pragma unroll
  for (int i = 0; i < 4; ++i) {
    const int t = tm * 128 + wm * 64 + i * 16 + l15, c0 = tn * 128 + wn * 64 + quad * 4; float s = 0.f;
#pragma unroll
    for (int j = 0; j < 4; ++j) {
      const size_t off = (size_t)t * D_ + c0 + j * 16;
      const f32x4 xn = *(const f32x4*)(xold + off) + acc[i][j];
      *(f32x4*)(p.out + off) = xn;
      s += xn[0] * xn[0] + xn[1] * xn[1] + xn[2] * xn[2] + xn[3] * xn[3];
      if (gnext) { const f32x4 gv = *(const f32x4*)(gnext + c0 + j * 16); *(u32x2*)((bf16_t*)(p.ws + O_XG) + off) = (u32x2){pk2(xn[0] * gv[0], xn[1] * gv[1]), pk2(xn[2] * gv[2], xn[3] * gv[3])}; }
    }
    s += __shfl_xor(s, 16); s += __shfl_xor(s, 32);
    if (quad == 0) ((float*)(p.ws + O_SSQ))[(size_t)t * 16 + tn * 2 + wn] = s;
  }
}
constexpr int PF_ITEMS = 256 * 8;
DI void phase_f(const Params& p, int layer, unsigned char* smem) {
  const bf16_t* wl = (const bf16_t*)(p.ws + O_W) + (size_t)layer * W_LAYER;
  xcd_tiles(32, 8, [&](int tm, int tn) { resid_tile(p, (const bf16_t*)(p.ws + O_MERGED), 1024, wl + W_OUT, layer == 0 ? p.x : p.out, p.ffn_norm + layer * D_, tm, tn, (bf16_t*)smem); });
}
DI void phase_h(const Params& p, int layer, unsigned char* smem) {
  const bf16_t* wl = (const bf16_t*)(p.ws + O_W) + (size_t)layer * W_LAYER;
  xcd_tiles(32, 8, [&](int tm, int tn) { resid_tile(p, (const bf16_t*)(p.ws + O_ACT), DFF_, wl + W_DN, p.out, layer == 0 ? p.mix_norm + D_ : nullptr, tm, tn, (bf16_t*)smem); });
}

struct UpRowPtr { const bf16_t* base; int s0;
  DI unsigned operator()(int r) const { const int s = s0 + r; return (unsigned)((s < 0 || s >= S_) ? 0 : s) * (unsigned)D_; }
  DI bool ok(int r) const { const int s = s0 + r; return s >= 0 && s < S_; } };
constexpr int PG_MT = 33, PG_ITEMS = NB_ * PG_MT * 44;
DI void ffnup_tile(const Params& p, int layer, int b, int mt, int tn, bf16_t* smem) {
  const bf16_t* wl = (const bf16_t*)(p.ws + O_W) + (size_t)layer * W_LAYER;
  f32x4 acc[4][4]; zero_acc<4>(acc);
  const int s0 = 126 * mt - 2;
  UpRowPtr ap{(const bf16_t*)(p.ws + O_XG) + (size_t)b * S_ * D_, s0}; RowPtr bp{wl + W_UP + (size_t)tn * 128 * D_, (size_t)D_};
  gemm_main<4, true>(acc, ap, 64, bp, 64, 16, smem);
  const int tid = TIDX(), lane = tid & 63, wid = tid >> 6, wm = wid >> 1, wn = wid & 1, l15 = lane & 15, quad = lane >> 4;
  constexpr int LDU = 68; float* U = (float*)smem; float* V = U + 128 * LDU;
#pragma unroll
  for (int i = 0; i < 4; ++i) {
    const int row = wm * 64 + i * 16 + l15, s = s0 + row;
    const float rs = (s >= 0 && s < S_) ? rstd_from16((const float*)(p.ws + O_SSQ) + ((size_t)b * S_ + s) * 16, 1.f / 1024.f) : 0.f;
    float* dst = (wn ? V : U) + row * LDU + quad * 4;
#pragma unroll
    for (int j = 0; j < 4; ++j) *(f32x4*)(dst + j * 16) = acc[i][j] * rs;
  }
  __syncthreads();
  const int c4 = (tid & 15) * 4, cg0 = tn * 64 + c4;
  const float* cw = p.conv_w + (size_t)layer * 3 * DFF_ + cg0; const f32x4 w0 = *(const f32x4*)cw, w1 = *(const f32x4*)(cw + DFF_), w2 = *(const f32x4*)(cw + 2 * DFF_);
  const f32x4 cb = *(const f32x4*)(p.conv_b + (size_t)layer * DFF_ + cg0);
  bf16_t* act = (bf16_t*)(p.ws + O_ACT);
#pragma unroll 2
  for (int itr = 0; itr < 8; ++itr) {
    const int i = (tid >> 4) + 16 * itr, s = s0 + i;
    if (i >= 2 && s < S_) {
      const f32x4 u0 = *(const f32x4*)(U + (i - 2) * LDU + c4), u1 = *(const f32x4*)(U + (i - 1) * LDU + c4), u2 = *(const f32x4*)(U + i * LDU + c4), vv = *(const f32x4*)(V + i * LDU + c4);
      float o[4];
#pragma unroll
      for (int r = 0; r < 4; ++r) { const float uc = w0[r] * u0[r] + w1[r] * u1[r] + w2[r] * u2[r] + cb[r]; o[r] = uc * sigmoidf_(uc) * vv[r]; }
      *(u32x2*)(act + ((size_t)b * S_ + s) * DFF_ + cg0) = (u32x2){pk2(o[0], o[1]), pk2(o[2], o[3])};
    }
  }
  __syncthreads();
}
DI void phase_g(const Params& p, int layer, unsigned char* smem) {
  xcd_tiles(PG_MT, 44, [&](int tmg, int tn) { ffnup_tile(p, layer, tmg / PG_MT, tmg % PG_MT, tn, (bf16_t*)smem); });
}

DI void phase_final(const Params& p) {
  const int lane = TIDX() & 63, wid = TIDX() >> 6;
  for (int it = blockIdx.x; it < T_ / 4; it += gridDim.x) {
    const int t = it * 4 + wid; const float rs = rstd_from16((const float*)(p.ws + O_SSQ) + (size_t)t * 16, 1.f / 1024.f);
    float* xr = p.out + (size_t)t * D_;
#pragma unroll
    for (int c = 0; c < 4; ++c) { const int k = c * 256 + lane * 4; const f32x4 v = *(const f32x4*)(xr + k), gv = *(const f32x4*)(p.final_norm + k); *(f32x4*)(xr + k) = v * rs * gv; }
  }
}


#define XB_TMO      128
#define XB_XCNT(j)  (256  + 64 * (j))
#define XB_XSUB(j)  (1280 + 64 * (j))
#define XB_XGEN(j)  (2304 + 64 * (j))
#define XB_TOP      3328
#define XB_TOPGEN   3392
#define XCD_BAR_WORDS 3456
#define XB_SPIN_CAP (1u << 22)
#define LAS __attribute__((address_space(3)))
DI unsigned xb_ld(unsigned* p)              { return __hip_atomic_load(p, __ATOMIC_RELAXED, __HIP_MEMORY_SCOPE_AGENT); }
DI unsigned xb_add(unsigned* p, unsigned v) { return __hip_atomic_fetch_add(p, v, __ATOMIC_RELAXED, __HIP_MEMORY_SCOPE_AGENT); }
DI unsigned xb_xcc_id() { return (unsigned)__builtin_amdgcn_s_getreg((3 << 11) | 20) & 0xFu; }
#define XB_SPIN(cond, bar) do { unsigned _sp = 0; while (cond) { __builtin_amdgcn_s_sleep(1); \
    if ((++_sp & 255u) == 0u) { if (xb_ld(&(bar)[XB_TMO])) break; if (_sp > XB_SPIN_CAP) { atomicAdd(&(bar)[XB_TMO], 1u); break; } } } } while (0)
struct XcdBarrier { unsigned* bar; unsigned x; volatile LAS unsigned* st; };
DI XcdBarrier xcd_barrier_post(unsigned* bar, volatile LAS unsigned* st) {
  XcdBarrier b; b.bar = bar; b.x = xb_xcc_id(); b.st = st;
  if (threadIdx.x == 0) (void)xb_add(&bar[XB_XCNT(b.x)], 1u);
  return b;
}
DI void xcd_barrier_complete(unsigned* bar, unsigned x, unsigned& nloc, unsigned& nx) {
  const unsigned G = gridDim.x * gridDim.y * gridDim.z;
  unsigned sum, cnt, mine, sp = 0u;
  for (;;) {
    sum = 0u; cnt = 0u; mine = 0u;
#pragma unroll
    for (unsigned j = 0; j < 16; ++j) { const unsigned c = xb_ld(&bar[XB_XCNT(j)]); sum += c; cnt += (c > 0u) ? 1u : 0u; mine = (j == x) ? c : mine; }
    if (sum == G) break;
    __builtin_amdgcn_s_sleep(1);
    if ((++sp & 255u) == 0u) { if (xb_ld(&bar[XB_TMO])) break; if (sp > XB_SPIN_CAP) { atomicAdd(&bar[XB_TMO], 1u); break; } }
  }
  nloc = mine > 0u ? mine : 1u; nx = cnt > 0u ? cnt : 1u;
}
DI void xcd_barrier(const XcdBarrier& b) {
  asm volatile("s_waitcnt vmcnt(0)" ::: "memory");
  __syncthreads();
  if (threadIdx.x == 0) {
    unsigned* bar = b.bar;
    __builtin_amdgcn_s_waitcnt(0);
    unsigned nloc = b.st[0], nx = b.st[1];
    if (nloc == 0u) { xcd_barrier_complete(bar, b.x, nloc, nx); b.st[0] = nloc; b.st[1] = nx; }
    const unsigned old = xb_add(&bar[XB_XSUB(b.x)], 1u);
    const unsigned gen = old / nloc;
    if (old + 1u == (gen + 1u) * nloc) {
      __builtin_amdgcn_fence(__ATOMIC_RELEASE, "agent");
      asm volatile("s_waitcnt vmcnt(0)" ::: "memory");
      const unsigned og = xb_add(&bar[XB_TOP], 1u);
      const unsigned tg = og / nx;
      if (og + 1u == (tg + 1u) * nx) xb_add(&bar[XB_TOPGEN], 1u);
      else XB_SPIN(xb_ld(&bar[XB_TOPGEN]) == tg, bar);
      __builtin_amdgcn_fence(__ATOMIC_ACQUIRE, "agent");
      xb_add(&bar[XB_XGEN(b.x)], 1u);
      asm volatile("s_waitcnt vmcnt(0)" ::: "memory");
    } else {
      XB_SPIN(xb_ld(&bar[XB_XGEN(b.x)]) == gen, bar);
      __builtin_amdgcn_fence(__ATOMIC_ACQUIRE, "agent");
      asm volatile("s_waitcnt vmcnt(0)" ::: "memory");
    }
  }
  __syncthreads();
}
DI void run_phase(const Params& p, int ph, unsigned char* smem) {
  if (ph == 0) { phase_prep(p, smem); return; }
  if (ph == 17) { phase_final(p); return; }
  const int layer = (ph - 1) >> 3, s = (ph - 1) & 7;
#ifdef PROBE_DUP
  if ((PROBE_DUP >> s) & 1) {
    switch (s) { case 0: phase_inproj(p, layer, smem); break; case 1: phase_b(p, layer, smem); break; case 2: phase_c(p, smem); break; case 4: phase_e(p, layer, smem); break; case 6: phase_g(p, layer, smem); break; default: break; }
    __syncthreads();
  }
#endif
  switch (s) {
    case 0: phase_inproj(p, layer, smem); break;
    case 1: phase_b(p, layer, smem); break;
    case 2: phase_c(p, smem); break;
    case 3: phase_d(p, smem); break;
    case 4: phase_e(p, layer, smem); break;
    case 5: phase_f(p, layer, smem); break;
    case 6: phase_g(p, layer, smem); break;
    default: phase_h(p, layer, smem); break;
  }
}
constexpr int N_PHASES = 18;

#if ONE_LAUNCH
template <int PH> DI void run_all(const Params& p, unsigned char* smem, cg::grid_group& grid, const XcdBarrier& xb) {
  run_phase(p, PH, smem);
  if constexpr (PH + 1 < N_PHASES) {
    if constexpr (PH == 0) grid.sync(); else xcd_barrier(xb);
    run_all<PH + 1>(p, smem, grid, xb);
  }
}
__global__ void __launch_bounds__(256, 2) mega_kernel(Params p) {
  __shared__ __attribute__((aligned(16))) unsigned char smem[SMEM_BYTES];
  __shared__ uint4 xb_words;
  if (threadIdx.x == 0) xb_words = make_uint4(0u, 0u, 0u, 0u);
  __syncthreads();
  const XcdBarrier xb = xcd_barrier_post((unsigned*)(p.ws + O_BAR), (volatile LAS unsigned*)&xb_words);
  cg::grid_group grid = cg::this_grid();
  run_all<0>(p, smem, grid, xb);
}
#else
template <int PH> __global__ void __launch_bounds__(256, 2) phase_kernel(Params p) {
  __shared__ __attribute__((aligned(16))) unsigned char smem[SMEM_BYTES];
  run_phase(p, PH, smem);
}
template <int PH> static void launch_phases(const Params& p, hipStream_t stream) {
  hipLaunchKernelGGL((phase_kernel<PH>), dim3(1024), dim3(256), 0, stream, p);
  if constexpr (PH + 1 < N_PHASES) launch_phases<PH + 1>(p, stream);
}
#endif

extern "C" void kernel_launch(void* const* d_in, const int* in_sizes, int n_in, void* d_out, int out_size, void* d_ws, size_t ws_size, hipStream_t stream) {
  if (ws_size < O_END || n_in < 25) { fprintf(stderr, "workspace too small: %zu < %zu\n", ws_size, (size_t)O_END); return; }
  Params p{};
  p.x = (const float*)d_in[0]; p.pos = (const int*)d_in[1]; p.mix_norm = (const float*)d_in[2]; p.w_in = (const float*)d_in[3]; p.b_forget = (const float*)d_in[4];
  p.pe_k = (const float*)d_in[5]; p.w1_k = (const float*)d_in[6]; p.w2_k = (const float*)d_in[7]; p.pe_v = (const float*)d_in[8]; p.w1_v = (const float*)d_in[9]; p.w2_v = (const float*)d_in[10];
  p.q_norm = (const float*)d_in[11]; p.w_uq = (const float*)d_in[12]; p.kv_norm = (const float*)d_in[13]; p.w_ukv = (const float*)d_in[14];
  p.wbr_nsa = (const float*)d_in[15]; p.wbr_fox = (const float*)d_in[16]; p.wbr_mla = (const float*)d_in[17]; p.w_out = (const float*)d_in[18];
  p.ffn_norm = (const float*)d_in[19]; p.w_up = (const float*)d_in[20]; p.conv_w = (const float*)d_in[21]; p.conv_b = (const float*)d_in[22]; p.w_down = (const float*)d_in[23]; p.final_norm = (const float*)d_in[24];
  p.out = (float*)d_out; p.ws = (unsigned char*)d_ws;
#if ONE_LAUNCH
  static int grid_blocks = 0;
  if (!grid_blocks) {
    int dev = 0, cus = 0, per_cu = 0;
    hipGetDevice(&dev); hipDeviceGetAttribute(&cus, hipDeviceAttributeMultiprocessorCount, dev);
    hipOccupancyMaxActiveBlocksPerMultiprocessor(&per_cu, mega_kernel, 256, 0);
    if (per_cu > 2) per_cu = 2;
    grid_blocks = cus * per_cu;
  }
  hipMemsetAsync(p.ws + O_BAR, 0, XCD_BAR_WORDS * 4, stream);
  void* args[] = {&p};
  hipError_t e = hipLaunchCooperativeKernel((void*)mega_kernel, dim3(grid_blocks), dim3(256), args, 0, stream);
  if (e != hipSuccess) fprintf(stderr, "cooperative launch failed: %s (grid %d)\n", hipGetErrorString(e), grid_blocks);
#else
  launch_phases<0>(p, stream);
#endif
}
```

```cpp
#include <hip/hip_runtime.h>
#include <hip/hip_cooperative_groups.h>
#include <stdint.h>
#include <stdio.h>
#include <type_traits>
namespace cg = cooperative_groups;

#ifndef ONE_LAUNCH
#define ONE_LAUNCH 1

#endif

#define DI __device__ __forceinline__
typedef unsigned short bf16_t;
typedef short bf16x8 __attribute__((ext_vector_type(8)));
typedef float f32x4 __attribute__((ext_vector_type(4)));
typedef float f32x16 __attribute__((ext_vector_type(16)));
typedef float f32x2 __attribute__((ext_vector_type(2)));
typedef __bf16 bfx2 __attribute__((ext_vector_type(2)));
typedef unsigned u32x4 __attribute__((ext_vector_type(4)));
typedef unsigned u32x2 __attribute__((ext_vector_type(2)));
typedef unsigned long long u64;

constexpr int T_ = 32768, S_ = 4096, NB_ = 8, D_ = 1024, DFF_ = 2816, NIN_ = 6592;
constexpr float EPS_ = 1e-6f;
constexpr float LOG2E_ = 1.4426950408889634f;
constexpr float QS64_ = 0.125f * LOG2E_;
constexpr float QS96_ = 0.10206207261596577f * LOG2E_;

constexpr size_t W_IN = 0;
constexpr size_t W_G = W_IN + (size_t)3584 * 1024;
constexpr size_t W_1K = W_G + (size_t)3072 * 1024;
constexpr size_t W_1V = W_1K + (size_t)256 * 2048;
constexpr size_t W_2K = W_1V + (size_t)256 * 2048;
constexpr size_t W_2V = W_2K + (size_t)64 * 256;
constexpr size_t W_UQ = W_2V + (size_t)64 * 256;
constexpr size_t W_UKV = W_UQ + (size_t)768 * 384;
constexpr size_t W_BN = W_UKV + (size_t)1024 * 256;
constexpr size_t W_BF = W_BN + (size_t)1024 * 512;
constexpr size_t W_BM = W_BF + (size_t)1024 * 512;
constexpr size_t W_OUT = W_BM + (size_t)1024 * 512;
constexpr size_t W_UP = W_OUT + (size_t)1024 * 1024;
constexpr size_t W_DN = W_UP + (size_t)5632 * 1024;
constexpr size_t W_LAYER = W_DN + (size_t)1024 * 2816;

constexpr size_t al256(size_t x) { return (x + 255) & ~(size_t)255; }
constexpr size_t O_BAR = 0;
constexpr size_t O_W = 16384;
constexpr size_t O_BIAS1 = al256(O_W + 2 * W_LAYER * 2);
constexpr size_t O_ROPE8 = al256(O_BIAS1 + 2 * 2 * 256 * 4);
constexpr size_t O_ROPE16 = al256(O_ROPE8 + (size_t)T_ * 16 * 4);
constexpr size_t O_XG = al256(O_ROPE16 + (size_t)T_ * 32 * 4);
constexpr size_t O_SSQ = al256(O_XG + (size_t)T_ * 1024 * 2);
constexpr size_t O_CSSQ = al256(O_SSQ + (size_t)T_ * 16 * 4);
constexpr size_t O_NSAQ = al256(O_CSSQ + (size_t)T_ * 16 * 4);
constexpr size_t O_KVCMP = O_NSAQ + (size_t)T_ * 512 * 2;
constexpr size_t O_KSLC = O_KVCMP + (size_t)T_ * 256 * 2;
constexpr size_t O_KWIN = O_KSLC + (size_t)T_ * 128 * 2;
constexpr size_t O_MERGED = O_NSAQ;
constexpr size_t O_VSLCT = O_KWIN + (size_t)T_ * 128 * 2;
constexpr size_t O_VWINT = O_VSLCT + (size_t)T_ * 128 * 2;
constexpr size_t O_FOXQ = O_VWINT + (size_t)T_ * 128 * 2;
constexpr size_t O_FOXK = O_FOXQ + (size_t)T_ * 512 * 2;
constexpr size_t O_FOXVT = O_FOXK + (size_t)T_ * 512 * 2;
constexpr size_t O_MLAQ = O_FOXVT + (size_t)T_ * 512 * 2;
constexpr size_t O_MLAKN = O_MLAQ + (size_t)T_ * 768 * 2;
constexpr size_t O_ACT = O_FOXQ;
constexpr size_t O_MLAVT = O_MLAKN + (size_t)T_ * 512 * 2;
constexpr size_t O_MLAKPE = O_MLAVT + (size_t)T_ * 512 * 2;
constexpr size_t O_ONSA = O_MLAKPE + (size_t)T_ * 32 * 2;
constexpr size_t O_CQ = O_ONSA;
constexpr size_t O_CKV = O_CQ + (size_t)T_ * 384 * 2;
constexpr size_t O_CEND = O_CKV + (size_t)T_ * 256 * 2;
constexpr size_t O_GATES = al256(O_CEND > O_ONSA + (size_t)T_ * 512 * 2 ? O_CEND : O_ONSA + (size_t)T_ * 512 * 2);
constexpr size_t O_LOGF = al256(O_GATES + (size_t)T_ * 24 * 4);
constexpr size_t O_F2 = al256(O_LOGF + (size_t)T_ * 8 * 4);
constexpr size_t O_KC = al256(O_F2 + (size_t)T_ * 8 * 4);
constexpr size_t O_VCT = al256(O_KC + (size_t)NB_ * 2 * 256 * 64 * 2);
constexpr size_t O_SEL = al256(O_VCT + (size_t)NB_ * 2 * 256 * 64 * 2);
constexpr size_t O_END = al256(O_SEL + (size_t)NB_ * 2 * S_ * 8);

struct Params {
  const float* x; const int* pos; const float* mix_norm; const float* w_in; const float* b_forget;
  const float* pe_k; const float* w1_k; const float* w2_k; const float* pe_v; const float* w1_v; const float* w2_v;
  const float* q_norm; const float* w_uq; const float* kv_norm; const float* w_ukv;
  const float* wbr_nsa; const float* wbr_fox; const float* wbr_mla; const float* w_out;
  const float* ffn_norm; const float* w_up; const float* conv_w; const float* conv_b; const float* w_down; const float* final_norm;
  float* out; unsigned char* ws;
};

constexpr int NTHR = 512;
constexpr int SMEM_BYTES = 147456;

DI int TIDX() { int t = (int)threadIdx.x; asm volatile("" : "+v"(t)); return t; }
DI unsigned pk2(float lo, float hi) { f32x2 v = {lo, hi}; return __builtin_bit_cast(unsigned, __builtin_convertvector(v, bfx2)); }
DI bf16_t f2bf(float x) { return (bf16_t)(pk2(x, 0.f) & 0xffffu); }
DI float bf2f(bf16_t h) { return __uint_as_float(((unsigned)h) << 16); }
DI float sigmoidf_(float x) { return 1.f / (1.f + __expf(-x)); }
DI float gelu_tanh(float x) { const float u = 0.7978845608028654f * (x + 0.044715f * x * x * x); return x / (1.f + __expf(-2.f * u)); }
DI float ex2(float x) { return __builtin_amdgcn_exp2f(x); }
DI f32x16 mfma32(bf16x8 a, bf16x8 b, f32x16 c) { return __builtin_amdgcn_mfma_f32_32x32x16_bf16(a, b, c, 0, 0, 0); }
DI f32x4 mfma16(bf16x8 a, bf16x8 b, f32x4 c) { return __builtin_amdgcn_mfma_f32_16x16x32_bf16(a, b, c, 0, 0, 0); }
DI float rstd_from16(const float* p, float inv_n) {
  const f32x4 a = *(const f32x4*)p, b = *(const f32x4*)(p + 4), c = *(const f32x4*)(p + 8), d = *(const f32x4*)(p + 12);
  const float s = ((a[0] + a[1]) + (a[2] + a[3])) + ((b[0] + b[1]) + (b[2] + b[3])) + ((c[0] + c[1]) + (c[2] + c[3])) + ((d[0] + d[1]) + (d[2] + d[3]));
  return rsqrtf(s * inv_n + EPS_);
}

constexpr int LDT = 72;
template <int MI, int NJ> struct GemmLds { static constexpr int BM = 32 * MI, BN = 64 * NJ, A_ELEMS = BM * LDT, B_ELEMS = BN * LDT, STAGE = A_ELEMS + B_ELEMS; };

template <int MI, int NJ, bool SWAP, class AP, class BP>
DI void gemm_main(f32x4 (&acc)[MI][NJ], const AP& ap, int a_kstep, const BP& bp, int b_kstep, int nk, bf16_t* smem) {
  typedef GemmLds<MI, NJ> L;
  constexpr int CA = MI / 2, CB = NJ;
  const int tid = TIDX(), lane = tid & 63, wid = tid >> 6, wm = wid >> 2, wn = wid & 3, l15 = lane & 15, quad = lane >> 4;
  unsigned pa[CA], pb[CB]; bool oka[CA];
#pragma unroll
  for (int i = 0; i < CA; ++i) { const int c = tid + NTHR * i; pa[i] = ap(c >> 3) + (c & 7) * 8; oka[i] = ap.ok(c >> 3); }
#pragma unroll
  for (int i = 0; i < CB; ++i) { const int c = tid + NTHR * i; pb[i] = bp(c >> 3) + (c & 7) * 8; }
  u32x4 ra[CA], rb[CB];
  auto gload = [&](int kt) {
    const bf16_t* ab = ap.base + (size_t)kt * a_kstep; const bf16_t* bb = bp.base + (size_t)kt * b_kstep;
#pragma unroll
    for (int i = 0; i < CA; ++i) ra[i] = *(const u32x4*)(ab + pa[i]);
#pragma unroll
    for (int i = 0; i < CB; ++i) rb[i] = *(const u32x4*)(bb + pb[i]);
  };
  auto sstore = [&](int buf) {
    bf16_t* As = smem + buf * L::STAGE; bf16_t* Bs = As + L::A_ELEMS;
#pragma unroll
    for (int i = 0; i < CA; ++i) { const int c = tid + NTHR * i; *(u32x4*)(As + (c >> 3) * LDT + (c & 7) * 8) = oka[i] ? ra[i] : (u32x4){0u, 0u, 0u, 0u}; }
#pragma unroll
    for (int i = 0; i < CB; ++i) { const int c = tid + NTHR * i; *(u32x4*)(Bs + (c >> 3) * LDT + (c & 7) * 8) = rb[i]; }
  };
  gload(0); sstore(0); __syncthreads();
#pragma unroll 1
  for (int kt = 0; kt < nk; ++kt) {
    const int buf = kt & 1;
    gload(kt + 1 < nk ? kt + 1 : nk - 1);
    __builtin_amdgcn_sched_barrier(0);
    const bf16_t* As = smem + buf * L::STAGE + (wm * 16 * MI + l15) * LDT + quad * 8;
    const bf16_t* Bs = smem + buf * L::STAGE + L::A_ELEMS + (wn * 16 * NJ + l15) * LDT + quad * 8;
#pragma unroll
    for (int ks = 0; ks < 2; ++ks) {
      if (MI * NJ >= 32 && ks == 1) asm volatile("" ::: "memory");
      bf16x8 b[NJ];
#pragma unroll
      for (int j = 0; j < NJ; ++j) b[j] = *(const bf16x8*)(Bs + j * 16 * LDT + ks * 32);
#pragma unroll
      for (int i = 0; i < MI; ++i) {
        const bf16x8 a = *(const bf16x8*)(As + i * 16 * LDT + ks * 32);
#pragma unroll
        for (int j = 0; j < NJ; ++j) acc[i][j] = SWAP ? mfma16(b[j], a, acc[i][j]) : mfma16(a, b[j], acc[i][j]);
      }
    }
    sstore(buf ^ 1);
    __syncthreads();
  }
}
template <int MI, int NJ> DI void zero_acc(f32x4 (&acc)[MI][NJ]) {
#pragma unroll
  for (int i = 0; i < MI; ++i)
#pragma unroll
    for (int j = 0; j < NJ; ++j) acc[i][j] = (f32x4){0.f, 0.f, 0.f, 0.f};
}
struct RowPtr { const bf16_t* base; size_t ld; DI unsigned operator()(int r) const { return (unsigned)r * (unsigned)ld; } DI bool ok(int) const { return true; } };


template <class F> DI void xcd_tiles(int MPX, int NT, F&& body) {
  const int xcd = blockIdx.x & 7, slot = blockIdx.x >> 3, nslots = gridDim.x >> 3, total = MPX * NT;
  for (int li = slot; li < total; li += nslots) {
    const int mg = li / (8 * NT), rem = li - mg * 8 * NT;
    const int gsz = (MPX - mg * 8) < 8 ? (MPX - mg * 8) : 8;
    const int tn = rem / gsz, mi = rem - tn * gsz;
    body(xcd * MPX + mg * 8 + mi, tn);
  }
}

DI int map_col(int map, int n) {
  if (map == 0) return n;
  if (map == 1) {
    if (n < 896) return n;
    if (n < 1024) return 1024 + (n - 896);
    if (n < 1152) return 896 + (n - 1024);
    if (n < 1280) return n;
    if (n < 2816) return 1304 + (n - 1280);
    if (n < 3200) return 2848 + (n - 2816);
    if (n < 3456) return 3232 + (n - 3200);
    const int c = n - 3456;
    if (c < 24) return 1280 + c;
    if (c < 32) return 2840 + (c - 24);
    if (c < 64) return 3488 + (c - 32);
    return -1;
  }
  if (map == 2) { const int j = n >> 8, c = n & 255; return c < 128 ? j * 128 + c : DFF_ + j * 128 + (c - 128); }
  if (map == 3) { return n < 512 ? (n >> 6) * 128 + (n & 63) : ((n - 512) >> 6) * 128 + 64 + ((n - 512) & 63); }
  return n;
}
struct WJob { const float* src; const float* scale; bf16_t* dst; int K, N, ld, map, off; };
DI void prep_weight_tile(const WJob& j, int tile, float* lds) {
  const int ntn = j.N >> 6, tk = tile / ntn, tn = tile % ntn, tid = TIDX();
  const int n = tn * 64 + (tid & 63); const int sc = map_col(j.map, n);
#pragma unroll 4
  for (int i = 0; i < 8; ++i) {
    const int kk = (tid >> 6) + 8 * i, k = tk * 64 + kk;
    float v = sc >= 0 ? j.src[(size_t)k * j.ld + j.off + sc] : 0.f;
    if (j.scale) v *= j.scale[k];
    lds[kk * 65 + (tid & 63)] = v;
  }
  __syncthreads();
  const int nn = tid >> 3, k0 = (tid & 7) * 8;
  unsigned w[4];
#pragma unroll
  for (int e = 0; e < 4; ++e) w[e] = pk2(lds[(k0 + 2 * e) * 65 + nn], lds[(k0 + 2 * e + 1) * 65 + nn]);
  bf16_t* d = j.dst + (size_t)(tn * 64 + nn) * j.K + tk * 64 + k0;
  *(u32x4*)d = (u32x4){w[0], w[1], w[2], w[3]};
  __syncthreads();
}
DI WJob get_wjob(const Params& p, int layer, int id) {
  bf16_t* wl = (bf16_t*)(p.ws + O_W) + (size_t)layer * W_LAYER; WJob j; j.scale = nullptr; j.map = 0; j.off = 0;
  switch (id) {
    case 0: j.src = p.w_in + (size_t)layer * 1024 * NIN_; j.dst = wl + W_IN; j.K = 1024; j.N = 3584; j.ld = NIN_; j.map = 1; break;
    case 1: j.src = p.w_in + (size_t)layer * 1024 * NIN_; j.dst = wl + W_G; j.K = 1024; j.N = 3072; j.ld = NIN_; j.off = 3520; break;
    case 2: j.src = p.w1_k + (size_t)layer * 2048 * 256; j.dst = wl + W_1K; j.K = 2048; j.N = 256; j.ld = 256; break;
    case 3: j.src = p.w1_v + (size_t)layer * 2048 * 256; j.dst = wl + W_1V; j.K = 2048; j.N = 256; j.ld = 256; break;
    case 4: j.src = p.w2_k + (size_t)layer * 256 * 64; j.dst = wl + W_2K; j.K = 256; j.N = 64; j.ld = 64; break;
    case 5: j.src = p.w2_v + (size_t)layer * 256 * 64; j.dst = wl + W_2V; j.K = 256; j.N = 64; j.ld = 64; break;
    case 6: j.src = p.w_uq + (size_t)layer * 384 * 768; j.dst = wl + W_UQ; j.K = 384; j.N = 768; j.ld = 768; j.scale = p.q_norm + layer * 384; break;
    case 7: j.src = p.w_ukv + (size_t)layer * 256 * 1024; j.dst = wl + W_UKV; j.K = 256; j.N = 1024; j.ld = 1024; j.scale = p.kv_norm + layer * 256; j.map = 3; break;
    case 8: j.src = p.wbr_nsa + (size_t)layer * 512 * 1024; j.dst = wl + W_BN; j.K = 512; j.N = 1024; j.ld = 1024; break;
    case 9: j.src = p.wbr_fox + (size_t)layer * 512 * 1024; j.dst = wl + W_BF; j.K = 512; j.N = 1024; j.ld = 1024; break;
    case 10: j.src = p.wbr_mla + (size_t)layer * 512 * 1024; j.dst = wl + W_BM; j.K = 512; j.N = 1024; j.ld = 1024; break;
    case 11: j.src = p.w_out + (size_t)layer * 1024 * 1024; j.dst = wl + W_OUT; j.K = 1024; j.N = 1024; j.ld = 1024; break;
    case 12: j.src = p.w_up + (size_t)layer * 1024 * 5632; j.dst = wl + W_UP; j.K = 1024; j.N = 5632; j.ld = 5632; j.map = 2; break;
    default: j.src = p.w_down + (size_t)layer * 2816 * 1024; j.dst = wl + W_DN; j.K = 2816; j.N = 1024; j.ld = 1024; break;
  }
  return j;
}
constexpr int WTILES_LAYER = (int)(W_LAYER / 4096);
constexpr int P0_XITEMS = T_ / 64;
constexpr int P0_ROPE_ITEMS = T_ / NTHR;
constexpr int P0_ITEMS = 2 * WTILES_LAYER + 4 + P0_ROPE_ITEMS + P0_XITEMS;

DI void xg_rows(const float* x, const float* g, bf16_t* xg, float* ssq, int row0) {
  const int lane = TIDX() & 63, wid = TIDX() >> 6;
  for (int rr = 0; rr < 8; ++rr) {
    const int t = row0 + wid * 8 + rr; const float* xr = x + (size_t)t * D_; float s = 0.f;
#pragma unroll
    for (int c = 0; c < 4; ++c) {
      const int k = c * 256 + lane * 4; const f32x4 v = *(const f32x4*)(xr + k), gv = *(const f32x4*)(g + k);
      s += v[0] * v[0] + v[1] * v[1] + v[2] * v[2] + v[3] * v[3];
      *(u32x2*)(xg + (size_t)t * D_ + k) = (u32x2){pk2(v[0] * gv[0], v[1] * gv[1]), pk2(v[2] * gv[2], v[3] * gv[3])};
    }
#pragma unroll
    for (int o = 32; o >= 1; o >>= 1) s += __shfl_xor(s, o);
    if (lane < 16) ssq[(size_t)t * 16 + lane] = lane == 0 ? s : 0.f;
  }
}
DI void phase_prep(const Params& p, unsigned char* smem) {
  for (int it = blockIdx.x; it < P0_ITEMS; it += gridDim.x) {
    int i = it;
    if (i < 2 * WTILES_LAYER) {
      const int layer = i / WTILES_LAYER; int t = i % WTILES_LAYER; int id = 0;
      for (;; ++id) { const WJob j = get_wjob(p, layer, id); const int nt = (j.K >> 6) * (j.N >> 6); if (t < nt) { prep_weight_tile(j, t, (float*)smem); break; } t -= nt; }
      continue;
    }
    i -= 2 * WTILES_LAYER;
    if (i < 4) {
      const int layer = i >> 1, kv = i & 1, c = TIDX();
      if (c < 256) {
        const float* pe = (kv ? p.pe_v : p.pe_k) + (size_t)layer * 2048; const float* w1 = (kv ? p.w1_v : p.w1_k) + (size_t)layer * 2048 * 256;
        float s = 0.f;
        for (int kk = 0; kk < 2048; ++kk) s += pe[kk] * w1[(size_t)kk * 256 + c];
        ((float*)(p.ws + O_BIAS1))[(layer * 2 + kv) * 256 + c] = s;
      }
      continue;
    }
    i -= 4;
    if (i < P0_ROPE_ITEMS) {
      const int t = i * NTHR + TIDX(); const float fp = (float)p.pos[t];
      float* r8 = (float*)(p.ws + O_ROPE8) + (size_t)t * 16; float* r16 = (float*)(p.ws + O_ROPE16) + (size_t)t * 32;
      for (int f = 0; f < 24; ++f) {
        const int half = f < 8 ? 8 : 16, idx = f < 8 ? f : f - 8;
        const float inv = exp2f(-(float)idx / (float)half * 18.931568569324174f);
        const float ang = fp * inv;
        const double rev = (double)ang * 0.15915494309189535; const float fr = (float)(rev - floor(rev));
        const float sn = __builtin_amdgcn_sinf(fr), cs = __builtin_amdgcn_cosf(fr);
        if (f < 8) { r8[2 * idx] = cs; r8[2 * idx + 1] = sn; } else { r16[2 * idx] = cs; r16[2 * idx + 1] = sn; }
      }
      continue;
    }
    i -= P0_ROPE_ITEMS;
    xg_rows(p.x, p.mix_norm, (bf16_t*)(p.ws + O_XG), (float*)(p.ws + O_SSQ), i * 64);
  }
}

DI void store4(bf16_t* dst, const f32x4& v, float s) { *(u32x2*)dst = (u32x2){pk2(v[0] * s, v[1] * s), pk2(v[2] * s, v[3] * s)}; }
constexpr int STG_LD = 72, STG_WAVE = 128 * 72;
DI void stage4(bf16_t* stg, int row, int col, const f32x4& v, float s) { *(u32x2*)(stg + row * STG_LD + col) = (u32x2){pk2(v[0] * s, v[1] * s), pk2(v[2] * s, v[3] * s)}; }
template <int ROWS, int COLS, int LD> DI void stage_out(const bf16_t* stg, bf16_t* dst, size_t ld, int lane) {
  asm volatile("s_waitcnt lgkmcnt(0)" ::: "memory");
  constexpr int CPR = COLS / 8, IT = ROWS * CPR / 64;
#pragma unroll
  for (int it = 0; it < IT; ++it) {
    const int idx = it * 64 + lane, r = idx / CPR, c = idx % CPR;
    __builtin_nontemporal_store(*(const u32x4*)(stg + r * LD + c * 8), (u32x4*)(dst + (size_t)r * ld + c * 8));
  }
}
template <bool SWAP> DI void inproj_tile(const Params& p, int layer, int tm, int tn, bf16_t* smem) {
  const bf16_t* wl = (const bf16_t*)(p.ws + O_W) + (size_t)layer * W_LAYER;
  f32x4 acc[8][4]; zero_acc<8, 4>(acc);
  RowPtr ap{(const bf16_t*)(p.ws + O_XG) + (size_t)tm * 256 * D_, (size_t)D_}, bp{wl + W_IN + (size_t)tn * 256 * D_, (size_t)D_};
  gemm_main<8, 4, SWAP>(acc, ap, 64, bp, 64, 16, smem);
  const int lane = TIDX() & 63, wid = TIDX() >> 6, wm = wid >> 2, wn = wid & 3, l15 = lane & 15, quad = lane >> 4;
  const float* ssq = (const float*)(p.ws + O_SSQ);
  bf16_t* stg = smem + wid * STG_WAVE;
  const int trow0 = tm * 256 + wm * 128;
  if constexpr (!SWAP) {
    bf16_t* dst; int hh, hd;
    if (tn == 4) { dst = (bf16_t*)(p.ws + (wn < 2 ? O_VSLCT : O_VWINT)); hh = 2; hd = wn & 1; } else { dst = (bf16_t*)(p.ws + O_FOXVT); hh = 8; hd = (tn - 9) * 4 + wn; }
    constexpr int VLD = 136;
#pragma unroll
    for (int i = 0; i < 8; ++i) {
      const int t0 = trow0 + i * 16 + quad * 4;
      float rs[4];
#pragma unroll
      for (int r = 0; r < 4; ++r) rs[r] = rstd_from16(ssq + (size_t)(t0 + r) * 16, 1.f / 1024.f);
#pragma unroll
      for (int j = 0; j < 4; ++j)
        *(u32x2*)(stg + (j * 16 + l15) * VLD + i * 16 + quad * 4) = (u32x2){pk2(acc[i][j][0] * rs[0], acc[i][j][1] * rs[1]), pk2(acc[i][j][2] * rs[2], acc[i][j][3] * rs[3])};
    }
    const int b = trow0 >> 12, s0 = trow0 & 4095;
    stage_out<64, 128, VLD>(stg, dst + ((size_t)(b * hh + hd) * 64) * S_ + s0, (size_t)S_, lane);
  } else {
    const int slab = tn * 4 + wn;
    if (slab == 54) {
#pragma unroll
      for (int i = 0; i < 8; ++i) {
        const int t = trow0 + i * 16 + l15; const float rs = rstd_from16(ssq + (size_t)t * 16, 1.f / 1024.f);
        float* gt = (float*)(p.ws + O_GATES) + (size_t)t * 24; float* lf = (float*)(p.ws + O_LOGF) + (size_t)t * 8;
#pragma unroll
        for (int r = 0; r < 4; ++r) gt[quad * 4 + r] = sigmoidf_(acc[i][0][r] * rs);
        if (quad < 2) {
#pragma unroll
          for (int r = 0; r < 4; ++r) gt[16 + quad * 4 + r] = sigmoidf_(acc[i][1][r] * rs);
        } else {
#pragma unroll
          for (int r = 0; r < 4; ++r) { const int h = (quad - 2) * 4 + r; const float xx = acc[i][1][r] * rs + p.b_forget[layer * 8 + h]; lf[h] = fminf(xx, 0.f) - log1pf(__expf(-fabsf(xx))); }
        }
        const float* rp = (const float*)(p.ws + O_ROPE16) + (size_t)t * 32 + quad * 8; float o1[4], o2[4];
#pragma unroll
        for (int r = 0; r < 4; ++r) { const float cs = rp[2 * r], sn = rp[2 * r + 1], x1 = acc[i][2][r] * rs, x2 = acc[i][3][r] * rs; o1[r] = x1 * cs - x2 * sn; o2[r] = x2 * cs + x1 * sn; }
        bf16_t* kp = (bf16_t*)(p.ws + O_MLAKPE) + (size_t)t * 32 + quad * 4;
        *(u32x2*)kp = (u32x2){pk2(o1[0], o1[1]), pk2(o1[2], o1[3])}; *(u32x2*)(kp + 16) = (u32x2){pk2(o2[0], o2[1]), pk2(o2[2], o2[3])};
      }
    } else if (slab != 55) {
      bf16_t* dbuf; int dld, dcol, kind = 0; float qs = 1.f; int cslot = 0;
      if (slab < 8) { dbuf = (bf16_t*)(p.ws + O_NSAQ); dld = 512; dcol = slab * 64; qs = QS64_; }
      else if (slab < 12) { dbuf = (bf16_t*)(p.ws + O_KVCMP); dld = 256; dcol = (slab - 8) * 64; }
      else if (slab < 16) { dbuf = (bf16_t*)(p.ws + (slab < 14 ? O_KSLC : O_KWIN)); dld = 128; dcol = (slab & 1) * 64; kind = 1; }
      else if (slab < 28) { dbuf = (bf16_t*)(p.ws + O_FOXQ); dld = 512; dcol = (slab - 20) * 64; qs = QS64_; }
      else if (slab < 36) { dbuf = (bf16_t*)(p.ws + O_FOXK); dld = 512; dcol = (slab - 28) * 64; }
      else if (slab < 50) { dbuf = (bf16_t*)(p.ws + O_CQ); dld = 384; dcol = (slab - 44) * 64; kind = 2; cslot = slab - 44; }
      else { dbuf = (bf16_t*)(p.ws + O_CKV); dld = 256; dcol = (slab - 50) * 64; kind = 2; cslot = 8 + slab - 50; }
#pragma unroll
      for (int i = 0; i < 8; ++i) {
        const int row = i * 16 + l15, t = trow0 + row; const float rs = rstd_from16(ssq + (size_t)t * 16, 1.f / 1024.f) * qs;
        if (kind == 1) {
          const float* rp = (const float*)(p.ws + O_ROPE8) + (size_t)t * 16 + (quad & 1) * 8;
          f32x4 v, o;
#pragma unroll
          for (int r = 0; r < 4; ++r) { v[r] = acc[i][0][r] * rs; o[r] = __shfl_xor(v[r], 32); }
#pragma unroll
          for (int r = 0; r < 4; ++r) { const float cs = rp[2 * r], sn = rp[2 * r + 1]; v[r] = quad < 2 ? v[r] * cs - o[r] * sn : v[r] * cs + o[r] * sn; }
          stage4(stg, row, quad * 4, v, 1.f);
        } else stage4(stg, row, quad * 4, acc[i][0], rs);
#pragma unroll
        for (int j = 1; j < 4; ++j) stage4(stg, row, j * 16 + quad * 4, acc[i][j], rs);
        if (kind == 2) {
          float s = 0.f;
#pragma unroll
          for (int j = 0; j < 4; ++j) { const f32x4 a = acc[i][j] * rs; s += a[0] * a[0] + a[1] * a[1] + a[2] * a[2] + a[3] * a[3]; }
          s += __shfl_xor(s, 16); s += __shfl_xor(s, 32);
          if (quad == 0) ((float*)(p.ws + O_CSSQ))[(size_t)t * 16 + cslot] = s;
        }
      }
      stage_out<128, 64, STG_LD>(stg, dbuf + (size_t)trow0 * dld + dcol, (size_t)dld, lane);
    }
  }
  __syncthreads();
}
DI void phase_inproj(const Params& p, int layer, unsigned char* smem) {
  xcd_tiles(16, 14, [&](int tm, int tn) {
    const bool vt = (tn == 4 || tn == 9 || tn == 10);
    if (vt) inproj_tile<false>(p, layer, tm, tn, (bf16_t*)smem); else inproj_tile<true>(p, layer, tm, tn, (bf16_t*)smem);
  });
}

template <int KIND> DI void mlaup_tile(const Params& p, int layer, int tm, int tn, bf16_t* smem) {
  const bf16_t* wl = (const bf16_t*)(p.ws + O_W) + (size_t)layer * W_LAYER;
  f32x4 acc[8][4]; zero_acc<8, 4>(acc);
  constexpr int K = KIND == 0 ? 384 : 256;
  RowPtr ap{KIND == 0 ? (const bf16_t*)(p.ws + O_CQ) + (size_t)tm * 256 * 384 : (const bf16_t*)(p.ws + O_CKV) + (size_t)tm * 256 * 256, (size_t)K};
  RowPtr bp{KIND == 0 ? wl + W_UQ + (size_t)tn * 256 * 384 : wl + W_UKV + (size_t)(tn - 3) * 256 * 256, (size_t)K};
  gemm_main<8, 4, KIND != 2>(acc, ap, 64, bp, 64, K / 64, smem);
  const int lane = TIDX() & 63, wid = TIDX() >> 6, wm = wid >> 2, wn = wid & 3, l15 = lane & 15, quad = lane >> 4;
  const float* cssq = (const float*)(p.ws + O_CSSQ);
  if constexpr (KIND == 2) {
    bf16_t* dst = (bf16_t*)(p.ws + O_MLAVT); const int h = (tn - 5) * 4 + wn;
#pragma unroll
    for (int i = 0; i < 8; ++i) {
      asm volatile("" ::: "memory");
      const int t0 = tm * 256 + wm * 128 + i * 16 + quad * 4; const int b = t0 >> 12, s = t0 & 4095; float rs[4];
#pragma unroll
      for (int r = 0; r < 4; ++r) { const float* c = cssq + (size_t)(t0 + r) * 16 + 8; rs[r] = rsqrtf((c[0] + c[1] + c[2] + c[3]) * (1.f / 256.f) + EPS_); }
#pragma unroll
      for (int j = 0; j < 4; ++j) {
        const int d = j * 16 + l15;
        *(u32x2*)(dst + ((size_t)(b * 8 + h) * 64 + d) * S_ + s) = (u32x2){pk2(acc[i][j][0] * rs[0], acc[i][j][1] * rs[1]), pk2(acc[i][j][2] * rs[2], acc[i][j][3] * rs[3])};
      }
    }
  } else if constexpr (KIND == 1) {
#pragma unroll
    for (int i = 0; i < 8; ++i) {
      asm volatile("" ::: "memory");
      const int t = tm * 256 + wm * 128 + i * 16 + l15; const float* c = cssq + (size_t)t * 16;
      const float rs = rsqrtf((c[8] + c[9] + c[10] + c[11]) * (1.f / 256.f) + EPS_);
      bf16_t* dst = (bf16_t*)(p.ws + O_MLAKN) + (size_t)t * 512 + (tn - 3) * 256 + wn * 64 + quad * 4;
#pragma unroll
      for (int j = 0; j < 4; ++j) store4(dst + j * 16, acc[i][j], rs);
    }
  } else {
    const int n0 = tn * 256 + wn * 64, ph = n0 % 96;
#pragma unroll
    for (int i = 0; i < 8; ++i) {
      asm volatile("" ::: "memory");
      const int t = tm * 256 + wm * 128 + i * 16 + l15; const float* c = cssq + (size_t)t * 16;
      const float rs = rsqrtf((c[0] + c[1] + c[2] + c[3] + c[4] + c[5]) * (1.f / 384.f) + EPS_) * QS96_;
      bf16_t* dst = (bf16_t*)(p.ws + O_MLAQ) + (size_t)t * 768 + n0 + quad * 4;
      f32x4 v0 = acc[i][0] * rs, v1 = acc[i][1] * rs, v2 = acc[i][2] * rs, v3 = acc[i][3] * rs;
      if (ph != 0) {
        const float* rp = (const float*)(p.ws + O_ROPE16) + (size_t)t * 32 + quad * 8;
        const f32x4 x1 = ph == 64 ? v0 : v2, x2 = ph == 64 ? v1 : v3; f32x4 o1, o2;
#pragma unroll
        for (int r = 0; r < 4; ++r) { const float cs = rp[2 * r], sn = rp[2 * r + 1]; o1[r] = x1[r] * cs - x2[r] * sn; o2[r] = x2[r] * cs + x1[r] * sn; }
        if (ph == 64) { v0 = o1; v1 = o2; } else { v2 = o1; v3 = o2; }
      }
      store4(dst, v0, 1.f); store4(dst + 16, v1, 1.f); store4(dst + 32, v2, 1.f); store4(dst + 48, v3, 1.f);
    }
  }
}
struct CmpRowPtr { const bf16_t* base; int r0;
  DI unsigned operator()(int r) const { int R = r0 + r; if (R >= 4080) R = 0; const int b = R / 510, rem = R - b * 510, n = rem >> 1, g = rem & 1; return (unsigned)(b * S_ + 16 * n) * 256u + g * 64; }
  DI bool ok(int r) const { return r0 + r < 4080; } };
DI void compress_item(const Params& p, int layer, int item, bf16_t* smem) {
  const int kv = item >> 4, tm = item & 15;
  const bf16_t* wl = (const bf16_t*)(p.ws + O_W) + (size_t)layer * W_LAYER;
  f32x4 acc[8][4]; zero_acc<8, 4>(acc);
  CmpRowPtr ap{(const bf16_t*)(p.ws + O_KVCMP) + kv * 128, tm * 256};
  RowPtr bp{wl + (kv ? W_1V : W_1K), (size_t)2048};
  gemm_main<8, 4, true>(acc, ap, 256, bp, 64, 32, smem);
  const int lane = TIDX() & 63, wid = TIDX() >> 6, wm = wid >> 2, wn = wid & 3, l15 = lane & 15, quad = lane >> 4;
  constexpr int LDH = 264; bf16_t* H = smem;
  const float* b1 = (const float*)(p.ws + O_BIAS1) + (layer * 2 + kv) * 256;
#pragma unroll
  for (int i = 0; i < 8; ++i)
#pragma unroll
    for (int j = 0; j < 4; ++j) {
      const int row = wm * 128 + i * 16 + l15, col = wn * 64 + j * 16 + quad * 4; const f32x4 bv = *(const f32x4*)(b1 + col);
      *(u32x2*)(H + row * LDH + col) = (u32x2){pk2(gelu_tanh(acc[i][j][0] + bv[0]), gelu_tanh(acc[i][j][1] + bv[1])), pk2(gelu_tanh(acc[i][j][2] + bv[2]), gelu_tanh(acc[i][j][3] + bv[3]))};
    }
  __syncthreads();
  f32x4 a2[2][4];
#pragma unroll
  for (int i = 0; i < 2; ++i)
#pragma unroll
    for (int j = 0; j < 4; ++j) a2[i][j] = (f32x4){0.f, 0.f, 0.f, 0.f};
  const bf16_t* w2 = wl + (kv ? W_2V : W_2K);
#pragma unroll
  for (int ks = 0; ks < 8; ++ks) {
    bf16x8 a[2], b[4];
#pragma unroll
    for (int i = 0; i < 2; ++i) a[i] = *(const bf16x8*)(H + (wid * 32 + i * 16 + l15) * LDH + ks * 32 + quad * 8);
#pragma unroll
    for (int j = 0; j < 4; ++j) b[j] = *(const bf16x8*)(w2 + (size_t)(j * 16 + l15) * 256 + ks * 32 + quad * 8);
#pragma unroll
    for (int i = 0; i < 2; ++i)
#pragma unroll
      for (int j = 0; j < 4; ++j) a2[i][j] = mfma16(a[i], b[j], a2[i][j]);
  }
  bf16_t* kc = (bf16_t*)(p.ws + O_KC); bf16_t* vct = (bf16_t*)(p.ws + O_VCT);
#pragma unroll
  for (int i = 0; i < 2; ++i)
#pragma unroll
    for (int r = 0; r < 4; ++r) {
      const int R = tm * 256 + wid * 32 + i * 16 + quad * 4 + r;
      if (R < 4080) {
        const int b = R / 510, rem = R - b * 510, n = rem >> 1, g = rem & 1;
#pragma unroll
        for (int j = 0; j < 4; ++j) {
          const int d = j * 16 + l15; const bf16_t v = f2bf(a2[i][j][r]);
          if (kv == 0) kc[((size_t)(b * 2 + g) * 256 + n) * 64 + d] = v; else vct[((size_t)(b * 2 + g) * 64 + d) * 256 + n] = v;
        }
      }
    }
  __syncthreads();
}
DI void foxscan_item(const Params& p, int item, float* lds) {
  const int b = item >> 3, h = item & 7, tid = TIDX();
  const float* lf = (const float*)(p.ws + O_LOGF) + (size_t)b * S_ * 8 + h; float v[8]; float s = 0.f;
#pragma unroll
  for (int i = 0; i < 8; ++i) { s += lf[(size_t)(tid * 8 + i) * 8]; v[i] = s; }
  lds[tid] = s; __syncthreads();
  float off = 0.f;
  for (int i = 0; i < tid; ++i) off += lds[i];
  float* F2 = (float*)(p.ws + O_F2) + (size_t)(b * 8 + h) * S_ + tid * 8;
#pragma unroll
  for (int i = 0; i < 8; ++i) F2[i] = -(off + v[i]) * LOG2E_;
  __syncthreads();
}
DI void phase_b(const Params& p, int layer, unsigned char* smem) {
  for (int it = blockIdx.x; it < 96; it += gridDim.x) {
    if (it < 32) compress_item(p, layer, it, (bf16_t*)smem);
    else foxscan_item(p, it - 32, (float*)smem);
  }
  xcd_tiles(16, 7, [&](int tm, int tn) {
    if (tn >= 5) mlaup_tile<2>(p, layer, tm, tn, (bf16_t*)smem); else if (tn >= 3) mlaup_tile<1>(p, layer, tm, tn, (bf16_t*)smem); else mlaup_tile<0>(p, layer, tm, tn, (bf16_t*)smem);
  });
}

constexpr int KC_LD = 72, VC_LD = 264;
DI void cmp_item(const Params& p, int item, unsigned char* smem_) {
  const int b = item >> 6, g = (item >> 5) & 1, tt = item & 31, t0 = tt * 128;
  const int tid = TIDX(), lane = tid & 63, wid = tid >> 6, l15 = lane & 15, quad = lane >> 4;
  bf16_t* kcs = (bf16_t*)smem_;
  bf16_t* vcs = kcs + 256 * KC_LD;
  float* imps = (float*)smem_;
  const int nmax = (t0 + 96) >> 4;
  const int nsub = (nmax >> 4) + 1;
  {
    const bf16_t* kcg = (const bf16_t*)(p.ws + O_KC) + (size_t)(b * 2 + g) * 256 * 64; const bf16_t* vcg = (const bf16_t*)(p.ws + O_VCT) + (size_t)(b * 2 + g) * 64 * 256;
    const int nrows = ((nsub + 1) & ~1) * 16;
    for (int e = tid; e < nrows * 8; e += NTHR) {
      const int n = e >> 3, dc = (e & 7) * 8;
      *(u32x4*)(kcs + n * KC_LD + dc) = n < 255 ? *(const u32x4*)(kcg + (size_t)n * 64 + dc) : (u32x4){0u, 0u, 0u, 0u};
    }
    const int ncs = nrows >> 3;
    for (int e = tid; e < 64 * ncs; e += NTHR) {
      const int d = e / ncs, nc = (e - d * ncs) * 8;
      u32x4 v = *(const u32x4*)(vcg + (size_t)d * 256 + nc);
      if (nc + 8 > 255) v[3] &= 0x0000ffffu;
      *(u32x4*)(vcs + d * VC_LD + nc) = v;
    }
  }
  __syncthreads();
  const int tq = t0 + wid * 16 + l15;
  const size_t trow = (size_t)b * S_ + tq;
  float impa[16], p3a[16];
#pragma unroll
  for (int s = 0; s < 16; ++s) { impa[s] = 0.f; p3a[s] = 0.f; }
  const float* gts = (const float*)(p.ws + O_GATES) + trow * 24;
#pragma unroll 1
  for (int r4 = 0; r4 < 4; ++r4) {
    const int head = g * 4 + r4;
    const bf16_t* qp = (const bf16_t*)(p.ws + O_NSAQ) + trow * 512 + head * 64 + quad * 8;
    const bf16x8 q0 = *(const bf16x8*)qp, q1 = *(const bf16x8*)(qp + 32);
    auto score = [&](int s) -> f32x4 {
      const bf16_t* kr = kcs + (s * 16 + l15) * KC_LD + quad * 8;
      f32x4 a = {0.f, 0.f, 0.f, 0.f};
      a = mfma16(*(const bf16x8*)kr, q0, a); a = mfma16(*(const bf16x8*)(kr + 32), q1, a);
#pragma unroll
      for (int r = 0; r < 4; ++r) { const int n = s * 16 + quad * 4 + r; a[r] = (16 * n + 31 <= tq) ? a[r] : -INFINITY; }
      return a;
    };
    float mx = -INFINITY;
#pragma unroll 1
    for (int s = 0; s < nsub; ++s) { const f32x4 a = score(s); mx = fmaxf(mx, fmaxf(fmaxf(a[0], a[1]), fmaxf(a[2], a[3]))); }
    mx = fmaxf(mx, __shfl_xor(mx, 16)); mx = fmaxf(mx, __shfl_xor(mx, 32));
    if (mx == -INFINITY) mx = 0.f;
    float sum = 0.f;
#pragma unroll 1
    for (int s = 0; s < nsub; ++s) { const f32x4 a = score(s); sum += (ex2(a[0] - mx) + ex2(a[1] - mx)) + (ex2(a[2] - mx) + ex2(a[3] - mx)); }
    sum += __shfl_xor(sum, 16); sum += __shfl_xor(sum, 32);
    const float inv = 1.f / fmaxf(sum, 1e-30f);
    f32x4 oacc[4];
#pragma unroll
    for (int j = 0; j < 4; ++j) oacc[j] = (f32x4){0.f, 0.f, 0.f, 0.f};
#pragma unroll
    for (int c = 0; c < 8; ++c) {
      asm volatile("" ::: "memory");
      if (2 * c < nsub) {
        f32x4 pa = score(2 * c), pb = {-INFINITY, -INFINITY, -INFINITY, -INFINITY};
        if (2 * c + 1 < nsub) pb = score(2 * c + 1);
#pragma unroll
        for (int r = 0; r < 4; ++r) { pa[r] = ex2(pa[r] - mx) * inv; pb[r] = ex2(pb[r] - mx) * inv; }
        impa[2 * c] += pa[0] + pa[1] + pa[2] + 0.5f * pa[3]; p3a[2 * c] += pa[3];
        impa[2 * c + 1] += pb[0] + pb[1] + pb[2] + 0.5f * pb[3]; p3a[2 * c + 1] += pb[3];
        const u32x4 pw = {pk2(pa[0], pa[1]), pk2(pa[2], pa[3]), pk2(pb[0], pb[1]), pk2(pb[2], pb[3])};
        const bf16x8 pf = __builtin_bit_cast(bf16x8, pw);
#pragma unroll
        for (int j = 0; j < 4; ++j) {
          const bf16_t* vr = vcs + (j * 16 + l15) * VC_LD + c * 32 + quad * 4;
          const u32x2 lo = *(const u32x2*)vr, hi = *(const u32x2*)(vr + 16);
          const u32x4 vw = {lo[0], lo[1], hi[0], hi[1]};
          oacc[j] = mfma16(__builtin_bit_cast(bf16x8, vw), pf, oacc[j]);
        }
      }
    }
    const float g0 = gts[head * 3 + 0];
    bf16_t* op = (bf16_t*)(p.ws + O_ONSA) + trow * 512 + head * 64 + quad * 4;
#pragma unroll
    for (int j = 0; j < 4; ++j) store4(op + j * 16, oacc[j], g0);
  }
  __syncthreads();
  float* myimp = imps + wid * 1024 + l15 * 64;
  const int cur = tq >> 6;
#pragma unroll
  for (int s = 0; s < 16; ++s) {
    const float up = __shfl(p3a[s], (lane + 48) & 63);
    const float up0 = s ? __shfl(p3a[s ? s - 1 : 0], (lane + 48) & 63) : 0.f;
    const float prev = quad ? up : up0;
    float v = impa[s] + 0.5f * prev;
    const int j = 4 * s + quad;
    if (j == 0 || j == cur || j == cur - 1) v = 1e9f; else if (j > cur) v = -1e9f;
    myimp[j] = v;
  }
  __syncthreads();
  u64* sel = (u64*)(p.ws + O_SEL) + (size_t)(b * 2 + g) * S_ + t0 + wid * 16;
#pragma unroll 1
  for (int q = 0; q < 16; ++q) {
    const float mine = imps[wid * 1024 + q * 64 + lane]; int rank = 0;
#pragma unroll
    for (int i = 0; i < 64; ++i) { const float v = __uint_as_float(__builtin_amdgcn_readlane(__float_as_uint(mine), i)); rank += (v > mine || (v == mine && i < lane)) ? 1 : 0; }
    const u64 m = __ballot(rank < 16);
    if (lane == 0) sel[q] = m;
  }
  __syncthreads();
}
constexpr int PC_ITEMS = NB_ * 2 * 32;
DI void phase_c(const Params& p, unsigned char* smem) { for (int it = blockIdx.x; it < PC_ITEMS; it += gridDim.x) cmp_item(p, it, smem); }

enum { M_FOX = 0, M_MLA = 1, M_WIN = 2, M_SLC = 3 };
template <int MODE> struct ACfg { static constexpr int DQK = MODE == M_MLA ? 96 : 64, KLD = DQK + 8, NKC = DQK / 8 * 64, KCH = (NKC + NTHR - 1) / NTHR, K_ELEMS = 64 * KLD, V_ELEMS = 64 * 72, STAGE = K_ELEMS + V_ELEMS + 128; };
struct AState { f32x16 o[2]; float m, l; };

template <int MODE>
DI void flash_pass(AState& st, const bf16x8* qf, u64 tmask, u64 wmask,
                   const bf16_t* kbase, size_t kld, const bf16_t* kpe, const bf16_t* vtbase, const float* fbias,
                   int tq, u64 mysel, bf16_t* smem) {
  typedef ACfg<MODE> C;
  const int tid = TIDX(), lane = tid & 63, l31 = lane & 31, half = lane >> 5;
  u32x4 rk[C::KCH], rv; float rf = 0.f;
  auto gload = [&](int j) {
    const int k0 = j * 64;
#pragma unroll
    for (int i = 0; i < C::KCH; ++i) {
      const int c = tid + NTHR * i;
      if (c < C::NKC) {
        if constexpr (MODE == M_MLA) { const int key = c / 12, dc = c % 12; rk[i] = dc < 8 ? *(const u32x4*)(kbase + (size_t)(k0 + key) * kld + dc * 8) : *(const u32x4*)(kpe + (size_t)(k0 + key) * 32 + (dc - 8) * 8); }
        else { const int key = c >> 3, dc = c & 7; rk[i] = *(const u32x4*)(kbase + (size_t)(k0 + key) * kld + dc * 8); }
      }
    }
    { const int d = tid >> 3, kc = tid & 7; rv = *(const u32x4*)(vtbase + (size_t)d * S_ + k0 + kc * 8); }
    if constexpr (MODE == M_FOX) { if (tid < 64) rf = fbias[k0 + tid]; }
  };
  auto sstore = [&](int buf) {
    bf16_t* Ks = smem + buf * C::STAGE; bf16_t* Vs = Ks + C::K_ELEMS;
#pragma unroll
    for (int i = 0; i < C::KCH; ++i) {
      const int c = tid + NTHR * i;
      if (c < C::NKC) {
        if constexpr (MODE == M_MLA) { const int key = c / 12, dc = c % 12; *(u32x4*)(Ks + key * C::KLD + dc * 8) = rk[i]; }
        else { const int key = c >> 3, dc = c & 7; *(u32x4*)(Ks + key * C::KLD + dc * 8) = rk[i]; }
      }
    }
    {
      const int d = tid >> 3, kc = tid & 7, cgp = kc >> 1, a = kc & 1;
      bf16_t* dst = Vs + d * 72 + cgp * 16 + 4 * a;
      *(u32x2*)dst = (u32x2){rv[0], rv[1]}; *(u32x2*)(dst + 8) = (u32x2){rv[2], rv[3]};
    }
    if constexpr (MODE == M_FOX) { if (tid < 64) ((float*)(Vs + C::V_ELEMS))[tid] = rf; }
  };
  u64 tm = tmask;
  if (tm == 0) return;
  int j = __builtin_ctzll(tm); tm &= tm - 1;
  gload(j); sstore(0); __syncthreads();
  int buf = 0;
  const int tmin = __builtin_amdgcn_readfirstlane(tq - l31), tmax = tmin + 31;
  while (true) {
    const int jn = tm ? __builtin_ctzll(tm) : -1; if (tm) tm &= tm - 1;
    if (jn >= 0) gload(jn);
    if ((wmask >> j) & 1) {
      const bf16_t* Ks = smem + buf * C::STAGE; const bf16_t* Vs = Ks + C::K_ELEMS;
      f32x16 s0, s1;
#pragma unroll
      for (int r = 0; r < 16; ++r) { s0[r] = 0.f; s1[r] = 0.f; }
      const bf16_t* kr = Ks + l31 * C::KLD + half * 8;
#pragma unroll
      for (int ks = 0; ks < C::DQK / 16; ++ks) {
        s0 = mfma32(*(const bf16x8*)(kr + ks * 16), qf[ks], s0);
        s1 = mfma32(*(const bf16x8*)(kr + 32 * C::KLD + ks * 16), qf[ks], s1);
      }
      const int k0 = j * 64;
      if constexpr (MODE == M_FOX) {
        const float* fb = (const float*)(Vs + C::V_ELEMS) + 4 * half;
#pragma unroll
        for (int g4 = 0; g4 < 4; ++g4) {
          const f32x4 b0 = *(const f32x4*)(fb + 8 * g4), b1 = *(const f32x4*)(fb + 32 + 8 * g4);
#pragma unroll
          for (int r = 0; r < 4; ++r) { s0[4 * g4 + r] += b0[r]; s1[4 * g4 + r] += b1[r]; }
        }
      }
      bool need = k0 + 63 > tmin;
      if constexpr (MODE == M_WIN) need = need || (k0 <= tmax - 512);
      if constexpr (MODE == M_SLC) need = true;
      if (need) {
        const bool rowok = MODE == M_SLC ? ((mysel >> j) & 1) != 0 : true;
#pragma unroll
        for (int r = 0; r < 16; ++r) {
          const int key = k0 + (r & 3) + 8 * (r >> 2) + 4 * half;
          bool ok0 = rowok && key <= tq, ok1 = rowok && key + 32 <= tq;
          if constexpr (MODE == M_WIN) { ok0 = ok0 && (tq - key < 512); ok1 = ok1 && (tq - key - 32 < 512); }
          s0[r] = ok0 ? s0[r] : -INFINITY; s1[r] = ok1 ? s1[r] : -INFINITY;
        }
      }
      float mx = -INFINITY;
#pragma unroll
      for (int r = 0; r < 16; ++r) mx = fmaxf(mx, fmaxf(s0[r], s1[r]));
      mx = fmaxf(mx, __shfl_xor(mx, 32));
      const float mn = fmaxf(st.m, mx), alpha = ex2(st.m - mn);
      st.m = mn;
      float sum = 0.f;
#pragma unroll
      for (int r = 0; r < 16; ++r) { s0[r] = ex2(s0[r] - mn); s1[r] = ex2(s1[r] - mn); sum += s0[r] + s1[r]; }
      st.l = st.l * alpha + sum;
#pragma unroll
      for (int r = 0; r < 16; ++r) { st.o[0][r] *= alpha; st.o[1][r] *= alpha; }
      const bf16_t* vr = Vs + l31 * 72 + half * 8;
#pragma unroll
      for (int c = 0; c < 4; ++c) {
        u32x4 pw;
        if (c < 2) pw = (u32x4){pk2(s0[8 * c + 0], s0[8 * c + 1]), pk2(s0[8 * c + 2], s0[8 * c + 3]), pk2(s0[8 * c + 4], s0[8 * c + 5]), pk2(s0[8 * c + 6], s0[8 * c + 7])};
        else pw = (u32x4){pk2(s1[8 * (c - 2) + 0], s1[8 * (c - 2) + 1]), pk2(s1[8 * (c - 2) + 2], s1[8 * (c - 2) + 3]), pk2(s1[8 * (c - 2) + 4], s1[8 * (c - 2) + 5]), pk2(s1[8 * (c - 2) + 6], s1[8 * (c - 2) + 7])};
        const bf16x8 pf = __builtin_bit_cast(bf16x8, pw);
        st.o[0] = mfma32(*(const bf16x8*)(vr + c * 16), pf, st.o[0]);
        st.o[1] = mfma32(*(const bf16x8*)(vr + 32 * 72 + c * 16), pf, st.o[1]);
      }
    }
    if (jn >= 0) sstore(buf ^ 1);
    __syncthreads();
    if (jn < 0) break;
    j = jn; buf ^= 1;
  }
}
DI void astate_init(AState& s) {
#pragma unroll
  for (int r = 0; r < 16; ++r) { s.o[0][r] = 0.f; s.o[1][r] = 0.f; }
  s.m = -1e30f; s.l = 0.f;
}
DI u64 lowbits(int n) { return n >= 64 ? ~0ull : ((1ull << n) - 1ull); }

template <int MODE> DI void dense_attn_item(const Params& p, int b, int h, int qt, bf16_t* smem) {
  const int lane = TIDX() & 63, wid = TIDX() >> 6, l31 = lane & 31, half = lane >> 5;
  const int t0 = qt * 256, tq = t0 + wid * 32 + l31; const size_t trow = (size_t)b * S_ + tq;
  constexpr int NQ = ACfg<MODE>::DQK / 16;
  bf16x8 qf[NQ];
  const bf16_t* qp = MODE == M_FOX ? (const bf16_t*)(p.ws + O_FOXQ) + trow * 512 + h * 64 : (const bf16_t*)(p.ws + O_MLAQ) + trow * 768 + h * 96;
#pragma unroll
  for (int ks = 0; ks < NQ; ++ks) qf[ks] = *(const bf16x8*)(qp + ks * 16 + half * 8);
  AState st; astate_init(st);
  const u64 tmask = lowbits(4 * qt + 4), wmask = lowbits(((t0 + wid * 32 + 31) >> 6) + 1);
  if constexpr (MODE == M_FOX)
    flash_pass<M_FOX>(st, qf, tmask, wmask, (const bf16_t*)(p.ws + O_FOXK) + (size_t)b * S_ * 512 + h * 64, 512, nullptr,
                      (const bf16_t*)(p.ws + O_FOXVT) + (size_t)(b * 8 + h) * 64 * S_, (const float*)(p.ws + O_F2) + (size_t)(b * 8 + h) * S_, tq, 0ull, smem);
  else
    flash_pass<M_MLA>(st, qf, tmask, wmask, (const bf16_t*)(p.ws + O_MLAKN) + (size_t)b * S_ * 512 + h * 64, 512, (const bf16_t*)(p.ws + O_MLAKPE) + (size_t)b * S_ * 32,
                      (const bf16_t*)(p.ws + O_MLAVT) + (size_t)(b * 8 + h) * 64 * S_, nullptr, tq, 0ull, smem);
  const float l = st.l + __shfl_xor(st.l, 32), inv = 1.f / fmaxf(l, 1e-30f);
  bf16_t* op = (bf16_t*)qp;
#pragma unroll
  for (int dt = 0; dt < 2; ++dt)
#pragma unroll
    for (int g4 = 0; g4 < 4; ++g4) {
      const int d = dt * 32 + g4 * 8 + half * 4;
      *(u32x2*)(op + d) = (u32x2){pk2(st.o[dt][4 * g4] * inv, st.o[dt][4 * g4 + 1] * inv), pk2(st.o[dt][4 * g4 + 2] * inv, st.o[dt][4 * g4 + 3] * inv)};
    }
}
DI void nsa_attn_item(const Params& p, int b, int g, int qt, bf16_t* smem) {
  const int lane = TIDX() & 63, wid = TIDX() >> 6, l31 = lane & 31, half = lane >> 5;
  const int t0 = qt * 64, tw0 = t0 + (wid >> 2) * 32, tq = tw0 + l31, head = g * 4 + (wid & 3); const size_t trow = (size_t)b * S_ + tq;
  bf16x8 qf[4];
  const bf16_t* qp = (const bf16_t*)(p.ws + O_NSAQ) + trow * 512 + head * 64;
#pragma unroll
  for (int ks = 0; ks < 4; ++ks) qf[ks] = *(const bf16x8*)(qp + ks * 16 + half * 8);
  {
    const float* rp = (const float*)(p.ws + O_ROPE8) + trow * 16;
    u32x4 me = __builtin_bit_cast(u32x4, qf[0]), ot;
#pragma unroll
    for (int e = 0; e < 4; ++e) ot[e] = __shfl_xor(me[e], 32);
    unsigned res[4];
#pragma unroll
    for (int e = 0; e < 4; ++e) {
      float o2[2];
#pragma unroll
      for (int u = 0; u < 2; ++u) {
        const int f = 2 * e + u; const float cs = rp[2 * f], sn = rp[2 * f + 1];
        const float a = bf2f((bf16_t)(u ? me[e] >> 16 : me[e] & 0xffffu)), o = bf2f((bf16_t)(u ? ot[e] >> 16 : ot[e] & 0xffffu));
        o2[u] = half == 0 ? a * cs - o * sn : a * cs + o * sn;
      }
      res[e] = pk2(o2[0], o2[1]);
    }
    qf[0] = __builtin_bit_cast(bf16x8, (u32x4){res[0], res[1], res[2], res[3]});
  }
  const float* gts = (const float*)(p.ws + O_GATES) + trow * 24 + head * 3;
  const int cur = t0 >> 6;
  f32x16 res[2];
  {
    AState st; astate_init(st);
    const int first = t0 >= 511 ? (t0 - 511) >> 6 : 0, firstw = tw0 >= 511 ? (tw0 - 511) >> 6 : 0;
    const u64 tmask = lowbits(cur + 1) & ~lowbits(first), wmask = lowbits(cur + 1) & ~lowbits(firstw);
    flash_pass<M_WIN>(st, qf, tmask, wmask, (const bf16_t*)(p.ws + O_KWIN) + (size_t)b * S_ * 128 + g * 64, 128, nullptr,
                      (const bf16_t*)(p.ws + O_VWINT) + (size_t)(b * 2 + g) * 64 * S_, nullptr, tq, 0ull, smem);
    const float l = st.l + __shfl_xor(st.l, 32), sc = gts[2] / fmaxf(l, 1e-30f);
#pragma unroll
    for (int r = 0; r < 16; ++r) { res[0][r] = st.o[0][r] * sc; res[1][r] = st.o[1][r] * sc; }
  }
  {
    AState st; astate_init(st);
    const u64* selp = (const u64*)(p.ws + O_SEL) + (size_t)(b * 2 + g) * S_;
    const u64 mysel = selp[tq];
    const u64 m64 = selp[t0 + lane];
    unsigned lo = (unsigned)m64, hi = (unsigned)(m64 >> 32);
#pragma unroll
    for (int o = 32; o >= 1; o >>= 1) { lo |= __shfl_xor(lo, o); hi |= __shfl_xor(hi, o); }
    const u64 um = (((u64)(unsigned)__builtin_amdgcn_readfirstlane(hi) << 32) | (u64)(unsigned)__builtin_amdgcn_readfirstlane(lo)) & lowbits(cur + 1);
    flash_pass<M_SLC>(st, qf, um, um, (const bf16_t*)(p.ws + O_KSLC) + (size_t)b * S_ * 128 + g * 64, 128, nullptr,
                      (const bf16_t*)(p.ws + O_VSLCT) + (size_t)(b * 2 + g) * 64 * S_, nullptr, tq, mysel, smem);
    const float l = st.l + __shfl_xor(st.l, 32), sc = gts[1] / fmaxf(l, 1e-30f);
#pragma unroll
    for (int r = 0; r < 16; ++r) { res[0][r] += st.o[0][r] * sc; res[1][r] += st.o[1][r] * sc; }
  }
  bf16_t* op = (bf16_t*)(p.ws + O_ONSA) + trow * 512 + head * 64;
#pragma unroll
  for (int dt = 0; dt < 2; ++dt)
#pragma unroll
    for (int g4 = 0; g4 < 4; ++g4) {
      const int d = dt * 32 + g4 * 8 + half * 4;
      const u32x2 oc = *(const u32x2*)(op + d);
      const float c0 = bf2f((bf16_t)(oc[0] & 0xffffu)), c1 = bf2f((bf16_t)(oc[0] >> 16)), c2 = bf2f((bf16_t)(oc[1] & 0xffffu)), c3 = bf2f((bf16_t)(oc[1] >> 16));
      *(u32x2*)(op + d) = (u32x2){pk2(res[dt][4 * g4] + c0, res[dt][4 * g4 + 1] + c1), pk2(res[dt][4 * g4 + 2] + c2, res[dt][4 * g4 + 3] + c3)};
    }
}
constexpr int PD_ITEMS = 16 * 192;
DI void phase_d(const Params& p, unsigned char* smem) {
  for (int it = blockIdx.x; it < PD_ITEMS; it += gridDim.x) {
    const int r = it / 192, w = it % 192, qt = 15 - r;
    if (w < 64) dense_attn_item<M_MLA>(p, w >> 3, w & 7, qt, (bf16_t*)smem);
    else if (w < 128) dense_attn_item<M_FOX>(p, (w - 64) >> 3, (w - 64) & 7, qt, (bf16_t*)smem);
    else { const int i = w - 128, bg = i & 15, q4 = i >> 4; nsa_attn_item(p, bg >> 1, bg & 1, qt * 4 + q4, (bf16_t*)smem); }
  }
}

DI void merge_tile(const Params& p, int layer, int tm, int tn, bf16_t* smem) {
  const bf16_t* wl = (const bf16_t*)(p.ws + O_W) + (size_t)layer * W_LAYER;
  const int lane = TIDX() & 63, wid = TIDX() >> 6, wm = wid >> 2, wn = wid & 3, l15 = lane & 15, quad = lane >> 4;
  f32x4 mg[4][2]; zero_acc<4, 2>(mg);
  unsigned* gsp = (unsigned*)((unsigned char*)smem + 2 * GemmLds<4, 2>::STAGE * 2) + TIDX();
#pragma unroll 1
  for (int br = 0; br < 3; ++br) {
    {
      f32x4 ga[4][2]; zero_acc<4, 2>(ga);
      RowPtr ap{(const bf16_t*)(p.ws + O_XG) + (size_t)tm * 128 * D_, (size_t)D_}, bp{wl + W_G + ((size_t)br * 1024 + tn * 128) * D_, (size_t)D_};
      gemm_main<4, 2, true>(ga, ap, 64, bp, 64, 16, smem);
#pragma unroll
      for (int i = 0; i < 4; ++i) {
        const float rs = rstd_from16((const float*)(p.ws + O_SSQ) + (size_t)(tm * 128 + wm * 64 + i * 16 + l15) * 16, 1.f / 1024.f);
#pragma unroll
        for (int j = 0; j < 2; ++j) {
          gsp[((i * 2 + j) * 2 + 0) * NTHR] = pk2(sigmoidf_(ga[i][j][0] * rs), sigmoidf_(ga[i][j][1] * rs));
          gsp[((i * 2 + j) * 2 + 1) * NTHR] = pk2(sigmoidf_(ga[i][j][2] * rs), sigmoidf_(ga[i][j][3] * rs));
        }
      }
    }
    f32x4 ba[4][2]; zero_acc<4, 2>(ba);
    RowPtr bp2{wl + (br == 0 ? W_BN : br == 1 ? W_BF : W_BM) + (size_t)tn * 128 * 512, (size_t)512};
    const bf16_t* abase = (const bf16_t*)(p.ws + (br == 0 ? O_ONSA : br == 1 ? O_FOXQ : O_MLAQ));
    const int ald = br == 2 ? 768 : 512;
    RowPtr ap2{abase + (size_t)tm * 128 * ald, (size_t)ald};
    gemm_main<4, 2, true>(ba, ap2, br == 2 ? 96 : 64, bp2, 64, 8, smem);
#pragma unroll
    for (int i = 0; i < 4; ++i)
#pragma unroll
      for (int j = 0; j < 2; ++j) {
        const unsigned w0 = gsp[((i * 2 + j) * 2 + 0) * NTHR], w1 = gsp[((i * 2 + j) * 2 + 1) * NTHR];
        mg[i][j][0] += bf2f((bf16_t)(w0 & 0xffffu)) * ba[i][j][0];
        mg[i][j][1] += bf2f((bf16_t)(w0 >> 16)) * ba[i][j][1];
        mg[i][j][2] += bf2f((bf16_t)(w1 & 0xffffu)) * ba[i][j][2];
        mg[i][j][3] += bf2f((bf16_t)(w1 >> 16)) * ba[i][j][3];
      }
  }
#pragma unroll
  for (int i = 0; i < 4; ++i) {
    bf16_t* dst = (bf16_t*)(p.ws + O_MERGED) + (size_t)(tm * 128 + wm * 64 + i * 16 + l15) * D_ + tn * 128 + wn * 32 + quad * 4;
#pragma unroll
    for (int j = 0; j < 2; ++j) *(u32x2*)(dst + j * 16) = (u32x2){pk2(mg[i][j][0], mg[i][j][1]), pk2(mg[i][j][2], mg[i][j][3])};
  }
}
DI void phase_e(const Params& p, int layer, unsigned char* smem) {
  xcd_tiles(32, 8, [&](int tm, int tn) { merge_tile(p, layer, tm, tn, (bf16_t*)smem); });
}

DI void resid_tile(const Params& p, const bf16_t* A, int K, const bf16_t* W, const float* xold, const float* gnext, int tm, int tn, bf16_t* smem) {
  f32x4 acc[8][4]; zero_acc<8, 4>(acc);
  RowPtr ap{A + (size_t)tm * 256 * K, (size_t)K}, bp{W + (size_t)tn * 256 * K, (size_t)K};
  gemm_main<8, 4, true>(acc, ap, 64, bp, 64, K / 64, smem);
  const int lane = TIDX() & 63, wid = TIDX() >> 6, wm = wid >> 2, wn = wid & 3, l15 = lane & 15, quad = lane >> 4;
#pragma unroll
  for (int i = 0; i < 8; ++i) {
    const int t = tm * 256 + wm * 128 + i * 16 + l15, c0 = tn * 256 + wn * 64 + quad * 4; float s = 0.f;
#pragma unroll
    for (int j = 0; j < 4; ++j) {
      const size_t off = (size_t)t * D_ + c0 + j * 16;
      const f32x4 xn = *(const f32x4*)(xold + off) + acc[i][j];
      *(f32x4*)(p.out + off) = xn;
      s += xn[0] * xn[0] + xn[1] * xn[1] + xn[2] * xn[2] + xn[3] * xn[3];
      if (gnext) { const f32x4 gv = *(const f32x4*)(gnext + c0 + j * 16); *(u32x2*)((bf16_t*)(p.ws + O_XG) + off) = (u32x2){pk2(xn[0] * gv[0], xn[1] * gv[1]), pk2(xn[2] * gv[2], xn[3] * gv[3])}; }
    }
    s += __shfl_xor(s, 16); s += __shfl_xor(s, 32);
    if (quad == 0) ((float*)(p.ws + O_SSQ))[(size_t)t * 16 + tn * 4 + wn] = s;
  }
}
DI void phase_f(const Params& p, int layer, unsigned char* smem) {
  const bf16_t* wl = (const bf16_t*)(p.ws + O_W) + (size_t)layer * W_LAYER;
  xcd_tiles(16, 4, [&](int tm, int tn) { resid_tile(p, (const bf16_t*)(p.ws + O_MERGED), 1024, wl + W_OUT, layer == 0 ? p.x : p.out, p.ffn_norm + layer * D_, tm, tn, (bf16_t*)smem); });
}
DI void phase_h(const Params& p, int layer, unsigned char* smem) {
  const bf16_t* wl = (const bf16_t*)(p.ws + O_W) + (size_t)layer * W_LAYER;
  xcd_tiles(16, 4, [&](int tm, int tn) { resid_tile(p, (const bf16_t*)(p.ws + O_ACT), DFF_, wl + W_DN, p.out, layer == 0 ? p.mix_norm + D_ : nullptr, tm, tn, (bf16_t*)smem); });
}

struct UpRowPtr { const bf16_t* base; int s0;
  DI unsigned operator()(int r) const { const int s = s0 + r; return (unsigned)((s < 0 || s >= S_) ? 0 : s) * (unsigned)D_; }
  DI bool ok(int r) const { const int s = s0 + r; return s >= 0 && s < S_; } };
constexpr int PG_MT = 17;
DI void ffnup_tile(const Params& p, int layer, int b, int mt, int tn, bf16_t* smem) {
  const bf16_t* wl = (const bf16_t*)(p.ws + O_W) + (size_t)layer * W_LAYER;
  f32x4 acc[8][4]; zero_acc<8, 4>(acc);
  const int s0 = 254 * mt - 2;
  UpRowPtr ap{(const bf16_t*)(p.ws + O_XG) + (size_t)b * S_ * D_, s0}; RowPtr bp{wl + W_UP + (size_t)tn * 256 * D_, (size_t)D_};
  gemm_main<8, 4, true>(acc, ap, 64, bp, 64, 16, smem);
  const int tid = TIDX(), lane = tid & 63, wid = tid >> 6, wm = wid >> 2, wn = wid & 3, l15 = lane & 15, quad = lane >> 4;
  constexpr int LDU = 132; float* U = (float*)smem;
  if (wn < 2) {
#pragma unroll
    for (int i = 0; i < 8; ++i) {
      const int row = wm * 128 + i * 16 + l15, s = s0 + row;
      const float rs = (s >= 0 && s < S_) ? rstd_from16((const float*)(p.ws + O_SSQ) + ((size_t)b * S_ + s) * 16, 1.f / 1024.f) : 0.f;
      float* dst = U + row * LDU + wn * 64 + quad * 4;
#pragma unroll
      for (int j = 0; j < 4; ++j) *(f32x4*)(dst + j * 16) = acc[i][j] * rs;
    }
  }
  __syncthreads();
  if (wn >= 2) {
    const int cl = (wn - 2) * 64 + quad * 4;
    bf16_t* act = (bf16_t*)(p.ws + O_ACT);
#pragma unroll
    for (int j = 0; j < 4; ++j) {
      const int cg0 = tn * 128 + cl + j * 16;
      const float* cw = p.conv_w + (size_t)layer * 3 * DFF_ + cg0; const f32x4 w0 = *(const f32x4*)cw, w1 = *(const f32x4*)(cw + DFF_), w2 = *(const f32x4*)(cw + 2 * DFF_);
      const f32x4 cb = *(const f32x4*)(p.conv_b + (size_t)layer * DFF_ + cg0);
#pragma unroll
      for (int i = 0; i < 8; ++i) {
        const int row = wm * 128 + i * 16 + l15, s = s0 + row;
        if (row >= 2 && s < S_) {
          const float rs = rstd_from16((const float*)(p.ws + O_SSQ) + ((size_t)b * S_ + s) * 16, 1.f / 1024.f);
          const float* up = U + row * LDU + cl + j * 16;
          const f32x4 u0 = *(const f32x4*)(up - 2 * LDU), u1 = *(const f32x4*)(up - LDU), u2 = *(const f32x4*)up;
          float o[4];
#pragma unroll
          for (int r = 0; r < 4; ++r) { const float uc = w0[r] * u0[r] + w1[r] * u1[r] + w2[r] * u2[r] + cb[r]; o[r] = uc * sigmoidf_(uc) * (acc[i][j][r] * rs); }
          *(u32x2*)(act + ((size_t)b * S_ + s) * DFF_ + cg0) = (u32x2){pk2(o[0], o[1]), pk2(o[2], o[3])};
        }
      }
    }
  }
  __syncthreads();
}
DI void phase_g(const Params& p, int layer, unsigned char* smem) {
  xcd_tiles(PG_MT, 22, [&](int tmg, int tn) { ffnup_tile(p, layer, tmg / PG_MT, tmg % PG_MT, tn, (bf16_t*)smem); });
}

DI void phase_final(const Params& p) {
  const int lane = TIDX() & 63, wid = TIDX() >> 6;
  for (int it = blockIdx.x; it < T_ / 8; it += gridDim.x) {
    const int t = it * 8 + wid; const float rs = rstd_from16((const float*)(p.ws + O_SSQ) + (size_t)t * 16, 1.f / 1024.f);
    float* xr = p.out + (size_t)t * D_;
#pragma unroll
    for (int c = 0; c < 4; ++c) { const int k = c * 256 + lane * 4; const f32x4 v = *(const f32x4*)(xr + k), gv = *(const f32x4*)(p.final_norm + k); *(f32x4*)(xr + k) = v * rs * gv; }
  }
}

#define XB_TMO      128
#define XB_XCNT(j)  (256  + 64 * (j))
#define XB_XSUB(j)  (1280 + 64 * (j))
#define XB_XGEN(j)  (2304 + 64 * (j))
#define XB_TOP      3328
#define XB_TOPGEN   3392
#define XCD_BAR_WORDS 3456
#define XB_SPIN_CAP (1u << 22)
#define LAS __attribute__((address_space(3)))
DI unsigned xb_ld(unsigned* p)              { return __hip_atomic_load(p, __ATOMIC_RELAXED, __HIP_MEMORY_SCOPE_AGENT); }
DI unsigned xb_add(unsigned* p, unsigned v) { return __hip_atomic_fetch_add(p, v, __ATOMIC_RELAXED, __HIP_MEMORY_SCOPE_AGENT); }
DI unsigned xb_xcc_id() { return (unsigned)__builtin_amdgcn_s_getreg((3 << 11) | 20) & 0xFu; }
#define XB_SPIN(cond, bar) do { unsigned _sp = 0; while (cond) { __builtin_amdgcn_s_sleep(1); \
    if ((++_sp & 255u) == 0u) { if (xb_ld(&(bar)[XB_TMO])) break; if (_sp > XB_SPIN_CAP) { atomicAdd(&(bar)[XB_TMO], 1u); break; } } } } while (0)
struct XcdBarrier { unsigned* bar; unsigned x; volatile LAS unsigned* st; };
DI XcdBarrier xcd_barrier_post(unsigned* bar, volatile LAS unsigned* st) {
  XcdBarrier b; b.bar = bar; b.x = xb_xcc_id(); b.st = st;
  if (threadIdx.x == 0) (void)xb_add(&bar[XB_XCNT(b.x)], 1u);
  return b;
}
DI void xcd_barrier_complete(unsigned* bar, unsigned x, unsigned& nloc, unsigned& nx) {
  const unsigned G = gridDim.x * gridDim.y * gridDim.z;
  unsigned sum, cnt, mine, sp = 0u;
  for (;;) {
    sum = 0u; cnt = 0u; mine = 0u;
#pragma unroll
    for (unsigned j = 0; j < 16; ++j) { const unsigned c = xb_ld(&bar[XB_XCNT(j)]); sum += c; cnt += (c > 0u) ? 1u : 0u; mine = (j == x) ? c : mine; }
    if (sum == G) break;
    __builtin_amdgcn_s_sleep(1);
    if ((++sp & 255u) == 0u) { if (xb_ld(&bar[XB_TMO])) break; if (sp > XB_SPIN_CAP) { atomicAdd(&bar[XB_TMO], 1u); break; } }
  }
  nloc = mine > 0u ? mine : 1u; nx = cnt > 0u ? cnt : 1u;
}
DI void xcd_barrier(const XcdBarrier& b) {
  asm volatile("s_waitcnt vmcnt(0)" ::: "memory");
  __syncthreads();
  if (threadIdx.x == 0) {
    unsigned* bar = b.bar;
    __builtin_amdgcn_s_waitcnt(0);
    unsigned nloc = b.st[0], nx = b.st[1];
    if (nloc == 0u) { xcd_barrier_complete(bar, b.x, nloc, nx); b.st[0] = nloc; b.st[1] = nx; }
    const unsigned old = xb_add(&bar[XB_XSUB(b.x)], 1u);
    const unsigned gen = old / nloc;
    if (old + 1u == (gen + 1u) * nloc) {
      __builtin_amdgcn_fence(__ATOMIC_RELEASE, "agent");
      asm volatile("s_waitcnt vmcnt(0)" ::: "memory");
      const unsigned og = xb_add(&bar[XB_TOP], 1u);
      const unsigned tg = og / nx;
      if (og + 1u == (tg + 1u) * nx) xb_add(&bar[XB_TOPGEN], 1u);
      else XB_SPIN(xb_ld(&bar[XB_TOPGEN]) == tg, bar);
      __builtin_amdgcn_fence(__ATOMIC_ACQUIRE, "agent");
      xb_add(&bar[XB_XGEN(b.x)], 1u);
      asm volatile("s_waitcnt vmcnt(0)" ::: "memory");
    } else {
      XB_SPIN(xb_ld(&bar[XB_XGEN(b.x)]) == gen, bar);
      __builtin_amdgcn_fence(__ATOMIC_ACQUIRE, "agent");
      asm volatile("s_waitcnt vmcnt(0)" ::: "memory");
    }
  }
  __syncthreads();
}
DI void run_phase(const Params& p, int ph, unsigned char* smem) {
  if (ph == 0) { phase_prep(p, smem); return; }
  if (ph == 17) { phase_final(p); return; }
  const int layer = (ph - 1) >> 3, s = (ph - 1) & 7;
#ifdef PROBE_DUP
  if ((PROBE_DUP >> s) & 1) {
    switch (s) { case 0: phase_inproj(p, layer, smem); break; case 1: phase_b(p, layer, smem); break; case 2: phase_c(p, smem); break; case 4: phase_e(p, layer, smem); break; case 6: phase_g(p, layer, smem); break; default: break; }
    __syncthreads();
  }
#endif
  switch (s) {
    case 0: phase_inproj(p, layer, smem); break;
    case 1: phase_b(p, layer, smem); break;
    case 2: phase_c(p, smem); break;
    case 3: phase_d(p, smem); break;
    case 4: phase_e(p, layer, smem); break;
    case 5: phase_f(p, layer, smem); break;
    case 6: phase_g(p, layer, smem); break;
    default: phase_h(p, layer, smem); break;
  }
}
constexpr int N_PHASES = 18;

#if ONE_LAUNCH
template <int PH> DI void run_all(const Params& p, unsigned char* smem, cg::grid_group& grid, const XcdBarrier& xb) {
  run_phase(p, PH, smem);
  if constexpr (PH + 1 < N_PHASES) {
    if constexpr (PH == 0) grid.sync(); else xcd_barrier(xb);
    run_all<PH + 1>(p, smem, grid, xb);
  }
}
__global__ void __launch_bounds__(NTHR, 2) mega_kernel(Params p) {
  __shared__ __attribute__((aligned(16))) unsigned char smem[SMEM_BYTES];
  __shared__ uint4 xb_words;
  if (threadIdx.x == 0) xb_words = make_uint4(0u, 0u, 0u, 0u);
  __syncthreads();
  const XcdBarrier xb = xcd_barrier_post((unsigned*)(p.ws + O_BAR), (volatile LAS unsigned*)&xb_words);
  cg::grid_group grid = cg::this_grid();
  run_all<0>(p, smem, grid, xb);
}
#else
template <int PH> __global__ void __launch_bounds__(NTHR, 2) phase_kernel(Params p) {
  __shared__ __attribute__((aligned(16))) unsigned char smem[SMEM_BYTES];
  run_phase(p, PH, smem);
}
template <int PH> static void launch_phases(const Params& p, hipStream_t stream) {
  hipLaunchKernelGGL((phase_kernel<PH>), dim3(256), dim3(NTHR), 0, stream, p);
  if constexpr (PH + 1 < N_PHASES) launch_phases<PH + 1>(p, stream);
}
#endif

extern "C" void kernel_launch(void* const* d_in, const int* in_sizes, int n_in, void* d_out, int out_size, void* d_ws, size_t ws_size, hipStream_t stream) {
  if (ws_size < O_END || n_in < 25) { fprintf(stderr, "workspace too small: %zu < %zu\n", ws_size, (size_t)O_END); return; }
  Params p{};
  p.x = (const float*)d_in[0]; p.pos = (const int*)d_in[1]; p.mix_norm = (const float*)d_in[2]; p.w_in = (const float*)d_in[3]; p.b_forget = (const float*)d_in[4];
  p.pe_k = (const float*)d_in[5]; p.w1_k = (const float*)d_in[6]; p.w2_k = (const float*)d_in[7]; p.pe_v = (const float*)d_in[8]; p.w1_v = (const float*)d_in[9]; p.w2_v = (const float*)d_in[10];
  p.q_norm = (const float*)d_in[11]; p.w_uq = (const float*)d_in[12]; p.kv_norm = (const float*)d_in[13]; p.w_ukv = (const float*)d_in[14];
  p.wbr_nsa = (const float*)d_in[15]; p.wbr_fox = (const float*)d_in[16]; p.wbr_mla = (const float*)d_in[17]; p.w_out = (const float*)d_in[18];
  p.ffn_norm = (const float*)d_in[19]; p.w_up = (const float*)d_in[20]; p.conv_w = (const float*)d_in[21]; p.conv_b = (const float*)d_in[22]; p.w_down = (const float*)d_in[23]; p.final_norm = (const float*)d_in[24];
  p.out = (float*)d_out; p.ws = (unsigned char*)d_ws;
#if ONE_LAUNCH
  static int grid_blocks = 0;
  if (!grid_blocks) {
    int dev = 0, cus = 0, per_cu = 0;
    hipGetDevice(&dev); hipDeviceGetAttribute(&cus, hipDeviceAttributeMultiprocessorCount, dev);
    hipOccupancyMaxActiveBlocksPerMultiprocessor(&per_cu, mega_kernel, NTHR, 0);
    if (per_cu > 1) per_cu = 1;
    grid_blocks = cus * per_cu;
  }
  hipMemsetAsync(p.ws + O_BAR, 0, XCD_BAR_WORDS * 4, stream);
  void* args[] = {&p};
  hipError_t e = hipLaunchCooperativeKernel((void*)mega_kernel, dim3(grid_blocks), dim3(NTHR), args, 0, stream);
  if (e != hipSuccess) fprintf(stderr, "cooperative launch failed: %s (grid %d)\n", hipGetErrorString(e), grid_blocks);
#else
  launch_phases<0>(p, stream);
#endif
}
```

```cpp
#include <hip/hip_runtime.h>
#include <hip/hip_cooperative_groups.h>
#include <stdint.h>
#include <stdio.h>
#include <type_traits>
namespace cg = cooperative_groups;

#ifndef ONE_LAUNCH
#define ONE_LAUNCH 1

#endif

#define DI __device__ __forceinline__
typedef unsigned short bf16_t;
typedef short bf16x8 __attribute__((ext_vector_type(8)));
typedef float f32x4 __attribute__((ext_vector_type(4)));
typedef float f32x16 __attribute__((ext_vector_type(16)));
typedef float f32x2 __attribute__((ext_vector_type(2)));
typedef __bf16 bfx2 __attribute__((ext_vector_type(2)));
typedef unsigned u32x4 __attribute__((ext_vector_type(4)));
typedef unsigned u32x2 __attribute__((ext_vector_type(2)));
typedef unsigned long long u64;

constexpr int T_ = 32768, S_ = 4096, NB_ = 8, D_ = 1024, DFF_ = 2816, NIN_ = 6592;
constexpr float EPS_ = 1e-6f;
constexpr float LOG2E_ = 1.4426950408889634f;
constexpr float QS64_ = 0.125f * LOG2E_;
constexpr float QS96_ = 0.10206207261596577f * LOG2E_;

constexpr size_t W_IN = 0;
constexpr size_t W_G = W_IN + (size_t)3584 * 1024;
constexpr size_t W_1K = W_G + (size_t)3072 * 1024;
constexpr size_t W_1V = W_1K + (size_t)256 * 2048;
constexpr size_t W_2K = W_1V + (size_t)256 * 2048;
constexpr size_t W_2V = W_2K + (size_t)64 * 256;
constexpr size_t W_UQ = W_2V + (size_t)64 * 256;
constexpr size_t W_UKV = W_UQ + (size_t)768 * 384;
constexpr size_t W_BN = W_UKV + (size_t)1024 * 256;
constexpr size_t W_BF = W_BN + (size_t)1024 * 512;
constexpr size_t W_BM = W_BF + (size_t)1024 * 512;
constexpr size_t W_OUT = W_BM + (size_t)1024 * 512;
constexpr size_t W_UP = W_OUT + (size_t)1024 * 1024;
constexpr size_t W_DN = W_UP + (size_t)5632 * 1024;
constexpr size_t W_LAYER = W_DN + (size_t)1024 * 2816;

constexpr size_t al256(size_t x) { return (x + 255) & ~(size_t)255; }
constexpr size_t O_BAR = 0;
constexpr size_t O_W = 16384;
constexpr size_t O_BIAS1 = al256(O_W + 2 * W_LAYER * 2);
constexpr size_t O_ROPE8 = al256(O_BIAS1 + 2 * 2 * 256 * 4);
constexpr size_t O_ROPE16 = al256(O_ROPE8 + (size_t)T_ * 16 * 4);
constexpr size_t O_XG = al256(O_ROPE16 + (size_t)T_ * 32 * 4);
constexpr size_t O_SSQ = al256(O_XG + (size_t)T_ * 1024 * 2);
constexpr size_t O_CSSQ = al256(O_SSQ + (size_t)T_ * 16 * 4);
constexpr size_t O_NSAQ = al256(O_CSSQ + (size_t)T_ * 16 * 4);
constexpr size_t O_KVCMP = O_NSAQ + (size_t)T_ * 512 * 2;
constexpr size_t O_KSLC = O_KVCMP + (size_t)T_ * 256 * 2;
constexpr size_t O_KWIN = O_KSLC + (size_t)T_ * 128 * 2;
constexpr size_t O_MERGED = O_NSAQ;
constexpr size_t O_VSLCT = O_KWIN + (size_t)T_ * 128 * 2;
constexpr size_t O_VWINT = O_VSLCT + (size_t)T_ * 128 * 2;
constexpr size_t O_FOXQ = O_VWINT + (size_t)T_ * 128 * 2;
constexpr size_t O_FOXK = O_FOXQ + (size_t)T_ * 512 * 2;
constexpr size_t O_FOXVT = O_FOXK + (size_t)T_ * 512 * 2;
constexpr size_t O_MLAQ = O_FOXVT + (size_t)T_ * 512 * 2;
constexpr size_t O_MLAKN = O_MLAQ + (size_t)T_ * 768 * 2;
constexpr size_t O_ACT = O_FOXQ;
constexpr size_t O_MLAVT = O_MLAKN + (size_t)T_ * 512 * 2;
constexpr size_t O_MLAKPE = O_MLAVT + (size_t)T_ * 512 * 2;
constexpr size_t O_ONSA = O_MLAKPE + (size_t)T_ * 32 * 2;
constexpr size_t O_CQ = O_ONSA;
constexpr size_t O_CKV = O_CQ + (size_t)T_ * 384 * 2;
constexpr size_t O_CEND = O_CKV + (size_t)T_ * 256 * 2;
constexpr size_t O_GATES = al256(O_CEND > O_ONSA + (size_t)T_ * 512 * 2 ? O_CEND : O_ONSA + (size_t)T_ * 512 * 2);
constexpr size_t O_LOGF = al256(O_GATES + (size_t)T_ * 24 * 4);
constexpr size_t O_F2 = al256(O_LOGF + (size_t)T_ * 8 * 4);
constexpr size_t O_KC = al256(O_F2 + (size_t)T_ * 8 * 4);
constexpr size_t O_VCT = al256(O_KC + (size_t)NB_ * 2 * 256 * 64 * 2);
constexpr size_t O_SEL = al256(O_VCT + (size_t)NB_ * 2 * 256 * 64 * 2);
constexpr size_t O_END = al256(O_SEL + (size_t)NB_ * 2 * S_ * 8);

struct Params {
  const float* x; const int* pos; const float* mix_norm; const float* w_in; const float* b_forget;
  const float* pe_k; const float* w1_k; const float* w2_k; const float* pe_v; const float* w1_v; const float* w2_v;
  const float* q_norm; const float* w_uq; const float* kv_norm; const float* w_ukv;
  const float* wbr_nsa; const float* wbr_fox; const float* wbr_mla; const float* w_out;
  const float* ffn_norm; const float* w_up; const float* conv_w; const float* conv_b; const float* w_down; const float* final_norm;
  float* out; unsigned char* ws;
};

constexpr int NTHR = 512;
constexpr int SMEM_BYTES = 147456;

DI int TIDX() { int t = (int)threadIdx.x; asm volatile("" : "+v"(t)); return t; }
DI unsigned pk2(float lo, float hi) { f32x2 v = {lo, hi}; return __builtin_bit_cast(unsigned, __builtin_convertvector(v, bfx2)); }
DI bf16_t f2bf(float x) { return (bf16_t)(pk2(x, 0.f) & 0xffffu); }
DI float bf2f(bf16_t h) { return __uint_as_float(((unsigned)h) << 16); }
DI float sigmoidf_(float x) { return 1.f / (1.f + __expf(-x)); }
DI float gelu_tanh(float x) { const float u = 0.7978845608028654f * (x + 0.044715f * x * x * x); return x / (1.f + __expf(-2.f * u)); }
DI float ex2(float x) { return __builtin_amdgcn_exp2f(x); }
DI f32x16 mfma32(bf16x8 a, bf16x8 b, f32x16 c) { return __builtin_amdgcn_mfma_f32_32x32x16_bf16(a, b, c, 0, 0, 0); }
DI f32x4 mfma16(bf16x8 a, bf16x8 b, f32x4 c) { return __builtin_amdgcn_mfma_f32_16x16x32_bf16(a, b, c, 0, 0, 0); }
DI float rstd_from16(const float* p, float inv_n) {
  const f32x4 a = *(const f32x4*)p, b = *(const f32x4*)(p + 4), c = *(const f32x4*)(p + 8), d = *(const f32x4*)(p + 12);
  const float s = ((a[0] + a[1]) + (a[2] + a[3])) + ((b[0] + b[1]) + (b[2] + b[3])) + ((c[0] + c[1]) + (c[2] + c[3])) + ((d[0] + d[1]) + (d[2] + d[3]));
  return rsqrtf(s * inv_n + EPS_);
}

constexpr int LDT = 72;
template <int MI, int NJ> struct GemmLds { static constexpr int BM = 32 * MI, BN = 64 * NJ, A_ELEMS = BM * LDT, B_ELEMS = BN * LDT, STAGE = A_ELEMS + B_ELEMS; };

template <int MI, int NJ, bool SWAP, class AP, class BP>
DI void gemm_main(f32x4 (&acc)[MI][NJ], const AP& ap, int a_kstep, const BP& bp, int b_kstep, int nk, bf16_t* smem) {
  typedef GemmLds<MI, NJ> L;
  constexpr int CA = MI / 2, CB = NJ;
  const int tid = TIDX(), lane = tid & 63, wid = tid >> 6, wm = wid >> 2, wn = wid & 3, l15 = lane & 15, quad = lane >> 4;
  unsigned pa[CA], pb[CB]; bool oka[CA];
#pragma unroll
  for (int i = 0; i < CA; ++i) { const int c = tid + NTHR * i; pa[i] = ap(c >> 3) + (c & 7) * 8; oka[i] = ap.ok(c >> 3); }
#pragma unroll
  for (int i = 0; i < CB; ++i) { const int c = tid + NTHR * i; pb[i] = bp(c >> 3) + (c & 7) * 8; }
  u32x4 ra[CA], rb[CB];
  auto gload = [&](int kt) {
    const bf16_t* ab = ap.base + (size_t)kt * a_kstep; const bf16_t* bb = bp.base + (size_t)kt * b_kstep;
#pragma unroll
    for (int i = 0; i < CA; ++i) ra[i] = *(const u32x4*)(ab + pa[i]);
#pragma unroll
    for (int i = 0; i < CB; ++i) rb[i] = *(const u32x4*)(bb + pb[i]);
  };
  auto sstore = [&](int buf) {
    bf16_t* As = smem + buf * L::STAGE; bf16_t* Bs = As + L::A_ELEMS;
#pragma unroll
    for (int i = 0; i < CA; ++i) { const int c = tid + NTHR * i; *(u32x4*)(As + (c >> 3) * LDT + (c & 7) * 8) = oka[i] ? ra[i] : (u32x4){0u, 0u, 0u, 0u}; }
#pragma unroll
    for (int i = 0; i < CB; ++i) { const int c = tid + NTHR * i; *(u32x4*)(Bs + (c >> 3) * LDT + (c & 7) * 8) = rb[i]; }
  };
  gload(0); sstore(0); __syncthreads();
#pragma unroll 1
  for (int kt = 0; kt < nk; ++kt) {
    const int buf = kt & 1;
    gload(kt + 1 < nk ? kt + 1 : nk - 1);
    __builtin_amdgcn_sched_barrier(0);
    const bf16_t* As = smem + buf * L::STAGE + (wm * 16 * MI + l15) * LDT + quad * 8;
    const bf16_t* Bs = smem + buf * L::STAGE + L::A_ELEMS + (wn * 16 * NJ + l15) * LDT + quad * 8;
#pragma unroll
    for (int ks = 0; ks < 2; ++ks) {
      if (MI * NJ >= 32 && ks == 1) asm volatile("" ::: "memory");
      bf16x8 b[NJ];
#pragma unroll
      for (int j = 0; j < NJ; ++j) b[j] = *(const bf16x8*)(Bs + j * 16 * LDT + ks * 32);
#pragma unroll
      for (int i = 0; i < MI; ++i) {
        const bf16x8 a = *(const bf16x8*)(As + i * 16 * LDT + ks * 32);
#pragma unroll
        for (int j = 0; j < NJ; ++j) acc[i][j] = SWAP ? mfma16(b[j], a, acc[i][j]) : mfma16(a, b[j], acc[i][j]);
      }
    }
    sstore(buf ^ 1);
    __syncthreads();
  }
}
template <int MI, int NJ> DI void zero_acc(f32x4 (&acc)[MI][NJ]) {
#pragma unroll
  for (int i = 0; i < MI; ++i)
#pragma unroll
    for (int j = 0; j < NJ; ++j) acc[i][j] = (f32x4){0.f, 0.f, 0.f, 0.f};
}
struct RowPtr { const bf16_t* base; size_t ld; DI unsigned operator()(int r) const { return (unsigned)r * (unsigned)ld; } DI bool ok(int) const { return true; } };


template <class F> DI void xcd_tiles(int MPX, int NT, F&& body) {
  const int xcd = blockIdx.x & 7, slot = blockIdx.x >> 3, nslots = gridDim.x >> 3, total = MPX * NT;
  for (int li = slot; li < total; li += nslots) {
    const int mg = li / (8 * NT), rem = li - mg * 8 * NT;
    const int gsz = (MPX - mg * 8) < 8 ? (MPX - mg * 8) : 8;
    const int tn = rem / gsz, mi = rem - tn * gsz;
    body(xcd * MPX + mg * 8 + mi, tn);
  }
}

DI int map_col(int map, int n) {
  if (map == 0) return n;
  if (map == 1) {
    if (n < 896) return n;
    if (n < 1024) return 1024 + (n - 896);
    if (n < 1152) return 896 + (n - 1024);
    if (n < 1280) return n;
    if (n < 2816) return 1304 + (n - 1280);
    if (n < 3200) return 2848 + (n - 2816);
    if (n < 3456) return 3232 + (n - 3200);
    const int c = n - 3456;
    if (c < 24) return 1280 + c;
    if (c < 32) return 2840 + (c - 24);
    if (c < 64) return 3488 + (c - 32);
    return -1;
  }
  if (map == 2) { const int j = n >> 8, c = n & 255; return c < 128 ? j * 128 + c : DFF_ + j * 128 + (c - 128); }
  if (map == 3) { return n < 512 ? (n >> 6) * 128 + (n & 63) : ((n - 512) >> 6) * 128 + 64 + ((n - 512) & 63); }
  return n;
}
struct WJob { const float* src; const float* scale; bf16_t* dst; int K, N, ld, map, off; };
DI void prep_weight_tile(const WJob& j, int tile, float* lds) {
  const int ntn = j.N >> 6, tk = tile / ntn, tn = tile % ntn, tid = TIDX();
  const int n = tn * 64 + (tid & 63); const int sc = map_col(j.map, n);
#pragma unroll 4
  for (int i = 0; i < 8; ++i) {
    const int kk = (tid >> 6) + 8 * i, k = tk * 64 + kk;
    float v = sc >= 0 ? j.src[(size_t)k * j.ld + j.off + sc] : 0.f;
    if (j.scale) v *= j.scale[k];
    lds[kk * 65 + (tid & 63)] = v;
  }
  __syncthreads();
  const int nn = tid >> 3, k0 = (tid & 7) * 8;
  unsigned w[4];
#pragma unroll
  for (int e = 0; e < 4; ++e) w[e] = pk2(lds[(k0 + 2 * e) * 65 + nn], lds[(k0 + 2 * e + 1) * 65 + nn]);
  bf16_t* d = j.dst + (size_t)(tn * 64 + nn) * j.K + tk * 64 + k0;
  *(u32x4*)d = (u32x4){w[0], w[1], w[2], w[3]};
  __syncthreads();
}
DI WJob get_wjob(const Params& p, int layer, int id) {
  bf16_t* wl = (bf16_t*)(p.ws + O_W) + (size_t)layer * W_LAYER; WJob j; j.scale = nullptr; j.map = 0; j.off = 0;
  switch (id) {
    case 0: j.src = p.w_in + (size_t)layer * 1024 * NIN_; j.dst = wl + W_IN; j.K = 1024; j.N = 3584; j.ld = NIN_; j.map = 1; break;
    case 1: j.src = p.w_in + (size_t)layer * 1024 * NIN_; j.dst = wl + W_G; j.K = 1024; j.N = 3072; j.ld = NIN_; j.off = 3520; break;
    case 2: j.src = p.w1_k + (size_t)layer * 2048 * 256; j.dst = wl + W_1K; j.K = 2048; j.N = 256; j.ld = 256; break;
    case 3: j.src = p.w1_v + (size_t)layer * 2048 * 256; j.dst = wl + W_1V; j.K = 2048; j.N = 256; j.ld = 256; break;
    case 4: j.src = p.w2_k + (size_t)layer * 256 * 64; j.dst = wl + W_2K; j.K = 256; j.N = 64; j.ld = 64; break;
    case 5: j.src = p.w2_v + (size_t)layer * 256 * 64; j.dst = wl + W_2V; j.K = 256; j.N = 64; j.ld = 64; break;
    case 6: j.src = p.w_uq + (size_t)layer * 384 * 768; j.dst = wl + W_UQ; j.K = 384; j.N = 768; j.ld = 768; j.scale = p.q_norm + layer * 384; break;
    case 7: j.src = p.w_ukv + (size_t)layer * 256 * 1024; j.dst = wl + W_UKV; j.K = 256; j.N = 1024; j.ld = 1024; j.scale = p.kv_norm + layer * 256; j.map = 3; break;
    case 8: j.src = p.wbr_nsa + (size_t)layer * 512 * 1024; j.dst = wl + W_BN; j.K = 512; j.N = 1024; j.ld = 1024; break;
    case 9: j.src = p.wbr_fox + (size_t)layer * 512 * 1024; j.dst = wl + W_BF; j.K = 512; j.N = 1024; j.ld = 1024; break;
    case 10: j.src = p.wbr_mla + (size_t)layer * 512 * 1024; j.dst = wl + W_BM; j.K = 512; j.N = 1024; j.ld = 1024; break;
    case 11: j.src = p.w_out + (size_t)layer * 1024 * 1024; j.dst = wl + W_OUT; j.K = 1024; j.N = 1024; j.ld = 1024; break;
    case 12: j.src = p.w_up + (size_t)layer * 1024 * 5632; j.dst = wl + W_UP; j.K = 1024; j.N = 5632; j.ld = 5632; j.map = 2; break;
    default: j.src = p.w_down + (size_t)layer * 2816 * 1024; j.dst = wl + W_DN; j.K = 2816; j.N = 1024; j.ld = 1024; break;
  }
  return j;
}
constexpr int WTILES_LAYER = (int)(W_LAYER / 4096);
constexpr int P0_XITEMS = T_ / 64;
constexpr int P0_ROPE_ITEMS = T_ / NTHR;
constexpr int P0_ITEMS = 2 * WTILES_LAYER + 4 + P0_ROPE_ITEMS + P0_XITEMS;

DI void xg_rows(const float* x, const float* g, bf16_t* xg, float* ssq, int row0) {
  const int lane = TIDX() & 63, wid = TIDX() >> 6;
  for (int rr = 0; rr < 8; ++rr) {
    const int t = row0 + wid * 8 + rr; const float* xr = x + (size_t)t * D_; float s = 0.f;
#pragma unroll
    for (int c = 0; c < 4; ++c) {
      const int k = c * 256 + lane * 4; const f32x4 v = *(const f32x4*)(xr + k), gv = *(const f32x4*)(g + k);
      s += v[0] * v[0] + v[1] * v[1] + v[2] * v[2] + v[3] * v[3];
      *(u32x2*)(xg + (size_t)t * D_ + k) = (u32x2){pk2(v[0] * gv[0], v[1] * gv[1]), pk2(v[2] * gv[2], v[3] * gv[3])};
    }
#pragma unroll
    for (int o = 32; o >= 1; o >>= 1) s += __shfl_xor(s, o);
    if (lane < 16) ssq[(size_t)t * 16 + lane] = lane == 0 ? s : 0.f;
  }
}
DI void phase_prep(const Params& p, unsigned char* smem) {
  for (int it = blockIdx.x; it < P0_ITEMS; it += gridDim.x) {
    int i = it;
    if (i < 2 * WTILES_LAYER) {
      const int layer = i / WTILES_LAYER; int t = i % WTILES_LAYER; int id = 0;
      for (;; ++id) { const WJob j = get_wjob(p, layer, id); const int nt = (j.K >> 6) * (j.N >> 6); if (t < nt) { prep_weight_tile(j, t, (float*)smem); break; } t -= nt; }
      continue;
    }
    i -= 2 * WTILES_LAYER;
    if (i < 4) {
      const int layer = i >> 1, kv = i & 1, c = TIDX();
      if (c < 256) {
        const float* pe = (kv ? p.pe_v : p.pe_k) + (size_t)layer * 2048; const float* w1 = (kv ? p.w1_v : p.w1_k) + (size_t)layer * 2048 * 256;
        float s = 0.f;
        for (int kk = 0; kk < 2048; ++kk) s += pe[kk] * w1[(size_t)kk * 256 + c];
        ((float*)(p.ws + O_BIAS1))[(layer * 2 + kv) * 256 + c] = s;
      }
      continue;
    }
    i -= 4;
    if (i < P0_ROPE_ITEMS) {
      const int t = i * NTHR + TIDX(); const float fp = (float)p.pos[t];
      float* r8 = (float*)(p.ws + O_ROPE8) + (size_t)t * 16; float* r16 = (float*)(p.ws + O_ROPE16) + (size_t)t * 32;
      for (int f = 0; f < 24; ++f) {
        const int half = f < 8 ? 8 : 16, idx = f < 8 ? f : f - 8;
        const float inv = exp2f(-(float)idx / (float)half * 18.931568569324174f);
        const float ang = fp * inv;
        const double rev = (double)ang * 0.15915494309189535; const float fr = (float)(rev - floor(rev));
        const float sn = __builtin_amdgcn_sinf(fr), cs = __builtin_amdgcn_cosf(fr);
        if (f < 8) { r8[2 * idx] = cs; r8[2 * idx + 1] = sn; } else { r16[2 * idx] = cs; r16[2 * idx + 1] = sn; }
      }
      continue;
    }
    i -= P0_ROPE_ITEMS;
    xg_rows(p.x, p.mix_norm, (bf16_t*)(p.ws + O_XG), (float*)(p.ws + O_SSQ), i * 64);
  }
}

DI void store4(bf16_t* dst, const f32x4& v, float s) { *(u32x2*)dst = (u32x2){pk2(v[0] * s, v[1] * s), pk2(v[2] * s, v[3] * s)}; }
constexpr int STG_LD = 72, STG_WAVE = 128 * 72;
DI void stage4(bf16_t* stg, int row, int col, const f32x4& v, float s) { *(u32x2*)(stg + row * STG_LD + col) = (u32x2){pk2(v[0] * s, v[1] * s), pk2(v[2] * s, v[3] * s)}; }
template <int ROWS, int COLS, int LD> DI void stage_out(const bf16_t* stg, bf16_t* dst, size_t ld, int lane) {
  asm volatile("s_waitcnt lgkmcnt(0)" ::: "memory");
  constexpr int CPR = COLS / 8, IT = ROWS * CPR / 64;
#pragma unroll
  for (int it = 0; it < IT; ++it) {
    const int idx = it * 64 + lane, r = idx / CPR, c = idx % CPR;
    __builtin_nontemporal_store(*(const u32x4*)(stg + r * LD + c * 8), (u32x4*)(dst + (size_t)r * ld + c * 8));
  }
}
template <bool SWAP> DI void inproj_tile(const Params& p, int layer, int tm, int tn, bf16_t* smem) {
  const bf16_t* wl = (const bf16_t*)(p.ws + O_W) + (size_t)layer * W_LAYER;
  f32x4 acc[8][4]; zero_acc<8, 4>(acc);
  RowPtr ap{(const bf16_t*)(p.ws + O_XG) + (size_t)tm * 256 * D_, (size_t)D_}, bp{wl + W_IN + (size_t)tn * 256 * D_, (size_t)D_};
  gemm_main<8, 4, SWAP>(acc, ap, 64, bp, 64, 16, smem);
  const int lane = TIDX() & 63, wid = TIDX() >> 6, wm = wid >> 2, wn = wid & 3, l15 = lane & 15, quad = lane >> 4;
  const float* ssq = (const float*)(p.ws + O_SSQ);
  bf16_t* stg = smem + wid * STG_WAVE;
  const int trow0 = tm * 256 + wm * 128;
  if constexpr (!SWAP) {
    bf16_t* dst; int hh, hd;
    if (tn == 4) { dst = (bf16_t*)(p.ws + (wn < 2 ? O_VSLCT : O_VWINT)); hh = 2; hd = wn & 1; } else { dst = (bf16_t*)(p.ws + O_FOXVT); hh = 8; hd = (tn - 9) * 4 + wn; }
    constexpr int VLD = 136;
#pragma unroll
    for (int i = 0; i < 8; ++i) {
      const int t0 = trow0 + i * 16 + quad * 4;
      float rs[4];
#pragma unroll
      for (int r = 0; r < 4; ++r) rs[r] = rstd_from16(ssq + (size_t)(t0 + r) * 16, 1.f / 1024.f);
#pragma unroll
      for (int j = 0; j < 4; ++j)
        *(u32x2*)(stg + (j * 16 + l15) * VLD + i * 16 + quad * 4) = (u32x2){pk2(acc[i][j][0] * rs[0], acc[i][j][1] * rs[1]), pk2(acc[i][j][2] * rs[2], acc[i][j][3] * rs[3])};
    }
    const int b = trow0 >> 12, s0 = trow0 & 4095;
    stage_out<64, 128, VLD>(stg, dst + ((size_t)(b * hh + hd) * 64) * S_ + s0, (size_t)S_, lane);
  } else {
    const int slab = tn * 4 + wn;
    if (slab == 54) {
#pragma unroll
      for (int i = 0; i < 8; ++i) {
        const int t = trow0 + i * 16 + l15; const float rs = rstd_from16(ssq + (size_t)t * 16, 1.f / 1024.f);
        float* gt = (float*)(p.ws + O_GATES) + (size_t)t * 24; float* lf = (float*)(p.ws + O_LOGF) + (size_t)t * 8;
#pragma unroll
        for (int r = 0; r < 4; ++r) gt[quad * 4 + r] = sigmoidf_(acc[i][0][r] * rs);
        if (quad < 2) {
#pragma unroll
          for (int r = 0; r < 4; ++r) gt[16 + quad * 4 + r] = sigmoidf_(acc[i][1][r] * rs);
        } else {
#pragma unroll
          for (int r = 0; r < 4; ++r) { const int h = (quad - 2) * 4 + r; const float xx = acc[i][1][r] * rs + p.b_forget[layer * 8 + h]; lf[h] = fminf(xx, 0.f) - log1pf(__expf(-fabsf(xx))); }
        }
        const float* rp = (const float*)(p.ws + O_ROPE16) + (size_t)t * 32 + quad * 8; float o1[4], o2[4];
#pragma unroll
        for (int r = 0; r < 4; ++r) { const float cs = rp[2 * r], sn = rp[2 * r + 1], x1 = acc[i][2][r] * rs, x2 = acc[i][3][r] * rs; o1[r] = x1 * cs - x2 * sn; o2[r] = x2 * cs + x1 * sn; }
        bf16_t* kp = (bf16_t*)(p.ws + O_MLAKPE) + (size_t)t * 32 + quad * 4;
        *(u32x2*)kp = (u32x2){pk2(o1[0], o1[1]), pk2(o1[2], o1[3])}; *(u32x2*)(kp + 16) = (u32x2){pk2(o2[0], o2[1]), pk2(o2[2], o2[3])};
      }
    } else if (slab != 55) {
      bf16_t* dbuf; int dld, dcol, kind = 0; float qs = 1.f; int cslot = 0;
      if (slab < 8) { dbuf = (bf16_t*)(p.ws + O_NSAQ); dld = 512; dcol = slab * 64; qs = QS64_; }
      else if (slab < 12) { dbuf = (bf16_t*)(p.ws + O_KVCMP); dld = 256; dcol = (slab - 8) * 64; }
      else if (slab < 16) { dbuf = (bf16_t*)(p.ws + (slab < 14 ? O_KSLC : O_KWIN)); dld = 128; dcol = (slab & 1) * 64; kind = 1; }
      else if (slab < 28) { dbuf = (bf16_t*)(p.ws + O_FOXQ); dld = 512; dcol = (slab - 20) * 64; qs = QS64_; }
      else if (slab < 36) { dbuf = (bf16_t*)(p.ws + O_FOXK); dld = 512; dcol = (slab - 28) * 64; }
      else if (slab < 50) { dbuf = (bf16_t*)(p.ws + O_CQ); dld = 384; dcol = (slab - 44) * 64; kind = 2; cslot = slab - 44; }
      else { dbuf = (bf16_t*)(p.ws + O_CKV); dld = 256; dcol = (slab - 50) * 64; kind = 2; cslot = 8 + slab - 50; }
#pragma unroll
      for (int i = 0; i < 8; ++i) {
        const int row = i * 16 + l15, t = trow0 + row; const float rs = rstd_from16(ssq + (size_t)t * 16, 1.f / 1024.f) * qs;
        if (kind == 1) {
          const float* rp = (const float*)(p.ws + O_ROPE8) + (size_t)t * 16 + (quad & 1) * 8;
          f32x4 v, o;
#pragma unroll
          for (int r = 0; r < 4; ++r) { v[r] = acc[i][0][r] * rs; o[r] = __shfl_xor(v[r], 32); }
#pragma unroll
          for (int r = 0; r < 4; ++r) { const float cs = rp[2 * r], sn = rp[2 * r + 1]; v[r] = quad < 2 ? v[r] * cs - o[r] * sn : v[r] * cs + o[r] * sn; }
          stage4(stg, row, quad * 4, v, 1.f);
        } else stage4(stg, row, quad * 4, acc[i][0], rs);
#pragma unroll
        for (int j = 1; j < 4; ++j) stage4(stg, row, j * 16 + quad * 4, acc[i][j], rs);
        if (kind == 2) {
          float s = 0.f;
#pragma unroll
          for (int j = 0; j < 4; ++j) { const f32x4 a = acc[i][j] * rs; s += a[0] * a[0] + a[1] * a[1] + a[2] * a[2] + a[3] * a[3]; }
          s += __shfl_xor(s, 16); s += __shfl_xor(s, 32);
          if (quad == 0) ((float*)(p.ws + O_CSSQ))[(size_t)t * 16 + cslot] = s;
        }
      }
      stage_out<128, 64, STG_LD>(stg, dbuf + (size_t)trow0 * dld + dcol, (size_t)dld, lane);
    }
  }
  __syncthreads();
}
DI void phase_inproj(const Params& p, int layer, unsigned char* smem) {
  xcd_tiles(16, 14, [&](int tm, int tn) {
    const bool vt = (tn == 4 || tn == 9 || tn == 10);
    if (vt) inproj_tile<false>(p, layer, tm, tn, (bf16_t*)smem); else inproj_tile<true>(p, layer, tm, tn, (bf16_t*)smem);
  });
}

template <int KIND> DI void mlaup_tile(const Params& p, int layer, int tm, int tn, bf16_t* smem) {
  const bf16_t* wl = (const bf16_t*)(p.ws + O_W) + (size_t)layer * W_LAYER;
  f32x4 acc[8][4]; zero_acc<8, 4>(acc);
  constexpr int K = KIND == 0 ? 384 : 256;
  RowPtr ap{KIND == 0 ? (const bf16_t*)(p.ws + O_CQ) + (size_t)tm * 256 * 384 : (const bf16_t*)(p.ws + O_CKV) + (size_t)tm * 256 * 256, (size_t)K};
  RowPtr bp{KIND == 0 ? wl + W_UQ + (size_t)tn * 256 * 384 : wl + W_UKV + (size_t)(tn - 3) * 256 * 256, (size_t)K};
  gemm_main<8, 4, KIND != 2>(acc, ap, 64, bp, 64, K / 64, smem);
  const int lane = TIDX() & 63, wid = TIDX() >> 6, wm = wid >> 2, wn = wid & 3, l15 = lane & 15, quad = lane >> 4;
  const float* cssq = (const float*)(p.ws + O_CSSQ);
  if constexpr (KIND == 2) {
    bf16_t* dst = (bf16_t*)(p.ws + O_MLAVT); const int h = (tn - 5) * 4 + wn;
#pragma unroll
    for (int i = 0; i < 8; ++i) {
      asm volatile("" ::: "memory");
      const int t0 = tm * 256 + wm * 128 + i * 16 + quad * 4; const int b = t0 >> 12, s = t0 & 4095; float rs[4];
#pragma unroll
      for (int r = 0; r < 4; ++r) { const float* c = cssq + (size_t)(t0 + r) * 16 + 8; rs[r] = rsqrtf((c[0] + c[1] + c[2] + c[3]) * (1.f / 256.f) + EPS_); }
#pragma unroll
      for (int j = 0; j < 4; ++j) {
        const int d = j * 16 + l15;
        *(u32x2*)(dst + ((size_t)(b * 8 + h) * 64 + d) * S_ + s) = (u32x2){pk2(acc[i][j][0] * rs[0], acc[i][j][1] * rs[1]), pk2(acc[i][j][2] * rs[2], acc[i][j][3] * rs[3])};
      }
    }
  } else if constexpr (KIND == 1) {
#pragma unroll
    for (int i = 0; i < 8; ++i) {
      asm volatile("" ::: "memory");
      const int t = tm * 256 + wm * 128 + i * 16 + l15; const float* c = cssq + (size_t)t * 16;
      const float rs = rsqrtf((c[8] + c[9] + c[10] + c[11]) * (1.f / 256.f) + EPS_);
      bf16_t* dst = (bf16_t*)(p.ws + O_MLAKN) + (size_t)t * 512 + (tn - 3) * 256 + wn * 64 + quad * 4;
#pragma unroll
      for (int j = 0; j < 4; ++j) store4(dst + j * 16, acc[i][j], rs);
    }
  } else {
    const int n0 = tn * 256 + wn * 64, ph = n0 % 96;
#pragma unroll
    for (int i = 0; i < 8; ++i) {
      asm volatile("" ::: "memory");
      const int t = tm * 256 + wm * 128 + i * 16 + l15; const float* c = cssq + (size_t)t * 16;
      const float rs = rsqrtf((c[0] + c[1] + c[2] + c[3] + c[4] + c[5]) * (1.f / 384.f) + EPS_) * QS96_;
      bf16_t* dst = (bf16_t*)(p.ws + O_MLAQ) + (size_t)t * 768 + n0 + quad * 4;
      f32x4 v0 = acc[i][0] * rs, v1 = acc[i][1] * rs, v2 = acc[i][2] * rs, v3 = acc[i][3] * rs;
      if (ph != 0) {
        const float* rp = (const float*)(p.ws + O_ROPE16) + (size_t)t * 32 + quad * 8;
        const f32x4 x1 = ph == 64 ? v0 : v2, x2 = ph == 64 ? v1 : v3; f32x4 o1, o2;
#pragma unroll
        for (int r = 0; r < 4; ++r) { const float cs = rp[2 * r], sn = rp[2 * r + 1]; o1[r] = x1[r] * cs - x2[r] * sn; o2[r] = x2[r] * cs + x1[r] * sn; }
        if (ph == 64) { v0 = o1; v1 = o2; } else { v2 = o1; v3 = o2; }
      }
      store4(dst, v0, 1.f); store4(dst + 16, v1, 1.f); store4(dst + 32, v2, 1.f); store4(dst + 48, v3, 1.f);
    }
  }
}
struct CmpRowPtr { const bf16_t* base; int r0;
  DI unsigned operator()(int r) const { int R = r0 + r; if (R >= 4080) R = 0; const int b = R / 510, rem = R - b * 510, n = rem >> 1, g = rem & 1; return (unsigned)(b * S_ + 16 * n) * 256u + g * 64; }
  DI bool ok(int r) const { return r0 + r < 4080; } };
DI void compress_item(const Params& p, int layer, int item, bf16_t* smem) {
  const int kv = item >> 4, tm = item & 15;
  const bf16_t* wl = (const bf16_t*)(p.ws + O_W) + (size_t)layer * W_LAYER;
  f32x4 acc[8][4]; zero_acc<8, 4>(acc);
  CmpRowPtr ap{(const bf16_t*)(p.ws + O_KVCMP) + kv * 128, tm * 256};
  RowPtr bp{wl + (kv ? W_1V : W_1K), (size_t)2048};
  gemm_main<8, 4, true>(acc, ap, 256, bp, 64, 32, smem);
  const int lane = TIDX() & 63, wid = TIDX() >> 6, wm = wid >> 2, wn = wid & 3, l15 = lane & 15, quad = lane >> 4;
  constexpr int LDH = 264; bf16_t* H = smem;
  const float* b1 = (const float*)(p.ws + O_BIAS1) + (layer * 2 + kv) * 256;
#pragma unroll
  for (int i = 0; i < 8; ++i)
#pragma unroll
    for (int j = 0; j < 4; ++j) {
      const int row = wm * 128 + i * 16 + l15, col = wn * 64 + j * 16 + quad * 4; const f32x4 bv = *(const f32x4*)(b1 + col);
      *(u32x2*)(H + row * LDH + col) = (u32x2){pk2(gelu_tanh(acc[i][j][0] + bv[0]), gelu_tanh(acc[i][j][1] + bv[1])), pk2(gelu_tanh(acc[i][j][2] + bv[2]), gelu_tanh(acc[i][j][3] + bv[3]))};
    }
  __syncthreads();
  f32x4 a2[2][4];
#pragma unroll
  for (int i = 0; i < 2; ++i)
#pragma unroll
    for (int j = 0; j < 4; ++j) a2[i][j] = (f32x4){0.f, 0.f, 0.f, 0.f};
  const bf16_t* w2 = wl + (kv ? W_2V : W_2K);
#pragma unroll
  for (int ks = 0; ks < 8; ++ks) {
    bf16x8 a[2], b[4];
#pragma unroll
    for (int i = 0; i < 2; ++i) a[i] = *(const bf16x8*)(H + (wid * 32 + i * 16 + l15) * LDH + ks * 32 + quad * 8);
#pragma unroll
    for (int j = 0; j < 4; ++j) b[j] = *(const bf16x8*)(w2 + (size_t)(j * 16 + l15) * 256 + ks * 32 + quad * 8);
#pragma unroll
    for (int i = 0; i < 2; ++i)
#pragma unroll
      for (int j = 0; j < 4; ++j) a2[i][j] = mfma16(a[i], b[j], a2[i][j]);
  }
  bf16_t* kc = (bf16_t*)(p.ws + O_KC); bf16_t* vct = (bf16_t*)(p.ws + O_VCT);
#pragma unroll
  for (int i = 0; i < 2; ++i)
#pragma unroll
    for (int r = 0; r < 4; ++r) {
      const int R = tm * 256 + wid * 32 + i * 16 + quad * 4 + r;
      if (R < 4080) {
        const int b = R / 510, rem = R - b * 510, n = rem >> 1, g = rem & 1;
#pragma unroll
        for (int j = 0; j < 4; ++j) {
          const int d = j * 16 + l15; const bf16_t v = f2bf(a2[i][j][r]);
          if (kv == 0) kc[((size_t)(b * 2 + g) * 256 + n) * 64 + d] = v; else vct[((size_t)(b * 2 + g) * 64 + d) * 256 + n] = v;
        }
      }
    }
  __syncthreads();
}
DI void foxscan_item(const Params& p, int item, float* lds) {
  const int b = item >> 3, h = item & 7, tid = TIDX();
  const float* lf = (const float*)(p.ws + O_LOGF) + (size_t)b * S_ * 8 + h; float v[8]; float s = 0.f;
#pragma unroll
  for (int i = 0; i < 8; ++i) { s += lf[(size_t)(tid * 8 + i) * 8]; v[i] = s; }
  lds[tid] = s; __syncthreads();
  float off = 0.f;
  for (int i = 0; i < tid; ++i) off += lds[i];
  float* F2 = (float*)(p.ws + O_F2) + (size_t)(b * 8 + h) * S_ + tid * 8;
#pragma unroll
  for (int i = 0; i < 8; ++i) F2[i] = -(off + v[i]) * LOG2E_;
  __syncthreads();
}
DI void phase_b(const Params& p, int layer, unsigned char* smem) {
  for (int it = blockIdx.x; it < 96; it += gridDim.x) {
    if (it < 32) compress_item(p, layer, it, (bf16_t*)smem);
    else foxscan_item(p, it - 32, (float*)smem);
  }
  xcd_tiles(16, 7, [&](int tm, int tn) {
    if (tn >= 5) mlaup_tile<2>(p, layer, tm, tn, (bf16_t*)smem); else if (tn >= 3) mlaup_tile<1>(p, layer, tm, tn, (bf16_t*)smem); else mlaup_tile<0>(p, layer, tm, tn, (bf16_t*)smem);
  });
}

constexpr int KC_LD = 72, VC_LD = 264;
DI void cmp_item(const Params& p, int item, unsigned char* smem_) {
  const int b = item >> 6, g = (item >> 5) & 1, tt = item & 31, t0 = tt * 128;
  const int tid = TIDX(), lane = tid & 63, wid = tid >> 6, l15 = lane & 15, quad = lane >> 4;
  bf16_t* kcs = (bf16_t*)smem_;
  bf16_t* vcs = kcs + 256 * KC_LD;
  float* imps = (float*)smem_;
  const int nmax = (t0 + 96) >> 4;
  const int nsub = (nmax >> 4) + 1;
  {
    const bf16_t* kcg = (const bf16_t*)(p.ws + O_KC) + (size_t)(b * 2 + g) * 256 * 64; const bf16_t* vcg = (const bf16_t*)(p.ws + O_VCT) + (size_t)(b * 2 + g) * 64 * 256;
    const int nrows = ((nsub + 1) & ~1) * 16;
    for (int e = tid; e < nrows * 8; e += NTHR) {
      const int n = e >> 3, dc = (e & 7) * 8;
      *(u32x4*)(kcs + n * KC_LD + dc) = n < 255 ? *(const u32x4*)(kcg + (size_t)n * 64 + dc) : (u32x4){0u, 0u, 0u, 0u};
    }
    const int ncs = nrows >> 3;
    for (int e = tid; e < 64 * ncs; e += NTHR) {
      const int d = e / ncs, nc = (e - d * ncs) * 8;
      u32x4 v = *(const u32x4*)(vcg + (size_t)d * 256 + nc);
      if (nc + 8 > 255) v[3] &= 0x0000ffffu;
      *(u32x4*)(vcs + d * VC_LD + nc) = v;
    }
  }
  __syncthreads();
  const int tq = t0 + wid * 16 + l15;
  const size_t trow = (size_t)b * S_ + tq;
  float impa[16], p3a[16];
#pragma unroll
  for (int s = 0; s < 16; ++s) { impa[s] = 0.f; p3a[s] = 0.f; }
  const float* gts = (const float*)(p.ws + O_GATES) + trow * 24;
#pragma unroll 1
  for (int r4 = 0; r4 < 4; ++r4) {
    const int head = g * 4 + r4;
    const bf16_t* qp = (const bf16_t*)(p.ws + O_NSAQ) + trow * 512 + head * 64 + quad * 8;
    const bf16x8 q0 = *(const bf16x8*)qp, q1 = *(const bf16x8*)(qp + 32);
    auto score = [&](int s) -> f32x4 {
      const bf16_t* kr = kcs + (s * 16 + l15) * KC_LD + quad * 8;
      f32x4 a = {0.f, 0.f, 0.f, 0.f};
      a = mfma16(*(const bf16x8*)kr, q0, a); a = mfma16(*(const bf16x8*)(kr + 32), q1, a);
#pragma unroll
      for (int r = 0; r < 4; ++r) { const int n = s * 16 + quad * 4 + r; a[r] = (16 * n + 31 <= tq) ? a[r] : -INFINITY; }
      return a;
    };
    float mx = -INFINITY;
#pragma unroll 1
    for (int s = 0; s < nsub; ++s) { const f32x4 a = score(s); mx = fmaxf(mx, fmaxf(fmaxf(a[0], a[1]), fmaxf(a[2], a[3]))); }
    mx = fmaxf(mx, __shfl_xor(mx, 16)); mx = fmaxf(mx, __shfl_xor(mx, 32));
    if (mx == -INFINITY) mx = 0.f;
    float sum = 0.f;
#pragma unroll 1
    for (int s = 0; s < nsub; ++s) { const f32x4 a = score(s); sum += (ex2(a[0] - mx) + ex2(a[1] - mx)) + (ex2(a[2] - mx) + ex2(a[3] - mx)); }
    sum += __shfl_xor(sum, 16); sum += __shfl_xor(sum, 32);
    const float inv = 1.f / fmaxf(sum, 1e-30f);
    f32x4 oacc[4];
#pragma unroll
    for (int j = 0; j < 4; ++j) oacc[j] = (f32x4){0.f, 0.f, 0.f, 0.f};
#pragma unroll
    for (int c = 0; c < 8; ++c) {
      asm volatile("" ::: "memory");
      if (2 * c < nsub) {
        f32x4 pa = score(2 * c), pb = {-INFINITY, -INFINITY, -INFINITY, -INFINITY};
        if (2 * c + 1 < nsub) pb = score(2 * c + 1);
#pragma unroll
        for (int r = 0; r < 4; ++r) { pa[r] = ex2(pa[r] - mx) * inv; pb[r] = ex2(pb[r] - mx) * inv; }
        impa[2 * c] += pa[0] + pa[1] + pa[2] + 0.5f * pa[3]; p3a[2 * c] += pa[3];
        impa[2 * c + 1] += pb[0] + pb[1] + pb[2] + 0.5f * pb[3]; p3a[2 * c + 1] += pb[3];
        const u32x4 pw = {pk2(pa[0], pa[1]), pk2(pa[2], pa[3]), pk2(pb[0], pb[1]), pk2(pb[2], pb[3])};
        const bf16x8 pf = __builtin_bit_cast(bf16x8, pw);
#pragma unroll
        for (int j = 0; j < 4; ++j) {
          const bf16_t* vr = vcs + (j * 16 + l15) * VC_LD + c * 32 + quad * 4;
          const u32x2 lo = *(const u32x2*)vr, hi = *(const u32x2*)(vr + 16);
          const u32x4 vw = {lo[0], lo[1], hi[0], hi[1]};
          oacc[j] = mfma16(__builtin_bit_cast(bf16x8, vw), pf, oacc[j]);
        }
      }
    }
    const float g0 = gts[head * 3 + 0];
    bf16_t* op = (bf16_t*)(p.ws + O_ONSA) + trow * 512 + head * 64 + quad * 4;
#pragma unroll
    for (int j = 0; j < 4; ++j) store4(op + j * 16, oacc[j], g0);
  }
  __syncthreads();
  float* myimp = imps + wid * 1024 + l15 * 64;
  const int cur = tq >> 6;
#pragma unroll
  for (int s = 0; s < 16; ++s) {
    const float up = __shfl(p3a[s], (lane + 48) & 63);
    const float up0 = s ? __shfl(p3a[s ? s - 1 : 0], (lane + 48) & 63) : 0.f;
    const float prev = quad ? up : up0;
    float v = impa[s] + 0.5f * prev;
    const int j = 4 * s + quad;
    if (j == 0 || j == cur || j == cur - 1) v = 1e9f; else if (j > cur) v = -1e9f;
    myimp[j] = v;
  }
  __syncthreads();
  u64* sel = (u64*)(p.ws + O_SEL) + (size_t)(b * 2 + g) * S_ + t0 + wid * 16;
#pragma unroll 1
  for (int q = 0; q < 16; ++q) {
    const float mine = imps[wid * 1024 + q * 64 + lane]; int rank = 0;
#pragma unroll
    for (int i = 0; i < 64; ++i) { const float v = __uint_as_float(__builtin_amdgcn_readlane(__float_as_uint(mine), i)); rank += (v > mine || (v == mine && i < lane)) ? 1 : 0; }
    const u64 m = __ballot(rank < 16);
    if (lane == 0) sel[q] = m;
  }
  __syncthreads();
}
constexpr int PC_ITEMS = NB_ * 2 * 32;
DI void phase_c(const Params& p, unsigned char* smem) { for (int it = blockIdx.x; it < PC_ITEMS; it += gridDim.x) cmp_item(p, it, smem); }

enum { M_FOX = 0, M_MLA = 1, M_WIN = 2, M_SLC = 3 };
template <int MODE> struct ACfg { static constexpr int DQK = MODE == M_MLA ? 96 : 64, KLD = DQK + 8, NKC = DQK / 8 * 64, KCH = (NKC + NTHR - 1) / NTHR, K_ELEMS = 64 * KLD, V_ELEMS = 64 * 72, STAGE = K_ELEMS + V_ELEMS + 128; };
struct AState { f32x16 o[2]; float m, l; };

template <int MODE>
DI void flash_pass(AState& st, const bf16x8* qf, u64 tmask, u64 wmask,
                   const bf16_t* kbase, size_t kld, const bf16_t* kpe, const bf16_t* vtbase, const float* fbias,
                   int tq, u64 mysel, bf16_t* smem) {
  typedef ACfg<MODE> C;
  const int tid = TIDX(), lane = tid & 63, l31 = lane & 31, half = lane >> 5;
  u32x4 rk[C::KCH], rv; float rf = 0.f;
  auto gload = [&](int j) {
    const int k0 = j * 64;
#pragma unroll
    for (int i = 0; i < C::KCH; ++i) {
      const int c = tid + NTHR * i;
      if (c < C::NKC) {
        if constexpr (MODE == M_MLA) { const int key = c / 12, dc = c % 12; rk[i] = dc < 8 ? *(const u32x4*)(kbase + (size_t)(k0 + key) * kld + dc * 8) : *(const u32x4*)(kpe + (size_t)(k0 + key) * 32 + (dc - 8) * 8); }
        else { const int key = c >> 3, dc = c & 7; rk[i] = *(const u32x4*)(kbase + (size_t)(k0 + key) * kld + dc * 8); }
      }
    }
    { const int d = tid >> 3, kc = tid & 7; rv = *(const u32x4*)(vtbase + (size_t)d * S_ + k0 + kc * 8); }
    if constexpr (MODE == M_FOX) { if (tid < 64) rf = fbias[k0 + tid]; }
  };
  auto sstore = [&](int buf) {
    bf16_t* Ks = smem + buf * C::STAGE; bf16_t* Vs = Ks + C::K_ELEMS;
#pragma unroll
    for (int i = 0; i < C::KCH; ++i) {
      const int c = tid + NTHR * i;
      if (c < C::NKC) {
        if constexpr (MODE == M_MLA) { const int key = c / 12, dc = c % 12; *(u32x4*)(Ks + key * C::KLD + dc * 8) = rk[i]; }
        else { const int key = c >> 3, dc = c & 7; *(u32x4*)(Ks + key * C::KLD + dc * 8) = rk[i]; }
      }
    }
    {
      const int d = tid >> 3, kc = tid & 7, cgp = kc >> 1, a = kc & 1;
      bf16_t* dst = Vs + d * 72 + cgp * 16 + 4 * a;
      *(u32x2*)dst = (u32x2){rv[0], rv[1]}; *(u32x2*)(dst + 8) = (u32x2){rv[2], rv[3]};
    }
    if constexpr (MODE == M_FOX) { if (tid < 64) ((float*)(Vs + C::V_ELEMS))[tid] = rf; }
  };
  u64 tm = tmask;
  if (tm == 0) return;
  int j = __builtin_ctzll(tm); tm &= tm - 1;
  gload(j); sstore(0); __syncthreads();
  int buf = 0;
  const int tmin = __builtin_amdgcn_readfirstlane(tq - l31), tmax = tmin + 31;
  while (true) {
    const int jn = tm ? __builtin_ctzll(tm) : -1; if (tm) tm &= tm - 1;
    if (jn >= 0) gload(jn);
    bool active = (wmask >> j) & 1;
    if constexpr (MODE == M_SLC) active = active && __any((mysel >> j) & 1);
    if (active) {
      const bf16_t* Ks = smem + buf * C::STAGE; const bf16_t* Vs = Ks + C::K_ELEMS;
      f32x16 s0, s1;
#pragma unroll
      for (int r = 0; r < 16; ++r) { s0[r] = 0.f; s1[r] = 0.f; }
      const bf16_t* kr = Ks + l31 * C::KLD + half * 8;
#pragma unroll
      for (int ks = 0; ks < C::DQK / 16; ++ks) {
        s0 = mfma32(*(const bf16x8*)(kr + ks * 16), qf[ks], s0);
        s1 = mfma32(*(const bf16x8*)(kr + 32 * C::KLD + ks * 16), qf[ks], s1);
      }
      const int k0 = j * 64;
      if constexpr (MODE == M_FOX) {
        const float* fb = (const float*)(Vs + C::V_ELEMS) + 4 * half;
#pragma unroll
        for (int g4 = 0; g4 < 4; ++g4) {
          const f32x4 b0 = *(const f32x4*)(fb + 8 * g4), b1 = *(const f32x4*)(fb + 32 + 8 * g4);
#pragma unroll
          for (int r = 0; r < 4; ++r) { s0[4 * g4 + r] += b0[r]; s1[4 * g4 + r] += b1[r]; }
        }
      }
      bool need = k0 + 63 > tmin;
      if constexpr (MODE == M_WIN) need = need || (k0 <= tmax - 512);
      if constexpr (MODE == M_SLC) {
        if (!need) {
          const bool rsel = ((mysel >> j) & 1) != 0;
          if (!__all(rsel)) {
#pragma unroll
            for (int r = 0; r < 16; ++r) { s0[r] = rsel ? s0[r] : -INFINITY; s1[r] = rsel ? s1[r] : -INFINITY; }
          }
        }
      }
      if (need) {
        const bool rowok = MODE == M_SLC ? ((mysel >> j) & 1) != 0 : true;
#pragma unroll
        for (int r = 0; r < 16; ++r) {
          const int key = k0 + (r & 3) + 8 * (r >> 2) + 4 * half;
          bool ok0 = rowok && key <= tq, ok1 = rowok && key + 32 <= tq;
          if constexpr (MODE == M_WIN) { ok0 = ok0 && (tq - key < 512); ok1 = ok1 && (tq - key - 32 < 512); }
          s0[r] = ok0 ? s0[r] : -INFINITY; s1[r] = ok1 ? s1[r] : -INFINITY;
        }
      }
      float mx = -INFINITY;
#pragma unroll
      for (int r = 0; r < 16; ++r) mx = fmaxf(mx, fmaxf(s0[r], s1[r]));
      mx = fmaxf(mx, __shfl_xor(mx, 32));
      const float mn = fmaxf(st.m, mx), alpha = ex2(st.m - mn);
      st.m = mn;
      float sum = 0.f;
#pragma unroll
      for (int r = 0; r < 16; ++r) { s0[r] = ex2(s0[r] - mn); s1[r] = ex2(s1[r] - mn); sum += s0[r] + s1[r]; }
      st.l = st.l * alpha + sum;
#pragma unroll
      for (int r = 0; r < 16; ++r) { st.o[0][r] *= alpha; st.o[1][r] *= alpha; }
      const bf16_t* vr = Vs + l31 * 72 + half * 8;
#pragma unroll
      for (int c = 0; c < 4; ++c) {
        u32x4 pw;
        if (c < 2) pw = (u32x4){pk2(s0[8 * c + 0], s0[8 * c + 1]), pk2(s0[8 * c + 2], s0[8 * c + 3]), pk2(s0[8 * c + 4], s0[8 * c + 5]), pk2(s0[8 * c + 6], s0[8 * c + 7])};
        else pw = (u32x4){pk2(s1[8 * (c - 2) + 0], s1[8 * (c - 2) + 1]), pk2(s1[8 * (c - 2) + 2], s1[8 * (c - 2) + 3]), pk2(s1[8 * (c - 2) + 4], s1[8 * (c - 2) + 5]), pk2(s1[8 * (c - 2) + 6], s1[8 * (c - 2) + 7])};
        const bf16x8 pf = __builtin_bit_cast(bf16x8, pw);
        st.o[0] = mfma32(*(const bf16x8*)(vr + c * 16), pf, st.o[0]);
        st.o[1] = mfma32(*(const bf16x8*)(vr + 32 * 72 + c * 16), pf, st.o[1]);
      }
    }
    if (jn >= 0) sstore(buf ^ 1);
    __syncthreads();
    if (jn < 0) break;
    j = jn; buf ^= 1;
  }
}
DI void astate_init(AState& s) {
#pragma unroll
  for (int r = 0; r < 16; ++r) { s.o[0][r] = 0.f; s.o[1][r] = 0.f; }
  s.m = -1e30f; s.l = 0.f;
}
DI u64 lowbits(int n) { return n >= 64 ? ~0ull : ((1ull << n) - 1ull); }

template <int MODE> DI void dense_attn_item(const Params& p, int b, int h, int qt, bf16_t* smem) {
  const int lane = TIDX() & 63, wid = TIDX() >> 6, l31 = lane & 31, half = lane >> 5;
  const int t0 = qt * 256, tq = t0 + wid * 32 + l31; const size_t trow = (size_t)b * S_ + tq;
  constexpr int NQ = ACfg<MODE>::DQK / 16;
  bf16x8 qf[NQ];
  const bf16_t* qp = MODE == M_FOX ? (const bf16_t*)(p.ws + O_FOXQ) + trow * 512 + h * 64 : (const bf16_t*)(p.ws + O_MLAQ) + trow * 768 + h * 96;
#pragma unroll
  for (int ks = 0; ks < NQ; ++ks) qf[ks] = *(const bf16x8*)(qp + ks * 16 + half * 8);
  AState st; astate_init(st);
  const u64 tmask = lowbits(4 * qt + 4), wmask = lowbits(((t0 + wid * 32 + 31) >> 6) + 1);
  if constexpr (MODE == M_FOX)
    flash_pass<M_FOX>(st, qf, tmask, wmask, (const bf16_t*)(p.ws + O_FOXK) + (size_t)b * S_ * 512 + h * 64, 512, nullptr,
                      (const bf16_t*)(p.ws + O_FOXVT) + (size_t)(b * 8 + h) * 64 * S_, (const float*)(p.ws + O_F2) + (size_t)(b * 8 + h) * S_, tq, 0ull, smem);
  else
    flash_pass<M_MLA>(st, qf, tmask, wmask, (const bf16_t*)(p.ws + O_MLAKN) + (size_t)b * S_ * 512 + h * 64, 512, (const bf16_t*)(p.ws + O_MLAKPE) + (size_t)b * S_ * 32,
                      (const bf16_t*)(p.ws + O_MLAVT) + (size_t)(b * 8 + h) * 64 * S_, nullptr, tq, 0ull, smem);
  const float l = st.l + __shfl_xor(st.l, 32), inv = 1.f / fmaxf(l, 1e-30f);
  bf16_t* op = (bf16_t*)qp;
#pragma unroll
  for (int dt = 0; dt < 2; ++dt)
#pragma unroll
    for (int g4 = 0; g4 < 4; ++g4) {
      const int d = dt * 32 + g4 * 8 + half * 4;
      *(u32x2*)(op + d) = (u32x2){pk2(st.o[dt][4 * g4] * inv, st.o[dt][4 * g4 + 1] * inv), pk2(st.o[dt][4 * g4 + 2] * inv, st.o[dt][4 * g4 + 3] * inv)};
    }
}
DI void nsa_attn_item(const Params& p, int b, int g, int qt, bf16_t* smem) {
  const int lane = TIDX() & 63, wid = TIDX() >> 6, l31 = lane & 31, half = lane >> 5;
  const int t0 = qt * 64, tw0 = t0 + (wid >> 2) * 32, tq = tw0 + l31, head = g * 4 + (wid & 3); const size_t trow = (size_t)b * S_ + tq;
  bf16x8 qf[4];
  const bf16_t* qp = (const bf16_t*)(p.ws + O_NSAQ) + trow * 512 + head * 64;
#pragma unroll
  for (int ks = 0; ks < 4; ++ks) qf[ks] = *(const bf16x8*)(qp + ks * 16 + half * 8);
  {
    const float* rp = (const float*)(p.ws + O_ROPE8) + trow * 16;
    u32x4 me = __builtin_bit_cast(u32x4, qf[0]), ot;
#pragma unroll
    for (int e = 0; e < 4; ++e) ot[e] = __shfl_xor(me[e], 32);
    unsigned res[4];
#pragma unroll
    for (int e = 0; e < 4; ++e) {
      float o2[2];
#pragma unroll
      for (int u = 0; u < 2; ++u) {
        const int f = 2 * e + u; const float cs = rp[2 * f], sn = rp[2 * f + 1];
        const float a = bf2f((bf16_t)(u ? me[e] >> 16 : me[e] & 0xffffu)), o = bf2f((bf16_t)(u ? ot[e] >> 16 : ot[e] & 0xffffu));
        o2[u] = half == 0 ? a * cs - o * sn : a * cs + o * sn;
      }
      res[e] = pk2(o2[0], o2[1]);
    }
    qf[0] = __builtin_bit_cast(bf16x8, (u32x4){res[0], res[1], res[2], res[3]});
  }
  const float* gts = (const float*)(p.ws + O_GATES) + trow * 24 + head * 3;
  const int cur = t0 >> 6;
  f32x16 res[2];
  {
    AState st; astate_init(st);
    const int first = t0 >= 511 ? (t0 - 511) >> 6 : 0, firstw = tw0 >= 511 ? (tw0 - 511) >> 6 : 0;
    const u64 tmask = lowbits(cur + 1) & ~lowbits(first), wmask = lowbits(cur + 1) & ~lowbits(firstw);
    flash_pass<M_WIN>(st, qf, tmask, wmask, (const bf16_t*)(p.ws + O_KWIN) + (size_t)b * S_ * 128 + g * 64, 128, nullptr,
                      (const bf16_t*)(p.ws + O_VWINT) + (size_t)(b * 2 + g) * 64 * S_, nullptr, tq, 0ull, smem);
    const float l = st.l + __shfl_xor(st.l, 32), sc = gts[2] / fmaxf(l, 1e-30f);
#pragma unroll
    for (int r = 0; r < 16; ++r) { res[0][r] = st.o[0][r] * sc; res[1][r] = st.o[1][r] * sc; }
  }
  {
    AState st; astate_init(st);
    const u64* selp = (const u64*)(p.ws + O_SEL) + (size_t)(b * 2 + g) * S_;
    const u64 mysel = selp[tq];
    const u64 m64 = selp[t0 + lane];
    unsigned lo = (unsigned)m64, hi = (unsigned)(m64 >> 32);
#pragma unroll
    for (int o = 32; o >= 1; o >>= 1) { lo |= __shfl_xor(lo, o); hi |= __shfl_xor(hi, o); }
    const u64 um = (((u64)(unsigned)__builtin_amdgcn_readfirstlane(hi) << 32) | (u64)(unsigned)__builtin_amdgcn_readfirstlane(lo)) & lowbits(cur + 1);
    flash_pass<M_SLC>(st, qf, um, um, (const bf16_t*)(p.ws + O_KSLC) + (size_t)b * S_ * 128 + g * 64, 128, nullptr,
                      (const bf16_t*)(p.ws + O_VSLCT) + (size_t)(b * 2 + g) * 64 * S_, nullptr, tq, mysel, smem);
    const float l = st.l + __shfl_xor(st.l, 32), sc = gts[1] / fmaxf(l, 1e-30f);
#pragma unroll
    for (int r = 0; r < 16; ++r) { res[0][r] += st.o[0][r] * sc; res[1][r] += st.o[1][r] * sc; }
  }
  bf16_t* op = (bf16_t*)(p.ws + O_ONSA) + trow * 512 + head * 64;
#pragma unroll
  for (int dt = 0; dt < 2; ++dt)
#pragma unroll
    for (int g4 = 0; g4 < 4; ++g4) {
      const int d = dt * 32 + g4 * 8 + half * 4;
      const u32x2 oc = *(const u32x2*)(op + d);
      const float c0 = bf2f((bf16_t)(oc[0] & 0xffffu)), c1 = bf2f((bf16_t)(oc[0] >> 16)), c2 = bf2f((bf16_t)(oc[1] & 0xffffu)), c3 = bf2f((bf16_t)(oc[1] >> 16));
      *(u32x2*)(op + d) = (u32x2){pk2(res[dt][4 * g4] + c0, res[dt][4 * g4 + 1] + c1), pk2(res[dt][4 * g4 + 2] + c2, res[dt][4 * g4 + 3] + c3)};
    }
}
constexpr int PD_ITEMS = 16 * 192;
DI void phase_d(const Params& p, unsigned char* smem) {
  for (int it = blockIdx.x; it < PD_ITEMS; it += gridDim.x) {
    const int r = it / 192, w = it % 192, qt = 15 - r;
    if (w < 64) dense_attn_item<M_MLA>(p, w >> 3, w & 7, qt, (bf16_t*)smem);
    else if (w < 128) dense_attn_item<M_FOX>(p, (w - 64) >> 3, (w - 64) & 7, qt, (bf16_t*)smem);
    else { const int i = w - 128, bg = i & 15, q4 = i >> 4; nsa_attn_item(p, bg >> 1, bg & 1, qt * 4 + q4, (bf16_t*)smem); }
  }
}

DI void merge_tile(const Params& p, int layer, int tm, int tn, bf16_t* smem) {
  const bf16_t* wl = (const bf16_t*)(p.ws + O_W) + (size_t)layer * W_LAYER;
  const int lane = TIDX() & 63, wid = TIDX() >> 6, wm = wid >> 2, wn = wid & 3, l15 = lane & 15, quad = lane >> 4;
  f32x4 mg[4][2]; zero_acc<4, 2>(mg);
  unsigned* gsp = (unsigned*)((unsigned char*)smem + 2 * GemmLds<4, 2>::STAGE * 2) + TIDX();
#pragma unroll 1
  for (int br = 0; br < 3; ++br) {
    {
      f32x4 ga[4][2]; zero_acc<4, 2>(ga);
      RowPtr ap{(const bf16_t*)(p.ws + O_XG) + (size_t)tm * 128 * D_, (size_t)D_}, bp{wl + W_G + ((size_t)br * 1024 + tn * 128) * D_, (size_t)D_};
      gemm_main<4, 2, true>(ga, ap, 64, bp, 64, 16, smem);
#pragma unroll
      for (int i = 0; i < 4; ++i) {
        const float rs = rstd_from16((const float*)(p.ws + O_SSQ) + (size_t)(tm * 128 + wm * 64 + i * 16 + l15) * 16, 1.f / 1024.f);
#pragma unroll
        for (int j = 0; j < 2; ++j) {
          gsp[((i * 2 + j) * 2 + 0) * NTHR] = pk2(sigmoidf_(ga[i][j][0] * rs), sigmoidf_(ga[i][j][1] * rs));
          gsp[((i * 2 + j) * 2 + 1) * NTHR] = pk2(sigmoidf_(ga[i][j][2] * rs), sigmoidf_(ga[i][j][3] * rs));
        }
      }
    }
    f32x4 ba[4][2]; zero_acc<4, 2>(ba);
    RowPtr bp2{wl + (br == 0 ? W_BN : br == 1 ? W_BF : W_BM) + (size_t)tn * 128 * 512, (size_t)512};
    const bf16_t* abase = (const bf16_t*)(p.ws + (br == 0 ? O_ONSA : br == 1 ? O_FOXQ : O_MLAQ));
    const int ald = br == 2 ? 768 : 512;
    RowPtr ap2{abase + (size_t)tm * 128 * ald, (size_t)ald};
    gemm_main<4, 2, true>(ba, ap2, br == 2 ? 96 : 64, bp2, 64, 8, smem);
#pragma unroll
    for (int i = 0; i < 4; ++i)
#pragma unroll
      for (int j = 0; j < 2; ++j) {
        const unsigned w0 = gsp[((i * 2 + j) * 2 + 0) * NTHR], w1 = gsp[((i * 2 + j) * 2 + 1) * NTHR];
        mg[i][j][0] += bf2f((bf16_t)(w0 & 0xffffu)) * ba[i][j][0];
        mg[i][j][1] += bf2f((bf16_t)(w0 >> 16)) * ba[i][j][1];
        mg[i][j][2] += bf2f((bf16_t)(w1 & 0xffffu)) * ba[i][j][2];
        mg[i][j][3] += bf2f((bf16_t)(w1 >> 16)) * ba[i][j][3];
      }
  }
#pragma unroll
  for (int i = 0; i < 4; ++i) {
    bf16_t* dst = (bf16_t*)(p.ws + O_MERGED) + (size_t)(tm * 128 + wm * 64 + i * 16 + l15) * D_ + tn * 128 + wn * 32 + quad * 4;
#pragma unroll
    for (int j = 0; j < 2; ++j) *(u32x2*)(dst + j * 16) = (u32x2){pk2(mg[i][j][0], mg[i][j][1]), pk2(mg[i][j][2], mg[i][j][3])};
  }
}
DI void phase_e(const Params& p, int layer, unsigned char* smem) {
  xcd_tiles(32, 8, [&](int tm, int tn) { merge_tile(p, layer, tm, tn, (bf16_t*)smem); });
}

DI void resid_tile(const Params& p, const bf16_t* A, int K, const bf16_t* W, const float* xold, const float* gnext, int tm, int tn, bf16_t* smem) {
  f32x4 acc[8][4]; zero_acc<8, 4>(acc);
  RowPtr ap{A + (size_t)tm * 256 * K, (size_t)K}, bp{W + (size_t)tn * 256 * K, (size_t)K};
  gemm_main<8, 4, true>(acc, ap, 64, bp, 64, K / 64, smem);
  const int lane = TIDX() & 63, wid = TIDX() >> 6, wm = wid >> 2, wn = wid & 3, l15 = lane & 15, quad = lane >> 4;
#pragma unroll
  for (int i = 0; i < 8; ++i) {
    const int t = tm * 256 + wm * 128 + i * 16 + l15, c0 = tn * 256 + wn * 64 + quad * 4; float s = 0.f;
#pragma unroll
    for (int j = 0; j < 4; ++j) {
      const size_t off = (size_t)t * D_ + c0 + j * 16;
      const f32x4 xn = *(const f32x4*)(xold + off) + acc[i][j];
      *(f32x4*)(p.out + off) = xn;
      s += xn[0] * xn[0] + xn[1] * xn[1] + xn[2] * xn[2] + xn[3] * xn[3];
      if (gnext) { const f32x4 gv = *(const f32x4*)(gnext + c0 + j * 16); *(u32x2*)((bf16_t*)(p.ws + O_XG) + off) = (u32x2){pk2(xn[0] * gv[0], xn[1] * gv[1]), pk2(xn[2] * gv[2], xn[3] * gv[3])}; }
    }
    s += __shfl_xor(s, 16); s += __shfl_xor(s, 32);
    if (quad == 0) ((float*)(p.ws + O_SSQ))[(size_t)t * 16 + tn * 4 + wn] = s;
  }
}
DI void phase_f(const Params& p, int layer, unsigned char* smem) {
  const bf16_t* wl = (const bf16_t*)(p.ws + O_W) + (size_t)layer * W_LAYER;
  xcd_tiles(16, 4, [&](int tm, int tn) { resid_tile(p, (const bf16_t*)(p.ws + O_MERGED), 1024, wl + W_OUT, layer == 0 ? p.x : p.out, p.ffn_norm + layer * D_, tm, tn, (bf16_t*)smem); });
}
DI void phase_h(const Params& p, int layer, unsigned char* smem) {
  const bf16_t* wl = (const bf16_t*)(p.ws + O_W) + (size_t)layer * W_LAYER;
  xcd_tiles(16, 4, [&](int tm, int tn) { resid_tile(p, (const bf16_t*)(p.ws + O_ACT), DFF_, wl + W_DN, p.out, layer == 0 ? p.mix_norm + D_ : nullptr, tm, tn, (bf16_t*)smem); });
}

struct UpRowPtr { const bf16_t* base; int s0;
  DI unsigned operator()(int r) const { const int s = s0 + r; return (unsigned)((s < 0 || s >= S_) ? 0 : s) * (unsigned)D_; }
  DI bool ok(int r) const { const int s = s0 + r; return s >= 0 && s < S_; } };
constexpr int PG_MT = 17;
DI void ffnup_tile(const Params& p, int layer, int b, int mt, int tn, bf16_t* smem) {
  const bf16_t* wl = (const bf16_t*)(p.ws + O_W) + (size_t)layer * W_LAYER;
  f32x4 acc[8][4]; zero_acc<8, 4>(acc);
  const int s0 = 254 * mt - 2;
  UpRowPtr ap{(const bf16_t*)(p.ws + O_XG) + (size_t)b * S_ * D_, s0}; RowPtr bp{wl + W_UP + (size_t)tn * 256 * D_, (size_t)D_};
  gemm_main<8, 4, true>(acc, ap, 64, bp, 64, 16, smem);
  const int tid = TIDX(), lane = tid & 63, wid = tid >> 6, wm = wid >> 2, wn = wid & 3, l15 = lane & 15, quad = lane >> 4;
  constexpr int LDU = 132; float* U = (float*)smem;
  if (wn < 2) {
#pragma unroll
    for (int i = 0; i < 8; ++i) {
      const int row = wm * 128 + i * 16 + l15, s = s0 + row;
      const float rs = (s >= 0 && s < S_) ? rstd_from16((const float*)(p.ws + O_SSQ) + ((size_t)b * S_ + s) * 16, 1.f / 1024.f) : 0.f;
      float* dst = U + row * LDU + wn * 64 + quad * 4;
#pragma unroll
      for (int j = 0; j < 4; ++j) *(f32x4*)(dst + j * 16) = acc[i][j] * rs;
    }
  }
  __syncthreads();
  if (wn >= 2) {
    const int cl = (wn - 2) * 64 + quad * 4;
    bf16_t* act = (bf16_t*)(p.ws + O_ACT);
#pragma unroll
    for (int j = 0; j < 4; ++j) {
      const int cg0 = tn * 128 + cl + j * 16;
      const float* cw = p.conv_w + (size_t)layer * 3 * DFF_ + cg0; const f32x4 w0 = *(const f32x4*)cw, w1 = *(const f32x4*)(cw + DFF_), w2 = *(const f32x4*)(cw + 2 * DFF_);
      const f32x4 cb = *(const f32x4*)(p.conv_b + (size_t)layer * DFF_ + cg0);
#pragma unroll
      for (int i = 0; i < 8; ++i) {
        const int row = wm * 128 + i * 16 + l15, s = s0 + row;
        if (row >= 2 && s < S_) {
          const float rs = rstd_from16((const float*)(p.ws + O_SSQ) + ((size_t)b * S_ + s) * 16, 1.f / 1024.f);
          const float* up = U + row * LDU + cl + j * 16;
          const f32x4 u0 = *(const f32x4*)(up - 2 * LDU), u1 = *(const f32x4*)(up - LDU), u2 = *(const f32x4*)up;
          float o[4];
#pragma unroll
          for (int r = 0; r < 4; ++r) { const float uc = w0[r] * u0[r] + w1[r] * u1[r] + w2[r] * u2[r] + cb[r]; o[r] = uc * sigmoidf_(uc) * (acc[i][j][r] * rs); }
          *(u32x2*)(act + ((size_t)b * S_ + s) * DFF_ + cg0) = (u32x2){pk2(o[0], o[1]), pk2(o[2], o[3])};
        }
      }
    }
  }
  __syncthreads();
}
DI void phase_g(const Params& p, int layer, unsigned char* smem) {
  xcd_tiles(PG_MT, 22, [&](int tmg, int tn) { ffnup_tile(p, layer, tmg / PG_MT, tmg % PG_MT, tn, (bf16_t*)smem); });
}

DI void phase_final(const Params& p) {
  const int lane = TIDX() & 63, wid = TIDX() >> 6;
  for (int it = blockIdx.x; it < T_ / 8; it += gridDim.x) {
    const int t = it * 8 + wid; const float rs = rstd_from16((const float*)(p.ws + O_SSQ) + (size_t)t * 16, 1.f / 1024.f);
    float* xr = p.out + (size_t)t * D_;
#pragma unroll
    for (int c = 0; c < 4; ++c) { const int k = c * 256 + lane * 4; const f32x4 v = *(const f32x4*)(xr + k), gv = *(const f32x4*)(p.final_norm + k); *(f32x4*)(xr + k) = v * rs * gv; }
  }
}

#define XB_TMO      128
#define XB_XCNT(j)  (256  + 64 * (j))
#define XB_XSUB(j)  (1280 + 64 * (j))
#define XB_XGEN(j)  (2304 + 64 * (j))
#define XB_TOP      3328
#define XB_TOPGEN   3392
#define XCD_BAR_WORDS 3456
#define XB_SPIN_CAP (1u << 22)
#define LAS __attribute__((address_space(3)))
DI unsigned xb_ld(unsigned* p)              { return __hip_atomic_load(p, __ATOMIC_RELAXED, __HIP_MEMORY_SCOPE_AGENT); }
DI unsigned xb_add(unsigned* p, unsigned v) { return __hip_atomic_fetch_add(p, v, __ATOMIC_RELAXED, __HIP_MEMORY_SCOPE_AGENT); }
DI unsigned xb_xcc_id() { return (unsigned)__builtin_amdgcn_s_getreg((3 << 11) | 20) & 0xFu; }
#define XB_SPIN(cond, bar) do { unsigned _sp = 0; while (cond) { __builtin_amdgcn_s_sleep(1); \
    if ((++_sp & 255u) == 0u) { if (xb_ld(&(bar)[XB_TMO])) break; if (_sp > XB_SPIN_CAP) { atomicAdd(&(bar)[XB_TMO], 1u); break; } } } } while (0)
struct XcdBarrier { unsigned* bar; unsigned x; volatile LAS unsigned* st; };
DI XcdBarrier xcd_barrier_post(unsigned* bar, volatile LAS unsigned* st) {
  XcdBarrier b; b.bar = bar; b.x = xb_xcc_id(); b.st = st;
  if (threadIdx.x == 0) (void)xb_add(&bar[XB_XCNT(b.x)], 1u);
  return b;
}
DI void xcd_barrier_complete(unsigned* bar, unsigned x, unsigned& nloc, unsigned& nx) {
  const unsigned G = gridDim.x * gridDim.y * gridDim.z;
  unsigned sum, cnt, mine, sp = 0u;
  for (;;) {
    sum = 0u; cnt = 0u; mine = 0u;
#pragma unroll
    for (unsigned j = 0; j < 16; ++j) { const unsigned c = xb_ld(&bar[XB_XCNT(j)]); sum += c; cnt += (c > 0u) ? 1u : 0u; mine = (j == x) ? c : mine; }
    if (sum == G) break;
    __builtin_amdgcn_s_sleep(1);
    if ((++sp & 255u) == 0u) { if (xb_ld(&bar[XB_TMO])) break; if (sp > XB_SPIN_CAP) { atomicAdd(&bar[XB_TMO], 1u); break; } }
  }
  nloc = mine > 0u ? mine : 1u; nx = cnt > 0u ? cnt : 1u;
}
DI void xcd_barrier(const XcdBarrier& b) {
  asm volatile("s_waitcnt vmcnt(0)" ::: "memory");
  __syncthreads();
  if (threadIdx.x == 0) {
    unsigned* bar = b.bar;
    __builtin_amdgcn_s_waitcnt(0);
    unsigned nloc = b.st[0], nx = b.st[1];
    if (nloc == 0u) { xcd_barrier_complete(bar, b.x, nloc, nx); b.st[0] = nloc; b.st[1] = nx; }
    const unsigned old = xb_add(&bar[XB_XSUB(b.x)], 1u);
    const unsigned gen = old / nloc;
    if (old + 1u == (gen + 1u) * nloc) {
      __builtin_amdgcn_fence(__ATOMIC_RELEASE, "agent");
      asm volatile("s_waitcnt vmcnt(0)" ::: "memory");
      const unsigned og = xb_add(&bar[XB_TOP], 1u);
      const unsigned tg = og / nx;
      if (og + 1u == (tg + 1u) * nx) xb_add(&bar[XB_TOPGEN], 1u);
      else XB_SPIN(xb_ld(&bar[XB_TOPGEN]) == tg, bar);
      __builtin_amdgcn_fence(__ATOMIC_ACQUIRE, "agent");
      xb_add(&bar[XB_XGEN(b.x)], 1u);
      asm volatile("s_waitcnt vmcnt(0)" ::: "memory");
    } else {
      XB_SPIN(xb_ld(&bar[XB_XGEN(b.x)]) == gen, bar);
      __builtin_amdgcn_fence(__ATOMIC_ACQUIRE, "agent");
      asm volatile("s_waitcnt vmcnt(0)" ::: "memory");
    }
  }
  __syncthreads();
}
DI void run_phase(const Params& p, int ph, unsigned char* smem) {
  if (ph == 0) { phase_prep(p, smem); return; }
  if (ph == 17) { phase_final(p); return; }
  const int layer = (ph - 1) >> 3, s = (ph - 1) & 7;
#ifdef PROBE_DUP
  if ((PROBE_DUP >> s) & 1) {
    switch (s) { case 0: phase_inproj(p, layer, smem); break; case 1: phase_b(p, layer, smem); break; case 2: phase_c(p, smem); break; case 4: phase_e(p, layer, smem); break; case 6: phase_g(p, layer, smem); break; default: break; }
    __syncthreads();
  }
#endif
  switch (s) {
    case 0: phase_inproj(p, layer, smem); break;
    case 1: phase_b(p, layer, smem); break;
    case 2: phase_c(p, smem); break;
    case 3: phase_d(p, smem); break;
    case 4: phase_e(p, layer, smem); break;
    case 5: phase_f(p, layer, smem); break;
    case 6: phase_g(p, layer, smem); break;
    default: phase_h(p, layer, smem); break;
  }
}
constexpr int N_PHASES = 18;

#if ONE_LAUNCH
template <int PH> DI void run_all(const Params& p, unsigned char* smem, cg::grid_group& grid, const XcdBarrier& xb) {
  run_phase(p, PH, smem);
  if constexpr (PH + 1 < N_PHASES) {
    if constexpr (PH == 0) grid.sync(); else xcd_barrier(xb);
    run_all<PH + 1>(p, smem, grid, xb);
  }
}
__global__ void __launch_bounds__(NTHR, 2) mega_kernel(Params p) {
  __shared__ __attribute__((aligned(16))) unsigned char smem[SMEM_BYTES];
  __shared__ uint4 xb_words;
  if (threadIdx.x == 0) xb_words = make_uint4(0u, 0u, 0u, 0u);
  __syncthreads();
  const XcdBarrier xb = xcd_barrier_post((unsigned*)(p.ws + O_BAR), (volatile LAS unsigned*)&xb_words);
  cg::grid_group grid = cg::this_grid();
  run_all<0>(p, smem, grid, xb);
}
#else
template <int PH> __global__ void __launch_bounds__(NTHR, 2) phase_kernel(Params p) {
  __shared__ __attribute__((aligned(16))) unsigned char smem[SMEM_BYTES];
  run_phase(p, PH, smem);
}
template <int PH> static void launch_phases(const Params& p, hipStream_t stream) {
  hipLaunchKernelGGL((phase_kernel<PH>), dim3(256), dim3(NTHR), 0, stream, p);
  if constexpr (PH + 1 < N_PHASES) launch_phases<PH + 1>(p, stream);
}
#endif

extern "C" void kernel_launch(void* const* d_in, const int* in_sizes, int n_in, void* d_out, int out_size, void* d_ws, size_t ws_size, hipStream_t stream) {
  if (ws_size < O_END || n_in < 25) { fprintf(stderr, "workspace too small: %zu < %zu\n", ws_size, (size_t)O_END); return; }
  Params p{};
  p.x = (const float*)d_in[0]; p.pos = (const int*)d_in[1]; p.mix_norm = (const float*)d_in[2]; p.w_in = (const float*)d_in[3]; p.b_forget = (const float*)d_in[4];
  p.pe_k = (const float*)d_in[5]; p.w1_k = (const float*)d_in[6]; p.w2_k = (const float*)d_in[7]; p.pe_v = (const float*)d_in[8]; p.w1_v = (const float*)d_in[9]; p.w2_v = (const float*)d_in[10];
  p.q_norm = (const float*)d_in[11]; p.w_uq = (const float*)d_in[12]; p.kv_norm = (const float*)d_in[13]; p.w_ukv = (const float*)d_in[14];
  p.wbr_nsa = (const float*)d_in[15]; p.wbr_fox = (const float*)d_in[16]; p.wbr_mla = (const float*)d_in[17]; p.w_out = (const float*)d_in[18];
  p.ffn_norm = (const float*)d_in[19]; p.w_up = (const float*)d_in[20]; p.conv_w = (const float*)d_in[21]; p.conv_b = (const float*)d_in[22]; p.w_down = (const float*)d_in[23]; p.final_norm = (const float*)d_in[24];
  p.out = (float*)d_out; p.ws = (unsigned char*)d_ws;
#if ONE_LAUNCH
  static int grid_blocks = 0;
  if (!grid_blocks) {
    int dev = 0, cus = 0, per_cu = 0;
    hipGetDevice(&dev); hipDeviceGetAttribute(&cus, hipDeviceAttributeMultiprocessorCount, dev);
    hipOccupancyMaxActiveBlocksPerMultiprocessor(&per_cu, mega_kernel, NTHR, 0);
    if (per_cu > 1) per_cu = 1;
    grid_blocks = cus * per_cu;
  }
  hipMemsetAsync(p.ws + O_BAR, 0, XCD_BAR_WORDS * 4, stream);
  void* args[] = {&p};
  hipError_t e = hipLaunchCooperativeKernel((void*)mega_kernel, dim3(grid_blocks), dim3(NTHR), args, 0, stream);
  if (e != hipSuccess) fprintf(stderr, "cooperative launch failed: %s (grid %d)\n", hipGetErrorString(e), grid_blocks);
#else
  launch_phases<0>(p, stream);
#endif
}
```

```cpp
#include <hip/hip_runtime.h>
#include <hip/hip_cooperative_groups.h>
#include <stdint.h>
#include <stdio.h>
#include <type_traits>
namespace cg = cooperative_groups;

#ifndef ONE_LAUNCH
#define ONE_LAUNCH 1

#endif

#define DI __device__ __forceinline__
typedef unsigned short bf16_t;
typedef short bf16x8 __attribute__((ext_vector_type(8)));
typedef float f32x4 __attribute__((ext_vector_type(4)));
typedef float f32x16 __attribute__((ext_vector_type(16)));
typedef float f32x2 __attribute__((ext_vector_type(2)));
typedef __bf16 bfx2 __attribute__((ext_vector_type(2)));
typedef unsigned u32x4 __attribute__((ext_vector_type(4)));
typedef unsigned u32x2 __attribute__((ext_vector_type(2)));
typedef unsigned long long u64;

constexpr int T_ = 32768, S_ = 4096, NB_ = 8, D_ = 1024, DFF_ = 2816, NIN_ = 6592;
constexpr float EPS_ = 1e-6f;
constexpr float LOG2E_ = 1.4426950408889634f;
constexpr float QS64_ = 0.125f * LOG2E_;
constexpr float QS96_ = 0.10206207261596577f * LOG2E_;

constexpr size_t W_IN = 0;
constexpr size_t W_G = W_IN + (size_t)3584 * 1024;
constexpr size_t W_1K = W_G + (size_t)3072 * 1024;
constexpr size_t W_1V = W_1K + (size_t)256 * 2048;
constexpr size_t W_2K = W_1V + (size_t)256 * 2048;
constexpr size_t W_2V = W_2K + (size_t)64 * 256;
constexpr size_t W_UQ = W_2V + (size_t)64 * 256;
constexpr size_t W_UKV = W_UQ + (size_t)768 * 384;
constexpr size_t W_BN = W_UKV + (size_t)1024 * 256;
constexpr size_t W_BF = W_BN + (size_t)1024 * 512;
constexpr size_t W_BM = W_BF + (size_t)1024 * 512;
constexpr size_t W_OUT = W_BM + (size_t)1024 * 512;
constexpr size_t W_UP = W_OUT + (size_t)1024 * 1024;
constexpr size_t W_DN = W_UP + (size_t)5632 * 1024;
constexpr size_t W_LAYER = W_DN + (size_t)1024 * 2816;

constexpr size_t al256(size_t x) { return (x + 255) & ~(size_t)255; }
constexpr size_t O_BAR = 0;
constexpr size_t O_W = 16384;
constexpr size_t O_BIAS1 = al256(O_W + 2 * W_LAYER * 2);
constexpr size_t O_ROPE8 = al256(O_BIAS1 + 2 * 2 * 256 * 4);
constexpr size_t O_ROPE16 = al256(O_ROPE8 + (size_t)T_ * 16 * 4);
constexpr size_t O_XG = al256(O_ROPE16 + (size_t)T_ * 32 * 4);
constexpr size_t O_SSQ = al256(O_XG + (size_t)T_ * 1024 * 2);
constexpr size_t O_CSSQ = al256(O_SSQ + (size_t)T_ * 16 * 4);
constexpr size_t O_NSAQ = al256(O_CSSQ + (size_t)T_ * 16 * 4);
constexpr size_t O_KVCMP = O_NSAQ + (size_t)T_ * 512 * 2;
constexpr size_t O_KSLC = O_KVCMP + (size_t)T_ * 256 * 2;
constexpr size_t O_KWIN = O_KSLC + (size_t)T_ * 128 * 2;
constexpr size_t O_MERGED = O_NSAQ;
constexpr size_t O_VSLCT = O_KWIN + (size_t)T_ * 128 * 2;
constexpr size_t O_VWINT = O_VSLCT + (size_t)T_ * 128 * 2;
constexpr size_t O_FOXQ = O_VWINT + (size_t)T_ * 128 * 2;
constexpr size_t O_FOXK = O_FOXQ + (size_t)T_ * 512 * 2;
constexpr size_t O_FOXVT = O_FOXK + (size_t)T_ * 512 * 2;
constexpr size_t O_MLAQ = O_FOXVT + (size_t)T_ * 512 * 2;
constexpr size_t O_MLAKN = O_MLAQ + (size_t)T_ * 768 * 2;
constexpr size_t O_ACT = O_FOXQ;
constexpr size_t O_MLAVT = O_MLAKN + (size_t)T_ * 512 * 2;
constexpr size_t O_MLAKPE = O_MLAVT + (size_t)T_ * 512 * 2;
constexpr size_t O_ONSA = O_MLAKPE + (size_t)T_ * 32 * 2;
constexpr size_t O_CQ = O_ONSA;
constexpr size_t O_CKV = O_CQ + (size_t)T_ * 384 * 2;
constexpr size_t O_CEND = O_CKV + (size_t)T_ * 256 * 2;
constexpr size_t O_GATES = al256(O_CEND > O_ONSA + (size_t)T_ * 512 * 2 ? O_CEND : O_ONSA + (size_t)T_ * 512 * 2);
constexpr size_t O_LOGF = al256(O_GATES + (size_t)T_ * 24 * 4);
constexpr size_t O_F2 = al256(O_LOGF + (size_t)T_ * 8 * 4);
constexpr size_t O_KC = al256(O_F2 + (size_t)T_ * 8 * 4);
constexpr size_t O_VCT = al256(O_KC + (size_t)NB_ * 2 * 256 * 64 * 2);
constexpr size_t O_SEL = al256(O_VCT + (size_t)NB_ * 2 * 256 * 64 * 2);
constexpr size_t O_END = al256(O_SEL + (size_t)NB_ * 2 * S_ * 8);

struct Params {
  const float* x; const int* pos; const float* mix_norm; const float* w_in; const float* b_forget;
  const float* pe_k; const float* w1_k; const float* w2_k; const float* pe_v; const float* w1_v; const float* w2_v;
  const float* q_norm; const float* w_uq; const float* kv_norm; const float* w_ukv;
  const float* wbr_nsa; const float* wbr_fox; const float* wbr_mla; const float* w_out;
  const float* ffn_norm; const float* w_up; const float* conv_w; const float* conv_b; const float* w_down; const float* final_norm;
  float* out; unsigned char* ws;
};

constexpr int NTHR = 512;
constexpr int SMEM_BYTES = 147456;

DI int TIDX() { int t = (int)threadIdx.x; asm volatile("" : "+v"(t)); return t; }
DI unsigned pk2(float lo, float hi) { f32x2 v = {lo, hi}; return __builtin_bit_cast(unsigned, __builtin_convertvector(v, bfx2)); }
DI bf16_t f2bf(float x) { return (bf16_t)(pk2(x, 0.f) & 0xffffu); }
DI float bf2f(bf16_t h) { return __uint_as_float(((unsigned)h) << 16); }
DI float sigmoidf_(float x) { return 1.f / (1.f + __expf(-x)); }
DI float gelu_tanh(float x) { const float u = 0.7978845608028654f * (x + 0.044715f * x * x * x); return x / (1.f + __expf(-2.f * u)); }
DI float ex2(float x) { return __builtin_amdgcn_exp2f(x); }
DI f32x16 mfma32(bf16x8 a, bf16x8 b, f32x16 c) { return __builtin_amdgcn_mfma_f32_32x32x16_bf16(a, b, c, 0, 0, 0); }
DI f32x4 mfma16(bf16x8 a, bf16x8 b, f32x4 c) { return __builtin_amdgcn_mfma_f32_16x16x32_bf16(a, b, c, 0, 0, 0); }
DI float rstd_from16(const float* p, float inv_n) {
  const f32x4 a = *(const f32x4*)p, b = *(const f32x4*)(p + 4), c = *(const f32x4*)(p + 8), d = *(const f32x4*)(p + 12);
  const float s = ((a[0] + a[1]) + (a[2] + a[3])) + ((b[0] + b[1]) + (b[2] + b[3])) + ((c[0] + c[1]) + (c[2] + c[3])) + ((d[0] + d[1]) + (d[2] + d[3]));
  return rsqrtf(s * inv_n + EPS_);
}

constexpr int LDT = 72;
template <int MI, int NJ> struct GemmLds { static constexpr int BM = 32 * MI, BN = 64 * NJ, A_ELEMS = BM * LDT, B_ELEMS = BN * LDT, STAGE = A_ELEMS + B_ELEMS; };

template <int MI, int NJ, bool SWAP, class AP, class BP>
DI void gemm_main(f32x4 (&acc)[MI][NJ], const AP& ap, int a_kstep, const BP& bp, int b_kstep, int nk, bf16_t* smem) {
  typedef GemmLds<MI, NJ> L;
  constexpr int CA = MI / 2, CB = NJ;
  const int tid = TIDX(), lane = tid & 63, wid = tid >> 6, wm = wid >> 2, wn = wid & 3, l15 = lane & 15, quad = lane >> 4;
  unsigned pa[CA], pb[CB]; bool oka[CA];
#pragma unroll
  for (int i = 0; i < CA; ++i) { const int c = tid + NTHR * i; pa[i] = ap(c >> 3) + (c & 7) * 8; oka[i] = ap.ok(c >> 3); }
#pragma unroll
  for (int i = 0; i < CB; ++i) { const int c = tid + NTHR * i; pb[i] = bp(c >> 3) + (c & 7) * 8; }
  u32x4 ra[CA], rb[CB];
  auto gload = [&](int kt) {
    const bf16_t* ab = ap.base + (size_t)kt * a_kstep; const bf16_t* bb = bp.base + (size_t)kt * b_kstep;
#pragma unroll
    for (int i = 0; i < CA; ++i) ra[i] = *(const u32x4*)(ab + pa[i]);
#pragma unroll
    for (int i = 0; i < CB; ++i) rb[i] = *(const u32x4*)(bb + pb[i]);
  };
  auto sstore = [&](int buf) {
    bf16_t* As = smem + buf * L::STAGE; bf16_t* Bs = As + L::A_ELEMS;
#pragma unroll
    for (int i = 0; i < CA; ++i) { const int c = tid + NTHR * i; *(u32x4*)(As + (c >> 3) * LDT + (c & 7) * 8) = oka[i] ? ra[i] : (u32x4){0u, 0u, 0u, 0u}; }
#pragma unroll
    for (int i = 0; i < CB; ++i) { const int c = tid + NTHR * i; *(u32x4*)(Bs + (c >> 3) * LDT + (c & 7) * 8) = rb[i]; }
  };
  gload(0); sstore(0); __syncthreads();
#pragma unroll 1
  for (int kt = 0; kt < nk; ++kt) {
    const int buf = kt & 1;
    gload(kt + 1 < nk ? kt + 1 : nk - 1);
    __builtin_amdgcn_sched_barrier(0);
    const bf16_t* As = smem + buf * L::STAGE + (wm * 16 * MI + l15) * LDT + quad * 8;
    const bf16_t* Bs = smem + buf * L::STAGE + L::A_ELEMS + (wn * 16 * NJ + l15) * LDT + quad * 8;
#pragma unroll
    for (int ks = 0; ks < 2; ++ks) {
      if (MI * NJ >= 32 && ks == 1) asm volatile("" ::: "memory");
      bf16x8 b[NJ];
#pragma unroll
      for (int j = 0; j < NJ; ++j) b[j] = *(const bf16x8*)(Bs + j * 16 * LDT + ks * 32);
#pragma unroll
      for (int i = 0; i < MI; ++i) {
        const bf16x8 a = *(const bf16x8*)(As + i * 16 * LDT + ks * 32);
#pragma unroll
        for (int j = 0; j < NJ; ++j) acc[i][j] = SWAP ? mfma16(b[j], a, acc[i][j]) : mfma16(a, b[j], acc[i][j]);
      }
    }
    sstore(buf ^ 1);
    __syncthreads();
  }
}
template <int MI, int NJ> DI void zero_acc(f32x4 (&acc)[MI][NJ]) {
#pragma unroll
  for (int i = 0; i < MI; ++i)
#pragma unroll
    for (int j = 0; j < NJ; ++j) acc[i][j] = (f32x4){0.f, 0.f, 0.f, 0.f};
}
struct RowPtr { const bf16_t* base; size_t ld; DI unsigned operator()(int r) const { return (unsigned)r * (unsigned)ld; } DI bool ok(int) const { return true; } };


template <class F> DI void xcd_tiles(int MPX, int NT, F&& body) {
  const int xcd = blockIdx.x & 7, slot = blockIdx.x >> 3, nslots = gridDim.x >> 3, total = MPX * NT;
  for (int li = slot; li < total; li += nslots) {
    const int mg = li / (8 * NT), rem = li - mg * 8 * NT;
    const int gsz = (MPX - mg * 8) < 8 ? (MPX - mg * 8) : 8;
    const int tn = rem / gsz, mi = rem - tn * gsz;
    body(xcd * MPX + mg * 8 + mi, tn);
  }
}

DI int map_col(int map, int n) {
  if (map == 0) return n;
  if (map == 1) {
    if (n < 896) return n;
    if (n < 1024) return 1024 + (n - 896);
    if (n < 1152) return 896 + (n - 1024);
    if (n < 1280) return n;
    if (n < 2816) return 1304 + (n - 1280);
    if (n < 3200) return 2848 + (n - 2816);
    if (n < 3456) return 3232 + (n - 3200);
    const int c = n - 3456;
    if (c < 24) return 1280 + c;
    if (c < 32) return 2840 + (c - 24);
    if (c < 64) return 3488 + (c - 32);
    return -1;
  }
  if (map == 2) { const int j = n >> 8, c = n & 255; return c < 128 ? j * 128 + c : DFF_ + j * 128 + (c - 128); }
  if (map == 3) { return n < 512 ? (n >> 6) * 128 + (n & 63) : ((n - 512) >> 6) * 128 + 64 + ((n - 512) & 63); }
  return n;
}
struct WJob { const float* src; const float* scale; bf16_t* dst; int K, N, ld, map, off; };
DI void prep_weight_tile(const WJob& j, int tile, float* lds) {
  const int ntn = j.N >> 6, tk = tile / ntn, tn = tile % ntn, tid = TIDX();
  const int n = tn * 64 + (tid & 63); const int sc = map_col(j.map, n);
#pragma unroll 4
  for (int i = 0; i < 8; ++i) {
    const int kk = (tid >> 6) + 8 * i, k = tk * 64 + kk;
    float v = sc >= 0 ? j.src[(size_t)k * j.ld + j.off + sc] : 0.f;
    if (j.scale) v *= j.scale[k];
    lds[kk * 65 + (tid & 63)] = v;
  }
  __syncthreads();
  const int nn = tid >> 3, k0 = (tid & 7) * 8;
  unsigned w[4];
#pragma unroll
  for (int e = 0; e < 4; ++e) w[e] = pk2(lds[(k0 + 2 * e) * 65 + nn], lds[(k0 + 2 * e + 1) * 65 + nn]);
  bf16_t* d = j.dst + (size_t)(tn * 64 + nn) * j.K + tk * 64 + k0;
  *(u32x4*)d = (u32x4){w[0], w[1], w[2], w[3]};
  __syncthreads();
}
DI WJob get_wjob(const Params& p, int layer, int id) {
  bf16_t* wl = (bf16_t*)(p.ws + O_W) + (size_t)layer * W_LAYER; WJob j; j.scale = nullptr; j.map = 0; j.off = 0;
  switch (id) {
    case 0: j.src = p.w_in + (size_t)layer * 1024 * NIN_; j.dst = wl + W_IN; j.K = 1024; j.N = 3584; j.ld = NIN_; j.map = 1; break;
    case 1: j.src = p.w_in + (size_t)layer * 1024 * NIN_; j.dst = wl + W_G; j.K = 1024; j.N = 3072; j.ld = NIN_; j.off = 3520; break;
    case 2: j.src = p.w1_k + (size_t)layer * 2048 * 256; j.dst = wl + W_1K; j.K = 2048; j.N = 256; j.ld = 256; break;
    case 3: j.src = p.w1_v + (size_t)layer * 2048 * 256; j.dst = wl + W_1V; j.K = 2048; j.N = 256; j.ld = 256; break;
    case 4: j.src = p.w2_k + (size_t)layer * 256 * 64; j.dst = wl + W_2K; j.K = 256; j.N = 64; j.ld = 64; break;
    case 5: j.src = p.w2_v + (size_t)layer * 256 * 64; j.dst = wl + W_2V; j.K = 256; j.N = 64; j.ld = 64; break;
    case 6: j.src = p.w_uq + (size_t)layer * 384 * 768; j.dst = wl + W_UQ; j.K = 384; j.N = 768; j.ld = 768; j.scale = p.q_norm + layer * 384; break;
    case 7: j.src = p.w_ukv + (size_t)layer * 256 * 1024; j.dst = wl + W_UKV; j.K = 256; j.N = 1024; j.ld = 1024; j.scale = p.kv_norm + layer * 256; j.map = 3; break;
    case 8: j.src = p.wbr_nsa + (size_t)layer * 512 * 1024; j.dst = wl + W_BN; j.K = 512; j.N = 1024; j.ld = 1024; break;
    case 9: j.src = p.wbr_fox + (size_t)layer * 512 * 1024; j.dst = wl + W_BF; j.K = 512; j.N = 1024; j.ld = 1024; break;
    case 10: j.src = p.wbr_mla + (size_t)layer * 512 * 1024; j.dst = wl + W_BM; j.K = 512; j.N = 1024; j.ld = 1024; break;
    case 11: j.src = p.w_out + (size_t)layer * 1024 * 1024; j.dst = wl + W_OUT; j.K = 1024; j.N = 1024; j.ld = 1024; break;
    case 12: j.src = p.w_up + (size_t)layer * 1024 * 5632; j.dst = wl + W_UP; j.K = 1024; j.N = 5632; j.ld = 5632; j.map = 2; break;
    default: j.src = p.w_down + (size_t)layer * 2816 * 1024; j.dst = wl + W_DN; j.K = 2816; j.N = 1024; j.ld = 1024; break;
  }
  return j;
}
constexpr int WTILES_LAYER = (int)(W_LAYER / 4096);
constexpr int P0_XITEMS = T_ / 64;
constexpr int P0_ROPE_ITEMS = T_ / NTHR;
constexpr int P0_ITEMS = 2 * WTILES_LAYER + 4 + P0_ROPE_ITEMS + P0_XITEMS;

DI void xg_rows(const float* x, const float* g, bf16_t* xg, float* ssq, int row0) {
  const int lane = TIDX() & 63, wid = TIDX() >> 6;
  for (int rr = 0; rr < 8; ++rr) {
    const int t = row0 + wid * 8 + rr; const float* xr = x + (size_t)t * D_; float s = 0.f;
#pragma unroll
    for (int c = 0; c < 4; ++c) {
      const int k = c * 256 + lane * 4; const f32x4 v = *(const f32x4*)(xr + k), gv = *(const f32x4*)(g + k);
      s += v[0] * v[0] + v[1] * v[1] + v[2] * v[2] + v[3] * v[3];
      *(u32x2*)(xg + (size_t)t * D_ + k) = (u32x2){pk2(v[0] * gv[0], v[1] * gv[1]), pk2(v[2] * gv[2], v[3] * gv[3])};
    }
#pragma unroll
    for (int o = 32; o >= 1; o >>= 1) s += __shfl_xor(s, o);
    if (lane < 16) ssq[(size_t)t * 16 + lane] = lane == 0 ? s : 0.f;
  }
}
DI void phase_prep(const Params& p, unsigned char* smem) {
  for (int it = blockIdx.x; it < P0_ITEMS; it += gridDim.x) {
    int i = it;
    if (i < 2 * WTILES_LAYER) {
      const int layer = i / WTILES_LAYER; int t = i % WTILES_LAYER; int id = 0;
      for (;; ++id) { const WJob j = get_wjob(p, layer, id); const int nt = (j.K >> 6) * (j.N >> 6); if (t < nt) { prep_weight_tile(j, t, (float*)smem); break; } t -= nt; }
      continue;
    }
    i -= 2 * WTILES_LAYER;
    if (i < 4) {
      const int layer = i >> 1, kv = i & 1, c = TIDX();
      if (c < 256) {
        const float* pe = (kv ? p.pe_v : p.pe_k) + (size_t)layer * 2048; const float* w1 = (kv ? p.w1_v : p.w1_k) + (size_t)layer * 2048 * 256;
        float s = 0.f;
        for (int kk = 0; kk < 2048; ++kk) s += pe[kk] * w1[(size_t)kk * 256 + c];
        ((float*)(p.ws + O_BIAS1))[(layer * 2 + kv) * 256 + c] = s;
      }
      continue;
    }
    i -= 4;
    if (i < P0_ROPE_ITEMS) {
      const int t = i * NTHR + TIDX(); const float fp = (float)p.pos[t];
      float* r8 = (float*)(p.ws + O_ROPE8) + (size_t)t * 16; float* r16 = (float*)(p.ws + O_ROPE16) + (size_t)t * 32;
      for (int f = 0; f < 24; ++f) {
        const int half = f < 8 ? 8 : 16, idx = f < 8 ? f : f - 8;
        const float inv = exp2f(-(float)idx / (float)half * 18.931568569324174f);
        const float ang = fp * inv;
        const double rev = (double)ang * 0.15915494309189535; const float fr = (float)(rev - floor(rev));
        const float sn = __builtin_amdgcn_sinf(fr), cs = __builtin_amdgcn_cosf(fr);
        if (f < 8) { r8[2 * idx] = cs; r8[2 * idx + 1] = sn; } else { r16[2 * idx] = cs; r16[2 * idx + 1] = sn; }
      }
      continue;
    }
    i -= P0_ROPE_ITEMS;
    xg_rows(p.x, p.mix_norm, (bf16_t*)(p.ws + O_XG), (float*)(p.ws + O_SSQ), i * 64);
  }
}

DI void store4(bf16_t* dst, const f32x4& v, float s) { *(u32x2*)dst = (u32x2){pk2(v[0] * s, v[1] * s), pk2(v[2] * s, v[3] * s)}; }
constexpr int STG_LD = 72, STG_WAVE = 128 * 72;
DI void stage4(bf16_t* stg, int row, int col, const f32x4& v, float s) { *(u32x2*)(stg + row * STG_LD + col) = (u32x2){pk2(v[0] * s, v[1] * s), pk2(v[2] * s, v[3] * s)}; }
template <int ROWS, int COLS, int LD> DI void stage_out(const bf16_t* stg, bf16_t* dst, size_t ld, int lane) {
  asm volatile("s_waitcnt lgkmcnt(0)" ::: "memory");
  constexpr int CPR = COLS / 8, IT = ROWS * CPR / 64;
#pragma unroll
  for (int it = 0; it < IT; ++it) {
    const int idx = it * 64 + lane, r = idx / CPR, c = idx % CPR;
    __builtin_nontemporal_store(*(const u32x4*)(stg + r * LD + c * 8), (u32x4*)(dst + (size_t)r * ld + c * 8));
  }
}
template <bool SWAP> DI void inproj_tile(const Params& p, int layer, int tm, int tn, bf16_t* smem) {
  const bf16_t* wl = (const bf16_t*)(p.ws + O_W) + (size_t)layer * W_LAYER;
  f32x4 acc[8][4]; zero_acc<8, 4>(acc);
  RowPtr ap{(const bf16_t*)(p.ws + O_XG) + (size_t)tm * 256 * D_, (size_t)D_}, bp{wl + W_IN + (size_t)tn * 256 * D_, (size_t)D_};
  gemm_main<8, 4, SWAP>(acc, ap, 64, bp, 64, 16, smem);
  const int lane = TIDX() & 63, wid = TIDX() >> 6, wm = wid >> 2, wn = wid & 3, l15 = lane & 15, quad = lane >> 4;
  const float* ssq = (const float*)(p.ws + O_SSQ);
  bf16_t* stg = smem + wid * STG_WAVE;
  const int trow0 = tm * 256 + wm * 128;
  if constexpr (!SWAP) {
    bf16_t* dst; int hh, hd;
    if (tn == 4) { dst = (bf16_t*)(p.ws + (wn < 2 ? O_VSLCT : O_VWINT)); hh = 2; hd = wn & 1; } else { dst = (bf16_t*)(p.ws + O_FOXVT); hh = 8; hd = (tn - 9) * 4 + wn; }
    constexpr int VLD = 136;
#pragma unroll
    for (int i = 0; i < 8; ++i) {
      const int t0 = trow0 + i * 16 + quad * 4;
      float rs[4];
#pragma unroll
      for (int r = 0; r < 4; ++r) rs[r] = rstd_from16(ssq + (size_t)(t0 + r) * 16, 1.f / 1024.f);
#pragma unroll
      for (int j = 0; j < 4; ++j)
        *(u32x2*)(stg + (j * 16 + l15) * VLD + i * 16 + quad * 4) = (u32x2){pk2(acc[i][j][0] * rs[0], acc[i][j][1] * rs[1]), pk2(acc[i][j][2] * rs[2], acc[i][j][3] * rs[3])};
    }
    const int b = trow0 >> 12, s0 = trow0 & 4095;
    stage_out<64, 128, VLD>(stg, dst + ((size_t)(b * hh + hd) * 64) * S_ + s0, (size_t)S_, lane);
  } else {
    const int slab = tn * 4 + wn;
    if (slab == 54) {
#pragma unroll
      for (int i = 0; i < 8; ++i) {
        const int t = trow0 + i * 16 + l15; const float rs = rstd_from16(ssq + (size_t)t * 16, 1.f / 1024.f);
        float* gt = (float*)(p.ws + O_GATES) + (size_t)t * 24; float* lf = (float*)(p.ws + O_LOGF) + (size_t)t * 8;
#pragma unroll
        for (int r = 0; r < 4; ++r) gt[quad * 4 + r] = sigmoidf_(acc[i][0][r] * rs);
        if (quad < 2) {
#pragma unroll
          for (int r = 0; r < 4; ++r) gt[16 + quad * 4 + r] = sigmoidf_(acc[i][1][r] * rs);
        } else {
#pragma unroll
          for (int r = 0; r < 4; ++r) { const int h = (quad - 2) * 4 + r; const float xx = acc[i][1][r] * rs + p.b_forget[layer * 8 + h]; lf[h] = fminf(xx, 0.f) - log1pf(__expf(-fabsf(xx))); }
        }
        const float* rp = (const float*)(p.ws + O_ROPE16) + (size_t)t * 32 + quad * 8; float o1[4], o2[4];
#pragma unroll
        for (int r = 0; r < 4; ++r) { const float cs = rp[2 * r], sn = rp[2 * r + 1], x1 = acc[i][2][r] * rs, x2 = acc[i][3][r] * rs; o1[r] = x1 * cs - x2 * sn; o2[r] = x2 * cs + x1 * sn; }
        bf16_t* kp = (bf16_t*)(p.ws + O_MLAKPE) + (size_t)t * 32 + quad * 4;
        *(u32x2*)kp = (u32x2){pk2(o1[0], o1[1]), pk2(o1[2], o1[3])}; *(u32x2*)(kp + 16) = (u32x2){pk2(o2[0], o2[1]), pk2(o2[2], o2[3])};
      }
    } else if (slab != 55) {
      bf16_t* dbuf; int dld, dcol, kind = 0; float qs = 1.f; int cslot = 0;
      if (slab < 8) { dbuf = (bf16_t*)(p.ws + O_NSAQ); dld = 512; dcol = slab * 64; qs = QS64_; }
      else if (slab < 12) { dbuf = (bf16_t*)(p.ws + O_KVCMP); dld = 256; dcol = (slab - 8) * 64; }
      else if (slab < 16) { dbuf = (bf16_t*)(p.ws + (slab < 14 ? O_KSLC : O_KWIN)); dld = 128; dcol = (slab & 1) * 64; kind = 1; }
      else if (slab < 28) { dbuf = (bf16_t*)(p.ws + O_FOXQ); dld = 512; dcol = (slab - 20) * 64; qs = QS64_; }
      else if (slab < 36) { dbuf = (bf16_t*)(p.ws + O_FOXK); dld = 512; dcol = (slab - 28) * 64; }
      else if (slab < 50) { dbuf = (bf16_t*)(p.ws + O_CQ); dld = 384; dcol = (slab - 44) * 64; kind = 2; cslot = slab - 44; }
      else { dbuf = (bf16_t*)(p.ws + O_CKV); dld = 256; dcol = (slab - 50) * 64; kind = 2; cslot = 8 + slab - 50; }
#pragma unroll
      for (int i = 0; i < 8; ++i) {
        const int row = i * 16 + l15, t = trow0 + row; const float rs = rstd_from16(ssq + (size_t)t * 16, 1.f / 1024.f) * qs;
        if (kind == 1) {
          const float* rp = (const float*)(p.ws + O_ROPE8) + (size_t)t * 16 + (quad & 1) * 8;
          f32x4 v, o;
#pragma unroll
          for (int r = 0; r < 4; ++r) { v[r] = acc[i][0][r] * rs; o[r] = __shfl_xor(v[r], 32); }
#pragma unroll
          for (int r = 0; r < 4; ++r) { const float cs = rp[2 * r], sn = rp[2 * r + 1]; v[r] = quad < 2 ? v[r] * cs - o[r] * sn : v[r] * cs + o[r] * sn; }
          stage4(stg, row, quad * 4, v, 1.f);
        } else stage4(stg, row, quad * 4, acc[i][0], rs);
#pragma unroll
        for (int j = 1; j < 4; ++j) stage4(stg, row, j * 16 + quad * 4, acc[i][j], rs);
        if (kind == 2) {
          float s = 0.f;
#pragma unroll
          for (int j = 0; j < 4; ++j) { const f32x4 a = acc[i][j] * rs; s += a[0] * a[0] + a[1] * a[1] + a[2] * a[2] + a[3] * a[3]; }
          s += __shfl_xor(s, 16); s += __shfl_xor(s, 32);
          if (quad == 0) ((float*)(p.ws + O_CSSQ))[(size_t)t * 16 + cslot] = s;
        }
      }
      stage_out<128, 64, STG_LD>(stg, dbuf + (size_t)trow0 * dld + dcol, (size_t)dld, lane);
    }
  }
  __syncthreads();
}
DI void phase_inproj(const Params& p, int layer, unsigned char* smem) {
  xcd_tiles(16, 14, [&](int tm, int tn) {
    const bool vt = (tn == 4 || tn == 9 || tn == 10);
    if (vt) inproj_tile<false>(p, layer, tm, tn, (bf16_t*)smem); else inproj_tile<true>(p, layer, tm, tn, (bf16_t*)smem);
  });
}

template <int KIND> DI void mlaup_tile(const Params& p, int layer, int tm, int tn, bf16_t* smem) {
  const bf16_t* wl = (const bf16_t*)(p.ws + O_W) + (size_t)layer * W_LAYER;
  f32x4 acc[8][4]; zero_acc<8, 4>(acc);
  constexpr int K = KIND == 0 ? 384 : 256;
  RowPtr ap{KIND == 0 ? (const bf16_t*)(p.ws + O_CQ) + (size_t)tm * 256 * 384 : (const bf16_t*)(p.ws + O_CKV) + (size_t)tm * 256 * 256, (size_t)K};
  RowPtr bp{KIND == 0 ? wl + W_UQ + (size_t)tn * 256 * 384 : wl + W_UKV + (size_t)(tn - 3) * 256 * 256, (size_t)K};
  gemm_main<8, 4, KIND != 2>(acc, ap, 64, bp, 64, K / 64, smem);
  const int lane = TIDX() & 63, wid = TIDX() >> 6, wm = wid >> 2, wn = wid & 3, l15 = lane & 15, quad = lane >> 4;
  const float* cssq = (const float*)(p.ws + O_CSSQ);
  bf16_t* stg = smem + wid * STG_WAVE; const int trow0 = tm * 256 + wm * 128;
  if constexpr (KIND == 2) {
    bf16_t* dst = (bf16_t*)(p.ws + O_MLAVT); const int h = (tn - 5) * 4 + wn;
    constexpr int VLD = 136;
#pragma unroll
    for (int i = 0; i < 8; ++i) {
      asm volatile("" ::: "memory");
      const int t0 = trow0 + i * 16 + quad * 4; float rs[4];
#pragma unroll
      for (int r = 0; r < 4; ++r) { const float* c = cssq + (size_t)(t0 + r) * 16 + 8; rs[r] = rsqrtf((c[0] + c[1] + c[2] + c[3]) * (1.f / 256.f) + EPS_); }
#pragma unroll
      for (int j = 0; j < 4; ++j)
        *(u32x2*)(stg + (j * 16 + l15) * VLD + i * 16 + quad * 4) = (u32x2){pk2(acc[i][j][0] * rs[0], acc[i][j][1] * rs[1]), pk2(acc[i][j][2] * rs[2], acc[i][j][3] * rs[3])};
    }
    stage_out<64, 128, VLD>(stg, dst + ((size_t)((trow0 >> 12) * 8 + h) * 64) * S_ + (trow0 & 4095), (size_t)S_, lane);
  } else if constexpr (KIND == 1) {
#pragma unroll
    for (int i = 0; i < 8; ++i) {
      asm volatile("" ::: "memory");
      const int row = i * 16 + l15, t = trow0 + row; const float* c = cssq + (size_t)t * 16;
      const float rs = rsqrtf((c[8] + c[9] + c[10] + c[11]) * (1.f / 256.f) + EPS_);
#pragma unroll
      for (int j = 0; j < 4; ++j) stage4(stg, row, j * 16 + quad * 4, acc[i][j], rs);
    }
    stage_out<128, 64, STG_LD>(stg, (bf16_t*)(p.ws + O_MLAKN) + (size_t)trow0 * 512 + (tn - 3) * 256 + wn * 64, (size_t)512, lane);
  } else {
    const int n0 = tn * 256 + wn * 64, ph = n0 % 96;
#pragma unroll
    for (int i = 0; i < 8; ++i) {
      asm volatile("" ::: "memory");
      const int row = i * 16 + l15, t = trow0 + row; const float* c = cssq + (size_t)t * 16;
      const float rs = rsqrtf((c[0] + c[1] + c[2] + c[3] + c[4] + c[5]) * (1.f / 384.f) + EPS_) * QS96_;
      f32x4 v0 = acc[i][0] * rs, v1 = acc[i][1] * rs, v2 = acc[i][2] * rs, v3 = acc[i][3] * rs;
      if (ph != 0) {
        const float* rp = (const float*)(p.ws + O_ROPE16) + (size_t)t * 32 + quad * 8;
        const f32x4 x1 = ph == 64 ? v0 : v2, x2 = ph == 64 ? v1 : v3; f32x4 o1, o2;
#pragma unroll
        for (int r = 0; r < 4; ++r) { const float cs = rp[2 * r], sn = rp[2 * r + 1]; o1[r] = x1[r] * cs - x2[r] * sn; o2[r] = x2[r] * cs + x1[r] * sn; }
        if (ph == 64) { v0 = o1; v1 = o2; } else { v2 = o1; v3 = o2; }
      }
      stage4(stg, row, quad * 4, v0, 1.f); stage4(stg, row, 16 + quad * 4, v1, 1.f); stage4(stg, row, 32 + quad * 4, v2, 1.f); stage4(stg, row, 48 + quad * 4, v3, 1.f);
    }
    stage_out<128, 64, STG_LD>(stg, (bf16_t*)(p.ws + O_MLAQ) + (size_t)trow0 * 768 + n0, (size_t)768, lane);
  }
  __syncthreads();
}
struct CmpRowPtr { const bf16_t* base; int r0;
  DI unsigned operator()(int r) const { int R = r0 + r; if (R >= 4080) R = 0; const int b = R / 510, rem = R - b * 510, n = rem >> 1, g = rem & 1; return (unsigned)(b * S_ + 16 * n) * 256u + g * 64; }
  DI bool ok(int r) const { return r0 + r < 4080; } };
DI void compress_item(const Params& p, int layer, int item, bf16_t* smem) {
  const int kv = item >> 4, tm = item & 15;
  const bf16_t* wl = (const bf16_t*)(p.ws + O_W) + (size_t)layer * W_LAYER;
  f32x4 acc[8][4]; zero_acc<8, 4>(acc);
  CmpRowPtr ap{(const bf16_t*)(p.ws + O_KVCMP) + kv * 128, tm * 256};
  RowPtr bp{wl + (kv ? W_1V : W_1K), (size_t)2048};
  gemm_main<8, 4, true>(acc, ap, 256, bp, 64, 32, smem);
  const int lane = TIDX() & 63, wid = TIDX() >> 6, wm = wid >> 2, wn = wid & 3, l15 = lane & 15, quad = lane >> 4;
  constexpr int LDH = 264; bf16_t* H = smem;
  const float* b1 = (const float*)(p.ws + O_BIAS1) + (layer * 2 + kv) * 256;
#pragma unroll
  for (int i = 0; i < 8; ++i)
#pragma unroll
    for (int j = 0; j < 4; ++j) {
      const int row = wm * 128 + i * 16 + l15, col = wn * 64 + j * 16 + quad * 4; const f32x4 bv = *(const f32x4*)(b1 + col);
      *(u32x2*)(H + row * LDH + col) = (u32x2){pk2(gelu_tanh(acc[i][j][0] + bv[0]), gelu_tanh(acc[i][j][1] + bv[1])), pk2(gelu_tanh(acc[i][j][2] + bv[2]), gelu_tanh(acc[i][j][3] + bv[3]))};
    }
  __syncthreads();
  f32x4 a2[2][4];
#pragma unroll
  for (int i = 0; i < 2; ++i)
#pragma unroll
    for (int j = 0; j < 4; ++j) a2[i][j] = (f32x4){0.f, 0.f, 0.f, 0.f};
  const bf16_t* w2 = wl + (kv ? W_2V : W_2K);
#pragma unroll
  for (int ks = 0; ks < 8; ++ks) {
    bf16x8 a[2], b[4];
#pragma unroll
    for (int i = 0; i < 2; ++i) a[i] = *(const bf16x8*)(H + (wid * 32 + i * 16 + l15) * LDH + ks * 32 + quad * 8);
#pragma unroll
    for (int j = 0; j < 4; ++j) b[j] = *(const bf16x8*)(w2 + (size_t)(j * 16 + l15) * 256 + ks * 32 + quad * 8);
#pragma unroll
    for (int i = 0; i < 2; ++i)
#pragma unroll
      for (int j = 0; j < 4; ++j) a2[i][j] = mfma16(a[i], b[j], a2[i][j]);
  }
  bf16_t* kc = (bf16_t*)(p.ws + O_KC); bf16_t* vct = (bf16_t*)(p.ws + O_VCT);
#pragma unroll
  for (int i = 0; i < 2; ++i)
#pragma unroll
    for (int r = 0; r < 4; ++r) {
      const int R = tm * 256 + wid * 32 + i * 16 + quad * 4 + r;
      if (R < 4080) {
        const int b = R / 510, rem = R - b * 510, n = rem >> 1, g = rem & 1;
#pragma unroll
        for (int j = 0; j < 4; ++j) {
          const int d = j * 16 + l15; const bf16_t v = f2bf(a2[i][j][r]);
          if (kv == 0) kc[((size_t)(b * 2 + g) * 256 + n) * 64 + d] = v; else vct[((size_t)(b * 2 + g) * 64 + d) * 256 + n] = v;
        }
      }
    }
  __syncthreads();
}
DI void foxscan_item(const Params& p, int item, float* lds) {
  const int b = item >> 3, h = item & 7, tid = TIDX();
  const float* lf = (const float*)(p.ws + O_LOGF) + (size_t)b * S_ * 8 + h; float v[8]; float s = 0.f;
#pragma unroll
  for (int i = 0; i < 8; ++i) { s += lf[(size_t)(tid * 8 + i) * 8]; v[i] = s; }
  lds[tid] = s; __syncthreads();
  float off = 0.f;
  for (int i = 0; i < tid; ++i) off += lds[i];
  float* F2 = (float*)(p.ws + O_F2) + (size_t)(b * 8 + h) * S_ + tid * 8;
#pragma unroll
  for (int i = 0; i < 8; ++i) F2[i] = -(off + v[i]) * LOG2E_;
  __syncthreads();
}
DI void phase_b(const Params& p, int layer, unsigned char* smem) {
  for (int it = blockIdx.x; it < 96; it += gridDim.x) {
    if (it < 32) compress_item(p, layer, it, (bf16_t*)smem);
    else foxscan_item(p, it - 32, (float*)smem);
  }
  xcd_tiles(16, 7, [&](int tm, int tn) {
    if (tn >= 5) mlaup_tile<2>(p, layer, tm, tn, (bf16_t*)smem); else if (tn >= 3) mlaup_tile<1>(p, layer, tm, tn, (bf16_t*)smem); else mlaup_tile<0>(p, layer, tm, tn, (bf16_t*)smem);
  });
}

constexpr int KC_LD = 72, VC_LD = 264;
DI void cmp_item(const Params& p, int item, unsigned char* smem_) {
  const int b = item >> 6, g = (item >> 5) & 1, tt = item & 31, t0 = tt * 128;
  const int tid = TIDX(), lane = tid & 63, wid = tid >> 6, l15 = lane & 15, quad = lane >> 4;
  bf16_t* kcs = (bf16_t*)smem_;
  bf16_t* vcs = kcs + 256 * KC_LD;
  float* imps = (float*)smem_;
  const int nmax = (t0 + 96) >> 4;
  const int nsub = (nmax >> 4) + 1;
  {
    const bf16_t* kcg = (const bf16_t*)(p.ws + O_KC) + (size_t)(b * 2 + g) * 256 * 64; const bf16_t* vcg = (const bf16_t*)(p.ws + O_VCT) + (size_t)(b * 2 + g) * 64 * 256;
    const int nrows = ((nsub + 1) & ~1) * 16;
    for (int e = tid; e < nrows * 8; e += NTHR) {
      const int n = e >> 3, dc = (e & 7) * 8;
      *(u32x4*)(kcs + n * KC_LD + dc) = n < 255 ? *(const u32x4*)(kcg + (size_t)n * 64 + dc) : (u32x4){0u, 0u, 0u, 0u};
    }
    const int ncs = nrows >> 3;
    for (int e = tid; e < 64 * ncs; e += NTHR) {
      const int d = e / ncs, nc = (e - d * ncs) * 8;
      u32x4 v = *(const u32x4*)(vcg + (size_t)d * 256 + nc);
      if (nc + 8 > 255) v[3] &= 0x0000ffffu;
      *(u32x4*)(vcs + d * VC_LD + nc) = v;
    }
  }
  __syncthreads();
  const int tq = t0 + wid * 16 + l15;
  const size_t trow = (size_t)b * S_ + tq;
  float impa[16], p3a[16];
#pragma unroll
  for (int s = 0; s < 16; ++s) { impa[s] = 0.f; p3a[s] = 0.f; }
  const float* gts = (const float*)(p.ws + O_GATES) + trow * 24;
#pragma unroll 1
  for (int r4 = 0; r4 < 4; ++r4) {
    const int head = g * 4 + r4;
    const bf16_t* qp = (const bf16_t*)(p.ws + O_NSAQ) + trow * 512 + head * 64 + quad * 8;
    const bf16x8 q0 = *(const bf16x8*)qp, q1 = *(const bf16x8*)(qp + 32);
    auto score = [&](int s) -> f32x4 {
      const bf16_t* kr = kcs + (s * 16 + l15) * KC_LD + quad * 8;
      f32x4 a = {0.f, 0.f, 0.f, 0.f};
      a = mfma16(*(const bf16x8*)kr, q0, a); a = mfma16(*(const bf16x8*)(kr + 32), q1, a);
#pragma unroll
      for (int r = 0; r < 4; ++r) { const int n = s * 16 + quad * 4 + r; a[r] = (16 * n + 31 <= tq) ? a[r] : -INFINITY; }
      return a;
    };
    float mx = -INFINITY;
#pragma unroll 1
    for (int s = 0; s < nsub; ++s) { const f32x4 a = score(s); mx = fmaxf(mx, fmaxf(fmaxf(a[0], a[1]), fmaxf(a[2], a[3]))); }
    mx = fmaxf(mx, __shfl_xor(mx, 16)); mx = fmaxf(mx, __shfl_xor(mx, 32));
    if (mx == -INFINITY) mx = 0.f;
    float sum = 0.f;
#pragma unroll 1
    for (int s = 0; s < nsub; ++s) { const f32x4 a = score(s); sum += (ex2(a[0] - mx) + ex2(a[1] - mx)) + (ex2(a[2] - mx) + ex2(a[3] - mx)); }
    sum += __shfl_xor(sum, 16); sum += __shfl_xor(sum, 32);
    const float inv = 1.f / fmaxf(sum, 1e-30f);
    f32x4 oacc[4];
#pragma unroll
    for (int j = 0; j < 4; ++j) oacc[j] = (f32x4){0.f, 0.f, 0.f, 0.f};
#pragma unroll
    for (int c = 0; c < 8; ++c) {
      asm volatile("" ::: "memory");
      if (2 * c < nsub) {
        f32x4 pa = score(2 * c), pb = {-INFINITY, -INFINITY, -INFINITY, -INFINITY};
        if (2 * c + 1 < nsub) pb = score(2 * c + 1);
#pragma unroll
        for (int r = 0; r < 4; ++r) { pa[r] = ex2(pa[r] - mx) * inv; pb[r] = ex2(pb[r] - mx) * inv; }
        impa[2 * c] += pa[0] + pa[1] + pa[2] + 0.5f * pa[3]; p3a[2 * c] += pa[3];
        impa[2 * c + 1] += pb[0] + pb[1] + pb[2] + 0.5f * pb[3]; p3a[2 * c + 1] += pb[3];
        const u32x4 pw = {pk2(pa[0], pa[1]), pk2(pa[2], pa[3]), pk2(pb[0], pb[1]), pk2(pb[2], pb[3])};
        const bf16x8 pf = __builtin_bit_cast(bf16x8, pw);
#pragma unroll
        for (int j = 0; j < 4; ++j) {
          const bf16_t* vr = vcs + (j * 16 + l15) * VC_LD + c * 32 + quad * 4;
          const u32x2 lo = *(const u32x2*)vr, hi = *(const u32x2*)(vr + 16);
          const u32x4 vw = {lo[0], lo[1], hi[0], hi[1]};
          oacc[j] = mfma16(__builtin_bit_cast(bf16x8, vw), pf, oacc[j]);
        }
      }
    }
    const float g0 = gts[head * 3 + 0];
    bf16_t* op = (bf16_t*)(p.ws + O_ONSA) + trow * 512 + head * 64 + quad * 4;
#pragma unroll
    for (int j = 0; j < 4; ++j) store4(op + j * 16, oacc[j], g0);
  }
  __syncthreads();
  float* myimp = imps + wid * 1024 + l15 * 64;
  const int cur = tq >> 6;
#pragma unroll
  for (int s = 0; s < 16; ++s) {
    const float up = __shfl(p3a[s], (lane + 48) & 63);
    const float up0 = s ? __shfl(p3a[s ? s - 1 : 0], (lane + 48) & 63) : 0.f;
    const float prev = quad ? up : up0;
    float v = impa[s] + 0.5f * prev;
    const int j = 4 * s + quad;
    if (j == 0 || j == cur || j == cur - 1) v = 1e9f; else if (j > cur) v = -1e9f;
    myimp[j] = v;
  }
  __syncthreads();
  u64* sel = (u64*)(p.ws + O_SEL) + (size_t)(b * 2 + g) * S_ + t0 + wid * 16;
#pragma unroll 1
  for (int q = 0; q < 16; ++q) {
    const float mine = imps[wid * 1024 + q * 64 + lane]; int rank = 0;
#pragma unroll
    for (int i = 0; i < 64; ++i) { const float v = __uint_as_float(__builtin_amdgcn_readlane(__float_as_uint(mine), i)); rank += (v > mine || (v == mine && i < lane)) ? 1 : 0; }
    const u64 m = __ballot(rank < 16);
    if (lane == 0) sel[q] = m;
  }
  __syncthreads();
}
constexpr int PC_ITEMS = NB_ * 2 * 32;
DI void phase_c(const Params& p, unsigned char* smem) { for (int it = blockIdx.x; it < PC_ITEMS; it += gridDim.x) cmp_item(p, it, smem); }

enum { M_FOX = 0, M_MLA = 1, M_WIN = 2, M_SLC = 3 };
template <int MODE> struct ACfg { static constexpr int DQK = MODE == M_MLA ? 96 : 64, KLD = DQK + 8, NKC = DQK / 8 * 64, KCH = (NKC + NTHR - 1) / NTHR, K_ELEMS = 64 * KLD, V_ELEMS = 64 * 72, STAGE = K_ELEMS + V_ELEMS + 128; };
struct AState { f32x16 o[2]; float m, l; };

template <int MODE>
DI void flash_pass(AState& st, const bf16x8* qf, u64 tmask, u64 wmask,
                   const bf16_t* kbase, size_t kld, const bf16_t* kpe, const bf16_t* vtbase, const float* fbias,
                   int tq, u64 mysel, bf16_t* smem) {
  typedef ACfg<MODE> C;
  const int tid = TIDX(), lane = tid & 63, l31 = lane & 31, half = lane >> 5;
  u32x4 rk[C::KCH], rv; float rf = 0.f;
  auto gload = [&](int j) {
    const int k0 = j * 64;
#pragma unroll
    for (int i = 0; i < C::KCH; ++i) {
      const int c = tid + NTHR * i;
      if (c < C::NKC) {
        if constexpr (MODE == M_MLA) { const int key = c / 12, dc = c % 12; rk[i] = dc < 8 ? *(const u32x4*)(kbase + (size_t)(k0 + key) * kld + dc * 8) : *(const u32x4*)(kpe + (size_t)(k0 + key) * 32 + (dc - 8) * 8); }
        else { const int key = c >> 3, dc = c & 7; rk[i] = *(const u32x4*)(kbase + (size_t)(k0 + key) * kld + dc * 8); }
      }
    }
    { const int d = tid >> 3, kc = tid & 7; rv = *(const u32x4*)(vtbase + (size_t)d * S_ + k0 + kc * 8); }
    if constexpr (MODE == M_FOX) { if (tid < 64) rf = fbias[k0 + tid]; }
  };
  auto sstore = [&](int buf) {
    bf16_t* Ks = smem + buf * C::STAGE; bf16_t* Vs = Ks + C::K_ELEMS;
#pragma unroll
    for (int i = 0; i < C::KCH; ++i) {
      const int c = tid + NTHR * i;
      if (c < C::NKC) {
        if constexpr (MODE == M_MLA) { const int key = c / 12, dc = c % 12; *(u32x4*)(Ks + key * C::KLD + dc * 8) = rk[i]; }
        else { const int key = c >> 3, dc = c & 7; *(u32x4*)(Ks + key * C::KLD + dc * 8) = rk[i]; }
      }
    }
    {
      const int d = tid >> 3, kc = tid & 7, cgp = kc >> 1, a = kc & 1;
      bf16_t* dst = Vs + d * 72 + cgp * 16 + 4 * a;
      *(u32x2*)dst = (u32x2){rv[0], rv[1]}; *(u32x2*)(dst + 8) = (u32x2){rv[2], rv[3]};
    }
    if constexpr (MODE == M_FOX) { if (tid < 64) ((float*)(Vs + C::V_ELEMS))[tid] = rf; }
  };
  u64 tm = tmask;
  if (tm == 0) return;
  int j = __builtin_ctzll(tm); tm &= tm - 1;
  gload(j); sstore(0); __syncthreads();
  int buf = 0;
  const int tmin = __builtin_amdgcn_readfirstlane(tq - l31), tmax = tmin + 31;
  while (true) {
    const int jn = tm ? __builtin_ctzll(tm) : -1; if (tm) tm &= tm - 1;
    if (jn >= 0) gload(jn);
    bool active = (wmask >> j) & 1;
    if constexpr (MODE == M_SLC) active = active && __any((mysel >> j) & 1);
    if (active) {
      const bf16_t* Ks = smem + buf * C::STAGE; const bf16_t* Vs = Ks + C::K_ELEMS;
      f32x16 s0, s1;
#pragma unroll
      for (int r = 0; r < 16; ++r) { s0[r] = 0.f; s1[r] = 0.f; }
      const bf16_t* kr = Ks + l31 * C::KLD + half * 8;
#pragma unroll
      for (int ks = 0; ks < C::DQK / 16; ++ks) {
        s0 = mfma32(*(const bf16x8*)(kr + ks * 16), qf[ks], s0);
        s1 = mfma32(*(const bf16x8*)(kr + 32 * C::KLD + ks * 16), qf[ks], s1);
      }
      const int k0 = j * 64;
      if constexpr (MODE == M_FOX) {
        const float* fb = (const float*)(Vs + C::V_ELEMS) + 4 * half;
#pragma unroll
        for (int g4 = 0; g4 < 4; ++g4) {
          const f32x4 b0 = *(const f32x4*)(fb + 8 * g4), b1 = *(const f32x4*)(fb + 32 + 8 * g4);
#pragma unroll
          for (int r = 0; r < 4; ++r) { s0[4 * g4 + r] += b0[r]; s1[4 * g4 + r] += b1[r]; }
        }
      }
      bool need = k0 + 63 > tmin;
      if constexpr (MODE == M_WIN) need = need || (k0 <= tmax - 512);
      if constexpr (MODE == M_SLC) {
        if (!need) {
          const bool rsel = ((mysel >> j) & 1) != 0;
          if (!__all(rsel)) {
#pragma unroll
            for (int r = 0; r < 16; ++r) { s0[r] = rsel ? s0[r] : -INFINITY; s1[r] = rsel ? s1[r] : -INFINITY; }
          }
        }
      }
      if (need) {
        const bool rowok = MODE == M_SLC ? ((mysel >> j) & 1) != 0 : true;
#pragma unroll
        for (int r = 0; r < 16; ++r) {
          const int key = k0 + (r & 3) + 8 * (r >> 2) + 4 * half;
          bool ok0 = rowok && key <= tq, ok1 = rowok && key + 32 <= tq;
          if constexpr (MODE == M_WIN) { ok0 = ok0 && (tq - key < 512); ok1 = ok1 && (tq - key - 32 < 512); }
          s0[r] = ok0 ? s0[r] : -INFINITY; s1[r] = ok1 ? s1[r] : -INFINITY;
        }
      }
      float mx = -INFINITY;
#pragma unroll
      for (int r = 0; r < 16; ++r) mx = fmaxf(mx, fmaxf(s0[r], s1[r]));
      mx = fmaxf(mx, __shfl_xor(mx, 32));
      const float mn = fmaxf(st.m, mx), alpha = ex2(st.m - mn);
      st.m = mn;
      float sum = 0.f;
#pragma unroll
      for (int r = 0; r < 16; ++r) { s0[r] = ex2(s0[r] - mn); s1[r] = ex2(s1[r] - mn); sum += s0[r] + s1[r]; }
      st.l = st.l * alpha + sum;
#pragma unroll
      for (int r = 0; r < 16; ++r) { st.o[0][r] *= alpha; st.o[1][r] *= alpha; }
      const bf16_t* vr = Vs + l31 * 72 + half * 8;
#pragma unroll
      for (int c = 0; c < 4; ++c) {
        u32x4 pw;
        if (c < 2) pw = (u32x4){pk2(s0[8 * c + 0], s0[8 * c + 1]), pk2(s0[8 * c + 2], s0[8 * c + 3]), pk2(s0[8 * c + 4], s0[8 * c + 5]), pk2(s0[8 * c + 6], s0[8 * c + 7])};
        else pw = (u32x4){pk2(s1[8 * (c - 2) + 0], s1[8 * (c - 2) + 1]), pk2(s1[8 * (c - 2) + 2], s1[8 * (c - 2) + 3]), pk2(s1[8 * (c - 2) + 4], s1[8 * (c - 2) + 5]), pk2(s1[8 * (c - 2) + 6], s1[8 * (c - 2) + 7])};
        const bf16x8 pf = __builtin_bit_cast(bf16x8, pw);
        st.o[0] = mfma32(*(const bf16x8*)(vr + c * 16), pf, st.o[0]);
        st.o[1] = mfma32(*(const bf16x8*)(vr + 32 * 72 + c * 16), pf, st.o[1]);
      }
    }
    if (jn >= 0) sstore(buf ^ 1);
    __syncthreads();
    if (jn < 0) break;
    j = jn; buf ^= 1;
  }
}
DI void astate_init(AState& s) {
#pragma unroll
  for (int r = 0; r < 16; ++r) { s.o[0][r] = 0.f; s.o[1][r] = 0.f; }
  s.m = -1e30f; s.l = 0.f;
}
DI u64 lowbits(int n) { return n >= 64 ? ~0ull : ((1ull << n) - 1ull); }

template <int MODE> DI void dense_attn_item(const Params& p, int b, int h, int qt, bf16_t* smem) {
  const int lane = TIDX() & 63, wid = TIDX() >> 6, l31 = lane & 31, half = lane >> 5;
  const int t0 = qt * 256, tq = t0 + wid * 32 + l31; const size_t trow = (size_t)b * S_ + tq;
  constexpr int NQ = ACfg<MODE>::DQK / 16;
  bf16x8 qf[NQ];
  const bf16_t* qp = MODE == M_FOX ? (const bf16_t*)(p.ws + O_FOXQ) + trow * 512 + h * 64 : (const bf16_t*)(p.ws + O_MLAQ) + trow * 768 + h * 96;
#pragma unroll
  for (int ks = 0; ks < NQ; ++ks) qf[ks] = *(const bf16x8*)(qp + ks * 16 + half * 8);
  AState st; astate_init(st);
  const u64 tmask = lowbits(4 * qt + 4), wmask = lowbits(((t0 + wid * 32 + 31) >> 6) + 1);
  if constexpr (MODE == M_FOX)
    flash_pass<M_FOX>(st, qf, tmask, wmask, (const bf16_t*)(p.ws + O_FOXK) + (size_t)b * S_ * 512 + h * 64, 512, nullptr,
                      (const bf16_t*)(p.ws + O_FOXVT) + (size_t)(b * 8 + h) * 64 * S_, (const float*)(p.ws + O_F2) + (size_t)(b * 8 + h) * S_, tq, 0ull, smem);
  else
    flash_pass<M_MLA>(st, qf, tmask, wmask, (const bf16_t*)(p.ws + O_MLAKN) + (size_t)b * S_ * 512 + h * 64, 512, (const bf16_t*)(p.ws + O_MLAKPE) + (size_t)b * S_ * 32,
                      (const bf16_t*)(p.ws + O_MLAVT) + (size_t)(b * 8 + h) * 64 * S_, nullptr, tq, 0ull, smem);
  const float l = st.l + __shfl_xor(st.l, 32), inv = 1.f / fmaxf(l, 1e-30f);
  bf16_t* op = (bf16_t*)qp;
#pragma unroll
  for (int dt = 0; dt < 2; ++dt)
#pragma unroll
    for (int g4 = 0; g4 < 4; ++g4) {
      const int d = dt * 32 + g4 * 8 + half * 4;
      *(u32x2*)(op + d) = (u32x2){pk2(st.o[dt][4 * g4] * inv, st.o[dt][4 * g4 + 1] * inv), pk2(st.o[dt][4 * g4 + 2] * inv, st.o[dt][4 * g4 + 3] * inv)};
    }
}
DI void nsa_attn_item(const Params& p, int b, int g, int qt, bf16_t* smem) {
  const int lane = TIDX() & 63, wid = TIDX() >> 6, l31 = lane & 31, half = lane >> 5;
  const int t0 = qt * 64, tw0 = t0 + (wid >> 2) * 32, tq = tw0 + l31, head = g * 4 + (wid & 3); const size_t trow = (size_t)b * S_ + tq;
  bf16x8 qf[4];
  const bf16_t* qp = (const bf16_t*)(p.ws + O_NSAQ) + trow * 512 + head * 64;
#pragma unroll
  for (int ks = 0; ks < 4; ++ks) qf[ks] = *(const bf16x8*)(qp + ks * 16 + half * 8);
  {
    const float* rp = (const float*)(p.ws + O_ROPE8) + trow * 16;
    u32x4 me = __builtin_bit_cast(u32x4, qf[0]), ot;
#pragma unroll
    for (int e = 0; e < 4; ++e) ot[e] = __shfl_xor(me[e], 32);
    unsigned res[4];
#pragma unroll
    for (int e = 0; e < 4; ++e) {
      float o2[2];
#pragma unroll
      for (int u = 0; u < 2; ++u) {
        const int f = 2 * e + u; const float cs = rp[2 * f], sn = rp[2 * f + 1];
        const float a = bf2f((bf16_t)(u ? me[e] >> 16 : me[e] & 0xffffu)), o = bf2f((bf16_t)(u ? ot[e] >> 16 : ot[e] & 0xffffu));
        o2[u] = half == 0 ? a * cs - o * sn : a * cs + o * sn;
      }
      res[e] = pk2(o2[0], o2[1]);
    }
    qf[0] = __builtin_bit_cast(bf16x8, (u32x4){res[0], res[1], res[2], res[3]});
  }
  const float* gts = (const float*)(p.ws + O_GATES) + trow * 24 + head * 3;
  const int cur = t0 >> 6;
  f32x16 res[2];
  {
    AState st; astate_init(st);
    const int first = t0 >= 511 ? (t0 - 511) >> 6 : 0, firstw = tw0 >= 511 ? (tw0 - 511) >> 6 : 0;
    const u64 tmask = lowbits(cur + 1) & ~lowbits(first), wmask = lowbits(cur + 1) & ~lowbits(firstw);
    flash_pass<M_WIN>(st, qf, tmask, wmask, (const bf16_t*)(p.ws + O_KWIN) + (size_t)b * S_ * 128 + g * 64, 128, nullptr,
                      (const bf16_t*)(p.ws + O_VWINT) + (size_t)(b * 2 + g) * 64 * S_, nullptr, tq, 0ull, smem);
    const float l = st.l + __shfl_xor(st.l, 32), sc = gts[2] / fmaxf(l, 1e-30f);
#pragma unroll
    for (int r = 0; r < 16; ++r) { res[0][r] = st.o[0][r] * sc; res[1][r] = st.o[1][r] * sc; }
  }
  {
    AState st; astate_init(st);
    const u64* selp = (const u64*)(p.ws + O_SEL) + (size_t)(b * 2 + g) * S_;
    const u64 mysel = selp[tq];
    const u64 m64 = selp[t0 + lane];
    unsigned lo = (unsigned)m64, hi = (unsigned)(m64 >> 32);
#pragma unroll
    for (int o = 32; o >= 1; o >>= 1) { lo |= __shfl_xor(lo, o); hi |= __shfl_xor(hi, o); }
    const u64 um = (((u64)(unsigned)__builtin_amdgcn_readfirstlane(hi) << 32) | (u64)(unsigned)__builtin_amdgcn_readfirstlane(lo)) & lowbits(cur + 1);
    flash_pass<M_SLC>(st, qf, um, um, (const bf16_t*)(p.ws + O_KSLC) + (size_t)b * S_ * 128 + g * 64, 128, nullptr,
                      (const bf16_t*)(p.ws + O_VSLCT) + (size_t)(b * 2 + g) * 64 * S_, nullptr, tq, mysel, smem);
    const float l = st.l + __shfl_xor(st.l, 32), sc = gts[1] / fmaxf(l, 1e-30f);
#pragma unroll
    for (int r = 0; r < 16; ++r) { res[0][r] += st.o[0][r] * sc; res[1][r] += st.o[1][r] * sc; }
  }
  bf16_t* op = (bf16_t*)(p.ws + O_ONSA) + trow * 512 + head * 64;
#pragma unroll
  for (int dt = 0; dt < 2; ++dt)
#pragma unroll
    for (int g4 = 0; g4 < 4; ++g4) {
      const int d = dt * 32 + g4 * 8 + half * 4;
      const u32x2 oc = *(const u32x2*)(op + d);
      const float c0 = bf2f((bf16_t)(oc[0] & 0xffffu)), c1 = bf2f((bf16_t)(oc[0] >> 16)), c2 = bf2f((bf16_t)(oc[1] & 0xffffu)), c3 = bf2f((bf16_t)(oc[1] >> 16));
      *(u32x2*)(op + d) = (u32x2){pk2(res[dt][4 * g4] + c0, res[dt][4 * g4 + 1] + c1), pk2(res[dt][4 * g4 + 2] + c2, res[dt][4 * g4 + 3] + c3)};
    }
}
constexpr int PD_ITEMS = 16 * 192;
DI void phase_d(const Params& p, unsigned char* smem) {
  for (int it = blockIdx.x; it < PD_ITEMS; it += gridDim.x) {
    const int r = it / 192, w = it % 192, qt = 15 - r;
    if (w < 64) dense_attn_item<M_MLA>(p, w >> 3, w & 7, qt, (bf16_t*)smem);
    else if (w < 128) dense_attn_item<M_FOX>(p, (w - 64) >> 3, (w - 64) & 7, qt, (bf16_t*)smem);
    else { const int i = w - 128, bg = i & 15, q4 = i >> 4; nsa_attn_item(p, bg >> 1, bg & 1, qt * 4 + q4, (bf16_t*)smem); }
  }
}

DI void merge_tile(const Params& p, int layer, int tm, int tn, bf16_t* smem) {
  const bf16_t* wl = (const bf16_t*)(p.ws + O_W) + (size_t)layer * W_LAYER;
  const int lane = TIDX() & 63, wid = TIDX() >> 6, wm = wid >> 2, wn = wid & 3, l15 = lane & 15, quad = lane >> 4;
  f32x4 mg[4][2]; zero_acc<4, 2>(mg);
  unsigned* gsp = (unsigned*)((unsigned char*)smem + 2 * GemmLds<4, 2>::STAGE * 2) + TIDX();
#pragma unroll 1
  for (int br = 0; br < 3; ++br) {
    {
      f32x4 ga[4][2]; zero_acc<4, 2>(ga);
      RowPtr ap{(const bf16_t*)(p.ws + O_XG) + (size_t)tm * 128 * D_, (size_t)D_}, bp{wl + W_G + ((size_t)br * 1024 + tn * 128) * D_, (size_t)D_};
      gemm_main<4, 2, true>(ga, ap, 64, bp, 64, 16, smem);
#pragma unroll
      for (int i = 0; i < 4; ++i) {
        const float rs = rstd_from16((const float*)(p.ws + O_SSQ) + (size_t)(tm * 128 + wm * 64 + i * 16 + l15) * 16, 1.f / 1024.f);
#pragma unroll
        for (int j = 0; j < 2; ++j) {
          gsp[((i * 2 + j) * 2 + 0) * NTHR] = pk2(sigmoidf_(ga[i][j][0] * rs), sigmoidf_(ga[i][j][1] * rs));
          gsp[((i * 2 + j) * 2 + 1) * NTHR] = pk2(sigmoidf_(ga[i][j][2] * rs), sigmoidf_(ga[i][j][3] * rs));
        }
      }
    }
    f32x4 ba[4][2]; zero_acc<4, 2>(ba);
    RowPtr bp2{wl + (br == 0 ? W_BN : br == 1 ? W_BF : W_BM) + (size_t)tn * 128 * 512, (size_t)512};
    const bf16_t* abase = (const bf16_t*)(p.ws + (br == 0 ? O_ONSA : br == 1 ? O_FOXQ : O_MLAQ));
    const int ald = br == 2 ? 768 : 512;
    RowPtr ap2{abase + (size_t)tm * 128 * ald, (size_t)ald};
    gemm_main<4, 2, true>(ba, ap2, br == 2 ? 96 : 64, bp2, 64, 8, smem);
#pragma unroll
    for (int i = 0; i < 4; ++i)
#pragma unroll
      for (int j = 0; j < 2; ++j) {
        const unsigned w0 = gsp[((i * 2 + j) * 2 + 0) * NTHR], w1 = gsp[((i * 2 + j) * 2 + 1) * NTHR];
        mg[i][j][0] += bf2f((bf16_t)(w0 & 0xffffu)) * ba[i][j][0];
        mg[i][j][1] += bf2f((bf16_t)(w0 >> 16)) * ba[i][j][1];
        mg[i][j][2] += bf2f((bf16_t)(w1 & 0xffffu)) * ba[i][j][2];
        mg[i][j][3] += bf2f((bf16_t)(w1 >> 16)) * ba[i][j][3];
      }
  }
  bf16_t* stg = (bf16_t*)((unsigned char*)smem + 106496 + wid * 5120);
#pragma unroll
  for (int i = 0; i < 4; ++i)
#pragma unroll
    for (int j = 0; j < 2; ++j) *(u32x2*)(stg + (i * 16 + l15) * 40 + j * 16 + quad * 4) = (u32x2){pk2(mg[i][j][0], mg[i][j][1]), pk2(mg[i][j][2], mg[i][j][3])};
  stage_out<64, 32, 40>(stg, (bf16_t*)(p.ws + O_MERGED) + (size_t)(tm * 128 + wm * 64) * D_ + tn * 128 + wn * 32, (size_t)D_, lane);
}
DI void phase_e(const Params& p, int layer, unsigned char* smem) {
  xcd_tiles(32, 8, [&](int tm, int tn) { merge_tile(p, layer, tm, tn, (bf16_t*)smem); });
}

DI void resid_tile(const Params& p, const bf16_t* A, int K, const bf16_t* W, const float* xold, const float* gnext, int tm, int tn, bf16_t* smem) {
  f32x4 acc[8][4]; zero_acc<8, 4>(acc);
  RowPtr ap{A + (size_t)tm * 256 * K, (size_t)K}, bp{W + (size_t)tn * 256 * K, (size_t)K};
  gemm_main<8, 4, true>(acc, ap, 64, bp, 64, K / 64, smem);
  const int lane = TIDX() & 63, wid = TIDX() >> 6, wm = wid >> 2, wn = wid & 3, l15 = lane & 15, quad = lane >> 4;
  bf16_t* stg = smem + wid * STG_WAVE;
#pragma unroll
  for (int i = 0; i < 8; ++i) {
    const int t = tm * 256 + wm * 128 + i * 16 + l15, c0 = tn * 256 + wn * 64 + quad * 4; float s = 0.f;
#pragma unroll
    for (int j = 0; j < 4; ++j) {
      const size_t off = (size_t)t * D_ + c0 + j * 16;
      const f32x4 xn = *(const f32x4*)(xold + off) + acc[i][j];
      *(f32x4*)(p.out + off) = xn;
      s += xn[0] * xn[0] + xn[1] * xn[1] + xn[2] * xn[2] + xn[3] * xn[3];
      if (gnext) { const f32x4 gv = *(const f32x4*)(gnext + c0 + j * 16); *(u32x2*)(stg + (i * 16 + l15) * STG_LD + j * 16 + quad * 4) = (u32x2){pk2(xn[0] * gv[0], xn[1] * gv[1]), pk2(xn[2] * gv[2], xn[3] * gv[3])}; }
    }
    s += __shfl_xor(s, 16); s += __shfl_xor(s, 32);
    if (quad == 0) ((float*)(p.ws + O_SSQ))[(size_t)t * 16 + tn * 4 + wn] = s;
  }
  if (gnext) stage_out<128, 64, STG_LD>(stg, (bf16_t*)(p.ws + O_XG) + (size_t)(tm * 256 + wm * 128) * D_ + tn * 256 + wn * 64, (size_t)D_, lane);
  __syncthreads();
}
DI void phase_f(const Params& p, int layer, unsigned char* smem) {
  const bf16_t* wl = (const bf16_t*)(p.ws + O_W) + (size_t)layer * W_LAYER;
  xcd_tiles(16, 4, [&](int tm, int tn) { resid_tile(p, (const bf16_t*)(p.ws + O_MERGED), 1024, wl + W_OUT, layer == 0 ? p.x : p.out, p.ffn_norm + layer * D_, tm, tn, (bf16_t*)smem); });
}
DI void phase_h(const Params& p, int layer, unsigned char* smem) {
  const bf16_t* wl = (const bf16_t*)(p.ws + O_W) + (size_t)layer * W_LAYER;
  xcd_tiles(16, 4, [&](int tm, int tn) { resid_tile(p, (const bf16_t*)(p.ws + O_ACT), DFF_, wl + W_DN, p.out, layer == 0 ? p.mix_norm + D_ : nullptr, tm, tn, (bf16_t*)smem); });
}

struct UpRowPtr { const bf16_t* base; int s0;
  DI unsigned operator()(int r) const { const int s = s0 + r; return (unsigned)((s < 0 || s >= S_) ? 0 : s) * (unsigned)D_; }
  DI bool ok(int r) const { const int s = s0 + r; return s >= 0 && s < S_; } };
constexpr int PG_MT = 17;
DI void ffnup_tile(const Params& p, int layer, int b, int mt, int tn, bf16_t* smem) {
  const bf16_t* wl = (const bf16_t*)(p.ws + O_W) + (size_t)layer * W_LAYER;
  f32x4 acc[8][4]; zero_acc<8, 4>(acc);
  const int s0 = 254 * mt - 2;
  UpRowPtr ap{(const bf16_t*)(p.ws + O_XG) + (size_t)b * S_ * D_, s0}; RowPtr bp{wl + W_UP + (size_t)tn * 256 * D_, (size_t)D_};
  gemm_main<8, 4, true>(acc, ap, 64, bp, 64, 16, smem);
  const int tid = TIDX(), lane = tid & 63, wid = tid >> 6, wm = wid >> 2, wn = wid & 3, l15 = lane & 15, quad = lane >> 4;
  constexpr int LDU = 132; float* U = (float*)smem;
  if (wn < 2) {
#pragma unroll
    for (int i = 0; i < 8; ++i) {
      const int row = wm * 128 + i * 16 + l15, s = s0 + row;
      const float rs = (s >= 0 && s < S_) ? rstd_from16((const float*)(p.ws + O_SSQ) + ((size_t)b * S_ + s) * 16, 1.f / 1024.f) : 0.f;
      float* dst = U + row * LDU + wn * 64 + quad * 4;
#pragma unroll
      for (int j = 0; j < 4; ++j) *(f32x4*)(dst + j * 16) = acc[i][j] * rs;
    }
  }
  __syncthreads();
  if (wn >= 2) {
    const int cl = (wn - 2) * 64 + quad * 4;
    bf16_t* act = (bf16_t*)(p.ws + O_ACT);
#pragma unroll
    for (int j = 0; j < 4; ++j) {
      const int cg0 = tn * 128 + cl + j * 16;
      const float* cw = p.conv_w + (size_t)layer * 3 * DFF_ + cg0; const f32x4 w0 = *(const f32x4*)cw, w1 = *(const f32x4*)(cw + DFF_), w2 = *(const f32x4*)(cw + 2 * DFF_);
      const f32x4 cb = *(const f32x4*)(p.conv_b + (size_t)layer * DFF_ + cg0);
#pragma unroll
      for (int i = 0; i < 8; ++i) {
        const int row = wm * 128 + i * 16 + l15, s = s0 + row;
        if (row >= 2 && s < S_) {
          const float rs = rstd_from16((const float*)(p.ws + O_SSQ) + ((size_t)b * S_ + s) * 16, 1.f / 1024.f);
          const float* up = U + row * LDU + cl + j * 16;
          const f32x4 u0 = *(const f32x4*)(up - 2 * LDU), u1 = *(const f32x4*)(up - LDU), u2 = *(const f32x4*)up;
          float o[4];
#pragma unroll
          for (int r = 0; r < 4; ++r) { const float uc = w0[r] * u0[r] + w1[r] * u1[r] + w2[r] * u2[r] + cb[r]; o[r] = uc * sigmoidf_(uc) * (acc[i][j][r] * rs); }
          *(u32x2*)(act + ((size_t)b * S_ + s) * DFF_ + cg0) = (u32x2){pk2(o[0], o[1]), pk2(o[2], o[3])};
        }
      }
    }
  }
  __syncthreads();
}
DI void phase_g(const Params& p, int layer, unsigned char* smem) {
  xcd_tiles(PG_MT, 22, [&](int tmg, int tn) { ffnup_tile(p, layer, tmg / PG_MT, tmg % PG_MT, tn, (bf16_t*)smem); });
}

DI void phase_final(const Params& p) {
  const int lane = TIDX() & 63, wid = TIDX() >> 6;
  for (int it = blockIdx.x; it < T_ / 8; it += gridDim.x) {
    const int t = it * 8 + wid; const float rs = rstd_from16((const float*)(p.ws + O_SSQ) + (size_t)t * 16, 1.f / 1024.f);
    float* xr = p.out + (size_t)t * D_;
#pragma unroll
    for (int c = 0; c < 4; ++c) { const int k = c * 256 + lane * 4; const f32x4 v = *(const f32x4*)(xr + k), gv = *(const f32x4*)(p.final_norm + k); *(f32x4*)(xr + k) = v * rs * gv; }
  }
}

#define XB_TMO      128
#define XB_XCNT(j)  (256  + 64 * (j))
#define XB_XSUB(j)  (1280 + 64 * (j))
#define XB_XGEN(j)  (2304 + 64 * (j))
#define XB_TOP      3328
#define XB_TOPGEN   3392
#define XCD_BAR_WORDS 3456
#define XB_SPIN_CAP (1u << 22)
#define LAS __attribute__((address_space(3)))
DI unsigned xb_ld(unsigned* p)              { return __hip_atomic_load(p, __ATOMIC_RELAXED, __HIP_MEMORY_SCOPE_AGENT); }
DI unsigned xb_add(unsigned* p, unsigned v) { return __hip_atomic_fetch_add(p, v, __ATOMIC_RELAXED, __HIP_MEMORY_SCOPE_AGENT); }
DI unsigned xb_xcc_id() { return (unsigned)__builtin_amdgcn_s_getreg((3 << 11) | 20) & 0xFu; }
#define XB_SPIN(cond, bar) do { unsigned _sp = 0; while (cond) { __builtin_amdgcn_s_sleep(1); \
    if ((++_sp & 255u) == 0u) { if (xb_ld(&(bar)[XB_TMO])) break; if (_sp > XB_SPIN_CAP) { atomicAdd(&(bar)[XB_TMO], 1u); break; } } } } while (0)
struct XcdBarrier { unsigned* bar; unsigned x; volatile LAS unsigned* st; };
DI XcdBarrier xcd_barrier_post(unsigned* bar, volatile LAS unsigned* st) {
  XcdBarrier b; b.bar = bar; b.x = xb_xcc_id(); b.st = st;
  if (threadIdx.x == 0) (void)xb_add(&bar[XB_XCNT(b.x)], 1u);
  return b;
}
DI void xcd_barrier_complete(unsigned* bar, unsigned x, unsigned& nloc, unsigned& nx) {
  const unsigned G = gridDim.x * gridDim.y * gridDim.z;
  unsigned sum, cnt, mine, sp = 0u;
  for (;;) {
    sum = 0u; cnt = 0u; mine = 0u;
#pragma unroll
    for (unsigned j = 0; j < 16; ++j) { const unsigned c = xb_ld(&bar[XB_XCNT(j)]); sum += c; cnt += (c > 0u) ? 1u : 0u; mine = (j == x) ? c : mine; }
    if (sum == G) break;
    __builtin_amdgcn_s_sleep(1);
    if ((++sp & 255u) == 0u) { if (xb_ld(&bar[XB_TMO])) break; if (sp > XB_SPIN_CAP) { atomicAdd(&bar[XB_TMO], 1u); break; } }
  }
  nloc = mine > 0u ? mine : 1u; nx = cnt > 0u ? cnt : 1u;
}
DI void xcd_barrier(const XcdBarrier& b) {
  asm volatile("s_waitcnt vmcnt(0)" ::: "memory");
  __syncthreads();
  if (threadIdx.x == 0) {
    unsigned* bar = b.bar;
    __builtin_amdgcn_s_waitcnt(0);
    unsigned nloc = b.st[0], nx = b.st[1];
    if (nloc == 0u) { xcd_barrier_complete(bar, b.x, nloc, nx); b.st[0] = nloc; b.st[1] = nx; }
    const unsigned old = xb_add(&bar[XB_XSUB(b.x)], 1u);
    const unsigned gen = old / nloc;
    if (old + 1u == (gen + 1u) * nloc) {
      __builtin_amdgcn_fence(__ATOMIC_RELEASE, "agent");
      asm volatile("s_waitcnt vmcnt(0)" ::: "memory");
      const unsigned og = xb_add(&bar[XB_TOP], 1u);
      const unsigned tg = og / nx;
      if (og + 1u == (tg + 1u) * nx) xb_add(&bar[XB_TOPGEN], 1u);
      else XB_SPIN(xb_ld(&bar[XB_TOPGEN]) == tg, bar);
      __builtin_amdgcn_fence(__ATOMIC_ACQUIRE, "agent");
      xb_add(&bar[XB_XGEN(b.x)], 1u);
      asm volatile("s_waitcnt vmcnt(0)" ::: "memory");
    } else {
      XB_SPIN(xb_ld(&bar[XB_XGEN(b.x)]) == gen, bar);
      __builtin_amdgcn_fence(__ATOMIC_ACQUIRE, "agent");
      asm volatile("s_waitcnt vmcnt(0)" ::: "memory");
    }
  }
  __syncthreads();
}
DI void run_phase(const Params& p, int ph, unsigned char* smem) {
  if (ph == 0) { phase_prep(p, smem); return; }
  if (ph == 17) { phase_final(p); return; }
  const int layer = (ph - 1) >> 3, s = (ph - 1) & 7;
#ifdef PROBE_DUP
  if ((PROBE_DUP >> s) & 1) {
    switch (s) { case 0: phase_inproj(p, layer, smem); break; case 1: phase_b(p, layer, smem); break; case 2: phase_c(p, smem); break; case 4: phase_e(p, layer, smem); break; case 6: phase_g(p, layer, smem); break; default: break; }
    __syncthreads();
  }
#endif
  switch (s) {
    case 0: phase_inproj(p, layer, smem); break;
    case 1: phase_b(p, layer, smem); break;
    case 2: phase_c(p, smem); break;
    case 3: phase_d(p, smem); break;
    case 4: phase_e(p, layer, smem); break;
    case 5: phase_f(p, layer, smem); break;
    case 6: phase_g(p, layer, smem); break;
    default: phase_h(p, layer, smem); break;
  }
}
constexpr int N_PHASES = 18;

#if ONE_LAUNCH
template <int PH> DI void run_all(const Params& p, unsigned char* smem, cg::grid_group& grid, const XcdBarrier& xb) {
  run_phase(p, PH, smem);
  if constexpr (PH + 1 < N_PHASES) {
    if constexpr (PH == 0) grid.sync(); else xcd_barrier(xb);
    run_all<PH + 1>(p, smem, grid, xb);
  }
}
__global__ void __launch_bounds__(NTHR, 2) mega_kernel(Params p) {
  __shared__ __attribute__((aligned(16))) unsigned char smem[SMEM_BYTES];
  __shared__ uint4 xb_words;
  if (threadIdx.x == 0) xb_words = make_uint4(0u, 0u, 0u, 0u);
  __syncthreads();
  const XcdBarrier xb = xcd_barrier_post((unsigned*)(p.ws + O_BAR), (volatile LAS unsigned*)&xb_words);
  cg::grid_group grid = cg::this_grid();
  run_all<0>(p, smem, grid, xb);
}
#else
template <int PH> __global__ void __launch_bounds__(NTHR, 2) phase_kernel(Params p) {
  __shared__ __attribute__((aligned(16))) unsigned char smem[SMEM_BYTES];
  run_phase(p, PH, smem);
}
template <int PH> static void launch_phases(const Params& p, hipStream_t stream) {
  hipLaunchKernelGGL((phase_kernel<PH>), dim3(256), dim3(NTHR), 0, stream, p);
  if constexpr (PH + 1 < N_PHASES) launch_phases<PH + 1>(p, stream);
}
#endif

extern "C" void kernel_launch(void* const* d_in, const int* in_sizes, int n_in, void* d_out, int out_size, void* d_ws, size_t ws_size, hipStream_t stream) {
  if (ws_size < O_END || n_in < 25) { fprintf(stderr, "workspace too small: %zu < %zu\n", ws_size, (size_t)O_END); return; }
  Params p{};
  p.x = (const float*)d_in[0]; p.pos = (const int*)d_in[1]; p.mix_norm = (const float*)d_in[2]; p.w_in = (const float*)d_in[3]; p.b_forget = (const float*)d_in[4];
  p.pe_k = (const float*)d_in[5]; p.w1_k = (const float*)d_in[6]; p.w2_k = (const float*)d_in[7]; p.pe_v = (const float*)d_in[8]; p.w1_v = (const float*)d_in[9]; p.w2_v = (const float*)d_in[10];
  p.q_norm = (const float*)d_in[11]; p.w_uq = (const float*)d_in[12]; p.kv_norm = (const float*)d_in[13]; p.w_ukv = (const float*)d_in[14];
  p.wbr_nsa = (const float*)d_in[15]; p.wbr_fox = (const float*)d_in[16]; p.wbr_mla = (const float*)d_in[17]; p.w_out = (const float*)d_in[18];
  p.ffn_norm = (const float*)d_in[19]; p.w_up = (const float*)d_in[20]; p.conv_w = (const float*)d_in[21]; p.conv_b = (const float*)d_in[22]; p.w_down = (const float*)d_in[23]; p.final_norm = (const float*)d_in[24];
  p.out = (float*)d_out; p.ws = (unsigned char*)d_ws;
#if ONE_LAUNCH
  static int grid_blocks = 0;
  if (!grid_blocks) {
    int dev = 0, cus = 0, per_cu = 0;
    hipGetDevice(&dev); hipDeviceGetAttribute(&cus, hipDeviceAttributeMultiprocessorCount, dev);
    hipOccupancyMaxActiveBlocksPerMultiprocessor(&per_cu, mega_kernel, NTHR, 0);
    if (per_cu > 1) per_cu = 1;
    grid_blocks = cus * per_cu;
  }
  hipMemsetAsync(p.ws + O_BAR, 0, XCD_BAR_WORDS * 4, stream);
  void* args[] = {&p};
  hipError_t e = hipLaunchCooperativeKernel((void*)mega_kernel, dim3(grid_blocks), dim3(NTHR), args, 0, stream);
  if (e != hipSuccess) fprintf(stderr, "cooperative launch failed: %s (grid %d)\n", hipGetErrorString(e), grid_blocks);
#else
  launch_phases<0>(p, stream);
#endif
}
```

```cpp
#include <hip/hip_runtime.h>
#include <hip/hip_cooperative_groups.h>
#include <stdint.h>
#include <stdio.h>
#include <type_traits>
namespace cg = cooperative_groups;

#ifndef ONE_LAUNCH
#define ONE_LAUNCH 1

#endif

#define DI __device__ __forceinline__
typedef unsigned short bf16_t;
typedef short bf16x8 __attribute__((ext_vector_type(8)));
typedef float f32x4 __attribute__((ext_vector_type(4)));
typedef float f32x16 __attribute__((ext_vector_type(16)));
typedef float f32x2 __attribute__((ext_vector_type(2)));
typedef __bf16 bfx2 __attribute__((ext_vector_type(2)));
typedef unsigned u32x4 __attribute__((ext_vector_type(4)));
typedef unsigned u32x2 __attribute__((ext_vector_type(2)));
typedef unsigned long long u64;

constexpr int T_ = 32768, S_ = 4096, NB_ = 8, D_ = 1024, DFF_ = 2816, NIN_ = 6592;
constexpr float EPS_ = 1e-6f;
constexpr float LOG2E_ = 1.4426950408889634f;
constexpr float QS64_ = 0.125f * LOG2E_;
constexpr float QS96_ = 0.10206207261596577f * LOG2E_;

constexpr size_t W_IN = 0;
constexpr size_t W_G = W_IN + (size_t)3584 * 1024;
constexpr size_t W_1K = W_G + (size_t)3072 * 1024;
constexpr size_t W_1V = W_1K + (size_t)256 * 2048;
constexpr size_t W_2K = W_1V + (size_t)256 * 2048;
constexpr size_t W_2V = W_2K + (size_t)64 * 256;
constexpr size_t W_UQ = W_2V + (size_t)64 * 256;
constexpr size_t W_UKV = W_UQ + (size_t)768 * 384;
constexpr size_t W_BN = W_UKV + (size_t)1024 * 256;
constexpr size_t W_BF = W_BN + (size_t)1024 * 512;
constexpr size_t W_BM = W_BF + (size_t)1024 * 512;
constexpr size_t W_OUT = W_BM + (size_t)1024 * 512;
constexpr size_t W_UP = W_OUT + (size_t)1024 * 1024;
constexpr size_t W_DN = W_UP + (size_t)5632 * 1024;
constexpr size_t W_LAYER = W_DN + (size_t)1024 * 2816;

constexpr size_t al256(size_t x) { return (x + 255) & ~(size_t)255; }
constexpr size_t O_BAR = 0;
constexpr size_t O_W = 16384;
constexpr size_t O_BIAS1 = al256(O_W + 2 * W_LAYER * 2);
constexpr size_t O_ROPE8 = al256(O_BIAS1 + 2 * 2 * 256 * 4);
constexpr size_t O_ROPE16 = al256(O_ROPE8 + (size_t)T_ * 16 * 4);
constexpr size_t O_XG = al256(O_ROPE16 + (size_t)T_ * 32 * 4);
constexpr size_t O_SSQ = al256(O_XG + (size_t)T_ * 1024 * 2);
constexpr size_t O_CSSQ = al256(O_SSQ + (size_t)T_ * 16 * 4);
constexpr size_t O_NSAQ = al256(O_CSSQ + (size_t)T_ * 16 * 4);
constexpr size_t O_KVCMP = O_NSAQ + (size_t)T_ * 512 * 2;
constexpr size_t O_KSLC = O_KVCMP + (size_t)T_ * 256 * 2;
constexpr size_t O_KWIN = O_KSLC + (size_t)T_ * 128 * 2;
constexpr size_t O_MERGED = O_NSAQ;
constexpr size_t O_VSLCT = O_KWIN + (size_t)T_ * 128 * 2;
constexpr size_t O_VWINT = O_VSLCT + (size_t)T_ * 128 * 2;
constexpr size_t O_FOXQ = O_VWINT + (size_t)T_ * 128 * 2;
constexpr size_t O_FOXK = O_FOXQ + (size_t)T_ * 512 * 2;
constexpr size_t O_FOXVT = O_FOXK + (size_t)T_ * 512 * 2;
constexpr size_t O_MLAQ = O_FOXVT + (size_t)T_ * 512 * 2;
constexpr size_t O_MLAKN = O_MLAQ + (size_t)T_ * 768 * 2;
constexpr size_t O_ACT = O_FOXQ;
constexpr size_t O_MLAVT = O_MLAKN + (size_t)T_ * 512 * 2;
constexpr size_t O_MLAKPE = O_MLAVT + (size_t)T_ * 512 * 2;
constexpr size_t O_ONSA = O_MLAKPE + (size_t)T_ * 32 * 2;
constexpr size_t O_CQ = O_ONSA;
constexpr size_t O_CKV = O_CQ + (size_t)T_ * 384 * 2;
constexpr size_t O_CEND = O_CKV + (size_t)T_ * 256 * 2;
constexpr size_t O_GATES = al256(O_CEND > O_ONSA + (size_t)T_ * 512 * 2 ? O_CEND : O_ONSA + (size_t)T_ * 512 * 2);
constexpr size_t O_LOGF = al256(O_GATES + (size_t)T_ * 24 * 4);
constexpr size_t O_F2 = al256(O_LOGF + (size_t)T_ * 8 * 4);
constexpr size_t O_KC = al256(O_F2 + (size_t)T_ * 8 * 4);
constexpr size_t O_VCT = al256(O_KC + (size_t)NB_ * 2 * 256 * 64 * 2);
constexpr size_t O_SEL = al256(O_VCT + (size_t)NB_ * 2 * 256 * 64 * 2);
constexpr size_t O_END = al256(O_SEL + (size_t)NB_ * 2 * S_ * 8);

struct Params {
  const float* x; const int* pos; const float* mix_norm; const float* w_in; const float* b_forget;
  const float* pe_k; const float* w1_k; const float* w2_k; const float* pe_v; const float* w1_v; const float* w2_v;
  const float* q_norm; const float* w_uq; const float* kv_norm; const float* w_ukv;
  const float* wbr_nsa; const float* wbr_fox; const float* wbr_mla; const float* w_out;
  const float* ffn_norm; const float* w_up; const float* conv_w; const float* conv_b; const float* w_down; const float* final_norm;
  float* out; unsigned char* ws;
};

constexpr int NTHR = 512;
constexpr int SMEM_BYTES = 147456;

DI int TIDX() { int t = (int)threadIdx.x; asm volatile("" : "+v"(t)); return t; }
DI unsigned pk2(float lo, float hi) { f32x2 v = {lo, hi}; return __builtin_bit_cast(unsigned, __builtin_convertvector(v, bfx2)); }
DI bf16_t f2bf(float x) { return (bf16_t)(pk2(x, 0.f) & 0xffffu); }
DI float bf2f(bf16_t h) { return __uint_as_float(((unsigned)h) << 16); }
DI float sigmoidf_(float x) { return 1.f / (1.f + __expf(-x)); }
DI float gelu_tanh(float x) { const float u = 0.7978845608028654f * (x + 0.044715f * x * x * x); return x / (1.f + __expf(-2.f * u)); }
DI float ex2(float x) { return __builtin_amdgcn_exp2f(x); }
DI f32x16 mfma32(bf16x8 a, bf16x8 b, f32x16 c) { return __builtin_amdgcn_mfma_f32_32x32x16_bf16(a, b, c, 0, 0, 0); }
DI f32x4 mfma16(bf16x8 a, bf16x8 b, f32x4 c) { return __builtin_amdgcn_mfma_f32_16x16x32_bf16(a, b, c, 0, 0, 0); }
DI float rstd_from16(const float* p, float inv_n) {
  const f32x4 a = *(const f32x4*)p, b = *(const f32x4*)(p + 4), c = *(const f32x4*)(p + 8), d = *(const f32x4*)(p + 12);
  const float s = ((a[0] + a[1]) + (a[2] + a[3])) + ((b[0] + b[1]) + (b[2] + b[3])) + ((c[0] + c[1]) + (c[2] + c[3])) + ((d[0] + d[1]) + (d[2] + d[3]));
  return rsqrtf(s * inv_n + EPS_);
}

constexpr int LDT = 72;
template <int MI, int NJ> struct GemmLds { static constexpr int BM = 32 * MI, BN = 64 * NJ, A_ELEMS = BM * LDT, B_ELEMS = BN * LDT, STAGE = A_ELEMS + B_ELEMS; };

template <int MI, int NJ, bool SWAP, class AP, class BP>
DI void gemm_main(f32x4 (&acc)[MI][NJ], const AP& ap, int a_kstep, const BP& bp, int b_kstep, int nk, bf16_t* smem) {
  typedef GemmLds<MI, NJ> L;
  constexpr int CA = MI / 2, CB = NJ;
  const int tid = TIDX(), lane = tid & 63, wid = tid >> 6, wm = wid >> 2, wn = wid & 3, l15 = lane & 15, quad = lane >> 4;
  unsigned pa[CA], pb[CB]; bool oka[CA];
#pragma unroll
  for (int i = 0; i < CA; ++i) { const int c = tid + NTHR * i; pa[i] = ap(c >> 3) + (c & 7) * 8; oka[i] = ap.ok(c >> 3); }
#pragma unroll
  for (int i = 0; i < CB; ++i) { const int c = tid + NTHR * i; pb[i] = bp(c >> 3) + (c & 7) * 8; }
  u32x4 ra[CA], rb[CB];
  auto gload = [&](int kt) {
    const bf16_t* ab = ap.base + (size_t)kt * a_kstep; const bf16_t* bb = bp.base + (size_t)kt * b_kstep;
#pragma unroll
    for (int i = 0; i < CA; ++i) ra[i] = *(const u32x4*)(ab + pa[i]);
#pragma unroll
    for (int i = 0; i < CB; ++i) rb[i] = *(const u32x4*)(bb + pb[i]);
  };
  auto sstore = [&](int buf) {
    bf16_t* As = smem + buf * L::STAGE; bf16_t* Bs = As + L::A_ELEMS;
#pragma unroll
    for (int i = 0; i < CA; ++i) { const int c = tid + NTHR * i; *(u32x4*)(As + (c >> 3) * LDT + (c & 7) * 8) = oka[i] ? ra[i] : (u32x4){0u, 0u, 0u, 0u}; }
#pragma unroll
    for (int i = 0; i < CB; ++i) { const int c = tid + NTHR * i; *(u32x4*)(Bs + (c >> 3) * LDT + (c & 7) * 8) = rb[i]; }
  };
  gload(0); sstore(0); __syncthreads();
#pragma unroll 1
  for (int kt = 0; kt < nk; ++kt) {
    const int buf = kt & 1;
    gload(kt + 1 < nk ? kt + 1 : nk - 1);
    __builtin_amdgcn_sched_barrier(0);
    const bf16_t* As = smem + buf * L::STAGE + (wm * 16 * MI + l15) * LDT + quad * 8;
    const bf16_t* Bs = smem + buf * L::STAGE + L::A_ELEMS + (wn * 16 * NJ + l15) * LDT + quad * 8;
#pragma unroll
    for (int ks = 0; ks < 2; ++ks) {
      if (MI * NJ >= 32 && ks == 1) asm volatile("" ::: "memory");
      bf16x8 b[NJ];
#pragma unroll
      for (int j = 0; j < NJ; ++j) b[j] = *(const bf16x8*)(Bs + j * 16 * LDT + ks * 32);
#pragma unroll
      for (int i = 0; i < MI; ++i) {
        const bf16x8 a = *(const bf16x8*)(As + i * 16 * LDT + ks * 32);
#pragma unroll
        for (int j = 0; j < NJ; ++j) acc[i][j] = SWAP ? mfma16(b[j], a, acc[i][j]) : mfma16(a, b[j], acc[i][j]);
      }
    }
    sstore(buf ^ 1);
    __syncthreads();
  }
}
template <int MI, int NJ> DI void zero_acc(f32x4 (&acc)[MI][NJ]) {
#pragma unroll
  for (int i = 0; i < MI; ++i)
#pragma unroll
    for (int j = 0; j < NJ; ++j) acc[i][j] = (f32x4){0.f, 0.f, 0.f, 0.f};
}
struct RowPtr { const bf16_t* base; size_t ld; DI unsigned operator()(int r) const { return (unsigned)r * (unsigned)ld; } DI bool ok(int) const { return true; } };


template <class F> DI void xcd_tiles(int MPX, int NT, F&& body) {
  const int xcd = blockIdx.x & 7, slot = blockIdx.x >> 3, nslots = gridDim.x >> 3, total = MPX * NT;
  for (int li = slot; li < total; li += nslots) {
    const int mg = li / (8 * NT), rem = li - mg * 8 * NT;
    const int gsz = (MPX - mg * 8) < 8 ? (MPX - mg * 8) : 8;
    const int tn = rem / gsz, mi = rem - tn * gsz;
    body(xcd * MPX + mg * 8 + mi, tn);
  }
}

DI int map_col(int map, int n) {
  if (map == 0) return n;
  if (map == 1) {
    if (n < 896) return n;
    if (n < 1024) return 1024 + (n - 896);
    if (n < 1152) return 896 + (n - 1024);
    if (n < 1280) return n;
    if (n < 2816) return 1304 + (n - 1280);
    if (n < 3200) return 2848 + (n - 2816);
    if (n < 3456) return 3232 + (n - 3200);
    const int c = n - 3456;
    if (c < 24) return 1280 + c;
    if (c < 32) return 2840 + (c - 24);
    if (c < 64) return 3488 + (c - 32);
    return -1;
  }
  if (map == 2) { const int j = n >> 8, c = n & 255; return c < 128 ? j * 128 + c : DFF_ + j * 128 + (c - 128); }
  if (map == 3) { return n < 512 ? (n >> 6) * 128 + (n & 63) : ((n - 512) >> 6) * 128 + 64 + ((n - 512) & 63); }
  return n;
}
struct WJob { const float* src; const float* scale; bf16_t* dst; int K, N, ld, map, off; };
DI void prep_weight_tile(const WJob& j, int tile, float* lds) {
  const int ntn = j.N >> 6, tk = tile / ntn, tn = tile % ntn, tid = TIDX();
  const int n = tn * 64 + (tid & 63); const int sc = map_col(j.map, n);
#pragma unroll 4
  for (int i = 0; i < 8; ++i) {
    const int kk = (tid >> 6) + 8 * i, k = tk * 64 + kk;
    float v = sc >= 0 ? j.src[(size_t)k * j.ld + j.off + sc] : 0.f;
    if (j.scale) v *= j.scale[k];
    lds[kk * 65 + (tid & 63)] = v;
  }
  __syncthreads();
  const int nn = tid >> 3, k0 = (tid & 7) * 8;
  unsigned w[4];
#pragma unroll
  for (int e = 0; e < 4; ++e) w[e] = pk2(lds[(k0 + 2 * e) * 65 + nn], lds[(k0 + 2 * e + 1) * 65 + nn]);
  bf16_t* d = j.dst + (size_t)(tn * 64 + nn) * j.K + tk * 64 + k0;
  *(u32x4*)d = (u32x4){w[0], w[1], w[2], w[3]};
  __syncthreads();
}
DI WJob get_wjob(const Params& p, int layer, int id) {
  bf16_t* wl = (bf16_t*)(p.ws + O_W) + (size_t)layer * W_LAYER; WJob j; j.scale = nullptr; j.map = 0; j.off = 0;
  switch (id) {
    case 0: j.src = p.w_in + (size_t)layer * 1024 * NIN_; j.dst = wl + W_IN; j.K = 1024; j.N = 3584; j.ld = NIN_; j.map = 1; break;
    case 1: j.src = p.w_in + (size_t)layer * 1024 * NIN_; j.dst = wl + W_G; j.K = 1024; j.N = 3072; j.ld = NIN_; j.off = 3520; break;
    case 2: j.src = p.w1_k + (size_t)layer * 2048 * 256; j.dst = wl + W_1K; j.K = 2048; j.N = 256; j.ld = 256; break;
    case 3: j.src = p.w1_v + (size_t)layer * 2048 * 256; j.dst = wl + W_1V; j.K = 2048; j.N = 256; j.ld = 256; break;
    case 4: j.src = p.w2_k + (size_t)layer * 256 * 64; j.dst = wl + W_2K; j.K = 256; j.N = 64; j.ld = 64; break;
    case 5: j.src = p.w2_v + (size_t)layer * 256 * 64; j.dst = wl + W_2V; j.K = 256; j.N = 64; j.ld = 64; break;
    case 6: j.src = p.w_uq + (size_t)layer * 384 * 768; j.dst = wl + W_UQ; j.K = 384; j.N = 768; j.ld = 768; j.scale = p.q_norm + layer * 384; break;
    case 7: j.src = p.w_ukv + (size_t)layer * 256 * 1024; j.dst = wl + W_UKV; j.K = 256; j.N = 1024; j.ld = 1024; j.scale = p.kv_norm + layer * 256; j.map = 3; break;
    case 8: j.src = p.wbr_nsa + (size_t)layer * 512 * 1024; j.dst = wl + W_BN; j.K = 512; j.N = 1024; j.ld = 1024; break;
    case 9: j.src = p.wbr_fox + (size_t)layer * 512 * 1024; j.dst = wl + W_BF; j.K = 512; j.N = 1024; j.ld = 1024; break;
    case 10: j.src = p.wbr_mla + (size_t)layer * 512 * 1024; j.dst = wl + W_BM; j.K = 512; j.N = 1024; j.ld = 1024; break;
    case 11: j.src = p.w_out + (size_t)layer * 1024 * 1024; j.dst = wl + W_OUT; j.K = 1024; j.N = 1024; j.ld = 1024; break;
    case 12: j.src = p.w_up + (size_t)layer * 1024 * 5632; j.dst = wl + W_UP; j.K = 1024; j.N = 5632; j.ld = 5632; j.map = 2; break;
    default: j.src = p.w_down + (size_t)layer * 2816 * 1024; j.dst = wl + W_DN; j.K = 2816; j.N = 1024; j.ld = 1024; break;
  }
  return j;
}
constexpr int WTILES_LAYER = (int)(W_LAYER / 4096);
constexpr int P0_XITEMS = T_ / 64;
constexpr int P0_ROPE_ITEMS = T_ / NTHR;
constexpr int P0_ITEMS = 2 * WTILES_LAYER + 4 + P0_ROPE_ITEMS + P0_XITEMS;

DI void xg_rows(const float* x, const float* g, bf16_t* xg, float* ssq, int row0) {
  const int lane = TIDX() & 63, wid = TIDX() >> 6;
  for (int rr = 0; rr < 8; ++rr) {
    const int t = row0 + wid * 8 + rr; const float* xr = x + (size_t)t * D_; float s = 0.f;
#pragma unroll
    for (int c = 0; c < 4; ++c) {
      const int k = c * 256 + lane * 4; const f32x4 v = *(const f32x4*)(xr + k), gv = *(const f32x4*)(g + k);
      s += v[0] * v[0] + v[1] * v[1] + v[2] * v[2] + v[3] * v[3];
      *(u32x2*)(xg + (size_t)t * D_ + k) = (u32x2){pk2(v[0] * gv[0], v[1] * gv[1]), pk2(v[2] * gv[2], v[3] * gv[3])};
    }
#pragma unroll
    for (int o = 32; o >= 1; o >>= 1) s += __shfl_xor(s, o);
    if (lane < 16) ssq[(size_t)t * 16 + lane] = lane == 0 ? s : 0.f;
  }
}
DI void phase_prep(const Params& p, unsigned char* smem) {
  for (int it = blockIdx.x; it < P0_ITEMS; it += gridDim.x) {
    int i = it;
    if (i < 2 * WTILES_LAYER) {
      const int layer = i / WTILES_LAYER; int t = i % WTILES_LAYER; int id = 0;
      for (;; ++id) { const WJob j = get_wjob(p, layer, id); const int nt = (j.K >> 6) * (j.N >> 6); if (t < nt) { prep_weight_tile(j, t, (float*)smem); break; } t -= nt; }
      continue;
    }
    i -= 2 * WTILES_LAYER;
    if (i < 4) {
      const int layer = i >> 1, kv = i & 1, c = TIDX();
      if (c < 256) {
        const float* pe = (kv ? p.pe_v : p.pe_k) + (size_t)layer * 2048; const float* w1 = (kv ? p.w1_v : p.w1_k) + (size_t)layer * 2048 * 256;
        float s = 0.f;
        for (int kk = 0; kk < 2048; ++kk) s += pe[kk] * w1[(size_t)kk * 256 + c];
        ((float*)(p.ws + O_BIAS1))[(layer * 2 + kv) * 256 + c] = s;
      }
      continue;
    }
    i -= 4;
    if (i < P0_ROPE_ITEMS) {
      const int t = i * NTHR + TIDX(); const float fp = (float)p.pos[t];
      float* r8 = (float*)(p.ws + O_ROPE8) + (size_t)t * 16; float* r16 = (float*)(p.ws + O_ROPE16) + (size_t)t * 32;
      for (int f = 0; f < 24; ++f) {
        const int half = f < 8 ? 8 : 16, idx = f < 8 ? f : f - 8;
        const float inv = exp2f(-(float)idx / (float)half * 18.931568569324174f);
        const float ang = fp * inv;
        const double rev = (double)ang * 0.15915494309189535; const float fr = (float)(rev - floor(rev));
        const float sn = __builtin_amdgcn_sinf(fr), cs = __builtin_amdgcn_cosf(fr);
        if (f < 8) { r8[2 * idx] = cs; r8[2 * idx + 1] = sn; } else { r16[2 * idx] = cs; r16[2 * idx + 1] = sn; }
      }
      continue;
    }
    i -= P0_ROPE_ITEMS;
    xg_rows(p.x, p.mix_norm, (bf16_t*)(p.ws + O_XG), (float*)(p.ws + O_SSQ), i * 64);
  }
}

DI void store4(bf16_t* dst, const f32x4& v, float s) { *(u32x2*)dst = (u32x2){pk2(v[0] * s, v[1] * s), pk2(v[2] * s, v[3] * s)}; }
constexpr int STG_LD = 72, STG_WAVE = 128 * 72;
DI void stage4(bf16_t* stg, int row, int col, const f32x4& v, float s) { *(u32x2*)(stg + row * STG_LD + col) = (u32x2){pk2(v[0] * s, v[1] * s), pk2(v[2] * s, v[3] * s)}; }
template <int ROWS, int COLS, int LD> DI void stage_out(const bf16_t* stg, bf16_t* dst, size_t ld, int lane) {
  asm volatile("s_waitcnt lgkmcnt(0)" ::: "memory");
  constexpr int CPR = COLS / 8, IT = ROWS * CPR / 64;
#pragma unroll
  for (int it = 0; it < IT; ++it) {
    const int idx = it * 64 + lane, r = idx / CPR, c = idx % CPR;
    __builtin_nontemporal_store(*(const u32x4*)(stg + r * LD + c * 8), (u32x4*)(dst + (size_t)r * ld + c * 8));
  }
}
template <bool SWAP> DI void inproj_tile(const Params& p, int layer, int tm, int tn, bf16_t* smem) {
  const bf16_t* wl = (const bf16_t*)(p.ws + O_W) + (size_t)layer * W_LAYER;
  f32x4 acc[8][4]; zero_acc<8, 4>(acc);
  RowPtr ap{(const bf16_t*)(p.ws + O_XG) + (size_t)tm * 256 * D_, (size_t)D_}, bp{wl + W_IN + (size_t)tn * 256 * D_, (size_t)D_};
  gemm_main<8, 4, SWAP>(acc, ap, 64, bp, 64, 16, smem);
  const int lane = TIDX() & 63, wid = TIDX() >> 6, wm = wid >> 2, wn = wid & 3, l15 = lane & 15, quad = lane >> 4;
  const float* ssq = (const float*)(p.ws + O_SSQ);
  bf16_t* stg = smem + wid * STG_WAVE;
  const int trow0 = tm * 256 + wm * 128;
  if constexpr (!SWAP) {
    bf16_t* dst; int hh, hd;
    if (tn == 4) { dst = (bf16_t*)(p.ws + (wn < 2 ? O_VSLCT : O_VWINT)); hh = 2; hd = wn & 1; } else { dst = (bf16_t*)(p.ws + O_FOXVT); hh = 8; hd = (tn - 9) * 4 + wn; }
    constexpr int VLD = 136;
#pragma unroll
    for (int i = 0; i < 8; ++i) {
      const int t0 = trow0 + i * 16 + quad * 4;
      float rs[4];
#pragma unroll
      for (int r = 0; r < 4; ++r) rs[r] = rstd_from16(ssq + (size_t)(t0 + r) * 16, 1.f / 1024.f);
#pragma unroll
      for (int j = 0; j < 4; ++j)
        *(u32x2*)(stg + (j * 16 + l15) * VLD + i * 16 + quad * 4) = (u32x2){pk2(acc[i][j][0] * rs[0], acc[i][j][1] * rs[1]), pk2(acc[i][j][2] * rs[2], acc[i][j][3] * rs[3])};
    }
    const int b = trow0 >> 12, s0 = trow0 & 4095;
    stage_out<64, 128, VLD>(stg, dst + ((size_t)(b * hh + hd) * 64) * S_ + s0, (size_t)S_, lane);
  } else {
    const int slab = tn * 4 + wn;
    if (slab == 54) {
#pragma unroll
      for (int i = 0; i < 8; ++i) {
        const int t = trow0 + i * 16 + l15; const float rs = rstd_from16(ssq + (size_t)t * 16, 1.f / 1024.f);
        float* gt = (float*)(p.ws + O_GATES) + (size_t)t * 24; float* lf = (float*)(p.ws + O_LOGF) + (size_t)t * 8;
#pragma unroll
        for (int r = 0; r < 4; ++r) gt[quad * 4 + r] = sigmoidf_(acc[i][0][r] * rs);
        if (quad < 2) {
#pragma unroll
          for (int r = 0; r < 4; ++r) gt[16 + quad * 4 + r] = sigmoidf_(acc[i][1][r] * rs);
        } else {
#pragma unroll
          for (int r = 0; r < 4; ++r) { const int h = (quad - 2) * 4 + r; const float xx = acc[i][1][r] * rs + p.b_forget[layer * 8 + h]; lf[h] = fminf(xx, 0.f) - log1pf(__expf(-fabsf(xx))); }
        }
        const float* rp = (const float*)(p.ws + O_ROPE16) + (size_t)t * 32 + quad * 8; float o1[4], o2[4];
#pragma unroll
        for (int r = 0; r < 4; ++r) { const float cs = rp[2 * r], sn = rp[2 * r + 1], x1 = acc[i][2][r] * rs, x2 = acc[i][3][r] * rs; o1[r] = x1 * cs - x2 * sn; o2[r] = x2 * cs + x1 * sn; }
        bf16_t* kp = (bf16_t*)(p.ws + O_MLAKPE) + (size_t)t * 32 + quad * 4;
        *(u32x2*)kp = (u32x2){pk2(o1[0], o1[1]), pk2(o1[2], o1[3])}; *(u32x2*)(kp + 16) = (u32x2){pk2(o2[0], o2[1]), pk2(o2[2], o2[3])};
      }
    } else if (slab != 55) {
      bf16_t* dbuf; int dld, dcol, kind = 0; float qs = 1.f; int cslot = 0;
      if (slab < 8) { dbuf = (bf16_t*)(p.ws + O_NSAQ); dld = 512; dcol = slab * 64; qs = QS64_; }
      else if (slab < 12) { dbuf = (bf16_t*)(p.ws + O_KVCMP); dld = 256; dcol = (slab - 8) * 64; }
      else if (slab < 16) { dbuf = (bf16_t*)(p.ws + (slab < 14 ? O_KSLC : O_KWIN)); dld = 128; dcol = (slab & 1) * 64; kind = 1; }
      else if (slab < 28) { dbuf = (bf16_t*)(p.ws + O_FOXQ); dld = 512; dcol = (slab - 20) * 64; qs = QS64_; }
      else if (slab < 36) { dbuf = (bf16_t*)(p.ws + O_FOXK); dld = 512; dcol = (slab - 28) * 64; }
      else if (slab < 50) { dbuf = (bf16_t*)(p.ws + O_CQ); dld = 384; dcol = (slab - 44) * 64; kind = 2; cslot = slab - 44; }
      else { dbuf = (bf16_t*)(p.ws + O_CKV); dld = 256; dcol = (slab - 50) * 64; kind = 2; cslot = 8 + slab - 50; }
#pragma unroll
      for (int i = 0; i < 8; ++i) {
        const int row = i * 16 + l15, t = trow0 + row; const float rs = rstd_from16(ssq + (size_t)t * 16, 1.f / 1024.f) * qs;
        if (kind == 1) {
          const float* rp = (const float*)(p.ws + O_ROPE8) + (size_t)t * 16 + (quad & 1) * 8;
          f32x4 v, o;
#pragma unroll
          for (int r = 0; r < 4; ++r) { v[r] = acc[i][0][r] * rs; o[r] = __shfl_xor(v[r], 32); }
#pragma unroll
          for (int r = 0; r < 4; ++r) { const float cs = rp[2 * r], sn = rp[2 * r + 1]; v[r] = quad < 2 ? v[r] * cs - o[r] * sn : v[r] * cs + o[r] * sn; }
          stage4(stg, row, quad * 4, v, 1.f);
        } else stage4(stg, row, quad * 4, acc[i][0], rs);
#pragma unroll
        for (int j = 1; j < 4; ++j) stage4(stg, row, j * 16 + quad * 4, acc[i][j], rs);
        if (kind == 2) {
          float s = 0.f;
#pragma unroll
          for (int j = 0; j < 4; ++j) { const f32x4 a = acc[i][j] * rs; s += a[0] * a[0] + a[1] * a[1] + a[2] * a[2] + a[3] * a[3]; }
          s += __shfl_xor(s, 16); s += __shfl_xor(s, 32);
          if (quad == 0) ((float*)(p.ws + O_CSSQ))[(size_t)t * 16 + cslot] = s;
        }
      }
      stage_out<128, 64, STG_LD>(stg, dbuf + (size_t)trow0 * dld + dcol, (size_t)dld, lane);
    }
  }
  __syncthreads();
}
DI void phase_inproj(const Params& p, int layer, unsigned char* smem) {
  xcd_tiles(16, 14, [&](int tm, int tn) {
    const bool vt = (tn == 4 || tn == 9 || tn == 10);
    if (vt) inproj_tile<false>(p, layer, tm, tn, (bf16_t*)smem); else inproj_tile<true>(p, layer, tm, tn, (bf16_t*)smem);
  });
}

template <int KIND> DI void mlaup_tile(const Params& p, int layer, int tm, int tn, bf16_t* smem) {
  const bf16_t* wl = (const bf16_t*)(p.ws + O_W) + (size_t)layer * W_LAYER;
  f32x4 acc[8][4]; zero_acc<8, 4>(acc);
  constexpr int K = KIND == 0 ? 384 : 256;
  RowPtr ap{KIND == 0 ? (const bf16_t*)(p.ws + O_CQ) + (size_t)tm * 256 * 384 : (const bf16_t*)(p.ws + O_CKV) + (size_t)tm * 256 * 256, (size_t)K};
  RowPtr bp{KIND == 0 ? wl + W_UQ + (size_t)tn * 256 * 384 : wl + W_UKV + (size_t)(tn - 3) * 256 * 256, (size_t)K};
  gemm_main<8, 4, KIND != 2>(acc, ap, 64, bp, 64, K / 64, smem);
  const int lane = TIDX() & 63, wid = TIDX() >> 6, wm = wid >> 2, wn = wid & 3, l15 = lane & 15, quad = lane >> 4;
  const float* cssq = (const float*)(p.ws + O_CSSQ);
  bf16_t* stg = smem + wid * STG_WAVE; const int trow0 = tm * 256 + wm * 128;
  if constexpr (KIND == 2) {
    bf16_t* dst = (bf16_t*)(p.ws + O_MLAVT); const int h = (tn - 5) * 4 + wn;
    constexpr int VLD = 136;
#pragma unroll
    for (int i = 0; i < 8; ++i) {
      asm volatile("" ::: "memory");
      const int t0 = trow0 + i * 16 + quad * 4; float rs[4];
#pragma unroll
      for (int r = 0; r < 4; ++r) { const float* c = cssq + (size_t)(t0 + r) * 16 + 8; rs[r] = rsqrtf((c[0] + c[1] + c[2] + c[3]) * (1.f / 256.f) + EPS_); }
#pragma unroll
      for (int j = 0; j < 4; ++j)
        *(u32x2*)(stg + (j * 16 + l15) * VLD + i * 16 + quad * 4) = (u32x2){pk2(acc[i][j][0] * rs[0], acc[i][j][1] * rs[1]), pk2(acc[i][j][2] * rs[2], acc[i][j][3] * rs[3])};
    }
    stage_out<64, 128, VLD>(stg, dst + ((size_t)((trow0 >> 12) * 8 + h) * 64) * S_ + (trow0 & 4095), (size_t)S_, lane);
  } else if constexpr (KIND == 1) {
#pragma unroll
    for (int i = 0; i < 8; ++i) {
      asm volatile("" ::: "memory");
      const int row = i * 16 + l15, t = trow0 + row; const float* c = cssq + (size_t)t * 16;
      const float rs = rsqrtf((c[8] + c[9] + c[10] + c[11]) * (1.f / 256.f) + EPS_);
#pragma unroll
      for (int j = 0; j < 4; ++j) stage4(stg, row, j * 16 + quad * 4, acc[i][j], rs);
    }
    stage_out<128, 64, STG_LD>(stg, (bf16_t*)(p.ws + O_MLAKN) + (size_t)trow0 * 512 + (tn - 3) * 256 + wn * 64, (size_t)512, lane);
  } else {
    const int n0 = tn * 256 + wn * 64, ph = n0 % 96;
#pragma unroll
    for (int i = 0; i < 8; ++i) {
      asm volatile("" ::: "memory");
      const int row = i * 16 + l15, t = trow0 + row; const float* c = cssq + (size_t)t * 16;
      const float rs = rsqrtf((c[0] + c[1] + c[2] + c[3] + c[4] + c[5]) * (1.f / 384.f) + EPS_) * QS96_;
      f32x4 v0 = acc[i][0] * rs, v1 = acc[i][1] * rs, v2 = acc[i][2] * rs, v3 = acc[i][3] * rs;
      if (ph != 0) {
        const float* rp = (const float*)(p.ws + O_ROPE16) + (size_t)t * 32 + quad * 8;
        const f32x4 x1 = ph == 64 ? v0 : v2, x2 = ph == 64 ? v1 : v3; f32x4 o1, o2;
#pragma unroll
        for (int r = 0; r < 4; ++r) { const float cs = rp[2 * r], sn = rp[2 * r + 1]; o1[r] = x1[r] * cs - x2[r] * sn; o2[r] = x2[r] * cs + x1[r] * sn; }
        if (ph == 64) { v0 = o1; v1 = o2; } else { v2 = o1; v3 = o2; }
      }
      stage4(stg, row, quad * 4, v0, 1.f); stage4(stg, row, 16 + quad * 4, v1, 1.f); stage4(stg, row, 32 + quad * 4, v2, 1.f); stage4(stg, row, 48 + quad * 4, v3, 1.f);
    }
    stage_out<128, 64, STG_LD>(stg, (bf16_t*)(p.ws + O_MLAQ) + (size_t)trow0 * 768 + n0, (size_t)768, lane);
  }
  __syncthreads();
}
struct CmpRowPtr { const bf16_t* base; int r0;
  DI unsigned operator()(int r) const { int R = r0 + r; if (R >= 4080) R = 0; const int b = R / 510, rem = R - b * 510, n = rem >> 1, g = rem & 1; return (unsigned)(b * S_ + 16 * n) * 256u + g * 64; }
  DI bool ok(int r) const { return r0 + r < 4080; } };
DI void compress_item(const Params& p, int layer, int item, bf16_t* smem) {
  const int kv = item >> 4, tm = item & 15;
  const bf16_t* wl = (const bf16_t*)(p.ws + O_W) + (size_t)layer * W_LAYER;
  f32x4 acc[8][4]; zero_acc<8, 4>(acc);
  CmpRowPtr ap{(const bf16_t*)(p.ws + O_KVCMP) + kv * 128, tm * 256};
  RowPtr bp{wl + (kv ? W_1V : W_1K), (size_t)2048};
  gemm_main<8, 4, true>(acc, ap, 256, bp, 64, 32, smem);
  const int lane = TIDX() & 63, wid = TIDX() >> 6, wm = wid >> 2, wn = wid & 3, l15 = lane & 15, quad = lane >> 4;
  constexpr int LDH = 264; bf16_t* H = smem;
  const float* b1 = (const float*)(p.ws + O_BIAS1) + (layer * 2 + kv) * 256;
#pragma unroll
  for (int i = 0; i < 8; ++i)
#pragma unroll
    for (int j = 0; j < 4; ++j) {
      const int row = wm * 128 + i * 16 + l15, col = wn * 64 + j * 16 + quad * 4; const f32x4 bv = *(const f32x4*)(b1 + col);
      *(u32x2*)(H + row * LDH + col) = (u32x2){pk2(gelu_tanh(acc[i][j][0] + bv[0]), gelu_tanh(acc[i][j][1] + bv[1])), pk2(gelu_tanh(acc[i][j][2] + bv[2]), gelu_tanh(acc[i][j][3] + bv[3]))};
    }
  __syncthreads();
  f32x4 a2[2][4];
#pragma unroll
  for (int i = 0; i < 2; ++i)
#pragma unroll
    for (int j = 0; j < 4; ++j) a2[i][j] = (f32x4){0.f, 0.f, 0.f, 0.f};
  const bf16_t* w2 = wl + (kv ? W_2V : W_2K);
#pragma unroll
  for (int ks = 0; ks < 8; ++ks) {
    bf16x8 a[2], b[4];
#pragma unroll
    for (int i = 0; i < 2; ++i) a[i] = *(const bf16x8*)(H + (wid * 32 + i * 16 + l15) * LDH + ks * 32 + quad * 8);
#pragma unroll
    for (int j = 0; j < 4; ++j) b[j] = *(const bf16x8*)(w2 + (size_t)(j * 16 + l15) * 256 + ks * 32 + quad * 8);
#pragma unroll
    for (int i = 0; i < 2; ++i)
#pragma unroll
      for (int j = 0; j < 4; ++j) a2[i][j] = mfma16(a[i], b[j], a2[i][j]);
  }
  bf16_t* kc = (bf16_t*)(p.ws + O_KC); bf16_t* vct = (bf16_t*)(p.ws + O_VCT);
#pragma unroll
  for (int i = 0; i < 2; ++i)
#pragma unroll
    for (int r = 0; r < 4; ++r) {
      const int R = tm * 256 + wid * 32 + i * 16 + quad * 4 + r;
      if (R < 4080) {
        const int b = R / 510, rem = R - b * 510, n = rem >> 1, g = rem & 1;
#pragma unroll
        for (int j = 0; j < 4; ++j) {
          const int d = j * 16 + l15; const bf16_t v = f2bf(a2[i][j][r]);
          if (kv == 0) kc[((size_t)(b * 2 + g) * 256 + n) * 64 + d] = v; else vct[((size_t)(b * 2 + g) * 64 + d) * 256 + n] = v;
        }
      }
    }
  __syncthreads();
}
DI void foxscan_item(const Params& p, int item, float* lds) {
  const int b = item >> 3, h = item & 7, tid = TIDX();
  const float* lf = (const float*)(p.ws + O_LOGF) + (size_t)b * S_ * 8 + h; float v[8]; float s = 0.f;
#pragma unroll
  for (int i = 0; i < 8; ++i) { s += lf[(size_t)(tid * 8 + i) * 8]; v[i] = s; }
  lds[tid] = s; __syncthreads();
  float off = 0.f;
  for (int i = 0; i < tid; ++i) off += lds[i];
  float* F2 = (float*)(p.ws + O_F2) + (size_t)(b * 8 + h) * S_ + tid * 8;
#pragma unroll
  for (int i = 0; i < 8; ++i) F2[i] = -(off + v[i]) * LOG2E_;
  __syncthreads();
}
DI void phase_b(const Params& p, int layer, unsigned char* smem) {
  for (int it = blockIdx.x; it < 96; it += gridDim.x) {
    if (it < 32) compress_item(p, layer, it, (bf16_t*)smem);
    else foxscan_item(p, it - 32, (float*)smem);
  }
  xcd_tiles(16, 7, [&](int tm, int tn) {
    if (tn >= 5) mlaup_tile<2>(p, layer, tm, tn, (bf16_t*)smem); else if (tn >= 3) mlaup_tile<1>(p, layer, tm, tn, (bf16_t*)smem); else mlaup_tile<0>(p, layer, tm, tn, (bf16_t*)smem);
  });
}

constexpr int KC_LD = 72, VC_LD = 264;
DI void cmp_item(const Params& p, int item, unsigned char* smem_) {
  const int b = item >> 6, g = (item >> 5) & 1, tt = item & 31, t0 = tt * 128;
  const int tid = TIDX(), lane = tid & 63, wid = tid >> 6, l15 = lane & 15, quad = lane >> 4;
  bf16_t* kcs = (bf16_t*)smem_;
  bf16_t* vcs = kcs + 256 * KC_LD;
  float* imps = (float*)smem_;
  const int nmax = (t0 + 96) >> 4;
  const int nsub = (nmax >> 4) + 1;
  {
    const bf16_t* kcg = (const bf16_t*)(p.ws + O_KC) + (size_t)(b * 2 + g) * 256 * 64; const bf16_t* vcg = (const bf16_t*)(p.ws + O_VCT) + (size_t)(b * 2 + g) * 64 * 256;
    const int nrows = ((nsub + 1) & ~1) * 16;
    for (int e = tid; e < nrows * 8; e += NTHR) {
      const int n = e >> 3, dc = (e & 7) * 8;
      *(u32x4*)(kcs + n * KC_LD + dc) = n < 255 ? *(const u32x4*)(kcg + (size_t)n * 64 + dc) : (u32x4){0u, 0u, 0u, 0u};
    }
    const int ncs = nrows >> 3;
    for (int e = tid; e < 64 * ncs; e += NTHR) {
      const int d = e / ncs, nc = (e - d * ncs) * 8;
      u32x4 v = *(const u32x4*)(vcg + (size_t)d * 256 + nc);
      if (nc + 8 > 255) v[3] &= 0x0000ffffu;
      *(u32x4*)(vcs + d * VC_LD + nc) = v;
    }
  }
  __syncthreads();
  const int tq = t0 + wid * 16 + l15;
  const size_t trow = (size_t)b * S_ + tq;
  float impa[16], p3a[16];
#pragma unroll
  for (int s = 0; s < 16; ++s) { impa[s] = 0.f; p3a[s] = 0.f; }
  const float* gts = (const float*)(p.ws + O_GATES) + trow * 24;
#pragma unroll 1
  for (int r4 = 0; r4 < 4; ++r4) {
    const int head = g * 4 + r4;
    const bf16_t* qp = (const bf16_t*)(p.ws + O_NSAQ) + trow * 512 + head * 64 + quad * 8;
    const bf16x8 q0 = *(const bf16x8*)qp, q1 = *(const bf16x8*)(qp + 32);
    auto score = [&](int s) -> f32x4 {
      const bf16_t* kr = kcs + (s * 16 + l15) * KC_LD + quad * 8;
      f32x4 a = {0.f, 0.f, 0.f, 0.f};
      a = mfma16(*(const bf16x8*)kr, q0, a); a = mfma16(*(const bf16x8*)(kr + 32), q1, a);
#pragma unroll
      for (int r = 0; r < 4; ++r) { const int n = s * 16 + quad * 4 + r; a[r] = (16 * n + 31 <= tq) ? a[r] : -INFINITY; }
      return a;
    };
    float mx = -INFINITY;
#pragma unroll 1
    for (int s = 0; s < nsub; ++s) { const f32x4 a = score(s); mx = fmaxf(mx, fmaxf(fmaxf(a[0], a[1]), fmaxf(a[2], a[3]))); }
    mx = fmaxf(mx, __shfl_xor(mx, 16)); mx = fmaxf(mx, __shfl_xor(mx, 32));
    if (mx == -INFINITY) mx = 0.f;
    float sum = 0.f;
#pragma unroll 1
    for (int s = 0; s < nsub; ++s) { const f32x4 a = score(s); sum += (ex2(a[0] - mx) + ex2(a[1] - mx)) + (ex2(a[2] - mx) + ex2(a[3] - mx)); }
    sum += __shfl_xor(sum, 16); sum += __shfl_xor(sum, 32);
    const float inv = 1.f / fmaxf(sum, 1e-30f);
    f32x4 oacc[4];
#pragma unroll
    for (int j = 0; j < 4; ++j) oacc[j] = (f32x4){0.f, 0.f, 0.f, 0.f};
#pragma unroll
    for (int c = 0; c < 8; ++c) {
      asm volatile("" ::: "memory");
      if (2 * c < nsub) {
        f32x4 pa = score(2 * c), pb = {-INFINITY, -INFINITY, -INFINITY, -INFINITY};
        if (2 * c + 1 < nsub) pb = score(2 * c + 1);
#pragma unroll
        for (int r = 0; r < 4; ++r) { pa[r] = ex2(pa[r] - mx) * inv; pb[r] = ex2(pb[r] - mx) * inv; }
        impa[2 * c] += pa[0] + pa[1] + pa[2] + 0.5f * pa[3]; p3a[2 * c] += pa[3];
        impa[2 * c + 1] += pb[0] + pb[1] + pb[2] + 0.5f * pb[3]; p3a[2 * c + 1] += pb[3];
        const u32x4 pw = {pk2(pa[0], pa[1]), pk2(pa[2], pa[3]), pk2(pb[0], pb[1]), pk2(pb[2], pb[3])};
        const bf16x8 pf = __builtin_bit_cast(bf16x8, pw);
#pragma unroll
        for (int j = 0; j < 4; ++j) {
          const bf16_t* vr = vcs + (j * 16 + l15) * VC_LD + c * 32 + quad * 4;
          const u32x2 lo = *(const u32x2*)vr, hi = *(const u32x2*)(vr + 16);
          const u32x4 vw = {lo[0], lo[1], hi[0], hi[1]};
          oacc[j] = mfma16(__builtin_bit_cast(bf16x8, vw), pf, oacc[j]);
        }
      }
    }
    const float g0 = gts[head * 3 + 0];
    bf16_t* op = (bf16_t*)(p.ws + O_ONSA) + trow * 512 + head * 64 + quad * 4;
#pragma unroll
    for (int j = 0; j < 4; ++j) store4(op + j * 16, oacc[j], g0);
  }
  __syncthreads();
  float* myimp = imps + wid * 1024 + l15 * 64;
  const int cur = tq >> 6;
#pragma unroll
  for (int s = 0; s < 16; ++s) {
    const float up = __shfl(p3a[s], (lane + 48) & 63);
    const float up0 = s ? __shfl(p3a[s ? s - 1 : 0], (lane + 48) & 63) : 0.f;
    const float prev = quad ? up : up0;
    float v = impa[s] + 0.5f * prev;
    const int j = 4 * s + quad;
    if (j == 0 || j == cur || j == cur - 1) v = 1e9f; else if (j > cur) v = -1e9f;
    myimp[j] = v;
  }
  __syncthreads();
  u64* sel = (u64*)(p.ws + O_SEL) + (size_t)(b * 2 + g) * S_ + t0 + wid * 16;
#pragma unroll 1
  for (int q = 0; q < 16; ++q) {
    const float mine = imps[wid * 1024 + q * 64 + lane]; int rank = 0;
#pragma unroll
    for (int i = 0; i < 64; ++i) { const float v = __uint_as_float(__builtin_amdgcn_readlane(__float_as_uint(mine), i)); rank += (v > mine || (v == mine && i < lane)) ? 1 : 0; }
    const u64 m = __ballot(rank < 16);
    if (lane == 0) sel[q] = m;
  }
  __syncthreads();
}
constexpr int PC_ITEMS = NB_ * 2 * 32;
DI void phase_c(const Params& p, unsigned char* smem) { for (int it = blockIdx.x; it < PC_ITEMS; it += gridDim.x) cmp_item(p, it, smem); }

enum { M_FOX = 0, M_MLA = 1, M_WIN = 2, M_SLC = 3 };
template <int MODE> struct ACfg { static constexpr int DQK = MODE == M_MLA ? 96 : 64, KLD = DQK + 8, NKC = DQK / 8 * 64, KCH = (NKC + NTHR - 1) / NTHR, K_ELEMS = 64 * KLD, V_ELEMS = 64 * 72, STAGE = K_ELEMS + V_ELEMS + 128; };
struct AState { f32x16 o[2]; f32x16 mr; float m, l; };

template <int MODE>
DI void flash_pass(AState& st, const bf16x8* qf, u64 tmask, u64 wmask,
                   const bf16_t* kbase, size_t kld, const bf16_t* kpe, const bf16_t* vtbase, const float* fbias,
                   int tq, u64 mysel, bf16_t* smem) {
  typedef ACfg<MODE> C;
  const int tid = TIDX(), lane = tid & 63, l31 = lane & 31, half = lane >> 5;
  u32x4 rk[C::KCH], rv; float rf = 0.f;
  auto gload = [&](int j) {
    const int k0 = j * 64;
#pragma unroll
    for (int i = 0; i < C::KCH; ++i) {
      const int c = tid + NTHR * i;
      if (c < C::NKC) {
        if constexpr (MODE == M_MLA) { const int key = c / 12, dc = c % 12; rk[i] = dc < 8 ? *(const u32x4*)(kbase + (size_t)(k0 + key) * kld + dc * 8) : *(const u32x4*)(kpe + (size_t)(k0 + key) * 32 + (dc - 8) * 8); }
        else { const int key = c >> 3, dc = c & 7; rk[i] = *(const u32x4*)(kbase + (size_t)(k0 + key) * kld + dc * 8); }
      }
    }
    { const int d = tid >> 3, kc = tid & 7; rv = *(const u32x4*)(vtbase + (size_t)d * S_ + k0 + kc * 8); }
    if constexpr (MODE == M_FOX) { if (tid < 64) rf = fbias[k0 + tid]; }
  };
  auto sstore = [&](int buf) {
    bf16_t* Ks = smem + buf * C::STAGE; bf16_t* Vs = Ks + C::K_ELEMS;
#pragma unroll
    for (int i = 0; i < C::KCH; ++i) {
      const int c = tid + NTHR * i;
      if (c < C::NKC) {
        if constexpr (MODE == M_MLA) { const int key = c / 12, dc = c % 12; *(u32x4*)(Ks + key * C::KLD + dc * 8) = rk[i]; }
        else { const int key = c >> 3, dc = c & 7; *(u32x4*)(Ks + key * C::KLD + dc * 8) = rk[i]; }
      }
    }
    {
      const int d = tid >> 3, kc = tid & 7, cgp = kc >> 1, a = kc & 1;
      bf16_t* dst = Vs + d * 72 + cgp * 16 + 4 * a;
      *(u32x2*)dst = (u32x2){rv[0], rv[1]}; *(u32x2*)(dst + 8) = (u32x2){rv[2], rv[3]};
    }
    if constexpr (MODE == M_FOX) { if (tid < 64) ((float*)(Vs + C::V_ELEMS))[tid] = rf; }
  };
  u64 tm = tmask;
  if (tm == 0) return;
  int j = __builtin_ctzll(tm); tm &= tm - 1;
  gload(j); sstore(0); __syncthreads();
  int buf = 0;
  const int tmin = __builtin_amdgcn_readfirstlane(tq - l31), tmax = tmin + 31;
  while (true) {
    const int jn = tm ? __builtin_ctzll(tm) : -1; if (tm) tm &= tm - 1;
    if (jn >= 0) gload(jn);
    bool active = (wmask >> j) & 1;
    if constexpr (MODE == M_SLC) active = active && __any((mysel >> j) & 1);
    if (active) {
      const bf16_t* Ks = smem + buf * C::STAGE; const bf16_t* Vs = Ks + C::K_ELEMS;
      f32x16 s0 = st.mr, s1 = st.mr;
      const bf16_t* kr = Ks + l31 * C::KLD + half * 8;
#pragma unroll
      for (int ks = 0; ks < C::DQK / 16; ++ks) {
        s0 = mfma32(*(const bf16x8*)(kr + ks * 16), qf[ks], s0);
        s1 = mfma32(*(const bf16x8*)(kr + 32 * C::KLD + ks * 16), qf[ks], s1);
      }
      const int k0 = j * 64;
      if constexpr (MODE == M_FOX) {
        const float* fb = (const float*)(Vs + C::V_ELEMS) + 4 * half;
#pragma unroll
        for (int g4 = 0; g4 < 4; ++g4) {
          const f32x4 b0 = *(const f32x4*)(fb + 8 * g4), b1 = *(const f32x4*)(fb + 32 + 8 * g4);
#pragma unroll
          for (int r = 0; r < 4; ++r) { s0[4 * g4 + r] += b0[r]; s1[4 * g4 + r] += b1[r]; }
        }
      }
      bool need = k0 + 63 > tmin;
      if constexpr (MODE == M_WIN) need = need || (k0 <= tmax - 512);
      if constexpr (MODE == M_SLC) {
        if (!need) {
          const bool rsel = ((mysel >> j) & 1) != 0;
          if (!__all(rsel)) {
#pragma unroll
            for (int r = 0; r < 16; ++r) { s0[r] = rsel ? s0[r] : -INFINITY; s1[r] = rsel ? s1[r] : -INFINITY; }
          }
        }
      }
      if (need) {
        const bool rowok = MODE == M_SLC ? ((mysel >> j) & 1) != 0 : true;
#pragma unroll
        for (int r = 0; r < 16; ++r) {
          const int key = k0 + (r & 3) + 8 * (r >> 2) + 4 * half;
          bool ok0 = rowok && key <= tq, ok1 = rowok && key + 32 <= tq;
          if constexpr (MODE == M_WIN) { ok0 = ok0 && (tq - key < 512); ok1 = ok1 && (tq - key - 32 < 512); }
          s0[r] = ok0 ? s0[r] : -INFINITY; s1[r] = ok1 ? s1[r] : -INFINITY;
        }
      }
      int im = (int)0x80000000;
#pragma unroll
      for (int r = 0; r < 16; ++r) im = max(im, max(__float_as_int(s0[r]), __float_as_int(s1[r])));
      im = max(im, __shfl_xor(im, 32));
      constexpr int TBITS = 0x41200000;
      if (__any(im > TBITS)) {
        const float d = im > TBITS ? __int_as_float(im) : 0.f;
        const float a = ex2(-d);
#pragma unroll
        for (int r = 0; r < 16; ++r) { s0[r] -= d; s1[r] -= d; st.o[0][r] *= a; st.o[1][r] *= a; }
        st.l *= a; st.m += d;
#pragma unroll
        for (int r = 0; r < 16; ++r) st.mr[r] = -st.m;
      }
      float sum = 0.f;
#pragma unroll
      for (int r = 0; r < 16; ++r) { s0[r] = ex2(s0[r]); s1[r] = ex2(s1[r]); sum += s0[r] + s1[r]; }
      st.l += sum;
      const bf16_t* vr = Vs + l31 * 72 + half * 8;
#pragma unroll
      for (int c = 0; c < 4; ++c) {
        u32x4 pw;
        if (c < 2) pw = (u32x4){pk2(s0[8 * c + 0], s0[8 * c + 1]), pk2(s0[8 * c + 2], s0[8 * c + 3]), pk2(s0[8 * c + 4], s0[8 * c + 5]), pk2(s0[8 * c + 6], s0[8 * c + 7])};
        else pw = (u32x4){pk2(s1[8 * (c - 2) + 0], s1[8 * (c - 2) + 1]), pk2(s1[8 * (c - 2) + 2], s1[8 * (c - 2) + 3]), pk2(s1[8 * (c - 2) + 4], s1[8 * (c - 2) + 5]), pk2(s1[8 * (c - 2) + 6], s1[8 * (c - 2) + 7])};
        const bf16x8 pf = __builtin_bit_cast(bf16x8, pw);
        st.o[0] = mfma32(*(const bf16x8*)(vr + c * 16), pf, st.o[0]);
        st.o[1] = mfma32(*(const bf16x8*)(vr + 32 * 72 + c * 16), pf, st.o[1]);
      }
    }
    if (jn >= 0) sstore(buf ^ 1);
    __syncthreads();
    if (jn < 0) break;
    j = jn; buf ^= 1;
  }
}
DI void astate_init(AState& s) {
#pragma unroll
  for (int r = 0; r < 16; ++r) { s.o[0][r] = 0.f; s.o[1][r] = 0.f; }
#pragma unroll
  for (int r = 0; r < 16; ++r) s.mr[r] = 0.f;
  s.m = 0.f; s.l = 0.f;
}
DI u64 lowbits(int n) { return n >= 64 ? ~0ull : ((1ull << n) - 1ull); }

template <int MODE> DI void dense_attn_item(const Params& p, int b, int h, int qt, bf16_t* smem) {
  const int lane = TIDX() & 63, wid = TIDX() >> 6, l31 = lane & 31, half = lane >> 5;
  const int t0 = qt * 256, tq = t0 + wid * 32 + l31; const size_t trow = (size_t)b * S_ + tq;
  constexpr int NQ = ACfg<MODE>::DQK / 16;
  bf16x8 qf[NQ];
  const bf16_t* qp = MODE == M_FOX ? (const bf16_t*)(p.ws + O_FOXQ) + trow * 512 + h * 64 : (const bf16_t*)(p.ws + O_MLAQ) + trow * 768 + h * 96;
#pragma unroll
  for (int ks = 0; ks < NQ; ++ks) qf[ks] = *(const bf16x8*)(qp + ks * 16 + half * 8);
  AState st; astate_init(st);
  const u64 tmask = lowbits(4 * qt + 4), wmask = lowbits(((t0 + wid * 32 + 31) >> 6) + 1);
  if constexpr (MODE == M_FOX)
    flash_pass<M_FOX>(st, qf, tmask, wmask, (const bf16_t*)(p.ws + O_FOXK) + (size_t)b * S_ * 512 + h * 64, 512, nullptr,
                      (const bf16_t*)(p.ws + O_FOXVT) + (size_t)(b * 8 + h) * 64 * S_, (const float*)(p.ws + O_F2) + (size_t)(b * 8 + h) * S_, tq, 0ull, smem);
  else
    flash_pass<M_MLA>(st, qf, tmask, wmask, (const bf16_t*)(p.ws + O_MLAKN) + (size_t)b * S_ * 512 + h * 64, 512, (const bf16_t*)(p.ws + O_MLAKPE) + (size_t)b * S_ * 32,
                      (const bf16_t*)(p.ws + O_MLAVT) + (size_t)(b * 8 + h) * 64 * S_, nullptr, tq, 0ull, smem);
  const float l = st.l + __shfl_xor(st.l, 32), inv = 1.f / fmaxf(l, 1e-30f);
  bf16_t* op = (bf16_t*)qp;
#pragma unroll
  for (int dt = 0; dt < 2; ++dt)
#pragma unroll
    for (int g4 = 0; g4 < 4; ++g4) {
      const int d = dt * 32 + g4 * 8 + half * 4;
      *(u32x2*)(op + d) = (u32x2){pk2(st.o[dt][4 * g4] * inv, st.o[dt][4 * g4 + 1] * inv), pk2(st.o[dt][4 * g4 + 2] * inv, st.o[dt][4 * g4 + 3] * inv)};
    }
}
DI void nsa_attn_item(const Params& p, int b, int g, int qt, bf16_t* smem) {
  const int lane = TIDX() & 63, wid = TIDX() >> 6, l31 = lane & 31, half = lane >> 5;
  const int t0 = qt * 64, tw0 = t0 + (wid >> 2) * 32, tq = tw0 + l31, head = g * 4 + (wid & 3); const size_t trow = (size_t)b * S_ + tq;
  bf16x8 qf[4];
  const bf16_t* qp = (const bf16_t*)(p.ws + O_NSAQ) + trow * 512 + head * 64;
#pragma unroll
  for (int ks = 0; ks < 4; ++ks) qf[ks] = *(const bf16x8*)(qp + ks * 16 + half * 8);
  {
    const float* rp = (const float*)(p.ws + O_ROPE8) + trow * 16;
    u32x4 me = __builtin_bit_cast(u32x4, qf[0]), ot;
#pragma unroll
    for (int e = 0; e < 4; ++e) ot[e] = __shfl_xor(me[e], 32);
    unsigned res[4];
#pragma unroll
    for (int e = 0; e < 4; ++e) {
      float o2[2];
#pragma unroll
      for (int u = 0; u < 2; ++u) {
        const int f = 2 * e + u; const float cs = rp[2 * f], sn = rp[2 * f + 1];
        const float a = bf2f((bf16_t)(u ? me[e] >> 16 : me[e] & 0xffffu)), o = bf2f((bf16_t)(u ? ot[e] >> 16 : ot[e] & 0xffffu));
        o2[u] = half == 0 ? a * cs - o * sn : a * cs + o * sn;
      }
      res[e] = pk2(o2[0], o2[1]);
    }
    qf[0] = __builtin_bit_cast(bf16x8, (u32x4){res[0], res[1], res[2], res[3]});
  }
  const float* gts = (const float*)(p.ws + O_GATES) + trow * 24 + head * 3;
  const int cur = t0 >> 6;
  f32x16 res[2];
  {
    AState st; astate_init(st);
    const int first = t0 >= 511 ? (t0 - 511) >> 6 : 0, firstw = tw0 >= 511 ? (tw0 - 511) >> 6 : 0;
    const u64 tmask = lowbits(cur + 1) & ~lowbits(first), wmask = lowbits(cur + 1) & ~lowbits(firstw);
    flash_pass<M_WIN>(st, qf, tmask, wmask, (const bf16_t*)(p.ws + O_KWIN) + (size_t)b * S_ * 128 + g * 64, 128, nullptr,
                      (const bf16_t*)(p.ws + O_VWINT) + (size_t)(b * 2 + g) * 64 * S_, nullptr, tq, 0ull, smem);
    const float l = st.l + __shfl_xor(st.l, 32), sc = gts[2] / fmaxf(l, 1e-30f);
#pragma unroll
    for (int r = 0; r < 16; ++r) { res[0][r] = st.o[0][r] * sc; res[1][r] = st.o[1][r] * sc; }
  }
  {
    AState st; astate_init(st);
    const u64* selp = (const u64*)(p.ws + O_SEL) + (size_t)(b * 2 + g) * S_;
    const u64 mysel = selp[tq];
    const u64 m64 = selp[t0 + lane];
    unsigned lo = (unsigned)m64, hi = (unsigned)(m64 >> 32);
#pragma unroll
    for (int o = 32; o >= 1; o >>= 1) { lo |= __shfl_xor(lo, o); hi |= __shfl_xor(hi, o); }
    const u64 um = (((u64)(unsigned)__builtin_amdgcn_readfirstlane(hi) << 32) | (u64)(unsigned)__builtin_amdgcn_readfirstlane(lo)) & lowbits(cur + 1);
    flash_pass<M_SLC>(st, qf, um, um, (const bf16_t*)(p.ws + O_KSLC) + (size_t)b * S_ * 128 + g * 64, 128, nullptr,
                      (const bf16_t*)(p.ws + O_VSLCT) + (size_t)(b * 2 + g) * 64 * S_, nullptr, tq, mysel, smem);
    const float l = st.l + __shfl_xor(st.l, 32), sc = gts[1] / fmaxf(l, 1e-30f);
#pragma unroll
    for (int r = 0; r < 16; ++r) { res[0][r] += st.o[0][r] * sc; res[1][r] += st.o[1][r] * sc; }
  }
  bf16_t* op = (bf16_t*)(p.ws + O_ONSA) + trow * 512 + head * 64;
#pragma unroll
  for (int dt = 0; dt < 2; ++dt)
#pragma unroll
    for (int g4 = 0; g4 < 4; ++g4) {
      const int d = dt * 32 + g4 * 8 + half * 4;
      const u32x2 oc = *(const u32x2*)(op + d);
      const float c0 = bf2f((bf16_t)(oc[0] & 0xffffu)), c1 = bf2f((bf16_t)(oc[0] >> 16)), c2 = bf2f((bf16_t)(oc[1] & 0xffffu)), c3 = bf2f((bf16_t)(oc[1] >> 16));
      *(u32x2*)(op + d) = (u32x2){pk2(res[dt][4 * g4] + c0, res[dt][4 * g4 + 1] + c1), pk2(res[dt][4 * g4 + 2] + c2, res[dt][4 * g4 + 3] + c3)};
    }
}
constexpr int PD_ITEMS = 16 * 192;
DI void phase_d(const Params& p, unsigned char* smem) {
  for (int it = blockIdx.x; it < PD_ITEMS; it += gridDim.x) {
    const int r = it / 192, w = it % 192, qt = 15 - r;
    if (w < 64) dense_attn_item<M_MLA>(p, w >> 3, w & 7, qt, (bf16_t*)smem);
    else if (w < 128) dense_attn_item<M_FOX>(p, (w - 64) >> 3, (w - 64) & 7, qt, (bf16_t*)smem);
    else { const int i = w - 128, bg = i & 15, q4 = i >> 4; nsa_attn_item(p, bg >> 1, bg & 1, qt * 4 + q4, (bf16_t*)smem); }
  }
}

DI void merge_tile(const Params& p, int layer, int tm, int tn, bf16_t* smem) {
  const bf16_t* wl = (const bf16_t*)(p.ws + O_W) + (size_t)layer * W_LAYER;
  const int lane = TIDX() & 63, wid = TIDX() >> 6, wm = wid >> 2, wn = wid & 3, l15 = lane & 15, quad = lane >> 4;
  f32x4 mg[4][2]; zero_acc<4, 2>(mg);
  unsigned* gsp = (unsigned*)((unsigned char*)smem + 2 * GemmLds<4, 2>::STAGE * 2) + TIDX();
#pragma unroll 1
  for (int br = 0; br < 3; ++br) {
    {
      f32x4 ga[4][2]; zero_acc<4, 2>(ga);
      RowPtr ap{(const bf16_t*)(p.ws + O_XG) + (size_t)tm * 128 * D_, (size_t)D_}, bp{wl + W_G + ((size_t)br * 1024 + tn * 128) * D_, (size_t)D_};
      gemm_main<4, 2, true>(ga, ap, 64, bp, 64, 16, smem);
#pragma unroll
      for (int i = 0; i < 4; ++i) {
        const float rs = rstd_from16((const float*)(p.ws + O_SSQ) + (size_t)(tm * 128 + wm * 64 + i * 16 + l15) * 16, 1.f / 1024.f);
#pragma unroll
        for (int j = 0; j < 2; ++j) {
          gsp[((i * 2 + j) * 2 + 0) * NTHR] = pk2(sigmoidf_(ga[i][j][0] * rs), sigmoidf_(ga[i][j][1] * rs));
          gsp[((i * 2 + j) * 2 + 1) * NTHR] = pk2(sigmoidf_(ga[i][j][2] * rs), sigmoidf_(ga[i][j][3] * rs));
        }
      }
    }
    f32x4 ba[4][2]; zero_acc<4, 2>(ba);
    RowPtr bp2{wl + (br == 0 ? W_BN : br == 1 ? W_BF : W_BM) + (size_t)tn * 128 * 512, (size_t)512};
    const bf16_t* abase = (const bf16_t*)(p.ws + (br == 0 ? O_ONSA : br == 1 ? O_FOXQ : O_MLAQ));
    const int ald = br == 2 ? 768 : 512;
    RowPtr ap2{abase + (size_t)tm * 128 * ald, (size_t)ald};
    gemm_main<4, 2, true>(ba, ap2, br == 2 ? 96 : 64, bp2, 64, 8, smem);
#pragma unroll
    for (int i = 0; i < 4; ++i)
#pragma unroll
      for (int j = 0; j < 2; ++j) {
        const unsigned w0 = gsp[((i * 2 + j) * 2 + 0) * NTHR], w1 = gsp[((i * 2 + j) * 2 + 1) * NTHR];
        mg[i][j][0] += bf2f((bf16_t)(w0 & 0xffffu)) * ba[i][j][0];
        mg[i][j][1] += bf2f((bf16_t)(w0 >> 16)) * ba[i][j][1];
        mg[i][j][2] += bf2f((bf16_t)(w1 & 0xffffu)) * ba[i][j][2];
        mg[i][j][3] += bf2f((bf16_t)(w1 >> 16)) * ba[i][j][3];
      }
  }
  bf16_t* stg = (bf16_t*)((unsigned char*)smem + 106496 + wid * 5120);
#pragma unroll
  for (int i = 0; i < 4; ++i)
#pragma unroll
    for (int j = 0; j < 2; ++j) *(u32x2*)(stg + (i * 16 + l15) * 40 + j * 16 + quad * 4) = (u32x2){pk2(mg[i][j][0], mg[i][j][1]), pk2(mg[i][j][2], mg[i][j][3])};
  stage_out<64, 32, 40>(stg, (bf16_t*)(p.ws + O_MERGED) + (size_t)(tm * 128 + wm * 64) * D_ + tn * 128 + wn * 32, (size_t)D_, lane);
}
DI void phase_e(const Params& p, int layer, unsigned char* smem) {
  xcd_tiles(32, 8, [&](int tm, int tn) { merge_tile(p, layer, tm, tn, (bf16_t*)smem); });
}

DI void resid_tile(const Params& p, const bf16_t* A, int K, const bf16_t* W, const float* xold, const float* gnext, int tm, int tn, bf16_t* smem) {
  f32x4 acc[8][4]; zero_acc<8, 4>(acc);
  RowPtr ap{A + (size_t)tm * 256 * K, (size_t)K}, bp{W + (size_t)tn * 256 * K, (size_t)K};
  gemm_main<8, 4, true>(acc, ap, 64, bp, 64, K / 64, smem);
  const int lane = TIDX() & 63, wid = TIDX() >> 6, wm = wid >> 2, wn = wid & 3, l15 = lane & 15, quad = lane >> 4;
  bf16_t* stg = smem + wid * STG_WAVE;
#pragma unroll
  for (int i = 0; i < 8; ++i) {
    const int t = tm * 256 + wm * 128 + i * 16 + l15, c0 = tn * 256 + wn * 64 + quad * 4; float s = 0.f;
#pragma unroll
    for (int j = 0; j < 4; ++j) {
      const size_t off = (size_t)t * D_ + c0 + j * 16;
      const f32x4 xn = *(const f32x4*)(xold + off) + acc[i][j];
      *(f32x4*)(p.out + off) = xn;
      s += xn[0] * xn[0] + xn[1] * xn[1] + xn[2] * xn[2] + xn[3] * xn[3];
      if (gnext) { const f32x4 gv = *(const f32x4*)(gnext + c0 + j * 16); *(u32x2*)(stg + (i * 16 + l15) * STG_LD + j * 16 + quad * 4) = (u32x2){pk2(xn[0] * gv[0], xn[1] * gv[1]), pk2(xn[2] * gv[2], xn[3] * gv[3])}; }
    }
    s += __shfl_xor(s, 16); s += __shfl_xor(s, 32);
    if (quad == 0) ((float*)(p.ws + O_SSQ))[(size_t)t * 16 + tn * 4 + wn] = s;
  }
  if (gnext) stage_out<128, 64, STG_LD>(stg, (bf16_t*)(p.ws + O_XG) + (size_t)(tm * 256 + wm * 128) * D_ + tn * 256 + wn * 64, (size_t)D_, lane);
  __syncthreads();
}
DI void phase_f(const Params& p, int layer, unsigned char* smem) {
  const bf16_t* wl = (const bf16_t*)(p.ws + O_W) + (size_t)layer * W_LAYER;
  xcd_tiles(16, 4, [&](int tm, int tn) { resid_tile(p, (const bf16_t*)(p.ws + O_MERGED), 1024, wl + W_OUT, layer == 0 ? p.x : p.out, p.ffn_norm + layer * D_, tm, tn, (bf16_t*)smem); });
}
DI void phase_h(const Params& p, int layer, unsigned char* smem) {
  const bf16_t* wl = (const bf16_t*)(p.ws + O_W) + (size_t)layer * W_LAYER;
  xcd_tiles(16, 4, [&](int tm, int tn) { resid_tile(p, (const bf16_t*)(p.ws + O_ACT), DFF_, wl + W_DN, p.out, layer == 0 ? p.mix_norm + D_ : nullptr, tm, tn, (bf16_t*)smem); });
}

struct UpRowPtr { const bf16_t* base; int s0;
  DI unsigned operator()(int r) const { const int s = s0 + r; return (unsigned)((s < 0 || s >= S_) ? 0 : s) * (unsigned)D_; }
  DI bool ok(int r) const { const int s = s0 + r; return s >= 0 && s < S_; } };
constexpr int PG_MT = 17;
DI void ffnup_tile(const Params& p, int layer, int b, int mt, int tn, bf16_t* smem) {
  const bf16_t* wl = (const bf16_t*)(p.ws + O_W) + (size_t)layer * W_LAYER;
  f32x4 acc[8][4]; zero_acc<8, 4>(acc);
  const int s0 = 254 * mt - 2;
  UpRowPtr ap{(const bf16_t*)(p.ws + O_XG) + (size_t)b * S_ * D_, s0}; RowPtr bp{wl + W_UP + (size_t)tn * 256 * D_, (size_t)D_};
  gemm_main<8, 4, true>(acc, ap, 64, bp, 64, 16, smem);
  const int tid = TIDX(), lane = tid & 63, wid = tid >> 6, wm = wid >> 2, wn = wid & 3, l15 = lane & 15, quad = lane >> 4;
  constexpr int LDU = 132; float* U = (float*)smem;
  if (wn < 2) {
#pragma unroll
    for (int i = 0; i < 8; ++i) {
      const int row = wm * 128 + i * 16 + l15, s = s0 + row;
      const float rs = (s >= 0 && s < S_) ? rstd_from16((const float*)(p.ws + O_SSQ) + ((size_t)b * S_ + s) * 16, 1.f / 1024.f) : 0.f;
      float* dst = U + row * LDU + wn * 64 + quad * 4;
#pragma unroll
      for (int j = 0; j < 4; ++j) *(f32x4*)(dst + j * 16) = acc[i][j] * rs;
    }
  }
  __syncthreads();
  if (wn >= 2) {
    const int cl = (wn - 2) * 64 + quad * 4;
    bf16_t* act = (bf16_t*)(p.ws + O_ACT);
#pragma unroll
    for (int j = 0; j < 4; ++j) {
      const int cg0 = tn * 128 + cl + j * 16;
      const float* cw = p.conv_w + (size_t)layer * 3 * DFF_ + cg0; const f32x4 w0 = *(const f32x4*)cw, w1 = *(const f32x4*)(cw + DFF_), w2 = *(const f32x4*)(cw + 2 * DFF_);
      const f32x4 cb = *(const f32x4*)(p.conv_b + (size_t)layer * DFF_ + cg0);
#pragma unroll
      for (int i = 0; i < 8; ++i) {
        const int row = wm * 128 + i * 16 + l15, s = s0 + row;
        if (row >= 2 && s < S_) {
          const float rs = rstd_from16((const float*)(p.ws + O_SSQ) + ((size_t)b * S_ + s) * 16, 1.f / 1024.f);
          const float* up = U + row * LDU + cl + j * 16;
          const f32x4 u0 = *(const f32x4*)(up - 2 * LDU), u1 = *(const f32x4*)(up - LDU), u2 = *(const f32x4*)up;
          float o[4];
#pragma unroll
          for (int r = 0; r < 4; ++r) { const float uc = w0[r] * u0[r] + w1[r] * u1[r] + w2[r] * u2[r] + cb[r]; o[r] = uc * sigmoidf_(uc) * (acc[i][j][r] * rs); }
          *(u32x2*)(act + ((size_t)b * S_ + s) * DFF_ + cg0) = (u32x2){pk2(o[0], o[1]), pk2(o[2], o[3])};
        }
      }
    }
  }
  __syncthreads();
}
DI void phase_g(const Params& p, int layer, unsigned char* smem) {
  xcd_tiles(PG_MT, 22, [&](int tmg, int tn) { ffnup_tile(p, layer, tmg / PG_MT, tmg % PG_MT, tn, (bf16_t*)smem); });
}

DI void phase_final(const Params& p) {
  const int lane = TIDX() & 63, wid = TIDX() >> 6;
  for (int it = blockIdx.x; it < T_ / 8; it += gridDim.x) {
    const int t = it * 8 + wid; const float rs = rstd_from16((const float*)(p.ws + O_SSQ) + (size_t)t * 16, 1.f / 1024.f);
    float* xr = p.out + (size_t)t * D_;
#pragma unroll
    for (int c = 0; c < 4; ++c) { const int k = c * 256 + lane * 4; const f32x4 v = *(const f32x4*)(xr + k), gv = *(const f32x4*)(p.final_norm + k); *(f32x4*)(xr + k) = v * rs * gv; }
  }
}

#define XB_TMO      128
#define XB_XCNT(j)  (256  + 64 * (j))
#define XB_XSUB(j)  (1280 + 64 * (j))
#define XB_XGEN(j)  (2304 + 64 * (j))
#define XB_TOP      3328
#define XB_TOPGEN   3392
#define XCD_BAR_WORDS 3456
#define XB_SPIN_CAP (1u << 22)
#define LAS __attribute__((address_space(3)))
DI unsigned xb_ld(unsigned* p)              { return __hip_atomic_load(p, __ATOMIC_RELAXED, __HIP_MEMORY_SCOPE_AGENT); }
DI unsigned xb_add(unsigned* p, unsigned v) { return __hip_atomic_fetch_add(p, v, __ATOMIC_RELAXED, __HIP_MEMORY_SCOPE_AGENT); }
DI unsigned xb_xcc_id() { return (unsigned)__builtin_amdgcn_s_getreg((3 << 11) | 20) & 0xFu; }
#define XB_SPIN(cond, bar) do { unsigned _sp = 0; while (cond) { __builtin_amdgcn_s_sleep(1); \
    if ((++_sp & 255u) == 0u) { if (xb_ld(&(bar)[XB_TMO])) break; if (_sp > XB_SPIN_CAP) { atomicAdd(&(bar)[XB_TMO], 1u); break; } } } } while (0)
struct XcdBarrier { unsigned* bar; unsigned x; volatile LAS unsigned* st; };
DI XcdBarrier xcd_barrier_post(unsigned* bar, volatile LAS unsigned* st) {
  XcdBarrier b; b.bar = bar; b.x = xb_xcc_id(); b.st = st;
  if (threadIdx.x == 0) (void)xb_add(&bar[XB_XCNT(b.x)], 1u);
  return b;
}
DI void xcd_barrier_complete(unsigned* bar, unsigned x, unsigned& nloc, unsigned& nx) {
  const unsigned G = gridDim.x * gridDim.y * gridDim.z;
  unsigned sum, cnt, mine, sp = 0u;
  for (;;) {
    sum = 0u; cnt = 0u; mine = 0u;
#pragma unroll
    for (unsigned j = 0; j < 16; ++j) { const unsigned c = xb_ld(&bar[XB_XCNT(j)]); sum += c; cnt += (c > 0u) ? 1u : 0u; mine = (j == x) ? c : mine; }
    if (sum == G) break;
    __builtin_amdgcn_s_sleep(1);
    if ((++sp & 255u) == 0u) { if (xb_ld(&bar[XB_TMO])) break; if (sp > XB_SPIN_CAP) { atomicAdd(&bar[XB_TMO], 1u); break; } }
  }
  nloc = mine > 0u ? mine : 1u; nx = cnt > 0u ? cnt : 1u;
}
DI void xcd_barrier(const XcdBarrier& b) {
  asm volatile("s_waitcnt vmcnt(0)" ::: "memory");
  __syncthreads();
  if (threadIdx.x == 0) {
    unsigned* bar = b.bar;
    __builtin_amdgcn_s_waitcnt(0);
    unsigned nloc = b.st[0], nx = b.st[1];
    if (nloc == 0u) { xcd_barrier_complete(bar, b.x, nloc, nx); b.st[0] = nloc; b.st[1] = nx; }
    const unsigned old = xb_add(&bar[XB_XSUB(b.x)], 1u);
    const unsigned gen = old / nloc;
    if (old + 1u == (gen + 1u) * nloc) {
      __builtin_amdgcn_fence(__ATOMIC_RELEASE, "agent");
      asm volatile("s_waitcnt vmcnt(0)" ::: "memory");
      const unsigned og = xb_add(&bar[XB_TOP], 1u);
      const unsigned tg = og / nx;
      if (og + 1u == (tg + 1u) * nx) xb_add(&bar[XB_TOPGEN], 1u);
      else XB_SPIN(xb_ld(&bar[XB_TOPGEN]) == tg, bar);
      __builtin_amdgcn_fence(__ATOMIC_ACQUIRE, "agent");
      xb_add(&bar[XB_XGEN(b.x)], 1u);
      asm volatile("s_waitcnt vmcnt(0)" ::: "memory");
    } else {
      XB_SPIN(xb_ld(&bar[XB_XGEN(b.x)]) == gen, bar);
      __builtin_amdgcn_fence(__ATOMIC_ACQUIRE, "agent");
      asm volatile("s_waitcnt vmcnt(0)" ::: "memory");
    }
  }
  __syncthreads();
}
DI void run_phase(const Params& p, int ph, unsigned char* smem) {
  if (ph == 0) { phase_prep(p, smem); return; }
  if (ph == 17) { phase_final(p); return; }
  const int layer = (ph - 1) >> 3, s = (ph - 1) & 7;
#ifdef PROBE_DUP
  if ((PROBE_DUP >> s) & 1) {
    switch (s) { case 0: phase_inproj(p, layer, smem); break; case 1: phase_b(p, layer, smem); break; case 2: phase_c(p, smem); break; case 4: phase_e(p, layer, smem); break; case 6: phase_g(p, layer, smem); break; default: break; }
    __syncthreads();
  }
#endif
  switch (s) {
    case 0: phase_inproj(p, layer, smem); break;
    case 1: phase_b(p, layer, smem); break;
    case 2: phase_c(p, smem); break;
    case 3: phase_d(p, smem); break;
    case 4: phase_e(p, layer, smem); break;
    case 5: phase_f(p, layer, smem); break;
    case 6: phase_g(p, layer, smem); break;
    default: phase_h(p, layer, smem); break;
  }
}
constexpr int N_PHASES = 18;

#if ONE_LAUNCH
template <int PH> DI void run_all(const Params& p, unsigned char* smem, cg::grid_group& grid, const XcdBarrier& xb) {
  run_phase(p, PH, smem);
  if constexpr (PH + 1 < N_PHASES) {
    if constexpr (PH == 0) grid.sync(); else xcd_barrier(xb);
    run_all<PH + 1>(p, smem, grid, xb);
  }
}
__global__ void __launch_bounds__(NTHR, 2) mega_kernel(Params p) {
  __shared__ __attribute__((aligned(16))) unsigned char smem[SMEM_BYTES];
  __shared__ uint4 xb_words;
  if (threadIdx.x == 0) xb_words = make_uint4(0u, 0u, 0u, 0u);
  __syncthreads();
  const XcdBarrier xb = xcd_barrier_post((unsigned*)(p.ws + O_BAR), (volatile LAS unsigned*)&xb_words);
  cg::grid_group grid = cg::this_grid();
  run_all<0>(p, smem, grid, xb);
}
#else
template <int PH> __global__ void __launch_bounds__(NTHR, 2) phase_kernel(Params p) {
  __shared__ __attribute__((aligned(16))) unsigned char smem[SMEM_BYTES];
  run_phase(p, PH, smem);
}
template <int PH> static void launch_phases(const Params& p, hipStream_t stream) {
  hipLaunchKernelGGL((phase_kernel<PH>), dim3(256), dim3(NTHR), 0, stream, p);
  if constexpr (PH + 1 < N_PHASES) launch_phases<PH + 1>(p, stream);
}
#endif

extern "C" void kernel_launch(void* const* d_in, const int* in_sizes, int n_in, void* d_out, int out_size, void* d_ws, size_t ws_size, hipStream_t stream) {
  if (ws_size < O_END || n_in < 25) { fprintf(stderr, "workspace too small: %zu < %zu\n", ws_size, (size_t)O_END); return; }
  Params p{};
  p.x = (const float*)d_in[0]; p.pos = (const int*)d_in[1]; p.mix_norm = (const float*)d_in[2]; p.w_in = (const float*)d_in[3]; p.b_forget = (const float*)d_in[4];
  p.pe_k = (const float*)d_in[5]; p.w1_k = (const float*)d_in[6]; p.w2_k = (const float*)d_in[7]; p.pe_v = (const float*)d_in[8]; p.w1_v = (const float*)d_in[9]; p.w2_v = (const float*)d_in[10];
  p.q_norm = (const float*)d_in[11]; p.w_uq = (const float*)d_in[12]; p.kv_norm = (const float*)d_in[13]; p.w_ukv = (const float*)d_in[14];
  p.wbr_nsa = (const float*)d_in[15]; p.wbr_fox = (const float*)d_in[16]; p.wbr_mla = (const float*)d_in[17]; p.w_out = (const float*)d_in[18];
  p.ffn_norm = (const float*)d_in[19]; p.w_up = (const float*)d_in[20]; p.conv_w = (const float*)d_in[21]; p.conv_b = (const float*)d_in[22]; p.w_down = (const float*)d_in[23]; p.final_norm = (const float*)d_in[24];
  p.out = (float*)d_out; p.ws = (unsigned char*)d_ws;
#if ONE_LAUNCH
  static int grid_blocks = 0;
  if (!grid_blocks) {
    int dev = 0, cus = 0, per_cu = 0;
    hipGetDevice(&dev); hipDeviceGetAttribute(&cus, hipDeviceAttributeMultiprocessorCount, dev);
    hipOccupancyMaxActiveBlocksPerMultiprocessor(&per_cu, mega_kernel, NTHR, 0);
    if (per_cu > 1) per_cu = 1;
    grid_blocks = cus * per_cu;
  }
  hipMemsetAsync(p.ws + O_BAR, 0, XCD_BAR_WORDS * 4, stream);
  void* args[] = {&p};
  hipError_t e = hipLaunchCooperativeKernel((void*)mega_kernel, dim3(grid_blocks), dim3(NTHR), args, 0, stream);
  if (e != hipSuccess) fprintf(stderr, "cooperative launch failed: %s (grid %d)\n", hipGetErrorString(e), grid_blocks);
#else
  launch_phases<0>(p, stream);
#endif
}
```

```cpp
#include <hip/hip_runtime.h>
#include <hip/hip_cooperative_groups.h>
#include <stdint.h>
#include <stdio.h>
#include <type_traits>
namespace cg = cooperative_groups;

#ifndef ONE_LAUNCH
#define ONE_LAUNCH 1

#endif

#define DI __device__ __forceinline__
typedef unsigned short bf16_t;
typedef short bf16x8 __attribute__((ext_vector_type(8)));
typedef float f32x4 __attribute__((ext_vector_type(4)));
typedef float f32x16 __attribute__((ext_vector_type(16)));
typedef float f32x2 __attribute__((ext_vector_type(2)));
typedef __bf16 bfx2 __attribute__((ext_vector_type(2)));
typedef unsigned u32x4 __attribute__((ext_vector_type(4)));
typedef unsigned u32x2 __attribute__((ext_vector_type(2)));
typedef unsigned long long u64;

constexpr int T_ = 32768, S_ = 4096, NB_ = 8, D_ = 1024, DFF_ = 2816, NIN_ = 6592;
constexpr float EPS_ = 1e-6f;
constexpr float LOG2E_ = 1.4426950408889634f;
constexpr float QS64_ = 0.125f * LOG2E_;
constexpr float QS96_ = 0.10206207261596577f * LOG2E_;

constexpr size_t W_IN = 0;
constexpr size_t W_G = W_IN + (size_t)3584 * 1024;
constexpr size_t W_1K = W_G + (size_t)3072 * 1024;
constexpr size_t W_1V = W_1K + (size_t)256 * 2048;
constexpr size_t W_2K = W_1V + (size_t)256 * 2048;
constexpr size_t W_2V = W_2K + (size_t)64 * 256;
constexpr size_t W_UQ = W_2V + (size_t)64 * 256;
constexpr size_t W_UKV = W_UQ + (size_t)768 * 384;
constexpr size_t W_BN = W_UKV + (size_t)1024 * 256;
constexpr size_t W_BF = W_BN + (size_t)1024 * 512;
constexpr size_t W_BM = W_BF + (size_t)1024 * 512;
constexpr size_t W_OUT = W_BM + (size_t)1024 * 512;
constexpr size_t W_UP = W_OUT + (size_t)1024 * 1024;
constexpr size_t W_DN = W_UP + (size_t)5632 * 1024;
constexpr size_t W_LAYER = W_DN + (size_t)1024 * 2816;

constexpr size_t al256(size_t x) { return (x + 255) & ~(size_t)255; }
constexpr size_t O_BAR = 0;
constexpr size_t O_W = 16384;
constexpr size_t O_BIAS1 = al256(O_W + 2 * W_LAYER * 2);
constexpr size_t O_ROPE8 = al256(O_BIAS1 + 2 * 2 * 256 * 4);
constexpr size_t O_ROPE16 = al256(O_ROPE8 + (size_t)T_ * 16 * 4);
constexpr size_t O_XG = al256(O_ROPE16 + (size_t)T_ * 32 * 4);
constexpr size_t O_SSQ = al256(O_XG + (size_t)T_ * 1024 * 2);
constexpr size_t O_CSSQ = al256(O_SSQ + (size_t)T_ * 16 * 4);
constexpr size_t O_NSAQ = al256(O_CSSQ + (size_t)T_ * 16 * 4);
constexpr size_t O_KVCMP = O_NSAQ + (size_t)T_ * 512 * 2;
constexpr size_t O_KSLC = O_KVCMP + (size_t)T_ * 256 * 2;
constexpr size_t O_KWIN = O_KSLC + (size_t)T_ * 128 * 2;
constexpr size_t O_MERGED = O_NSAQ;
constexpr size_t O_VSLCT = O_KWIN + (size_t)T_ * 128 * 2;
constexpr size_t O_VWINT = O_VSLCT + (size_t)T_ * 128 * 2;
constexpr size_t O_FOXQ = O_VWINT + (size_t)T_ * 128 * 2;
constexpr size_t O_FOXK = O_FOXQ + (size_t)T_ * 512 * 2;
constexpr size_t O_FOXVT = O_FOXK + (size_t)T_ * 512 * 2;
constexpr size_t O_MLAQ = O_FOXVT + (size_t)T_ * 512 * 2;
constexpr size_t O_MLAKN = O_MLAQ + (size_t)T_ * 768 * 2;
constexpr size_t O_ACT = O_FOXQ;
constexpr size_t O_MLAVT = O_MLAKN + (size_t)T_ * 512 * 2;
constexpr size_t O_MLAKPE = O_MLAVT + (size_t)T_ * 512 * 2;
constexpr size_t O_ONSA = O_MLAKPE + (size_t)T_ * 32 * 2;
constexpr size_t O_CQ = O_ONSA;
constexpr size_t O_CKV = O_CQ + (size_t)T_ * 384 * 2;
constexpr size_t O_CEND = O_CKV + (size_t)T_ * 256 * 2;
constexpr size_t O_GATES = al256(O_CEND > O_ONSA + (size_t)T_ * 512 * 2 ? O_CEND : O_ONSA + (size_t)T_ * 512 * 2);
constexpr size_t O_LOGF = al256(O_GATES + (size_t)T_ * 24 * 4);
constexpr size_t O_F2 = al256(O_LOGF + (size_t)T_ * 8 * 4);
constexpr size_t O_KC = al256(O_F2 + (size_t)T_ * 8 * 4);
constexpr size_t O_VCT = al256(O_KC + (size_t)NB_ * 2 * 256 * 64 * 2);
constexpr size_t O_SEL = al256(O_VCT + (size_t)NB_ * 2 * 256 * 64 * 2);
constexpr size_t O_END = al256(O_SEL + (size_t)NB_ * 2 * S_ * 8);

struct Params {
  const float* x; const int* pos; const float* mix_norm; const float* w_in; const float* b_forget;
  const float* pe_k; const float* w1_k; const float* w2_k; const float* pe_v; const float* w1_v; const float* w2_v;
  const float* q_norm; const float* w_uq; const float* kv_norm; const float* w_ukv;
  const float* wbr_nsa; const float* wbr_fox; const float* wbr_mla; const float* w_out;
  const float* ffn_norm; const float* w_up; const float* conv_w; const float* conv_b; const float* w_down; const float* final_norm;
  float* out; unsigned char* ws;
};

constexpr int NTHR = 512;
constexpr int SMEM_BYTES = 147456;

DI int TIDX() { int t = (int)threadIdx.x; asm volatile("" : "+v"(t)); return t; }
DI unsigned pk2(float lo, float hi) { f32x2 v = {lo, hi}; return __builtin_bit_cast(unsigned, __builtin_convertvector(v, bfx2)); }
DI bf16_t f2bf(float x) { return (bf16_t)(pk2(x, 0.f) & 0xffffu); }
DI float bf2f(bf16_t h) { return __uint_as_float(((unsigned)h) << 16); }
DI float sigmoidf_(float x) { return 1.f / (1.f + __expf(-x)); }
DI float gelu_tanh(float x) { const float u = 0.7978845608028654f * (x + 0.044715f * x * x * x); return x / (1.f + __expf(-2.f * u)); }
DI float ex2(float x) { return __builtin_amdgcn_exp2f(x); }
DI f32x16 mfma32(bf16x8 a, bf16x8 b, f32x16 c) { return __builtin_amdgcn_mfma_f32_32x32x16_bf16(a, b, c, 0, 0, 0); }
DI f32x4 mfma16(bf16x8 a, bf16x8 b, f32x4 c) { return __builtin_amdgcn_mfma_f32_16x16x32_bf16(a, b, c, 0, 0, 0); }
DI float rstd_from16(const float* p, float inv_n) {
  const f32x4 a = *(const f32x4*)p, b = *(const f32x4*)(p + 4), c = *(const f32x4*)(p + 8), d = *(const f32x4*)(p + 12);
  const float s = ((a[0] + a[1]) + (a[2] + a[3])) + ((b[0] + b[1]) + (b[2] + b[3])) + ((c[0] + c[1]) + (c[2] + c[3])) + ((d[0] + d[1]) + (d[2] + d[3]));
  return rsqrtf(s * inv_n + EPS_);
}

constexpr int LDT = 72;
template <int MI, int NJ> struct GemmLds { static constexpr int BM = 32 * MI, BN = 64 * NJ, A_ELEMS = BM * LDT, B_ELEMS = BN * LDT, STAGE = A_ELEMS + B_ELEMS; };

template <int MI, int NJ, bool SWAP, class AP, class BP>
DI void gemm_main(f32x4 (&acc)[MI][NJ], const AP& ap, int a_kstep, const BP& bp, int b_kstep, int nk, bf16_t* smem) {
  typedef GemmLds<MI, NJ> L;
  constexpr int CA = MI / 2, CB = NJ;
  const int tid = TIDX(), lane = tid & 63, wid = tid >> 6, wm = wid >> 2, wn = wid & 3, l15 = lane & 15, quad = lane >> 4;
  unsigned pa[CA], pb[CB]; bool oka[CA];
#pragma unroll
  for (int i = 0; i < CA; ++i) { const int c = tid + NTHR * i; pa[i] = ap(c >> 3) + (c & 7) * 8; oka[i] = ap.ok(c >> 3); }
#pragma unroll
  for (int i = 0; i < CB; ++i) { const int c = tid + NTHR * i; pb[i] = bp(c >> 3) + (c & 7) * 8; }
  u32x4 ra[CA], rb[CB];
  auto gload = [&](int kt) {
    const bf16_t* ab = ap.base + (size_t)kt * a_kstep; const bf16_t* bb = bp.base + (size_t)kt * b_kstep;
#pragma unroll
    for (int i = 0; i < CA; ++i) ra[i] = *(const u32x4*)(ab + pa[i]);
#pragma unroll
    for (int i = 0; i < CB; ++i) rb[i] = *(const u32x4*)(bb + pb[i]);
  };
  auto sstore = [&](int buf) {
    bf16_t* As = smem + buf * L::STAGE; bf16_t* Bs = As + L::A_ELEMS;
#pragma unroll
    for (int i = 0; i < CA; ++i) { const int c = tid + NTHR * i; *(u32x4*)(As + (c >> 3) * LDT + (c & 7) * 8) = oka[i] ? ra[i] : (u32x4){0u, 0u, 0u, 0u}; }
#pragma unroll
    for (int i = 0; i < CB; ++i) { const int c = tid + NTHR * i; *(u32x4*)(Bs + (c >> 3) * LDT + (c & 7) * 8) = rb[i]; }
  };
  gload(0); sstore(0); __syncthreads();
#pragma unroll 1
  for (int kt = 0; kt < nk; ++kt) {
    const int buf = kt & 1;
    gload(kt + 1 < nk ? kt + 1 : nk - 1);
    __builtin_amdgcn_sched_barrier(0);
    const bf16_t* As = smem + buf * L::STAGE + (wm * 16 * MI + l15) * LDT + quad * 8;
    const bf16_t* Bs = smem + buf * L::STAGE + L::A_ELEMS + (wn * 16 * NJ + l15) * LDT + quad * 8;
#pragma unroll
    for (int ks = 0; ks < 2; ++ks) {
      if (MI * NJ >= 32 && ks == 1) asm volatile("" ::: "memory");
      bf16x8 b[NJ];
#pragma unroll
      for (int j = 0; j < NJ; ++j) b[j] = *(const bf16x8*)(Bs + j * 16 * LDT + ks * 32);
#pragma unroll
      for (int i = 0; i < MI; ++i) {
        const bf16x8 a = *(const bf16x8*)(As + i * 16 * LDT + ks * 32);
#pragma unroll
        for (int j = 0; j < NJ; ++j) acc[i][j] = SWAP ? mfma16(b[j], a, acc[i][j]) : mfma16(a, b[j], acc[i][j]);
      }
    }
    sstore(buf ^ 1);
    __syncthreads();
  }
}
template <int MI, int NJ> DI void zero_acc(f32x4 (&acc)[MI][NJ]) {
#pragma unroll
  for (int i = 0; i < MI; ++i)
#pragma unroll
    for (int j = 0; j < NJ; ++j) acc[i][j] = (f32x4){0.f, 0.f, 0.f, 0.f};
}
struct RowPtr { const bf16_t* base; size_t ld; DI unsigned operator()(int r) const { return (unsigned)r * (unsigned)ld; } DI bool ok(int) const { return true; } };


template <class F> DI void xcd_tiles(int MPX, int NT, F&& body) {
  const int xcd = blockIdx.x & 7, slot = blockIdx.x >> 3, nslots = gridDim.x >> 3, total = MPX * NT;
  for (int li = slot; li < total; li += nslots) {
    const int mg = li / (8 * NT), rem = li - mg * 8 * NT;
    const int gsz = (MPX - mg * 8) < 8 ? (MPX - mg * 8) : 8;
    const int tn = rem / gsz, mi = rem - tn * gsz;
    body(xcd * MPX + mg * 8 + mi, tn);
  }
}

DI int map_col(int map, int n) {
  if (map == 0) return n;
  if (map == 1) {
    if (n < 896) return n;
    if (n < 1024) return 1024 + (n - 896);
    if (n < 1152) return 896 + (n - 1024);
    if (n < 1280) return n;
    if (n < 2816) return 1304 + (n - 1280);
    if (n < 3200) return 2848 + (n - 2816);
    if (n < 3456) return 3232 + (n - 3200);
    const int c = n - 3456;
    if (c < 24) return 1280 + c;
    if (c < 32) return 2840 + (c - 24);
    if (c < 64) return 3488 + (c - 32);
    return -1;
  }
  if (map == 2) { const int j = n >> 8, c = n & 255; return c < 128 ? j * 128 + c : DFF_ + j * 128 + (c - 128); }
  if (map == 3) { return n < 512 ? (n >> 6) * 128 + (n & 63) : ((n - 512) >> 6) * 128 + 64 + ((n - 512) & 63); }
  return n;
}
struct WJob { const float* src; const float* scale; bf16_t* dst; int K, N, ld, map, off; };
DI void prep_weight_tile(const WJob& j, int tile, float* lds) {
  const int ntn = j.N >> 6, tk = tile / ntn, tn = tile % ntn, tid = TIDX();
  const int n = tn * 64 + (tid & 63); const int sc = map_col(j.map, n);
#pragma unroll 4
  for (int i = 0; i < 8; ++i) {
    const int kk = (tid >> 6) + 8 * i, k = tk * 64 + kk;
    float v = sc >= 0 ? j.src[(size_t)k * j.ld + j.off + sc] : 0.f;
    if (j.scale) v *= j.scale[k];
    lds[kk * 65 + (tid & 63)] = v;
  }
  __syncthreads();
  const int nn = tid >> 3, k0 = (tid & 7) * 8;
  unsigned w[4];
#pragma unroll
  for (int e = 0; e < 4; ++e) w[e] = pk2(lds[(k0 + 2 * e) * 65 + nn], lds[(k0 + 2 * e + 1) * 65 + nn]);
  bf16_t* d = j.dst + (size_t)(tn * 64 + nn) * j.K + tk * 64 + k0;
  *(u32x4*)d = (u32x4){w[0], w[1], w[2], w[3]};
  __syncthreads();
}
DI WJob get_wjob(const Params& p, int layer, int id) {
  bf16_t* wl = (bf16_t*)(p.ws + O_W) + (size_t)layer * W_LAYER; WJob j; j.scale = nullptr; j.map = 0; j.off = 0;
  switch (id) {
    case 0: j.src = p.w_in + (size_t)layer * 1024 * NIN_; j.dst = wl + W_IN; j.K = 1024; j.N = 3584; j.ld = NIN_; j.map = 1; break;
    case 1: j.src = p.w_in + (size_t)layer * 1024 * NIN_; j.dst = wl + W_G; j.K = 1024; j.N = 3072; j.ld = NIN_; j.off = 3520; break;
    case 2: j.src = p.w1_k + (size_t)layer * 2048 * 256; j.dst = wl + W_1K; j.K = 2048; j.N = 256; j.ld = 256; break;
    case 3: j.src = p.w1_v + (size_t)layer * 2048 * 256; j.dst = wl + W_1V; j.K = 2048; j.N = 256; j.ld = 256; break;
    case 4: j.src = p.w2_k + (size_t)layer * 256 * 64; j.dst = wl + W_2K; j.K = 256; j.N = 64; j.ld = 64; break;
    case 5: j.src = p.w2_v + (size_t)layer * 256 * 64; j.dst = wl + W_2V; j.K = 256; j.N = 64; j.ld = 64; break;
    case 6: j.src = p.w_uq + (size_t)layer * 384 * 768; j.dst = wl + W_UQ; j.K = 384; j.N = 768; j.ld = 768; j.scale = p.q_norm + layer * 384; break;
    case 7: j.src = p.w_ukv + (size_t)layer * 256 * 1024; j.dst = wl + W_UKV; j.K = 256; j.N = 1024; j.ld = 1024; j.scale = p.kv_norm + layer * 256; j.map = 3; break;
    case 8: j.src = p.wbr_nsa + (size_t)layer * 512 * 1024; j.dst = wl + W_BN; j.K = 512; j.N = 1024; j.ld = 1024; break;
    case 9: j.src = p.wbr_fox + (size_t)layer * 512 * 1024; j.dst = wl + W_BF; j.K = 512; j.N = 1024; j.ld = 1024; break;
    case 10: j.src = p.wbr_mla + (size_t)layer * 512 * 1024; j.dst = wl + W_BM; j.K = 512; j.N = 1024; j.ld = 1024; break;
    case 11: j.src = p.w_out + (size_t)layer * 1024 * 1024; j.dst = wl + W_OUT; j.K = 1024; j.N = 1024; j.ld = 1024; break;
    case 12: j.src = p.w_up + (size_t)layer * 1024 * 5632; j.dst = wl + W_UP; j.K = 1024; j.N = 5632; j.ld = 5632; j.map = 2; break;
    default: j.src = p.w_down + (size_t)layer * 2816 * 1024; j.dst = wl + W_DN; j.K = 2816; j.N = 1024; j.ld = 1024; break;
  }
  return j;
}
constexpr int WTILES_LAYER = (int)(W_LAYER / 4096);
constexpr int P0_XITEMS = T_ / 64;
constexpr int P0_ROPE_ITEMS = T_ / NTHR;
constexpr int P0_ITEMS = 2 * WTILES_LAYER + 4 + P0_ROPE_ITEMS + P0_XITEMS;

DI void xg_rows(const float* x, const float* g, bf16_t* xg, float* ssq, int row0) {
  const int lane = TIDX() & 63, wid = TIDX() >> 6;
  for (int rr = 0; rr < 8; ++rr) {
    const int t = row0 + wid * 8 + rr; const float* xr = x + (size_t)t * D_; float s = 0.f;
#pragma unroll
    for (int c = 0; c < 4; ++c) {
      const int k = c * 256 + lane * 4; const f32x4 v = *(const f32x4*)(xr + k), gv = *(const f32x4*)(g + k);
      s += v[0] * v[0] + v[1] * v[1] + v[2] * v[2] + v[3] * v[3];
      *(u32x2*)(xg + (size_t)t * D_ + k) = (u32x2){pk2(v[0] * gv[0], v[1] * gv[1]), pk2(v[2] * gv[2], v[3] * gv[3])};
    }
#pragma unroll
    for (int o = 32; o >= 1; o >>= 1) s += __shfl_xor(s, o);
    if (lane < 16) ssq[(size_t)t * 16 + lane] = lane == 0 ? s : 0.f;
  }
}
DI void phase_prep(const Params& p, unsigned char* smem) {
  for (int it = blockIdx.x; it < P0_ITEMS; it += gridDim.x) {
    int i = it;
    if (i < 2 * WTILES_LAYER) {
      const int layer = i / WTILES_LAYER; int t = i % WTILES_LAYER; int id = 0;
      for (;; ++id) { const WJob j = get_wjob(p, layer, id); const int nt = (j.K >> 6) * (j.N >> 6); if (t < nt) { prep_weight_tile(j, t, (float*)smem); break; } t -= nt; }
      continue;
    }
    i -= 2 * WTILES_LAYER;
    if (i < 4) {
      const int layer = i >> 1, kv = i & 1, c = TIDX();
      if (c < 256) {
        const float* pe = (kv ? p.pe_v : p.pe_k) + (size_t)layer * 2048; const float* w1 = (kv ? p.w1_v : p.w1_k) + (size_t)layer * 2048 * 256;
        float s = 0.f;
        for (int kk = 0; kk < 2048; ++kk) s += pe[kk] * w1[(size_t)kk * 256 + c];
        ((float*)(p.ws + O_BIAS1))[(layer * 2 + kv) * 256 + c] = s;
      }
      continue;
    }
    i -= 4;
    if (i < P0_ROPE_ITEMS) {
      const int t = i * NTHR + TIDX(); const float fp = (float)p.pos[t];
      float* r8 = (float*)(p.ws + O_ROPE8) + (size_t)t * 16; float* r16 = (float*)(p.ws + O_ROPE16) + (size_t)t * 32;
      for (int f = 0; f < 24; ++f) {
        const int half = f < 8 ? 8 : 16, idx = f < 8 ? f : f - 8;
        const float inv = exp2f(-(float)idx / (float)half * 18.931568569324174f);
        const float ang = fp * inv;
        const double rev = (double)ang * 0.15915494309189535; const float fr = (float)(rev - floor(rev));
        const float sn = __builtin_amdgcn_sinf(fr), cs = __builtin_amdgcn_cosf(fr);
        if (f < 8) { r8[2 * idx] = cs; r8[2 * idx + 1] = sn; } else { r16[2 * idx] = cs; r16[2 * idx + 1] = sn; }
      }
      continue;
    }
    i -= P0_ROPE_ITEMS;
    xg_rows(p.x, p.mix_norm, (bf16_t*)(p.ws + O_XG), (float*)(p.ws + O_SSQ), i * 64);
  }
}

DI void store4(bf16_t* dst, const f32x4& v, float s) { *(u32x2*)dst = (u32x2){pk2(v[0] * s, v[1] * s), pk2(v[2] * s, v[3] * s)}; }
constexpr int STG_LD = 72, STG_WAVE = 128 * 72;
DI void stage4(bf16_t* stg, int row, int col, const f32x4& v, float s) { *(u32x2*)(stg + row * STG_LD + col) = (u32x2){pk2(v[0] * s, v[1] * s), pk2(v[2] * s, v[3] * s)}; }
template <int ROWS, int COLS, int LD> DI void stage_out(const bf16_t* stg, bf16_t* dst, size_t ld, int lane) {
  asm volatile("s_waitcnt lgkmcnt(0)" ::: "memory");
  constexpr int CPR = COLS / 8, IT = ROWS * CPR / 64;
#pragma unroll
  for (int it = 0; it < IT; ++it) {
    const int idx = it * 64 + lane, r = idx / CPR, c = idx % CPR;
    __builtin_nontemporal_store(*(const u32x4*)(stg + r * LD + c * 8), (u32x4*)(dst + (size_t)r * ld + c * 8));
  }
}
template <bool SWAP> DI void inproj_tile(const Params& p, int layer, int tm, int tn, bf16_t* smem) {
  const bf16_t* wl = (const bf16_t*)(p.ws + O_W) + (size_t)layer * W_LAYER;
  f32x4 acc[8][4]; zero_acc<8, 4>(acc);
  RowPtr ap{(const bf16_t*)(p.ws + O_XG) + (size_t)tm * 256 * D_, (size_t)D_}, bp{wl + W_IN + (size_t)tn * 256 * D_, (size_t)D_};
  gemm_main<8, 4, SWAP>(acc, ap, 64, bp, 64, 16, smem);
  const int lane = TIDX() & 63, wid = TIDX() >> 6, wm = wid >> 2, wn = wid & 3, l15 = lane & 15, quad = lane >> 4;
  const float* ssq = (const float*)(p.ws + O_SSQ);
  bf16_t* stg = smem + wid * STG_WAVE;
  const int trow0 = tm * 256 + wm * 128;
  if constexpr (!SWAP) {
    bf16_t* dst; int hh, hd;
    if (tn == 4) { dst = (bf16_t*)(p.ws + (wn < 2 ? O_VSLCT : O_VWINT)); hh = 2; hd = wn & 1; } else { dst = (bf16_t*)(p.ws + O_FOXVT); hh = 8; hd = (tn - 9) * 4 + wn; }
    constexpr int VLD = 136;
#pragma unroll
    for (int i = 0; i < 8; ++i) {
      const int t0 = trow0 + i * 16 + quad * 4;
      float rs[4];
#pragma unroll
      for (int r = 0; r < 4; ++r) rs[r] = rstd_from16(ssq + (size_t)(t0 + r) * 16, 1.f / 1024.f);
#pragma unroll
      for (int j = 0; j < 4; ++j)
        *(u32x2*)(stg + (j * 16 + l15) * VLD + i * 16 + quad * 4) = (u32x2){pk2(acc[i][j][0] * rs[0], acc[i][j][1] * rs[1]), pk2(acc[i][j][2] * rs[2], acc[i][j][3] * rs[3])};
    }
    const int b = trow0 >> 12, s0 = trow0 & 4095;
    stage_out<64, 128, VLD>(stg, dst + ((size_t)(b * hh + hd) * 64) * S_ + s0, (size_t)S_, lane);
  } else {
    const int slab = tn * 4 + wn;
    if (slab == 54) {
#pragma unroll
      for (int i = 0; i < 8; ++i) {
        const int t = trow0 + i * 16 + l15; const float rs = rstd_from16(ssq + (size_t)t * 16, 1.f / 1024.f);
        float* gt = (float*)(p.ws + O_GATES) + (size_t)t * 24; float* lf = (float*)(p.ws + O_LOGF) + (size_t)t * 8;
#pragma unroll
        for (int r = 0; r < 4; ++r) gt[quad * 4 + r] = sigmoidf_(acc[i][0][r] * rs);
        if (quad < 2) {
#pragma unroll
          for (int r = 0; r < 4; ++r) gt[16 + quad * 4 + r] = sigmoidf_(acc[i][1][r] * rs);
        } else {
#pragma unroll
          for (int r = 0; r < 4; ++r) { const int h = (quad - 2) * 4 + r; const float xx = acc[i][1][r] * rs + p.b_forget[layer * 8 + h]; lf[h] = fminf(xx, 0.f) - log1pf(__expf(-fabsf(xx))); }
        }
        const float* rp = (const float*)(p.ws + O_ROPE16) + (size_t)t * 32 + quad * 8; float o1[4], o2[4];
#pragma unroll
        for (int r = 0; r < 4; ++r) { const float cs = rp[2 * r], sn = rp[2 * r + 1], x1 = acc[i][2][r] * rs, x2 = acc[i][3][r] * rs; o1[r] = x1 * cs - x2 * sn; o2[r] = x2 * cs + x1 * sn; }
        bf16_t* kp = (bf16_t*)(p.ws + O_MLAKPE) + (size_t)t * 32 + quad * 4;
        *(u32x2*)kp = (u32x2){pk2(o1[0], o1[1]), pk2(o1[2], o1[3])}; *(u32x2*)(kp + 16) = (u32x2){pk2(o2[0], o2[1]), pk2(o2[2], o2[3])};
      }
    } else if (slab != 55) {
      bf16_t* dbuf; int dld, dcol, kind = 0; float qs = 1.f; int cslot = 0;
      if (slab < 8) { dbuf = (bf16_t*)(p.ws + O_NSAQ); dld = 512; dcol = slab * 64; qs = QS64_; }
      else if (slab < 12) { dbuf = (bf16_t*)(p.ws + O_KVCMP); dld = 256; dcol = (slab - 8) * 64; }
      else if (slab < 16) { dbuf = (bf16_t*)(p.ws + (slab < 14 ? O_KSLC : O_KWIN)); dld = 128; dcol = (slab & 1) * 64; kind = 1; }
      else if (slab < 28) { dbuf = (bf16_t*)(p.ws + O_FOXQ); dld = 512; dcol = (slab - 20) * 64; qs = QS64_; }
      else if (slab < 36) { dbuf = (bf16_t*)(p.ws + O_FOXK); dld = 512; dcol = (slab - 28) * 64; }
      else if (slab < 50) { dbuf = (bf16_t*)(p.ws + O_CQ); dld = 384; dcol = (slab - 44) * 64; kind = 2; cslot = slab - 44; }
      else { dbuf = (bf16_t*)(p.ws + O_CKV); dld = 256; dcol = (slab - 50) * 64; kind = 2; cslot = 8 + slab - 50; }
#pragma unroll
      for (int i = 0; i < 8; ++i) {
        const int row = i * 16 + l15, t = trow0 + row; const float rs = rstd_from16(ssq + (size_t)t * 16, 1.f / 1024.f) * qs;
        if (kind == 1) {
          const float* rp = (const float*)(p.ws + O_ROPE8) + (size_t)t * 16 + (quad & 1) * 8;
          f32x4 v, o;
#pragma unroll
          for (int r = 0; r < 4; ++r) { v[r] = acc[i][0][r] * rs; o[r] = __shfl_xor(v[r], 32); }
#pragma unroll
          for (int r = 0; r < 4; ++r) { const float cs = rp[2 * r], sn = rp[2 * r + 1]; v[r] = quad < 2 ? v[r] * cs - o[r] * sn : v[r] * cs + o[r] * sn; }
          stage4(stg, row, quad * 4, v, 1.f);
        } else stage4(stg, row, quad * 4, acc[i][0], rs);
#pragma unroll
        for (int j = 1; j < 4; ++j) stage4(stg, row, j * 16 + quad * 4, acc[i][j], rs);
        if (kind == 2) {
          float s = 0.f;
#pragma unroll
          for (int j = 0; j < 4; ++j) { const f32x4 a = acc[i][j] * rs; s += a[0] * a[0] + a[1] * a[1] + a[2] * a[2] + a[3] * a[3]; }
          s += __shfl_xor(s, 16); s += __shfl_xor(s, 32);
          if (quad == 0) ((float*)(p.ws + O_CSSQ))[(size_t)t * 16 + cslot] = s;
        }
      }
      stage_out<128, 64, STG_LD>(stg, dbuf + (size_t)trow0 * dld + dcol, (size_t)dld, lane);
    }
  }
  __syncthreads();
}
DI void phase_inproj(const Params& p, int layer, unsigned char* smem) {
  xcd_tiles(16, 14, [&](int tm, int tn) {
    const bool vt = (tn == 4 || tn == 9 || tn == 10);
    if (vt) inproj_tile<false>(p, layer, tm, tn, (bf16_t*)smem); else inproj_tile<true>(p, layer, tm, tn, (bf16_t*)smem);
  });
}

template <int KIND> DI void mlaup_tile(const Params& p, int layer, int tm, int tn, bf16_t* smem) {
  const bf16_t* wl = (const bf16_t*)(p.ws + O_W) + (size_t)layer * W_LAYER;
  f32x4 acc[8][4]; zero_acc<8, 4>(acc);
  constexpr int K = KIND == 0 ? 384 : 256;
  RowPtr ap{KIND == 0 ? (const bf16_t*)(p.ws + O_CQ) + (size_t)tm * 256 * 384 : (const bf16_t*)(p.ws + O_CKV) + (size_t)tm * 256 * 256, (size_t)K};
  RowPtr bp{KIND == 0 ? wl + W_UQ + (size_t)tn * 256 * 384 : wl + W_UKV + (size_t)(tn - 3) * 256 * 256, (size_t)K};
  gemm_main<8, 4, KIND != 2>(acc, ap, 64, bp, 64, K / 64, smem);
  const int lane = TIDX() & 63, wid = TIDX() >> 6, wm = wid >> 2, wn = wid & 3, l15 = lane & 15, quad = lane >> 4;
  const float* cssq = (const float*)(p.ws + O_CSSQ);
  bf16_t* stg = smem + wid * STG_WAVE; const int trow0 = tm * 256 + wm * 128;
  if constexpr (KIND == 2) {
    bf16_t* dst = (bf16_t*)(p.ws + O_MLAVT); const int h = (tn - 5) * 4 + wn;
    constexpr int VLD = 136;
#pragma unroll
    for (int i = 0; i < 8; ++i) {
      asm volatile("" ::: "memory");
      const int t0 = trow0 + i * 16 + quad * 4; float rs[4];
#pragma unroll
      for (int r = 0; r < 4; ++r) { const float* c = cssq + (size_t)(t0 + r) * 16 + 8; rs[r] = rsqrtf((c[0] + c[1] + c[2] + c[3]) * (1.f / 256.f) + EPS_); }
#pragma unroll
      for (int j = 0; j < 4; ++j)
        *(u32x2*)(stg + (j * 16 + l15) * VLD + i * 16 + quad * 4) = (u32x2){pk2(acc[i][j][0] * rs[0], acc[i][j][1] * rs[1]), pk2(acc[i][j][2] * rs[2], acc[i][j][3] * rs[3])};
    }
    stage_out<64, 128, VLD>(stg, dst + ((size_t)((trow0 >> 12) * 8 + h) * 64) * S_ + (trow0 & 4095), (size_t)S_, lane);
  } else if constexpr (KIND == 1) {
#pragma unroll
    for (int i = 0; i < 8; ++i) {
      asm volatile("" ::: "memory");
      const int row = i * 16 + l15, t = trow0 + row; const float* c = cssq + (size_t)t * 16;
      const float rs = rsqrtf((c[8] + c[9] + c[10] + c[11]) * (1.f / 256.f) + EPS_);
#pragma unroll
      for (int j = 0; j < 4; ++j) stage4(stg, row, j * 16 + quad * 4, acc[i][j], rs);
    }
    stage_out<128, 64, STG_LD>(stg, (bf16_t*)(p.ws + O_MLAKN) + (size_t)trow0 * 512 + (tn - 3) * 256 + wn * 64, (size_t)512, lane);
  } else {
    const int n0 = tn * 256 + wn * 64, ph = n0 % 96;
#pragma unroll
    for (int i = 0; i < 8; ++i) {
      asm volatile("" ::: "memory");
      const int row = i * 16 + l15, t = trow0 + row; const float* c = cssq + (size_t)t * 16;
      const float rs = rsqrtf((c[0] + c[1] + c[2] + c[3] + c[4] + c[5]) * (1.f / 384.f) + EPS_) * QS96_;
      f32x4 v0 = acc[i][0] * rs, v1 = acc[i][1] * rs, v2 = acc[i][2] * rs, v3 = acc[i][3] * rs;
      if (ph != 0) {
        const float* rp = (const float*)(p.ws + O_ROPE16) + (size_t)t * 32 + quad * 8;
        const f32x4 x1 = ph == 64 ? v0 : v2, x2 = ph == 64 ? v1 : v3; f32x4 o1, o2;
#pragma unroll
        for (int r = 0; r < 4; ++r) { const float cs = rp[2 * r], sn = rp[2 * r + 1]; o1[r] = x1[r] * cs - x2[r] * sn; o2[r] = x2[r] * cs + x1[r] * sn; }
        if (ph == 64) { v0 = o1; v1 = o2; } else { v2 = o1; v3 = o2; }
      }
      stage4(stg, row, quad * 4, v0, 1.f); stage4(stg, row, 16 + quad * 4, v1, 1.f); stage4(stg, row, 32 + quad * 4, v2, 1.f); stage4(stg, row, 48 + quad * 4, v3, 1.f);
    }
    stage_out<128, 64, STG_LD>(stg, (bf16_t*)(p.ws + O_MLAQ) + (size_t)trow0 * 768 + n0, (size_t)768, lane);
  }
  __syncthreads();
}
struct CmpRowPtr { const bf16_t* base; int r0;
  DI unsigned operator()(int r) const { int R = r0 + r; if (R >= 4080) R = 0; const int b = R / 510, rem = R - b * 510, n = rem >> 1, g = rem & 1; return (unsigned)(b * S_ + 16 * n) * 256u + g * 64; }
  DI bool ok(int r) const { return r0 + r < 4080; } };
DI void compress_item(const Params& p, int layer, int item, bf16_t* smem) {
  const int kv = item >> 4, tm = item & 15;
  const bf16_t* wl = (const bf16_t*)(p.ws + O_W) + (size_t)layer * W_LAYER;
  f32x4 acc[8][4]; zero_acc<8, 4>(acc);
  CmpRowPtr ap{(const bf16_t*)(p.ws + O_KVCMP) + kv * 128, tm * 256};
  RowPtr bp{wl + (kv ? W_1V : W_1K), (size_t)2048};
  gemm_main<8, 4, true>(acc, ap, 256, bp, 64, 32, smem);
  const int lane = TIDX() & 63, wid = TIDX() >> 6, wm = wid >> 2, wn = wid & 3, l15 = lane & 15, quad = lane >> 4;
  constexpr int LDH = 264; bf16_t* H = smem;
  const float* b1 = (const float*)(p.ws + O_BIAS1) + (layer * 2 + kv) * 256;
#pragma unroll
  for (int i = 0; i < 8; ++i)
#pragma unroll
    for (int j = 0; j < 4; ++j) {
      const int row = wm * 128 + i * 16 + l15, col = wn * 64 + j * 16 + quad * 4; const f32x4 bv = *(const f32x4*)(b1 + col);
      *(u32x2*)(H + row * LDH + col) = (u32x2){pk2(gelu_tanh(acc[i][j][0] + bv[0]), gelu_tanh(acc[i][j][1] + bv[1])), pk2(gelu_tanh(acc[i][j][2] + bv[2]), gelu_tanh(acc[i][j][3] + bv[3]))};
    }
  __syncthreads();
  f32x4 a2[2][4];
#pragma unroll
  for (int i = 0; i < 2; ++i)
#pragma unroll
    for (int j = 0; j < 4; ++j) a2[i][j] = (f32x4){0.f, 0.f, 0.f, 0.f};
  const bf16_t* w2 = wl + (kv ? W_2V : W_2K);
#pragma unroll
  for (int ks = 0; ks < 8; ++ks) {
    bf16x8 a[2], b[4];
#pragma unroll
    for (int i = 0; i < 2; ++i) a[i] = *(const bf16x8*)(H + (wid * 32 + i * 16 + l15) * LDH + ks * 32 + quad * 8);
#pragma unroll
    for (int j = 0; j < 4; ++j) b[j] = *(const bf16x8*)(w2 + (size_t)(j * 16 + l15) * 256 + ks * 32 + quad * 8);
#pragma unroll
    for (int i = 0; i < 2; ++i)
#pragma unroll
      for (int j = 0; j < 4; ++j) a2[i][j] = mfma16(a[i], b[j], a2[i][j]);
  }
  bf16_t* kc = (bf16_t*)(p.ws + O_KC); bf16_t* vct = (bf16_t*)(p.ws + O_VCT);
#pragma unroll
  for (int i = 0; i < 2; ++i)
#pragma unroll
    for (int r = 0; r < 4; ++r) {
      const int R = tm * 256 + wid * 32 + i * 16 + quad * 4 + r;
      if (R < 4080) {
        const int b = R / 510, rem = R - b * 510, n = rem >> 1, g = rem & 1;
#pragma unroll
        for (int j = 0; j < 4; ++j) {
          const int d = j * 16 + l15; const bf16_t v = f2bf(a2[i][j][r]);
          if (kv == 0) kc[((size_t)(b * 2 + g) * 256 + n) * 64 + d] = v; else vct[((size_t)(b * 2 + g) * 64 + d) * 256 + n] = v;
        }
      }
    }
  __syncthreads();
}
DI void foxscan_item(const Params& p, int item, float* lds) {
  const int b = item >> 3, h = item & 7, tid = TIDX();
  const float* lf = (const float*)(p.ws + O_LOGF) + (size_t)b * S_ * 8 + h; float v[8]; float s = 0.f;
#pragma unroll
  for (int i = 0; i < 8; ++i) { s += lf[(size_t)(tid * 8 + i) * 8]; v[i] = s; }
  lds[tid] = s; __syncthreads();
  float off = 0.f;
  for (int i = 0; i < tid; ++i) off += lds[i];
  float* F2 = (float*)(p.ws + O_F2) + (size_t)(b * 8 + h) * S_ + tid * 8;
#pragma unroll
  for (int i = 0; i < 8; ++i) F2[i] = -(off + v[i]) * LOG2E_;
  __syncthreads();
}
DI void phase_b(const Params& p, int layer, unsigned char* smem) {
  for (int it = blockIdx.x; it < 96; it += gridDim.x) {
    if (it < 32) compress_item(p, layer, it, (bf16_t*)smem);
    else foxscan_item(p, it - 32, (float*)smem);
  }
  xcd_tiles(16, 7, [&](int tm, int tn) {
    if (tn >= 5) mlaup_tile<2>(p, layer, tm, tn, (bf16_t*)smem); else if (tn >= 3) mlaup_tile<1>(p, layer, tm, tn, (bf16_t*)smem); else mlaup_tile<0>(p, layer, tm, tn, (bf16_t*)smem);
  });
}

constexpr int KC_LD = 72, VC_LD = 264;
DI void cmp_item(const Params& p, int item, unsigned char* smem_) {
  const int b = item >> 6, g = (item >> 5) & 1, tt = item & 31, t0 = tt * 128;
  const int tid = TIDX(), lane = tid & 63, wid = tid >> 6, l15 = lane & 15, quad = lane >> 4;
  bf16_t* kcs = (bf16_t*)smem_;
  bf16_t* vcs = kcs + 256 * KC_LD;
  float* imps = (float*)smem_;
  const int nmax = (t0 + 96) >> 4;
  const int nsub = (nmax >> 4) + 1;
  {
    const bf16_t* kcg = (const bf16_t*)(p.ws + O_KC) + (size_t)(b * 2 + g) * 256 * 64; const bf16_t* vcg = (const bf16_t*)(p.ws + O_VCT) + (size_t)(b * 2 + g) * 64 * 256;
    const int nrows = ((nsub + 1) & ~1) * 16;
    for (int e = tid; e < nrows * 8; e += NTHR) {
      const int n = e >> 3, dc = (e & 7) * 8;
      *(u32x4*)(kcs + n * KC_LD + dc) = n < 255 ? *(const u32x4*)(kcg + (size_t)n * 64 + dc) : (u32x4){0u, 0u, 0u, 0u};
    }
    const int ncs = nrows >> 3;
    for (int e = tid; e < 64 * ncs; e += NTHR) {
      const int d = e / ncs, nc = (e - d * ncs) * 8;
      u32x4 v = *(const u32x4*)(vcg + (size_t)d * 256 + nc);
      if (nc + 8 > 255) v[3] &= 0x0000ffffu;
      *(u32x4*)(vcs + d * VC_LD + nc) = v;
    }
  }
  __syncthreads();
  const int tq = t0 + wid * 16 + l15;
  const size_t trow = (size_t)b * S_ + tq;
  float impa[16], p3a[16];
#pragma unroll
  for (int s = 0; s < 16; ++s) { impa[s] = 0.f; p3a[s] = 0.f; }
  const float* gts = (const float*)(p.ws + O_GATES) + trow * 24;
#pragma unroll 1
  for (int r4 = 0; r4 < 4; ++r4) {
    const int head = g * 4 + r4;
    const bf16_t* qp = (const bf16_t*)(p.ws + O_NSAQ) + trow * 512 + head * 64 + quad * 8;
    const bf16x8 q0 = *(const bf16x8*)qp, q1 = *(const bf16x8*)(qp + 32);
    auto score = [&](int s) -> f32x4 {
      const bf16_t* kr = kcs + (s * 16 + l15) * KC_LD + quad * 8;
      f32x4 a = {0.f, 0.f, 0.f, 0.f};
      a = mfma16(*(const bf16x8*)kr, q0, a); a = mfma16(*(const bf16x8*)(kr + 32), q1, a);
#pragma unroll
      for (int r = 0; r < 4; ++r) { const int n = s * 16 + quad * 4 + r; a[r] = (16 * n + 31 <= tq) ? a[r] : -INFINITY; }
      return a;
    };
    float mx = -INFINITY;
#pragma unroll 1
    for (int s = 0; s < nsub; ++s) { const f32x4 a = score(s); mx = fmaxf(mx, fmaxf(fmaxf(a[0], a[1]), fmaxf(a[2], a[3]))); }
    mx = fmaxf(mx, __shfl_xor(mx, 16)); mx = fmaxf(mx, __shfl_xor(mx, 32));
    if (mx == -INFINITY) mx = 0.f;
    float sum = 0.f;
#pragma unroll 1
    for (int s = 0; s < nsub; ++s) { const f32x4 a = score(s); sum += (ex2(a[0] - mx) + ex2(a[1] - mx)) + (ex2(a[2] - mx) + ex2(a[3] - mx)); }
    sum += __shfl_xor(sum, 16); sum += __shfl_xor(sum, 32);
    const float inv = 1.f / fmaxf(sum, 1e-30f);
    f32x4 oacc[4];
#pragma unroll
    for (int j = 0; j < 4; ++j) oacc[j] = (f32x4){0.f, 0.f, 0.f, 0.f};
#pragma unroll
    for (int c = 0; c < 8; ++c) {
      asm volatile("" ::: "memory");
      if (2 * c < nsub) {
        f32x4 pa = score(2 * c), pb = {-INFINITY, -INFINITY, -INFINITY, -INFINITY};
        if (2 * c + 1 < nsub) pb = score(2 * c + 1);
#pragma unroll
        for (int r = 0; r < 4; ++r) { pa[r] = ex2(pa[r] - mx) * inv; pb[r] = ex2(pb[r] - mx) * inv; }
        impa[2 * c] += pa[0] + pa[1] + pa[2] + 0.5f * pa[3]; p3a[2 * c] += pa[3];
        impa[2 * c + 1] += pb[0] + pb[1] + pb[2] + 0.5f * pb[3]; p3a[2 * c + 1] += pb[3];
        const u32x4 pw = {pk2(pa[0], pa[1]), pk2(pa[2], pa[3]), pk2(pb[0], pb[1]), pk2(pb[2], pb[3])};
        const bf16x8 pf = __builtin_bit_cast(bf16x8, pw);
#pragma unroll
        for (int j = 0; j < 4; ++j) {
          const bf16_t* vr = vcs + (j * 16 + l15) * VC_LD + c * 32 + quad * 4;
          const u32x2 lo = *(const u32x2*)vr, hi = *(const u32x2*)(vr + 16);
          const u32x4 vw = {lo[0], lo[1], hi[0], hi[1]};
          oacc[j] = mfma16(__builtin_bit_cast(bf16x8, vw), pf, oacc[j]);
        }
      }
    }
    const float g0 = gts[head * 3 + 0];
    bf16_t* op = (bf16_t*)(p.ws + O_ONSA) + trow * 512 + head * 64 + quad * 4;
#pragma unroll
    for (int j = 0; j < 4; ++j) store4(op + j * 16, oacc[j], g0);
  }
  __syncthreads();
  float* myimp = imps + wid * 1024 + l15 * 64;
  const int cur = tq >> 6;
#pragma unroll
  for (int s = 0; s < 16; ++s) {
    const float up = __shfl(p3a[s], (lane + 48) & 63);
    const float up0 = s ? __shfl(p3a[s ? s - 1 : 0], (lane + 48) & 63) : 0.f;
    const float prev = quad ? up : up0;
    float v = impa[s] + 0.5f * prev;
    const int j = 4 * s + quad;
    if (j == 0 || j == cur || j == cur - 1) v = 1e9f; else if (j > cur) v = -1e9f;
    myimp[j] = v;
  }
  __syncthreads();
  u64* sel = (u64*)(p.ws + O_SEL) + (size_t)(b * 2 + g) * S_ + t0 + wid * 16;
#pragma unroll 1
  for (int q = 0; q < 16; ++q) {
    const float mine = imps[wid * 1024 + q * 64 + lane]; int rank = 0;
#pragma unroll
    for (int i = 0; i < 64; ++i) { const float v = __uint_as_float(__builtin_amdgcn_readlane(__float_as_uint(mine), i)); rank += (v > mine || (v == mine && i < lane)) ? 1 : 0; }
    const u64 m = __ballot(rank < 16);
    if (lane == 0) sel[q] = m;
  }
  __syncthreads();
}
constexpr int PC_ITEMS = NB_ * 2 * 32;
DI void phase_c(const Params& p, unsigned char* smem) { for (int it = blockIdx.x; it < PC_ITEMS; it += gridDim.x) cmp_item(p, it, smem); }

enum { M_FOX = 0, M_MLA = 1, M_WIN = 2, M_SLC = 3 };
template <int MODE> struct ACfg { static constexpr int DQK = MODE == M_MLA ? 96 : 64, KLD = DQK + 8, NKC = DQK / 8 * 64, KCH = (NKC + NTHR - 1) / NTHR, K_ELEMS = 64 * KLD, V_ELEMS = 64 * 72, STAGE = K_ELEMS + V_ELEMS + 128; };
struct AState { f32x16 o[2]; f32x16 mr; float m, l; };

template <int MODE>
DI void flash_pass(AState& st, const bf16x8* qf, u64 tmask, u64 wmask,
                   const bf16_t* kbase, size_t kld, const bf16_t* kpe, const bf16_t* vtbase, const float* fbias,
                   int tq, u64 mysel, bf16_t* smem) {
  typedef ACfg<MODE> C;
  const int tid = TIDX(), lane = tid & 63, l31 = lane & 31, half = lane >> 5;
  u32x4 rk[C::KCH], rv; float rf = 0.f;
  auto gload = [&](int j) {
    const int k0 = j * 64;
#pragma unroll
    for (int i = 0; i < C::KCH; ++i) {
      const int c = tid + NTHR * i;
      if (c < C::NKC) {
        if constexpr (MODE == M_MLA) { const int key = c / 12, dc = c % 12; rk[i] = dc < 8 ? *(const u32x4*)(kbase + (size_t)(k0 + key) * kld + dc * 8) : *(const u32x4*)(kpe + (size_t)(k0 + key) * 32 + (dc - 8) * 8); }
        else { const int key = c >> 3, dc = c & 7; rk[i] = *(const u32x4*)(kbase + (size_t)(k0 + key) * kld + dc * 8); }
      }
    }
    { const int d = tid >> 3, kc = tid & 7; rv = *(const u32x4*)(vtbase + (size_t)d * S_ + k0 + kc * 8); }
    if constexpr (MODE == M_FOX) { if (tid < 64) rf = fbias[k0 + tid]; }
  };
  auto sstore = [&](int buf) {
    bf16_t* Ks = smem + buf * C::STAGE; bf16_t* Vs = Ks + C::K_ELEMS;
#pragma unroll
    for (int i = 0; i < C::KCH; ++i) {
      const int c = tid + NTHR * i;
      if (c < C::NKC) {
        if constexpr (MODE == M_MLA) { const int key = c / 12, dc = c % 12; *(u32x4*)(Ks + key * C::KLD + dc * 8) = rk[i]; }
        else { const int key = c >> 3, dc = c & 7; *(u32x4*)(Ks + key * C::KLD + dc * 8) = rk[i]; }
      }
    }
    {
      const int d = tid >> 3, kc = tid & 7, cgp = kc >> 1, a = kc & 1;
      bf16_t* dst = Vs + d * 72 + cgp * 16 + 4 * a;
      *(u32x2*)dst = (u32x2){rv[0], rv[1]}; *(u32x2*)(dst + 8) = (u32x2){rv[2], rv[3]};
    }
    if constexpr (MODE == M_FOX) { if (tid < 64) ((float*)(Vs + C::V_ELEMS))[tid] = rf; }
  };
  u64 tm = tmask;
  if (tm == 0) return;
  int j = __builtin_ctzll(tm); tm &= tm - 1;
  gload(j); sstore(0); __syncthreads();
  int buf = 0;
  const int tmin = __builtin_amdgcn_readfirstlane(tq - l31), tmax = tmin + 31;
  while (true) {
    const int jn = tm ? __builtin_ctzll(tm) : -1; if (tm) tm &= tm - 1;
    if (jn >= 0) gload(jn);
    bool active = (wmask >> j) & 1;
    if constexpr (MODE == M_SLC) active = active && __any((mysel >> j) & 1);
    if (active) {
      const bf16_t* Ks = smem + buf * C::STAGE; const bf16_t* Vs = Ks + C::K_ELEMS;
      f32x16 s0 = st.mr, s1 = st.mr;
      const bf16_t* kr = Ks + l31 * C::KLD + half * 8;
#pragma unroll
      for (int ks = 0; ks < C::DQK / 16; ++ks) {
        s0 = mfma32(*(const bf16x8*)(kr + ks * 16), qf[ks], s0);
        s1 = mfma32(*(const bf16x8*)(kr + 32 * C::KLD + ks * 16), qf[ks], s1);
      }
      const int k0 = j * 64;
      if constexpr (MODE == M_FOX) {
        const float* fb = (const float*)(Vs + C::V_ELEMS) + 4 * half;
#pragma unroll
        for (int g4 = 0; g4 < 4; ++g4) {
          const f32x4 b0 = *(const f32x4*)(fb + 8 * g4), b1 = *(const f32x4*)(fb + 32 + 8 * g4);
#pragma unroll
          for (int r = 0; r < 4; ++r) { s0[4 * g4 + r] += b0[r]; s1[4 * g4 + r] += b1[r]; }
        }
      }
      bool need = k0 + 63 > tmin;
      if constexpr (MODE == M_WIN) need = need || (k0 <= tmax - 512);
      if constexpr (MODE == M_SLC) {
        if (!need) {
          const bool rsel = ((mysel >> j) & 1) != 0;
          if (!__all(rsel)) {
#pragma unroll
            for (int r = 0; r < 16; ++r) { s0[r] = rsel ? s0[r] : -INFINITY; s1[r] = rsel ? s1[r] : -INFINITY; }
          }
        }
      }
      if (need) {
        const bool rowok = MODE == M_SLC ? ((mysel >> j) & 1) != 0 : true;
#pragma unroll
        for (int r = 0; r < 16; ++r) {
          const int key = k0 + (r & 3) + 8 * (r >> 2) + 4 * half;
          bool ok0 = rowok && key <= tq, ok1 = rowok && key + 32 <= tq;
          if constexpr (MODE == M_WIN) { ok0 = ok0 && (tq - key < 512); ok1 = ok1 && (tq - key - 32 < 512); }
          s0[r] = ok0 ? s0[r] : -INFINITY; s1[r] = ok1 ? s1[r] : -INFINITY;
        }
      }
      int im = (int)0x80000000;
#pragma unroll
      for (int r = 0; r < 16; ++r) im = max(im, max(__float_as_int(s0[r]), __float_as_int(s1[r])));
      im = max(im, __shfl_xor(im, 32));
      constexpr int TBITS = 0x41200000;
      if (__any(im > TBITS)) {
        const float d = im > TBITS ? __int_as_float(im) : 0.f;
        const float a = ex2(-d);
#pragma unroll
        for (int r = 0; r < 16; ++r) { s0[r] -= d; s1[r] -= d; st.o[0][r] *= a; st.o[1][r] *= a; }
        st.l *= a; st.m += d;
#pragma unroll
        for (int r = 0; r < 16; ++r) st.mr[r] = -st.m;
      }
      float sum = 0.f;
#pragma unroll
      for (int r = 0; r < 16; ++r) { s0[r] = ex2(s0[r]); s1[r] = ex2(s1[r]); sum += s0[r] + s1[r]; }
      st.l += sum;
      const bf16_t* vr = Vs + l31 * 72 + half * 8;
#pragma unroll
      for (int c = 0; c < 4; ++c) {
        u32x4 pw;
        if (c < 2) pw = (u32x4){pk2(s0[8 * c + 0], s0[8 * c + 1]), pk2(s0[8 * c + 2], s0[8 * c + 3]), pk2(s0[8 * c + 4], s0[8 * c + 5]), pk2(s0[8 * c + 6], s0[8 * c + 7])};
        else pw = (u32x4){pk2(s1[8 * (c - 2) + 0], s1[8 * (c - 2) + 1]), pk2(s1[8 * (c - 2) + 2], s1[8 * (c - 2) + 3]), pk2(s1[8 * (c - 2) + 4], s1[8 * (c - 2) + 5]), pk2(s1[8 * (c - 2) + 6], s1[8 * (c - 2) + 7])};
        const bf16x8 pf = __builtin_bit_cast(bf16x8, pw);
        st.o[0] = mfma32(*(const bf16x8*)(vr + c * 16), pf, st.o[0]);
        st.o[1] = mfma32(*(const bf16x8*)(vr + 32 * 72 + c * 16), pf, st.o[1]);
      }
    }
    if (jn >= 0) sstore(buf ^ 1);
    __syncthreads();
    if (jn < 0) break;
    j = jn; buf ^= 1;
  }
}
DI void astate_init(AState& s) {
#pragma unroll
  for (int r = 0; r < 16; ++r) { s.o[0][r] = 0.f; s.o[1][r] = 0.f; }
#pragma unroll
  for (int r = 0; r < 16; ++r) s.mr[r] = 0.f;
  s.m = 0.f; s.l = 0.f;
}
DI u64 lowbits(int n) { return n >= 64 ? ~0ull : ((1ull << n) - 1ull); }

template <int MODE> DI void dense_attn_item(const Params& p, int b, int h, int qt, bf16_t* smem) {
  const int lane = TIDX() & 63, wid = TIDX() >> 6, l31 = lane & 31, half = lane >> 5;
  const int t0 = qt * 256, tq = t0 + wid * 32 + l31; const size_t trow = (size_t)b * S_ + tq;
  constexpr int NQ = ACfg<MODE>::DQK / 16;
  bf16x8 qf[NQ];
  const bf16_t* qp = MODE == M_FOX ? (const bf16_t*)(p.ws + O_FOXQ) + trow * 512 + h * 64 : (const bf16_t*)(p.ws + O_MLAQ) + trow * 768 + h * 96;
#pragma unroll
  for (int ks = 0; ks < NQ; ++ks) qf[ks] = *(const bf16x8*)(qp + ks * 16 + half * 8);
  AState st; astate_init(st);
  const u64 tmask = lowbits(4 * qt + 4), wmask = lowbits(((t0 + wid * 32 + 31) >> 6) + 1);
  if constexpr (MODE == M_FOX)
    flash_pass<M_FOX>(st, qf, tmask, wmask, (const bf16_t*)(p.ws + O_FOXK) + (size_t)b * S_ * 512 + h * 64, 512, nullptr,
                      (const bf16_t*)(p.ws + O_FOXVT) + (size_t)(b * 8 + h) * 64 * S_, (const float*)(p.ws + O_F2) + (size_t)(b * 8 + h) * S_, tq, 0ull, smem);
  else
    flash_pass<M_MLA>(st, qf, tmask, wmask, (const bf16_t*)(p.ws + O_MLAKN) + (size_t)b * S_ * 512 + h * 64, 512, (const bf16_t*)(p.ws + O_MLAKPE) + (size_t)b * S_ * 32,
                      (const bf16_t*)(p.ws + O_MLAVT) + (size_t)(b * 8 + h) * 64 * S_, nullptr, tq, 0ull, smem);
  const float l = st.l + __shfl_xor(st.l, 32), inv = 1.f / fmaxf(l, 1e-30f);
  bf16_t* op = (bf16_t*)qp;
#pragma unroll
  for (int dt = 0; dt < 2; ++dt)
#pragma unroll
    for (int g4 = 0; g4 < 4; ++g4) {
      const int d = dt * 32 + g4 * 8 + half * 4;
      *(u32x2*)(op + d) = (u32x2){pk2(st.o[dt][4 * g4] * inv, st.o[dt][4 * g4 + 1] * inv), pk2(st.o[dt][4 * g4 + 2] * inv, st.o[dt][4 * g4 + 3] * inv)};
    }
}
DI void nsa_attn_item(const Params& p, int b, int g, int qt, bf16_t* smem) {
  const int lane = TIDX() & 63, wid = TIDX() >> 6, l31 = lane & 31, half = lane >> 5;
  const int t0 = qt * 64, tw0 = t0 + (wid >> 2) * 32, tq = tw0 + l31, head = g * 4 + (wid & 3); const size_t trow = (size_t)b * S_ + tq;
  bf16x8 qf[4];
  const bf16_t* qp = (const bf16_t*)(p.ws + O_NSAQ) + trow * 512 + head * 64;
#pragma unroll
  for (int ks = 0; ks < 4; ++ks) qf[ks] = *(const bf16x8*)(qp + ks * 16 + half * 8);
  {
    const float* rp = (const float*)(p.ws + O_ROPE8) + trow * 16;
    u32x4 me = __builtin_bit_cast(u32x4, qf[0]), ot;
#pragma unroll
    for (int e = 0; e < 4; ++e) ot[e] = __shfl_xor(me[e], 32);
    unsigned res[4];
#pragma unroll
    for (int e = 0; e < 4; ++e) {
      float o2[2];
#pragma unroll
      for (int u = 0; u < 2; ++u) {
        const int f = 2 * e + u; const float cs = rp[2 * f], sn = rp[2 * f + 1];
        const float a = bf2f((bf16_t)(u ? me[e] >> 16 : me[e] & 0xffffu)), o = bf2f((bf16_t)(u ? ot[e] >> 16 : ot[e] & 0xffffu));
        o2[u] = half == 0 ? a * cs - o * sn : a * cs + o * sn;
      }
      res[e] = pk2(o2[0], o2[1]);
    }
    qf[0] = __builtin_bit_cast(bf16x8, (u32x4){res[0], res[1], res[2], res[3]});
  }
  const float* gts = (const float*)(p.ws + O_GATES) + trow * 24 + head * 3;
  const int cur = t0 >> 6;
  f32x16 res[2];
  {
    AState st; astate_init(st);
    const int first = t0 >= 511 ? (t0 - 511) >> 6 : 0, firstw = tw0 >= 511 ? (tw0 - 511) >> 6 : 0;
    const u64 tmask = lowbits(cur + 1) & ~lowbits(first), wmask = lowbits(cur + 1) & ~lowbits(firstw);
    flash_pass<M_WIN>(st, qf, tmask, wmask, (const bf16_t*)(p.ws + O_KWIN) + (size_t)b * S_ * 128 + g * 64, 128, nullptr,
                      (const bf16_t*)(p.ws + O_VWINT) + (size_t)(b * 2 + g) * 64 * S_, nullptr, tq, 0ull, smem);
    const float l = st.l + __shfl_xor(st.l, 32), sc = gts[2] / fmaxf(l, 1e-30f);
#pragma unroll
    for (int r = 0; r < 16; ++r) { res[0][r] = st.o[0][r] * sc; res[1][r] = st.o[1][r] * sc; }
  }
  {
    AState st; astate_init(st);
    const u64* selp = (const u64*)(p.ws + O_SEL) + (size_t)(b * 2 + g) * S_;
    const u64 mysel = selp[tq];
    const u64 m64 = selp[t0 + lane];
    unsigned lo = (unsigned)m64, hi = (unsigned)(m64 >> 32);
#pragma unroll
    for (int o = 32; o >= 1; o >>= 1) { lo |= __shfl_xor(lo, o); hi |= __shfl_xor(hi, o); }
    const u64 um = (((u64)(unsigned)__builtin_amdgcn_readfirstlane(hi) << 32) | (u64)(unsigned)__builtin_amdgcn_readfirstlane(lo)) & lowbits(cur + 1);
    flash_pass<M_SLC>(st, qf, um, um, (const bf16_t*)(p.ws + O_KSLC) + (size_t)b * S_ * 128 + g * 64, 128, nullptr,
                      (const bf16_t*)(p.ws + O_VSLCT) + (size_t)(b * 2 + g) * 64 * S_, nullptr, tq, mysel, smem);
    const float l = st.l + __shfl_xor(st.l, 32), sc = gts[1] / fmaxf(l, 1e-30f);
#pragma unroll
    for (int r = 0; r < 16; ++r) { res[0][r] += st.o[0][r] * sc; res[1][r] += st.o[1][r] * sc; }
  }
  bf16_t* op = (bf16_t*)(p.ws + O_ONSA) + trow * 512 + head * 64;
#pragma unroll
  for (int dt = 0; dt < 2; ++dt)
#pragma unroll
    for (int g4 = 0; g4 < 4; ++g4) {
      const int d = dt * 32 + g4 * 8 + half * 4;
      const u32x2 oc = *(const u32x2*)(op + d);
      const float c0 = bf2f((bf16_t)(oc[0] & 0xffffu)), c1 = bf2f((bf16_t)(oc[0] >> 16)), c2 = bf2f((bf16_t)(oc[1] & 0xffffu)), c3 = bf2f((bf16_t)(oc[1] >> 16));
      *(u32x2*)(op + d) = (u32x2){pk2(res[dt][4 * g4] + c0, res[dt][4 * g4 + 1] + c1), pk2(res[dt][4 * g4 + 2] + c2, res[dt][4 * g4 + 3] + c3)};
    }
}
constexpr int PD_ITEMS = 16 * 192;
DI void phase_d(const Params& p, unsigned char* smem) {
  for (int it = blockIdx.x; it < PD_ITEMS; it += gridDim.x) {
    const int r = it / 192, w = it % 192, qt = 15 - r;
    if (w < 64) dense_attn_item<M_MLA>(p, w >> 3, w & 7, qt, (bf16_t*)smem);
    else if (w < 128) dense_attn_item<M_FOX>(p, (w - 64) >> 3, (w - 64) & 7, qt, (bf16_t*)smem);
    else { const int i = w - 128, bg = i & 15, q4 = i >> 4; nsa_attn_item(p, bg >> 1, bg & 1, qt * 4 + q4, (bf16_t*)smem); }
  }
}

DI void merge_tile(const Params& p, int layer, int tm, int tn, bf16_t* smem) {
  const bf16_t* wl = (const bf16_t*)(p.ws + O_W) + (size_t)layer * W_LAYER;
  const int lane = TIDX() & 63, wid = TIDX() >> 6, wm = wid >> 2, wn = wid & 3, l15 = lane & 15, quad = lane >> 4;
  f32x4 mg[4][2]; zero_acc<4, 2>(mg);
  unsigned* gsp = (unsigned*)((unsigned char*)smem + 2 * GemmLds<4, 2>::STAGE * 2) + TIDX();
#pragma unroll 1
  for (int br = 0; br < 3; ++br) {
    {
      f32x4 ga[4][2]; zero_acc<4, 2>(ga);
      RowPtr ap{(const bf16_t*)(p.ws + O_XG) + (size_t)tm * 128 * D_, (size_t)D_}, bp{wl + W_G + ((size_t)br * 1024 + tn * 128) * D_, (size_t)D_};
      gemm_main<4, 2, true>(ga, ap, 64, bp, 64, 16, smem);
#pragma unroll
      for (int i = 0; i < 4; ++i) {
        const float rs = rstd_from16((const float*)(p.ws + O_SSQ) + (size_t)(tm * 128 + wm * 64 + i * 16 + l15) * 16, 1.f / 1024.f);
#pragma unroll
        for (int j = 0; j < 2; ++j) {
          gsp[((i * 2 + j) * 2 + 0) * NTHR] = pk2(sigmoidf_(ga[i][j][0] * rs), sigmoidf_(ga[i][j][1] * rs));
          gsp[((i * 2 + j) * 2 + 1) * NTHR] = pk2(sigmoidf_(ga[i][j][2] * rs), sigmoidf_(ga[i][j][3] * rs));
        }
      }
    }
    f32x4 ba[4][2]; zero_acc<4, 2>(ba);
    RowPtr bp2{wl + (br == 0 ? W_BN : br == 1 ? W_BF : W_BM) + (size_t)tn * 128 * 512, (size_t)512};
    const bf16_t* abase = (const bf16_t*)(p.ws + (br == 0 ? O_ONSA : br == 1 ? O_FOXQ : O_MLAQ));
    const int ald = br == 2 ? 768 : 512;
    RowPtr ap2{abase + (size_t)tm * 128 * ald, (size_t)ald};
    gemm_main<4, 2, true>(ba, ap2, br == 2 ? 96 : 64, bp2, 64, 8, smem);
#pragma unroll
    for (int i = 0; i < 4; ++i)
#pragma unroll
      for (int j = 0; j < 2; ++j) {
        const unsigned w0 = gsp[((i * 2 + j) * 2 + 0) * NTHR], w1 = gsp[((i * 2 + j) * 2 + 1) * NTHR];
        mg[i][j][0] += bf2f((bf16_t)(w0 & 0xffffu)) * ba[i][j][0];
        mg[i][j][1] += bf2f((bf16_t)(w0 >> 16)) * ba[i][j][1];
        mg[i][j][2] += bf2f((bf16_t)(w1 & 0xffffu)) * ba[i][j][2];
        mg[i][j][3] += bf2f((bf16_t)(w1 >> 16)) * ba[i][j][3];
      }
  }
  bf16_t* stg = (bf16_t*)((unsigned char*)smem + 106496 + wid * 5120);
#pragma unroll
  for (int i = 0; i < 4; ++i)
#pragma unroll
    for (int j = 0; j < 2; ++j) *(u32x2*)(stg + (i * 16 + l15) * 40 + j * 16 + quad * 4) = (u32x2){pk2(mg[i][j][0], mg[i][j][1]), pk2(mg[i][j][2], mg[i][j][3])};
  stage_out<64, 32, 40>(stg, (bf16_t*)(p.ws + O_MERGED) + (size_t)(tm * 128 + wm * 64) * D_ + tn * 128 + wn * 32, (size_t)D_, lane);
}
DI void phase_e(const Params& p, int layer, unsigned char* smem) {
  xcd_tiles(32, 8, [&](int tm, int tn) { merge_tile(p, layer, tm, tn, (bf16_t*)smem); });
}

DI void resid_tile(const Params& p, const bf16_t* A, int K, const bf16_t* W, const float* xold, const float* gnext, int tm, int tn, bf16_t* smem) {
  f32x4 acc[8][4]; zero_acc<8, 4>(acc);
  RowPtr ap{A + (size_t)tm * 256 * K, (size_t)K}, bp{W + (size_t)tn * 256 * K, (size_t)K};
  gemm_main<8, 4, true>(acc, ap, 64, bp, 64, K / 64, smem);
  const int lane = TIDX() & 63, wid = TIDX() >> 6, wm = wid >> 2, wn = wid & 3, l15 = lane & 15, quad = lane >> 4;
  bf16_t* stg = smem + wid * STG_WAVE;
#pragma unroll
  for (int i = 0; i < 8; ++i) {
    const int t = tm * 256 + wm * 128 + i * 16 + l15, c0 = tn * 256 + wn * 64 + quad * 4; float s = 0.f;
#pragma unroll
    for (int j = 0; j < 4; ++j) {
      const size_t off = (size_t)t * D_ + c0 + j * 16;
      const f32x4 xn = *(const f32x4*)(xold + off) + acc[i][j];
      *(f32x4*)(p.out + off) = xn;
      s += xn[0] * xn[0] + xn[1] * xn[1] + xn[2] * xn[2] + xn[3] * xn[3];
      if (gnext) { const f32x4 gv = *(const f32x4*)(gnext + c0 + j * 16); *(u32x2*)(stg + (i * 16 + l15) * STG_LD + j * 16 + quad * 4) = (u32x2){pk2(xn[0] * gv[0], xn[1] * gv[1]), pk2(xn[2] * gv[2], xn[3] * gv[3])}; }
    }
    s += __shfl_xor(s, 16); s += __shfl_xor(s, 32);
    if (quad == 0) ((float*)(p.ws + O_SSQ))[(size_t)t * 16 + tn * 4 + wn] = s;
  }
  if (gnext) stage_out<128, 64, STG_LD>(stg, (bf16_t*)(p.ws + O_XG) + (size_t)(tm * 256 + wm * 128) * D_ + tn * 256 + wn * 64, (size_t)D_, lane);
  __syncthreads();
}
DI void phase_f(const Params& p, int layer, unsigned char* smem) {
  const bf16_t* wl = (const bf16_t*)(p.ws + O_W) + (size_t)layer * W_LAYER;
  xcd_tiles(16, 4, [&](int tm, int tn) { resid_tile(p, (const bf16_t*)(p.ws + O_MERGED), 1024, wl + W_OUT, layer == 0 ? p.x : p.out, p.ffn_norm + layer * D_, tm, tn, (bf16_t*)smem); });
}
DI void phase_h(const Params& p, int layer, unsigned char* smem) {
  const bf16_t* wl = (const bf16_t*)(p.ws + O_W) + (size_t)layer * W_LAYER;
  xcd_tiles(16, 4, [&](int tm, int tn) { resid_tile(p, (const bf16_t*)(p.ws + O_ACT), DFF_, wl + W_DN, p.out, layer == 0 ? p.mix_norm + D_ : nullptr, tm, tn, (bf16_t*)smem); });
}

struct UpRowPtr { const bf16_t* base; int s0;
  DI unsigned operator()(int r) const { const int s = s0 + r; return (unsigned)((s < 0 || s >= S_) ? 0 : s) * (unsigned)D_; }
  DI bool ok(int r) const { const int s = s0 + r; return s >= 0 && s < S_; } };
constexpr int PG_MT = 17;
DI void ffnup_tile(const Params& p, int layer, int b, int mt, int tn, bf16_t* smem) {
  const bf16_t* wl = (const bf16_t*)(p.ws + O_W) + (size_t)layer * W_LAYER;
  f32x4 acc[8][4]; zero_acc<8, 4>(acc);
  const int s0 = 254 * mt - 2;
  UpRowPtr ap{(const bf16_t*)(p.ws + O_XG) + (size_t)b * S_ * D_, s0}; RowPtr bp{wl + W_UP + (size_t)tn * 256 * D_, (size_t)D_};
  gemm_main<8, 4, true>(acc, ap, 64, bp, 64, 16, smem);
  const int tid = TIDX(), lane = tid & 63, wid = tid >> 6, wm = wid >> 2, wn = wid & 3, l15 = lane & 15, quad = lane >> 4;
  constexpr int LDU = 136; bf16_t* U = smem; bf16_t* V = smem + 256 * LDU;
  {
    bf16_t* dstb = (wn < 2 ? U : V) + (wn & 1) * 64 + quad * 4;
#pragma unroll
    for (int i = 0; i < 8; ++i) {
      const int row = wm * 128 + i * 16 + l15, s = s0 + row;
      const float rs = (s >= 0 && s < S_) ? rstd_from16((const float*)(p.ws + O_SSQ) + ((size_t)b * S_ + s) * 16, 1.f / 1024.f) : 0.f;
#pragma unroll
      for (int j = 0; j < 4; ++j) store4(dstb + row * LDU + j * 16, acc[i][j], rs);
    }
  }
  __syncthreads();
  {
    const int cc = tid & 15, cg0 = tn * 128 + cc * 8;
    const float* cw = p.conv_w + (size_t)layer * 3 * DFF_ + cg0; const float* cbp = p.conv_b + (size_t)layer * DFF_ + cg0;
    float w0[8], w1[8], w2[8], cb[8];
#pragma unroll
    for (int e = 0; e < 8; ++e) { w0[e] = cw[e]; w1[e] = cw[DFF_ + e]; w2[e] = cw[2 * DFF_ + e]; cb[e] = cbp[e]; }
    bf16_t* act = (bf16_t*)(p.ws + O_ACT);
#pragma unroll 2
    for (int it = 0; it < 8; ++it) {
      const int row = it * 32 + (tid >> 4), s = s0 + row;
      if (row >= 2 && s < S_) {
        const u32x4 u0 = *(const u32x4*)(U + (row - 2) * LDU + cc * 8), u1 = *(const u32x4*)(U + (row - 1) * LDU + cc * 8), u2 = *(const u32x4*)(U + row * LDU + cc * 8), vv = *(const u32x4*)(V + row * LDU + cc * 8);
        unsigned o[4];
#pragma unroll
        for (int e = 0; e < 4; ++e) {
          float r2[2];
#pragma unroll
          for (int h = 0; h < 2; ++h) {
            const int k = 2 * e + h;
            const float a0 = bf2f((bf16_t)(h ? u0[e] >> 16 : u0[e] & 0xffffu)), a1 = bf2f((bf16_t)(h ? u1[e] >> 16 : u1[e] & 0xffffu)), a2 = bf2f((bf16_t)(h ? u2[e] >> 16 : u2[e] & 0xffffu)), vx = bf2f((bf16_t)(h ? vv[e] >> 16 : vv[e] & 0xffffu));
            const float uc = w0[k] * a0 + w1[k] * a1 + w2[k] * a2 + cb[k];
            r2[h] = uc * sigmoidf_(uc) * vx;
          }
          o[e] = pk2(r2[0], r2[1]);
        }
        __builtin_nontemporal_store((u32x4){o[0], o[1], o[2], o[3]}, (u32x4*)(act + ((size_t)b * S_ + s) * DFF_ + cg0));
      }
    }
  }
  __syncthreads();
}
DI void phase_g(const Params& p, int layer, unsigned char* smem) {
  xcd_tiles(PG_MT, 22, [&](int tmg, int tn) { ffnup_tile(p, layer, tmg / PG_MT, tmg % PG_MT, tn, (bf16_t*)smem); });
}

DI void phase_final(const Params& p) {
  const int lane = TIDX() & 63, wid = TIDX() >> 6;
  for (int it = blockIdx.x; it < T_ / 8; it += gridDim.x) {
    const int t = it * 8 + wid; const float rs = rstd_from16((const float*)(p.ws + O_SSQ) + (size_t)t * 16, 1.f / 1024.f);
    float* xr = p.out + (size_t)t * D_;
#pragma unroll
    for (int c = 0; c < 4; ++c) { const int k = c * 256 + lane * 4; const f32x4 v = *(const f32x4*)(xr + k), gv = *(const f32x4*)(p.final_norm + k); *(f32x4*)(xr + k) = v * rs * gv; }
  }
}

#define XB_TMO      128
#define XB_XCNT(j)  (256  + 64 * (j))
#define XB_XSUB(j)  (1280 + 64 * (j))
#define XB_XGEN(j)  (2304 + 64 * (j))
#define XB_TOP      3328
#define XB_TOPGEN   3392
#define XCD_BAR_WORDS 3456
#define XB_SPIN_CAP (1u << 22)
#define LAS __attribute__((address_space(3)))
DI unsigned xb_ld(unsigned* p)              { return __hip_atomic_load(p, __ATOMIC_RELAXED, __HIP_MEMORY_SCOPE_AGENT); }
DI unsigned xb_add(unsigned* p, unsigned v) { return __hip_atomic_fetch_add(p, v, __ATOMIC_RELAXED, __HIP_MEMORY_SCOPE_AGENT); }
DI unsigned xb_xcc_id() { return (unsigned)__builtin_amdgcn_s_getreg((3 << 11) | 20) & 0xFu; }
#define XB_SPIN(cond, bar) do { unsigned _sp = 0; while (cond) { __builtin_amdgcn_s_sleep(1); \
    if ((++_sp & 255u) == 0u) { if (xb_ld(&(bar)[XB_TMO])) break; if (_sp > XB_SPIN_CAP) { atomicAdd(&(bar)[XB_TMO], 1u); break; } } } } while (0)
struct XcdBarrier { unsigned* bar; unsigned x; volatile LAS unsigned* st; };
DI XcdBarrier xcd_barrier_post(unsigned* bar, volatile LAS unsigned* st) {
  XcdBarrier b; b.bar = bar; b.x = xb_xcc_id(); b.st = st;
  if (threadIdx.x == 0) (void)xb_add(&bar[XB_XCNT(b.x)], 1u);
  return b;
}
DI void xcd_barrier_complete(unsigned* bar, unsigned x, unsigned& nloc, unsigned& nx) {
  const unsigned G = gridDim.x * gridDim.y * gridDim.z;
  unsigned sum, cnt, mine, sp = 0u;
  for (;;) {
    sum = 0u; cnt = 0u; mine = 0u;
#pragma unroll
    for (unsigned j = 0; j < 16; ++j) { const unsigned c = xb_ld(&bar[XB_XCNT(j)]); sum += c; cnt += (c > 0u) ? 1u : 0u; mine = (j == x) ? c : mine; }
    if (sum == G) break;
    __builtin_amdgcn_s_sleep(1);
    if ((++sp & 255u) == 0u) { if (xb_ld(&bar[XB_TMO])) break; if (sp > XB_SPIN_CAP) { atomicAdd(&bar[XB_TMO], 1u); break; } }
  }
  nloc = mine > 0u ? mine : 1u; nx = cnt > 0u ? cnt : 1u;
}
DI void xcd_barrier(const XcdBarrier& b) {
  asm volatile("s_waitcnt vmcnt(0)" ::: "memory");
  __syncthreads();
  if (threadIdx.x == 0) {
    unsigned* bar = b.bar;
    __builtin_amdgcn_s_waitcnt(0);
    unsigned nloc = b.st[0], nx = b.st[1];
    if (nloc == 0u) { xcd_barrier_complete(bar, b.x, nloc, nx); b.st[0] = nloc; b.st[1] = nx; }
    const unsigned old = xb_add(&bar[XB_XSUB(b.x)], 1u);
    const unsigned gen = old / nloc;
    if (old + 1u == (gen + 1u) * nloc) {
      __builtin_amdgcn_fence(__ATOMIC_RELEASE, "agent");
      asm volatile("s_waitcnt vmcnt(0)" ::: "memory");
      const unsigned og = xb_add(&bar[XB_TOP], 1u);
      const unsigned tg = og / nx;
      if (og + 1u == (tg + 1u) * nx) xb_add(&bar[XB_TOPGEN], 1u);
      else XB_SPIN(xb_ld(&bar[XB_TOPGEN]) == tg, bar);
      __builtin_amdgcn_fence(__ATOMIC_ACQUIRE, "agent");
      xb_add(&bar[XB_XGEN(b.x)], 1u);
      asm volatile("s_waitcnt vmcnt(0)" ::: "memory");
    } else {
      XB_SPIN(xb_ld(&bar[XB_XGEN(b.x)]) == gen, bar);
      __builtin_amdgcn_fence(__ATOMIC_ACQUIRE, "agent");
      asm volatile("s_waitcnt vmcnt(0)" ::: "memory");
    }
  }
  __syncthreads();
}
DI void run_phase(const Params& p, int ph, unsigned char* smem) {
  if (ph == 0) { phase_prep(p, smem); return; }
  if (ph == 17) { phase_final(p); return; }
  const int layer = (ph - 1) >> 3, s = (ph - 1) & 7;
#ifdef PROBE_DUP
  if ((PROBE_DUP >> s) & 1) {
    switch (s) { case 0: phase_inproj(p, layer, smem); break; case 1: phase_b(p, layer, smem); break; case 2: phase_c(p, smem); break; case 4: phase_e(p, layer, smem); break; case 6: phase_g(p, layer, smem); break; default: break; }
    __syncthreads();
  }
#endif
  switch (s) {
    case 0: phase_inproj(p, layer, smem); break;
    case 1: phase_b(p, layer, smem); break;
    case 2: phase_c(p, smem); break;
    case 3: phase_d(p, smem); break;
    case 4: phase_e(p, layer, smem); break;
    case 5: phase_f(p, layer, smem); break;
    case 6: phase_g(p, layer, smem); break;
    default: phase_h(p, layer, smem); break;
  }
}
constexpr int N_PHASES = 18;

#if ONE_LAUNCH
template <int PH> DI void run_all(const Params& p, unsigned char* smem, cg::grid_group& grid, const XcdBarrier& xb) {
  run_phase(p, PH, smem);
  if constexpr (PH + 1 < N_PHASES) {
    if constexpr (PH == 0) grid.sync(); else xcd_barrier(xb);
    run_all<PH + 1>(p, smem, grid, xb);
  }
}
__global__ void __launch_bounds__(NTHR, 2) mega_kernel(Params p) {
  __shared__ __attribute__((aligned(16))) unsigned char smem[SMEM_BYTES];
  __shared__ uint4 xb_words;
  if (threadIdx.x == 0) xb_words = make_uint4(0u, 0u, 0u, 0u);
  __syncthreads();
  const XcdBarrier xb = xcd_barrier_post((unsigned*)(p.ws + O_BAR), (volatile LAS unsigned*)&xb_words);
  cg::grid_group grid = cg::this_grid();
  run_all<0>(p, smem, grid, xb);
}
#else
template <int PH> __global__ void __launch_bounds__(NTHR, 2) phase_kernel(Params p) {
  __shared__ __attribute__((aligned(16))) unsigned char smem[SMEM_BYTES];
  run_phase(p, PH, smem);
}
template <int PH> static void launch_phases(const Params& p, hipStream_t stream) {
  hipLaunchKernelGGL((phase_kernel<PH>), dim3(256), dim3(NTHR), 0, stream, p);
  if constexpr (PH + 1 < N_PHASES) launch_phases<PH + 1>(p, stream);
}
#endif

extern "C" void kernel_launch(void* const* d_in, const int* in_sizes, int n_in, void* d_out, int out_size, void* d_ws, size_t ws_size, hipStream_t stream) {
  if (ws_size < O_END || n_in < 25) { fprintf(stderr, "workspace too small: %zu < %zu\n", ws_size, (size_t)O_END); return; }
  Params p{};
  p.x = (const float*)d_in[0]; p.pos = (const int*)d_in[1]; p.mix_norm = (const float*)d_in[2]; p.w_in = (const float*)d_in[3]; p.b_forget = (const float*)d_in[4];
  p.pe_k = (const float*)d_in[5]; p.w1_k = (const float*)d_in[6]; p.w2_k = (const float*)d_in[7]; p.pe_v = (const float*)d_in[8]; p.w1_v = (const float*)d_in[9]; p.w2_v = (const float*)d_in[10];
  p.q_norm = (const float*)d_in[11]; p.w_uq = (const float*)d_in[12]; p.kv_norm = (const float*)d_in[13]; p.w_ukv = (const float*)d_in[14];
  p.wbr_nsa = (const float*)d_in[15]; p.wbr_fox = (const float*)d_in[16]; p.wbr_mla = (const float*)d_in[17]; p.w_out = (const float*)d_in[18];
  p.ffn_norm = (const float*)d_in[19]; p.w_up = (const float*)d_in[20]; p.conv_w = (const float*)d_in[21]; p.conv_b = (const float*)d_in[22]; p.w_down = (const float*)d_in[23]; p.final_norm = (const float*)d_in[24];
  p.out = (float*)d_out; p.ws = (unsigned char*)d_ws;
#if ONE_LAUNCH
  static int grid_blocks = 0;
  if (!grid_blocks) {
    int dev = 0, cus = 0, per_cu = 0;
    hipGetDevice(&dev); hipDeviceGetAttribute(&cus, hipDeviceAttributeMultiprocessorCount, dev);
    hipOccupancyMaxActiveBlocksPerMultiprocessor(&per_cu, mega_kernel, NTHR, 0);
    if (per_cu > 1) per_cu = 1;
    grid_blocks = cus * per_cu;
  }
  hipMemsetAsync(p.ws + O_BAR, 0, XCD_BAR_WORDS * 4, stream);
  void* args[] = {&p};
  hipError_t e = hipLaunchCooperativeKernel((void*)mega_kernel, dim3(grid_blocks), dim3(NTHR), args, 0, stream);
  if (e != hipSuccess) fprintf(stderr, "cooperative launch failed: %s (grid %d)\n", hipGetErrorString(e), grid_blocks);
#else
  launch_phases<0>(p, stream);
#endif
}
```

```cpp
#include <hip/hip_runtime.h>
#include <hip/hip_cooperative_groups.h>
#include <stdint.h>
#include <stdio.h>
#include <type_traits>
namespace cg = cooperative_groups;

#ifndef ONE_LAUNCH
#define ONE_LAUNCH 1

#endif

#define DI __device__ __forceinline__
typedef unsigned short bf16_t;
typedef short bf16x8 __attribute__((ext_vector_type(8)));
typedef float f32x4 __attribute__((ext_vector_type(4)));
typedef float f32x16 __attribute__((ext_vector_type(16)));
typedef float f32x2 __attribute__((ext_vector_type(2)));
typedef __bf16 bfx2 __attribute__((ext_vector_type(2)));
typedef unsigned u32x4 __attribute__((ext_vector_type(4)));
typedef unsigned u32x2 __attribute__((ext_vector_type(2)));
typedef unsigned long long u64;

constexpr int T_ = 32768, S_ = 4096, NB_ = 8, D_ = 1024, DFF_ = 2816, NIN_ = 6592;
constexpr float EPS_ = 1e-6f;
constexpr float LOG2E_ = 1.4426950408889634f;
constexpr float QS64_ = 0.125f * LOG2E_;
constexpr float QS96_ = 0.10206207261596577f * LOG2E_;

constexpr size_t W_IN = 0;
constexpr size_t W_G = W_IN + (size_t)3584 * 1024;
constexpr size_t W_1K = W_G + (size_t)3072 * 1024;
constexpr size_t W_1V = W_1K + (size_t)256 * 2048;
constexpr size_t W_2K = W_1V + (size_t)256 * 2048;
constexpr size_t W_2V = W_2K + (size_t)64 * 256;
constexpr size_t W_UQ = W_2V + (size_t)64 * 256;
constexpr size_t W_UKV = W_UQ + (size_t)768 * 384;
constexpr size_t W_BN = W_UKV + (size_t)1024 * 256;
constexpr size_t W_BF = W_BN + (size_t)1024 * 512;
constexpr size_t W_BM = W_BF + (size_t)1024 * 512;
constexpr size_t W_OUT = W_BM + (size_t)1024 * 512;
constexpr size_t W_UP = W_OUT + (size_t)1024 * 1024;
constexpr size_t W_DN = W_UP + (size_t)5632 * 1024;
constexpr size_t W_LAYER = W_DN + (size_t)1024 * 2816;

constexpr size_t al256(size_t x) { return (x + 255) & ~(size_t)255; }
constexpr size_t O_BAR = 0;
constexpr size_t O_W = 16384;
constexpr size_t O_BIAS1 = al256(O_W + 2 * W_LAYER * 2);
constexpr size_t O_ROPE8 = al256(O_BIAS1 + 2 * 2 * 16 * 256 * 4);
constexpr size_t O_ROPE16 = al256(O_ROPE8 + (size_t)T_ * 16 * 4);
constexpr size_t O_XG = al256(O_ROPE16 + (size_t)T_ * 32 * 4);
constexpr size_t O_SSQ = al256(O_XG + (size_t)T_ * 1024 * 2);
constexpr size_t O_CSSQ = al256(O_SSQ + (size_t)T_ * 16 * 4);
constexpr size_t O_NSAQ = al256(O_CSSQ + (size_t)T_ * 16 * 4);
constexpr size_t O_KVCMP = O_NSAQ + (size_t)T_ * 512 * 2;
constexpr size_t O_KSLC = O_KVCMP + (size_t)T_ * 256 * 2;
constexpr size_t O_KWIN = O_KSLC + (size_t)T_ * 128 * 2;
constexpr size_t O_MERGED = O_NSAQ;
constexpr size_t O_VSLCT = O_KWIN + (size_t)T_ * 128 * 2;
constexpr size_t O_VWINT = O_VSLCT + (size_t)T_ * 128 * 2;
constexpr size_t O_FOXQ = O_VWINT + (size_t)T_ * 128 * 2;
constexpr size_t O_FOXK = O_FOXQ + (size_t)T_ * 512 * 2;
constexpr size_t O_FOXVT = O_FOXK + (size_t)T_ * 512 * 2;
constexpr size_t O_MLAQ = O_FOXVT + (size_t)T_ * 512 * 2;
constexpr size_t O_MLAKN = O_MLAQ + (size_t)T_ * 768 * 2;
constexpr size_t O_ACT = O_FOXQ;
constexpr size_t O_MLAVT = O_MLAKN + (size_t)T_ * 512 * 2;
constexpr size_t O_MLAKPE = O_MLAVT + (size_t)T_ * 512 * 2;
constexpr size_t O_ONSA = O_MLAKPE + (size_t)T_ * 32 * 2;
constexpr size_t O_CQ = O_ONSA;
constexpr size_t O_CKV = O_CQ + (size_t)T_ * 384 * 2;
constexpr size_t O_CEND = O_CKV + (size_t)T_ * 256 * 2;
constexpr size_t O_GATES = al256(O_CEND > O_ONSA + (size_t)T_ * 512 * 2 ? O_CEND : O_ONSA + (size_t)T_ * 512 * 2);
constexpr size_t O_LOGF = al256(O_GATES + (size_t)T_ * 24 * 4);
constexpr size_t O_F2 = al256(O_LOGF + (size_t)T_ * 8 * 4);
constexpr size_t O_KC = al256(O_F2 + (size_t)T_ * 8 * 4);
constexpr size_t O_VCT = al256(O_KC + (size_t)NB_ * 2 * 256 * 64 * 2);
constexpr size_t O_SEL = al256(O_VCT + (size_t)NB_ * 2 * 256 * 64 * 2);
constexpr size_t O_END = al256(O_SEL + (size_t)NB_ * 2 * S_ * 8);

struct Params {
  const float* x; const int* pos; const float* mix_norm; const float* w_in; const float* b_forget;
  const float* pe_k; const float* w1_k; const float* w2_k; const float* pe_v; const float* w1_v; const float* w2_v;
  const float* q_norm; const float* w_uq; const float* kv_norm; const float* w_ukv;
  const float* wbr_nsa; const float* wbr_fox; const float* wbr_mla; const float* w_out;
  const float* ffn_norm; const float* w_up; const float* conv_w; const float* conv_b; const float* w_down; const float* final_norm;
  float* out; unsigned char* ws;
};

constexpr int NTHR = 512;
constexpr int SMEM_BYTES = 147456;

DI int TIDX() { int t = (int)threadIdx.x; asm volatile("" : "+v"(t)); return t; }
DI unsigned pk2(float lo, float hi) { f32x2 v = {lo, hi}; return __builtin_bit_cast(unsigned, __builtin_convertvector(v, bfx2)); }
DI bf16_t f2bf(float x) { return (bf16_t)(pk2(x, 0.f) & 0xffffu); }
DI float bf2f(bf16_t h) { return __uint_as_float(((unsigned)h) << 16); }
DI float sigmoidf_(float x) { return 1.f / (1.f + __expf(-x)); }
DI float gelu_tanh(float x) { const float u = 0.7978845608028654f * (x + 0.044715f * x * x * x); return x / (1.f + __expf(-2.f * u)); }
DI float ex2(float x) { return __builtin_amdgcn_exp2f(x); }
DI f32x16 mfma32(bf16x8 a, bf16x8 b, f32x16 c) { return __builtin_amdgcn_mfma_f32_32x32x16_bf16(a, b, c, 0, 0, 0); }
DI f32x4 mfma16(bf16x8 a, bf16x8 b, f32x4 c) { return __builtin_amdgcn_mfma_f32_16x16x32_bf16(a, b, c, 0, 0, 0); }
DI float rstd_from16(const float* p, float inv_n) {
  const f32x4 a = *(const f32x4*)p, b = *(const f32x4*)(p + 4), c = *(const f32x4*)(p + 8), d = *(const f32x4*)(p + 12);
  const float s = ((a[0] + a[1]) + (a[2] + a[3])) + ((b[0] + b[1]) + (b[2] + b[3])) + ((c[0] + c[1]) + (c[2] + c[3])) + ((d[0] + d[1]) + (d[2] + d[3]));
  return rsqrtf(s * inv_n + EPS_);
}

constexpr int LDT = 72;
template <int MI, int NJ> struct GemmLds { static constexpr int BM = 32 * MI, BN = 64 * NJ, A_ELEMS = BM * LDT, B_ELEMS = BN * LDT, STAGE = A_ELEMS + B_ELEMS; };

template <int MI, int NJ, bool SWAP, class AP, class BP>
DI void gemm_main(f32x4 (&acc)[MI][NJ], const AP& ap, int a_kstep, const BP& bp, int b_kstep, int nk, bf16_t* smem) {
  typedef GemmLds<MI, NJ> L;
  constexpr int CA = MI / 2, CB = NJ;
  const int tid = TIDX(), lane = tid & 63, wid = tid >> 6, wm = wid >> 2, wn = wid & 3, l15 = lane & 15, quad = lane >> 4;
  unsigned pa[CA], pb[CB]; bool oka[CA];
#pragma unroll
  for (int i = 0; i < CA; ++i) { const int c = tid + NTHR * i; pa[i] = ap(c >> 3) + (c & 7) * 8; oka[i] = ap.ok(c >> 3); }
#pragma unroll
  for (int i = 0; i < CB; ++i) { const int c = tid + NTHR * i; pb[i] = bp(c >> 3) + (c & 7) * 8; }
  u32x4 ra[CA], rb[CB];
  auto gload = [&](int kt) {
    const bf16_t* ab = ap.base + (size_t)kt * a_kstep; const bf16_t* bb = bp.base + (size_t)kt * b_kstep;
#pragma unroll
    for (int i = 0; i < CA; ++i) ra[i] = *(const u32x4*)(ab + pa[i]);
#pragma unroll
    for (int i = 0; i < CB; ++i) rb[i] = *(const u32x4*)(bb + pb[i]);
  };
  auto sstore = [&](int buf) {
    bf16_t* As = smem + buf * L::STAGE; bf16_t* Bs = As + L::A_ELEMS;
#pragma unroll
    for (int i = 0; i < CA; ++i) { const int c = tid + NTHR * i; *(u32x4*)(As + (c >> 3) * LDT + (c & 7) * 8) = oka[i] ? ra[i] : (u32x4){0u, 0u, 0u, 0u}; }
#pragma unroll
    for (int i = 0; i < CB; ++i) { const int c = tid + NTHR * i; *(u32x4*)(Bs + (c >> 3) * LDT + (c & 7) * 8) = rb[i]; }
  };
  gload(0); sstore(0); __syncthreads();
#pragma unroll 1
  for (int kt = 0; kt < nk; ++kt) {
    const int buf = kt & 1;
    gload(kt + 1 < nk ? kt + 1 : nk - 1);
    __builtin_amdgcn_sched_barrier(0);
    const bf16_t* As = smem + buf * L::STAGE + (wm * 16 * MI + l15) * LDT + quad * 8;
    const bf16_t* Bs = smem + buf * L::STAGE + L::A_ELEMS + (wn * 16 * NJ + l15) * LDT + quad * 8;
#pragma unroll
    for (int ks = 0; ks < 2; ++ks) {
      if (MI * NJ >= 32 && ks == 1) asm volatile("" ::: "memory");
      bf16x8 b[NJ];
#pragma unroll
      for (int j = 0; j < NJ; ++j) b[j] = *(const bf16x8*)(Bs + j * 16 * LDT + ks * 32);
#pragma unroll
      for (int i = 0; i < MI; ++i) {
        const bf16x8 a = *(const bf16x8*)(As + i * 16 * LDT + ks * 32);
#pragma unroll
        for (int j = 0; j < NJ; ++j) acc[i][j] = SWAP ? mfma16(b[j], a, acc[i][j]) : mfma16(a, b[j], acc[i][j]);
      }
    }
    sstore(buf ^ 1);
    __syncthreads();
  }
}
template <int MI, int NJ> DI void zero_acc(f32x4 (&acc)[MI][NJ]) {
#pragma unroll
  for (int i = 0; i < MI; ++i)
#pragma unroll
    for (int j = 0; j < NJ; ++j) acc[i][j] = (f32x4){0.f, 0.f, 0.f, 0.f};
}
struct RowPtr { const bf16_t* base; size_t ld; DI unsigned operator()(int r) const { return (unsigned)r * (unsigned)ld; } DI bool ok(int) const { return true; } };


template <class F> DI void xcd_tiles(int MPX, int NT, F&& body) {
  const int xcd = blockIdx.x & 7, slot = blockIdx.x >> 3, nslots = gridDim.x >> 3, total = MPX * NT;
  for (int li = slot; li < total; li += nslots) {
    const int mg = li / (8 * NT), rem = li - mg * 8 * NT;
    const int gsz = (MPX - mg * 8) < 8 ? (MPX - mg * 8) : 8;
    const int tn = rem / gsz, mi = rem - tn * gsz;
    body(xcd * MPX + mg * 8 + mi, tn);
  }
}

DI int map_col(int map, int n) {
  if (map == 0) return n;
  if (map == 1) {
    if (n < 896) return n;
    if (n < 1024) return 1024 + (n - 896);
    if (n < 1152) return 896 + (n - 1024);
    if (n < 1280) return n;
    if (n < 2816) return 1304 + (n - 1280);
    if (n < 3200) return 2848 + (n - 2816);
    if (n < 3456) return 3232 + (n - 3200);
    const int c = n - 3456;
    if (c < 24) return 1280 + c;
    if (c < 32) return 2840 + (c - 24);
    if (c < 64) return 3488 + (c - 32);
    return -1;
  }
  if (map == 2) { const int j = n >> 8, c = n & 255; return c < 128 ? j * 128 + c : DFF_ + j * 128 + (c - 128); }
  if (map == 3) { return n < 512 ? (n >> 6) * 128 + (n & 63) : ((n - 512) >> 6) * 128 + 64 + ((n - 512) & 63); }
  return n;
}
struct WJob { const float* src; const float* scale; bf16_t* dst; int K, N, ld, map, off; };
DI void prep_weight_tile(const WJob& j, int tile, float* lds) {
  const int ntn = j.N >> 6, tk = tile / ntn, tn = tile % ntn, tid = TIDX();
  const int n4 = (tid & 15) * 4; const int sc = map_col(j.map, tn * 64 + n4);
  f32x4 v[4];
#pragma unroll
  for (int i = 0; i < 4; ++i) {
    const int kk = (tid >> 4) + 32 * i, k = tk * 128 + kk;
    v[i] = sc >= 0 ? *(const f32x4*)(j.src + (size_t)k * j.ld + j.off + sc) : (f32x4){0.f, 0.f, 0.f, 0.f};
    if (j.scale) v[i] = v[i] * j.scale[k];
  }
#pragma unroll
  for (int i = 0; i < 4; ++i) {
    const int kk = (tid >> 4) + 32 * i;
#pragma unroll
    for (int e = 0; e < 4; ++e) lds[kk * 65 + n4 + e] = v[i][e];
  }
  __syncthreads();
  const int nn = tid >> 3, k0 = (tid & 7) * 16;
  unsigned w[8];
#pragma unroll
  for (int e = 0; e < 8; ++e) w[e] = pk2(lds[(k0 + 2 * e) * 65 + nn], lds[(k0 + 2 * e + 1) * 65 + nn]);
  bf16_t* d = j.dst + (size_t)(tn * 64 + nn) * j.K + tk * 128 + k0;
  *(u32x4*)d = (u32x4){w[0], w[1], w[2], w[3]}; *(u32x4*)(d + 8) = (u32x4){w[4], w[5], w[6], w[7]};
  __syncthreads();
}
DI WJob get_wjob(const Params& p, int layer, int id) {
  bf16_t* wl = (bf16_t*)(p.ws + O_W) + (size_t)layer * W_LAYER; WJob j; j.scale = nullptr; j.map = 0; j.off = 0;
  switch (id) {
    case 0: j.src = p.w_in + (size_t)layer * 1024 * NIN_; j.dst = wl + W_IN; j.K = 1024; j.N = 3584; j.ld = NIN_; j.map = 1; break;
    case 1: j.src = p.w_in + (size_t)layer * 1024 * NIN_; j.dst = wl + W_G; j.K = 1024; j.N = 3072; j.ld = NIN_; j.off = 3520; break;
    case 2: j.src = p.w1_k + (size_t)layer * 2048 * 256; j.dst = wl + W_1K; j.K = 2048; j.N = 256; j.ld = 256; break;
    case 3: j.src = p.w1_v + (size_t)layer * 2048 * 256; j.dst = wl + W_1V; j.K = 2048; j.N = 256; j.ld = 256; break;
    case 4: j.src = p.w2_k + (size_t)layer * 256 * 64; j.dst = wl + W_2K; j.K = 256; j.N = 64; j.ld = 64; break;
    case 5: j.src = p.w2_v + (size_t)layer * 256 * 64; j.dst = wl + W_2V; j.K = 256; j.N = 64; j.ld = 64; break;
    case 6: j.src = p.w_uq + (size_t)layer * 384 * 768; j.dst = wl + W_UQ; j.K = 384; j.N = 768; j.ld = 768; j.scale = p.q_norm + layer * 384; break;
    case 7: j.src = p.w_ukv + (size_t)layer * 256 * 1024; j.dst = wl + W_UKV; j.K = 256; j.N = 1024; j.ld = 1024; j.scale = p.kv_norm + layer * 256; j.map = 3; break;
    case 8: j.src = p.wbr_nsa + (size_t)layer * 512 * 1024; j.dst = wl + W_BN; j.K = 512; j.N = 1024; j.ld = 1024; break;
    case 9: j.src = p.wbr_fox + (size_t)layer * 512 * 1024; j.dst = wl + W_BF; j.K = 512; j.N = 1024; j.ld = 1024; break;
    case 10: j.src = p.wbr_mla + (size_t)layer * 512 * 1024; j.dst = wl + W_BM; j.K = 512; j.N = 1024; j.ld = 1024; break;
    case 11: j.src = p.w_out + (size_t)layer * 1024 * 1024; j.dst = wl + W_OUT; j.K = 1024; j.N = 1024; j.ld = 1024; break;
    case 12: j.src = p.w_up + (size_t)layer * 1024 * 5632; j.dst = wl + W_UP; j.K = 1024; j.N = 5632; j.ld = 5632; j.map = 2; break;
    default: j.src = p.w_down + (size_t)layer * 2816 * 1024; j.dst = wl + W_DN; j.K = 2816; j.N = 1024; j.ld = 1024; break;
  }
  return j;
}
constexpr int WTILES_LAYER = (int)(W_LAYER / 8192);
constexpr int P0_XITEMS = T_ / 64;
constexpr int P0_ROPE_ITEMS = T_ / NTHR;
constexpr int P0_ITEMS = 2 * WTILES_LAYER + 64 + P0_ROPE_ITEMS + P0_XITEMS;

DI void xg_rows(const float* x, const float* g, bf16_t* xg, float* ssq, int row0) {
  const int lane = TIDX() & 63, wid = TIDX() >> 6;
  for (int rr = 0; rr < 8; ++rr) {
    const int t = row0 + wid * 8 + rr; const float* xr = x + (size_t)t * D_; float s = 0.f;
#pragma unroll
    for (int c = 0; c < 4; ++c) {
      const int k = c * 256 + lane * 4; const f32x4 v = *(const f32x4*)(xr + k), gv = *(const f32x4*)(g + k);
      s += v[0] * v[0] + v[1] * v[1] + v[2] * v[2] + v[3] * v[3];
      *(u32x2*)(xg + (size_t)t * D_ + k) = (u32x2){pk2(v[0] * gv[0], v[1] * gv[1]), pk2(v[2] * gv[2], v[3] * gv[3])};
    }
#pragma unroll
    for (int o = 32; o >= 1; o >>= 1) s += __shfl_xor(s, o);
    if (lane < 16) ssq[(size_t)t * 16 + lane] = lane == 0 ? s : 0.f;
  }
}
DI void phase_prep(const Params& p, unsigned char* smem) {
  for (int it = blockIdx.x; it < P0_ITEMS; it += gridDim.x) {
    int i = it;
    if (i < 2 * WTILES_LAYER) {
      const int layer = i / WTILES_LAYER; int t = i % WTILES_LAYER; int id = 0;
      for (;; ++id) { const WJob j = get_wjob(p, layer, id); const int nt = (j.K >> 7) * (j.N >> 6); if (t < nt) { prep_weight_tile(j, t, (float*)smem); break; } t -= nt; }
      continue;
    }
    i -= 2 * WTILES_LAYER;
    if (i < 64) {
      const int lk = i >> 4, pc = i & 15, layer = lk >> 1, kv = lk & 1, c = TIDX() & 255, hf = TIDX() >> 8;
      const float* pe = (kv ? p.pe_v : p.pe_k) + (size_t)layer * 2048 + pc * 128 + hf * 64; const float* w1 = (kv ? p.w1_v : p.w1_k) + (size_t)layer * 2048 * 256 + (size_t)(pc * 128 + hf * 64) * 256;
      float sacc = 0.f;
#pragma unroll 8
      for (int kk = 0; kk < 64; ++kk) sacc += pe[kk] * w1[(size_t)kk * 256 + c];
      float* lds = (float*)smem;
      if (hf) lds[c] = sacc;
      __syncthreads();
      if (!hf) ((float*)(p.ws + O_BIAS1))[(lk * 16 + pc) * 256 + c] = sacc + lds[c];
      __syncthreads();
      continue;
    }
    i -= 64;
    if (i < P0_ROPE_ITEMS) {
      const int t = i * NTHR + TIDX(); const float fp = (float)p.pos[t];
      float* r8 = (float*)(p.ws + O_ROPE8) + (size_t)t * 16; float* r16 = (float*)(p.ws + O_ROPE16) + (size_t)t * 32;
      for (int f = 0; f < 24; ++f) {
        const int half = f < 8 ? 8 : 16, idx = f < 8 ? f : f - 8;
        const float inv = exp2f(-(float)idx / (float)half * 18.931568569324174f);
        const float ang = fp * inv;
        const double rev = (double)ang * 0.15915494309189535; const float fr = (float)(rev - floor(rev));
        const float sn = __builtin_amdgcn_sinf(fr), cs = __builtin_amdgcn_cosf(fr);
        if (f < 8) { r8[2 * idx] = cs; r8[2 * idx + 1] = sn; } else { r16[2 * idx] = cs; r16[2 * idx + 1] = sn; }
      }
      continue;
    }
    i -= P0_ROPE_ITEMS;
    xg_rows(p.x, p.mix_norm, (bf16_t*)(p.ws + O_XG), (float*)(p.ws + O_SSQ), i * 64);
  }
}

DI void store4(bf16_t* dst, const f32x4& v, float s) { *(u32x2*)dst = (u32x2){pk2(v[0] * s, v[1] * s), pk2(v[2] * s, v[3] * s)}; }
constexpr int STG_LD = 72, STG_WAVE = 128 * 72;
DI void stage4(bf16_t* stg, int row, int col, const f32x4& v, float s) { *(u32x2*)(stg + row * STG_LD + col) = (u32x2){pk2(v[0] * s, v[1] * s), pk2(v[2] * s, v[3] * s)}; }
template <int ROWS, int COLS, int LD> DI void stage_out(const bf16_t* stg, bf16_t* dst, size_t ld, int lane) {
  asm volatile("s_waitcnt lgkmcnt(0)" ::: "memory");
  constexpr int CPR = COLS / 8, IT = ROWS * CPR / 64;
#pragma unroll
  for (int it = 0; it < IT; ++it) {
    const int idx = it * 64 + lane, r = idx / CPR, c = idx % CPR;
    __builtin_nontemporal_store(*(const u32x4*)(stg + r * LD + c * 8), (u32x4*)(dst + (size_t)r * ld + c * 8));
  }
}
template <bool SWAP> DI void inproj_tile(const Params& p, int layer, int tm, int tn, bf16_t* smem) {
  const bf16_t* wl = (const bf16_t*)(p.ws + O_W) + (size_t)layer * W_LAYER;
  f32x4 acc[8][4]; zero_acc<8, 4>(acc);
  RowPtr ap{(const bf16_t*)(p.ws + O_XG) + (size_t)tm * 256 * D_, (size_t)D_}, bp{wl + W_IN + (size_t)tn * 256 * D_, (size_t)D_};
  gemm_main<8, 4, SWAP>(acc, ap, 64, bp, 64, 16, smem);
  const int lane = TIDX() & 63, wid = TIDX() >> 6, wm = wid >> 2, wn = wid & 3, l15 = lane & 15, quad = lane >> 4;
  const float* ssq = (const float*)(p.ws + O_SSQ);
  bf16_t* stg = smem + wid * STG_WAVE;
  const int trow0 = tm * 256 + wm * 128;
  if constexpr (!SWAP) {
    bf16_t* dst; int hh, hd;
    if (tn == 4) { dst = (bf16_t*)(p.ws + (wn < 2 ? O_VSLCT : O_VWINT)); hh = 2; hd = wn & 1; } else { dst = (bf16_t*)(p.ws + O_FOXVT); hh = 8; hd = (tn - 9) * 4 + wn; }
    constexpr int VLD = 136;
#pragma unroll
    for (int i = 0; i < 8; ++i) {
      const int t0 = trow0 + i * 16 + quad * 4;
      float rs[4];
#pragma unroll
      for (int r = 0; r < 4; ++r) rs[r] = rstd_from16(ssq + (size_t)(t0 + r) * 16, 1.f / 1024.f);
#pragma unroll
      for (int j = 0; j < 4; ++j)
        *(u32x2*)(stg + (j * 16 + l15) * VLD + i * 16 + quad * 4) = (u32x2){pk2(acc[i][j][0] * rs[0], acc[i][j][1] * rs[1]), pk2(acc[i][j][2] * rs[2], acc[i][j][3] * rs[3])};
    }
    const int b = trow0 >> 12, s0 = trow0 & 4095;
    stage_out<64, 128, VLD>(stg, dst + ((size_t)(b * hh + hd) * 64) * S_ + s0, (size_t)S_, lane);
  } else {
    const int slab = tn * 4 + wn;
    if (slab == 54) {
#pragma unroll
      for (int i = 0; i < 8; ++i) {
        const int t = trow0 + i * 16 + l15; const float rs = rstd_from16(ssq + (size_t)t * 16, 1.f / 1024.f);
        float* gt = (float*)(p.ws + O_GATES) + (size_t)t * 24; float* lf = (float*)(p.ws + O_LOGF) + (size_t)t * 8;
#pragma unroll
        for (int r = 0; r < 4; ++r) gt[quad * 4 + r] = sigmoidf_(acc[i][0][r] * rs);
        if (quad < 2) {
#pragma unroll
          for (int r = 0; r < 4; ++r) gt[16 + quad * 4 + r] = sigmoidf_(acc[i][1][r] * rs);
        } else {
#pragma unroll
          for (int r = 0; r < 4; ++r) { const int h = (quad - 2) * 4 + r; const float xx = acc[i][1][r] * rs + p.b_forget[layer * 8 + h]; lf[h] = fminf(xx, 0.f) - log1pf(__expf(-fabsf(xx))); }
        }
        const float* rp = (const float*)(p.ws + O_ROPE16) + (size_t)t * 32 + quad * 8; float o1[4], o2[4];
#pragma unroll
        for (int r = 0; r < 4; ++r) { const float cs = rp[2 * r], sn = rp[2 * r + 1], x1 = acc[i][2][r] * rs, x2 = acc[i][3][r] * rs; o1[r] = x1 * cs - x2 * sn; o2[r] = x2 * cs + x1 * sn; }
        bf16_t* kp = (bf16_t*)(p.ws + O_MLAKPE) + (size_t)t * 32 + quad * 4;
        *(u32x2*)kp = (u32x2){pk2(o1[0], o1[1]), pk2(o1[2], o1[3])}; *(u32x2*)(kp + 16) = (u32x2){pk2(o2[0], o2[1]), pk2(o2[2], o2[3])};
      }
    } else if (slab != 55) {
      bf16_t* dbuf; int dld, dcol, kind = 0; float qs = 1.f; int cslot = 0;
      if (slab < 8) { dbuf = (bf16_t*)(p.ws + O_NSAQ); dld = 512; dcol = slab * 64; qs = QS64_; }
      else if (slab < 12) { dbuf = (bf16_t*)(p.ws + O_KVCMP); dld = 256; dcol = (slab - 8) * 64; }
      else if (slab < 16) { dbuf = (bf16_t*)(p.ws + (slab < 14 ? O_KSLC : O_KWIN)); dld = 128; dcol = (slab & 1) * 64; kind = 1; }
      else if (slab < 28) { dbuf = (bf16_t*)(p.ws + O_FOXQ); dld = 512; dcol = (slab - 20) * 64; qs = QS64_; }
      else if (slab < 36) { dbuf = (bf16_t*)(p.ws + O_FOXK); dld = 512; dcol = (slab - 28) * 64; }
      else if (slab < 50) { dbuf = (bf16_t*)(p.ws + O_CQ); dld = 384; dcol = (slab - 44) * 64; kind = 2; cslot = slab - 44; }
      else { dbuf = (bf16_t*)(p.ws + O_CKV); dld = 256; dcol = (slab - 50) * 64; kind = 2; cslot = 8 + slab - 50; }
#pragma unroll
      for (int i = 0; i < 8; ++i) {
        const int row = i * 16 + l15, t = trow0 + row; const float rs = rstd_from16(ssq + (size_t)t * 16, 1.f / 1024.f) * qs;
        if (kind == 1) {
          const float* rp = (const float*)(p.ws + O_ROPE8) + (size_t)t * 16 + (quad & 1) * 8;
          f32x4 v, o;
#pragma unroll
          for (int r = 0; r < 4; ++r) { v[r] = acc[i][0][r] * rs; o[r] = __shfl_xor(v[r], 32); }
#pragma unroll
          for (int r = 0; r < 4; ++r) { const float cs = rp[2 * r], sn = rp[2 * r + 1]; v[r] = quad < 2 ? v[r] * cs - o[r] * sn : v[r] * cs + o[r] * sn; }
          stage4(stg, row, quad * 4, v, 1.f);
        } else stage4(stg, row, quad * 4, acc[i][0], rs);
#pragma unroll
        for (int j = 1; j < 4; ++j) stage4(stg, row, j * 16 + quad * 4, acc[i][j], rs);
        if (kind == 2) {
          float s = 0.f;
#pragma unroll
          for (int j = 0; j < 4; ++j) { const f32x4 a = acc[i][j] * rs; s += a[0] * a[0] + a[1] * a[1] + a[2] * a[2] + a[3] * a[3]; }
          s += __shfl_xor(s, 16); s += __shfl_xor(s, 32);
          if (quad == 0) ((float*)(p.ws + O_CSSQ))[(size_t)t * 16 + cslot] = s;
        }
      }
      stage_out<128, 64, STG_LD>(stg, dbuf + (size_t)trow0 * dld + dcol, (size_t)dld, lane);
    }
  }
  __syncthreads();
}
DI void phase_inproj(const Params& p, int layer, unsigned char* smem) {
  xcd_tiles(16, 14, [&](int tm, int tn) {
    const bool vt = (tn == 4 || tn == 9 || tn == 10);
    if (vt) inproj_tile<false>(p, layer, tm, tn, (bf16_t*)smem); else inproj_tile<true>(p, layer, tm, tn, (bf16_t*)smem);
  });
}

template <int KIND> DI void mlaup_tile(const Params& p, int layer, int tm, int tn, bf16_t* smem) {
  const bf16_t* wl = (const bf16_t*)(p.ws + O_W) + (size_t)layer * W_LAYER;
  f32x4 acc[8][4]; zero_acc<8, 4>(acc);
  constexpr int K = KIND == 0 ? 384 : 256;
  RowPtr ap{KIND == 0 ? (const bf16_t*)(p.ws + O_CQ) + (size_t)tm * 256 * 384 : (const bf16_t*)(p.ws + O_CKV) + (size_t)tm * 256 * 256, (size_t)K};
  RowPtr bp{KIND == 0 ? wl + W_UQ + (size_t)tn * 256 * 384 : wl + W_UKV + (size_t)(tn - 3) * 256 * 256, (size_t)K};
  gemm_main<8, 4, KIND != 2>(acc, ap, 64, bp, 64, K / 64, smem);
  const int lane = TIDX() & 63, wid = TIDX() >> 6, wm = wid >> 2, wn = wid & 3, l15 = lane & 15, quad = lane >> 4;
  const float* cssq = (const float*)(p.ws + O_CSSQ);
  bf16_t* stg = smem + wid * STG_WAVE; const int trow0 = tm * 256 + wm * 128;
  if constexpr (KIND == 2) {
    bf16_t* dst = (bf16_t*)(p.ws + O_MLAVT); const int h = (tn - 5) * 4 + wn;
    constexpr int VLD = 136;
#pragma unroll
    for (int i = 0; i < 8; ++i) {
      asm volatile("" ::: "memory");
      const int t0 = trow0 + i * 16 + quad * 4; float rs[4];
#pragma unroll
      for (int r = 0; r < 4; ++r) { const float* c = cssq + (size_t)(t0 + r) * 16 + 8; rs[r] = rsqrtf((c[0] + c[1] + c[2] + c[3]) * (1.f / 256.f) + EPS_); }
#pragma unroll
      for (int j = 0; j < 4; ++j)
        *(u32x2*)(stg + (j * 16 + l15) * VLD + i * 16 + quad * 4) = (u32x2){pk2(acc[i][j][0] * rs[0], acc[i][j][1] * rs[1]), pk2(acc[i][j][2] * rs[2], acc[i][j][3] * rs[3])};
    }
    stage_out<64, 128, VLD>(stg, dst + ((size_t)((trow0 >> 12) * 8 + h) * 64) * S_ + (trow0 & 4095), (size_t)S_, lane);
  } else if constexpr (KIND == 1) {
#pragma unroll
    for (int i = 0; i < 8; ++i) {
      asm volatile("" ::: "memory");
      const int row = i * 16 + l15, t = trow0 + row; const float* c = cssq + (size_t)t * 16;
      const float rs = rsqrtf((c[8] + c[9] + c[10] + c[11]) * (1.f / 256.f) + EPS_);
#pragma unroll
      for (int j = 0; j < 4; ++j) stage4(stg, row, j * 16 + quad * 4, acc[i][j], rs);
    }
    stage_out<128, 64, STG_LD>(stg, (bf16_t*)(p.ws + O_MLAKN) + (size_t)trow0 * 512 + (tn - 3) * 256 + wn * 64, (size_t)512, lane);
  } else {
    const int n0 = tn * 256 + wn * 64, ph = n0 % 96;
#pragma unroll
    for (int i = 0; i < 8; ++i) {
      asm volatile("" ::: "memory");
      const int row = i * 16 + l15, t = trow0 + row; const float* c = cssq + (size_t)t * 16;
      const float rs = rsqrtf((c[0] + c[1] + c[2] + c[3] + c[4] + c[5]) * (1.f / 384.f) + EPS_) * QS96_;
      f32x4 v0 = acc[i][0] * rs, v1 = acc[i][1] * rs, v2 = acc[i][2] * rs, v3 = acc[i][3] * rs;
      if (ph != 0) {
        const float* rp = (const float*)(p.ws + O_ROPE16) + (size_t)t * 32 + quad * 8;
        const f32x4 x1 = ph == 64 ? v0 : v2, x2 = ph == 64 ? v1 : v3; f32x4 o1, o2;
#pragma unroll
        for (int r = 0; r < 4; ++r) { const float cs = rp[2 * r], sn = rp[2 * r + 1]; o1[r] = x1[r] * cs - x2[r] * sn; o2[r] = x2[r] * cs + x1[r] * sn; }
        if (ph == 64) { v0 = o1; v1 = o2; } else { v2 = o1; v3 = o2; }
      }
      stage4(stg, row, quad * 4, v0, 1.f); stage4(stg, row, 16 + quad * 4, v1, 1.f); stage4(stg, row, 32 + quad * 4, v2, 1.f); stage4(stg, row, 48 + quad * 4, v3, 1.f);
    }
    stage_out<128, 64, STG_LD>(stg, (bf16_t*)(p.ws + O_MLAQ) + (size_t)trow0 * 768 + n0, (size_t)768, lane);
  }
  __syncthreads();
}
struct CmpRowPtr { const bf16_t* base; int r0;
  DI unsigned operator()(int r) const { int R = r0 + r; if (R >= 4080) R = 0; const int b = R / 510, rem = R - b * 510, n = rem >> 1, g = rem & 1; return (unsigned)(b * S_ + 16 * n) * 256u + g * 64; }
  DI bool ok(int r) const { return r0 + r < 4080; } };
DI void compress_item(const Params& p, int layer, int item, bf16_t* smem) {
  const int kv = item >> 4, tm = item & 15;
  const bf16_t* wl = (const bf16_t*)(p.ws + O_W) + (size_t)layer * W_LAYER;
  f32x4 acc[8][4]; zero_acc<8, 4>(acc);
  CmpRowPtr ap{(const bf16_t*)(p.ws + O_KVCMP) + kv * 128, tm * 256};
  RowPtr bp{wl + (kv ? W_1V : W_1K), (size_t)2048};
  gemm_main<8, 4, true>(acc, ap, 256, bp, 64, 32, smem);
  const int lane = TIDX() & 63, wid = TIDX() >> 6, wm = wid >> 2, wn = wid & 3, l15 = lane & 15, quad = lane >> 4;
  constexpr int LDH = 264; bf16_t* H = smem;
  const float* b1 = (const float*)(p.ws + O_BIAS1) + (size_t)(layer * 2 + kv) * 16 * 256;
#pragma unroll
  for (int j = 0; j < 4; ++j) {
    asm volatile("" ::: "memory");
    f32x4 bv = {0.f, 0.f, 0.f, 0.f};
    for (int pc = 0; pc < 16; ++pc) bv += *(const f32x4*)(b1 + pc * 256 + wn * 64 + j * 16 + quad * 4);
#pragma unroll
    for (int i = 0; i < 8; ++i) {
      const int row = wm * 128 + i * 16 + l15, col = wn * 64 + j * 16 + quad * 4;
      *(u32x2*)(H + row * LDH + col) = (u32x2){pk2(gelu_tanh(acc[i][j][0] + bv[0]), gelu_tanh(acc[i][j][1] + bv[1])), pk2(gelu_tanh(acc[i][j][2] + bv[2]), gelu_tanh(acc[i][j][3] + bv[3]))};
    }
  }
  __syncthreads();
  f32x4 a2[2][4];
#pragma unroll
  for (int i = 0; i < 2; ++i)
#pragma unroll
    for (int j = 0; j < 4; ++j) a2[i][j] = (f32x4){0.f, 0.f, 0.f, 0.f};
  const bf16_t* w2 = wl + (kv ? W_2V : W_2K);
#pragma unroll
  for (int ks = 0; ks < 8; ++ks) {
    bf16x8 a[2], b[4];
#pragma unroll
    for (int i = 0; i < 2; ++i) a[i] = *(const bf16x8*)(H + (wid * 32 + i * 16 + l15) * LDH + ks * 32 + quad * 8);
#pragma unroll
    for (int j = 0; j < 4; ++j) b[j] = *(const bf16x8*)(w2 + (size_t)(j * 16 + l15) * 256 + ks * 32 + quad * 8);
#pragma unroll
    for (int i = 0; i < 2; ++i)
#pragma unroll
      for (int j = 0; j < 4; ++j) a2[i][j] = mfma16(a[i], b[j], a2[i][j]);
  }
  bf16_t* kc = (bf16_t*)(p.ws + O_KC); bf16_t* vct = (bf16_t*)(p.ws + O_VCT);
#pragma unroll
  for (int i = 0; i < 2; ++i)
#pragma unroll
    for (int r = 0; r < 4; ++r) {
      const int R = tm * 256 + wid * 32 + i * 16 + quad * 4 + r;
      if (R < 4080) {
        const int b = R / 510, rem = R - b * 510, n = rem >> 1, g = rem & 1;
#pragma unroll
        for (int j = 0; j < 4; ++j) {
          const int d = j * 16 + l15; const bf16_t v = f2bf(a2[i][j][r]);
          if (kv == 0) kc[((size_t)(b * 2 + g) * 256 + n) * 64 + d] = v; else vct[((size_t)(b * 2 + g) * 64 + d) * 256 + n] = v;
        }
      }
    }
  __syncthreads();
}
DI void foxscan_item(const Params& p, int item, float* lds) {
  const int b = item >> 3, h = item & 7, tid = TIDX();
  const float* lf = (const float*)(p.ws + O_LOGF) + (size_t)b * S_ * 8 + h; float v[8]; float s = 0.f;
#pragma unroll
  for (int i = 0; i < 8; ++i) { s += lf[(size_t)(tid * 8 + i) * 8]; v[i] = s; }
  lds[tid] = s; __syncthreads();
  float off = 0.f;
  for (int i = 0; i < tid; ++i) off += lds[i];
  float* F2 = (float*)(p.ws + O_F2) + (size_t)(b * 8 + h) * S_ + tid * 8;
#pragma unroll
  for (int i = 0; i < 8; ++i) F2[i] = -(off + v[i]) * LOG2E_;
  __syncthreads();
}
DI void phase_b(const Params& p, int layer, unsigned char* smem) {
  for (int it = blockIdx.x; it < 96; it += gridDim.x) {
    if (it < 32) compress_item(p, layer, it, (bf16_t*)smem);
    else foxscan_item(p, it - 32, (float*)smem);
  }
  xcd_tiles(16, 7, [&](int tm, int tn) {
    if (tn >= 5) mlaup_tile<2>(p, layer, tm, tn, (bf16_t*)smem); else if (tn >= 3) mlaup_tile<1>(p, layer, tm, tn, (bf16_t*)smem); else mlaup_tile<0>(p, layer, tm, tn, (bf16_t*)smem);
  });
}

constexpr int KC_LD = 72, VC_LD = 264;
DI void cmp_item(const Params& p, int item, unsigned char* smem_) {
  const int b = item >> 6, g = (item >> 5) & 1, tt = item & 31, t0 = tt * 128;
  const int tid = TIDX(), lane = tid & 63, wid = tid >> 6, l15 = lane & 15, quad = lane >> 4;
  bf16_t* kcs = (bf16_t*)smem_;
  bf16_t* vcs = kcs + 256 * KC_LD;
  float* imps = (float*)smem_;
  const int nmax = (t0 + 96) >> 4;
  const int nsub = (nmax >> 4) + 1;
  {
    const bf16_t* kcg = (const bf16_t*)(p.ws + O_KC) + (size_t)(b * 2 + g) * 256 * 64; const bf16_t* vcg = (const bf16_t*)(p.ws + O_VCT) + (size_t)(b * 2 + g) * 64 * 256;
    const int nrows = ((nsub + 1) & ~1) * 16;
    for (int e = tid; e < nrows * 8; e += NTHR) {
      const int n = e >> 3, dc = (e & 7) * 8;
      *(u32x4*)(kcs + n * KC_LD + dc) = n < 255 ? *(const u32x4*)(kcg + (size_t)n * 64 + dc) : (u32x4){0u, 0u, 0u, 0u};
    }
    const int ncs = nrows >> 3;
    for (int e = tid; e < 64 * ncs; e += NTHR) {
      const int d = e / ncs, nc = (e - d * ncs) * 8;
      u32x4 v = *(const u32x4*)(vcg + (size_t)d * 256 + nc);
      if (nc + 8 > 255) v[3] &= 0x0000ffffu;
      *(u32x4*)(vcs + d * VC_LD + nc) = v;
    }
  }
  __syncthreads();
  const int tq = t0 + wid * 16 + l15;
  const size_t trow = (size_t)b * S_ + tq;
  float impa[16], p3a[16];
#pragma unroll
  for (int s = 0; s < 16; ++s) { impa[s] = 0.f; p3a[s] = 0.f; }
  const float* gts = (const float*)(p.ws + O_GATES) + trow * 24;
#pragma unroll 1
  for (int r4 = 0; r4 < 4; ++r4) {
    const int head = g * 4 + r4;
    const bf16_t* qp = (const bf16_t*)(p.ws + O_NSAQ) + trow * 512 + head * 64 + quad * 8;
    const bf16x8 q0 = *(const bf16x8*)qp, q1 = *(const bf16x8*)(qp + 32);
    auto score = [&](int s) -> f32x4 {
      const bf16_t* kr = kcs + (s * 16 + l15) * KC_LD + quad * 8;
      f32x4 a = {0.f, 0.f, 0.f, 0.f};
      a = mfma16(*(const bf16x8*)kr, q0, a); a = mfma16(*(const bf16x8*)(kr + 32), q1, a);
#pragma unroll
      for (int r = 0; r < 4; ++r) { const int n = s * 16 + quad * 4 + r; a[r] = (16 * n + 31 <= tq) ? a[r] : -INFINITY; }
      return a;
    };
    float mx = -INFINITY;
#pragma unroll 1
    for (int s = 0; s < nsub; ++s) { const f32x4 a = score(s); mx = fmaxf(mx, fmaxf(fmaxf(a[0], a[1]), fmaxf(a[2], a[3]))); }
    mx = fmaxf(mx, __shfl_xor(mx, 16)); mx = fmaxf(mx, __shfl_xor(mx, 32));
    if (mx == -INFINITY) mx = 0.f;
    float sum = 0.f;
#pragma unroll 1
    for (int s = 0; s < nsub; ++s) { const f32x4 a = score(s); sum += (ex2(a[0] - mx) + ex2(a[1] - mx)) + (ex2(a[2] - mx) + ex2(a[3] - mx)); }
    sum += __shfl_xor(sum, 16); sum += __shfl_xor(sum, 32);
    const float inv = 1.f / fmaxf(sum, 1e-30f);
    f32x4 oacc[4];
#pragma unroll
    for (int j = 0; j < 4; ++j) oacc[j] = (f32x4){0.f, 0.f, 0.f, 0.f};
#pragma unroll
    for (int c = 0; c < 8; ++c) {
      asm volatile("" ::: "memory");
      if (2 * c < nsub) {
        f32x4 pa = score(2 * c), pb = {-INFINITY, -INFINITY, -INFINITY, -INFINITY};
        if (2 * c + 1 < nsub) pb = score(2 * c + 1);
#pragma unroll
        for (int r = 0; r < 4; ++r) { pa[r] = ex2(pa[r] - mx) * inv; pb[r] = ex2(pb[r] - mx) * inv; }
        impa[2 * c] += pa[0] + pa[1] + pa[2] + 0.5f * pa[3]; p3a[2 * c] += pa[3];
        impa[2 * c + 1] += pb[0] + pb[1] + pb[2] + 0.5f * pb[3]; p3a[2 * c + 1] += pb[3];
        const u32x4 pw = {pk2(pa[0], pa[1]), pk2(pa[2], pa[3]), pk2(pb[0], pb[1]), pk2(pb[2], pb[3])};
        const bf16x8 pf = __builtin_bit_cast(bf16x8, pw);
#pragma unroll
        for (int j = 0; j < 4; ++j) {
          const bf16_t* vr = vcs + (j * 16 + l15) * VC_LD + c * 32 + quad * 4;
          const u32x2 lo = *(const u32x2*)vr, hi = *(const u32x2*)(vr + 16);
          const u32x4 vw = {lo[0], lo[1], hi[0], hi[1]};
          oacc[j] = mfma16(__builtin_bit_cast(bf16x8, vw), pf, oacc[j]);
        }
      }
    }
    const float g0 = gts[head * 3 + 0];
    bf16_t* op = (bf16_t*)(p.ws + O_ONSA) + trow * 512 + head * 64 + quad * 4;
#pragma unroll
    for (int j = 0; j < 4; ++j) store4(op + j * 16, oacc[j], g0);
  }
  __syncthreads();
  float* myimp = imps + wid * 1024 + l15 * 64;
  const int cur = tq >> 6;
#pragma unroll
  for (int s = 0; s < 16; ++s) {
    const float up = __shfl(p3a[s], (lane + 48) & 63);
    const float up0 = s ? __shfl(p3a[s ? s - 1 : 0], (lane + 48) & 63) : 0.f;
    const float prev = quad ? up : up0;
    float v = impa[s] + 0.5f * prev;
    const int j = 4 * s + quad;
    if (j == 0 || j == cur || j == cur - 1) v = 1e9f; else if (j > cur) v = -1e9f;
    myimp[j] = v;
  }
  __syncthreads();
  u64* sel = (u64*)(p.ws + O_SEL) + (size_t)(b * 2 + g) * S_ + t0 + wid * 16;
#pragma unroll 1
  for (int q = 0; q < 16; ++q) {
    const float mine = imps[wid * 1024 + q * 64 + lane]; int rank = 0;
#pragma unroll
    for (int i = 0; i < 64; ++i) { const float v = __uint_as_float(__builtin_amdgcn_readlane(__float_as_uint(mine), i)); rank += (v > mine || (v == mine && i < lane)) ? 1 : 0; }
    const u64 m = __ballot(rank < 16);
    if (lane == 0) sel[q] = m;
  }
  __syncthreads();
}
constexpr int PC_ITEMS = NB_ * 2 * 32;
DI void phase_c(const Params& p, unsigned char* smem) { for (int it = blockIdx.x; it < PC_ITEMS; it += gridDim.x) cmp_item(p, it, smem); }

enum { M_FOX = 0, M_MLA = 1, M_WIN = 2, M_SLC = 3 };
template <int MODE> struct ACfg { static constexpr int DQK = MODE == M_MLA ? 96 : 64, KLD = DQK + 8, NKC = DQK / 8 * 64, KCH = (NKC + NTHR - 1) / NTHR, K_ELEMS = 64 * KLD, V_ELEMS = 64 * 72, STAGE = K_ELEMS + V_ELEMS + 128; };
struct AState { f32x16 o[2]; f32x16 mr; float m, l; };

template <int MODE>
DI void flash_pass(AState& st, const bf16x8* qf, u64 tmask, u64 wmask,
                   const bf16_t* kbase, size_t kld, const bf16_t* kpe, const bf16_t* vtbase, const float* fbias,
                   int tq, u64 mysel, bf16_t* smem) {
  typedef ACfg<MODE> C;
  const int tid = TIDX(), lane = tid & 63, l31 = lane & 31, half = lane >> 5;
  u32x4 rk[C::KCH], rv; float rf = 0.f;
  auto gload = [&](int j) {
    const int k0 = j * 64;
#pragma unroll
    for (int i = 0; i < C::KCH; ++i) {
      const int c = tid + NTHR * i;
      if (c < C::NKC) {
        if constexpr (MODE == M_MLA) { const int key = c / 12, dc = c % 12; rk[i] = dc < 8 ? *(const u32x4*)(kbase + (size_t)(k0 + key) * kld + dc * 8) : *(const u32x4*)(kpe + (size_t)(k0 + key) * 32 + (dc - 8) * 8); }
        else { const int key = c >> 3, dc = c & 7; rk[i] = *(const u32x4*)(kbase + (size_t)(k0 + key) * kld + dc * 8); }
      }
    }
    { const int d = tid >> 3, kc = tid & 7; rv = *(const u32x4*)(vtbase + (size_t)d * S_ + k0 + kc * 8); }
    if constexpr (MODE == M_FOX) { if (tid < 64) rf = fbias[k0 + tid]; }
  };
  auto sstore = [&](int buf) {
    bf16_t* Ks = smem + buf * C::STAGE; bf16_t* Vs = Ks + C::K_ELEMS;
#pragma unroll
    for (int i = 0; i < C::KCH; ++i) {
      const int c = tid + NTHR * i;
      if (c < C::NKC) {
        if constexpr (MODE == M_MLA) { const int key = c / 12, dc = c % 12; *(u32x4*)(Ks + key * C::KLD + dc * 8) = rk[i]; }
        else { const int key = c >> 3, dc = c & 7; *(u32x4*)(Ks + key * C::KLD + dc * 8) = rk[i]; }
      }
    }
    {
      const int d = tid >> 3, kc = tid & 7, cgp = kc >> 1, a = kc & 1;
      bf16_t* dst = Vs + d * 72 + cgp * 16 + 4 * a;
      *(u32x2*)dst = (u32x2){rv[0], rv[1]}; *(u32x2*)(dst + 8) = (u32x2){rv[2], rv[3]};
    }
    if constexpr (MODE == M_FOX) { if (tid < 64) ((float*)(Vs + C::V_ELEMS))[tid] = rf; }
  };
  u64 tm = tmask;
  if (tm == 0) return;
  int j = __builtin_ctzll(tm); tm &= tm - 1;
  gload(j); sstore(0); __syncthreads();
  int buf = 0;
  const int tmin = __builtin_amdgcn_readfirstlane(tq - l31), tmax = tmin + 31;
  while (true) {
    const int jn = tm ? __builtin_ctzll(tm) : -1; if (tm) tm &= tm - 1;
    if (jn >= 0) gload(jn);
    bool active = (wmask >> j) & 1;
    if constexpr (MODE == M_SLC) active = active && __any((mysel >> j) & 1);
    if (active) {
      const bf16_t* Ks = smem + buf * C::STAGE; const bf16_t* Vs = Ks + C::K_ELEMS;
      f32x16 s0 = st.mr, s1 = st.mr;
      const bf16_t* kr = Ks + l31 * C::KLD + half * 8;
#pragma unroll
      for (int ks = 0; ks < C::DQK / 16; ++ks) {
        s0 = mfma32(*(const bf16x8*)(kr + ks * 16), qf[ks], s0);
        s1 = mfma32(*(const bf16x8*)(kr + 32 * C::KLD + ks * 16), qf[ks], s1);
      }
      const int k0 = j * 64;
      if constexpr (MODE == M_FOX) {
        const float* fb = (const float*)(Vs + C::V_ELEMS) + 4 * half;
#pragma unroll
        for (int g4 = 0; g4 < 4; ++g4) {
          const f32x4 b0 = *(const f32x4*)(fb + 8 * g4), b1 = *(const f32x4*)(fb + 32 + 8 * g4);
#pragma unroll
          for (int r = 0; r < 4; ++r) { s0[4 * g4 + r] += b0[r]; s1[4 * g4 + r] += b1[r]; }
        }
      }
      bool need = k0 + 63 > tmin;
      if constexpr (MODE == M_WIN) need = need || (k0 <= tmax - 512);
      if constexpr (MODE == M_SLC) {
        if (!need) {
          const bool rsel = ((mysel >> j) & 1) != 0;
          if (!__all(rsel)) {
#pragma unroll
            for (int r = 0; r < 16; ++r) { s0[r] = rsel ? s0[r] : -INFINITY; s1[r] = rsel ? s1[r] : -INFINITY; }
          }
        }
      }
      if (need) {
        const bool rowok = MODE == M_SLC ? ((mysel >> j) & 1) != 0 : true;
#pragma unroll
        for (int r = 0; r < 16; ++r) {
          const int key = k0 + (r & 3) + 8 * (r >> 2) + 4 * half;
          bool ok0 = rowok && key <= tq, ok1 = rowok && key + 32 <= tq;
          if constexpr (MODE == M_WIN) { ok0 = ok0 && (tq - key < 512); ok1 = ok1 && (tq - key - 32 < 512); }
          s0[r] = ok0 ? s0[r] : -INFINITY; s1[r] = ok1 ? s1[r] : -INFINITY;
        }
      }
      int im = (int)0x80000000;
#pragma unroll
      for (int r = 0; r < 16; ++r) im = max(im, max(__float_as_int(s0[r]), __float_as_int(s1[r])));
      im = max(im, __shfl_xor(im, 32));
      constexpr int TBITS = 0x41200000;
      if (__any(im > TBITS)) {
        const float d = im > TBITS ? __int_as_float(im) : 0.f;
        const float a = ex2(-d);
#pragma unroll
        for (int r = 0; r < 16; ++r) { s0[r] -= d; s1[r] -= d; st.o[0][r] *= a; st.o[1][r] *= a; }
        st.l *= a; st.m += d;
#pragma unroll
        for (int r = 0; r < 16; ++r) st.mr[r] = -st.m;
      }
      float sum = 0.f;
#pragma unroll
      for (int r = 0; r < 16; ++r) { s0[r] = ex2(s0[r]); s1[r] = ex2(s1[r]); sum += s0[r] + s1[r]; }
      st.l += sum;
      const bf16_t* vr = Vs + l31 * 72 + half * 8;
#pragma unroll
      for (int c = 0; c < 4; ++c) {
        u32x4 pw;
        if (c < 2) pw = (u32x4){pk2(s0[8 * c + 0], s0[8 * c + 1]), pk2(s0[8 * c + 2], s0[8 * c + 3]), pk2(s0[8 * c + 4], s0[8 * c + 5]), pk2(s0[8 * c + 6], s0[8 * c + 7])};
        else pw = (u32x4){pk2(s1[8 * (c - 2) + 0], s1[8 * (c - 2) + 1]), pk2(s1[8 * (c - 2) + 2], s1[8 * (c - 2) + 3]), pk2(s1[8 * (c - 2) + 4], s1[8 * (c - 2) + 5]), pk2(s1[8 * (c - 2) + 6], s1[8 * (c - 2) + 7])};
        const bf16x8 pf = __builtin_bit_cast(bf16x8, pw);
        st.o[0] = mfma32(*(const bf16x8*)(vr + c * 16), pf, st.o[0]);
        st.o[1] = mfma32(*(const bf16x8*)(vr + 32 * 72 + c * 16), pf, st.o[1]);
      }
    }
    if (jn >= 0) sstore(buf ^ 1);
    __syncthreads();
    if (jn < 0) break;
    j = jn; buf ^= 1;
  }
}
DI void astate_init(AState& s) {
#pragma unroll
  for (int r = 0; r < 16; ++r) { s.o[0][r] = 0.f; s.o[1][r] = 0.f; }
#pragma unroll
  for (int r = 0; r < 16; ++r) s.mr[r] = 0.f;
  s.m = 0.f; s.l = 0.f;
}
DI u64 lowbits(int n) { return n >= 64 ? ~0ull : ((1ull << n) - 1ull); }

template <int MODE> DI void dense_attn_item(const Params& p, int b, int h, int qt, bf16_t* smem) {
  const int lane = TIDX() & 63, wid = TIDX() >> 6, l31 = lane & 31, half = lane >> 5;
  const int t0 = qt * 256, tq = t0 + wid * 32 + l31; const size_t trow = (size_t)b * S_ + tq;
  constexpr int NQ = ACfg<MODE>::DQK / 16;
  bf16x8 qf[NQ];
  const bf16_t* qp = MODE == M_FOX ? (const bf16_t*)(p.ws + O_FOXQ) + trow * 512 + h * 64 : (const bf16_t*)(p.ws + O_MLAQ) + trow * 768 + h * 96;
#pragma unroll
  for (int ks = 0; ks < NQ; ++ks) qf[ks] = *(const bf16x8*)(qp + ks * 16 + half * 8);
  AState st; astate_init(st);
  const u64 tmask = lowbits(4 * qt + 4), wmask = lowbits(((t0 + wid * 32 + 31) >> 6) + 1);
  if constexpr (MODE == M_FOX)
    flash_pass<M_FOX>(st, qf, tmask, wmask, (const bf16_t*)(p.ws + O_FOXK) + (size_t)b * S_ * 512 + h * 64, 512, nullptr,
                      (const bf16_t*)(p.ws + O_FOXVT) + (size_t)(b * 8 + h) * 64 * S_, (const float*)(p.ws + O_F2) + (size_t)(b * 8 + h) * S_, tq, 0ull, smem);
  else
    flash_pass<M_MLA>(st, qf, tmask, wmask, (const bf16_t*)(p.ws + O_MLAKN) + (size_t)b * S_ * 512 + h * 64, 512, (const bf16_t*)(p.ws + O_MLAKPE) + (size_t)b * S_ * 32,
                      (const bf16_t*)(p.ws + O_MLAVT) + (size_t)(b * 8 + h) * 64 * S_, nullptr, tq, 0ull, smem);
  const float l = st.l + __shfl_xor(st.l, 32), inv = 1.f / fmaxf(l, 1e-30f);
  bf16_t* op = (bf16_t*)qp;
#pragma unroll
  for (int dt = 0; dt < 2; ++dt)
#pragma unroll
    for (int g4 = 0; g4 < 4; ++g4) {
      const int d = dt * 32 + g4 * 8 + half * 4;
      *(u32x2*)(op + d) = (u32x2){pk2(st.o[dt][4 * g4] * inv, st.o[dt][4 * g4 + 1] * inv), pk2(st.o[dt][4 * g4 + 2] * inv, st.o[dt][4 * g4 + 3] * inv)};
    }
}
DI void nsa_attn_item(const Params& p, int b, int g, int qt, bf16_t* smem) {
  const int lane = TIDX() & 63, wid = TIDX() >> 6, l31 = lane & 31, half = lane >> 5;
  const int t0 = qt * 64, tw0 = t0 + (wid >> 2) * 32, tq = tw0 + l31, head = g * 4 + (wid & 3); const size_t trow = (size_t)b * S_ + tq;
  bf16x8 qf[4];
  const bf16_t* qp = (const bf16_t*)(p.ws + O_NSAQ) + trow * 512 + head * 64;
#pragma unroll
  for (int ks = 0; ks < 4; ++ks) qf[ks] = *(const bf16x8*)(qp + ks * 16 + half * 8);
  {
    const float* rp = (const float*)(p.ws + O_ROPE8) + trow * 16;
    u32x4 me = __builtin_bit_cast(u32x4, qf[0]), ot;
#pragma unroll
    for (int e = 0; e < 4; ++e) ot[e] = __shfl_xor(me[e], 32);
    unsigned res[4];
#pragma unroll
    for (int e = 0; e < 4; ++e) {
      float o2[2];
#pragma unroll
      for (int u = 0; u < 2; ++u) {
        const int f = 2 * e + u; const float cs = rp[2 * f], sn = rp[2 * f + 1];
        const float a = bf2f((bf16_t)(u ? me[e] >> 16 : me[e] & 0xffffu)), o = bf2f((bf16_t)(u ? ot[e] >> 16 : ot[e] & 0xffffu));
        o2[u] = half == 0 ? a * cs - o * sn : a * cs + o * sn;
      }
      res[e] = pk2(o2[0], o2[1]);
    }
    qf[0] = __builtin_bit_cast(bf16x8, (u32x4){res[0], res[1], res[2], res[3]});
  }
  const float* gts = (const float*)(p.ws + O_GATES) + trow * 24 + head * 3;
  const int cur = t0 >> 6;
  f32x16 res[2];
  {
    AState st; astate_init(st);
    const int first = t0 >= 511 ? (t0 - 511) >> 6 : 0, firstw = tw0 >= 511 ? (tw0 - 511) >> 6 : 0;
    const u64 tmask = lowbits(cur + 1) & ~lowbits(first), wmask = lowbits(cur + 1) & ~lowbits(firstw);
    flash_pass<M_WIN>(st, qf, tmask, wmask, (const bf16_t*)(p.ws + O_KWIN) + (size_t)b * S_ * 128 + g * 64, 128, nullptr,
                      (const bf16_t*)(p.ws + O_VWINT) + (size_t)(b * 2 + g) * 64 * S_, nullptr, tq, 0ull, smem);
    const float l = st.l + __shfl_xor(st.l, 32), sc = gts[2] / fmaxf(l, 1e-30f);
#pragma unroll
    for (int r = 0; r < 16; ++r) { res[0][r] = st.o[0][r] * sc; res[1][r] = st.o[1][r] * sc; }
  }
  {
    AState st; astate_init(st);
    const u64* selp = (const u64*)(p.ws + O_SEL) + (size_t)(b * 2 + g) * S_;
    const u64 mysel = selp[tq];
    const u64 m64 = selp[t0 + lane];
    unsigned lo = (unsigned)m64, hi = (unsigned)(m64 >> 32);
#pragma unroll
    for (int o = 32; o >= 1; o >>= 1) { lo |= __shfl_xor(lo, o); hi |= __shfl_xor(hi, o); }
    const u64 um = (((u64)(unsigned)__builtin_amdgcn_readfirstlane(hi) << 32) | (u64)(unsigned)__builtin_amdgcn_readfirstlane(lo)) & lowbits(cur + 1);
    flash_pass<M_SLC>(st, qf, um, um, (const bf16_t*)(p.ws + O_KSLC) + (size_t)b * S_ * 128 + g * 64, 128, nullptr,
                      (const bf16_t*)(p.ws + O_VSLCT) + (size_t)(b * 2 + g) * 64 * S_, nullptr, tq, mysel, smem);
    const float l = st.l + __shfl_xor(st.l, 32), sc = gts[1] / fmaxf(l, 1e-30f);
#pragma unroll
    for (int r = 0; r < 16; ++r) { res[0][r] += st.o[0][r] * sc; res[1][r] += st.o[1][r] * sc; }
  }
  bf16_t* op = (bf16_t*)(p.ws + O_ONSA) + trow * 512 + head * 64;
#pragma unroll
  for (int dt = 0; dt < 2; ++dt)
#pragma unroll
    for (int g4 = 0; g4 < 4; ++g4) {
      const int d = dt * 32 + g4 * 8 + half * 4;
      const u32x2 oc = *(const u32x2*)(op + d);
      const float c0 = bf2f((bf16_t)(oc[0] & 0xffffu)), c1 = bf2f((bf16_t)(oc[0] >> 16)), c2 = bf2f((bf16_t)(oc[1] & 0xffffu)), c3 = bf2f((bf16_t)(oc[1] >> 16));
      *(u32x2*)(op + d) = (u32x2){pk2(res[dt][4 * g4] + c0, res[dt][4 * g4 + 1] + c1), pk2(res[dt][4 * g4 + 2] + c2, res[dt][4 * g4 + 3] + c3)};
    }
}
constexpr int PD_ITEMS = 16 * 192;
DI void phase_d(const Params& p, unsigned char* smem) {
  for (int it = blockIdx.x; it < PD_ITEMS; it += gridDim.x) {
    const int r = it / 192, w = it % 192, qt = 15 - r;
    if (w < 64) dense_attn_item<M_MLA>(p, w >> 3, w & 7, qt, (bf16_t*)smem);
    else if (w < 128) dense_attn_item<M_FOX>(p, (w - 64) >> 3, (w - 64) & 7, qt, (bf16_t*)smem);
    else { const int i = w - 128, bg = i & 15, q4 = i >> 4; nsa_attn_item(p, bg >> 1, bg & 1, qt * 4 + q4, (bf16_t*)smem); }
  }
}

DI void merge_tile(const Params& p, int layer, int tm, int tn, bf16_t* smem) {
  const bf16_t* wl = (const bf16_t*)(p.ws + O_W) + (size_t)layer * W_LAYER;
  const int lane = TIDX() & 63, wid = TIDX() >> 6, wm = wid >> 2, wn = wid & 3, l15 = lane & 15, quad = lane >> 4;
  f32x4 mg[4][2]; zero_acc<4, 2>(mg);
  unsigned* gsp = (unsigned*)((unsigned char*)smem + 2 * GemmLds<4, 2>::STAGE * 2) + TIDX();
#pragma unroll 1
  for (int br = 0; br < 3; ++br) {
    {
      f32x4 ga[4][2]; zero_acc<4, 2>(ga);
      RowPtr ap{(const bf16_t*)(p.ws + O_XG) + (size_t)tm * 128 * D_, (size_t)D_}, bp{wl + W_G + ((size_t)br * 1024 + tn * 128) * D_, (size_t)D_};
      gemm_main<4, 2, true>(ga, ap, 64, bp, 64, 16, smem);
#pragma unroll
      for (int i = 0; i < 4; ++i) {
        const float rs = rstd_from16((const float*)(p.ws + O_SSQ) + (size_t)(tm * 128 + wm * 64 + i * 16 + l15) * 16, 1.f / 1024.f);
#pragma unroll
        for (int j = 0; j < 2; ++j) {
          gsp[((i * 2 + j) * 2 + 0) * NTHR] = pk2(sigmoidf_(ga[i][j][0] * rs), sigmoidf_(ga[i][j][1] * rs));
          gsp[((i * 2 + j) * 2 + 1) * NTHR] = pk2(sigmoidf_(ga[i][j][2] * rs), sigmoidf_(ga[i][j][3] * rs));
        }
      }
    }
    f32x4 ba[4][2]; zero_acc<4, 2>(ba);
    RowPtr bp2{wl + (br == 0 ? W_BN : br == 1 ? W_BF : W_BM) + (size_t)tn * 128 * 512, (size_t)512};
    const bf16_t* abase = (const bf16_t*)(p.ws + (br == 0 ? O_ONSA : br == 1 ? O_FOXQ : O_MLAQ));
    const int ald = br == 2 ? 768 : 512;
    RowPtr ap2{abase + (size_t)tm * 128 * ald, (size_t)ald};
    gemm_main<4, 2, true>(ba, ap2, br == 2 ? 96 : 64, bp2, 64, 8, smem);
#pragma unroll
    for (int i = 0; i < 4; ++i)
#pragma unroll
      for (int j = 0; j < 2; ++j) {
        const unsigned w0 = gsp[((i * 2 + j) * 2 + 0) * NTHR], w1 = gsp[((i * 2 + j) * 2 + 1) * NTHR];
        mg[i][j][0] += bf2f((bf16_t)(w0 & 0xffffu)) * ba[i][j][0];
        mg[i][j][1] += bf2f((bf16_t)(w0 >> 16)) * ba[i][j][1];
        mg[i][j][2] += bf2f((bf16_t)(w1 & 0xffffu)) * ba[i][j][2];
        mg[i][j][3] += bf2f((bf16_t)(w1 >> 16)) * ba[i][j][3];
      }
  }
  bf16_t* stg = (bf16_t*)((unsigned char*)smem + 106496 + wid * 5120);
#pragma unroll
  for (int i = 0; i < 4; ++i)
#pragma unroll
    for (int j = 0; j < 2; ++j) *(u32x2*)(stg + (i * 16 + l15) * 40 + j * 16 + quad * 4) = (u32x2){pk2(mg[i][j][0], mg[i][j][1]), pk2(mg[i][j][2], mg[i][j][3])};
  stage_out<64, 32, 40>(stg, (bf16_t*)(p.ws + O_MERGED) + (size_t)(tm * 128 + wm * 64) * D_ + tn * 128 + wn * 32, (size_t)D_, lane);
}
DI void phase_e(const Params& p, int layer, unsigned char* smem) {
  xcd_tiles(32, 8, [&](int tm, int tn) { merge_tile(p, layer, tm, tn, (bf16_t*)smem); });
}

DI void resid_tile(const Params& p, const bf16_t* A, int K, const bf16_t* W, const float* xold, const float* gnext, int tm, int tn, bf16_t* smem) {
  f32x4 acc[8][4]; zero_acc<8, 4>(acc);
  RowPtr ap{A + (size_t)tm * 256 * K, (size_t)K}, bp{W + (size_t)tn * 256 * K, (size_t)K};
  gemm_main<8, 4, true>(acc, ap, 64, bp, 64, K / 64, smem);
  const int lane = TIDX() & 63, wid = TIDX() >> 6, wm = wid >> 2, wn = wid & 3, l15 = lane & 15, quad = lane >> 4;
  bf16_t* stg = smem + wid * STG_WAVE;
#pragma unroll
  for (int i = 0; i < 8; ++i) {
    const int t = tm * 256 + wm * 128 + i * 16 + l15, c0 = tn * 256 + wn * 64 + quad * 4; float s = 0.f;
#pragma unroll
    for (int j = 0; j < 4; ++j) {
      const size_t off = (size_t)t * D_ + c0 + j * 16;
      const f32x4 xn = *(const f32x4*)(xold + off) + acc[i][j];
      *(f32x4*)(p.out + off) = xn;
      s += xn[0] * xn[0] + xn[1] * xn[1] + xn[2] * xn[2] + xn[3] * xn[3];
      if (gnext) { const f32x4 gv = *(const f32x4*)(gnext + c0 + j * 16); *(u32x2*)(stg + (i * 16 + l15) * STG_LD + j * 16 + quad * 4) = (u32x2){pk2(xn[0] * gv[0], xn[1] * gv[1]), pk2(xn[2] * gv[2], xn[3] * gv[3])}; }
    }
    s += __shfl_xor(s, 16); s += __shfl_xor(s, 32);
    if (quad == 0) ((float*)(p.ws + O_SSQ))[(size_t)t * 16 + tn * 4 + wn] = s;
  }
  if (gnext) stage_out<128, 64, STG_LD>(stg, (bf16_t*)(p.ws + O_XG) + (size_t)(tm * 256 + wm * 128) * D_ + tn * 256 + wn * 64, (size_t)D_, lane);
  __syncthreads();
}
DI void phase_f(const Params& p, int layer, unsigned char* smem) {
  const bf16_t* wl = (const bf16_t*)(p.ws + O_W) + (size_t)layer * W_LAYER;
  xcd_tiles(16, 4, [&](int tm, int tn) { resid_tile(p, (const bf16_t*)(p.ws + O_MERGED), 1024, wl + W_OUT, layer == 0 ? p.x : p.out, p.ffn_norm + layer * D_, tm, tn, (bf16_t*)smem); });
}
DI void phase_h(const Params& p, int layer, unsigned char* smem) {
  const bf16_t* wl = (const bf16_t*)(p.ws + O_W) + (size_t)layer * W_LAYER;
  xcd_tiles(16, 4, [&](int tm, int tn) { resid_tile(p, (const bf16_t*)(p.ws + O_ACT), DFF_, wl + W_DN, p.out, layer == 0 ? p.mix_norm + D_ : nullptr, tm, tn, (bf16_t*)smem); });
}

struct UpRowPtr { const bf16_t* base; int s0;
  DI unsigned operator()(int r) const { const int s = s0 + r; return (unsigned)((s < 0 || s >= S_) ? 0 : s) * (unsigned)D_; }
  DI bool ok(int r) const { const int s = s0 + r; return s >= 0 && s < S_; } };
constexpr int PG_MT = 17;
DI void ffnup_tile(const Params& p, int layer, int b, int mt, int tn, bf16_t* smem) {
  const bf16_t* wl = (const bf16_t*)(p.ws + O_W) + (size_t)layer * W_LAYER;
  f32x4 acc[8][4]; zero_acc<8, 4>(acc);
  const int s0 = 254 * mt - 2;
  UpRowPtr ap{(const bf16_t*)(p.ws + O_XG) + (size_t)b * S_ * D_, s0}; RowPtr bp{wl + W_UP + (size_t)tn * 256 * D_, (size_t)D_};
  gemm_main<8, 4, true>(acc, ap, 64, bp, 64, 16, smem);
  const int tid = TIDX(), lane = tid & 63, wid = tid >> 6, wm = wid >> 2, wn = wid & 3, l15 = lane & 15, quad = lane >> 4;
  constexpr int LDU = 136; bf16_t* U = smem; bf16_t* V = smem + 256 * LDU;
  {
    bf16_t* dstb = (wn < 2 ? U : V) + (wn & 1) * 64 + quad * 4;
#pragma unroll
    for (int i = 0; i < 8; ++i) {
      const int row = wm * 128 + i * 16 + l15, s = s0 + row;
      const float rs = (s >= 0 && s < S_) ? rstd_from16((const float*)(p.ws + O_SSQ) + ((size_t)b * S_ + s) * 16, 1.f / 1024.f) : 0.f;
#pragma unroll
      for (int j = 0; j < 4; ++j) store4(dstb + row * LDU + j * 16, acc[i][j], rs);
    }
  }
  __syncthreads();
  {
    const int cc = tid & 15, cg0 = tn * 128 + cc * 8;
    const float* cw = p.conv_w + (size_t)layer * 3 * DFF_ + cg0; const float* cbp = p.conv_b + (size_t)layer * DFF_ + cg0;
    float w0[8], w1[8], w2[8], cb[8];
#pragma unroll
    for (int e = 0; e < 8; ++e) { w0[e] = cw[e]; w1[e] = cw[DFF_ + e]; w2[e] = cw[2 * DFF_ + e]; cb[e] = cbp[e]; }
    bf16_t* act = (bf16_t*)(p.ws + O_ACT);
#pragma unroll 2
    for (int it = 0; it < 8; ++it) {
      const int row = it * 32 + (tid >> 4), s = s0 + row;
      if (row >= 2 && s < S_) {
        const u32x4 u0 = *(const u32x4*)(U + (row - 2) * LDU + cc * 8), u1 = *(const u32x4*)(U + (row - 1) * LDU + cc * 8), u2 = *(const u32x4*)(U + row * LDU + cc * 8), vv = *(const u32x4*)(V + row * LDU + cc * 8);
        unsigned o[4];
#pragma unroll
        for (int e = 0; e < 4; ++e) {
          float r2[2];
#pragma unroll
          for (int h = 0; h < 2; ++h) {
            const int k = 2 * e + h;
            const float a0 = bf2f((bf16_t)(h ? u0[e] >> 16 : u0[e] & 0xffffu)), a1 = bf2f((bf16_t)(h ? u1[e] >> 16 : u1[e] & 0xffffu)), a2 = bf2f((bf16_t)(h ? u2[e] >> 16 : u2[e] & 0xffffu)), vx = bf2f((bf16_t)(h ? vv[e] >> 16 : vv[e] & 0xffffu));
            const float uc = w0[k] * a0 + w1[k] * a1 + w2[k] * a2 + cb[k];
            r2[h] = uc * sigmoidf_(uc) * vx;
          }
          o[e] = pk2(r2[0], r2[1]);
        }
        __builtin_nontemporal_store((u32x4){o[0], o[1], o[2], o[3]}, (u32x4*)(act + ((size_t)b * S_ + s) * DFF_ + cg0));
      }
    }
  }
  __syncthreads();
}
DI void phase_g(const Params& p, int layer, unsigned char* smem) {
  xcd_tiles(PG_MT, 22, [&](int tmg, int tn) { ffnup_tile(p, layer, tmg / PG_MT, tmg % PG_MT, tn, (bf16_t*)smem); });
}

DI void phase_final(const Params& p) {
  const int lane = TIDX() & 63, wid = TIDX() >> 6;
  for (int it = blockIdx.x; it < T_ / 8; it += gridDim.x) {
    const int t = it * 8 + wid; const float rs = rstd_from16((const float*)(p.ws + O_SSQ) + (size_t)t * 16, 1.f / 1024.f);
    float* xr = p.out + (size_t)t * D_;
#pragma unroll
    for (int c = 0; c < 4; ++c) { const int k = c * 256 + lane * 4; const f32x4 v = *(const f32x4*)(xr + k), gv = *(const f32x4*)(p.final_norm + k); *(f32x4*)(xr + k) = v * rs * gv; }
  }
}

#define XB_TMO      128
#define XB_XCNT(j)  (256  + 64 * (j))
#define XB_XSUB(j)  (1280 + 64 * (j))
#define XB_XGEN(j)  (2304 + 64 * (j))
#define XB_TOP      3328
#define XB_TOPGEN   3392
#define XCD_BAR_WORDS 3456
#define XB_SPIN_CAP (1u << 22)
#define LAS __attribute__((address_space(3)))
DI unsigned xb_ld(unsigned* p)              { return __hip_atomic_load(p, __ATOMIC_RELAXED, __HIP_MEMORY_SCOPE_AGENT); }
DI unsigned xb_add(unsigned* p, unsigned v) { return __hip_atomic_fetch_add(p, v, __ATOMIC_RELAXED, __HIP_MEMORY_SCOPE_AGENT); }
DI unsigned xb_xcc_id() { return (unsigned)__builtin_amdgcn_s_getreg((3 << 11) | 20) & 0xFu; }
#define XB_SPIN(cond, bar) do { unsigned _sp = 0; while (cond) { __builtin_amdgcn_s_sleep(1); \
    if ((++_sp & 255u) == 0u) { if (xb_ld(&(bar)[XB_TMO])) break; if (_sp > XB_SPIN_CAP) { atomicAdd(&(bar)[XB_TMO], 1u); break; } } } } while (0)
struct XcdBarrier { unsigned* bar; unsigned x; volatile LAS unsigned* st; };
DI XcdBarrier xcd_barrier_post(unsigned* bar, volatile LAS unsigned* st) {
  XcdBarrier b; b.bar = bar; b.x = xb_xcc_id(); b.st = st;
  if (threadIdx.x == 0) (void)xb_add(&bar[XB_XCNT(b.x)], 1u);
  return b;
}
DI void xcd_barrier_complete(unsigned* bar, unsigned x, unsigned& nloc, unsigned& nx) {
  const unsigned G = gridDim.x * gridDim.y * gridDim.z;
  unsigned sum, cnt, mine, sp = 0u;
  for (;;) {
    sum = 0u; cnt = 0u; mine = 0u;
#pragma unroll
    for (unsigned j = 0; j < 16; ++j) { const unsigned c = xb_ld(&bar[XB_XCNT(j)]); sum += c; cnt += (c > 0u) ? 1u : 0u; mine = (j == x) ? c : mine; }
    if (sum == G) break;
    __builtin_amdgcn_s_sleep(1);
    if ((++sp & 255u) == 0u) { if (xb_ld(&bar[XB_TMO])) break; if (sp > XB_SPIN_CAP) { atomicAdd(&bar[XB_TMO], 1u); break; } }
  }
  nloc = mine > 0u ? mine : 1u; nx = cnt > 0u ? cnt : 1u;
}
DI void xcd_barrier(const XcdBarrier& b) {
  asm volatile("s_waitcnt vmcnt(0)" ::: "memory");
  __syncthreads();
  if (threadIdx.x == 0) {
    unsigned* bar = b.bar;
    __builtin_amdgcn_s_waitcnt(0);
    unsigned nloc = b.st[0], nx = b.st[1];
    if (nloc == 0u) { xcd_barrier_complete(bar, b.x, nloc, nx); b.st[0] = nloc; b.st[1] = nx; }
    const unsigned old = xb_add(&bar[XB_XSUB(b.x)], 1u);
    const unsigned gen = old / nloc;
    if (old + 1u == (gen + 1u) * nloc) {
      __builtin_amdgcn_fence(__ATOMIC_RELEASE, "agent");
      asm volatile("s_waitcnt vmcnt(0)" ::: "memory");
      const unsigned og = xb_add(&bar[XB_TOP], 1u);
      const unsigned tg = og / nx;
      if (og + 1u == (tg + 1u) * nx) xb_add(&bar[XB_TOPGEN], 1u);
      else XB_SPIN(xb_ld(&bar[XB_TOPGEN]) == tg, bar);
      __builtin_amdgcn_fence(__ATOMIC_ACQUIRE, "agent");
      xb_add(&bar[XB_XGEN(b.x)], 1u);
      asm volatile("s_waitcnt vmcnt(0)" ::: "memory");
    } else {
      XB_SPIN(xb_ld(&bar[XB_XGEN(b.x)]) == gen, bar);
      __builtin_amdgcn_fence(__ATOMIC_ACQUIRE, "agent");
      asm volatile("s_waitcnt vmcnt(0)" ::: "memory");
    }
  }
  __syncthreads();
}
DI void run_phase(const Params& p, int ph, unsigned char* smem) {
  if (ph == 0) { phase_prep(p, smem); return; }
  if (ph == 17) { phase_final(p); return; }
  const int layer = (ph - 1) >> 3, s = (ph - 1) & 7;
#ifdef PROBE_DUP
  if ((PROBE_DUP >> s) & 1) {
    switch (s) { case 0: phase_inproj(p, layer, smem); break; case 1: phase_b(p, layer, smem); break; case 2: phase_c(p, smem); break; case 4: phase_e(p, layer, smem); break; case 6: phase_g(p, layer, smem); break; default: break; }
    __syncthreads();
  }
#endif
  switch (s) {
    case 0: phase_inproj(p, layer, smem); break;
    case 1: phase_b(p, layer, smem); break;
    case 2: phase_c(p, smem); break;
    case 3: phase_d(p, smem); break;
    case 4: phase_e(p, layer, smem); break;
    case 5: phase_f(p, layer, smem); break;
    case 6: phase_g(p, layer, smem); break;
    default: phase_h(p, layer, smem); break;
  }
}
constexpr int N_PHASES = 18;

#if ONE_LAUNCH
template <int PH> DI void run_all(const Params& p, unsigned char* smem, cg::grid_group& grid, const XcdBarrier& xb) {
  run_phase(p, PH, smem);
  if constexpr (PH + 1 < N_PHASES) {
    if constexpr (PH == 0) grid.sync(); else xcd_barrier(xb);
    run_all<PH + 1>(p, smem, grid, xb);
  }
}
__global__ void __launch_bounds__(NTHR, 2) mega_kernel(Params p) {
  __shared__ __attribute__((aligned(16))) unsigned char smem[SMEM_BYTES];
  __shared__ uint4 xb_words;
  if (threadIdx.x == 0) xb_words = make_uint4(0u, 0u, 0u, 0u);
  __syncthreads();
  const XcdBarrier xb = xcd_barrier_post((unsigned*)(p.ws + O_BAR), (volatile LAS unsigned*)&xb_words);
  cg::grid_group grid = cg::this_grid();
  run_all<0>(p, smem, grid, xb);
}
#else
template <int PH> __global__ void __launch_bounds__(NTHR, 2) phase_kernel(Params p) {
  __shared__ __attribute__((aligned(16))) unsigned char smem[SMEM_BYTES];
  run_phase(p, PH, smem);
}
template <int PH> static void launch_phases(const Params& p, hipStream_t stream) {
  hipLaunchKernelGGL((phase_kernel<PH>), dim3(256), dim3(NTHR), 0, stream, p);
  if constexpr (PH + 1 < N_PHASES) launch_phases<PH + 1>(p, stream);
}
#endif

extern "C" void kernel_launch(void* const* d_in, const int* in_sizes, int n_in, void* d_out, int out_size, void* d_ws, size_t ws_size, hipStream_t stream) {
  if (ws_size < O_END || n_in < 25) { fprintf(stderr, "workspace too small: %zu < %zu\n", ws_size, (size_t)O_END); return; }
  Params p{};
  p.x = (const float*)d_in[0]; p.pos = (const int*)d_in[1]; p.mix_norm = (const float*)d_in[2]; p.w_in = (const float*)d_in[3]; p.b_forget = (const float*)d_in[4];
  p.pe_k = (const float*)d_in[5]; p.w1_k = (const float*)d_in[6]; p.w2_k = (const float*)d_in[7]; p.pe_v = (const float*)d_in[8]; p.w1_v = (const float*)d_in[9]; p.w2_v = (const float*)d_in[10];
  p.q_norm = (const float*)d_in[11]; p.w_uq = (const float*)d_in[12]; p.kv_norm = (const float*)d_in[13]; p.w_ukv = (const float*)d_in[14];
  p.wbr_nsa = (const float*)d_in[15]; p.wbr_fox = (const float*)d_in[16]; p.wbr_mla = (const float*)d_in[17]; p.w_out = (const float*)d_in[18];
  p.ffn_norm = (const float*)d_in[19]; p.w_up = (const float*)d_in[20]; p.conv_w = (const float*)d_in[21]; p.conv_b = (const float*)d_in[22]; p.w_down = (const float*)d_in[23]; p.final_norm = (const float*)d_in[24];
  p.out = (float*)d_out; p.ws = (unsigned char*)d_ws;
#if ONE_LAUNCH
  static int grid_blocks = 0;
  if (!grid_blocks) {
    int dev = 0, cus = 0, per_cu = 0;
    hipGetDevice(&dev); hipDeviceGetAttribute(&cus, hipDeviceAttributeMultiprocessorCount, dev);
    hipOccupancyMaxActiveBlocksPerMultiprocessor(&per_cu, mega_kernel, NTHR, 0);
    if (per_cu > 1) per_cu = 1;
    grid_blocks = cus * per_cu;
  }
  hipMemsetAsync(p.ws + O_BAR, 0, XCD_BAR_WORDS * 4, stream);
  void* args[] = {&p};
  hipError_t e = hipLaunchCooperativeKernel((void*)mega_kernel, dim3(grid_blocks), dim3(NTHR), args, 0, stream);
  if (e != hipSuccess) fprintf(stderr, "cooperative launch failed: %s (grid %d)\n", hipGetErrorString(e), grid_blocks);
#else
  launch_phases<0>(p, stream);
#endif
}
```

```cpp
#include <hip/hip_runtime.h>
#include <hip/hip_cooperative_groups.h>
#include <stdint.h>
#include <stdio.h>
#include <type_traits>
namespace cg = cooperative_groups;

#ifndef ONE_LAUNCH
#define ONE_LAUNCH 1

#endif

#define DI __device__ __forceinline__
typedef unsigned short bf16_t;
typedef short bf16x8 __attribute__((ext_vector_type(8)));
typedef float f32x4 __attribute__((ext_vector_type(4)));
typedef float f32x16 __attribute__((ext_vector_type(16)));
typedef float f32x2 __attribute__((ext_vector_type(2)));
typedef __bf16 bfx2 __attribute__((ext_vector_type(2)));
typedef unsigned u32x4 __attribute__((ext_vector_type(4)));
typedef unsigned u32x2 __attribute__((ext_vector_type(2)));
typedef unsigned long long u64;

constexpr int T_ = 32768, S_ = 4096, NB_ = 8, D_ = 1024, DFF_ = 2816, NIN_ = 6592;
constexpr float EPS_ = 1e-6f;
constexpr float LOG2E_ = 1.4426950408889634f;
constexpr float QS64_ = 0.125f * LOG2E_;
constexpr float QS96_ = 0.10206207261596577f * LOG2E_;

constexpr size_t W_IN = 0;
constexpr size_t W_G = W_IN + (size_t)3584 * 1024;
constexpr size_t W_1K = W_G + (size_t)3072 * 1024;
constexpr size_t W_1V = W_1K + (size_t)256 * 2048;
constexpr size_t W_2K = W_1V + (size_t)256 * 2048;
constexpr size_t W_2V = W_2K + (size_t)64 * 256;
constexpr size_t W_UQ = W_2V + (size_t)64 * 256;
constexpr size_t W_UKV = W_UQ + (size_t)768 * 384;
constexpr size_t W_BN = W_UKV + (size_t)1024 * 256;
constexpr size_t W_BF = W_BN + (size_t)1024 * 512;
constexpr size_t W_BM = W_BF + (size_t)1024 * 512;
constexpr size_t W_OUT = W_BM + (size_t)1024 * 512;
constexpr size_t W_UP = W_OUT + (size_t)1024 * 1024;
constexpr size_t W_DN = W_UP + (size_t)5632 * 1024;
constexpr size_t W_LAYER = W_DN + (size_t)1024 * 2816;

constexpr size_t al256(size_t x) { return (x + 255) & ~(size_t)255; }
constexpr size_t O_BAR = 0;
constexpr size_t O_W = 16384;
constexpr size_t O_BIAS1 = al256(O_W + 2 * W_LAYER * 2);
constexpr size_t O_ROPE8 = al256(O_BIAS1 + 2 * 2 * 16 * 256 * 4);
constexpr size_t O_ROPE16 = al256(O_ROPE8 + (size_t)T_ * 16 * 4);
constexpr size_t O_XG = al256(O_ROPE16 + (size_t)T_ * 32 * 4);
constexpr size_t O_SSQ = al256(O_XG + (size_t)T_ * 1024 * 2);
constexpr size_t O_CSSQ = al256(O_SSQ + (size_t)T_ * 16 * 4);
constexpr size_t O_NSAQ = al256(O_CSSQ + (size_t)T_ * 16 * 4);
constexpr size_t O_KVCMP = O_NSAQ + (size_t)T_ * 512 * 2;
constexpr size_t O_KSLC = O_KVCMP + (size_t)T_ * 256 * 2;
constexpr size_t O_KWIN = O_KSLC + (size_t)T_ * 128 * 2;
constexpr size_t O_MERGED = O_NSAQ;
constexpr size_t O_VSLCT = O_KWIN + (size_t)T_ * 128 * 2;
constexpr size_t O_VWINT = O_VSLCT + (size_t)T_ * 128 * 2;
constexpr size_t O_FOXQ = O_VWINT + (size_t)T_ * 128 * 2;
constexpr size_t O_FOXK = O_FOXQ + (size_t)T_ * 512 * 2;
constexpr size_t O_FOXVT = O_FOXK + (size_t)T_ * 512 * 2;
constexpr size_t O_MLAQ = O_FOXVT + (size_t)T_ * 512 * 2;
constexpr size_t O_MLAKN = O_MLAQ + (size_t)T_ * 768 * 2;
constexpr size_t O_ACT = O_FOXQ;
constexpr size_t O_MLAVT = O_MLAKN + (size_t)T_ * 512 * 2;
constexpr size_t O_MLAKPE = O_MLAVT + (size_t)T_ * 512 * 2;
constexpr size_t O_ONSA = O_MLAKPE + (size_t)T_ * 32 * 2;
constexpr size_t O_CQ = O_ONSA;
constexpr size_t O_CKV = O_CQ + (size_t)T_ * 384 * 2;
constexpr size_t O_CEND = O_CKV + (size_t)T_ * 256 * 2;
constexpr size_t O_GATES = al256(O_CEND > O_ONSA + (size_t)T_ * 512 * 2 ? O_CEND : O_ONSA + (size_t)T_ * 512 * 2);
constexpr size_t O_LOGF = al256(O_GATES + (size_t)T_ * 24 * 4);
constexpr size_t O_F2 = al256(O_LOGF + (size_t)T_ * 8 * 4);
constexpr size_t O_KC = al256(O_F2 + (size_t)T_ * 8 * 4);
constexpr size_t O_VCT = al256(O_KC + (size_t)NB_ * 2 * 256 * 64 * 2);
constexpr size_t O_SEL = al256(O_VCT + (size_t)NB_ * 2 * 256 * 64 * 2);
constexpr size_t O_END = al256(O_SEL + (size_t)NB_ * 2 * S_ * 8);

struct Params {
  const float* x; const int* pos; const float* mix_norm; const float* w_in; const float* b_forget;
  const float* pe_k; const float* w1_k; const float* w2_k; const float* pe_v; const float* w1_v; const float* w2_v;
  const float* q_norm; const float* w_uq; const float* kv_norm; const float* w_ukv;
  const float* wbr_nsa; const float* wbr_fox; const float* wbr_mla; const float* w_out;
  const float* ffn_norm; const float* w_up; const float* conv_w; const float* conv_b; const float* w_down; const float* final_norm;
  float* out; unsigned char* ws;
};

constexpr int NTHR = 512;
constexpr int SMEM_BYTES = 147456;

DI int TIDX() { int t = (int)threadIdx.x; asm volatile("" : "+v"(t)); return t; }
DI unsigned pk2(float lo, float hi) { f32x2 v = {lo, hi}; return __builtin_bit_cast(unsigned, __builtin_convertvector(v, bfx2)); }
DI bf16_t f2bf(float x) { return (bf16_t)(pk2(x, 0.f) & 0xffffu); }
DI float bf2f(bf16_t h) { return __uint_as_float(((unsigned)h) << 16); }
DI float sigmoidf_(float x) { return 1.f / (1.f + __expf(-x)); }
DI float gelu_tanh(float x) { const float u = 0.7978845608028654f * (x + 0.044715f * x * x * x); return x / (1.f + __expf(-2.f * u)); }
DI float ex2(float x) { return __builtin_amdgcn_exp2f(x); }
DI f32x16 mfma32(bf16x8 a, bf16x8 b, f32x16 c) { return __builtin_amdgcn_mfma_f32_32x32x16_bf16(a, b, c, 0, 0, 0); }
DI f32x4 mfma16(bf16x8 a, bf16x8 b, f32x4 c) { return __builtin_amdgcn_mfma_f32_16x16x32_bf16(a, b, c, 0, 0, 0); }
DI float rstd_from16(const float* p, float inv_n) {
  const f32x4 a = *(const f32x4*)p, b = *(const f32x4*)(p + 4), c = *(const f32x4*)(p + 8), d = *(const f32x4*)(p + 12);
  const float s = ((a[0] + a[1]) + (a[2] + a[3])) + ((b[0] + b[1]) + (b[2] + b[3])) + ((c[0] + c[1]) + (c[2] + c[3])) + ((d[0] + d[1]) + (d[2] + d[3]));
  return rsqrtf(s * inv_n + EPS_);
}

constexpr int LDT = 72;
template <int MI, int NJ> struct GemmLds { static constexpr int BM = 32 * MI, BN = 64 * NJ, A_ELEMS = BM * LDT, B_ELEMS = BN * LDT, STAGE = A_ELEMS + B_ELEMS; };

template <int MI, int NJ, bool SWAP, class AP, class BP>
DI void gemm_main(f32x4 (&acc)[MI][NJ], const AP& ap, int a_kstep, const BP& bp, int b_kstep, int nk, bf16_t* smem) {
  typedef GemmLds<MI, NJ> L;
  constexpr int CA = MI / 2, CB = NJ;
  const int tid = TIDX(), lane = tid & 63, wid = tid >> 6, wm = wid >> 2, wn = wid & 3, l15 = lane & 15, quad = lane >> 4;
  unsigned pa[CA], pb[CB]; bool oka[CA];
#pragma unroll
  for (int i = 0; i < CA; ++i) { const int c = tid + NTHR * i; pa[i] = ap(c >> 3) + (c & 7) * 8; oka[i] = ap.ok(c >> 3); }
#pragma unroll
  for (int i = 0; i < CB; ++i) { const int c = tid + NTHR * i; pb[i] = bp(c >> 3) + (c & 7) * 8; }
  u32x4 ra[CA], rb[CB];
  auto gload = [&](int kt) {
    const bf16_t* ab = ap.base + (size_t)kt * a_kstep; const bf16_t* bb = bp.base + (size_t)kt * b_kstep;
#pragma unroll
    for (int i = 0; i < CA; ++i) ra[i] = *(const u32x4*)(ab + pa[i]);
#pragma unroll
    for (int i = 0; i < CB; ++i) rb[i] = *(const u32x4*)(bb + pb[i]);
  };
  auto sstore = [&](int buf) {
    bf16_t* As = smem + buf * L::STAGE; bf16_t* Bs = As + L::A_ELEMS;
#pragma unroll
    for (int i = 0; i < CA; ++i) { const int c = tid + NTHR * i; *(u32x4*)(As + (c >> 3) * LDT + (c & 7) * 8) = oka[i] ? ra[i] : (u32x4){0u, 0u, 0u, 0u}; }
#pragma unroll
    for (int i = 0; i < CB; ++i) { const int c = tid + NTHR * i; *(u32x4*)(Bs + (c >> 3) * LDT + (c & 7) * 8) = rb[i]; }
  };
  gload(0); sstore(0); __syncthreads();
#pragma unroll 1
  for (int kt = 0; kt < nk; ++kt) {
    const int buf = kt & 1;
    gload(kt + 1 < nk ? kt + 1 : nk - 1);
    __builtin_amdgcn_sched_barrier(0);
    const bf16_t* As = smem + buf * L::STAGE + (wm * 16 * MI + l15) * LDT + quad * 8;
    const bf16_t* Bs = smem + buf * L::STAGE + L::A_ELEMS + (wn * 16 * NJ + l15) * LDT + quad * 8;
#pragma unroll
    for (int ks = 0; ks < 2; ++ks) {
      if (MI * NJ >= 32 && ks == 1) asm volatile("" ::: "memory");
      bf16x8 b[NJ];
#pragma unroll
      for (int j = 0; j < NJ; ++j) b[j] = *(const bf16x8*)(Bs + j * 16 * LDT + ks * 32);
#pragma unroll
      for (int i = 0; i < MI; ++i) {
        const bf16x8 a = *(const bf16x8*)(As + i * 16 * LDT + ks * 32);
#pragma unroll
        for (int j = 0; j < NJ; ++j) acc[i][j] = SWAP ? mfma16(b[j], a, acc[i][j]) : mfma16(a, b[j], acc[i][j]);
      }
    }
    sstore(buf ^ 1);
    __syncthreads();
  }
}
template <int MI, int NJ> DI void zero_acc(f32x4 (&acc)[MI][NJ]) {
#pragma unroll
  for (int i = 0; i < MI; ++i)
#pragma unroll
    for (int j = 0; j < NJ; ++j) acc[i][j] = (f32x4){0.f, 0.f, 0.f, 0.f};
}
struct RowPtr { const bf16_t* base; size_t ld; DI unsigned operator()(int r) const { return (unsigned)r * (unsigned)ld; } DI bool ok(int) const { return true; } };


template <class F> DI void xcd_tiles(int MPX, int NT, F&& body) {
  const int xcd = blockIdx.x & 7, slot = blockIdx.x >> 3, nslots = gridDim.x >> 3, total = MPX * NT;
  for (int li = slot; li < total; li += nslots) {
    const int mg = li / (8 * NT), rem = li - mg * 8 * NT;
    const int gsz = (MPX - mg * 8) < 8 ? (MPX - mg * 8) : 8;
    const int tn = rem / gsz, mi = rem - tn * gsz;
    body(xcd * MPX + mg * 8 + mi, tn);
  }
}

DI int map_col(int map, int n) {
  if (map == 0) return n;
  if (map == 1) {
    if (n < 896) return n;
    if (n < 1024) return 1024 + (n - 896);
    if (n < 1152) return 896 + (n - 1024);
    if (n < 1280) return n;
    if (n < 2816) return 1304 + (n - 1280);
    if (n < 3200) return 2848 + (n - 2816);
    if (n < 3456) return 3232 + (n - 3200);
    const int c = n - 3456;
    if (c < 24) return 1280 + c;
    if (c < 32) return 2840 + (c - 24);
    if (c < 64) return 3488 + (c - 32);
    return -1;
  }
  if (map == 2) { const int j = n >> 8, c = n & 255; return c < 128 ? j * 128 + c : DFF_ + j * 128 + (c - 128); }
  if (map == 3) { return n < 512 ? (n >> 6) * 128 + (n & 63) : ((n - 512) >> 6) * 128 + 64 + ((n - 512) & 63); }
  return n;
}
struct WJob { const float* src; const float* scale; bf16_t* dst; int K, N, ld, map, off; };
DI void prep_weight_tile(const WJob& j, int tile, float* lds) {
  const int ntn = j.N >> 6, tk = tile / ntn, tn = tile % ntn, tid = TIDX();
  const int n4 = (tid & 15) * 4; const int sc = map_col(j.map, tn * 64 + n4);
  f32x4 v[4];
#pragma unroll
  for (int i = 0; i < 4; ++i) {
    const int kk = (tid >> 4) + 32 * i, k = tk * 128 + kk;
    v[i] = sc >= 0 ? *(const f32x4*)(j.src + (size_t)k * j.ld + j.off + sc) : (f32x4){0.f, 0.f, 0.f, 0.f};
    if (j.scale) v[i] = v[i] * j.scale[k];
  }
#pragma unroll
  for (int i = 0; i < 4; ++i) {
    const int kk = (tid >> 4) + 32 * i;
#pragma unroll
    for (int e = 0; e < 4; ++e) lds[kk * 65 + n4 + e] = v[i][e];
  }
  __syncthreads();
  const int nn = tid >> 3, k0 = (tid & 7) * 16;
  unsigned w[8];
#pragma unroll
  for (int e = 0; e < 8; ++e) w[e] = pk2(lds[(k0 + 2 * e) * 65 + nn], lds[(k0 + 2 * e + 1) * 65 + nn]);
  bf16_t* d = j.dst + (size_t)(tn * 64 + nn) * j.K + tk * 128 + k0;
  *(u32x4*)d = (u32x4){w[0], w[1], w[2], w[3]}; *(u32x4*)(d + 8) = (u32x4){w[4], w[5], w[6], w[7]};
  __syncthreads();
}
DI WJob get_wjob(const Params& p, int layer, int id) {
  bf16_t* wl = (bf16_t*)(p.ws + O_W) + (size_t)layer * W_LAYER; WJob j; j.scale = nullptr; j.map = 0; j.off = 0;
  switch (id) {
    case 0: j.src = p.w_in + (size_t)layer * 1024 * NIN_; j.dst = wl + W_IN; j.K = 1024; j.N = 3584; j.ld = NIN_; j.map = 1; break;
    case 1: j.src = p.w_in + (size_t)layer * 1024 * NIN_; j.dst = wl + W_G; j.K = 1024; j.N = 3072; j.ld = NIN_; j.off = 3520; break;
    case 2: j.src = p.w1_k + (size_t)layer * 2048 * 256; j.dst = wl + W_1K; j.K = 2048; j.N = 256; j.ld = 256; break;
    case 3: j.src = p.w1_v + (size_t)layer * 2048 * 256; j.dst = wl + W_1V; j.K = 2048; j.N = 256; j.ld = 256; break;
    case 4: j.src = p.w2_k + (size_t)layer * 256 * 64; j.dst = wl + W_2K; j.K = 256; j.N = 64; j.ld = 64; break;
    case 5: j.src = p.w2_v + (size_t)layer * 256 * 64; j.dst = wl + W_2V; j.K = 256; j.N = 64; j.ld = 64; break;
    case 6: j.src = p.w_uq + (size_t)layer * 384 * 768; j.dst = wl + W_UQ; j.K = 384; j.N = 768; j.ld = 768; j.scale = p.q_norm + layer * 384; break;
    case 7: j.src = p.w_ukv + (size_t)layer * 256 * 1024; j.dst = wl + W_UKV; j.K = 256; j.N = 1024; j.ld = 1024; j.scale = p.kv_norm + layer * 256; j.map = 3; break;
    case 8: j.src = p.wbr_nsa + (size_t)layer * 512 * 1024; j.dst = wl + W_BN; j.K = 512; j.N = 1024; j.ld = 1024; break;
    case 9: j.src = p.wbr_fox + (size_t)layer * 512 * 1024; j.dst = wl + W_BF; j.K = 512; j.N = 1024; j.ld = 1024; break;
    case 10: j.src = p.wbr_mla + (size_t)layer * 512 * 1024; j.dst = wl + W_BM; j.K = 512; j.N = 1024; j.ld = 1024; break;
    case 11: j.src = p.w_out + (size_t)layer * 1024 * 1024; j.dst = wl + W_OUT; j.K = 1024; j.N = 1024; j.ld = 1024; break;
    case 12: j.src = p.w_up + (size_t)layer * 1024 * 5632; j.dst = wl + W_UP; j.K = 1024; j.N = 5632; j.ld = 5632; j.map = 2; break;
    default: j.src = p.w_down + (size_t)layer * 2816 * 1024; j.dst = wl + W_DN; j.K = 2816; j.N = 1024; j.ld = 1024; break;
  }
  return j;
}
constexpr int WTILES_LAYER = (int)(W_LAYER / 8192);
constexpr int P0_XITEMS = T_ / 64;
constexpr int P0_ROPE_ITEMS = T_ / NTHR;
constexpr int P0_ITEMS = 2 * WTILES_LAYER + 64 + P0_ROPE_ITEMS + P0_XITEMS;

DI void xg_rows(const float* x, const float* g, bf16_t* xg, float* ssq, int row0) {
  const int lane = TIDX() & 63, wid = TIDX() >> 6;
  for (int rr = 0; rr < 8; ++rr) {
    const int t = row0 + wid * 8 + rr; const float* xr = x + (size_t)t * D_; float s = 0.f;
#pragma unroll
    for (int c = 0; c < 4; ++c) {
      const int k = c * 256 + lane * 4; const f32x4 v = *(const f32x4*)(xr + k), gv = *(const f32x4*)(g + k);
      s += v[0] * v[0] + v[1] * v[1] + v[2] * v[2] + v[3] * v[3];
      *(u32x2*)(xg + (size_t)t * D_ + k) = (u32x2){pk2(v[0] * gv[0], v[1] * gv[1]), pk2(v[2] * gv[2], v[3] * gv[3])};
    }
#pragma unroll
    for (int o = 32; o >= 1; o >>= 1) s += __shfl_xor(s, o);
    if (lane < 16) ssq[(size_t)t * 16 + lane] = lane == 0 ? s : 0.f;
  }
}
DI void phase_prep(const Params& p, unsigned char* smem) {
  for (int it = blockIdx.x; it < P0_ITEMS; it += gridDim.x) {
    int i = it;
    if (i < 2 * WTILES_LAYER) {
      const int layer = i / WTILES_LAYER; int t = i % WTILES_LAYER; int id = 0;
      for (;; ++id) { const WJob j = get_wjob(p, layer, id); const int nt = (j.K >> 7) * (j.N >> 6); if (t < nt) { prep_weight_tile(j, t, (float*)smem); break; } t -= nt; }
      continue;
    }
    i -= 2 * WTILES_LAYER;
    if (i < 64) {
      const int lk = i >> 4, pc = i & 15, layer = lk >> 1, kv = lk & 1, c = TIDX() & 255, hf = TIDX() >> 8;
      const float* pe = (kv ? p.pe_v : p.pe_k) + (size_t)layer * 2048 + pc * 128 + hf * 64; const float* w1 = (kv ? p.w1_v : p.w1_k) + (size_t)layer * 2048 * 256 + (size_t)(pc * 128 + hf * 64) * 256;
      float sacc = 0.f;
#pragma unroll 8
      for (int kk = 0; kk < 64; ++kk) sacc += pe[kk] * w1[(size_t)kk * 256 + c];
      float* lds = (float*)smem;
      if (hf) lds[c] = sacc;
      __syncthreads();
      if (!hf) ((float*)(p.ws + O_BIAS1))[(lk * 16 + pc) * 256 + c] = sacc + lds[c];
      __syncthreads();
      continue;
    }
    i -= 64;
    if (i < P0_ROPE_ITEMS) {
      const int t = i * NTHR + TIDX(); const float fp = (float)p.pos[t];
      float* r8 = (float*)(p.ws + O_ROPE8) + (size_t)t * 16; float* r16 = (float*)(p.ws + O_ROPE16) + (size_t)t * 32;
      for (int f = 0; f < 24; ++f) {
        const int half = f < 8 ? 8 : 16, idx = f < 8 ? f : f - 8;
        const float inv = exp2f(-(float)idx / (float)half * 18.931568569324174f);
        const float ang = fp * inv;
        const double rev = (double)ang * 0.15915494309189535; const float fr = (float)(rev - floor(rev));
        const float sn = __builtin_amdgcn_sinf(fr), cs = __builtin_amdgcn_cosf(fr);
        if (f < 8) { r8[2 * idx] = cs; r8[2 * idx + 1] = sn; } else { r16[2 * idx] = cs; r16[2 * idx + 1] = sn; }
      }
      continue;
    }
    i -= P0_ROPE_ITEMS;
    xg_rows(p.x, p.mix_norm, (bf16_t*)(p.ws + O_XG), (float*)(p.ws + O_SSQ), i * 64);
  }
}

DI void store4(bf16_t* dst, const f32x4& v, float s) { *(u32x2*)dst = (u32x2){pk2(v[0] * s, v[1] * s), pk2(v[2] * s, v[3] * s)}; }
constexpr int STG_LD = 72, STG_WAVE = 128 * 72;
DI void stage4(bf16_t* stg, int row, int col, const f32x4& v, float s) { *(u32x2*)(stg + row * STG_LD + col) = (u32x2){pk2(v[0] * s, v[1] * s), pk2(v[2] * s, v[3] * s)}; }
template <int ROWS, int COLS, int LD> DI void stage_out(const bf16_t* stg, bf16_t* dst, size_t ld, int lane) {
  asm volatile("s_waitcnt lgkmcnt(0)" ::: "memory");
  constexpr int CPR = COLS / 8, IT = ROWS * CPR / 64;
#pragma unroll
  for (int it = 0; it < IT; ++it) {
    const int idx = it * 64 + lane, r = idx / CPR, c = idx % CPR;
    __builtin_nontemporal_store(*(const u32x4*)(stg + r * LD + c * 8), (u32x4*)(dst + (size_t)r * ld + c * 8));
  }
}
template <bool SWAP> DI void inproj_tile(const Params& p, int layer, int tm, int tn, bf16_t* smem) {
  const bf16_t* wl = (const bf16_t*)(p.ws + O_W) + (size_t)layer * W_LAYER;
  f32x4 acc[8][4]; zero_acc<8, 4>(acc);
  RowPtr ap{(const bf16_t*)(p.ws + O_XG) + (size_t)tm * 256 * D_, (size_t)D_}, bp{wl + W_IN + (size_t)tn * 256 * D_, (size_t)D_};
  gemm_main<8, 4, SWAP>(acc, ap, 64, bp, 64, 16, smem);
  const int lane = TIDX() & 63, wid = TIDX() >> 6, wm = wid >> 2, wn = wid & 3, l15 = lane & 15, quad = lane >> 4;
  const float* ssq = (const float*)(p.ws + O_SSQ);
  bf16_t* stg = smem + wid * STG_WAVE;
  const int trow0 = tm * 256 + wm * 128;
  if constexpr (!SWAP) {
    bf16_t* dst; int hh, hd;
    if (tn == 4) { dst = (bf16_t*)(p.ws + (wn < 2 ? O_VSLCT : O_VWINT)); hh = 2; hd = wn & 1; } else { dst = (bf16_t*)(p.ws + O_FOXVT); hh = 8; hd = (tn - 9) * 4 + wn; }
    constexpr int VLD = 136;
#pragma unroll
    for (int i = 0; i < 8; ++i) {
      const int t0 = trow0 + i * 16 + quad * 4;
      float rs[4];
#pragma unroll
      for (int r = 0; r < 4; ++r) rs[r] = rstd_from16(ssq + (size_t)(t0 + r) * 16, 1.f / 1024.f);
#pragma unroll
      for (int j = 0; j < 4; ++j)
        *(u32x2*)(stg + (j * 16 + l15) * VLD + i * 16 + quad * 4) = (u32x2){pk2(acc[i][j][0] * rs[0], acc[i][j][1] * rs[1]), pk2(acc[i][j][2] * rs[2], acc[i][j][3] * rs[3])};
    }
    const int b = trow0 >> 12, s0 = trow0 & 4095;
    stage_out<64, 128, VLD>(stg, dst + ((size_t)(b * hh + hd) * 64) * S_ + s0, (size_t)S_, lane);
  } else {
    const int slab = tn * 4 + wn;
    if (slab == 54) {
#pragma unroll
      for (int i = 0; i < 8; ++i) {
        const int t = trow0 + i * 16 + l15; const float rs = rstd_from16(ssq + (size_t)t * 16, 1.f / 1024.f);
        float* gt = (float*)(p.ws + O_GATES) + (size_t)t * 24; float* lf = (float*)(p.ws + O_LOGF) + (size_t)t * 8;
#pragma unroll
        for (int r = 0; r < 4; ++r) gt[quad * 4 + r] = sigmoidf_(acc[i][0][r] * rs);
        if (quad < 2) {
#pragma unroll
          for (int r = 0; r < 4; ++r) gt[16 + quad * 4 + r] = sigmoidf_(acc[i][1][r] * rs);
        } else {
#pragma unroll
          for (int r = 0; r < 4; ++r) { const int h = (quad - 2) * 4 + r; const float xx = acc[i][1][r] * rs + p.b_forget[layer * 8 + h]; lf[h] = fminf(xx, 0.f) - log1pf(__expf(-fabsf(xx))); }
        }
        const float* rp = (const float*)(p.ws + O_ROPE16) + (size_t)t * 32 + quad * 8; float o1[4], o2[4];
#pragma unroll
        for (int r = 0; r < 4; ++r) { const float cs = rp[2 * r], sn = rp[2 * r + 1], x1 = acc[i][2][r] * rs, x2 = acc[i][3][r] * rs; o1[r] = x1 * cs - x2 * sn; o2[r] = x2 * cs + x1 * sn; }
        bf16_t* kp = (bf16_t*)(p.ws + O_MLAKPE) + (size_t)t * 32 + quad * 4;
        *(u32x2*)kp = (u32x2){pk2(o1[0], o1[1]), pk2(o1[2], o1[3])}; *(u32x2*)(kp + 16) = (u32x2){pk2(o2[0], o2[1]), pk2(o2[2], o2[3])};
      }
    } else if (slab != 55) {
      bf16_t* dbuf; int dld, dcol, kind = 0; float qs = 1.f; int cslot = 0;
      if (slab < 8) { dbuf = (bf16_t*)(p.ws + O_NSAQ); dld = 512; dcol = slab * 64; qs = QS64_; }
      else if (slab < 12) { dbuf = (bf16_t*)(p.ws + O_KVCMP); dld = 256; dcol = (slab - 8) * 64; }
      else if (slab < 16) { dbuf = (bf16_t*)(p.ws + (slab < 14 ? O_KSLC : O_KWIN)); dld = 128; dcol = (slab & 1) * 64; kind = 1; }
      else if (slab < 28) { dbuf = (bf16_t*)(p.ws + O_FOXQ); dld = 512; dcol = (slab - 20) * 64; qs = QS64_; }
      else if (slab < 36) { dbuf = (bf16_t*)(p.ws + O_FOXK); dld = 512; dcol = (slab - 28) * 64; }
      else if (slab < 50) { dbuf = (bf16_t*)(p.ws + O_CQ); dld = 384; dcol = (slab - 44) * 64; kind = 2; cslot = slab - 44; }
      else { dbuf = (bf16_t*)(p.ws + O_CKV); dld = 256; dcol = (slab - 50) * 64; kind = 2; cslot = 8 + slab - 50; }
#pragma unroll
      for (int i = 0; i < 8; ++i) {
        const int row = i * 16 + l15, t = trow0 + row; const float rs = rstd_from16(ssq + (size_t)t * 16, 1.f / 1024.f) * qs;
        if (kind == 1) {
          const float* rp = (const float*)(p.ws + O_ROPE8) + (size_t)t * 16 + (quad & 1) * 8;
          f32x4 v, o;
#pragma unroll
          for (int r = 0; r < 4; ++r) { v[r] = acc[i][0][r] * rs; o[r] = __shfl_xor(v[r], 32); }
#pragma unroll
          for (int r = 0; r < 4; ++r) { const float cs = rp[2 * r], sn = rp[2 * r + 1]; v[r] = quad < 2 ? v[r] * cs - o[r] * sn : v[r] * cs + o[r] * sn; }
          stage4(stg, row, quad * 4, v, 1.f);
        } else stage4(stg, row, quad * 4, acc[i][0], rs);
#pragma unroll
        for (int j = 1; j < 4; ++j) stage4(stg, row, j * 16 + quad * 4, acc[i][j], rs);
        if (kind == 2) {
          float s = 0.f;
#pragma unroll
          for (int j = 0; j < 4; ++j) { const f32x4 a = acc[i][j] * rs; s += a[0] * a[0] + a[1] * a[1] + a[2] * a[2] + a[3] * a[3]; }
          s += __shfl_xor(s, 16); s += __shfl_xor(s, 32);
          if (quad == 0) ((float*)(p.ws + O_CSSQ))[(size_t)t * 16 + cslot] = s;
        }
      }
      stage_out<128, 64, STG_LD>(stg, dbuf + (size_t)trow0 * dld + dcol, (size_t)dld, lane);
    }
  }
  __syncthreads();
}
DI void phase_inproj(const Params& p, int layer, unsigned char* smem) {
  xcd_tiles(16, 14, [&](int tm, int tn) {
    const bool vt = (tn == 4 || tn == 9 || tn == 10);
    if (vt) inproj_tile<false>(p, layer, tm, tn, (bf16_t*)smem); else inproj_tile<true>(p, layer, tm, tn, (bf16_t*)smem);
  });
}

template <int KIND> DI void mlaup_tile(const Params& p, int layer, int tm, int tn, bf16_t* smem) {
  const bf16_t* wl = (const bf16_t*)(p.ws + O_W) + (size_t)layer * W_LAYER;
  f32x4 acc[8][4]; zero_acc<8, 4>(acc);
  constexpr int K = KIND == 0 ? 384 : 256;
  RowPtr ap{KIND == 0 ? (const bf16_t*)(p.ws + O_CQ) + (size_t)tm * 256 * 384 : (const bf16_t*)(p.ws + O_CKV) + (size_t)tm * 256 * 256, (size_t)K};
  RowPtr bp{KIND == 0 ? wl + W_UQ + (size_t)tn * 256 * 384 : wl + W_UKV + (size_t)(tn - 3) * 256 * 256, (size_t)K};
  gemm_main<8, 4, KIND != 2>(acc, ap, 64, bp, 64, K / 64, smem);
  const int lane = TIDX() & 63, wid = TIDX() >> 6, wm = wid >> 2, wn = wid & 3, l15 = lane & 15, quad = lane >> 4;
  const float* cssq = (const float*)(p.ws + O_CSSQ);
  bf16_t* stg = smem + wid * STG_WAVE; const int trow0 = tm * 256 + wm * 128;
  if constexpr (KIND == 2) {
    bf16_t* dst = (bf16_t*)(p.ws + O_MLAVT); const int h = (tn - 5) * 4 + wn;
    constexpr int VLD = 136;
#pragma unroll
    for (int i = 0; i < 8; ++i) {
      asm volatile("" ::: "memory");
      const int t0 = trow0 + i * 16 + quad * 4; float rs[4];
#pragma unroll
      for (int r = 0; r < 4; ++r) { const float* c = cssq + (size_t)(t0 + r) * 16 + 8; rs[r] = rsqrtf((c[0] + c[1] + c[2] + c[3]) * (1.f / 256.f) + EPS_); }
#pragma unroll
      for (int j = 0; j < 4; ++j)
        *(u32x2*)(stg + (j * 16 + l15) * VLD + i * 16 + quad * 4) = (u32x2){pk2(acc[i][j][0] * rs[0], acc[i][j][1] * rs[1]), pk2(acc[i][j][2] * rs[2], acc[i][j][3] * rs[3])};
    }
    stage_out<64, 128, VLD>(stg, dst + ((size_t)((trow0 >> 12) * 8 + h) * 64) * S_ + (trow0 & 4095), (size_t)S_, lane);
  } else if constexpr (KIND == 1) {
#pragma unroll
    for (int i = 0; i < 8; ++i) {
      asm volatile("" ::: "memory");
      const int row = i * 16 + l15, t = trow0 + row; const float* c = cssq + (size_t)t * 16;
      const float rs = rsqrtf((c[8] + c[9] + c[10] + c[11]) * (1.f / 256.f) + EPS_);
#pragma unroll
      for (int j = 0; j < 4; ++j) stage4(stg, row, j * 16 + quad * 4, acc[i][j], rs);
    }
    stage_out<128, 64, STG_LD>(stg, (bf16_t*)(p.ws + O_MLAKN) + (size_t)trow0 * 512 + (tn - 3) * 256 + wn * 64, (size_t)512, lane);
  } else {
    const int n0 = tn * 256 + wn * 64, ph = n0 % 96;
#pragma unroll
    for (int i = 0; i < 8; ++i) {
      asm volatile("" ::: "memory");
      const int row = i * 16 + l15, t = trow0 + row; const float* c = cssq + (size_t)t * 16;
      const float rs = rsqrtf((c[0] + c[1] + c[2] + c[3] + c[4] + c[5]) * (1.f / 384.f) + EPS_) * QS96_;
      f32x4 v0 = acc[i][0] * rs, v1 = acc[i][1] * rs, v2 = acc[i][2] * rs, v3 = acc[i][3] * rs;
      if (ph != 0) {
        const float* rp = (const float*)(p.ws + O_ROPE16) + (size_t)t * 32 + quad * 8;
        const f32x4 x1 = ph == 64 ? v0 : v2, x2 = ph == 64 ? v1 : v3; f32x4 o1, o2;
#pragma unroll
        for (int r = 0; r < 4; ++r) { const float cs = rp[2 * r], sn = rp[2 * r + 1]; o1[r] = x1[r] * cs - x2[r] * sn; o2[r] = x2[r] * cs + x1[r] * sn; }
        if (ph == 64) { v0 = o1; v1 = o2; } else { v2 = o1; v3 = o2; }
      }
      stage4(stg, row, quad * 4, v0, 1.f); stage4(stg, row, 16 + quad * 4, v1, 1.f); stage4(stg, row, 32 + quad * 4, v2, 1.f); stage4(stg, row, 48 + quad * 4, v3, 1.f);
    }
    stage_out<128, 64, STG_LD>(stg, (bf16_t*)(p.ws + O_MLAQ) + (size_t)trow0 * 768 + n0, (size_t)768, lane);
  }
  __syncthreads();
}
struct CmpRowPtr { const bf16_t* base; int r0;
  DI unsigned operator()(int r) const { int R = r0 + r; if (R >= 4080) R = 0; const int b = R / 510, rem = R - b * 510, n = rem >> 1, g = rem & 1; return (unsigned)(b * S_ + 16 * n) * 256u + g * 64; }
  DI bool ok(int r) const { return r0 + r < 4080; } };
DI void compress_item(const Params& p, int layer, int item, bf16_t* smem) {
  const int kv = item >> 4, tm = item & 15;
  const bf16_t* wl = (const bf16_t*)(p.ws + O_W) + (size_t)layer * W_LAYER;
  f32x4 acc[8][4]; zero_acc<8, 4>(acc);
  CmpRowPtr ap{(const bf16_t*)(p.ws + O_KVCMP) + kv * 128, tm * 256};
  RowPtr bp{wl + (kv ? W_1V : W_1K), (size_t)2048};
  gemm_main<8, 4, true>(acc, ap, 256, bp, 64, 32, smem);
  const int lane = TIDX() & 63, wid = TIDX() >> 6, wm = wid >> 2, wn = wid & 3, l15 = lane & 15, quad = lane >> 4;
  constexpr int LDH = 264; bf16_t* H = smem;
  const float* b1 = (const float*)(p.ws + O_BIAS1) + (size_t)(layer * 2 + kv) * 16 * 256;
#pragma unroll
  for (int j = 0; j < 4; ++j) {
    asm volatile("" ::: "memory");
    f32x4 bv = {0.f, 0.f, 0.f, 0.f};
    for (int pc = 0; pc < 16; ++pc) bv += *(const f32x4*)(b1 + pc * 256 + wn * 64 + j * 16 + quad * 4);
#pragma unroll
    for (int i = 0; i < 8; ++i) {
      const int row = wm * 128 + i * 16 + l15, col = wn * 64 + j * 16 + quad * 4;
      *(u32x2*)(H + row * LDH + col) = (u32x2){pk2(gelu_tanh(acc[i][j][0] + bv[0]), gelu_tanh(acc[i][j][1] + bv[1])), pk2(gelu_tanh(acc[i][j][2] + bv[2]), gelu_tanh(acc[i][j][3] + bv[3]))};
    }
  }
  __syncthreads();
  f32x4 a2[2][4];
#pragma unroll
  for (int i = 0; i < 2; ++i)
#pragma unroll
    for (int j = 0; j < 4; ++j) a2[i][j] = (f32x4){0.f, 0.f, 0.f, 0.f};
  const bf16_t* w2 = wl + (kv ? W_2V : W_2K);
#pragma unroll
  for (int ks = 0; ks < 8; ++ks) {
    bf16x8 a[2], b[4];
#pragma unroll
    for (int i = 0; i < 2; ++i) a[i] = *(const bf16x8*)(H + (wid * 32 + i * 16 + l15) * LDH + ks * 32 + quad * 8);
#pragma unroll
    for (int j = 0; j < 4; ++j) b[j] = *(const bf16x8*)(w2 + (size_t)(j * 16 + l15) * 256 + ks * 32 + quad * 8);
#pragma unroll
    for (int i = 0; i < 2; ++i)
#pragma unroll
      for (int j = 0; j < 4; ++j) a2[i][j] = mfma16(a[i], b[j], a2[i][j]);
  }
  bf16_t* kc = (bf16_t*)(p.ws + O_KC); bf16_t* vct = (bf16_t*)(p.ws + O_VCT);
#pragma unroll
  for (int i = 0; i < 2; ++i)
#pragma unroll
    for (int r = 0; r < 4; ++r) {
      const int R = tm * 256 + wid * 32 + i * 16 + quad * 4 + r;
      if (R < 4080) {
        const int b = R / 510, rem = R - b * 510, n = rem >> 1, g = rem & 1;
#pragma unroll
        for (int j = 0; j < 4; ++j) {
          const int d = j * 16 + l15; const bf16_t v = f2bf(a2[i][j][r]);
          if (kv == 0) kc[((size_t)(b * 2 + g) * 256 + n) * 64 + d] = v; else vct[((size_t)(b * 2 + g) * 64 + d) * 256 + n] = v;
        }
      }
    }
  __syncthreads();
}
DI void foxscan_item(const Params& p, int item, float* lds) {
  const int b = item >> 3, h = item & 7, tid = TIDX();
  const float* lf = (const float*)(p.ws + O_LOGF) + (size_t)b * S_ * 8 + h; float v[8]; float s = 0.f;
#pragma unroll
  for (int i = 0; i < 8; ++i) { s += lf[(size_t)(tid * 8 + i) * 8]; v[i] = s; }
  lds[tid] = s; __syncthreads();
  float off = 0.f;
  for (int i = 0; i < tid; ++i) off += lds[i];
  float* F2 = (float*)(p.ws + O_F2) + (size_t)(b * 8 + h) * S_ + tid * 8;
#pragma unroll
  for (int i = 0; i < 8; ++i) F2[i] = -(off + v[i]) * LOG2E_;
  __syncthreads();
}
DI void phase_b(const Params& p, int layer, unsigned char* smem) {
  for (int it = blockIdx.x; it < 96; it += gridDim.x) {
    if (it < 32) compress_item(p, layer, it, (bf16_t*)smem);
    else foxscan_item(p, it - 32, (float*)smem);
  }
  xcd_tiles(16, 7, [&](int tm, int tn) {
    if (tn >= 5) mlaup_tile<2>(p, layer, tm, tn, (bf16_t*)smem); else if (tn >= 3) mlaup_tile<1>(p, layer, tm, tn, (bf16_t*)smem); else mlaup_tile<0>(p, layer, tm, tn, (bf16_t*)smem);
  });
}

constexpr int KC_LD = 72, VC_LD = 264;
DI void cmp_item(const Params& p, int item, unsigned char* smem_) {
  const int b = item >> 6, g = (item >> 5) & 1, tt = item & 31, t0 = tt * 128;
  const int tid = TIDX(), lane = tid & 63, wid = tid >> 6, l15 = lane & 15, quad = lane >> 4;
  bf16_t* kcs = (bf16_t*)smem_;
  bf16_t* vcs = kcs + 256 * KC_LD;
  float* imps = (float*)smem_;
  const int nmax = (t0 + 96) >> 4;
  const int nsub = (nmax >> 4) + 1;
  {
    const bf16_t* kcg = (const bf16_t*)(p.ws + O_KC) + (size_t)(b * 2 + g) * 256 * 64; const bf16_t* vcg = (const bf16_t*)(p.ws + O_VCT) + (size_t)(b * 2 + g) * 64 * 256;
    const int nrows = ((nsub + 1) & ~1) * 16;
    for (int e = tid; e < nrows * 8; e += NTHR) {
      const int n = e >> 3, dc = (e & 7) * 8;
      *(u32x4*)(kcs + n * KC_LD + dc) = n < 255 ? *(const u32x4*)(kcg + (size_t)n * 64 + dc) : (u32x4){0u, 0u, 0u, 0u};
    }
    const int ncs = nrows >> 3;
    for (int e = tid; e < 64 * ncs; e += NTHR) {
      const int d = e / ncs, nc = (e - d * ncs) * 8;
      u32x4 v = *(const u32x4*)(vcg + (size_t)d * 256 + nc);
      if (nc + 8 > 255) v[3] &= 0x0000ffffu;
      *(u32x4*)(vcs + d * VC_LD + nc) = v;
    }
  }
  __syncthreads();
  const int tq = t0 + wid * 16 + l15;
  const size_t trow = (size_t)b * S_ + tq;
  float impa[16], p3a[16];
#pragma unroll
  for (int s = 0; s < 16; ++s) { impa[s] = 0.f; p3a[s] = 0.f; }
  const float* gts = (const float*)(p.ws + O_GATES) + trow * 24;
#pragma unroll 1
  for (int r4 = 0; r4 < 4; ++r4) {
    const int head = g * 4 + r4;
    const bf16_t* qp = (const bf16_t*)(p.ws + O_NSAQ) + trow * 512 + head * 64 + quad * 8;
    const bf16x8 q0 = *(const bf16x8*)qp, q1 = *(const bf16x8*)(qp + 32);
    auto score = [&](int s) -> f32x4 {
      const bf16_t* kr = kcs + (s * 16 + l15) * KC_LD + quad * 8;
      f32x4 a = {0.f, 0.f, 0.f, 0.f};
      a = mfma16(*(const bf16x8*)kr, q0, a); a = mfma16(*(const bf16x8*)(kr + 32), q1, a);
#pragma unroll
      for (int r = 0; r < 4; ++r) { const int n = s * 16 + quad * 4 + r; a[r] = (16 * n + 31 <= tq) ? a[r] : -INFINITY; }
      return a;
    };
    float mx = -INFINITY;
#pragma unroll 1
    for (int s = 0; s < nsub; ++s) { const f32x4 a = score(s); mx = fmaxf(mx, fmaxf(fmaxf(a[0], a[1]), fmaxf(a[2], a[3]))); }
    mx = fmaxf(mx, __shfl_xor(mx, 16)); mx = fmaxf(mx, __shfl_xor(mx, 32));
    if (mx == -INFINITY) mx = 0.f;
    float sum = 0.f;
#pragma unroll 1
    for (int s = 0; s < nsub; ++s) { const f32x4 a = score(s); sum += (ex2(a[0] - mx) + ex2(a[1] - mx)) + (ex2(a[2] - mx) + ex2(a[3] - mx)); }
    sum += __shfl_xor(sum, 16); sum += __shfl_xor(sum, 32);
    const float inv = 1.f / fmaxf(sum, 1e-30f);
    f32x4 oacc[4];
#pragma unroll
    for (int j = 0; j < 4; ++j) oacc[j] = (f32x4){0.f, 0.f, 0.f, 0.f};
#pragma unroll
    for (int c = 0; c < 8; ++c) {
      asm volatile("" ::: "memory");
      if (2 * c < nsub) {
        f32x4 pa = score(2 * c), pb = {-INFINITY, -INFINITY, -INFINITY, -INFINITY};
        if (2 * c + 1 < nsub) pb = score(2 * c + 1);
#pragma unroll
        for (int r = 0; r < 4; ++r) { pa[r] = ex2(pa[r] - mx) * inv; pb[r] = ex2(pb[r] - mx) * inv; }
        impa[2 * c] += pa[0] + pa[1] + pa[2] + 0.5f * pa[3]; p3a[2 * c] += pa[3];
        impa[2 * c + 1] += pb[0] + pb[1] + pb[2] + 0.5f * pb[3]; p3a[2 * c + 1] += pb[3];
        const u32x4 pw = {pk2(pa[0], pa[1]), pk2(pa[2], pa[3]), pk2(pb[0], pb[1]), pk2(pb[2], pb[3])};
        const bf16x8 pf = __builtin_bit_cast(bf16x8, pw);
#pragma unroll
        for (int j = 0; j < 4; ++j) {
          const bf16_t* vr = vcs + (j * 16 + l15) * VC_LD + c * 32 + quad * 4;
          const u32x2 lo = *(const u32x2*)vr, hi = *(const u32x2*)(vr + 16);
          const u32x4 vw = {lo[0], lo[1], hi[0], hi[1]};
          oacc[j] = mfma16(__builtin_bit_cast(bf16x8, vw), pf, oacc[j]);
        }
      }
    }
    const float g0 = gts[head * 3 + 0];
    bf16_t* op = (bf16_t*)(p.ws + O_ONSA) + trow * 512 + head * 64 + quad * 4;
#pragma unroll
    for (int j = 0; j < 4; ++j) store4(op + j * 16, oacc[j], g0);
  }
  __syncthreads();
  float* myimp = imps + wid * 1024 + l15 * 64;
  const int cur = tq >> 6;
#pragma unroll
  for (int s = 0; s < 16; ++s) {
    const float up = __shfl(p3a[s], (lane + 48) & 63);
    const float up0 = s ? __shfl(p3a[s ? s - 1 : 0], (lane + 48) & 63) : 0.f;
    const float prev = quad ? up : up0;
    float v = impa[s] + 0.5f * prev;
    const int j = 4 * s + quad;
    if (j == 0 || j == cur || j == cur - 1) v = 1e9f; else if (j > cur) v = -1e9f;
    myimp[j] = v;
  }
  __syncthreads();
  u64* sel = (u64*)(p.ws + O_SEL) + (size_t)(b * 2 + g) * S_ + t0 + wid * 16;
#pragma unroll 1
  for (int q = 0; q < 16; ++q) {
    const float mine = imps[wid * 1024 + q * 64 + lane]; int rank = 0;
#pragma unroll
    for (int i = 0; i < 64; ++i) { const float v = __uint_as_float(__builtin_amdgcn_readlane(__float_as_uint(mine), i)); rank += (v > mine || (v == mine && i < lane)) ? 1 : 0; }
    const u64 m = __ballot(rank < 16);
    if (lane == 0) sel[q] = m;
  }
  __syncthreads();
}
constexpr int PC_ITEMS = NB_ * 2 * 32;
DI void phase_c(const Params& p, unsigned char* smem) { for (int it = blockIdx.x; it < PC_ITEMS; it += gridDim.x) cmp_item(p, it, smem); }

enum { M_FOX = 0, M_MLA = 1, M_WIN = 2, M_SLC = 3 };
template <int MODE> struct ACfg { static constexpr int DQK = MODE == M_MLA ? 96 : 64, KLD = DQK + 8, NKC = DQK / 8 * 64, KCH = (NKC + NTHR - 1) / NTHR, K_ELEMS = 64 * KLD, V_ELEMS = 64 * 72, STAGE = K_ELEMS + V_ELEMS + 128; };
struct AState { f32x16 o[2]; f32x16 mr; float m, l; };

template <int MODE>
DI void flash_pass(AState& st, const bf16x8* qf, u64 tmask, u64 wmask,
                   const bf16_t* kbase, size_t kld, const bf16_t* kpe, const bf16_t* vtbase, const float* fbias,
                   int tq, u64 mysel, bf16_t* smem) {
  typedef ACfg<MODE> C;
  const int tid = TIDX(), lane = tid & 63, l31 = lane & 31, half = lane >> 5;
  u32x4 rk[C::KCH], rv; float rf = 0.f;
  auto gload = [&](int j) {
    const int k0 = j * 64;
#pragma unroll
    for (int i = 0; i < C::KCH; ++i) {
      const int c = tid + NTHR * i;
      if (c < C::NKC) {
        if constexpr (MODE == M_MLA) { const int key = c / 12, dc = c % 12; rk[i] = dc < 8 ? *(const u32x4*)(kbase + (size_t)(k0 + key) * kld + dc * 8) : *(const u32x4*)(kpe + (size_t)(k0 + key) * 32 + (dc - 8) * 8); }
        else { const int key = c >> 3, dc = c & 7; rk[i] = *(const u32x4*)(kbase + (size_t)(k0 + key) * kld + dc * 8); }
      }
    }
    { const int d = tid >> 3, kc = tid & 7; rv = *(const u32x4*)(vtbase + (size_t)d * S_ + k0 + kc * 8); }
    if constexpr (MODE == M_FOX) { if (tid < 64) rf = fbias[k0 + tid]; }
  };
  auto sstore = [&](int buf) {
    bf16_t* Ks = smem + buf * C::STAGE; bf16_t* Vs = Ks + C::K_ELEMS;
#pragma unroll
    for (int i = 0; i < C::KCH; ++i) {
      const int c = tid + NTHR * i;
      if (c < C::NKC) {
        if constexpr (MODE == M_MLA) { const int key = c / 12, dc = c % 12; *(u32x4*)(Ks + key * C::KLD + dc * 8) = rk[i]; }
        else { const int key = c >> 3, dc = c & 7; *(u32x4*)(Ks + key * C::KLD + dc * 8) = rk[i]; }
      }
    }
    {
      const int d = tid >> 3, kc = tid & 7, cgp = kc >> 1, a = kc & 1;
      bf16_t* dst = Vs + d * 72 + cgp * 16 + 4 * a;
      *(u32x2*)dst = (u32x2){rv[0], rv[1]}; *(u32x2*)(dst + 8) = (u32x2){rv[2], rv[3]};
    }
    if constexpr (MODE == M_FOX) { if (tid < 64) ((float*)(Vs + C::V_ELEMS))[tid] = rf; }
  };
  u64 tm = tmask;
  if (tm == 0) return;
  int j = __builtin_ctzll(tm); tm &= tm - 1;
  gload(j); sstore(0); __syncthreads();
  int buf = 0;
  const int tmin = __builtin_amdgcn_readfirstlane(tq - l31), tmax = tmin + 31;
  while (true) {
    const int jn = tm ? __builtin_ctzll(tm) : -1; if (tm) tm &= tm - 1;
    if (jn >= 0) gload(jn);
    bool active = (wmask >> j) & 1;
    if constexpr (MODE == M_SLC) active = active && __any((mysel >> j) & 1);
    if (active) {
      const bf16_t* Ks = smem + buf * C::STAGE; const bf16_t* Vs = Ks + C::K_ELEMS;
      f32x16 s0 = st.mr, s1 = st.mr;
      const bf16_t* kr = Ks + l31 * C::KLD + half * 8;
#pragma unroll
      for (int ks = 0; ks < C::DQK / 16; ++ks) {
        s0 = mfma32(*(const bf16x8*)(kr + ks * 16), qf[ks], s0);
        s1 = mfma32(*(const bf16x8*)(kr + 32 * C::KLD + ks * 16), qf[ks], s1);
      }
      const int k0 = j * 64;
      if constexpr (MODE == M_FOX) {
        const float* fb = (const float*)(Vs + C::V_ELEMS) + 4 * half;
#pragma unroll
        for (int g4 = 0; g4 < 4; ++g4) {
          const f32x4 b0 = *(const f32x4*)(fb + 8 * g4), b1 = *(const f32x4*)(fb + 32 + 8 * g4);
#pragma unroll
          for (int r = 0; r < 4; ++r) { s0[4 * g4 + r] += b0[r]; s1[4 * g4 + r] += b1[r]; }
        }
      }
      bool need = k0 + 63 > tmin;
      if constexpr (MODE == M_WIN) need = need || (k0 <= tmax - 512);
      if constexpr (MODE == M_SLC) {
        if (!need) {
          const bool rsel = ((mysel >> j) & 1) != 0;
          if (!__all(rsel)) {
#pragma unroll
            for (int r = 0; r < 16; ++r) { s0[r] = rsel ? s0[r] : -INFINITY; s1[r] = rsel ? s1[r] : -INFINITY; }
          }
        }
      }
      if (need) {
        const bool rowok = MODE == M_SLC ? ((mysel >> j) & 1) != 0 : true;
#pragma unroll
        for (int r = 0; r < 16; ++r) {
          const int key = k0 + (r & 3) + 8 * (r >> 2) + 4 * half;
          bool ok0 = rowok && key <= tq, ok1 = rowok && key + 32 <= tq;
          if constexpr (MODE == M_WIN) { ok0 = ok0 && (tq - key < 512); ok1 = ok1 && (tq - key - 32 < 512); }
          s0[r] = ok0 ? s0[r] : -INFINITY; s1[r] = ok1 ? s1[r] : -INFINITY;
        }
      }
      int im = (int)0x80000000;
#pragma unroll
      for (int r = 0; r < 16; ++r) im = max(im, max(__float_as_int(s0[r]), __float_as_int(s1[r])));
      im = max(im, __shfl_xor(im, 32));
      constexpr int TBITS = 0x41200000;
      if (__any(im > TBITS)) {
        const float d = im > TBITS ? __int_as_float(im) : 0.f;
        const float a = ex2(-d);
#pragma unroll
        for (int r = 0; r < 16; ++r) { s0[r] -= d; s1[r] -= d; st.o[0][r] *= a; st.o[1][r] *= a; }
        st.l *= a; st.m += d;
#pragma unroll
        for (int r = 0; r < 16; ++r) st.mr[r] = -st.m;
      }
      float sum = 0.f;
#pragma unroll
      for (int r = 0; r < 16; ++r) { s0[r] = ex2(s0[r]); s1[r] = ex2(s1[r]); sum += s0[r] + s1[r]; }
      st.l += sum;
      const bf16_t* vr = Vs + l31 * 72 + half * 8;
#pragma unroll
      for (int c = 0; c < 4; ++c) {
        u32x4 pw;
        if (c < 2) pw = (u32x4){pk2(s0[8 * c + 0], s0[8 * c + 1]), pk2(s0[8 * c + 2], s0[8 * c + 3]), pk2(s0[8 * c + 4], s0[8 * c + 5]), pk2(s0[8 * c + 6], s0[8 * c + 7])};
        else pw = (u32x4){pk2(s1[8 * (c - 2) + 0], s1[8 * (c - 2) + 1]), pk2(s1[8 * (c - 2) + 2], s1[8 * (c - 2) + 3]), pk2(s1[8 * (c - 2) + 4], s1[8 * (c - 2) + 5]), pk2(s1[8 * (c - 2) + 6], s1[8 * (c - 2) + 7])};
        const bf16x8 pf = __builtin_bit_cast(bf16x8, pw);
        st.o[0] = mfma32(*(const bf16x8*)(vr + c * 16), pf, st.o[0]);
        st.o[1] = mfma32(*(const bf16x8*)(vr + 32 * 72 + c * 16), pf, st.o[1]);
      }
    }
    if (jn >= 0) sstore(buf ^ 1);
    __syncthreads();
    if (jn < 0) break;
    j = jn; buf ^= 1;
  }
}
DI void astate_init(AState& s) {
#pragma unroll
  for (int r = 0; r < 16; ++r) { s.o[0][r] = 0.f; s.o[1][r] = 0.f; }
#pragma unroll
  for (int r = 0; r < 16; ++r) s.mr[r] = 0.f;
  s.m = 0.f; s.l = 0.f;
}
DI u64 lowbits(int n) { return n >= 64 ? ~0ull : ((1ull << n) - 1ull); }

template <int MODE> DI void dense_attn_item(const Params& p, int b, int h, int qt, bf16_t* smem) {
  const int lane = TIDX() & 63, wid = TIDX() >> 6, l31 = lane & 31, half = lane >> 5;
  const int t0 = qt * 256, tq = t0 + wid * 32 + l31; const size_t trow = (size_t)b * S_ + tq;
  constexpr int NQ = ACfg<MODE>::DQK / 16;
  bf16x8 qf[NQ];
  const bf16_t* qp = MODE == M_FOX ? (const bf16_t*)(p.ws + O_FOXQ) + trow * 512 + h * 64 : (const bf16_t*)(p.ws + O_MLAQ) + trow * 768 + h * 96;
#pragma unroll
  for (int ks = 0; ks < NQ; ++ks) qf[ks] = *(const bf16x8*)(qp + ks * 16 + half * 8);
  AState st; astate_init(st);
  const u64 tmask = lowbits(4 * qt + 4), wmask = lowbits(((t0 + wid * 32 + 31) >> 6) + 1);
  if constexpr (MODE == M_FOX)
    flash_pass<M_FOX>(st, qf, tmask, wmask, (const bf16_t*)(p.ws + O_FOXK) + (size_t)b * S_ * 512 + h * 64, 512, nullptr,
                      (const bf16_t*)(p.ws + O_FOXVT) + (size_t)(b * 8 + h) * 64 * S_, (const float*)(p.ws + O_F2) + (size_t)(b * 8 + h) * S_, tq, 0ull, smem);
  else
    flash_pass<M_MLA>(st, qf, tmask, wmask, (const bf16_t*)(p.ws + O_MLAKN) + (size_t)b * S_ * 512 + h * 64, 512, (const bf16_t*)(p.ws + O_MLAKPE) + (size_t)b * S_ * 32,
                      (const bf16_t*)(p.ws + O_MLAVT) + (size_t)(b * 8 + h) * 64 * S_, nullptr, tq, 0ull, smem);
  const float l = st.l + __shfl_xor(st.l, 32), inv = 1.f / fmaxf(l, 1e-30f);
  bf16_t* op = (bf16_t*)qp;
#pragma unroll
  for (int dt = 0; dt < 2; ++dt)
#pragma unroll
    for (int g4 = 0; g4 < 4; ++g4) {
      const int d = dt * 32 + g4 * 8 + half * 4;
      *(u32x2*)(op + d) = (u32x2){pk2(st.o[dt][4 * g4] * inv, st.o[dt][4 * g4 + 1] * inv), pk2(st.o[dt][4 * g4 + 2] * inv, st.o[dt][4 * g4 + 3] * inv)};
    }
}
DI void nsa_attn_item(const Params& p, int b, int g, int qt, bf16_t* smem) {
  const int lane = TIDX() & 63, wid = TIDX() >> 6, l31 = lane & 31, half = lane >> 5;
  const int t0 = qt * 64, tw0 = t0 + (wid >> 2) * 32, tq = tw0 + l31, head = g * 4 + (wid & 3); const size_t trow = (size_t)b * S_ + tq;
  bf16x8 qf[4];
  const bf16_t* qp = (const bf16_t*)(p.ws + O_NSAQ) + trow * 512 + head * 64;
#pragma unroll
  for (int ks = 0; ks < 4; ++ks) qf[ks] = *(const bf16x8*)(qp + ks * 16 + half * 8);
  {
    const float* rp = (const float*)(p.ws + O_ROPE8) + trow * 16;
    u32x4 me = __builtin_bit_cast(u32x4, qf[0]), ot;
#pragma unroll
    for (int e = 0; e < 4; ++e) ot[e] = __shfl_xor(me[e], 32);
    unsigned res[4];
#pragma unroll
    for (int e = 0; e < 4; ++e) {
      float o2[2];
#pragma unroll
      for (int u = 0; u < 2; ++u) {
        const int f = 2 * e + u; const float cs = rp[2 * f], sn = rp[2 * f + 1];
        const float a = bf2f((bf16_t)(u ? me[e] >> 16 : me[e] & 0xffffu)), o = bf2f((bf16_t)(u ? ot[e] >> 16 : ot[e] & 0xffffu));
        o2[u] = half == 0 ? a * cs - o * sn : a * cs + o * sn;
      }
      res[e] = pk2(o2[0], o2[1]);
    }
    qf[0] = __builtin_bit_cast(bf16x8, (u32x4){res[0], res[1], res[2], res[3]});
  }
  const float* gts = (const float*)(p.ws + O_GATES) + trow * 24 + head * 3;
  const int cur = t0 >> 6;
  f32x16 res[2];
  {
    AState st; astate_init(st);
    const int first = t0 >= 511 ? (t0 - 511) >> 6 : 0, firstw = tw0 >= 511 ? (tw0 - 511) >> 6 : 0;
    const u64 tmask = lowbits(cur + 1) & ~lowbits(first), wmask = lowbits(cur + 1) & ~lowbits(firstw);
    flash_pass<M_WIN>(st, qf, tmask, wmask, (const bf16_t*)(p.ws + O_KWIN) + (size_t)b * S_ * 128 + g * 64, 128, nullptr,
                      (const bf16_t*)(p.ws + O_VWINT) + (size_t)(b * 2 + g) * 64 * S_, nullptr, tq, 0ull, smem);
    const float l = st.l + __shfl_xor(st.l, 32), sc = gts[2] / fmaxf(l, 1e-30f);
#pragma unroll
    for (int r = 0; r < 16; ++r) { res[0][r] = st.o[0][r] * sc; res[1][r] = st.o[1][r] * sc; }
  }
  {
    AState st; astate_init(st);
    const u64* selp = (const u64*)(p.ws + O_SEL) + (size_t)(b * 2 + g) * S_;
    const u64 mysel = selp[tq];
    const u64 m64 = selp[t0 + lane];
    unsigned lo = (unsigned)m64, hi = (unsigned)(m64 >> 32);
#pragma unroll
    for (int o = 32; o >= 1; o >>= 1) { lo |= __shfl_xor(lo, o); hi |= __shfl_xor(hi, o); }
    const u64 um = (((u64)(unsigned)__builtin_amdgcn_readfirstlane(hi) << 32) | (u64)(unsigned)__builtin_amdgcn_readfirstlane(lo)) & lowbits(cur + 1);
    flash_pass<M_SLC>(st, qf, um, um, (const bf16_t*)(p.ws + O_KSLC) + (size_t)b * S_ * 128 + g * 64, 128, nullptr,
                      (const bf16_t*)(p.ws + O_VSLCT) + (size_t)(b * 2 + g) * 64 * S_, nullptr, tq, mysel, smem);
    const float l = st.l + __shfl_xor(st.l, 32), sc = gts[1] / fmaxf(l, 1e-30f);
#pragma unroll
    for (int r = 0; r < 16; ++r) { res[0][r] += st.o[0][r] * sc; res[1][r] += st.o[1][r] * sc; }
  }
  bf16_t* op = (bf16_t*)(p.ws + O_ONSA) + trow * 512 + head * 64;
#pragma unroll
  for (int dt = 0; dt < 2; ++dt)
#pragma unroll
    for (int g4 = 0; g4 < 4; ++g4) {
      const int d = dt * 32 + g4 * 8 + half * 4;
      const u32x2 oc = *(const u32x2*)(op + d);
      const float c0 = bf2f((bf16_t)(oc[0] & 0xffffu)), c1 = bf2f((bf16_t)(oc[0] >> 16)), c2 = bf2f((bf16_t)(oc[1] & 0xffffu)), c3 = bf2f((bf16_t)(oc[1] >> 16));
      *(u32x2*)(op + d) = (u32x2){pk2(res[dt][4 * g4] + c0, res[dt][4 * g4 + 1] + c1), pk2(res[dt][4 * g4 + 2] + c2, res[dt][4 * g4 + 3] + c3)};
    }
}
constexpr int PD_ITEMS = 16 * 192;
DI void phase_d(const Params& p, unsigned char* smem) {
  for (int it = blockIdx.x; it < PD_ITEMS; it += gridDim.x) {
    const int r = it / 192, w = it % 192, qt = 15 - r;
    if (w < 64) dense_attn_item<M_MLA>(p, w >> 3, w & 7, qt, (bf16_t*)smem);
    else if (w < 128) dense_attn_item<M_FOX>(p, (w - 64) >> 3, (w - 64) & 7, qt, (bf16_t*)smem);
    else { const int i = w - 128, bg = i & 15, q4 = i >> 4; nsa_attn_item(p, bg >> 1, bg & 1, qt * 4 + q4, (bf16_t*)smem); }
  }
}

DI void merge_tile(const Params& p, int layer, int tm, int tn, bf16_t* smem) {
  typedef GemmLds<4, 2> L;
  const bf16_t* wl = (const bf16_t*)(p.ws + O_W) + (size_t)layer * W_LAYER;
  const int tid = TIDX(), lane = tid & 63, wid = tid >> 6, wm = wid >> 2, wn = wid & 3, l15 = lane & 15, quad = lane >> 4;
  f32x4 mg[4][2]; zero_acc<4, 2>(mg);
  f32x4 acc[4][2]; zero_acc<4, 2>(acc);
  unsigned* gsp = (unsigned*)((unsigned char*)smem + 2 * L::STAGE * 2) + tid;
  const bf16_t* la; const bf16_t* lb; unsigned lald, lbld; int laks, lnk;
  auto get_seg = [&](int sg) {
    const int br = sg >> 1;
    if ((sg & 1) == 0) { la = (const bf16_t*)(p.ws + O_XG) + (size_t)tm * 128 * D_; lald = D_; laks = 64; lb = wl + W_G + ((size_t)br * 1024 + tn * 128) * D_; lbld = D_; lnk = 16; }
    else {
      lald = br == 2 ? 768u : 512u; laks = br == 2 ? 96 : 64; lnk = 8; lbld = 512u;
      la = (const bf16_t*)(p.ws + (br == 0 ? O_ONSA : br == 1 ? O_FOXQ : O_MLAQ)) + (size_t)tm * 128 * lald;
      lb = wl + (br == 0 ? W_BN : br == 1 ? W_BF : W_BM) + (size_t)tn * 128 * 512;
    }
  };
  unsigned pa[2], pb[2]; u32x4 ra[2], rb[2];
  auto set_offsets = [&]() {
#pragma unroll
    for (int i = 0; i < 2; ++i) { const int c = tid + NTHR * i; pa[i] = (unsigned)(c >> 3) * lald + (c & 7) * 8; pb[i] = (unsigned)(c >> 3) * lbld + (c & 7) * 8; }
  };
  int ls = 0, lkt = 0;
  get_seg(0); set_offsets();
  auto gload_next = [&]() {
    const bf16_t* ab = la + (size_t)lkt * laks; const bf16_t* bb = lb + (size_t)lkt * 64;
#pragma unroll
    for (int i = 0; i < 2; ++i) { ra[i] = *(const u32x4*)(ab + pa[i]); rb[i] = *(const u32x4*)(bb + pb[i]); }
    if (++lkt == lnk) {
      if (ls + 1 < 6) { ++ls; lkt = 0; get_seg(ls); set_offsets(); } else lkt = lnk - 1;
    }
  };
  auto sstore = [&](int buf) {
    bf16_t* As = smem + buf * L::STAGE; bf16_t* Bs = As + L::A_ELEMS;
#pragma unroll
    for (int i = 0; i < 2; ++i) { const int c = tid + NTHR * i; *(u32x4*)(As + (c >> 3) * LDT + (c & 7) * 8) = ra[i]; *(u32x4*)(Bs + (c >> 3) * LDT + (c & 7) * 8) = rb[i]; }
  };
  gload_next(); sstore(0); __syncthreads();
  int buf = 0;
#pragma unroll 1
  for (int sg = 0; sg < 6; ++sg) {
    const int nk = (sg & 1) ? 8 : 16;
#pragma unroll 1
    for (int kt = 0; kt < nk; ++kt) {
      gload_next();
      __builtin_amdgcn_sched_barrier(0);
      const bf16_t* As = smem + buf * L::STAGE + (wm * 64 + l15) * LDT + quad * 8;
      const bf16_t* Bs = smem + buf * L::STAGE + L::A_ELEMS + (wn * 32 + l15) * LDT + quad * 8;
#pragma unroll
      for (int ks = 0; ks < 2; ++ks) {
        bf16x8 b[2];
#pragma unroll
        for (int j = 0; j < 2; ++j) b[j] = *(const bf16x8*)(Bs + j * 16 * LDT + ks * 32);
#pragma unroll
        for (int i = 0; i < 4; ++i) {
          const bf16x8 a = *(const bf16x8*)(As + i * 16 * LDT + ks * 32);
#pragma unroll
          for (int j = 0; j < 2; ++j) acc[i][j] = mfma16(b[j], a, acc[i][j]);
        }
      }
      sstore(buf ^ 1);
      __syncthreads();
      buf ^= 1;
    }
    if ((sg & 1) == 0) {
#pragma unroll
      for (int i = 0; i < 4; ++i) {
        const float rs = rstd_from16((const float*)(p.ws + O_SSQ) + (size_t)(tm * 128 + wm * 64 + i * 16 + l15) * 16, 1.f / 1024.f);
#pragma unroll
        for (int j = 0; j < 2; ++j) {
          gsp[((i * 2 + j) * 2 + 0) * NTHR] = pk2(sigmoidf_(acc[i][j][0] * rs), sigmoidf_(acc[i][j][1] * rs));
          gsp[((i * 2 + j) * 2 + 1) * NTHR] = pk2(sigmoidf_(acc[i][j][2] * rs), sigmoidf_(acc[i][j][3] * rs));
        }
      }
    } else {
#pragma unroll
      for (int i = 0; i < 4; ++i)
#pragma unroll
        for (int j = 0; j < 2; ++j) {
          const unsigned w0 = gsp[((i * 2 + j) * 2 + 0) * NTHR], w1 = gsp[((i * 2 + j) * 2 + 1) * NTHR];
          mg[i][j][0] += bf2f((bf16_t)(w0 & 0xffffu)) * acc[i][j][0];
          mg[i][j][1] += bf2f((bf16_t)(w0 >> 16)) * acc[i][j][1];
          mg[i][j][2] += bf2f((bf16_t)(w1 & 0xffffu)) * acc[i][j][2];
          mg[i][j][3] += bf2f((bf16_t)(w1 >> 16)) * acc[i][j][3];
        }
    }
    zero_acc<4, 2>(acc);
  }
  bf16_t* stg = (bf16_t*)((unsigned char*)smem + 106496 + wid * 5120);
#pragma unroll
  for (int i = 0; i < 4; ++i)
#pragma unroll
    for (int j = 0; j < 2; ++j) *(u32x2*)(stg + (i * 16 + l15) * 40 + j * 16 + quad * 4) = (u32x2){pk2(mg[i][j][0], mg[i][j][1]), pk2(mg[i][j][2], mg[i][j][3])};
  stage_out<64, 32, 40>(stg, (bf16_t*)(p.ws + O_MERGED) + (size_t)(tm * 128 + wm * 64) * D_ + tn * 128 + wn * 32, (size_t)D_, lane);
}
DI void phase_e(const Params& p, int layer, unsigned char* smem) {
  xcd_tiles(32, 8, [&](int tm, int tn) { merge_tile(p, layer, tm, tn, (bf16_t*)smem); });
}

DI void resid_tile(const Params& p, const bf16_t* A, int K, const bf16_t* W, const float* xold, const float* gnext, int tm, int tn, bf16_t* smem) {
  f32x4 acc[8][4]; zero_acc<8, 4>(acc);
  RowPtr ap{A + (size_t)tm * 256 * K, (size_t)K}, bp{W + (size_t)tn * 256 * K, (size_t)K};
  gemm_main<8, 4, true>(acc, ap, 64, bp, 64, K / 64, smem);
  const int lane = TIDX() & 63, wid = TIDX() >> 6, wm = wid >> 2, wn = wid & 3, l15 = lane & 15, quad = lane >> 4;
  bf16_t* stg = smem + wid * STG_WAVE;
#pragma unroll
  for (int i = 0; i < 8; ++i) {
    const int t = tm * 256 + wm * 128 + i * 16 + l15, c0 = tn * 256 + wn * 64 + quad * 4; float s = 0.f;
#pragma unroll
    for (int j = 0; j < 4; ++j) {
      const size_t off = (size_t)t * D_ + c0 + j * 16;
      const f32x4 xn = *(const f32x4*)(xold + off) + acc[i][j];
      *(f32x4*)(p.out + off) = xn;
      s += xn[0] * xn[0] + xn[1] * xn[1] + xn[2] * xn[2] + xn[3] * xn[3];
      if (gnext) { const f32x4 gv = *(const f32x4*)(gnext + c0 + j * 16); *(u32x2*)(stg + (i * 16 + l15) * STG_LD + j * 16 + quad * 4) = (u32x2){pk2(xn[0] * gv[0], xn[1] * gv[1]), pk2(xn[2] * gv[2], xn[3] * gv[3])}; }
    }
    s += __shfl_xor(s, 16); s += __shfl_xor(s, 32);
    if (quad == 0) ((float*)(p.ws + O_SSQ))[(size_t)t * 16 + tn * 4 + wn] = s;
  }
  if (gnext) stage_out<128, 64, STG_LD>(stg, (bf16_t*)(p.ws + O_XG) + (size_t)(tm * 256 + wm * 128) * D_ + tn * 256 + wn * 64, (size_t)D_, lane);
  __syncthreads();
}
DI void phase_f(const Params& p, int layer, unsigned char* smem) {
  const bf16_t* wl = (const bf16_t*)(p.ws + O_W) + (size_t)layer * W_LAYER;
  xcd_tiles(16, 4, [&](int tm, int tn) { resid_tile(p, (const bf16_t*)(p.ws + O_MERGED), 1024, wl + W_OUT, layer == 0 ? p.x : p.out, p.ffn_norm + layer * D_, tm, tn, (bf16_t*)smem); });
}
DI void phase_h(const Params& p, int layer, unsigned char* smem) {
  const bf16_t* wl = (const bf16_t*)(p.ws + O_W) + (size_t)layer * W_LAYER;
  xcd_tiles(16, 4, [&](int tm, int tn) { resid_tile(p, (const bf16_t*)(p.ws + O_ACT), DFF_, wl + W_DN, p.out, layer == 0 ? p.mix_norm + D_ : nullptr, tm, tn, (bf16_t*)smem); });
}

struct UpRowPtr { const bf16_t* base; int s0;
  DI unsigned operator()(int r) const { const int s = s0 + r; return (unsigned)((s < 0 || s >= S_) ? 0 : s) * (unsigned)D_; }
  DI bool ok(int r) const { const int s = s0 + r; return s >= 0 && s < S_; } };
constexpr int PG_MT = 17;
DI void ffnup_tile(const Params& p, int layer, int b, int mt, int tn, bf16_t* smem) {
  const bf16_t* wl = (const bf16_t*)(p.ws + O_W) + (size_t)layer * W_LAYER;
  f32x4 acc[8][4]; zero_acc<8, 4>(acc);
  const int s0 = 254 * mt - 2;
  UpRowPtr ap{(const bf16_t*)(p.ws + O_XG) + (size_t)b * S_ * D_, s0}; RowPtr bp{wl + W_UP + (size_t)tn * 256 * D_, (size_t)D_};
  gemm_main<8, 4, true>(acc, ap, 64, bp, 64, 16, smem);
  const int tid = TIDX(), lane = tid & 63, wid = tid >> 6, wm = wid >> 2, wn = wid & 3, l15 = lane & 15, quad = lane >> 4;
  constexpr int LDU = 136; bf16_t* U = smem; bf16_t* V = smem + 256 * LDU;
  {
    bf16_t* dstb = (wn < 2 ? U : V) + (wn & 1) * 64 + quad * 4;
#pragma unroll
    for (int i = 0; i < 8; ++i) {
      const int row = wm * 128 + i * 16 + l15, s = s0 + row;
      const float rs = (s >= 0 && s < S_) ? rstd_from16((const float*)(p.ws + O_SSQ) + ((size_t)b * S_ + s) * 16, 1.f / 1024.f) : 0.f;
#pragma unroll
      for (int j = 0; j < 4; ++j) store4(dstb + row * LDU + j * 16, acc[i][j], rs);
    }
  }
  __syncthreads();
  {
    const int cc = tid & 15, cg0 = tn * 128 + cc * 8;
    const float* cw = p.conv_w + (size_t)layer * 3 * DFF_ + cg0; const float* cbp = p.conv_b + (size_t)layer * DFF_ + cg0;
    float w0[8], w1[8], w2[8], cb[8];
#pragma unroll
    for (int e = 0; e < 8; ++e) { w0[e] = cw[e]; w1[e] = cw[DFF_ + e]; w2[e] = cw[2 * DFF_ + e]; cb[e] = cbp[e]; }
    bf16_t* act = (bf16_t*)(p.ws + O_ACT);
#pragma unroll 2
    for (int it = 0; it < 8; ++it) {
      const int row = it * 32 + (tid >> 4), s = s0 + row;
      if (row >= 2 && s < S_) {
        const u32x4 u0 = *(const u32x4*)(U + (row - 2) * LDU + cc * 8), u1 = *(const u32x4*)(U + (row - 1) * LDU + cc * 8), u2 = *(const u32x4*)(U + row * LDU + cc * 8), vv = *(const u32x4*)(V + row * LDU + cc * 8);
        unsigned o[4];
#pragma unroll
        for (int e = 0; e < 4; ++e) {
          float r2[2];
#pragma unroll
          for (int h = 0; h < 2; ++h) {
            const int k = 2 * e + h;
            const float a0 = bf2f((bf16_t)(h ? u0[e] >> 16 : u0[e] & 0xffffu)), a1 = bf2f((bf16_t)(h ? u1[e] >> 16 : u1[e] & 0xffffu)), a2 = bf2f((bf16_t)(h ? u2[e] >> 16 : u2[e] & 0xffffu)), vx = bf2f((bf16_t)(h ? vv[e] >> 16 : vv[e] & 0xffffu));
            const float uc = w0[k] * a0 + w1[k] * a1 + w2[k] * a2 + cb[k];
            r2[h] = uc * sigmoidf_(uc) * vx;
          }
          o[e] = pk2(r2[0], r2[1]);
        }
        __builtin_nontemporal_store((u32x4){o[0], o[1], o[2], o[3]}, (u32x4*)(act + ((size_t)b * S_ + s) * DFF_ + cg0));
      }
    }
  }
  __syncthreads();
}
DI void phase_g(const Params& p, int layer, unsigned char* smem) {
  xcd_tiles(PG_MT, 22, [&](int tmg, int tn) { ffnup_tile(p, layer, tmg / PG_MT, tmg % PG_MT, tn, (bf16_t*)smem); });
}

DI void phase_final(const Params& p) {
  const int lane = TIDX() & 63, wid = TIDX() >> 6;
  for (int it = blockIdx.x; it < T_ / 8; it += gridDim.x) {
    const int t = it * 8 + wid; const float rs = rstd_from16((const float*)(p.ws + O_SSQ) + (size_t)t * 16, 1.f / 1024.f);
    float* xr = p.out + (size_t)t * D_;
#pragma unroll
    for (int c = 0; c < 4; ++c) { const int k = c * 256 + lane * 4; const f32x4 v = *(const f32x4*)(xr + k), gv = *(const f32x4*)(p.final_norm + k); *(f32x4*)(xr + k) = v * rs * gv; }
  }
}

#define XB_TMO      128
#define XB_XCNT(j)  (256  + 64 * (j))
#define XB_XSUB(j)  (1280 + 64 * (j))
#define XB_XGEN(j)  (2304 + 64 * (j))
#define XB_TOP      3328
#define XB_TOPGEN   3392
#define XCD_BAR_WORDS 3456
#define XB_SPIN_CAP (1u << 22)
#define LAS __attribute__((address_space(3)))
DI unsigned xb_ld(unsigned* p)              { return __hip_atomic_load(p, __ATOMIC_RELAXED, __HIP_MEMORY_SCOPE_AGENT); }
DI unsigned xb_add(unsigned* p, unsigned v) { return __hip_atomic_fetch_add(p, v, __ATOMIC_RELAXED, __HIP_MEMORY_SCOPE_AGENT); }
DI unsigned xb_xcc_id() { return (unsigned)__builtin_amdgcn_s_getreg((3 << 11) | 20) & 0xFu; }
#define XB_SPIN(cond, bar) do { unsigned _sp = 0; while (cond) { __builtin_amdgcn_s_sleep(1); \
    if ((++_sp & 255u) == 0u) { if (xb_ld(&(bar)[XB_TMO])) break; if (_sp > XB_SPIN_CAP) { atomicAdd(&(bar)[XB_TMO], 1u); break; } } } } while (0)
struct XcdBarrier { unsigned* bar; unsigned x; volatile LAS unsigned* st; };
DI XcdBarrier xcd_barrier_post(unsigned* bar, volatile LAS unsigned* st) {
  XcdBarrier b; b.bar = bar; b.x = xb_xcc_id(); b.st = st;
  if (threadIdx.x == 0) (void)xb_add(&bar[XB_XCNT(b.x)], 1u);
  return b;
}
DI void xcd_barrier_complete(unsigned* bar, unsigned x, unsigned& nloc, unsigned& nx) {
  const unsigned G = gridDim.x * gridDim.y * gridDim.z;
  unsigned sum, cnt, mine, sp = 0u;
  for (;;) {
    sum = 0u; cnt = 0u; mine = 0u;
#pragma unroll
    for (unsigned j = 0; j < 16; ++j) { const unsigned c = xb_ld(&bar[XB_XCNT(j)]); sum += c; cnt += (c > 0u) ? 1u : 0u; mine = (j == x) ? c : mine; }
    if (sum == G) break;
    __builtin_amdgcn_s_sleep(1);
    if ((++sp & 255u) == 0u) { if (xb_ld(&bar[XB_TMO])) break; if (sp > XB_SPIN_CAP) { atomicAdd(&bar[XB_TMO], 1u); break; } }
  }
  nloc = mine > 0u ? mine : 1u; nx = cnt > 0u ? cnt : 1u;
}
DI void xcd_barrier(const XcdBarrier& b) {
  asm volatile("s_waitcnt vmcnt(0)" ::: "memory");
  __syncthreads();
  if (threadIdx.x == 0) {
    unsigned* bar = b.bar;
    __builtin_amdgcn_s_waitcnt(0);
    unsigned nloc = b.st[0], nx = b.st[1];
    if (nloc == 0u) { xcd_barrier_complete(bar, b.x, nloc, nx); b.st[0] = nloc; b.st[1] = nx; }
    const unsigned old = xb_add(&bar[XB_XSUB(b.x)], 1u);
    const unsigned gen = old / nloc;
    if (old + 1u == (gen + 1u) * nloc) {
      __builtin_amdgcn_fence(__ATOMIC_RELEASE, "agent");
      asm volatile("s_waitcnt vmcnt(0)" ::: "memory");
      const unsigned og = xb_add(&bar[XB_TOP], 1u);
      const unsigned tg = og / nx;
      if (og + 1u == (tg + 1u) * nx) xb_add(&bar[XB_TOPGEN], 1u);
      else XB_SPIN(xb_ld(&bar[XB_TOPGEN]) == tg, bar);
      __builtin_amdgcn_fence(__ATOMIC_ACQUIRE, "agent");
      xb_add(&bar[XB_XGEN(b.x)], 1u);
      asm volatile("s_waitcnt vmcnt(0)" ::: "memory");
    } else {
      XB_SPIN(xb_ld(&bar[XB_XGEN(b.x)]) == gen, bar);
      __builtin_amdgcn_fence(__ATOMIC_ACQUIRE, "agent");
      asm volatile("s_waitcnt vmcnt(0)" ::: "memory");
    }
  }
  __syncthreads();
}
DI void run_phase(const Params& p, int ph, unsigned char* smem) {
  if (ph == 0) { phase_prep(p, smem); return; }
  if (ph == 17) { phase_final(p); return; }
  const int layer = (ph - 1) >> 3, s = (ph - 1) & 7;
#ifdef PROBE_DUP
  if ((PROBE_DUP >> s) & 1) {
    switch (s) { case 0: phase_inproj(p, layer, smem); break; case 1: phase_b(p, layer, smem); break; case 2: phase_c(p, smem); break; case 4: phase_e(p, layer, smem); break; case 6: phase_g(p, layer, smem); break; default: break; }
    __syncthreads();
  }
#endif
  switch (s) {
    case 0: phase_inproj(p, layer, smem); break;
    case 1: phase_b(p, layer, smem); break;
    case 2: phase_c(p, smem); break;
    case 3: phase_d(p, smem); break;
    case 4: phase_e(p, layer, smem); break;
    case 5: phase_f(p, layer, smem); break;
    case 6: phase_g(p, layer, smem); break;
    default: phase_h(p, layer, smem); break;
  }
}
constexpr int N_PHASES = 18;

#if ONE_LAUNCH
template <int PH> DI void run_all(const Params& p, unsigned char* smem, cg::grid_group& grid, const XcdBarrier& xb) {
  run_phase(p, PH, smem);
  if constexpr (PH + 1 < N_PHASES) {
    if constexpr (PH == 0) grid.sync(); else xcd_barrier(xb);
    run_all<PH + 1>(p, smem, grid, xb);
  }
}
__global__ void __launch_bounds__(NTHR, 2) mega_kernel(Params p) {
  __shared__ __attribute__((aligned(16))) unsigned char smem[SMEM_BYTES];
  __shared__ uint4 xb_words;
  if (threadIdx.x == 0) xb_words = make_uint4(0u, 0u, 0u, 0u);
  __syncthreads();
  const XcdBarrier xb = xcd_barrier_post((unsigned*)(p.ws + O_BAR), (volatile LAS unsigned*)&xb_words);
  cg::grid_group grid = cg::this_grid();
  run_all<0>(p, smem, grid, xb);
}
#else
template <int PH> __global__ void __launch_bounds__(NTHR, 2) phase_kernel(Params p) {
  __shared__ __attribute__((aligned(16))) unsigned char smem[SMEM_BYTES];
  run_phase(p, PH, smem);
}
template <int PH> static void launch_phases(const Params& p, hipStream_t stream) {
  hipLaunchKernelGGL((phase_kernel<PH>), dim3(256), dim3(NTHR), 0, stream, p);
  if constexpr (PH + 1 < N_PHASES) launch_phases<PH + 1>(p, stream);
}
#endif

extern "C" void kernel_launch(void* const* d_in, const int* in_sizes, int n_in, void* d_out, int out_size, void* d_ws, size_t ws_size, hipStream_t stream) {
  if (ws_size < O_END || n_in < 25) { fprintf(stderr, "workspace too small: %zu < %zu\n", ws_size, (size_t)O_END); return; }
  Params p{};
  p.x = (const float*)d_in[0]; p.pos = (const int*)d_in[1]; p.mix_norm = (const float*)d_in[2]; p.w_in = (const float*)d_in[3]; p.b_forget = (const float*)d_in[4];
  p.pe_k = (const float*)d_in[5]; p.w1_k = (const float*)d_in[6]; p.w2_k = (const float*)d_in[7]; p.pe_v = (const float*)d_in[8]; p.w1_v = (const float*)d_in[9]; p.w2_v = (const float*)d_in[10];
  p.q_norm = (const float*)d_in[11]; p.w_uq = (const float*)d_in[12]; p.kv_norm = (const float*)d_in[13]; p.w_ukv = (const float*)d_in[14];
  p.wbr_nsa = (const float*)d_in[15]; p.wbr_fox = (const float*)d_in[16]; p.wbr_mla = (const float*)d_in[17]; p.w_out = (const float*)d_in[18];
  p.ffn_norm = (const float*)d_in[19]; p.w_up = (const float*)d_in[20]; p.conv_w = (const float*)d_in[21]; p.conv_b = (const float*)d_in[22]; p.w_down = (const float*)d_in[23]; p.final_norm = (const float*)d_in[24];
  p.out = (float*)d_out; p.ws = (unsigned char*)d_ws;
#if ONE_LAUNCH
  static int grid_blocks = 0;
  if (!grid_blocks) {
    int dev = 0, cus = 0, per_cu = 0;
    hipGetDevice(&dev); hipDeviceGetAttribute(&cus, hipDeviceAttributeMultiprocessorCount, dev);
    hipOccupancyMaxActiveBlocksPerMultiprocessor(&per_cu, mega_kernel, NTHR, 0);
    if (per_cu > 1) per_cu = 1;
    grid_blocks = cus * per_cu;
  }
  hipMemsetAsync(p.ws + O_BAR, 0, XCD_BAR_WORDS * 4, stream);
  void* args[] = {&p};
  hipError_t e = hipLaunchCooperativeKernel((void*)mega_kernel, dim3(grid_blocks), dim3(NTHR), args, 0, stream);
  if (e != hipSuccess) fprintf(stderr, "cooperative launch failed: %s (grid %d)\n", hipGetErrorString(e), grid_blocks);
#else
  launch_phases<0>(p, stream);
#endif
}
```

```cpp
#include <hip/hip_runtime.h>
#include <hip/hip_cooperative_groups.h>
#include <stdint.h>
#include <stdio.h>
#include <type_traits>
namespace cg = cooperative_groups;

#ifndef ONE_LAUNCH
#define ONE_LAUNCH 1

#endif

#define DI __device__ __forceinline__
typedef unsigned short bf16_t;
typedef short bf16x8 __attribute__((ext_vector_type(8)));
typedef float f32x4 __attribute__((ext_vector_type(4)));
typedef float f32x16 __attribute__((ext_vector_type(16)));
typedef float f32x2 __attribute__((ext_vector_type(2)));
typedef __bf16 bfx2 __attribute__((ext_vector_type(2)));
typedef unsigned u32x4 __attribute__((ext_vector_type(4)));
typedef unsigned u32x2 __attribute__((ext_vector_type(2)));
typedef unsigned long long u64;

constexpr int T_ = 32768, S_ = 4096, NB_ = 8, D_ = 1024, DFF_ = 2816, NIN_ = 6592;
constexpr float EPS_ = 1e-6f;
constexpr float LOG2E_ = 1.4426950408889634f;
constexpr float QS64_ = 0.125f * LOG2E_;
constexpr float QS96_ = 0.10206207261596577f * LOG2E_;

constexpr size_t W_IN = 0;
constexpr size_t W_G = W_IN + (size_t)3584 * 1024;
constexpr size_t W_1K = W_G + (size_t)3072 * 1024;
constexpr size_t W_1V = W_1K + (size_t)256 * 2048;
constexpr size_t W_2K = W_1V + (size_t)256 * 2048;
constexpr size_t W_2V = W_2K + (size_t)64 * 256;
constexpr size_t W_UQ = W_2V + (size_t)64 * 256;
constexpr size_t W_UKV = W_UQ + (size_t)768 * 384;
constexpr size_t W_BN = W_UKV + (size_t)1024 * 256;
constexpr size_t W_BF = W_BN + (size_t)1024 * 512;
constexpr size_t W_BM = W_BF + (size_t)1024 * 512;
constexpr size_t W_OUT = W_BM + (size_t)1024 * 512;
constexpr size_t W_UP = W_OUT + (size_t)1024 * 1024;
constexpr size_t W_DN = W_UP + (size_t)5632 * 1024;
constexpr size_t W_LAYER = W_DN + (size_t)1024 * 2816;

constexpr size_t al256(size_t x) { return (x + 255) & ~(size_t)255; }
constexpr size_t O_BAR = 0;
constexpr size_t O_W = 16384;
constexpr size_t O_BIAS1 = al256(O_W + 2 * W_LAYER * 2);
constexpr size_t O_ROPE8 = al256(O_BIAS1 + 2 * 2 * 16 * 256 * 4);
constexpr size_t O_ROPE16 = al256(O_ROPE8 + (size_t)T_ * 16 * 4);
constexpr size_t O_XG = al256(O_ROPE16 + (size_t)T_ * 32 * 4);
constexpr size_t O_SSQ = al256(O_XG + (size_t)T_ * 1024 * 2);
constexpr size_t O_CSSQ = al256(O_SSQ + (size_t)T_ * 16 * 4);
constexpr size_t O_NSAQ = al256(O_CSSQ + (size_t)T_ * 16 * 4);
constexpr size_t O_KVCMP = O_NSAQ + (size_t)T_ * 512 * 2;
constexpr size_t O_KSLC = O_KVCMP + (size_t)T_ * 256 * 2;
constexpr size_t O_KWIN = O_KSLC + (size_t)T_ * 128 * 2;
constexpr size_t O_MERGED = O_NSAQ;
constexpr size_t O_VSLCT = O_KWIN + (size_t)T_ * 128 * 2;
constexpr size_t O_VWINT = O_VSLCT + (size_t)T_ * 128 * 2;
constexpr size_t O_FOXQ = O_VWINT + (size_t)T_ * 128 * 2;
constexpr size_t O_FOXK = O_FOXQ + (size_t)T_ * 512 * 2;
constexpr size_t O_FOXVT = O_FOXK + (size_t)T_ * 512 * 2;
constexpr size_t O_MLAQ = O_FOXVT + (size_t)T_ * 512 * 2;
constexpr size_t O_MLAKN = O_MLAQ + (size_t)T_ * 768 * 2;
constexpr size_t O_ACT = O_FOXQ;
constexpr size_t O_MLAVT = O_MLAKN + (size_t)T_ * 512 * 2;
constexpr size_t O_MLAKPE = O_MLAVT + (size_t)T_ * 512 * 2;
constexpr size_t O_ONSA = O_MLAKPE + (size_t)T_ * 32 * 2;
constexpr size_t O_CQ = O_ONSA;
constexpr size_t O_CKV = O_CQ + (size_t)T_ * 384 * 2;
constexpr size_t O_CEND = O_CKV + (size_t)T_ * 256 * 2;
constexpr size_t O_GATES = al256(O_CEND > O_ONSA + (size_t)T_ * 512 * 2 ? O_CEND : O_ONSA + (size_t)T_ * 512 * 2);
constexpr size_t O_LOGF = al256(O_GATES + (size_t)T_ * 24 * 4);
constexpr size_t O_F2 = al256(O_LOGF + (size_t)T_ * 8 * 4);
constexpr size_t O_KC = al256(O_F2 + (size_t)T_ * 8 * 4);
constexpr size_t O_VCT = al256(O_KC + (size_t)NB_ * 2 * 256 * 64 * 2);
constexpr size_t O_SEL = al256(O_VCT + (size_t)NB_ * 2 * 256 * 64 * 2);
constexpr size_t O_END = al256(O_SEL + (size_t)NB_ * 2 * S_ * 8);

struct Params {
  const float* x; const int* pos; const float* mix_norm; const float* w_in; const float* b_forget;
  const float* pe_k; const float* w1_k; const float* w2_k; const float* pe_v; const float* w1_v; const float* w2_v;
  const float* q_norm; const float* w_uq; const float* kv_norm; const float* w_ukv;
  const float* wbr_nsa; const float* wbr_fox; const float* wbr_mla; const float* w_out;
  const float* ffn_norm; const float* w_up; const float* conv_w; const float* conv_b; const float* w_down; const float* final_norm;
  float* out; unsigned char* ws;
};

constexpr int NTHR = 512;
constexpr int SMEM_BYTES = 147456;

DI int TIDX() { int t = (int)threadIdx.x; asm volatile("" : "+v"(t)); return t; }
DI unsigned pk2(float lo, float hi) { f32x2 v = {lo, hi}; return __builtin_bit_cast(unsigned, __builtin_convertvector(v, bfx2)); }
DI bf16_t f2bf(float x) { return (bf16_t)(pk2(x, 0.f) & 0xffffu); }
DI float bf2f(bf16_t h) { return __uint_as_float(((unsigned)h) << 16); }
DI float sigmoidf_(float x) { return 1.f / (1.f + __expf(-x)); }
DI float gelu_tanh(float x) { const float u = 0.7978845608028654f * (x + 0.044715f * x * x * x); return x / (1.f + __expf(-2.f * u)); }
DI float ex2(float x) { return __builtin_amdgcn_exp2f(x); }
DI f32x16 mfma32(bf16x8 a, bf16x8 b, f32x16 c) { return __builtin_amdgcn_mfma_f32_32x32x16_bf16(a, b, c, 0, 0, 0); }
DI f32x4 mfma16(bf16x8 a, bf16x8 b, f32x4 c) { return __builtin_amdgcn_mfma_f32_16x16x32_bf16(a, b, c, 0, 0, 0); }
DI float rstd_from16(const float* p, float inv_n) {
  const f32x4 a = *(const f32x4*)p, b = *(const f32x4*)(p + 4), c = *(const f32x4*)(p + 8), d = *(const f32x4*)(p + 12);
  const float s = ((a[0] + a[1]) + (a[2] + a[3])) + ((b[0] + b[1]) + (b[2] + b[3])) + ((c[0] + c[1]) + (c[2] + c[3])) + ((d[0] + d[1]) + (d[2] + d[3]));
  return rsqrtf(s * inv_n + EPS_);
}

constexpr int LDT = 72;
template <int MI, int NJ> struct GemmLds { static constexpr int BM = 32 * MI, BN = 64 * NJ, A_ELEMS = BM * LDT, B_ELEMS = BN * LDT, STAGE = A_ELEMS + B_ELEMS; };

template <int MI, int NJ, bool SWAP, class AP, class BP>
DI void gemm_main(f32x4 (&acc)[MI][NJ], const AP& ap, int a_kstep, const BP& bp, int b_kstep, int nk, bf16_t* smem) {
  typedef GemmLds<MI, NJ> L;
  constexpr int CA = MI / 2, CB = NJ;
  const int tid = TIDX(), lane = tid & 63, wid = tid >> 6, wm = wid >> 2, wn = wid & 3, l15 = lane & 15, quad = lane >> 4;
  unsigned pa[CA], pb[CB]; bool oka[CA];
#pragma unroll
  for (int i = 0; i < CA; ++i) { const int c = tid + NTHR * i; pa[i] = ap(c >> 3) + (c & 7) * 8; oka[i] = ap.ok(c >> 3); }
#pragma unroll
  for (int i = 0; i < CB; ++i) { const int c = tid + NTHR * i; pb[i] = bp(c >> 3) + (c & 7) * 8; }
  u32x4 ra[CA], rb[CB];
  auto gload = [&](int kt) {
    const bf16_t* ab = ap.base + (size_t)kt * a_kstep; const bf16_t* bb = bp.base + (size_t)kt * b_kstep;
#pragma unroll
    for (int i = 0; i < CA; ++i) ra[i] = *(const u32x4*)(ab + pa[i]);
#pragma unroll
    for (int i = 0; i < CB; ++i) rb[i] = *(const u32x4*)(bb + pb[i]);
  };
  auto sstore = [&](int buf) {
    bf16_t* As = smem + buf * L::STAGE; bf16_t* Bs = As + L::A_ELEMS;
#pragma unroll
    for (int i = 0; i < CA; ++i) { const int c = tid + NTHR * i; *(u32x4*)(As + (c >> 3) * LDT + (c & 7) * 8) = oka[i] ? ra[i] : (u32x4){0u, 0u, 0u, 0u}; }
#pragma unroll
    for (int i = 0; i < CB; ++i) { const int c = tid + NTHR * i; *(u32x4*)(Bs + (c >> 3) * LDT + (c & 7) * 8) = rb[i]; }
  };
  gload(0); sstore(0); gload(nk > 1 ? 1 : 0); __syncthreads();
#pragma unroll 1
  for (int kt = 0; kt < nk; ++kt) {
    const int buf = kt & 1;
    sstore(buf ^ 1);
    gload(kt + 2 < nk ? kt + 2 : nk - 1);
    __builtin_amdgcn_sched_barrier(0);
    const bf16_t* As = smem + buf * L::STAGE + (wm * 16 * MI + l15) * LDT + quad * 8;
    const bf16_t* Bs = smem + buf * L::STAGE + L::A_ELEMS + (wn * 16 * NJ + l15) * LDT + quad * 8;
#pragma unroll
    for (int ks = 0; ks < 2; ++ks) {
      if (MI * NJ >= 32 && ks == 1) asm volatile("" ::: "memory");
      bf16x8 b[NJ];
#pragma unroll
      for (int j = 0; j < NJ; ++j) b[j] = *(const bf16x8*)(Bs + j * 16 * LDT + ks * 32);
#pragma unroll
      for (int i = 0; i < MI; ++i) {
        const bf16x8 a = *(const bf16x8*)(As + i * 16 * LDT + ks * 32);
#pragma unroll
        for (int j = 0; j < NJ; ++j) acc[i][j] = SWAP ? mfma16(b[j], a, acc[i][j]) : mfma16(a, b[j], acc[i][j]);
      }
    }
    __syncthreads();
  }
}
template <int MI, int NJ> DI void zero_acc(f32x4 (&acc)[MI][NJ]) {
#pragma unroll
  for (int i = 0; i < MI; ++i)
#pragma unroll
    for (int j = 0; j < NJ; ++j) acc[i][j] = (f32x4){0.f, 0.f, 0.f, 0.f};
}
struct RowPtr { const bf16_t* base; size_t ld; DI unsigned operator()(int r) const { return (unsigned)r * (unsigned)ld; } DI bool ok(int) const { return true; } };


template <class F> DI void xcd_tiles(int MPX, int NT, F&& body) {
  const int xcd = blockIdx.x & 7, slot = blockIdx.x >> 3, nslots = gridDim.x >> 3, total = MPX * NT;
  for (int li = slot; li < total; li += nslots) {
    const int mg = li / (8 * NT), rem = li - mg * 8 * NT;
    const int gsz = (MPX - mg * 8) < 8 ? (MPX - mg * 8) : 8;
    const int tn = rem / gsz, mi = rem - tn * gsz;
    body(xcd * MPX + mg * 8 + mi, tn);
  }
}

DI int map_col(int map, int n) {
  if (map == 0) return n;
  if (map == 1) {
    if (n < 896) return n;
    if (n < 1024) return 1024 + (n - 896);
    if (n < 1152) return 896 + (n - 1024);
    if (n < 1280) return n;
    if (n < 2816) return 1304 + (n - 1280);
    if (n < 3200) return 2848 + (n - 2816);
    if (n < 3456) return 3232 + (n - 3200);
    const int c = n - 3456;
    if (c < 24) return 1280 + c;
    if (c < 32) return 2840 + (c - 24);
    if (c < 64) return 3488 + (c - 32);
    return -1;
  }
  if (map == 2) { const int j = n >> 8, c = n & 255; return c < 128 ? j * 128 + c : DFF_ + j * 128 + (c - 128); }
  if (map == 3) { return n < 512 ? (n >> 6) * 128 + (n & 63) : ((n - 512) >> 6) * 128 + 64 + ((n - 512) & 63); }
  return n;
}
struct WJob { const float* src; const float* scale; bf16_t* dst; int K, N, ld, map, off; };
DI void prep_weight_tile(const WJob& j, int tile, float* lds) {
  const int ntn = j.N >> 6, tk = tile / ntn, tn = tile % ntn, tid = TIDX();
  const int n4 = (tid & 15) * 4; const int sc = map_col(j.map, tn * 64 + n4);
  f32x4 v[4];
#pragma unroll
  for (int i = 0; i < 4; ++i) {
    const int kk = (tid >> 4) + 32 * i, k = tk * 128 + kk;
    v[i] = sc >= 0 ? *(const f32x4*)(j.src + (size_t)k * j.ld + j.off + sc) : (f32x4){0.f, 0.f, 0.f, 0.f};
    if (j.scale) v[i] = v[i] * j.scale[k];
  }
#pragma unroll
  for (int i = 0; i < 4; ++i) {
    const int kk = (tid >> 4) + 32 * i;
#pragma unroll
    for (int e = 0; e < 4; ++e) lds[kk * 65 + n4 + e] = v[i][e];
  }
  __syncthreads();
  const int nn = tid >> 3, k0 = (tid & 7) * 16;
  unsigned w[8];
#pragma unroll
  for (int e = 0; e < 8; ++e) w[e] = pk2(lds[(k0 + 2 * e) * 65 + nn], lds[(k0 + 2 * e + 1) * 65 + nn]);
  bf16_t* d = j.dst + (size_t)(tn * 64 + nn) * j.K + tk * 128 + k0;
  *(u32x4*)d = (u32x4){w[0], w[1], w[2], w[3]}; *(u32x4*)(d + 8) = (u32x4){w[4], w[5], w[6], w[7]};
  __syncthreads();
}
DI WJob get_wjob(const Params& p, int layer, int id) {
  bf16_t* wl = (bf16_t*)(p.ws + O_W) + (size_t)layer * W_LAYER; WJob j; j.scale = nullptr; j.map = 0; j.off = 0;
  switch (id) {
    case 0: j.src = p.w_in + (size_t)layer * 1024 * NIN_; j.dst = wl + W_IN; j.K = 1024; j.N = 3584; j.ld = NIN_; j.map = 1; break;
    case 1: j.src = p.w_in + (size_t)layer * 1024 * NIN_; j.dst = wl + W_G; j.K = 1024; j.N = 3072; j.ld = NIN_; j.off = 3520; break;
    case 2: j.src = p.w1_k + (size_t)layer * 2048 * 256; j.dst = wl + W_1K; j.K = 2048; j.N = 256; j.ld = 256; break;
    case 3: j.src = p.w1_v + (size_t)layer * 2048 * 256; j.dst = wl + W_1V; j.K = 2048; j.N = 256; j.ld = 256; break;
    case 4: j.src = p.w2_k + (size_t)layer * 256 * 64; j.dst = wl + W_2K; j.K = 256; j.N = 64; j.ld = 64; break;
    case 5: j.src = p.w2_v + (size_t)layer * 256 * 64; j.dst = wl + W_2V; j.K = 256; j.N = 64; j.ld = 64; break;
    case 6: j.src = p.w_uq + (size_t)layer * 384 * 768; j.dst = wl + W_UQ; j.K = 384; j.N = 768; j.ld = 768; j.scale = p.q_norm + layer * 384; break;
    case 7: j.src = p.w_ukv + (size_t)layer * 256 * 1024; j.dst = wl + W_UKV; j.K = 256; j.N = 1024; j.ld = 1024; j.scale = p.kv_norm + layer * 256; j.map = 3; break;
    case 8: j.src = p.wbr_nsa + (size_t)layer * 512 * 1024; j.dst = wl + W_BN; j.K = 512; j.N = 1024; j.ld = 1024; break;
    case 9: j.src = p.wbr_fox + (size_t)layer * 512 * 1024; j.dst = wl + W_BF; j.K = 512; j.N = 1024; j.ld = 1024; break;
    case 10: j.src = p.wbr_mla + (size_t)layer * 512 * 1024; j.dst = wl + W_BM; j.K = 512; j.N = 1024; j.ld = 1024; break;
    case 11: j.src = p.w_out + (size_t)layer * 1024 * 1024; j.dst = wl + W_OUT; j.K = 1024; j.N = 1024; j.ld = 1024; break;
    case 12: j.src = p.w_up + (size_t)layer * 1024 * 5632; j.dst = wl + W_UP; j.K = 1024; j.N = 5632; j.ld = 5632; j.map = 2; break;
    default: j.src = p.w_down + (size_t)layer * 2816 * 1024; j.dst = wl + W_DN; j.K = 2816; j.N = 1024; j.ld = 1024; break;
  }
  return j;
}
constexpr int WTILES_LAYER = (int)(W_LAYER / 8192);
constexpr int P0_XITEMS = T_ / 64;
constexpr int P0_ROPE_ITEMS = T_ / NTHR;
constexpr int P0_ITEMS = 2 * WTILES_LAYER + 64 + P0_ROPE_ITEMS + P0_XITEMS;

DI void xg_rows(const float* x, const float* g, bf16_t* xg, float* ssq, int row0) {
  const int lane = TIDX() & 63, wid = TIDX() >> 6;
  for (int rr = 0; rr < 8; ++rr) {
    const int t = row0 + wid * 8 + rr; const float* xr = x + (size_t)t * D_; float s = 0.f;
#pragma unroll
    for (int c = 0; c < 4; ++c) {
      const int k = c * 256 + lane * 4; const f32x4 v = *(const f32x4*)(xr + k), gv = *(const f32x4*)(g + k);
      s += v[0] * v[0] + v[1] * v[1] + v[2] * v[2] + v[3] * v[3];
      *(u32x2*)(xg + (size_t)t * D_ + k) = (u32x2){pk2(v[0] * gv[0], v[1] * gv[1]), pk2(v[2] * gv[2], v[3] * gv[3])};
    }
#pragma unroll
    for (int o = 32; o >= 1; o >>= 1) s += __shfl_xor(s, o);
    if (lane < 16) ssq[(size_t)t * 16 + lane] = lane == 0 ? s : 0.f;
  }
}
DI void phase_prep(const Params& p, unsigned char* smem) {
  for (int it = blockIdx.x; it < P0_ITEMS; it += gridDim.x) {
    int i = it;
    if (i < 2 * WTILES_LAYER) {
      const int layer = i / WTILES_LAYER; int t = i % WTILES_LAYER; int id = 0;
      for (;; ++id) { const WJob j = get_wjob(p, layer, id); const int nt = (j.K >> 7) * (j.N >> 6); if (t < nt) { prep_weight_tile(j, t, (float*)smem); break; } t -= nt; }
      continue;
    }
    i -= 2 * WTILES_LAYER;
    if (i < 64) {
      const int lk = i >> 4, pc = i & 15, layer = lk >> 1, kv = lk & 1, c = TIDX() & 255, hf = TIDX() >> 8;
      const float* pe = (kv ? p.pe_v : p.pe_k) + (size_t)layer * 2048 + pc * 128 + hf * 64; const float* w1 = (kv ? p.w1_v : p.w1_k) + (size_t)layer * 2048 * 256 + (size_t)(pc * 128 + hf * 64) * 256;
      float sacc = 0.f;
#pragma unroll 8
      for (int kk = 0; kk < 64; ++kk) sacc += pe[kk] * w1[(size_t)kk * 256 + c];
      float* lds = (float*)smem;
      if (hf) lds[c] = sacc;
      __syncthreads();
      if (!hf) ((float*)(p.ws + O_BIAS1))[(lk * 16 + pc) * 256 + c] = sacc + lds[c];
      __syncthreads();
      continue;
    }
    i -= 64;
    if (i < P0_ROPE_ITEMS) {
      const int t = i * NTHR + TIDX(); const float fp = (float)p.pos[t];
      float* r8 = (float*)(p.ws + O_ROPE8) + (size_t)t * 16; float* r16 = (float*)(p.ws + O_ROPE16) + (size_t)t * 32;
      for (int f = 0; f < 24; ++f) {
        const int half = f < 8 ? 8 : 16, idx = f < 8 ? f : f - 8;
        const float inv = exp2f(-(float)idx / (float)half * 18.931568569324174f);
        const float ang = fp * inv;
        const double rev = (double)ang * 0.15915494309189535; const float fr = (float)(rev - floor(rev));
        const float sn = __builtin_amdgcn_sinf(fr), cs = __builtin_amdgcn_cosf(fr);
        if (f < 8) { r8[2 * idx] = cs; r8[2 * idx + 1] = sn; } else { r16[2 * idx] = cs; r16[2 * idx + 1] = sn; }
      }
      continue;
    }
    i -= P0_ROPE_ITEMS;
    xg_rows(p.x, p.mix_norm, (bf16_t*)(p.ws + O_XG), (float*)(p.ws + O_SSQ), i * 64);
  }
}

DI void store4(bf16_t* dst, const f32x4& v, float s) { *(u32x2*)dst = (u32x2){pk2(v[0] * s, v[1] * s), pk2(v[2] * s, v[3] * s)}; }
constexpr int STG_LD = 72, STG_WAVE = 128 * 72;
DI void stage4(bf16_t* stg, int row, int col, const f32x4& v, float s) { *(u32x2*)(stg + row * STG_LD + col) = (u32x2){pk2(v[0] * s, v[1] * s), pk2(v[2] * s, v[3] * s)}; }
template <int ROWS, int COLS, int LD> DI void stage_out(const bf16_t* stg, bf16_t* dst, size_t ld, int lane) {
  asm volatile("s_waitcnt lgkmcnt(0)" ::: "memory");
  constexpr int CPR = COLS / 8, IT = ROWS * CPR / 64;
#pragma unroll
  for (int it = 0; it < IT; ++it) {
    const int idx = it * 64 + lane, r = idx / CPR, c = idx % CPR;
    __builtin_nontemporal_store(*(const u32x4*)(stg + r * LD + c * 8), (u32x4*)(dst + (size_t)r * ld + c * 8));
  }
}
template <bool SWAP> DI void inproj_tile(const Params& p, int layer, int tm, int tn, bf16_t* smem) {
  const bf16_t* wl = (const bf16_t*)(p.ws + O_W) + (size_t)layer * W_LAYER;
  f32x4 acc[8][4]; zero_acc<8, 4>(acc);
  RowPtr ap{(const bf16_t*)(p.ws + O_XG) + (size_t)tm * 256 * D_, (size_t)D_}, bp{wl + W_IN + (size_t)tn * 256 * D_, (size_t)D_};
  gemm_main<8, 4, SWAP>(acc, ap, 64, bp, 64, 16, smem);
  const int lane = TIDX() & 63, wid = TIDX() >> 6, wm = wid >> 2, wn = wid & 3, l15 = lane & 15, quad = lane >> 4;
  const float* ssq = (const float*)(p.ws + O_SSQ);
  bf16_t* stg = smem + wid * STG_WAVE;
  const int trow0 = tm * 256 + wm * 128;
  if constexpr (!SWAP) {
    bf16_t* dst; int hh, hd;
    if (tn == 4) { dst = (bf16_t*)(p.ws + (wn < 2 ? O_VSLCT : O_VWINT)); hh = 2; hd = wn & 1; } else { dst = (bf16_t*)(p.ws + O_FOXVT); hh = 8; hd = (tn - 9) * 4 + wn; }
    constexpr int VLD = 136;
#pragma unroll
    for (int i = 0; i < 8; ++i) {
      const int t0 = trow0 + i * 16 + quad * 4;
      float rs[4];
#pragma unroll
      for (int r = 0; r < 4; ++r) rs[r] = rstd_from16(ssq + (size_t)(t0 + r) * 16, 1.f / 1024.f);
#pragma unroll
      for (int j = 0; j < 4; ++j)
        *(u32x2*)(stg + (j * 16 + l15) * VLD + i * 16 + quad * 4) = (u32x2){pk2(acc[i][j][0] * rs[0], acc[i][j][1] * rs[1]), pk2(acc[i][j][2] * rs[2], acc[i][j][3] * rs[3])};
    }
    const int b = trow0 >> 12, s0 = trow0 & 4095;
    stage_out<64, 128, VLD>(stg, dst + ((size_t)(b * hh + hd) * 64) * S_ + s0, (size_t)S_, lane);
  } else {
    const int slab = tn * 4 + wn;
    if (slab == 54) {
#pragma unroll
      for (int i = 0; i < 8; ++i) {
        const int t = trow0 + i * 16 + l15; const float rs = rstd_from16(ssq + (size_t)t * 16, 1.f / 1024.f);
        float* gt = (float*)(p.ws + O_GATES) + (size_t)t * 24; float* lf = (float*)(p.ws + O_LOGF) + (size_t)t * 8;
#pragma unroll
        for (int r = 0; r < 4; ++r) gt[quad * 4 + r] = sigmoidf_(acc[i][0][r] * rs);
        if (quad < 2) {
#pragma unroll
          for (int r = 0; r < 4; ++r) gt[16 + quad * 4 + r] = sigmoidf_(acc[i][1][r] * rs);
        } else {
#pragma unroll
          for (int r = 0; r < 4; ++r) { const int h = (quad - 2) * 4 + r; const float xx = acc[i][1][r] * rs + p.b_forget[layer * 8 + h]; lf[h] = fminf(xx, 0.f) - log1pf(__expf(-fabsf(xx))); }
        }
        const float* rp = (const float*)(p.ws + O_ROPE16) + (size_t)t * 32 + quad * 8; float o1[4], o2[4];
#pragma unroll
        for (int r = 0; r < 4; ++r) { const float cs = rp[2 * r], sn = rp[2 * r + 1], x1 = acc[i][2][r] * rs, x2 = acc[i][3][r] * rs; o1[r] = x1 * cs - x2 * sn; o2[r] = x2 * cs + x1 * sn; }
        bf16_t* kp = (bf16_t*)(p.ws + O_MLAKPE) + (size_t)t * 32 + quad * 4;
        *(u32x2*)kp = (u32x2){pk2(o1[0], o1[1]), pk2(o1[2], o1[3])}; *(u32x2*)(kp + 16) = (u32x2){pk2(o2[0], o2[1]), pk2(o2[2], o2[3])};
      }
    } else if (slab != 55) {
      bf16_t* dbuf; int dld, dcol, kind = 0; float qs = 1.f; int cslot = 0;
      if (slab < 8) { dbuf = (bf16_t*)(p.ws + O_NSAQ); dld = 512; dcol = slab * 64; qs = QS64_; }
      else if (slab < 12) { dbuf = (bf16_t*)(p.ws + O_KVCMP); dld = 256; dcol = (slab - 8) * 64; }
      else if (slab < 16) { dbuf = (bf16_t*)(p.ws + (slab < 14 ? O_KSLC : O_KWIN)); dld = 128; dcol = (slab & 1) * 64; kind = 1; }
      else if (slab < 28) { dbuf = (bf16_t*)(p.ws + O_FOXQ); dld = 512; dcol = (slab - 20) * 64; qs = QS64_; }
      else if (slab < 36) { dbuf = (bf16_t*)(p.ws + O_FOXK); dld = 512; dcol = (slab - 28) * 64; }
      else if (slab < 50) { dbuf = (bf16_t*)(p.ws + O_CQ); dld = 384; dcol = (slab - 44) * 64; kind = 2; cslot = slab - 44; }
      else { dbuf = (bf16_t*)(p.ws + O_CKV); dld = 256; dcol = (slab - 50) * 64; kind = 2; cslot = 8 + slab - 50; }
#pragma unroll
      for (int i = 0; i < 8; ++i) {
        const int row = i * 16 + l15, t = trow0 + row; const float rs = rstd_from16(ssq + (size_t)t * 16, 1.f / 1024.f) * qs;
        if (kind == 1) {
          const float* rp = (const float*)(p.ws + O_ROPE8) + (size_t)t * 16 + (quad & 1) * 8;
          f32x4 v, o;
#pragma unroll
          for (int r = 0; r < 4; ++r) { v[r] = acc[i][0][r] * rs; o[r] = __shfl_xor(v[r], 32); }
#pragma unroll
          for (int r = 0; r < 4; ++r) { const float cs = rp[2 * r], sn = rp[2 * r + 1]; v[r] = quad < 2 ? v[r] * cs - o[r] * sn : v[r] * cs + o[r] * sn; }
          stage4(stg, row, quad * 4, v, 1.f);
        } else stage4(stg, row, quad * 4, acc[i][0], rs);
#pragma unroll
        for (int j = 1; j < 4; ++j) stage4(stg, row, j * 16 + quad * 4, acc[i][j], rs);
        if (kind == 2) {
          float s = 0.f;
#pragma unroll
          for (int j = 0; j < 4; ++j) { const f32x4 a = acc[i][j] * rs; s += a[0] * a[0] + a[1] * a[1] + a[2] * a[2] + a[3] * a[3]; }
          s += __shfl_xor(s, 16); s += __shfl_xor(s, 32);
          if (quad == 0) ((float*)(p.ws + O_CSSQ))[(size_t)t * 16 + cslot] = s;
        }
      }
      stage_out<128, 64, STG_LD>(stg, dbuf + (size_t)trow0 * dld + dcol, (size_t)dld, lane);
    }
  }
  __syncthreads();
}
DI void phase_inproj(const Params& p, int layer, unsigned char* smem) {
  xcd_tiles(16, 14, [&](int tm, int tn) {
    const bool vt = (tn == 4 || tn == 9 || tn == 10);
    if (vt) inproj_tile<false>(p, layer, tm, tn, (bf16_t*)smem); else inproj_tile<true>(p, layer, tm, tn, (bf16_t*)smem);
  });
}

template <int KIND> DI void mlaup_tile(const Params& p, int layer, int tm, int tn, bf16_t* smem) {
  const bf16_t* wl = (const bf16_t*)(p.ws + O_W) + (size_t)layer * W_LAYER;
  f32x4 acc[8][4]; zero_acc<8, 4>(acc);
  constexpr int K = KIND == 0 ? 384 : 256;
  RowPtr ap{KIND == 0 ? (const bf16_t*)(p.ws + O_CQ) + (size_t)tm * 256 * 384 : (const bf16_t*)(p.ws + O_CKV) + (size_t)tm * 256 * 256, (size_t)K};
  RowPtr bp{KIND == 0 ? wl + W_UQ + (size_t)tn * 256 * 384 : wl + W_UKV + (size_t)(tn - 3) * 256 * 256, (size_t)K};
  gemm_main<8, 4, KIND != 2>(acc, ap, 64, bp, 64, K / 64, smem);
  const int lane = TIDX() & 63, wid = TIDX() >> 6, wm = wid >> 2, wn = wid & 3, l15 = lane & 15, quad = lane >> 4;
  const float* cssq = (const float*)(p.ws + O_CSSQ);
  bf16_t* stg = smem + wid * STG_WAVE; const int trow0 = tm * 256 + wm * 128;
  if constexpr (KIND == 2) {
    bf16_t* dst = (bf16_t*)(p.ws + O_MLAVT); const int h = (tn - 5) * 4 + wn;
    constexpr int VLD = 136;
#pragma unroll
    for (int i = 0; i < 8; ++i) {
      asm volatile("" ::: "memory");
      const int t0 = trow0 + i * 16 + quad * 4; float rs[4];
#pragma unroll
      for (int r = 0; r < 4; ++r) { const float* c = cssq + (size_t)(t0 + r) * 16 + 8; rs[r] = rsqrtf((c[0] + c[1] + c[2] + c[3]) * (1.f / 256.f) + EPS_); }
#pragma unroll
      for (int j = 0; j < 4; ++j)
        *(u32x2*)(stg + (j * 16 + l15) * VLD + i * 16 + quad * 4) = (u32x2){pk2(acc[i][j][0] * rs[0], acc[i][j][1] * rs[1]), pk2(acc[i][j][2] * rs[2], acc[i][j][3] * rs[3])};
    }
    stage_out<64, 128, VLD>(stg, dst + ((size_t)((trow0 >> 12) * 8 + h) * 64) * S_ + (trow0 & 4095), (size_t)S_, lane);
  } else if constexpr (KIND == 1) {
#pragma unroll
    for (int i = 0; i < 8; ++i) {
      asm volatile("" ::: "memory");
      const int row = i * 16 + l15, t = trow0 + row; const float* c = cssq + (size_t)t * 16;
      const float rs = rsqrtf((c[8] + c[9] + c[10] + c[11]) * (1.f / 256.f) + EPS_);
#pragma unroll
      for (int j = 0; j < 4; ++j) stage4(stg, row, j * 16 + quad * 4, acc[i][j], rs);
    }
    stage_out<128, 64, STG_LD>(stg, (bf16_t*)(p.ws + O_MLAKN) + (size_t)trow0 * 512 + (tn - 3) * 256 + wn * 64, (size_t)512, lane);
  } else {
    const int n0 = tn * 256 + wn * 64, ph = n0 % 96;
#pragma unroll
    for (int i = 0; i < 8; ++i) {
      asm volatile("" ::: "memory");
      const int row = i * 16 + l15, t = trow0 + row; const float* c = cssq + (size_t)t * 16;
      const float rs = rsqrtf((c[0] + c[1] + c[2] + c[3] + c[4] + c[5]) * (1.f / 384.f) + EPS_) * QS96_;
      f32x4 v0 = acc[i][0] * rs, v1 = acc[i][1] * rs, v2 = acc[i][2] * rs, v3 = acc[i][3] * rs;
      if (ph != 0) {
        const float* rp = (const float*)(p.ws + O_ROPE16) + (size_t)t * 32 + quad * 8;
        const f32x4 x1 = ph == 64 ? v0 : v2, x2 = ph == 64 ? v1 : v3; f32x4 o1, o2;
#pragma unroll
        for (int r = 0; r < 4; ++r) { const float cs = rp[2 * r], sn = rp[2 * r + 1]; o1[r] = x1[r] * cs - x2[r] * sn; o2[r] = x2[r] * cs + x1[r] * sn; }
        if (ph == 64) { v0 = o1; v1 = o2; } else { v2 = o1; v3 = o2; }
      }
      stage4(stg, row, quad * 4, v0, 1.f); stage4(stg, row, 16 + quad * 4, v1, 1.f); stage4(stg, row, 32 + quad * 4, v2, 1.f); stage4(stg, row, 48 + quad * 4, v3, 1.f);
    }
    stage_out<128, 64, STG_LD>(stg, (bf16_t*)(p.ws + O_MLAQ) + (size_t)trow0 * 768 + n0, (size_t)768, lane);
  }
  __syncthreads();
}
struct CmpRowPtr { const bf16_t* base; int r0;
  DI unsigned operator()(int r) const { int R = r0 + r; if (R >= 4080) R = 0; const int b = R / 510, rem = R - b * 510, n = rem >> 1, g = rem & 1; return (unsigned)(b * S_ + 16 * n) * 256u + g * 64; }
  DI bool ok(int r) const { return r0 + r < 4080; } };
DI void compress_item(const Params& p, int layer, int item, bf16_t* smem) {
  const int kv = item >> 4, tm = item & 15;
  const bf16_t* wl = (const bf16_t*)(p.ws + O_W) + (size_t)layer * W_LAYER;
  f32x4 acc[8][4]; zero_acc<8, 4>(acc);
  CmpRowPtr ap{(const bf16_t*)(p.ws + O_KVCMP) + kv * 128, tm * 256};
  RowPtr bp{wl + (kv ? W_1V : W_1K), (size_t)2048};
  gemm_main<8, 4, true>(acc, ap, 256, bp, 64, 32, smem);
  const int lane = TIDX() & 63, wid = TIDX() >> 6, wm = wid >> 2, wn = wid & 3, l15 = lane & 15, quad = lane >> 4;
  constexpr int LDH = 264; bf16_t* H = smem;
  const float* b1 = (const float*)(p.ws + O_BIAS1) + (size_t)(layer * 2 + kv) * 16 * 256;
#pragma unroll
  for (int j = 0; j < 4; ++j) {
    asm volatile("" ::: "memory");
    f32x4 bv = {0.f, 0.f, 0.f, 0.f};
    for (int pc = 0; pc < 16; ++pc) bv += *(const f32x4*)(b1 + pc * 256 + wn * 64 + j * 16 + quad * 4);
#pragma unroll
    for (int i = 0; i < 8; ++i) {
      const int row = wm * 128 + i * 16 + l15, col = wn * 64 + j * 16 + quad * 4;
      *(u32x2*)(H + row * LDH + col) = (u32x2){pk2(gelu_tanh(acc[i][j][0] + bv[0]), gelu_tanh(acc[i][j][1] + bv[1])), pk2(gelu_tanh(acc[i][j][2] + bv[2]), gelu_tanh(acc[i][j][3] + bv[3]))};
    }
  }
  __syncthreads();
  f32x4 a2[2][4];
#pragma unroll
  for (int i = 0; i < 2; ++i)
#pragma unroll
    for (int j = 0; j < 4; ++j) a2[i][j] = (f32x4){0.f, 0.f, 0.f, 0.f};
  const bf16_t* w2 = wl + (kv ? W_2V : W_2K);
#pragma unroll
  for (int ks = 0; ks < 8; ++ks) {
    bf16x8 a[2], b[4];
#pragma unroll
    for (int i = 0; i < 2; ++i) a[i] = *(const bf16x8*)(H + (wid * 32 + i * 16 + l15) * LDH + ks * 32 + quad * 8);
#pragma unroll
    for (int j = 0; j < 4; ++j) b[j] = *(const bf16x8*)(w2 + (size_t)(j * 16 + l15) * 256 + ks * 32 + quad * 8);
#pragma unroll
    for (int i = 0; i < 2; ++i)
#pragma unroll
      for (int j = 0; j < 4; ++j) a2[i][j] = mfma16(a[i], b[j], a2[i][j]);
  }
  bf16_t* kc = (bf16_t*)(p.ws + O_KC); bf16_t* vct = (bf16_t*)(p.ws + O_VCT);
#pragma unroll
  for (int i = 0; i < 2; ++i)
#pragma unroll
    for (int r = 0; r < 4; ++r) {
      const int R = tm * 256 + wid * 32 + i * 16 + quad * 4 + r;
      if (R < 4080) {
        const int b = R / 510, rem = R - b * 510, n = rem >> 1, g = rem & 1;
#pragma unroll
        for (int j = 0; j < 4; ++j) {
          const int d = j * 16 + l15; const bf16_t v = f2bf(a2[i][j][r]);
          if (kv == 0) kc[((size_t)(b * 2 + g) * 256 + n) * 64 + d] = v; else vct[((size_t)(b * 2 + g) * 64 + d) * 256 + n] = v;
        }
      }
    }
  __syncthreads();
}
DI void foxscan_item(const Params& p, int item, float* lds) {
  const int b = item >> 3, h = item & 7, tid = TIDX();
  const float* lf = (const float*)(p.ws + O_LOGF) + (size_t)b * S_ * 8 + h; float v[8]; float s = 0.f;
#pragma unroll
  for (int i = 0; i < 8; ++i) { s += lf[(size_t)(tid * 8 + i) * 8]; v[i] = s; }
  lds[tid] = s; __syncthreads();
  float off = 0.f;
  for (int i = 0; i < tid; ++i) off += lds[i];
  float* F2 = (float*)(p.ws + O_F2) + (size_t)(b * 8 + h) * S_ + tid * 8;
#pragma unroll
  for (int i = 0; i < 8; ++i) F2[i] = -(off + v[i]) * LOG2E_;
  __syncthreads();
}
DI void phase_b(const Params& p, int layer, unsigned char* smem) {
  for (int it = blockIdx.x; it < 96; it += gridDim.x) {
    if (it < 32) compress_item(p, layer, it, (bf16_t*)smem);
    else foxscan_item(p, it - 32, (float*)smem);
  }
  xcd_tiles(16, 7, [&](int tm, int tn) {
    if (tn >= 5) mlaup_tile<2>(p, layer, tm, tn, (bf16_t*)smem); else if (tn >= 3) mlaup_tile<1>(p, layer, tm, tn, (bf16_t*)smem); else mlaup_tile<0>(p, layer, tm, tn, (bf16_t*)smem);
  });
}

constexpr int KC_LD = 72, VC_LD = 264;
DI void cmp_item(const Params& p, int item, unsigned char* smem_) {
  const int b = item >> 6, g = (item >> 5) & 1, tt = item & 31, t0 = tt * 128;
  const int tid = TIDX(), lane = tid & 63, wid = tid >> 6, l15 = lane & 15, quad = lane >> 4;
  bf16_t* kcs = (bf16_t*)smem_;
  bf16_t* vcs = kcs + 256 * KC_LD;
  float* imps = (float*)smem_;
  const int nmax = (t0 + 96) >> 4;
  const int nsub = (nmax >> 4) + 1;
  {
    const bf16_t* kcg = (const bf16_t*)(p.ws + O_KC) + (size_t)(b * 2 + g) * 256 * 64; const bf16_t* vcg = (const bf16_t*)(p.ws + O_VCT) + (size_t)(b * 2 + g) * 64 * 256;
    const int nrows = ((nsub + 1) & ~1) * 16;
    for (int e = tid; e < nrows * 8; e += NTHR) {
      const int n = e >> 3, dc = (e & 7) * 8;
      *(u32x4*)(kcs + n * KC_LD + dc) = n < 255 ? *(const u32x4*)(kcg + (size_t)n * 64 + dc) : (u32x4){0u, 0u, 0u, 0u};
    }
    const int ncs = nrows >> 3;
    for (int e = tid; e < 64 * ncs; e += NTHR) {
      const int d = e / ncs, nc = (e - d * ncs) * 8;
      u32x4 v = *(const u32x4*)(vcg + (size_t)d * 256 + nc);
      if (nc + 8 > 255) v[3] &= 0x0000ffffu;
      *(u32x4*)(vcs + d * VC_LD + nc) = v;
    }
  }
  __syncthreads();
  const int tq = t0 + wid * 16 + l15;
  const size_t trow = (size_t)b * S_ + tq;
  float impa[16], p3a[16];
#pragma unroll
  for (int s = 0; s < 16; ++s) { impa[s] = 0.f; p3a[s] = 0.f; }
  const float* gts = (const float*)(p.ws + O_GATES) + trow * 24;
#pragma unroll 1
  for (int r4 = 0; r4 < 4; ++r4) {
    const int head = g * 4 + r4;
    const bf16_t* qp = (const bf16_t*)(p.ws + O_NSAQ) + trow * 512 + head * 64 + quad * 8;
    const bf16x8 q0 = *(const bf16x8*)qp, q1 = *(const bf16x8*)(qp + 32);
    auto score = [&](int s) -> f32x4 {
      const bf16_t* kr = kcs + (s * 16 + l15) * KC_LD + quad * 8;
      f32x4 a = {0.f, 0.f, 0.f, 0.f};
      a = mfma16(*(const bf16x8*)kr, q0, a); a = mfma16(*(const bf16x8*)(kr + 32), q1, a);
#pragma unroll
      for (int r = 0; r < 4; ++r) { const int n = s * 16 + quad * 4 + r; a[r] = (16 * n + 31 <= tq) ? a[r] : -INFINITY; }
      return a;
    };
    float mx = -INFINITY;
#pragma unroll 1
    for (int s = 0; s < nsub; ++s) { const f32x4 a = score(s); mx = fmaxf(mx, fmaxf(fmaxf(a[0], a[1]), fmaxf(a[2], a[3]))); }
    mx = fmaxf(mx, __shfl_xor(mx, 16)); mx = fmaxf(mx, __shfl_xor(mx, 32));
    if (mx == -INFINITY) mx = 0.f;
    float sum = 0.f;
#pragma unroll 1
    for (int s = 0; s < nsub; ++s) { const f32x4 a = score(s); sum += (ex2(a[0] - mx) + ex2(a[1] - mx)) + (ex2(a[2] - mx) + ex2(a[3] - mx)); }
    sum += __shfl_xor(sum, 16); sum += __shfl_xor(sum, 32);
    const float inv = 1.f / fmaxf(sum, 1e-30f);
    f32x4 oacc[4];
#pragma unroll
    for (int j = 0; j < 4; ++j) oacc[j] = (f32x4){0.f, 0.f, 0.f, 0.f};
#pragma unroll
    for (int c = 0; c < 8; ++c) {
      asm volatile("" ::: "memory");
      if (2 * c < nsub) {
        f32x4 pa = score(2 * c), pb = {-INFINITY, -INFINITY, -INFINITY, -INFINITY};
        if (2 * c + 1 < nsub) pb = score(2 * c + 1);
#pragma unroll
        for (int r = 0; r < 4; ++r) { pa[r] = ex2(pa[r] - mx) * inv; pb[r] = ex2(pb[r] - mx) * inv; }
        impa[2 * c] += pa[0] + pa[1] + pa[2] + 0.5f * pa[3]; p3a[2 * c] += pa[3];
        impa[2 * c + 1] += pb[0] + pb[1] + pb[2] + 0.5f * pb[3]; p3a[2 * c + 1] += pb[3];
        const u32x4 pw = {pk2(pa[0], pa[1]), pk2(pa[2], pa[3]), pk2(pb[0], pb[1]), pk2(pb[2], pb[3])};
        const bf16x8 pf = __builtin_bit_cast(bf16x8, pw);
#pragma unroll
        for (int j = 0; j < 4; ++j) {
          const bf16_t* vr = vcs + (j * 16 + l15) * VC_LD + c * 32 + quad * 4;
          const u32x2 lo = *(const u32x2*)vr, hi = *(const u32x2*)(vr + 16);
          const u32x4 vw = {lo[0], lo[1], hi[0], hi[1]};
          oacc[j] = mfma16(__builtin_bit_cast(bf16x8, vw), pf, oacc[j]);
        }
      }
    }
    const float g0 = gts[head * 3 + 0];
    bf16_t* op = (bf16_t*)(p.ws + O_ONSA) + trow * 512 + head * 64 + quad * 4;
#pragma unroll
    for (int j = 0; j < 4; ++j) store4(op + j * 16, oacc[j], g0);
  }
  __syncthreads();
  float* myimp = imps + wid * 1024 + l15 * 64;
  const int cur = tq >> 6;
#pragma unroll
  for (int s = 0; s < 16; ++s) {
    const float up = __shfl(p3a[s], (lane + 48) & 63);
    const float up0 = s ? __shfl(p3a[s ? s - 1 : 0], (lane + 48) & 63) : 0.f;
    const float prev = quad ? up : up0;
    float v = impa[s] + 0.5f * prev;
    const int j = 4 * s + quad;
    if (j == 0 || j == cur || j == cur - 1) v = 1e9f; else if (j > cur) v = -1e9f;
    myimp[j] = v;
  }
  __syncthreads();
  u64* sel = (u64*)(p.ws + O_SEL) + (size_t)(b * 2 + g) * S_ + t0 + wid * 16;
#pragma unroll 1
  for (int q = 0; q < 16; ++q) {
    const float mine = imps[wid * 1024 + q * 64 + lane]; int rank = 0;
#pragma unroll
    for (int i = 0; i < 64; ++i) { const float v = __uint_as_float(__builtin_amdgcn_readlane(__float_as_uint(mine), i)); rank += (v > mine || (v == mine && i < lane)) ? 1 : 0; }
    const u64 m = __ballot(rank < 16);
    if (lane == 0) sel[q] = m;
  }
  __syncthreads();
}
constexpr int PC_ITEMS = NB_ * 2 * 32;
DI void phase_c(const Params& p, unsigned char* smem) { for (int it = blockIdx.x; it < PC_ITEMS; it += gridDim.x) cmp_item(p, it, smem); }

enum { M_FOX = 0, M_MLA = 1, M_WIN = 2, M_SLC = 3 };
template <int MODE> struct ACfg { static constexpr int DQK = MODE == M_MLA ? 96 : 64, KLD = DQK + 8, NKC = DQK / 8 * 64, KCH = (NKC + NTHR - 1) / NTHR, K_ELEMS = 64 * KLD, V_ELEMS = 64 * 72, STAGE = K_ELEMS + V_ELEMS + 128; };
struct AState { f32x16 o[2]; f32x16 mr; float m, l; };

template <int MODE>
DI void flash_pass(AState& st, const bf16x8* qf, u64 tmask, u64 wmask,
                   const bf16_t* kbase, size_t kld, const bf16_t* kpe, const bf16_t* vtbase, const float* fbias,
                   int tq, u64 mysel, bf16_t* smem) {
  typedef ACfg<MODE> C;
  const int tid = TIDX(), lane = tid & 63, l31 = lane & 31, half = lane >> 5;
  u32x4 rk[C::KCH], rv; float rf = 0.f;
  auto gload = [&](int j) {
    const int k0 = j * 64;
#pragma unroll
    for (int i = 0; i < C::KCH; ++i) {
      const int c = tid + NTHR * i;
      if (c < C::NKC) {
        if constexpr (MODE == M_MLA) { const int key = c / 12, dc = c % 12; rk[i] = dc < 8 ? *(const u32x4*)(kbase + (size_t)(k0 + key) * kld + dc * 8) : *(const u32x4*)(kpe + (size_t)(k0 + key) * 32 + (dc - 8) * 8); }
        else { const int key = c >> 3, dc = c & 7; rk[i] = *(const u32x4*)(kbase + (size_t)(k0 + key) * kld + dc * 8); }
      }
    }
    { const int d = tid >> 3, kc = tid & 7; rv = *(const u32x4*)(vtbase + (size_t)d * S_ + k0 + kc * 8); }
    if constexpr (MODE == M_FOX) { if (tid < 64) rf = fbias[k0 + tid]; }
  };
  auto sstore = [&](int buf) {
    bf16_t* Ks = smem + buf * C::STAGE; bf16_t* Vs = Ks + C::K_ELEMS;
#pragma unroll
    for (int i = 0; i < C::KCH; ++i) {
      const int c = tid + NTHR * i;
      if (c < C::NKC) {
        if constexpr (MODE == M_MLA) { const int key = c / 12, dc = c % 12; *(u32x4*)(Ks + key * C::KLD + dc * 8) = rk[i]; }
        else { const int key = c >> 3, dc = c & 7; *(u32x4*)(Ks + key * C::KLD + dc * 8) = rk[i]; }
      }
    }
    {
      const int d = tid >> 3, kc = tid & 7, cgp = kc >> 1, a = kc & 1;
      bf16_t* dst = Vs + d * 72 + cgp * 16 + 4 * a;
      *(u32x2*)dst = (u32x2){rv[0], rv[1]}; *(u32x2*)(dst + 8) = (u32x2){rv[2], rv[3]};
    }
    if constexpr (MODE == M_FOX) { if (tid < 64) ((float*)(Vs + C::V_ELEMS))[tid] = rf; }
  };
  u64 tm = tmask;
  if (tm == 0) return;
  int j = __builtin_ctzll(tm); tm &= tm - 1;
  gload(j); sstore(0); __syncthreads();
  int buf = 0;
  const int tmin = __builtin_amdgcn_readfirstlane(tq - l31), tmax = tmin + 31;
  while (true) {
    const int jn = tm ? __builtin_ctzll(tm) : -1; if (tm) tm &= tm - 1;
    if (jn >= 0) gload(jn);
    bool active = (wmask >> j) & 1;
    if constexpr (MODE == M_SLC) active = active && __any((mysel >> j) & 1);
    if (active) {
      const bf16_t* Ks = smem + buf * C::STAGE; const bf16_t* Vs = Ks + C::K_ELEMS;
      f32x16 s0 = st.mr, s1 = st.mr;
      const bf16_t* kr = Ks + l31 * C::KLD + half * 8;
#pragma unroll
      for (int ks = 0; ks < C::DQK / 16; ++ks) {
        s0 = mfma32(*(const bf16x8*)(kr + ks * 16), qf[ks], s0);
        s1 = mfma32(*(const bf16x8*)(kr + 32 * C::KLD + ks * 16), qf[ks], s1);
      }
      const int k0 = j * 64;
      if constexpr (MODE == M_FOX) {
        const float* fb = (const float*)(Vs + C::V_ELEMS) + 4 * half;
#pragma unroll
        for (int g4 = 0; g4 < 4; ++g4) {
          const f32x4 b0 = *(const f32x4*)(fb + 8 * g4), b1 = *(const f32x4*)(fb + 32 + 8 * g4);
#pragma unroll
          for (int r = 0; r < 4; ++r) { s0[4 * g4 + r] += b0[r]; s1[4 * g4 + r] += b1[r]; }
        }
      }
      bool need = k0 + 63 > tmin;
      if constexpr (MODE == M_WIN) need = need || (k0 <= tmax - 512);
      if constexpr (MODE == M_SLC) {
        if (!need) {
          const bool rsel = ((mysel >> j) & 1) != 0;
          if (!__all(rsel)) {
#pragma unroll
            for (int r = 0; r < 16; ++r) { s0[r] = rsel ? s0[r] : -INFINITY; s1[r] = rsel ? s1[r] : -INFINITY; }
          }
        }
      }
      if (need) {
        const bool rowok = MODE == M_SLC ? ((mysel >> j) & 1) != 0 : true;
#pragma unroll
        for (int r = 0; r < 16; ++r) {
          const int key = k0 + (r & 3) + 8 * (r >> 2) + 4 * half;
          bool ok0 = rowok && key <= tq, ok1 = rowok && key + 32 <= tq;
          if constexpr (MODE == M_WIN) { ok0 = ok0 && (tq - key < 512); ok1 = ok1 && (tq - key - 32 < 512); }
          s0[r] = ok0 ? s0[r] : -INFINITY; s1[r] = ok1 ? s1[r] : -INFINITY;
        }
      }
      int im = (int)0x80000000;
#pragma unroll
      for (int r = 0; r < 16; ++r) im = max(im, max(__float_as_int(s0[r]), __float_as_int(s1[r])));
      im = max(im, __shfl_xor(im, 32));
      constexpr int TBITS = 0x41200000;
      if (__any(im > TBITS)) {
        const float d = im > TBITS ? __int_as_float(im) : 0.f;
        const float a = ex2(-d);
#pragma unroll
        for (int r = 0; r < 16; ++r) { s0[r] -= d; s1[r] -= d; st.o[0][r] *= a; st.o[1][r] *= a; }
        st.l *= a; st.m += d;
#pragma unroll
        for (int r = 0; r < 16; ++r) st.mr[r] = -st.m;
      }
      float sum = 0.f;
#pragma unroll
      for (int r = 0; r < 16; ++r) { s0[r] = ex2(s0[r]); s1[r] = ex2(s1[r]); sum += s0[r] + s1[r]; }
      st.l += sum;
      const bf16_t* vr = Vs + l31 * 72 + half * 8;
#pragma unroll
      for (int c = 0; c < 4; ++c) {
        u32x4 pw;
        if (c < 2) pw = (u32x4){pk2(s0[8 * c + 0], s0[8 * c + 1]), pk2(s0[8 * c + 2], s0[8 * c + 3]), pk2(s0[8 * c + 4], s0[8 * c + 5]), pk2(s0[8 * c + 6], s0[8 * c + 7])};
        else pw = (u32x4){pk2(s1[8 * (c - 2) + 0], s1[8 * (c - 2) + 1]), pk2(s1[8 * (c - 2) + 2], s1[8 * (c - 2) + 3]), pk2(s1[8 * (c - 2) + 4], s1[8 * (c - 2) + 5]), pk2(s1[8 * (c - 2) + 6], s1[8 * (c - 2) + 7])};
        const bf16x8 pf = __builtin_bit_cast(bf16x8, pw);
        st.o[0] = mfma32(*(const bf16x8*)(vr + c * 16), pf, st.o[0]);
        st.o[1] = mfma32(*(const bf16x8*)(vr + 32 * 72 + c * 16), pf, st.o[1]);
      }
    }
    if (jn >= 0) sstore(buf ^ 1);
    __syncthreads();
    if (jn < 0) break;
    j = jn; buf ^= 1;
  }
}
DI void astate_init(AState& s) {
#pragma unroll
  for (int r = 0; r < 16; ++r) { s.o[0][r] = 0.f; s.o[1][r] = 0.f; }
#pragma unroll
  for (int r = 0; r < 16; ++r) s.mr[r] = 0.f;
  s.m = 0.f; s.l = 0.f;
}
DI u64 lowbits(int n) { return n >= 64 ? ~0ull : ((1ull << n) - 1ull); }

template <int MODE> DI void dense_attn_item(const Params& p, int b, int h, int qt, bf16_t* smem) {
  const int lane = TIDX() & 63, wid = TIDX() >> 6, l31 = lane & 31, half = lane >> 5;
  const int t0 = qt * 256, tq = t0 + wid * 32 + l31; const size_t trow = (size_t)b * S_ + tq;
  constexpr int NQ = ACfg<MODE>::DQK / 16;
  bf16x8 qf[NQ];
  const bf16_t* qp = MODE == M_FOX ? (const bf16_t*)(p.ws + O_FOXQ) + trow * 512 + h * 64 : (const bf16_t*)(p.ws + O_MLAQ) + trow * 768 + h * 96;
#pragma unroll
  for (int ks = 0; ks < NQ; ++ks) qf[ks] = *(const bf16x8*)(qp + ks * 16 + half * 8);
  AState st; astate_init(st);
  const u64 tmask = lowbits(4 * qt + 4), wmask = lowbits(((t0 + wid * 32 + 31) >> 6) + 1);
  if constexpr (MODE == M_FOX)
    flash_pass<M_FOX>(st, qf, tmask, wmask, (const bf16_t*)(p.ws + O_FOXK) + (size_t)b * S_ * 512 + h * 64, 512, nullptr,
                      (const bf16_t*)(p.ws + O_FOXVT) + (size_t)(b * 8 + h) * 64 * S_, (const float*)(p.ws + O_F2) + (size_t)(b * 8 + h) * S_, tq, 0ull, smem);
  else
    flash_pass<M_MLA>(st, qf, tmask, wmask, (const bf16_t*)(p.ws + O_MLAKN) + (size_t)b * S_ * 512 + h * 64, 512, (const bf16_t*)(p.ws + O_MLAKPE) + (size_t)b * S_ * 32,
                      (const bf16_t*)(p.ws + O_MLAVT) + (size_t)(b * 8 + h) * 64 * S_, nullptr, tq, 0ull, smem);
  const float l = st.l + __shfl_xor(st.l, 32), inv = 1.f / fmaxf(l, 1e-30f);
  bf16_t* op = (bf16_t*)qp;
#pragma unroll
  for (int dt = 0; dt < 2; ++dt)
#pragma unroll
    for (int g4 = 0; g4 < 4; ++g4) {
      const int d = dt * 32 + g4 * 8 + half * 4;
      *(u32x2*)(op + d) = (u32x2){pk2(st.o[dt][4 * g4] * inv, st.o[dt][4 * g4 + 1] * inv), pk2(st.o[dt][4 * g4 + 2] * inv, st.o[dt][4 * g4 + 3] * inv)};
    }
}
DI void nsa_attn_item(const Params& p, int b, int g, int qt, bf16_t* smem) {
  const int lane = TIDX() & 63, wid = TIDX() >> 6, l31 = lane & 31, half = lane >> 5;
  const int t0 = qt * 64, tw0 = t0 + (wid >> 2) * 32, tq = tw0 + l31, head = g * 4 + (wid & 3); const size_t trow = (size_t)b * S_ + tq;
  bf16x8 qf[4];
  const bf16_t* qp = (const bf16_t*)(p.ws + O_NSAQ) + trow * 512 + head * 64;
#pragma unroll
  for (int ks = 0; ks < 4; ++ks) qf[ks] = *(const bf16x8*)(qp + ks * 16 + half * 8);
  {
    const float* rp = (const float*)(p.ws + O_ROPE8) + trow * 16;
    u32x4 me = __builtin_bit_cast(u32x4, qf[0]), ot;
#pragma unroll
    for (int e = 0; e < 4; ++e) ot[e] = __shfl_xor(me[e], 32);
    unsigned res[4];
#pragma unroll
    for (int e = 0; e < 4; ++e) {
      float o2[2];
#pragma unroll
      for (int u = 0; u < 2; ++u) {
        const int f = 2 * e + u; const float cs = rp[2 * f], sn = rp[2 * f + 1];
        const float a = bf2f((bf16_t)(u ? me[e] >> 16 : me[e] & 0xffffu)), o = bf2f((bf16_t)(u ? ot[e] >> 16 : ot[e] & 0xffffu));
        o2[u] = half == 0 ? a * cs - o * sn : a * cs + o * sn;
      }
      res[e] = pk2(o2[0], o2[1]);
    }
    qf[0] = __builtin_bit_cast(bf16x8, (u32x4){res[0], res[1], res[2], res[3]});
  }
  const float* gts = (const float*)(p.ws + O_GATES) + trow * 24 + head * 3;
  const int cur = t0 >> 6;
  f32x16 res[2];
  {
    AState st; astate_init(st);
    const int first = t0 >= 511 ? (t0 - 511) >> 6 : 0, firstw = tw0 >= 511 ? (tw0 - 511) >> 6 : 0;
    const u64 tmask = lowbits(cur + 1) & ~lowbits(first), wmask = lowbits(cur + 1) & ~lowbits(firstw);
    flash_pass<M_WIN>(st, qf, tmask, wmask, (const bf16_t*)(p.ws + O_KWIN) + (size_t)b * S_ * 128 + g * 64, 128, nullptr,
                      (const bf16_t*)(p.ws + O_VWINT) + (size_t)(b * 2 + g) * 64 * S_, nullptr, tq, 0ull, smem);
    const float l = st.l + __shfl_xor(st.l, 32), sc = gts[2] / fmaxf(l, 1e-30f);
#pragma unroll
    for (int r = 0; r < 16; ++r) { res[0][r] = st.o[0][r] * sc; res[1][r] = st.o[1][r] * sc; }
  }
  {
    AState st; astate_init(st);
    const u64* selp = (const u64*)(p.ws + O_SEL) + (size_t)(b * 2 + g) * S_;
    const u64 mysel = selp[tq];
    const u64 m64 = selp[t0 + lane];
    unsigned lo = (unsigned)m64, hi = (unsigned)(m64 >> 32);
#pragma unroll
    for (int o = 32; o >= 1; o >>= 1) { lo |= __shfl_xor(lo, o); hi |= __shfl_xor(hi, o); }
    const u64 um = (((u64)(unsigned)__builtin_amdgcn_readfirstlane(hi) << 32) | (u64)(unsigned)__builtin_amdgcn_readfirstlane(lo)) & lowbits(cur + 1);
    flash_pass<M_SLC>(st, qf, um, um, (const bf16_t*)(p.ws + O_KSLC) + (size_t)b * S_ * 128 + g * 64, 128, nullptr,
                      (const bf16_t*)(p.ws + O_VSLCT) + (size_t)(b * 2 + g) * 64 * S_, nullptr, tq, mysel, smem);
    const float l = st.l + __shfl_xor(st.l, 32), sc = gts[1] / fmaxf(l, 1e-30f);
#pragma unroll
    for (int r = 0; r < 16; ++r) { res[0][r] += st.o[0][r] * sc; res[1][r] += st.o[1][r] * sc; }
  }
  bf16_t* op = (bf16_t*)(p.ws + O_ONSA) + trow * 512 + head * 64;
#pragma unroll
  for (int dt = 0; dt < 2; ++dt)
#pragma unroll
    for (int g4 = 0; g4 < 4; ++g4) {
      const int d = dt * 32 + g4 * 8 + half * 4;
      const u32x2 oc = *(const u32x2*)(op + d);
      const float c0 = bf2f((bf16_t)(oc[0] & 0xffffu)), c1 = bf2f((bf16_t)(oc[0] >> 16)), c2 = bf2f((bf16_t)(oc[1] & 0xffffu)), c3 = bf2f((bf16_t)(oc[1] >> 16));
      *(u32x2*)(op + d) = (u32x2){pk2(res[dt][4 * g4] + c0, res[dt][4 * g4 + 1] + c1), pk2(res[dt][4 * g4 + 2] + c2, res[dt][4 * g4 + 3] + c3)};
    }
}
constexpr int PD_ITEMS = 16 * 192;
DI void phase_d(const Params& p, unsigned char* smem) {
  for (int it = blockIdx.x; it < PD_ITEMS; it += gridDim.x) {
    const int r = it / 192, w = it % 192, qt = 15 - r;
    if (w < 64) dense_attn_item<M_MLA>(p, w >> 3, w & 7, qt, (bf16_t*)smem);
    else if (w < 128) dense_attn_item<M_FOX>(p, (w - 64) >> 3, (w - 64) & 7, qt, (bf16_t*)smem);
    else { const int i = w - 128, bg = i & 15, q4 = i >> 4; nsa_attn_item(p, bg >> 1, bg & 1, qt * 4 + q4, (bf16_t*)smem); }
  }
}

DI void merge_tile(const Params& p, int layer, int tm, int tn, bf16_t* smem) {
  typedef GemmLds<4, 2> L;
  const bf16_t* wl = (const bf16_t*)(p.ws + O_W) + (size_t)layer * W_LAYER;
  const int tid = TIDX(), lane = tid & 63, wid = tid >> 6, wm = wid >> 2, wn = wid & 3, l15 = lane & 15, quad = lane >> 4;
  f32x4 mg[4][2]; zero_acc<4, 2>(mg);
  f32x4 acc[4][2]; zero_acc<4, 2>(acc);
  unsigned* gsp = (unsigned*)((unsigned char*)smem + 2 * L::STAGE * 2) + tid;
  const bf16_t* la; const bf16_t* lb; unsigned lald, lbld; int laks, lnk;
  auto get_seg = [&](int sg) {
    const int br = sg >> 1;
    if ((sg & 1) == 0) { la = (const bf16_t*)(p.ws + O_XG) + (size_t)tm * 128 * D_; lald = D_; laks = 64; lb = wl + W_G + ((size_t)br * 1024 + tn * 128) * D_; lbld = D_; lnk = 16; }
    else {
      lald = br == 2 ? 768u : 512u; laks = br == 2 ? 96 : 64; lnk = 8; lbld = 512u;
      la = (const bf16_t*)(p.ws + (br == 0 ? O_ONSA : br == 1 ? O_FOXQ : O_MLAQ)) + (size_t)tm * 128 * lald;
      lb = wl + (br == 0 ? W_BN : br == 1 ? W_BF : W_BM) + (size_t)tn * 128 * 512;
    }
  };
  unsigned pa[2], pb[2]; u32x4 ra[2], rb[2];
  auto set_offsets = [&]() {
#pragma unroll
    for (int i = 0; i < 2; ++i) { const int c = tid + NTHR * i; pa[i] = (unsigned)(c >> 3) * lald + (c & 7) * 8; pb[i] = (unsigned)(c >> 3) * lbld + (c & 7) * 8; }
  };
  int ls = 0, lkt = 0;
  get_seg(0); set_offsets();
  auto gload_next = [&]() {
    const bf16_t* ab = la + (size_t)lkt * laks; const bf16_t* bb = lb + (size_t)lkt * 64;
#pragma unroll
    for (int i = 0; i < 2; ++i) { ra[i] = *(const u32x4*)(ab + pa[i]); rb[i] = *(const u32x4*)(bb + pb[i]); }
    if (++lkt == lnk) {
      if (ls + 1 < 6) { ++ls; lkt = 0; get_seg(ls); set_offsets(); } else lkt = lnk - 1;
    }
  };
  auto sstore = [&](int buf) {
    bf16_t* As = smem + buf * L::STAGE; bf16_t* Bs = As + L::A_ELEMS;
#pragma unroll
    for (int i = 0; i < 2; ++i) { const int c = tid + NTHR * i; *(u32x4*)(As + (c >> 3) * LDT + (c & 7) * 8) = ra[i]; *(u32x4*)(Bs + (c >> 3) * LDT + (c & 7) * 8) = rb[i]; }
  };
  gload_next(); sstore(0); gload_next(); __syncthreads();
  int buf = 0;
#pragma unroll 1
  for (int sg = 0; sg < 6; ++sg) {
    const int nk = (sg & 1) ? 8 : 16;
#pragma unroll 1
    for (int kt = 0; kt < nk; ++kt) {
      sstore(buf ^ 1);
      gload_next();
      __builtin_amdgcn_sched_barrier(0);
      const bf16_t* As = smem + buf * L::STAGE + (wm * 64 + l15) * LDT + quad * 8;
      const bf16_t* Bs = smem + buf * L::STAGE + L::A_ELEMS + (wn * 32 + l15) * LDT + quad * 8;
#pragma unroll
      for (int ks = 0; ks < 2; ++ks) {
        bf16x8 b[2];
#pragma unroll
        for (int j = 0; j < 2; ++j) b[j] = *(const bf16x8*)(Bs + j * 16 * LDT + ks * 32);
#pragma unroll
        for (int i = 0; i < 4; ++i) {
          const bf16x8 a = *(const bf16x8*)(As + i * 16 * LDT + ks * 32);
#pragma unroll
          for (int j = 0; j < 2; ++j) acc[i][j] = mfma16(b[j], a, acc[i][j]);
        }
      }
      __syncthreads();
      buf ^= 1;
    }
    if ((sg & 1) == 0) {
#pragma unroll
      for (int i = 0; i < 4; ++i) {
        const float rs = rstd_from16((const float*)(p.ws + O_SSQ) + (size_t)(tm * 128 + wm * 64 + i * 16 + l15) * 16, 1.f / 1024.f);
#pragma unroll
        for (int j = 0; j < 2; ++j) {
          gsp[((i * 2 + j) * 2 + 0) * NTHR] = pk2(sigmoidf_(acc[i][j][0] * rs), sigmoidf_(acc[i][j][1] * rs));
          gsp[((i * 2 + j) * 2 + 1) * NTHR] = pk2(sigmoidf_(acc[i][j][2] * rs), sigmoidf_(acc[i][j][3] * rs));
        }
      }
    } else {
#pragma unroll
      for (int i = 0; i < 4; ++i)
#pragma unroll
        for (int j = 0; j < 2; ++j) {
          const unsigned w0 = gsp[((i * 2 + j) * 2 + 0) * NTHR], w1 = gsp[((i * 2 + j) * 2 + 1) * NTHR];
          mg[i][j][0] += bf2f((bf16_t)(w0 & 0xffffu)) * acc[i][j][0];
          mg[i][j][1] += bf2f((bf16_t)(w0 >> 16)) * acc[i][j][1];
          mg[i][j][2] += bf2f((bf16_t)(w1 & 0xffffu)) * acc[i][j][2];
          mg[i][j][3] += bf2f((bf16_t)(w1 >> 16)) * acc[i][j][3];
        }
    }
    zero_acc<4, 2>(acc);
  }
  bf16_t* stg = (bf16_t*)((unsigned char*)smem + 106496 + wid * 5120);
#pragma unroll
  for (int i = 0; i < 4; ++i)
#pragma unroll
    for (int j = 0; j < 2; ++j) *(u32x2*)(stg + (i * 16 + l15) * 40 + j * 16 + quad * 4) = (u32x2){pk2(mg[i][j][0], mg[i][j][1]), pk2(mg[i][j][2], mg[i][j][3])};
  stage_out<64, 32, 40>(stg, (bf16_t*)(p.ws + O_MERGED) + (size_t)(tm * 128 + wm * 64) * D_ + tn * 128 + wn * 32, (size_t)D_, lane);
}
DI void phase_e(const Params& p, int layer, unsigned char* smem) {
  xcd_tiles(32, 8, [&](int tm, int tn) { merge_tile(p, layer, tm, tn, (bf16_t*)smem); });
}

DI void resid_tile(const Params& p, const bf16_t* A, int K, const bf16_t* W, const float* xold, const float* gnext, int tm, int tn, bf16_t* smem) {
  f32x4 acc[8][4]; zero_acc<8, 4>(acc);
  RowPtr ap{A + (size_t)tm * 256 * K, (size_t)K}, bp{W + (size_t)tn * 256 * K, (size_t)K};
  gemm_main<8, 4, true>(acc, ap, 64, bp, 64, K / 64, smem);
  const int lane = TIDX() & 63, wid = TIDX() >> 6, wm = wid >> 2, wn = wid & 3, l15 = lane & 15, quad = lane >> 4;
  bf16_t* stg = smem + wid * STG_WAVE;
#pragma unroll
  for (int i = 0; i < 8; ++i) {
    const int t = tm * 256 + wm * 128 + i * 16 + l15, c0 = tn * 256 + wn * 64 + quad * 4; float s = 0.f;
#pragma unroll
    for (int j = 0; j < 4; ++j) {
      const size_t off = (size_t)t * D_ + c0 + j * 16;
      const f32x4 xn = *(const f32x4*)(xold + off) + acc[i][j];
      *(f32x4*)(p.out + off) = xn;
      s += xn[0] * xn[0] + xn[1] * xn[1] + xn[2] * xn[2] + xn[3] * xn[3];
      if (gnext) { const f32x4 gv = *(const f32x4*)(gnext + c0 + j * 16); *(u32x2*)(stg + (i * 16 + l15) * STG_LD + j * 16 + quad * 4) = (u32x2){pk2(xn[0] * gv[0], xn[1] * gv[1]), pk2(xn[2] * gv[2], xn[3] * gv[3])}; }
    }
    s += __shfl_xor(s, 16); s += __shfl_xor(s, 32);
    if (quad == 0) ((float*)(p.ws + O_SSQ))[(size_t)t * 16 + tn * 4 + wn] = s;
  }
  if (gnext) stage_out<128, 64, STG_LD>(stg, (bf16_t*)(p.ws + O_XG) + (size_t)(tm * 256 + wm * 128) * D_ + tn * 256 + wn * 64, (size_t)D_, lane);
  __syncthreads();
}
DI void phase_f(const Params& p, int layer, unsigned char* smem) {
  const bf16_t* wl = (const bf16_t*)(p.ws + O_W) + (size_t)layer * W_LAYER;
  xcd_tiles(16, 4, [&](int tm, int tn) { resid_tile(p, (const bf16_t*)(p.ws + O_MERGED), 1024, wl + W_OUT, layer == 0 ? p.x : p.out, p.ffn_norm + layer * D_, tm, tn, (bf16_t*)smem); });
}
DI void phase_h(const Params& p, int layer, unsigned char* smem) {
  const bf16_t* wl = (const bf16_t*)(p.ws + O_W) + (size_t)layer * W_LAYER;
  xcd_tiles(16, 4, [&](int tm, int tn) { resid_tile(p, (const bf16_t*)(p.ws + O_ACT), DFF_, wl + W_DN, p.out, layer == 0 ? p.mix_norm + D_ : nullptr, tm, tn, (bf16_t*)smem); });
}

struct UpRowPtr { const bf16_t* base; int s0;
  DI unsigned operator()(int r) const { const int s = s0 + r; return (unsigned)((s < 0 || s >= S_) ? 0 : s) * (unsigned)D_; }
  DI bool ok(int r) const { const int s = s0 + r; return s >= 0 && s < S_; } };
constexpr int PG_MT = 17;
DI void ffnup_tile(const Params& p, int layer, int b, int mt, int tn, bf16_t* smem) {
  const bf16_t* wl = (const bf16_t*)(p.ws + O_W) + (size_t)layer * W_LAYER;
  f32x4 acc[8][4]; zero_acc<8, 4>(acc);
  const int s0 = 254 * mt - 2;
  UpRowPtr ap{(const bf16_t*)(p.ws + O_XG) + (size_t)b * S_ * D_, s0}; RowPtr bp{wl + W_UP + (size_t)tn * 256 * D_, (size_t)D_};
  gemm_main<8, 4, true>(acc, ap, 64, bp, 64, 16, smem);
  const int tid = TIDX(), lane = tid & 63, wid = tid >> 6, wm = wid >> 2, wn = wid & 3, l15 = lane & 15, quad = lane >> 4;
  constexpr int LDU = 136; bf16_t* U = smem; bf16_t* V = smem + 256 * LDU;
  {
    bf16_t* dstb = (wn < 2 ? U : V) + (wn & 1) * 64 + quad * 4;
#pragma unroll
    for (int i = 0; i < 8; ++i) {
      const int row = wm * 128 + i * 16 + l15, s = s0 + row;
      const float rs = (s >= 0 && s < S_) ? rstd_from16((const float*)(p.ws + O_SSQ) + ((size_t)b * S_ + s) * 16, 1.f / 1024.f) : 0.f;
#pragma unroll
      for (int j = 0; j < 4; ++j) store4(dstb + row * LDU + j * 16, acc[i][j], rs);
    }
  }
  __syncthreads();
  {
    const int cc = tid & 15, cg0 = tn * 128 + cc * 8;
    const float* cw = p.conv_w + (size_t)layer * 3 * DFF_ + cg0; const float* cbp = p.conv_b + (size_t)layer * DFF_ + cg0;
    float w0[8], w1[8], w2[8], cb[8];
#pragma unroll
    for (int e = 0; e < 8; ++e) { w0[e] = cw[e]; w1[e] = cw[DFF_ + e]; w2[e] = cw[2 * DFF_ + e]; cb[e] = cbp[e]; }
    bf16_t* act = (bf16_t*)(p.ws + O_ACT);
#pragma unroll 2
    for (int it = 0; it < 8; ++it) {
      const int row = it * 32 + (tid >> 4), s = s0 + row;
      if (row >= 2 && s < S_) {
        const u32x4 u0 = *(const u32x4*)(U + (row - 2) * LDU + cc * 8), u1 = *(const u32x4*)(U + (row - 1) * LDU + cc * 8), u2 = *(const u32x4*)(U + row * LDU + cc * 8), vv = *(const u32x4*)(V + row * LDU + cc * 8);
        unsigned o[4];
#pragma unroll
        for (int e = 0; e < 4; ++e) {
          float r2[2];
#pragma unroll
          for (int h = 0; h < 2; ++h) {
            const int k = 2 * e + h;
            const float a0 = bf2f((bf16_t)(h ? u0[e] >> 16 : u0[e] & 0xffffu)), a1 = bf2f((bf16_t)(h ? u1[e] >> 16 : u1[e] & 0xffffu)), a2 = bf2f((bf16_t)(h ? u2[e] >> 16 : u2[e] & 0xffffu)), vx = bf2f((bf16_t)(h ? vv[e] >> 16 : vv[e] & 0xffffu));
            const float uc = w0[k] * a0 + w1[k] * a1 + w2[k] * a2 + cb[k];
            r2[h] = uc * sigmoidf_(uc) * vx;
          }
          o[e] = pk2(r2[0], r2[1]);
        }
        __builtin_nontemporal_store((u32x4){o[0], o[1], o[2], o[3]}, (u32x4*)(act + ((size_t)b * S_ + s) * DFF_ + cg0));
      }
    }
  }
  __syncthreads();
}
DI void phase_g(const Params& p, int layer, unsigned char* smem) {
  xcd_tiles(PG_MT, 22, [&](int tmg, int tn) { ffnup_tile(p, layer, tmg / PG_MT, tmg % PG_MT, tn, (bf16_t*)smem); });
}

DI void phase_final(const Params& p) {
  const int lane = TIDX() & 63, wid = TIDX() >> 6;
  for (int it = blockIdx.x; it < T_ / 8; it += gridDim.x) {
    const int t = it * 8 + wid; const float rs = rstd_from16((const float*)(p.ws + O_SSQ) + (size_t)t * 16, 1.f / 1024.f);
    float* xr = p.out + (size_t)t * D_;
#pragma unroll
    for (int c = 0; c < 4; ++c) { const int k = c * 256 + lane * 4; const f32x4 v = *(const f32x4*)(xr + k), gv = *(const f32x4*)(p.final_norm + k); *(f32x4*)(xr + k) = v * rs * gv; }
  }
}

#define XB_TMO      128
#define XB_XCNT(j)  (256  + 64 * (j))
#define XB_XSUB(j)  (1280 + 64 * (j))
#define XB_XGEN(j)  (2304 + 64 * (j))
#define XB_TOP      3328
#define XB_TOPGEN   3392
#define XCD_BAR_WORDS 3456
#define XB_SPIN_CAP (1u << 22)
#define LAS __attribute__((address_space(3)))
DI unsigned xb_ld(unsigned* p)              { return __hip_atomic_load(p, __ATOMIC_RELAXED, __HIP_MEMORY_SCOPE_AGENT); }
DI unsigned xb_add(unsigned* p, unsigned v) { return __hip_atomic_fetch_add(p, v, __ATOMIC_RELAXED, __HIP_MEMORY_SCOPE_AGENT); }
DI unsigned xb_xcc_id() { return (unsigned)__builtin_amdgcn_s_getreg((3 << 11) | 20) & 0xFu; }
#define XB_SPIN(cond, bar) do { unsigned _sp = 0; while (cond) { __builtin_amdgcn_s_sleep(1); \
    if ((++_sp & 255u) == 0u) { if (xb_ld(&(bar)[XB_TMO])) break; if (_sp > XB_SPIN_CAP) { atomicAdd(&(bar)[XB_TMO], 1u); break; } } } } while (0)
struct XcdBarrier { unsigned* bar; unsigned x; volatile LAS unsigned* st; };
DI XcdBarrier xcd_barrier_post(unsigned* bar, volatile LAS unsigned* st) {
  XcdBarrier b; b.bar = bar; b.x = xb_xcc_id(); b.st = st;
  if (threadIdx.x == 0) (void)xb_add(&bar[XB_XCNT(b.x)], 1u);
  return b;
}
DI void xcd_barrier_complete(unsigned* bar, unsigned x, unsigned& nloc, unsigned& nx) {
  const unsigned G = gridDim.x * gridDim.y * gridDim.z;
  unsigned sum, cnt, mine, sp = 0u;
  for (;;) {
    sum = 0u; cnt = 0u; mine = 0u;
#pragma unroll
    for (unsigned j = 0; j < 16; ++j) { const unsigned c = xb_ld(&bar[XB_XCNT(j)]); sum += c; cnt += (c > 0u) ? 1u : 0u; mine = (j == x) ? c : mine; }
    if (sum == G) break;
    __builtin_amdgcn_s_sleep(1);
    if ((++sp & 255u) == 0u) { if (xb_ld(&bar[XB_TMO])) break; if (sp > XB_SPIN_CAP) { atomicAdd(&bar[XB_TMO], 1u); break; } }
  }
  nloc = mine > 0u ? mine : 1u; nx = cnt > 0u ? cnt : 1u;
}
DI void xcd_barrier(const XcdBarrier& b) {
  asm volatile("s_waitcnt vmcnt(0)" ::: "memory");
  __syncthreads();
  if (threadIdx.x == 0) {
    unsigned* bar = b.bar;
    __builtin_amdgcn_s_waitcnt(0);
    unsigned nloc = b.st[0], nx = b.st[1];
    if (nloc == 0u) { xcd_barrier_complete(bar, b.x, nloc, nx); b.st[0] = nloc; b.st[1] = nx; }
    const unsigned old = xb_add(&bar[XB_XSUB(b.x)], 1u);
    const unsigned gen = old / nloc;
    if (old + 1u == (gen + 1u) * nloc) {
      __builtin_amdgcn_fence(__ATOMIC_RELEASE, "agent");
      asm volatile("s_waitcnt vmcnt(0)" ::: "memory");
      const unsigned og = xb_add(&bar[XB_TOP], 1u);
      const unsigned tg = og / nx;
      if (og + 1u == (tg + 1u) * nx) xb_add(&bar[XB_TOPGEN], 1u);
      else XB_SPIN(xb_ld(&bar[XB_TOPGEN]) == tg, bar);
      __builtin_amdgcn_fence(__ATOMIC_ACQUIRE, "agent");
      xb_add(&bar[XB_XGEN(b.x)], 1u);
      asm volatile("s_waitcnt vmcnt(0)" ::: "memory");
    } else {
      XB_SPIN(xb_ld(&bar[XB_XGEN(b.x)]) == gen, bar);
      __builtin_amdgcn_fence(__ATOMIC_ACQUIRE, "agent");
      asm volatile("s_waitcnt vmcnt(0)" ::: "memory");
    }
  }
  __syncthreads();
}
DI void run_phase(const Params& p, int ph, unsigned char* smem) {
  if (ph == 0) { phase_prep(p, smem); return; }
  if (ph == 17) { phase_final(p); return; }
  const int layer = (ph - 1) >> 3, s = (ph - 1) & 7;
#ifdef PROBE_DUP
  if ((PROBE_DUP >> s) & 1) {
    switch (s) { case 0: phase_inproj(p, layer, smem); break; case 1: phase_b(p, layer, smem); break; case 2: phase_c(p, smem); break; case 4: phase_e(p, layer, smem); break; case 6: phase_g(p, layer, smem); break; default: break; }
    __syncthreads();
  }
#endif
  switch (s) {
    case 0: phase_inproj(p, layer, smem); break;
    case 1: phase_b(p, layer, smem); break;
    case 2: phase_c(p, smem); break;
    case 3: phase_d(p, smem); break;
    case 4: phase_e(p, layer, smem); break;
    case 5: phase_f(p, layer, smem); break;
    case 6: phase_g(p, layer, smem); break;
    default: phase_h(p, layer, smem); break;
  }
}
constexpr int N_PHASES = 18;

#if ONE_LAUNCH
template <int PH> DI void run_all(const Params& p, unsigned char* smem, cg::grid_group& grid, const XcdBarrier& xb) {
  run_phase(p, PH, smem);
  if constexpr (PH + 1 < N_PHASES) {
    if constexpr (PH == 0) grid.sync(); else xcd_barrier(xb);
    run_all<PH + 1>(p, smem, grid, xb);
  }
}
__global__ void __launch_bounds__(NTHR, 2) mega_kernel(Params p) {
  __shared__ __attribute__((aligned(16))) unsigned char smem[SMEM_BYTES];
  __shared__ uint4 xb_words;
  if (threadIdx.x == 0) xb_words = make_uint4(0u, 0u, 0u, 0u);
  __syncthreads();
  const XcdBarrier xb = xcd_barrier_post((unsigned*)(p.ws + O_BAR), (volatile LAS unsigned*)&xb_words);
  cg::grid_group grid = cg::this_grid();
  run_all<0>(p, smem, grid, xb);
}
#else
template <int PH> __global__ void __launch_bounds__(NTHR, 2) phase_kernel(Params p) {
  __shared__ __attribute__((aligned(16))) unsigned char smem[SMEM_BYTES];
  run_phase(p, PH, smem);
}
template <int PH> static void launch_phases(const Params& p, hipStream_t stream) {
  hipLaunchKernelGGL((phase_kernel<PH>), dim3(256), dim3(NTHR), 0, stream, p);
  if constexpr (PH + 1 < N_PHASES) launch_phases<PH + 1>(p, stream);
}
#endif

extern "C" void kernel_launch(void* const* d_in, const int* in_sizes, int n_in, void* d_out, int out_size, void* d_ws, size_t ws_size, hipStream_t stream) {
  if (ws_size < O_END || n_in < 25) { fprintf(stderr, "workspace too small: %zu < %zu\n", ws_size, (size_t)O_END); return; }
  Params p{};
  p.x = (const float*)d_in[0]; p.pos = (const int*)d_in[1]; p.mix_norm = (const float*)d_in[2]; p.w_in = (const float*)d_in[3]; p.b_forget = (const float*)d_in[4];
  p.pe_k = (const float*)d_in[5]; p.w1_k = (const float*)d_in[6]; p.w2_k = (const float*)d_in[7]; p.pe_v = (const float*)d_in[8]; p.w1_v = (const float*)d_in[9]; p.w2_v = (const float*)d_in[10];
  p.q_norm = (const float*)d_in[11]; p.w_uq = (const float*)d_in[12]; p.kv_norm = (const float*)d_in[13]; p.w_ukv = (const float*)d_in[14];
  p.wbr_nsa = (const float*)d_in[15]; p.wbr_fox = (const float*)d_in[16]; p.wbr_mla = (const float*)d_in[17]; p.w_out = (const float*)d_in[18];
  p.ffn_norm = (const float*)d_in[19]; p.w_up = (const float*)d_in[20]; p.conv_w = (const float*)d_in[21]; p.conv_b = (const float*)d_in[22]; p.w_down = (const float*)d_in[23]; p.final_norm = (const float*)d_in[24];
  p.out = (float*)d_out; p.ws = (unsigned char*)d_ws;
#if ONE_LAUNCH
  static int grid_blocks = 0;
  if (!grid_blocks) {
    int dev = 0, cus = 0, per_cu = 0;
    hipGetDevice(&dev); hipDeviceGetAttribute(&cus, hipDeviceAttributeMultiprocessorCount, dev);
    hipOccupancyMaxActiveBlocksPerMultiprocessor(&per_cu, mega_kernel, NTHR, 0);
    if (per_cu > 1) per_cu = 1;
    grid_blocks = cus * per_cu;
  }
  hipMemsetAsync(p.ws + O_BAR, 0, XCD_BAR_WORDS * 4, stream);
  void* args[] = {&p};
  hipError_t e = hipLaunchCooperativeKernel((void*)mega_kernel, dim3(grid_blocks), dim3(NTHR), args, 0, stream);
  if (e != hipSuccess) fprintf(stderr, "cooperative launch failed: %s (grid %d)\n", hipGetErrorString(e), grid_blocks);
#else
  launch_phases<0>(p, stream);
#endif
}
```

```cpp
#include <hip/hip_runtime.h>
#include <hip/hip_cooperative_groups.h>
#include <stdint.h>
#include <stdio.h>
#include <type_traits>
namespace cg = cooperative_groups;

#ifndef ONE_LAUNCH
#define ONE_LAUNCH 1

#endif

#define DI __device__ __forceinline__
typedef unsigned short bf16_t;
typedef short bf16x8 __attribute__((ext_vector_type(8)));
typedef float f32x4 __attribute__((ext_vector_type(4)));
typedef float f32x16 __attribute__((ext_vector_type(16)));
typedef float f32x2 __attribute__((ext_vector_type(2)));
typedef __bf16 bfx2 __attribute__((ext_vector_type(2)));
typedef unsigned u32x4 __attribute__((ext_vector_type(4)));
typedef unsigned u32x2 __attribute__((ext_vector_type(2)));
typedef unsigned long long u64;

constexpr int T_ = 32768, S_ = 4096, NB_ = 8, D_ = 1024, DFF_ = 2816, NIN_ = 6592;
constexpr float EPS_ = 1e-6f;
constexpr float LOG2E_ = 1.4426950408889634f;
constexpr float QS64_ = 0.125f * LOG2E_;
constexpr float QS96_ = 0.10206207261596577f * LOG2E_;

constexpr size_t W_IN = 0;
constexpr size_t W_G = W_IN + (size_t)3584 * 1024;
constexpr size_t W_1K = W_G + (size_t)3072 * 1024;
constexpr size_t W_1V = W_1K + (size_t)256 * 2048;
constexpr size_t W_2K = W_1V + (size_t)256 * 2048;
constexpr size_t W_2V = W_2K + (size_t)64 * 256;
constexpr size_t W_UQ = W_2V + (size_t)64 * 256;
constexpr size_t W_UKV = W_UQ + (size_t)768 * 384;
constexpr size_t W_BN = W_UKV + (size_t)1024 * 256;
constexpr size_t W_BF = W_BN + (size_t)1024 * 512;
constexpr size_t W_BM = W_BF + (size_t)1024 * 512;
constexpr size_t W_OUT = W_BM + (size_t)1024 * 512;
constexpr size_t W_UP = W_OUT + (size_t)1024 * 1024;
constexpr size_t W_DN = W_UP + (size_t)5632 * 1024;
constexpr size_t W_LAYER = W_DN + (size_t)1024 * 2816;

constexpr size_t al256(size_t x) { return (x + 255) & ~(size_t)255; }
constexpr size_t O_BAR = 0;
constexpr size_t O_W = 16384;
constexpr size_t O_BIAS1 = al256(O_W + 2 * W_LAYER * 2);
constexpr size_t O_ROPE8 = al256(O_BIAS1 + 2 * 2 * 16 * 256 * 4);
constexpr size_t O_ROPE16 = al256(O_ROPE8 + (size_t)T_ * 16 * 4);
constexpr size_t O_XG = al256(O_ROPE16 + (size_t)T_ * 32 * 4);
constexpr size_t O_SSQ = al256(O_XG + (size_t)T_ * 1024 * 2);
constexpr size_t O_CSSQ = al256(O_SSQ + (size_t)T_ * 16 * 4);
constexpr size_t O_NSAQ = al256(O_CSSQ + (size_t)T_ * 16 * 4);
constexpr size_t O_KVCMP = O_NSAQ + (size_t)T_ * 512 * 2;
constexpr size_t O_KSLC = O_KVCMP + (size_t)T_ * 256 * 2;
constexpr size_t O_KWIN = O_KSLC + (size_t)T_ * 128 * 2;
constexpr size_t O_MERGED = O_NSAQ;
constexpr size_t O_VSLCT = O_KWIN + (size_t)T_ * 128 * 2;
constexpr size_t O_VWINT = O_VSLCT + (size_t)T_ * 128 * 2;
constexpr size_t O_FOXQ = O_VWINT + (size_t)T_ * 128 * 2;
constexpr size_t O_FOXK = O_FOXQ + (size_t)T_ * 512 * 2;
constexpr size_t O_FOXVT = O_FOXK + (size_t)T_ * 512 * 2;
constexpr size_t O_MLAQ = O_FOXVT + (size_t)T_ * 512 * 2;
constexpr size_t O_MLAKN = O_MLAQ + (size_t)T_ * 768 * 2;
constexpr size_t O_ACT = O_FOXQ;
constexpr size_t O_MLAVT = O_MLAKN + (size_t)T_ * 512 * 2;
constexpr size_t O_MLAKPE = O_MLAVT + (size_t)T_ * 512 * 2;
constexpr size_t O_ONSA = O_MLAKPE + (size_t)T_ * 32 * 2;
constexpr size_t O_CQ = O_ONSA;
constexpr size_t O_CKV = O_CQ + (size_t)T_ * 384 * 2;
constexpr size_t O_CEND = O_CKV + (size_t)T_ * 256 * 2;
constexpr size_t O_GATES = al256(O_CEND > O_ONSA + (size_t)T_ * 512 * 2 ? O_CEND : O_ONSA + (size_t)T_ * 512 * 2);
constexpr size_t O_LOGF = al256(O_GATES + (size_t)T_ * 24 * 4);
constexpr size_t O_F2 = al256(O_LOGF + (size_t)T_ * 8 * 4);
constexpr size_t O_KC = al256(O_F2 + (size_t)T_ * 8 * 4);
constexpr size_t O_VCT = al256(O_KC + (size_t)NB_ * 2 * 256 * 64 * 2);
constexpr size_t O_SEL = al256(O_VCT + (size_t)NB_ * 2 * 256 * 64 * 2);
constexpr size_t O_END = al256(O_SEL + (size_t)NB_ * 2 * S_ * 8);

struct Params {
  const float* x; const int* pos; const float* mix_norm; const float* w_in; const float* b_forget;
  const float* pe_k; const float* w1_k; const float* w2_k; const float* pe_v; const float* w1_v; const float* w2_v;
  const float* q_norm; const float* w_uq; const float* kv_norm; const float* w_ukv;
  const float* wbr_nsa; const float* wbr_fox; const float* wbr_mla; const float* w_out;
  const float* ffn_norm; const float* w_up; const float* conv_w; const float* conv_b; const float* w_down; const float* final_norm;
  float* out; unsigned char* ws;
};

constexpr int NTHR = 512;
constexpr int SMEM_BYTES = 147456;

DI int TIDX() { int t = (int)threadIdx.x; asm volatile("" : "+v"(t)); return t; }
DI unsigned pk2(float lo, float hi) { f32x2 v = {lo, hi}; return __builtin_bit_cast(unsigned, __builtin_convertvector(v, bfx2)); }
DI bf16_t f2bf(float x) { return (bf16_t)(pk2(x, 0.f) & 0xffffu); }
DI float bf2f(bf16_t h) { return __uint_as_float(((unsigned)h) << 16); }
DI float sigmoidf_(float x) { return 1.f / (1.f + __expf(-x)); }
DI float gelu_tanh(float x) { const float u = 0.7978845608028654f * (x + 0.044715f * x * x * x); return x / (1.f + __expf(-2.f * u)); }
DI float ex2(float x) { return __builtin_amdgcn_exp2f(x); }
DI f32x16 mfma32(bf16x8 a, bf16x8 b, f32x16 c) { return __builtin_amdgcn_mfma_f32_32x32x16_bf16(a, b, c, 0, 0, 0); }
DI f32x4 mfma16(bf16x8 a, bf16x8 b, f32x4 c) { return __builtin_amdgcn_mfma_f32_16x16x32_bf16(a, b, c, 0, 0, 0); }
DI float rstd_from16(const float* p, float inv_n) {
  const f32x4 a = *(const f32x4*)p, b = *(const f32x4*)(p + 4), c = *(const f32x4*)(p + 8), d = *(const f32x4*)(p + 12);
  const float s = ((a[0] + a[1]) + (a[2] + a[3])) + ((b[0] + b[1]) + (b[2] + b[3])) + ((c[0] + c[1]) + (c[2] + c[3])) + ((d[0] + d[1]) + (d[2] + d[3]));
  return rsqrtf(s * inv_n + EPS_);
}

constexpr int LDT = 72;
template <int MI, int NJ> struct GemmLds { static constexpr int BM = 32 * MI, BN = 64 * NJ, A_ELEMS = BM * LDT, B_ELEMS = BN * LDT, STAGE = A_ELEMS + B_ELEMS; };

template <int MI, int NJ, bool SWAP, class AP, class BP>
DI void gemm_main(f32x4 (&acc)[MI][NJ], const AP& ap, int a_kstep, const BP& bp, int b_kstep, int nk, bf16_t* smem) {
  typedef GemmLds<MI, NJ> L;
  constexpr int CA = MI / 2, CB = NJ;
  const int tid = TIDX(), lane = tid & 63, wid = tid >> 6, wm = wid >> 2, wn = wid & 3, l15 = lane & 15, quad = lane >> 4;
  unsigned pa[CA], pb[CB]; bool oka[CA];
#pragma unroll
  for (int i = 0; i < CA; ++i) { const int c = tid + NTHR * i; pa[i] = ap(c >> 3) + (c & 7) * 8; oka[i] = ap.ok(c >> 3); }
#pragma unroll
  for (int i = 0; i < CB; ++i) { const int c = tid + NTHR * i; pb[i] = bp(c >> 3) + (c & 7) * 8; }
  u32x4 ra[CA], rb[CB];
  auto gload = [&](int kt) {
    const bf16_t* ab = ap.base + (size_t)kt * a_kstep; const bf16_t* bb = bp.base + (size_t)kt * b_kstep;
#pragma unroll
    for (int i = 0; i < CA; ++i) ra[i] = *(const u32x4*)(ab + pa[i]);
#pragma unroll
    for (int i = 0; i < CB; ++i) rb[i] = *(const u32x4*)(bb + pb[i]);
  };
  auto sstore = [&](int buf) {
    bf16_t* As = smem + buf * L::STAGE; bf16_t* Bs = As + L::A_ELEMS;
#pragma unroll
    for (int i = 0; i < CA; ++i) { const int c = tid + NTHR * i; *(u32x4*)(As + (c >> 3) * LDT + (c & 7) * 8) = oka[i] ? ra[i] : (u32x4){0u, 0u, 0u, 0u}; }
#pragma unroll
    for (int i = 0; i < CB; ++i) { const int c = tid + NTHR * i; *(u32x4*)(Bs + (c >> 3) * LDT + (c & 7) * 8) = rb[i]; }
  };
  gload(0); sstore(0); gload(nk > 1 ? 1 : 0); __syncthreads();
#pragma unroll 1
  for (int kt = 0; kt < nk; ++kt) {
    const int buf = kt & 1;
    sstore(buf ^ 1);
    gload(kt + 2 < nk ? kt + 2 : nk - 1);
    __builtin_amdgcn_sched_barrier(0);
    const bf16_t* As = smem + buf * L::STAGE + (wm * 16 * MI + l15) * LDT + quad * 8;
    const bf16_t* Bs = smem + buf * L::STAGE + L::A_ELEMS + (wn * 16 * NJ + l15) * LDT + quad * 8;
#pragma unroll
    for (int ks = 0; ks < 2; ++ks) {
      if (MI * NJ >= 32 && ks == 1) asm volatile("" ::: "memory");
      bf16x8 b[NJ];
#pragma unroll
      for (int j = 0; j < NJ; ++j) b[j] = *(const bf16x8*)(Bs + j * 16 * LDT + ks * 32);
#pragma unroll
      for (int i = 0; i < MI; ++i) {
        const bf16x8 a = *(const bf16x8*)(As + i * 16 * LDT + ks * 32);
#pragma unroll
        for (int j = 0; j < NJ; ++j) acc[i][j] = SWAP ? mfma16(b[j], a, acc[i][j]) : mfma16(a, b[j], acc[i][j]);
      }
    }
    __syncthreads();
  }
}
template <int MI, int NJ> DI void zero_acc(f32x4 (&acc)[MI][NJ]) {
#pragma unroll
  for (int i = 0; i < MI; ++i)
#pragma unroll
    for (int j = 0; j < NJ; ++j) acc[i][j] = (f32x4){0.f, 0.f, 0.f, 0.f};
}
struct RowPtr { const bf16_t* base; size_t ld; DI unsigned operator()(int r) const { return (unsigned)r * (unsigned)ld; } DI bool ok(int) const { return true; } };


template <class F> DI void xcd_tiles(int MPX, int NT, F&& body) {
  const int xcd = blockIdx.x & 7, slot = blockIdx.x >> 3, nslots = gridDim.x >> 3, total = MPX * NT;
  for (int li = slot; li < total; li += nslots) {
    const int mg = li / (8 * NT), rem = li - mg * 8 * NT;
    const int gsz = (MPX - mg * 8) < 8 ? (MPX - mg * 8) : 8;
    const int tn = rem / gsz, mi = rem - tn * gsz;
    body(xcd * MPX + mg * 8 + mi, tn);
  }
}

DI int map_col(int map, int n) {
  if (map == 0) return n;
  if (map == 1) {
    if (n < 896) return n;
    if (n < 1024) return 1024 + (n - 896);
    if (n < 1152) return 896 + (n - 1024);
    if (n < 1280) return n;
    if (n < 2816) return 1304 + (n - 1280);
    if (n < 3200) return 2848 + (n - 2816);
    if (n < 3456) return 3232 + (n - 3200);
    const int c = n - 3456;
    if (c < 24) return 1280 + c;
    if (c < 32) return 2840 + (c - 24);
    if (c < 64) return 3488 + (c - 32);
    return -1;
  }
  if (map == 2) { const int j = n >> 8, c = n & 255; return c < 128 ? j * 128 + c : DFF_ + j * 128 + (c - 128); }
  if (map == 3) { return n < 512 ? (n >> 6) * 128 + (n & 63) : ((n - 512) >> 6) * 128 + 64 + ((n - 512) & 63); }
  return n;
}
struct WJob { const float* src; const float* scale; bf16_t* dst; int K, N, ld, map, off; };
DI void prep_weight_tile(const WJob& j, int tile, float* lds) {
  const int ntn = j.N >> 6, tk = tile / ntn, tn = tile % ntn, tid = TIDX();
  const int n4 = (tid & 15) * 4; const int sc = map_col(j.map, tn * 64 + n4);
  f32x4 v[4];
#pragma unroll
  for (int i = 0; i < 4; ++i) {
    const int kk = (tid >> 4) + 32 * i, k = tk * 128 + kk;
    v[i] = sc >= 0 ? *(const f32x4*)(j.src + (size_t)k * j.ld + j.off + sc) : (f32x4){0.f, 0.f, 0.f, 0.f};
    if (j.scale) v[i] = v[i] * j.scale[k];
  }
#pragma unroll
  for (int i = 0; i < 4; ++i) {
    const int kk = (tid >> 4) + 32 * i;
#pragma unroll
    for (int e = 0; e < 4; ++e) lds[kk * 65 + n4 + e] = v[i][e];
  }
  __syncthreads();
  const int nn = tid >> 3, k0 = (tid & 7) * 16;
  unsigned w[8];
#pragma unroll
  for (int e = 0; e < 8; ++e) w[e] = pk2(lds[(k0 + 2 * e) * 65 + nn], lds[(k0 + 2 * e + 1) * 65 + nn]);
  bf16_t* d = j.dst + (size_t)(tn * 64 + nn) * j.K + tk * 128 + k0;
  *(u32x4*)d = (u32x4){w[0], w[1], w[2], w[3]}; *(u32x4*)(d + 8) = (u32x4){w[4], w[5], w[6], w[7]};
  __syncthreads();
}
DI WJob get_wjob(const Params& p, int layer, int id) {
  bf16_t* wl = (bf16_t*)(p.ws + O_W) + (size_t)layer * W_LAYER; WJob j; j.scale = nullptr; j.map = 0; j.off = 0;
  switch (id) {
    case 0: j.src = p.w_in + (size_t)layer * 1024 * NIN_; j.dst = wl + W_IN; j.K = 1024; j.N = 3584; j.ld = NIN_; j.map = 1; break;
    case 1: j.src = p.w_in + (size_t)layer * 1024 * NIN_; j.dst = wl + W_G; j.K = 1024; j.N = 3072; j.ld = NIN_; j.off = 3520; break;
    case 2: j.src = p.w1_k + (size_t)layer * 2048 * 256; j.dst = wl + W_1K; j.K = 2048; j.N = 256; j.ld = 256; break;
    case 3: j.src = p.w1_v + (size_t)layer * 2048 * 256; j.dst = wl + W_1V; j.K = 2048; j.N = 256; j.ld = 256; break;
    case 4: j.src = p.w2_k + (size_t)layer * 256 * 64; j.dst = wl + W_2K; j.K = 256; j.N = 64; j.ld = 64; break;
    case 5: j.src = p.w2_v + (size_t)layer * 256 * 64; j.dst = wl + W_2V; j.K = 256; j.N = 64; j.ld = 64; break;
    case 6: j.src = p.w_uq + (size_t)layer * 384 * 768; j.dst = wl + W_UQ; j.K = 384; j.N = 768; j.ld = 768; j.scale = p.q_norm + layer * 384; break;
    case 7: j.src = p.w_ukv + (size_t)layer * 256 * 1024; j.dst = wl + W_UKV; j.K = 256; j.N = 1024; j.ld = 1024; j.scale = p.kv_norm + layer * 256; j.map = 3; break;
    case 8: j.src = p.wbr_nsa + (size_t)layer * 512 * 1024; j.dst = wl + W_BN; j.K = 512; j.N = 1024; j.ld = 1024; break;
    case 9: j.src = p.wbr_fox + (size_t)layer * 512 * 1024; j.dst = wl + W_BF; j.K = 512; j.N = 1024; j.ld = 1024; break;
    case 10: j.src = p.wbr_mla + (size_t)layer * 512 * 1024; j.dst = wl + W_BM; j.K = 512; j.N = 1024; j.ld = 1024; break;
    case 11: j.src = p.w_out + (size_t)layer * 1024 * 1024; j.dst = wl + W_OUT; j.K = 1024; j.N = 1024; j.ld = 1024; break;
    case 12: j.src = p.w_up + (size_t)layer * 1024 * 5632; j.dst = wl + W_UP; j.K = 1024; j.N = 5632; j.ld = 5632; j.map = 2; break;
    default: j.src = p.w_down + (size_t)layer * 2816 * 1024; j.dst = wl + W_DN; j.K = 2816; j.N = 1024; j.ld = 1024; break;
  }
  return j;
}
constexpr int WTILES_LAYER = (int)(W_LAYER / 8192);
constexpr int P0_XITEMS = T_ / 64;
constexpr int P0_ROPE_ITEMS = T_ / NTHR;
constexpr int P0_ITEMS = 2 * WTILES_LAYER + 64 + P0_ROPE_ITEMS + P0_XITEMS;

DI void xg_rows(const float* x, const float* g, bf16_t* xg, float* ssq, int row0) {
  const int lane = TIDX() & 63, wid = TIDX() >> 6;
  for (int rr = 0; rr < 8; ++rr) {
    const int t = row0 + wid * 8 + rr; const float* xr = x + (size_t)t * D_; float s = 0.f;
#pragma unroll
    for (int c = 0; c < 4; ++c) {
      const int k = c * 256 + lane * 4; const f32x4 v = *(const f32x4*)(xr + k), gv = *(const f32x4*)(g + k);
      s += v[0] * v[0] + v[1] * v[1] + v[2] * v[2] + v[3] * v[3];
      *(u32x2*)(xg + (size_t)t * D_ + k) = (u32x2){pk2(v[0] * gv[0], v[1] * gv[1]), pk2(v[2] * gv[2], v[3] * gv[3])};
    }
#pragma unroll
    for (int o = 32; o >= 1; o >>= 1) s += __shfl_xor(s, o);
    if (lane < 16) ssq[(size_t)t * 16 + lane] = lane == 0 ? s : 0.f;
  }
}
DI void phase_prep(const Params& p, unsigned char* smem) {
  for (int it = blockIdx.x; it < P0_ITEMS; it += gridDim.x) {
    int i = it;
    if (i < 2 * WTILES_LAYER) {
      const int layer = i / WTILES_LAYER; int t = i % WTILES_LAYER; int id = 0;
      for (;; ++id) { const WJob j = get_wjob(p, layer, id); const int nt = (j.K >> 7) * (j.N >> 6); if (t < nt) { prep_weight_tile(j, t, (float*)smem); break; } t -= nt; }
      continue;
    }
    i -= 2 * WTILES_LAYER;
    if (i < 64) {
      const int lk = i >> 4, pc = i & 15, layer = lk >> 1, kv = lk & 1, c = TIDX() & 255, hf = TIDX() >> 8;
      const float* pe = (kv ? p.pe_v : p.pe_k) + (size_t)layer * 2048 + pc * 128 + hf * 64; const float* w1 = (kv ? p.w1_v : p.w1_k) + (size_t)layer * 2048 * 256 + (size_t)(pc * 128 + hf * 64) * 256;
      float sacc = 0.f;
#pragma unroll 8
      for (int kk = 0; kk < 64; ++kk) sacc += pe[kk] * w1[(size_t)kk * 256 + c];
      float* lds = (float*)smem;
      if (hf) lds[c] = sacc;
      __syncthreads();
      if (!hf) ((float*)(p.ws + O_BIAS1))[(lk * 16 + pc) * 256 + c] = sacc + lds[c];
      __syncthreads();
      continue;
    }
    i -= 64;
    if (i < P0_ROPE_ITEMS) {
      const int t = i * NTHR + TIDX(); const float fp = (float)p.pos[t];
      float* r8 = (float*)(p.ws + O_ROPE8) + (size_t)t * 16; float* r16 = (float*)(p.ws + O_ROPE16) + (size_t)t * 32;
      for (int f = 0; f < 24; ++f) {
        const int half = f < 8 ? 8 : 16, idx = f < 8 ? f : f - 8;
        const float inv = exp2f(-(float)idx / (float)half * 18.931568569324174f);
        const float ang = fp * inv;
        const double rev = (double)ang * 0.15915494309189535; const float fr = (float)(rev - floor(rev));
        const float sn = __builtin_amdgcn_sinf(fr), cs = __builtin_amdgcn_cosf(fr);
        if (f < 8) { r8[2 * idx] = cs; r8[2 * idx + 1] = sn; } else { r16[2 * idx] = cs; r16[2 * idx + 1] = sn; }
      }
      continue;
    }
    i -= P0_ROPE_ITEMS;
    xg_rows(p.x, p.mix_norm, (bf16_t*)(p.ws + O_XG), (float*)(p.ws + O_SSQ), i * 64);
  }
}

DI void store4(bf16_t* dst, const f32x4& v, float s) { *(u32x2*)dst = (u32x2){pk2(v[0] * s, v[1] * s), pk2(v[2] * s, v[3] * s)}; }
constexpr int STG_LD = 72, STG_WAVE = 128 * 72;
DI void stage4(bf16_t* stg, int row, int col, const f32x4& v, float s) { *(u32x2*)(stg + row * STG_LD + col) = (u32x2){pk2(v[0] * s, v[1] * s), pk2(v[2] * s, v[3] * s)}; }
template <int ROWS, int COLS, int LD> DI void stage_out(const bf16_t* stg, bf16_t* dst, size_t ld, int lane) {
  asm volatile("s_waitcnt lgkmcnt(0)" ::: "memory");
  constexpr int CPR = COLS / 8, IT = ROWS * CPR / 64;
#pragma unroll
  for (int it = 0; it < IT; ++it) {
    const int idx = it * 64 + lane, r = idx / CPR, c = idx % CPR;
    __builtin_nontemporal_store(*(const u32x4*)(stg + r * LD + c * 8), (u32x4*)(dst + (size_t)r * ld + c * 8));
  }
}
template <bool SWAP> DI void inproj_tile(const Params& p, int layer, int tm, int tn, bf16_t* smem) {
  const bf16_t* wl = (const bf16_t*)(p.ws + O_W) + (size_t)layer * W_LAYER;
  f32x4 acc[8][4]; zero_acc<8, 4>(acc);
  RowPtr ap{(const bf16_t*)(p.ws + O_XG) + (size_t)tm * 256 * D_, (size_t)D_}, bp{wl + W_IN + (size_t)tn * 256 * D_, (size_t)D_};
  gemm_main<8, 4, SWAP>(acc, ap, 64, bp, 64, 16, smem);
  const int lane = TIDX() & 63, wid = TIDX() >> 6, wm = wid >> 2, wn = wid & 3, l15 = lane & 15, quad = lane >> 4;
  const float* ssq = (const float*)(p.ws + O_SSQ);
  bf16_t* stg = smem + wid * STG_WAVE;
  const int trow0 = tm * 256 + wm * 128;
  if constexpr (!SWAP) {
    bf16_t* dst; int hh, hd;
    if (tn == 4) { dst = (bf16_t*)(p.ws + (wn < 2 ? O_VSLCT : O_VWINT)); hh = 2; hd = wn & 1; } else { dst = (bf16_t*)(p.ws + O_FOXVT); hh = 8; hd = (tn - 9) * 4 + wn; }
    constexpr int VLD = 136;
#pragma unroll
    for (int i = 0; i < 8; ++i) {
      const int t0 = trow0 + i * 16 + quad * 4;
      float rs[4];
#pragma unroll
      for (int r = 0; r < 4; ++r) rs[r] = rstd_from16(ssq + (size_t)(t0 + r) * 16, 1.f / 1024.f);
#pragma unroll
      for (int j = 0; j < 4; ++j)
        *(u32x2*)(stg + (j * 16 + l15) * VLD + i * 16 + quad * 4) = (u32x2){pk2(acc[i][j][0] * rs[0], acc[i][j][1] * rs[1]), pk2(acc[i][j][2] * rs[2], acc[i][j][3] * rs[3])};
    }
    const int b = trow0 >> 12, s0 = trow0 & 4095;
    stage_out<64, 128, VLD>(stg, dst + ((size_t)(b * hh + hd) * 64) * S_ + s0, (size_t)S_, lane);
  } else {
    const int slab = tn * 4 + wn;
    if (slab == 54) {
#pragma unroll
      for (int i = 0; i < 8; ++i) {
        const int t = trow0 + i * 16 + l15; const float rs = rstd_from16(ssq + (size_t)t * 16, 1.f / 1024.f);
        float* gt = (float*)(p.ws + O_GATES) + (size_t)t * 24; float* lf = (float*)(p.ws + O_LOGF) + (size_t)t * 8;
#pragma unroll
        for (int r = 0; r < 4; ++r) gt[quad * 4 + r] = sigmoidf_(acc[i][0][r] * rs);
        if (quad < 2) {
#pragma unroll
          for (int r = 0; r < 4; ++r) gt[16 + quad * 4 + r] = sigmoidf_(acc[i][1][r] * rs);
        } else {
#pragma unroll
          for (int r = 0; r < 4; ++r) { const int h = (quad - 2) * 4 + r; const float xx = acc[i][1][r] * rs + p.b_forget[layer * 8 + h]; lf[h] = fminf(xx, 0.f) - log1pf(__expf(-fabsf(xx))); }
        }
        const float* rp = (const float*)(p.ws + O_ROPE16) + (size_t)t * 32 + quad * 8; float o1[4], o2[4];
#pragma unroll
        for (int r = 0; r < 4; ++r) { const float cs = rp[2 * r], sn = rp[2 * r + 1], x1 = acc[i][2][r] * rs, x2 = acc[i][3][r] * rs; o1[r] = x1 * cs - x2 * sn; o2[r] = x2 * cs + x1 * sn; }
        bf16_t* kp = (bf16_t*)(p.ws + O_MLAKPE) + (size_t)t * 32 + quad * 4;
        *(u32x2*)kp = (u32x2){pk2(o1[0], o1[1]), pk2(o1[2], o1[3])}; *(u32x2*)(kp + 16) = (u32x2){pk2(o2[0], o2[1]), pk2(o2[2], o2[3])};
      }
    } else if (slab != 55) {
      bf16_t* dbuf; int dld, dcol, kind = 0; float qs = 1.f; int cslot = 0;
      if (slab < 8) { dbuf = (bf16_t*)(p.ws + O_NSAQ); dld = 512; dcol = slab * 64; qs = QS64_; }
      else if (slab < 12) { dbuf = (bf16_t*)(p.ws + O_KVCMP); dld = 256; dcol = (slab - 8) * 64; }
      else if (slab < 16) { dbuf = (bf16_t*)(p.ws + (slab < 14 ? O_KSLC : O_KWIN)); dld = 128; dcol = (slab & 1) * 64; kind = 1; }
      else if (slab < 28) { dbuf = (bf16_t*)(p.ws + O_FOXQ); dld = 512; dcol = (slab - 20) * 64; qs = QS64_; }
      else if (slab < 36) { dbuf = (bf16_t*)(p.ws + O_FOXK); dld = 512; dcol = (slab - 28) * 64; }
      else if (slab < 50) { dbuf = (bf16_t*)(p.ws + O_CQ); dld = 384; dcol = (slab - 44) * 64; kind = 2; cslot = slab - 44; }
      else { dbuf = (bf16_t*)(p.ws + O_CKV); dld = 256; dcol = (slab - 50) * 64; kind = 2; cslot = 8 + slab - 50; }
#pragma unroll
      for (int i = 0; i < 8; ++i) {
        const int row = i * 16 + l15, t = trow0 + row; const float rs = rstd_from16(ssq + (size_t)t * 16, 1.f / 1024.f) * qs;
        if (kind == 1) {
          const float* rp = (const float*)(p.ws + O_ROPE8) + (size_t)t * 16 + (quad & 1) * 8;
          f32x4 v, o;
#pragma unroll
          for (int r = 0; r < 4; ++r) { v[r] = acc[i][0][r] * rs; o[r] = __shfl_xor(v[r], 32); }
#pragma unroll
          for (int r = 0; r < 4; ++r) { const float cs = rp[2 * r], sn = rp[2 * r + 1]; v[r] = quad < 2 ? v[r] * cs - o[r] * sn : v[r] * cs + o[r] * sn; }
          stage4(stg, row, quad * 4, v, 1.f);
        } else stage4(stg, row, quad * 4, acc[i][0], rs);
#pragma unroll
        for (int j = 1; j < 4; ++j) stage4(stg, row, j * 16 + quad * 4, acc[i][j], rs);
        if (kind == 2) {
          float s = 0.f;
#pragma unroll
          for (int j = 0; j < 4; ++j) { const f32x4 a = acc[i][j] * rs; s += a[0] * a[0] + a[1] * a[1] + a[2] * a[2] + a[3] * a[3]; }
          s += __shfl_xor(s, 16); s += __shfl_xor(s, 32);
          if (quad == 0) ((float*)(p.ws + O_CSSQ))[(size_t)t * 16 + cslot] = s;
        }
      }
      stage_out<128, 64, STG_LD>(stg, dbuf + (size_t)trow0 * dld + dcol, (size_t)dld, lane);
    }
  }
  __syncthreads();
}
DI void phase_inproj(const Params& p, int layer, unsigned char* smem) {
  xcd_tiles(16, 14, [&](int tm, int tn) {
    const bool vt = (tn == 4 || tn == 9 || tn == 10);
    if (vt) inproj_tile<false>(p, layer, tm, tn, (bf16_t*)smem); else inproj_tile<true>(p, layer, tm, tn, (bf16_t*)smem);
  });
}

template <int KIND> DI void mlaup_tile(const Params& p, int layer, int tm, int tn, bf16_t* smem) {
  const bf16_t* wl = (const bf16_t*)(p.ws + O_W) + (size_t)layer * W_LAYER;
  f32x4 acc[8][4]; zero_acc<8, 4>(acc);
  constexpr int K = KIND == 0 ? 384 : 256;
  RowPtr ap{KIND == 0 ? (const bf16_t*)(p.ws + O_CQ) + (size_t)tm * 256 * 384 : (const bf16_t*)(p.ws + O_CKV) + (size_t)tm * 256 * 256, (size_t)K};
  RowPtr bp{KIND == 0 ? wl + W_UQ + (size_t)tn * 256 * 384 : wl + W_UKV + (size_t)(tn - 3) * 256 * 256, (size_t)K};
  gemm_main<8, 4, KIND != 2>(acc, ap, 64, bp, 64, K / 64, smem);
  const int lane = TIDX() & 63, wid = TIDX() >> 6, wm = wid >> 2, wn = wid & 3, l15 = lane & 15, quad = lane >> 4;
  const float* cssq = (const float*)(p.ws + O_CSSQ);
  bf16_t* stg = smem + wid * STG_WAVE; const int trow0 = tm * 256 + wm * 128;
  if constexpr (KIND == 2) {
    bf16_t* dst = (bf16_t*)(p.ws + O_MLAVT); const int h = (tn - 5) * 4 + wn;
    constexpr int VLD = 136;
#pragma unroll
    for (int i = 0; i < 8; ++i) {
      asm volatile("" ::: "memory");
      const int t0 = trow0 + i * 16 + quad * 4; float rs[4];
#pragma unroll
      for (int r = 0; r < 4; ++r) { const float* c = cssq + (size_t)(t0 + r) * 16 + 8; rs[r] = rsqrtf((c[0] + c[1] + c[2] + c[3]) * (1.f / 256.f) + EPS_); }
#pragma unroll
      for (int j = 0; j < 4; ++j)
        *(u32x2*)(stg + (j * 16 + l15) * VLD + i * 16 + quad * 4) = (u32x2){pk2(acc[i][j][0] * rs[0], acc[i][j][1] * rs[1]), pk2(acc[i][j][2] * rs[2], acc[i][j][3] * rs[3])};
    }
    stage_out<64, 128, VLD>(stg, dst + ((size_t)((trow0 >> 12) * 8 + h) * 64) * S_ + (trow0 & 4095), (size_t)S_, lane);
  } else if constexpr (KIND == 1) {
#pragma unroll
    for (int i = 0; i < 8; ++i) {
      asm volatile("" ::: "memory");
      const int row = i * 16 + l15, t = trow0 + row; const float* c = cssq + (size_t)t * 16;
      const float rs = rsqrtf((c[8] + c[9] + c[10] + c[11]) * (1.f / 256.f) + EPS_);
#pragma unroll
      for (int j = 0; j < 4; ++j) stage4(stg, row, j * 16 + quad * 4, acc[i][j], rs);
    }
    stage_out<128, 64, STG_LD>(stg, (bf16_t*)(p.ws + O_MLAKN) + (size_t)trow0 * 512 + (tn - 3) * 256 + wn * 64, (size_t)512, lane);
  } else {
    const int n0 = tn * 256 + wn * 64, ph = n0 % 96;
#pragma unroll
    for (int i = 0; i < 8; ++i) {
      asm volatile("" ::: "memory");
      const int row = i * 16 + l15, t = trow0 + row; const float* c = cssq + (size_t)t * 16;
      const float rs = rsqrtf((c[0] + c[1] + c[2] + c[3] + c[4] + c[5]) * (1.f / 384.f) + EPS_) * QS96_;
      f32x4 v0 = acc[i][0] * rs, v1 = acc[i][1] * rs, v2 = acc[i][2] * rs, v3 = acc[i][3] * rs;
      if (ph != 0) {
        const float* rp = (const float*)(p.ws + O_ROPE16) + (size_t)t * 32 + quad * 8;
        const f32x4 x1 = ph == 64 ? v0 : v2, x2 = ph == 64 ? v1 : v3; f32x4 o1, o2;
#pragma unroll
        for (int r = 0; r < 4; ++r) { const float cs = rp[2 * r], sn = rp[2 * r + 1]; o1[r] = x1[r] * cs - x2[r] * sn; o2[r] = x2[r] * cs + x1[r] * sn; }
        if (ph == 64) { v0 = o1; v1 = o2; } else { v2 = o1; v3 = o2; }
      }
      stage4(stg, row, quad * 4, v0, 1.f); stage4(stg, row, 16 + quad * 4, v1, 1.f); stage4(stg, row, 32 + quad * 4, v2, 1.f); stage4(stg, row, 48 + quad * 4, v3, 1.f);
    }
    stage_out<128, 64, STG_LD>(stg, (bf16_t*)(p.ws + O_MLAQ) + (size_t)trow0 * 768 + n0, (size_t)768, lane);
  }
  __syncthreads();
}
struct CmpRowPtr { const bf16_t* base; int r0;
  DI unsigned operator()(int r) const { int R = r0 + r; if (R >= 4080) R = 0; const int b = R / 510, rem = R - b * 510, n = rem >> 1, g = rem & 1; return (unsigned)(b * S_ + 16 * n) * 256u + g * 64; }
  DI bool ok(int r) const { return r0 + r < 4080; } };
DI void compress_item(const Params& p, int layer, int item, bf16_t* smem) {
  const int kv = item >> 4, tm = item & 15;
  const bf16_t* wl = (const bf16_t*)(p.ws + O_W) + (size_t)layer * W_LAYER;
  f32x4 acc[8][4]; zero_acc<8, 4>(acc);
  CmpRowPtr ap{(const bf16_t*)(p.ws + O_KVCMP) + kv * 128, tm * 256};
  RowPtr bp{wl + (kv ? W_1V : W_1K), (size_t)2048};
  gemm_main<8, 4, true>(acc, ap, 256, bp, 64, 32, smem);
  const int lane = TIDX() & 63, wid = TIDX() >> 6, wm = wid >> 2, wn = wid & 3, l15 = lane & 15, quad = lane >> 4;
  constexpr int LDH = 264; bf16_t* H = smem;
  const float* b1 = (const float*)(p.ws + O_BIAS1) + (size_t)(layer * 2 + kv) * 16 * 256;
#pragma unroll
  for (int j = 0; j < 4; ++j) {
    asm volatile("" ::: "memory");
    f32x4 bv = {0.f, 0.f, 0.f, 0.f};
    for (int pc = 0; pc < 16; ++pc) bv += *(const f32x4*)(b1 + pc * 256 + wn * 64 + j * 16 + quad * 4);
#pragma unroll
    for (int i = 0; i < 8; ++i) {
      const int row = wm * 128 + i * 16 + l15, col = wn * 64 + j * 16 + quad * 4;
      *(u32x2*)(H + row * LDH + col) = (u32x2){pk2(gelu_tanh(acc[i][j][0] + bv[0]), gelu_tanh(acc[i][j][1] + bv[1])), pk2(gelu_tanh(acc[i][j][2] + bv[2]), gelu_tanh(acc[i][j][3] + bv[3]))};
    }
  }
  __syncthreads();
  f32x4 a2[2][4];
#pragma unroll
  for (int i = 0; i < 2; ++i)
#pragma unroll
    for (int j = 0; j < 4; ++j) a2[i][j] = (f32x4){0.f, 0.f, 0.f, 0.f};
  const bf16_t* w2 = wl + (kv ? W_2V : W_2K);
#pragma unroll
  for (int ks = 0; ks < 8; ++ks) {
    bf16x8 a[2], b[4];
#pragma unroll
    for (int i = 0; i < 2; ++i) a[i] = *(const bf16x8*)(H + (wid * 32 + i * 16 + l15) * LDH + ks * 32 + quad * 8);
#pragma unroll
    for (int j = 0; j < 4; ++j) b[j] = *(const bf16x8*)(w2 + (size_t)(j * 16 + l15) * 256 + ks * 32 + quad * 8);
#pragma unroll
    for (int i = 0; i < 2; ++i)
#pragma unroll
      for (int j = 0; j < 4; ++j) a2[i][j] = mfma16(a[i], b[j], a2[i][j]);
  }
  bf16_t* kc = (bf16_t*)(p.ws + O_KC); bf16_t* vct = (bf16_t*)(p.ws + O_VCT);
#pragma unroll
  for (int i = 0; i < 2; ++i)
#pragma unroll
    for (int r = 0; r < 4; ++r) {
      const int R = tm * 256 + wid * 32 + i * 16 + quad * 4 + r;
      if (R < 4080) {
        const int b = R / 510, rem = R - b * 510, n = rem >> 1, g = rem & 1;
#pragma unroll
        for (int j = 0; j < 4; ++j) {
          const int d = j * 16 + l15; const bf16_t v = f2bf(a2[i][j][r]);
          if (kv == 0) kc[((size_t)(b * 2 + g) * 256 + n) * 64 + d] = v; else vct[((size_t)(b * 2 + g) * 64 + d) * 256 + n] = v;
        }
      }
    }
  __syncthreads();
}
DI void foxscan_item(const Params& p, int item, float* lds) {
  const int b = item >> 3, h = item & 7, tid = TIDX();
  const float* lf = (const float*)(p.ws + O_LOGF) + (size_t)b * S_ * 8 + h; float v[8]; float s = 0.f;
#pragma unroll
  for (int i = 0; i < 8; ++i) { s += lf[(size_t)(tid * 8 + i) * 8]; v[i] = s; }
  lds[tid] = s; __syncthreads();
  float off = 0.f;
  for (int i = 0; i < tid; ++i) off += lds[i];
  float* F2 = (float*)(p.ws + O_F2) + (size_t)(b * 8 + h) * S_ + tid * 8;
#pragma unroll
  for (int i = 0; i < 8; ++i) F2[i] = -(off + v[i]) * LOG2E_;
  __syncthreads();
}
DI void phase_b(const Params& p, int layer, unsigned char* smem) {
  for (int it = blockIdx.x; it < 96; it += gridDim.x) {
    if (it < 32) compress_item(p, layer, it, (bf16_t*)smem);
    else foxscan_item(p, it - 32, (float*)smem);
  }
  xcd_tiles(16, 7, [&](int tm, int tn) {
    if (tn >= 5) mlaup_tile<2>(p, layer, tm, tn, (bf16_t*)smem); else if (tn >= 3) mlaup_tile<1>(p, layer, tm, tn, (bf16_t*)smem); else mlaup_tile<0>(p, layer, tm, tn, (bf16_t*)smem);
  });
}

constexpr int KC_LD = 72, VC_LD = 264;
DI void cmp_item(const Params& p, int item, unsigned char* smem_) {
  const int b = item >> 6, g = (item >> 5) & 1, tt = item & 31, t0 = tt * 128;
  const int tid = TIDX(), lane = tid & 63, wid = tid >> 6, l15 = lane & 15, quad = lane >> 4;
  bf16_t* kcs = (bf16_t*)smem_;
  bf16_t* vcs = kcs + 256 * KC_LD;
  float* imps = (float*)smem_;
  const int nmax = (t0 + 96) >> 4;
  const int nsub = (nmax >> 4) + 1;
  {
    const bf16_t* kcg = (const bf16_t*)(p.ws + O_KC) + (size_t)(b * 2 + g) * 256 * 64; const bf16_t* vcg = (const bf16_t*)(p.ws + O_VCT) + (size_t)(b * 2 + g) * 64 * 256;
    const int nrows = ((nsub + 1) & ~1) * 16;
    for (int e = tid; e < nrows * 8; e += NTHR) {
      const int n = e >> 3, dc = (e & 7) * 8;
      *(u32x4*)(kcs + n * KC_LD + dc) = n < 255 ? *(const u32x4*)(kcg + (size_t)n * 64 + dc) : (u32x4){0u, 0u, 0u, 0u};
    }
    const int ncs = nrows >> 3;
    for (int e = tid; e < 64 * ncs; e += NTHR) {
      const int d = e / ncs, nc = (e - d * ncs) * 8;
      u32x4 v = *(const u32x4*)(vcg + (size_t)d * 256 + nc);
      if (nc + 8 > 255) v[3] &= 0x0000ffffu;
      *(u32x4*)(vcs + d * VC_LD + nc) = v;
    }
  }
  __syncthreads();
  const int tq = t0 + wid * 16 + l15;
  const size_t trow = (size_t)b * S_ + tq;
  float impa[16], p3a[16];
#pragma unroll
  for (int s = 0; s < 16; ++s) { impa[s] = 0.f; p3a[s] = 0.f; }
  const float* gts = (const float*)(p.ws + O_GATES) + trow * 24;
#pragma unroll 1
  for (int r4 = 0; r4 < 4; ++r4) {
    const int head = g * 4 + r4;
    const bf16_t* qp = (const bf16_t*)(p.ws + O_NSAQ) + trow * 512 + head * 64 + quad * 8;
    const bf16x8 q0 = *(const bf16x8*)qp, q1 = *(const bf16x8*)(qp + 32);
    auto score = [&](int s) -> f32x4 {
      const bf16_t* kr = kcs + (s * 16 + l15) * KC_LD + quad * 8;
      f32x4 a = {0.f, 0.f, 0.f, 0.f};
      a = mfma16(*(const bf16x8*)kr, q0, a); a = mfma16(*(const bf16x8*)(kr + 32), q1, a);
#pragma unroll
      for (int r = 0; r < 4; ++r) { const int n = s * 16 + quad * 4 + r; a[r] = (16 * n + 31 <= tq) ? a[r] : -INFINITY; }
      return a;
    };
    float mx = -INFINITY;
#pragma unroll 1
    for (int s = 0; s < nsub; ++s) { const f32x4 a = score(s); mx = fmaxf(mx, fmaxf(fmaxf(a[0], a[1]), fmaxf(a[2], a[3]))); }
    mx = fmaxf(mx, __shfl_xor(mx, 16)); mx = fmaxf(mx, __shfl_xor(mx, 32));
    if (mx == -INFINITY) mx = 0.f;
    float sum = 0.f;
#pragma unroll 1
    for (int s = 0; s < nsub; ++s) { const f32x4 a = score(s); sum += (ex2(a[0] - mx) + ex2(a[1] - mx)) + (ex2(a[2] - mx) + ex2(a[3] - mx)); }
    sum += __shfl_xor(sum, 16); sum += __shfl_xor(sum, 32);
    const float inv = 1.f / fmaxf(sum, 1e-30f);
    f32x4 oacc[4];
#pragma unroll
    for (int j = 0; j < 4; ++j) oacc[j] = (f32x4){0.f, 0.f, 0.f, 0.f};
#pragma unroll
    for (int c = 0; c < 8; ++c) {
      asm volatile("" ::: "memory");
      if (2 * c < nsub) {
        f32x4 pa = score(2 * c), pb = {-INFINITY, -INFINITY, -INFINITY, -INFINITY};
        if (2 * c + 1 < nsub) pb = score(2 * c + 1);
#pragma unroll
        for (int r = 0; r < 4; ++r) { pa[r] = ex2(pa[r] - mx) * inv; pb[r] = ex2(pb[r] - mx) * inv; }
        impa[2 * c] += pa[0] + pa[1] + pa[2] + 0.5f * pa[3]; p3a[2 * c] += pa[3];
        impa[2 * c + 1] += pb[0] + pb[1] + pb[2] + 0.5f * pb[3]; p3a[2 * c + 1] += pb[3];
        const u32x4 pw = {pk2(pa[0], pa[1]), pk2(pa[2], pa[3]), pk2(pb[0], pb[1]), pk2(pb[2], pb[3])};
        const bf16x8 pf = __builtin_bit_cast(bf16x8, pw);
#pragma unroll
        for (int j = 0; j < 4; ++j) {
          const bf16_t* vr = vcs + (j * 16 + l15) * VC_LD + c * 32 + quad * 4;
          const u32x2 lo = *(const u32x2*)vr, hi = *(const u32x2*)(vr + 16);
          const u32x4 vw = {lo[0], lo[1], hi[0], hi[1]};
          oacc[j] = mfma16(__builtin_bit_cast(bf16x8, vw), pf, oacc[j]);
        }
      }
    }
    const float g0 = gts[head * 3 + 0];
    bf16_t* op = (bf16_t*)(p.ws + O_ONSA) + trow * 512 + head * 64 + quad * 4;
#pragma unroll
    for (int j = 0; j < 4; ++j) store4(op + j * 16, oacc[j], g0);
  }
  __syncthreads();
  float* myimp = imps + wid * 1024 + l15 * 64;
  const int cur = tq >> 6;
#pragma unroll
  for (int s = 0; s < 16; ++s) {
    const float up = __shfl(p3a[s], (lane + 48) & 63);
    const float up0 = s ? __shfl(p3a[s ? s - 1 : 0], (lane + 48) & 63) : 0.f;
    const float prev = quad ? up : up0;
    float v = impa[s] + 0.5f * prev;
    const int j = 4 * s + quad;
    if (j == 0 || j == cur || j == cur - 1) v = 1e9f; else if (j > cur) v = -1e9f;
    myimp[j] = v;
  }
  __syncthreads();
  u64* sel = (u64*)(p.ws + O_SEL) + (size_t)(b * 2 + g) * S_ + t0 + wid * 16;
#pragma unroll 1
  for (int q = 0; q < 16; ++q) {
    const float mine = imps[wid * 1024 + q * 64 + lane]; int rank = 0;
#pragma unroll
    for (int i = 0; i < 64; ++i) { const float v = __uint_as_float(__builtin_amdgcn_readlane(__float_as_uint(mine), i)); rank += (v > mine || (v == mine && i < lane)) ? 1 : 0; }
    const u64 m = __ballot(rank < 16);
    if (lane == 0) sel[q] = m;
  }
  __syncthreads();
}
constexpr int PC_ITEMS = NB_ * 2 * 32;
DI void phase_c(const Params& p, unsigned char* smem) { for (int it = blockIdx.x; it < PC_ITEMS; it += gridDim.x) cmp_item(p, it, smem); }

enum { M_FOX = 0, M_MLA = 1, M_WIN = 2, M_SLC = 3 };
template <int MODE> struct ACfg { static constexpr int DQK = MODE == M_MLA ? 96 : 64, KLD = DQK + 8, NKC = DQK / 8 * 64, KCH = (NKC + NTHR - 1) / NTHR, K_ELEMS = 64 * KLD, V_ELEMS = 64 * 72, STAGE = K_ELEMS + V_ELEMS + 128; };
struct AState { f32x16 o[2]; f32x16 mr; float m, l; };

template <int MODE>
DI void flash_pass(AState& st, const bf16x8* qf, u64 tmask, u64 wmask,
                   const bf16_t* kbase, size_t kld, const bf16_t* kpe, const bf16_t* vtbase, const float* fbias,
                   int tq, u64 mysel, bf16_t* smem) {
  typedef ACfg<MODE> C;
  const int tid = TIDX(), lane = tid & 63, l31 = lane & 31, half = lane >> 5;
  u32x4 rk[C::KCH], rv; float rf = 0.f;
  auto gload = [&](int j) {
    const int k0 = j * 64;
#pragma unroll
    for (int i = 0; i < C::KCH; ++i) {
      const int c = tid + NTHR * i;
      if (c < C::NKC) {
        if constexpr (MODE == M_MLA) { const int key = c / 12, dc = c % 12; rk[i] = dc < 8 ? *(const u32x4*)(kbase + (size_t)(k0 + key) * kld + dc * 8) : *(const u32x4*)(kpe + (size_t)(k0 + key) * 32 + (dc - 8) * 8); }
        else { const int key = c >> 3, dc = c & 7; rk[i] = *(const u32x4*)(kbase + (size_t)(k0 + key) * kld + dc * 8); }
      }
    }
    { const int d = tid >> 3, kc = tid & 7; rv = *(const u32x4*)(vtbase + (size_t)d * S_ + k0 + kc * 8); }
    if constexpr (MODE == M_FOX) { if (tid < 64) rf = fbias[k0 + tid]; }
  };
  auto sstore = [&](int buf) {
    bf16_t* Ks = smem + buf * C::STAGE; bf16_t* Vs = Ks + C::K_ELEMS;
#pragma unroll
    for (int i = 0; i < C::KCH; ++i) {
      const int c = tid + NTHR * i;
      if (c < C::NKC) {
        if constexpr (MODE == M_MLA) { const int key = c / 12, dc = c % 12; *(u32x4*)(Ks + key * C::KLD + dc * 8) = rk[i]; }
        else { const int key = c >> 3, dc = c & 7; *(u32x4*)(Ks + key * C::KLD + dc * 8) = rk[i]; }
      }
    }
    {
      const int d = tid >> 3, kc = tid & 7, cgp = kc >> 1, a = kc & 1;
      bf16_t* dst = Vs + d * 72 + cgp * 16 + 4 * a;
      *(u32x2*)dst = (u32x2){rv[0], rv[1]}; *(u32x2*)(dst + 8) = (u32x2){rv[2], rv[3]};
    }
    if constexpr (MODE == M_FOX) { if (tid < 64) ((float*)(Vs + C::V_ELEMS))[tid] = rf; }
  };
  u64 tm = tmask;
  if (tm == 0) return;
  int j = __builtin_ctzll(tm); tm &= tm - 1;
  gload(j); sstore(0); __syncthreads();
  int buf = 0;
  const int tmin = __builtin_amdgcn_readfirstlane(tq - l31), tmax = tmin + 31;
  while (true) {
    const int jn = tm ? __builtin_ctzll(tm) : -1; if (tm) tm &= tm - 1;
    if (jn >= 0) gload(jn);
    bool active = (wmask >> j) & 1;
    if constexpr (MODE == M_SLC) active = active && __any((mysel >> j) & 1);
    if (active) {
      const bf16_t* Ks = smem + buf * C::STAGE; const bf16_t* Vs = Ks + C::K_ELEMS;
      f32x16 s0 = st.mr, s1 = st.mr;
      const bf16_t* kr = Ks + l31 * C::KLD + half * 8;
#pragma unroll
      for (int ks = 0; ks < C::DQK / 16; ++ks) {
        s0 = mfma32(*(const bf16x8*)(kr + ks * 16), qf[ks], s0);
        s1 = mfma32(*(const bf16x8*)(kr + 32 * C::KLD + ks * 16), qf[ks], s1);
      }
      const int k0 = j * 64;
      if constexpr (MODE == M_FOX) {
        const float* fb = (const float*)(Vs + C::V_ELEMS) + 4 * half;
#pragma unroll
        for (int g4 = 0; g4 < 4; ++g4) {
          const f32x4 b0 = *(const f32x4*)(fb + 8 * g4), b1 = *(const f32x4*)(fb + 32 + 8 * g4);
#pragma unroll
          for (int r = 0; r < 4; ++r) { s0[4 * g4 + r] += b0[r]; s1[4 * g4 + r] += b1[r]; }
        }
      }
      bool need = k0 + 63 > tmin;
      if constexpr (MODE == M_WIN) need = need || (k0 <= tmax - 512);
      if constexpr (MODE == M_SLC) {
        if (!need) {
          const bool rsel = ((mysel >> j) & 1) != 0;
          if (!__all(rsel)) {
#pragma unroll
            for (int r = 0; r < 16; ++r) { s0[r] = rsel ? s0[r] : -INFINITY; s1[r] = rsel ? s1[r] : -INFINITY; }
          }
        }
      }
      if (need) {
        const bool rowok = MODE == M_SLC ? ((mysel >> j) & 1) != 0 : true;
#pragma unroll
        for (int r = 0; r < 16; ++r) {
          const int key = k0 + (r & 3) + 8 * (r >> 2) + 4 * half;
          bool ok0 = rowok && key <= tq, ok1 = rowok && key + 32 <= tq;
          if constexpr (MODE == M_WIN) { ok0 = ok0 && (tq - key < 512); ok1 = ok1 && (tq - key - 32 < 512); }
          s0[r] = ok0 ? s0[r] : -INFINITY; s1[r] = ok1 ? s1[r] : -INFINITY;
        }
      }
      int im = (int)0x80000000;
#pragma unroll
      for (int r = 0; r < 16; ++r) im = max(im, max(__float_as_int(s0[r]), __float_as_int(s1[r])));
      im = max(im, __shfl_xor(im, 32));
      constexpr int TBITS = 0x41200000;
      if (__any(im > TBITS)) {
        const float d = im > TBITS ? __int_as_float(im) : 0.f;
        const float a = ex2(-d);
#pragma unroll
        for (int r = 0; r < 16; ++r) { s0[r] -= d; s1[r] -= d; st.o[0][r] *= a; st.o[1][r] *= a; }
        st.l *= a; st.m += d;
#pragma unroll
        for (int r = 0; r < 16; ++r) st.mr[r] = -st.m;
      }
      float sum = 0.f;
#pragma unroll
      for (int r = 0; r < 16; ++r) { s0[r] = ex2(s0[r]); s1[r] = ex2(s1[r]); sum += s0[r] + s1[r]; }
      st.l += sum;
      const bf16_t* vr = Vs + l31 * 72 + half * 8;
#pragma unroll
      for (int c = 0; c < 4; ++c) {
        u32x4 pw;
        if (c < 2) pw = (u32x4){pk2(s0[8 * c + 0], s0[8 * c + 1]), pk2(s0[8 * c + 2], s0[8 * c + 3]), pk2(s0[8 * c + 4], s0[8 * c + 5]), pk2(s0[8 * c + 6], s0[8 * c + 7])};
        else pw = (u32x4){pk2(s1[8 * (c - 2) + 0], s1[8 * (c - 2) + 1]), pk2(s1[8 * (c - 2) + 2], s1[8 * (c - 2) + 3]), pk2(s1[8 * (c - 2) + 4], s1[8 * (c - 2) + 5]), pk2(s1[8 * (c - 2) + 6], s1[8 * (c - 2) + 7])};
        const bf16x8 pf = __builtin_bit_cast(bf16x8, pw);
        st.o[0] = mfma32(*(const bf16x8*)(vr + c * 16), pf, st.o[0]);
        st.o[1] = mfma32(*(const bf16x8*)(vr + 32 * 72 + c * 16), pf, st.o[1]);
      }
    }
    if (jn >= 0) sstore(buf ^ 1);
    __syncthreads();
    if (jn < 0) break;
    j = jn; buf ^= 1;
  }
}
DI void astate_init(AState& s) {
#pragma unroll
  for (int r = 0; r < 16; ++r) { s.o[0][r] = 0.f; s.o[1][r] = 0.f; }
#pragma unroll
  for (int r = 0; r < 16; ++r) s.mr[r] = 0.f;
  s.m = 0.f; s.l = 0.f;
}
DI u64 lowbits(int n) { return n >= 64 ? ~0ull : ((1ull << n) - 1ull); }

template <int MODE> DI void dense_attn_item(const Params& p, int b, int h, int qt, bf16_t* smem) {
  const int lane = TIDX() & 63, wid = TIDX() >> 6, l31 = lane & 31, half = lane >> 5;
  const int t0 = qt * 256, tq = t0 + wid * 32 + l31; const size_t trow = (size_t)b * S_ + tq;
  constexpr int NQ = ACfg<MODE>::DQK / 16;
  bf16x8 qf[NQ];
  const bf16_t* qp = MODE == M_FOX ? (const bf16_t*)(p.ws + O_FOXQ) + trow * 512 + h * 64 : (const bf16_t*)(p.ws + O_MLAQ) + trow * 768 + h * 96;
#pragma unroll
  for (int ks = 0; ks < NQ; ++ks) qf[ks] = *(const bf16x8*)(qp + ks * 16 + half * 8);
  AState st; astate_init(st);
  const u64 tmask = lowbits(4 * qt + 4), wmask = lowbits(((t0 + wid * 32 + 31) >> 6) + 1);
  if constexpr (MODE == M_FOX)
    flash_pass<M_FOX>(st, qf, tmask, wmask, (const bf16_t*)(p.ws + O_FOXK) + (size_t)b * S_ * 512 + h * 64, 512, nullptr,
                      (const bf16_t*)(p.ws + O_FOXVT) + (size_t)(b * 8 + h) * 64 * S_, (const float*)(p.ws + O_F2) + (size_t)(b * 8 + h) * S_, tq, 0ull, smem);
  else
    flash_pass<M_MLA>(st, qf, tmask, wmask, (const bf16_t*)(p.ws + O_MLAKN) + (size_t)b * S_ * 512 + h * 64, 512, (const bf16_t*)(p.ws + O_MLAKPE) + (size_t)b * S_ * 32,
                      (const bf16_t*)(p.ws + O_MLAVT) + (size_t)(b * 8 + h) * 64 * S_, nullptr, tq, 0ull, smem);
  const float l = st.l + __shfl_xor(st.l, 32), inv = 1.f / fmaxf(l, 1e-30f);
  bf16_t* op = (bf16_t*)qp;
#pragma unroll
  for (int dt = 0; dt < 2; ++dt)
#pragma unroll
    for (int g4 = 0; g4 < 4; ++g4) {
      const int d = dt * 32 + g4 * 8 + half * 4;
      *(u32x2*)(op + d) = (u32x2){pk2(st.o[dt][4 * g4] * inv, st.o[dt][4 * g4 + 1] * inv), pk2(st.o[dt][4 * g4 + 2] * inv, st.o[dt][4 * g4 + 3] * inv)};
    }
}
DI void nsa_attn_item(const Params& p, int b, int g, int qt, bf16_t* smem) {
  const int lane = TIDX() & 63, wid = TIDX() >> 6, l31 = lane & 31, half = lane >> 5;
  const int t0 = qt * 64, tw0 = t0 + (wid >> 2) * 32, tq = tw0 + l31, head = g * 4 + (wid & 3); const size_t trow = (size_t)b * S_ + tq;
  bf16x8 qf[4];
  const bf16_t* qp = (const bf16_t*)(p.ws + O_NSAQ) + trow * 512 + head * 64;
#pragma unroll
  for (int ks = 0; ks < 4; ++ks) qf[ks] = *(const bf16x8*)(qp + ks * 16 + half * 8);
  {
    const float* rp = (const float*)(p.ws + O_ROPE8) + trow * 16;
    u32x4 me = __builtin_bit_cast(u32x4, qf[0]), ot;
#pragma unroll
    for (int e = 0; e < 4; ++e) ot[e] = __shfl_xor(me[e], 32);
    unsigned res[4];
#pragma unroll
    for (int e = 0; e < 4; ++e) {
      float o2[2];
#pragma unroll
      for (int u = 0; u < 2; ++u) {
        const int f = 2 * e + u; const float cs = rp[2 * f], sn = rp[2 * f + 1];
        const float a = bf2f((bf16_t)(u ? me[e] >> 16 : me[e] & 0xffffu)), o = bf2f((bf16_t)(u ? ot[e] >> 16 : ot[e] & 0xffffu));
        o2[u] = half == 0 ? a * cs - o * sn : a * cs + o * sn;
      }
      res[e] = pk2(o2[0], o2[1]);
    }
    qf[0] = __builtin_bit_cast(bf16x8, (u32x4){res[0], res[1], res[2], res[3]});
  }
  const float* gts = (const float*)(p.ws + O_GATES) + trow * 24 + head * 3;
  const int cur = t0 >> 6;
  f32x16 res[2];
  {
    AState st; astate_init(st);
    const int first = t0 >= 511 ? (t0 - 511) >> 6 : 0, firstw = tw0 >= 511 ? (tw0 - 511) >> 6 : 0;
    const u64 tmask = lowbits(cur + 1) & ~lowbits(first), wmask = lowbits(cur + 1) & ~lowbits(firstw);
    flash_pass<M_WIN>(st, qf, tmask, wmask, (const bf16_t*)(p.ws + O_KWIN) + (size_t)b * S_ * 128 + g * 64, 128, nullptr,
                      (const bf16_t*)(p.ws + O_VWINT) + (size_t)(b * 2 + g) * 64 * S_, nullptr, tq, 0ull, smem);
    const float l = st.l + __shfl_xor(st.l, 32), sc = gts[2] / fmaxf(l, 1e-30f);
#pragma unroll
    for (int r = 0; r < 16; ++r) { res[0][r] = st.o[0][r] * sc; res[1][r] = st.o[1][r] * sc; }
  }
  {
    AState st; astate_init(st);
    const u64* selp = (const u64*)(p.ws + O_SEL) + (size_t)(b * 2 + g) * S_;
    const u64 mysel = selp[tq];
    const u64 m64 = selp[t0 + lane];
    unsigned lo = (unsigned)m64, hi = (unsigned)(m64 >> 32);
#pragma unroll
    for (int o = 32; o >= 1; o >>= 1) { lo |= __shfl_xor(lo, o); hi |= __shfl_xor(hi, o); }
    const u64 um = (((u64)(unsigned)__builtin_amdgcn_readfirstlane(hi) << 32) | (u64)(unsigned)__builtin_amdgcn_readfirstlane(lo)) & lowbits(cur + 1);
    flash_pass<M_SLC>(st, qf, um, um, (const bf16_t*)(p.ws + O_KSLC) + (size_t)b * S_ * 128 + g * 64, 128, nullptr,
                      (const bf16_t*)(p.ws + O_VSLCT) + (size_t)(b * 2 + g) * 64 * S_, nullptr, tq, mysel, smem);
    const float l = st.l + __shfl_xor(st.l, 32), sc = gts[1] / fmaxf(l, 1e-30f);
#pragma unroll
    for (int r = 0; r < 16; ++r) { res[0][r] += st.o[0][r] * sc; res[1][r] += st.o[1][r] * sc; }
  }
  bf16_t* op = (bf16_t*)(p.ws + O_ONSA) + trow * 512 + head * 64;
#pragma unroll
  for (int dt = 0; dt < 2; ++dt)
#pragma unroll
    for (int g4 = 0; g4 < 4; ++g4) {
      const int d = dt * 32 + g4 * 8 + half * 4;
      const u32x2 oc = *(const u32x2*)(op + d);
      const float c0 = bf2f((bf16_t)(oc[0] & 0xffffu)), c1 = bf2f((bf16_t)(oc[0] >> 16)), c2 = bf2f((bf16_t)(oc[1] & 0xffffu)), c3 = bf2f((bf16_t)(oc[1] >> 16));
      *(u32x2*)(op + d) = (u32x2){pk2(res[dt][4 * g4] + c0, res[dt][4 * g4 + 1] + c1), pk2(res[dt][4 * g4 + 2] + c2, res[dt][4 * g4 + 3] + c3)};
    }
}
constexpr int PD_ITEMS = 16 * 192;
DI void phase_d(const Params& p, unsigned char* smem) {
  for (int it = blockIdx.x; it < PD_ITEMS; it += gridDim.x) {
    const int r = it / 192, w = it % 192, qt = 15 - r;
    if (w < 64) dense_attn_item<M_MLA>(p, w >> 3, w & 7, qt, (bf16_t*)smem);
    else if (w < 128) dense_attn_item<M_FOX>(p, (w - 64) >> 3, (w - 64) & 7, qt, (bf16_t*)smem);
    else { const int i = w - 128, bg = i & 15, q4 = i >> 4; nsa_attn_item(p, bg >> 1, bg & 1, qt * 4 + q4, (bf16_t*)smem); }
  }
}

DI void merge_tile(const Params& p, int layer, int tm, int tn, bf16_t* smem) {
  typedef GemmLds<8, 2> L;
  const bf16_t* wl = (const bf16_t*)(p.ws + O_W) + (size_t)layer * W_LAYER;
  const int tid = TIDX(), lane = tid & 63, wid = tid >> 6, wm = wid >> 2, wn = wid & 3, l15 = lane & 15, quad = lane >> 4;
  f32x4 mg[8][2]; zero_acc<8, 2>(mg);
  f32x4 acc[8][2]; zero_acc<8, 2>(acc);
  unsigned* gsp = (unsigned*)((unsigned char*)smem + 2 * L::STAGE * 2) + tid;
  const bf16_t* la; const bf16_t* lb; unsigned lald, lbld; int laks, lnk;
  auto get_seg = [&](int sg) {
    const int br = sg >> 1;
    if ((sg & 1) == 0) { la = (const bf16_t*)(p.ws + O_XG) + (size_t)tm * 256 * D_; lald = D_; laks = 64; lb = wl + W_G + ((size_t)br * 1024 + tn * 128) * D_; lbld = D_; lnk = 16; }
    else {
      lald = br == 2 ? 768u : 512u; laks = br == 2 ? 96 : 64; lnk = 8; lbld = 512u;
      la = (const bf16_t*)(p.ws + (br == 0 ? O_ONSA : br == 1 ? O_FOXQ : O_MLAQ)) + (size_t)tm * 256 * lald;
      lb = wl + (br == 0 ? W_BN : br == 1 ? W_BF : W_BM) + (size_t)tn * 128 * 512;
    }
  };
  unsigned pa0, pb0; u32x4 ra[4], rb[2];
  auto set_offsets = [&]() { pa0 = (unsigned)(tid >> 3) * lald + (tid & 7) * 8; pb0 = (unsigned)(tid >> 3) * lbld + (tid & 7) * 8; };
  int ls = 0, lkt = 0;
  get_seg(0); set_offsets();
  auto gload_next = [&]() {
    const bf16_t* ab = la + (size_t)lkt * laks; const bf16_t* bb = lb + (size_t)lkt * 64;
#pragma unroll
    for (int i = 0; i < 4; ++i) ra[i] = *(const u32x4*)(ab + pa0 + (size_t)i * 64 * lald);
#pragma unroll
    for (int i = 0; i < 2; ++i) rb[i] = *(const u32x4*)(bb + pb0 + (size_t)i * 64 * lbld);
    if (++lkt == lnk) {
      if (ls + 1 < 6) { ++ls; lkt = 0; get_seg(ls); set_offsets(); } else lkt = lnk - 1;
    }
  };
  auto sstore = [&](int buf) {
    bf16_t* As = smem + buf * L::STAGE; bf16_t* Bs = As + L::A_ELEMS;
#pragma unroll
    for (int i = 0; i < 4; ++i) { const int c = tid + NTHR * i; *(u32x4*)(As + (c >> 3) * LDT + (c & 7) * 8) = ra[i]; }
#pragma unroll
    for (int i = 0; i < 2; ++i) { const int c = tid + NTHR * i; *(u32x4*)(Bs + (c >> 3) * LDT + (c & 7) * 8) = rb[i]; }
  };
  gload_next(); sstore(0); gload_next(); __syncthreads();
  int buf = 0;
#pragma unroll 1
  for (int sg = 0; sg < 6; ++sg) {
    const int nk = (sg & 1) ? 8 : 16;
#pragma unroll 1
    for (int kt = 0; kt < nk; ++kt) {
      sstore(buf ^ 1);
      gload_next();
      __builtin_amdgcn_sched_barrier(0);
      const bf16_t* As = smem + buf * L::STAGE + (wm * 128 + l15) * LDT + quad * 8;
      const bf16_t* Bs = smem + buf * L::STAGE + L::A_ELEMS + (wn * 32 + l15) * LDT + quad * 8;
#pragma unroll
      for (int ks = 0; ks < 2; ++ks) {
        if (ks == 1) asm volatile("" ::: "memory");
        bf16x8 b[2];
#pragma unroll
        for (int j = 0; j < 2; ++j) b[j] = *(const bf16x8*)(Bs + j * 16 * LDT + ks * 32);
#pragma unroll
        for (int i = 0; i < 8; ++i) {
          const bf16x8 a = *(const bf16x8*)(As + i * 16 * LDT + ks * 32);
#pragma unroll
          for (int j = 0; j < 2; ++j) acc[i][j] = mfma16(b[j], a, acc[i][j]);
        }
      }
      __syncthreads();
      buf ^= 1;
    }
    if ((sg & 1) == 0) {
      const int t2 = TIDX(), row0 = tm * 256 + ((t2 >> 8) & 1) * 128 + (t2 & 15);
#pragma unroll
      for (int i = 0; i < 8; ++i) {
        asm volatile("" ::: "memory");
        const float rs = rstd_from16((const float*)(p.ws + O_SSQ) + (size_t)(row0 + i * 16) * 16, 1.f / 1024.f);
#pragma unroll
        for (int j = 0; j < 2; ++j) {
          unsigned w = 0;
#pragma unroll
          for (int r = 0; r < 4; ++r) w |= (unsigned)__float2int_rn(sigmoidf_(acc[i][j][r] * rs) * 255.f) << (8 * r);
          gsp[(i * 2 + j) * NTHR] = w;
        }
      }
    } else {
#pragma unroll
      for (int i = 0; i < 8; ++i)
#pragma unroll
        for (int j = 0; j < 2; ++j) {
          asm volatile("" ::: "memory");
          const unsigned w = gsp[(i * 2 + j) * NTHR];
#pragma unroll
          for (int r = 0; r < 4; ++r) mg[i][j][r] += (float)((w >> (8 * r)) & 0xffu) * (1.f / 255.f) * acc[i][j][r];
        }
    }
    zero_acc<8, 2>(acc);
  }
  const int t3 = TIDX(), lane3 = t3 & 63, wid3 = t3 >> 6;
  bf16_t* stg = smem + wid3 * (128 * 40);
#pragma unroll
  for (int i = 0; i < 8; ++i)
#pragma unroll
    for (int j = 0; j < 2; ++j) *(u32x2*)(stg + (i * 16 + (lane3 & 15)) * 40 + j * 16 + (lane3 >> 4) * 4) = (u32x2){pk2(mg[i][j][0], mg[i][j][1]), pk2(mg[i][j][2], mg[i][j][3])};
  stage_out<128, 32, 40>(stg, (bf16_t*)(p.ws + O_MERGED) + (size_t)(tm * 256 + (wid3 >> 2) * 128) * D_ + tn * 128 + (wid3 & 3) * 32, (size_t)D_, lane3);
  __syncthreads();
}
DI void phase_e(const Params& p, int layer, unsigned char* smem) {
  xcd_tiles(16, 8, [&](int tm, int tn) { merge_tile(p, layer, tm, tn, (bf16_t*)smem); });
}

DI void resid_tile(const Params& p, const bf16_t* A, int K, const bf16_t* W, const float* xold, const float* gnext, int tm, int tn, bf16_t* smem) {
  f32x4 acc[8][4]; zero_acc<8, 4>(acc);
  RowPtr ap{A + (size_t)tm * 256 * K, (size_t)K}, bp{W + (size_t)tn * 256 * K, (size_t)K};
  gemm_main<8, 4, true>(acc, ap, 64, bp, 64, K / 64, smem);
  const int lane = TIDX() & 63, wid = TIDX() >> 6, wm = wid >> 2, wn = wid & 3, l15 = lane & 15, quad = lane >> 4;
  bf16_t* stg = smem + wid * STG_WAVE;
#pragma unroll
  for (int i = 0; i < 8; ++i) {
    const int t = tm * 256 + wm * 128 + i * 16 + l15, c0 = tn * 256 + wn * 64 + quad * 4; float s = 0.f;
#pragma unroll
    for (int j = 0; j < 4; ++j) {
      const size_t off = (size_t)t * D_ + c0 + j * 16;
      const f32x4 xn = *(const f32x4*)(xold + off) + acc[i][j];
      *(f32x4*)(p.out + off) = xn;
      s += xn[0] * xn[0] + xn[1] * xn[1] + xn[2] * xn[2] + xn[3] * xn[3];
      if (gnext) { const f32x4 gv = *(const f32x4*)(gnext + c0 + j * 16); *(u32x2*)(stg + (i * 16 + l15) * STG_LD + j * 16 + quad * 4) = (u32x2){pk2(xn[0] * gv[0], xn[1] * gv[1]), pk2(xn[2] * gv[2], xn[3] * gv[3])}; }
    }
    s += __shfl_xor(s, 16); s += __shfl_xor(s, 32);
    if (quad == 0) ((float*)(p.ws + O_SSQ))[(size_t)t * 16 + tn * 4 + wn] = s;
  }
  if (gnext) stage_out<128, 64, STG_LD>(stg, (bf16_t*)(p.ws + O_XG) + (size_t)(tm * 256 + wm * 128) * D_ + tn * 256 + wn * 64, (size_t)D_, lane);
  __syncthreads();
}
DI void phase_f(const Params& p, int layer, unsigned char* smem) {
  const bf16_t* wl = (const bf16_t*)(p.ws + O_W) + (size_t)layer * W_LAYER;
  xcd_tiles(16, 4, [&](int tm, int tn) { resid_tile(p, (const bf16_t*)(p.ws + O_MERGED), 1024, wl + W_OUT, layer == 0 ? p.x : p.out, p.ffn_norm + layer * D_, tm, tn, (bf16_t*)smem); });
}
DI void phase_h(const Params& p, int layer, unsigned char* smem) {
  const bf16_t* wl = (const bf16_t*)(p.ws + O_W) + (size_t)layer * W_LAYER;
  xcd_tiles(16, 4, [&](int tm, int tn) { resid_tile(p, (const bf16_t*)(p.ws + O_ACT), DFF_, wl + W_DN, p.out, layer == 0 ? p.mix_norm + D_ : nullptr, tm, tn, (bf16_t*)smem); });
}

struct UpRowPtr { const bf16_t* base; int s0;
  DI unsigned operator()(int r) const { const int s = s0 + r; return (unsigned)((s < 0 || s >= S_) ? 0 : s) * (unsigned)D_; }
  DI bool ok(int r) const { const int s = s0 + r; return s >= 0 && s < S_; } };
constexpr int PG_MT = 17;
DI void ffnup_tile(const Params& p, int layer, int b, int mt, int tn, bf16_t* smem) {
  const bf16_t* wl = (const bf16_t*)(p.ws + O_W) + (size_t)layer * W_LAYER;
  f32x4 acc[8][4]; zero_acc<8, 4>(acc);
  const int s0 = 254 * mt - 2;
  UpRowPtr ap{(const bf16_t*)(p.ws + O_XG) + (size_t)b * S_ * D_, s0}; RowPtr bp{wl + W_UP + (size_t)tn * 256 * D_, (size_t)D_};
  gemm_main<8, 4, true>(acc, ap, 64, bp, 64, 16, smem);
  const int tid = TIDX(), lane = tid & 63, wid = tid >> 6, wm = wid >> 2, wn = wid & 3, l15 = lane & 15, quad = lane >> 4;
  constexpr int LDU = 136; bf16_t* U = smem; bf16_t* V = smem + 256 * LDU;
  {
    bf16_t* dstb = (wn < 2 ? U : V) + (wn & 1) * 64 + quad * 4;
#pragma unroll
    for (int i = 0; i < 8; ++i) {
      const int row = wm * 128 + i * 16 + l15, s = s0 + row;
      const float rs = (s >= 0 && s < S_) ? rstd_from16((const float*)(p.ws + O_SSQ) + ((size_t)b * S_ + s) * 16, 1.f / 1024.f) : 0.f;
#pragma unroll
      for (int j = 0; j < 4; ++j) store4(dstb + row * LDU + j * 16, acc[i][j], rs);
    }
  }
  __syncthreads();
  {
    const int cc = tid & 15, cg0 = tn * 128 + cc * 8;
    const float* cw = p.conv_w + (size_t)layer * 3 * DFF_ + cg0; const float* cbp = p.conv_b + (size_t)layer * DFF_ + cg0;
    float w0[8], w1[8], w2[8], cb[8];
#pragma unroll
    for (int e = 0; e < 8; ++e) { w0[e] = cw[e]; w1[e] = cw[DFF_ + e]; w2[e] = cw[2 * DFF_ + e]; cb[e] = cbp[e]; }
    bf16_t* act = (bf16_t*)(p.ws + O_ACT);
#pragma unroll 2
    for (int it = 0; it < 8; ++it) {
      const int row = it * 32 + (tid >> 4), s = s0 + row;
      if (row >= 2 && s < S_) {
        const u32x4 u0 = *(const u32x4*)(U + (row - 2) * LDU + cc * 8), u1 = *(const u32x4*)(U + (row - 1) * LDU + cc * 8), u2 = *(const u32x4*)(U + row * LDU + cc * 8), vv = *(const u32x4*)(V + row * LDU + cc * 8);
        unsigned o[4];
#pragma unroll
        for (int e = 0; e < 4; ++e) {
          float r2[2];
#pragma unroll
          for (int h = 0; h < 2; ++h) {
            const int k = 2 * e + h;
            const float a0 = bf2f((bf16_t)(h ? u0[e] >> 16 : u0[e] & 0xffffu)), a1 = bf2f((bf16_t)(h ? u1[e] >> 16 : u1[e] & 0xffffu)), a2 = bf2f((bf16_t)(h ? u2[e] >> 16 : u2[e] & 0xffffu)), vx = bf2f((bf16_t)(h ? vv[e] >> 16 : vv[e] & 0xffffu));
            const float uc = w0[k] * a0 + w1[k] * a1 + w2[k] * a2 + cb[k];
            r2[h] = uc * sigmoidf_(uc) * vx;
          }
          o[e] = pk2(r2[0], r2[1]);
        }
        __builtin_nontemporal_store((u32x4){o[0], o[1], o[2], o[3]}, (u32x4*)(act + ((size_t)b * S_ + s) * DFF_ + cg0));
      }
    }
  }
  __syncthreads();
}
DI void phase_g(const Params& p, int layer, unsigned char* smem) {
  xcd_tiles(PG_MT, 22, [&](int tmg, int tn) { ffnup_tile(p, layer, tmg / PG_MT, tmg % PG_MT, tn, (bf16_t*)smem); });
}

DI void phase_final(const Params& p) {
  const int lane = TIDX() & 63, wid = TIDX() >> 6;
  for (int it = blockIdx.x; it < T_ / 8; it += gridDim.x) {
    const int t = it * 8 + wid; const float rs = rstd_from16((const float*)(p.ws + O_SSQ) + (size_t)t * 16, 1.f / 1024.f);
    float* xr = p.out + (size_t)t * D_;
#pragma unroll
    for (int c = 0; c < 4; ++c) { const int k = c * 256 + lane * 4; const f32x4 v = *(const f32x4*)(xr + k), gv = *(const f32x4*)(p.final_norm + k); *(f32x4*)(xr + k) = v * rs * gv; }
  }
}

#define XB_TMO      128
#define XB_XCNT(j)  (256  + 64 * (j))
#define XB_XSUB(j)  (1280 + 64 * (j))
#define XB_XGEN(j)  (2304 + 64 * (j))
#define XB_TOP      3328
#define XB_TOPGEN   3392
#define XCD_BAR_WORDS 3456
#define XB_SPIN_CAP (1u << 22)
#define LAS __attribute__((address_space(3)))
DI unsigned xb_ld(unsigned* p)              { return __hip_atomic_load(p, __ATOMIC_RELAXED, __HIP_MEMORY_SCOPE_AGENT); }
DI unsigned xb_add(unsigned* p, unsigned v) { return __hip_atomic_fetch_add(p, v, __ATOMIC_RELAXED, __HIP_MEMORY_SCOPE_AGENT); }
DI unsigned xb_xcc_id() { return (unsigned)__builtin_amdgcn_s_getreg((3 << 11) | 20) & 0xFu; }
#define XB_SPIN(cond, bar) do { unsigned _sp = 0; while (cond) { __builtin_amdgcn_s_sleep(1); \
    if ((++_sp & 255u) == 0u) { if (xb_ld(&(bar)[XB_TMO])) break; if (_sp > XB_SPIN_CAP) { atomicAdd(&(bar)[XB_TMO], 1u); break; } } } } while (0)
struct XcdBarrier { unsigned* bar; unsigned x; volatile LAS unsigned* st; };
DI XcdBarrier xcd_barrier_post(unsigned* bar, volatile LAS unsigned* st) {
  XcdBarrier b; b.bar = bar; b.x = xb_xcc_id(); b.st = st;
  if (threadIdx.x == 0) (void)xb_add(&bar[XB_XCNT(b.x)], 1u);
  return b;
}
DI void xcd_barrier_complete(unsigned* bar, unsigned x, unsigned& nloc, unsigned& nx) {
  const unsigned G = gridDim.x * gridDim.y * gridDim.z;
  unsigned sum, cnt, mine, sp = 0u;
  for (;;) {
    sum = 0u; cnt = 0u; mine = 0u;
#pragma unroll
    for (unsigned j = 0; j < 16; ++j) { const unsigned c = xb_ld(&bar[XB_XCNT(j)]); sum += c; cnt += (c > 0u) ? 1u : 0u; mine = (j == x) ? c : mine; }
    if (sum == G) break;
    __builtin_amdgcn_s_sleep(1);
    if ((++sp & 255u) == 0u) { if (xb_ld(&bar[XB_TMO])) break; if (sp > XB_SPIN_CAP) { atomicAdd(&bar[XB_TMO], 1u); break; } }
  }
  nloc = mine > 0u ? mine : 1u; nx = cnt > 0u ? cnt : 1u;
}
DI void xcd_barrier(const XcdBarrier& b) {
  asm volatile("s_waitcnt vmcnt(0)" ::: "memory");
  __syncthreads();
  if (threadIdx.x == 0) {
    unsigned* bar = b.bar;
    __builtin_amdgcn_s_waitcnt(0);
    unsigned nloc = b.st[0], nx = b.st[1];
    if (nloc == 0u) { xcd_barrier_complete(bar, b.x, nloc, nx); b.st[0] = nloc; b.st[1] = nx; }
    const unsigned old = xb_add(&bar[XB_XSUB(b.x)], 1u);
    const unsigned gen = old / nloc;
    if (old + 1u == (gen + 1u) * nloc) {
      __builtin_amdgcn_fence(__ATOMIC_RELEASE, "agent");
      asm volatile("s_waitcnt vmcnt(0)" ::: "memory");
      const unsigned og = xb_add(&bar[XB_TOP], 1u);
      const unsigned tg = og / nx;
      if (og + 1u == (tg + 1u) * nx) xb_add(&bar[XB_TOPGEN], 1u);
      else XB_SPIN(xb_ld(&bar[XB_TOPGEN]) == tg, bar);
      __builtin_amdgcn_fence(__ATOMIC_ACQUIRE, "agent");
      xb_add(&bar[XB_XGEN(b.x)], 1u);
      asm volatile("s_waitcnt vmcnt(0)" ::: "memory");
    } else {
      XB_SPIN(xb_ld(&bar[XB_XGEN(b.x)]) == gen, bar);
      __builtin_amdgcn_fence(__ATOMIC_ACQUIRE, "agent");
      asm volatile("s_waitcnt vmcnt(0)" ::: "memory");
    }
  }
  __syncthreads();
}
DI void run_phase(const Params& p, int ph, unsigned char* smem) {
  if (ph == 0) { phase_prep(p, smem); return; }
  if (ph == 17) { phase_final(p); return; }
  const int layer = (ph - 1) >> 3, s = (ph - 1) & 7;
#ifdef PROBE_DUP
  if ((PROBE_DUP >> s) & 1) {
    switch (s) { case 0: phase_inproj(p, layer, smem); break; case 1: phase_b(p, layer, smem); break; case 2: phase_c(p, smem); break; case 4: phase_e(p, layer, smem); break; case 6: phase_g(p, layer, smem); break; default: break; }
    __syncthreads();
  }
#endif
  switch (s) {
    case 0: phase_inproj(p, layer, smem); break;
    case 1: phase_b(p, layer, smem); break;
    case 2: phase_c(p, smem); break;
    case 3: phase_d(p, smem); break;
    case 4: phase_e(p, layer, smem); break;
    case 5: phase_f(p, layer, smem); break;
    case 6: phase_g(p, layer, smem); break;
    default: phase_h(p, layer, smem); break;
  }
}
constexpr int N_PHASES = 18;

#if ONE_LAUNCH
template <int PH> DI void run_all(const Params& p, unsigned char* smem, cg::grid_group& grid, const XcdBarrier& xb) {
  run_phase(p, PH, smem);
  if constexpr (PH + 1 < N_PHASES) {
    if constexpr (PH == 0) grid.sync(); else xcd_barrier(xb);
    run_all<PH + 1>(p, smem, grid, xb);
  }
}
__global__ void __launch_bounds__(NTHR, 2) mega_kernel(Params p) {
  __shared__ __attribute__((aligned(16))) unsigned char smem[SMEM_BYTES];
  __shared__ uint4 xb_words;
  if (threadIdx.x == 0) xb_words = make_uint4(0u, 0u, 0u, 0u);
  __syncthreads();
  const XcdBarrier xb = xcd_barrier_post((unsigned*)(p.ws + O_BAR), (volatile LAS unsigned*)&xb_words);
  cg::grid_group grid = cg::this_grid();
  run_all<0>(p, smem, grid, xb);
}
#else
template <int PH> __global__ void __launch_bounds__(NTHR, 2) phase_kernel(Params p) {
  __shared__ __attribute__((aligned(16))) unsigned char smem[SMEM_BYTES];
  run_phase(p, PH, smem);
}
template <int PH> static void launch_phases(const Params& p, hipStream_t stream) {
  hipLaunchKernelGGL((phase_kernel<PH>), dim3(256), dim3(NTHR), 0, stream, p);
  if constexpr (PH + 1 < N_PHASES) launch_phases<PH + 1>(p, stream);
}
#endif

extern "C" void kernel_launch(void* const* d_in, const int* in_sizes, int n_in, void* d_out, int out_size, void* d_ws, size_t ws_size, hipStream_t stream) {
  if (ws_size < O_END || n_in < 25) { fprintf(stderr, "workspace too small: %zu < %zu\n", ws_size, (size_t)O_END); return; }
  Params p{};
  p.x = (const float*)d_in[0]; p.pos = (const int*)d_in[1]; p.mix_norm = (const float*)d_in[2]; p.w_in = (const float*)d_in[3]; p.b_forget = (const float*)d_in[4];
  p.pe_k = (const float*)d_in[5]; p.w1_k = (const float*)d_in[6]; p.w2_k = (const float*)d_in[7]; p.pe_v = (const float*)d_in[8]; p.w1_v = (const float*)d_in[9]; p.w2_v = (const float*)d_in[10];
  p.q_norm = (const float*)d_in[11]; p.w_uq = (const float*)d_in[12]; p.kv_norm = (const float*)d_in[13]; p.w_ukv = (const float*)d_in[14];
  p.wbr_nsa = (const float*)d_in[15]; p.wbr_fox = (const float*)d_in[16]; p.wbr_mla = (const float*)d_in[17]; p.w_out = (const float*)d_in[18];
  p.ffn_norm = (const float*)d_in[19]; p.w_up = (const float*)d_in[20]; p.conv_w = (const float*)d_in[21]; p.conv_b = (const float*)d_in[22]; p.w_down = (const float*)d_in[23]; p.final_norm = (const float*)d_in[24];
  p.out = (float*)d_out; p.ws = (unsigned char*)d_ws;
#if ONE_LAUNCH
  static int grid_blocks = 0;
  if (!grid_blocks) {
    int dev = 0, cus = 0, per_cu = 0;
    hipGetDevice(&dev); hipDeviceGetAttribute(&cus, hipDeviceAttributeMultiprocessorCount, dev);
    hipOccupancyMaxActiveBlocksPerMultiprocessor(&per_cu, mega_kernel, NTHR, 0);
    if (per_cu > 1) per_cu = 1;
    grid_blocks = cus * per_cu;
  }
  hipMemsetAsync(p.ws + O_BAR, 0, XCD_BAR_WORDS * 4, stream);
  void* args[] = {&p};
  hipError_t e = hipLaunchCooperativeKernel((void*)mega_kernel, dim3(grid_blocks), dim3(NTHR), args, 0, stream);
  if (e != hipSuccess) fprintf(stderr, "cooperative launch failed: %s (grid %d)\n", hipGetErrorString(e), grid_blocks);
#else
  launch_phases<0>(p, stream);
#endif
}
```

```cpp
#include <hip/hip_runtime.h>
#include <hip/hip_cooperative_groups.h>
#include <stdint.h>
#include <stdio.h>
#include <type_traits>
namespace cg = cooperative_groups;

#ifndef ONE_LAUNCH
#define ONE_LAUNCH 1

#endif

#define DI __device__ __forceinline__
typedef unsigned short bf16_t;
typedef short bf16x8 __attribute__((ext_vector_type(8)));
typedef float f32x4 __attribute__((ext_vector_type(4)));
typedef float f32x16 __attribute__((ext_vector_type(16)));
typedef float f32x2 __attribute__((ext_vector_type(2)));
typedef __bf16 bfx2 __attribute__((ext_vector_type(2)));
typedef unsigned u32x4 __attribute__((ext_vector_type(4)));
typedef unsigned u32x2 __attribute__((ext_vector_type(2)));
typedef unsigned long long u64;

constexpr int T_ = 32768, S_ = 4096, NB_ = 8, D_ = 1024, DFF_ = 2816, NIN_ = 6592;
constexpr float EPS_ = 1e-6f;
constexpr float LOG2E_ = 1.4426950408889634f;
constexpr float QS64_ = 0.125f * LOG2E_;
constexpr float QS96_ = 0.10206207261596577f * LOG2E_;

constexpr size_t W_IN = 0;
constexpr size_t W_G = W_IN + (size_t)3584 * 1024;
constexpr size_t W_1K = W_G + (size_t)3072 * 1024;
constexpr size_t W_1V = W_1K + (size_t)256 * 2048;
constexpr size_t W_2K = W_1V + (size_t)256 * 2048;
constexpr size_t W_2V = W_2K + (size_t)64 * 256;
constexpr size_t W_UQ = W_2V + (size_t)64 * 256;
constexpr size_t W_UKV = W_UQ + (size_t)768 * 384;
constexpr size_t W_BN = W_UKV + (size_t)1024 * 256;
constexpr size_t W_BF = W_BN + (size_t)1024 * 512;
constexpr size_t W_BM = W_BF + (size_t)1024 * 512;
constexpr size_t W_OUT = W_BM + (size_t)1024 * 512;
constexpr size_t W_UP = W_OUT + (size_t)1024 * 1024;
constexpr size_t W_DN = W_UP + (size_t)5632 * 1024;
constexpr size_t W_LAYER = W_DN + (size_t)1024 * 2816;

constexpr size_t al256(size_t x) { return (x + 255) & ~(size_t)255; }
constexpr size_t O_BAR = 0;
constexpr size_t O_W = 16384;
constexpr size_t O_BIAS1 = al256(O_W + 2 * W_LAYER * 2);
constexpr size_t O_ROPE8 = al256(O_BIAS1 + 2 * 2 * 16 * 256 * 4);
constexpr size_t O_ROPE16 = al256(O_ROPE8 + (size_t)T_ * 16 * 4);
constexpr size_t O_XG = al256(O_ROPE16 + (size_t)T_ * 32 * 4);
constexpr size_t O_SSQ = al256(O_XG + (size_t)T_ * 1024 * 2);
constexpr size_t O_CSSQ = al256(O_SSQ + (size_t)T_ * 16 * 4);
constexpr size_t O_NSAQ = al256(O_CSSQ + (size_t)T_ * 16 * 4);
constexpr size_t O_KVCMP = O_NSAQ + (size_t)T_ * 512 * 2;
constexpr size_t O_KSLC = O_KVCMP + (size_t)T_ * 256 * 2;
constexpr size_t O_KWIN = O_KSLC + (size_t)T_ * 128 * 2;
constexpr size_t O_MERGED = O_NSAQ;
constexpr size_t O_VSLCT = O_KWIN + (size_t)T_ * 128 * 2;
constexpr size_t O_VWINT = O_VSLCT + (size_t)T_ * 128 * 2;
constexpr size_t O_FOXQ = O_VWINT + (size_t)T_ * 128 * 2;
constexpr size_t O_FOXK = O_FOXQ + (size_t)T_ * 512 * 2;
constexpr size_t O_FOXVT = O_FOXK + (size_t)T_ * 512 * 2;
constexpr size_t O_MLAQ = O_FOXVT + (size_t)T_ * 512 * 2;
constexpr size_t O_MLAKN = O_MLAQ + (size_t)T_ * 768 * 2;
constexpr size_t O_ACT = O_FOXQ;
constexpr size_t O_MLAVT = O_MLAKN + (size_t)T_ * 512 * 2;
constexpr size_t O_MLAKPE = O_MLAVT + (size_t)T_ * 512 * 2;
constexpr size_t O_ONSA = O_MLAKPE + (size_t)T_ * 32 * 2;
constexpr size_t O_CQ = O_ONSA;
constexpr size_t O_CKV = O_CQ + (size_t)T_ * 384 * 2;
constexpr size_t O_CEND = O_CKV + (size_t)T_ * 256 * 2;
constexpr size_t O_GATES = al256(O_CEND > O_ONSA + (size_t)T_ * 512 * 2 ? O_CEND : O_ONSA + (size_t)T_ * 512 * 2);
constexpr size_t O_LOGF = al256(O_GATES + (size_t)T_ * 24 * 4);
constexpr size_t O_F2 = al256(O_LOGF + (size_t)T_ * 8 * 4);
constexpr size_t O_KC = al256(O_F2 + (size_t)T_ * 8 * 4);
constexpr size_t O_VCT = al256(O_KC + (size_t)NB_ * 2 * 256 * 64 * 2);
constexpr size_t O_SEL = al256(O_VCT + (size_t)NB_ * 2 * 256 * 64 * 2);
constexpr size_t O_END = al256(O_SEL + (size_t)NB_ * 2 * S_ * 8);

struct Params {
  const float* x; const int* pos; const float* mix_norm; const float* w_in; const float* b_forget;
  const float* pe_k; const float* w1_k; const float* w2_k; const float* pe_v; const float* w1_v; const float* w2_v;
  const float* q_norm; const float* w_uq; const float* kv_norm; const float* w_ukv;
  const float* wbr_nsa; const float* wbr_fox; const float* wbr_mla; const float* w_out;
  const float* ffn_norm; const float* w_up; const float* conv_w; const float* conv_b; const float* w_down; const float* final_norm;
  float* out; unsigned char* ws;
};

constexpr int NTHR = 512;
constexpr int SMEM_BYTES = 147456;

DI int TIDX() { int t = (int)threadIdx.x; asm volatile("" : "+v"(t)); return t; }
DI unsigned pk2(float lo, float hi) { f32x2 v = {lo, hi}; return __builtin_bit_cast(unsigned, __builtin_convertvector(v, bfx2)); }
DI bf16_t f2bf(float x) { return (bf16_t)(pk2(x, 0.f) & 0xffffu); }
DI float bf2f(bf16_t h) { return __uint_as_float(((unsigned)h) << 16); }
DI float sigmoidf_(float x) { return 1.f / (1.f + __expf(-x)); }
DI float gelu_tanh(float x) { const float u = 0.7978845608028654f * (x + 0.044715f * x * x * x); return x / (1.f + __expf(-2.f * u)); }
DI float ex2(float x) { return __builtin_amdgcn_exp2f(x); }
DI f32x16 mfma32(bf16x8 a, bf16x8 b, f32x16 c) { return __builtin_amdgcn_mfma_f32_32x32x16_bf16(a, b, c, 0, 0, 0); }
DI f32x4 mfma16(bf16x8 a, bf16x8 b, f32x4 c) { return __builtin_amdgcn_mfma_f32_16x16x32_bf16(a, b, c, 0, 0, 0); }
DI float rstd_from16(const float* p, float inv_n) {
  const f32x4 a = *(const f32x4*)p, b = *(const f32x4*)(p + 4), c = *(const f32x4*)(p + 8), d = *(const f32x4*)(p + 12);
  const float s = ((a[0] + a[1]) + (a[2] + a[3])) + ((b[0] + b[1]) + (b[2] + b[3])) + ((c[0] + c[1]) + (c[2] + c[3])) + ((d[0] + d[1]) + (d[2] + d[3]));
  return rsqrtf(s * inv_n + EPS_);
}

constexpr int LDT = 72;
template <int MI, int NJ> struct GemmLds { static constexpr int BM = 32 * MI, BN = 64 * NJ, A_ELEMS = BM * LDT, B_ELEMS = BN * LDT, STAGE = A_ELEMS + B_ELEMS; };

template <int MI, int NJ, bool SWAP, class AP, class BP>
DI void gemm_main(f32x4 (&acc)[MI][NJ], const AP& ap, int a_kstep, const BP& bp, int b_kstep, int nk, bf16_t* smem) {
  typedef GemmLds<MI, NJ> L;
  constexpr int CA = MI / 2, CB = NJ;
  const int tid = TIDX(), lane = tid & 63, wid = tid >> 6, wm = wid >> 2, wn = wid & 3, l15 = lane & 15, quad = lane >> 4;
  unsigned pa[CA], pb[CB]; bool oka[CA];
#pragma unroll
  for (int i = 0; i < CA; ++i) { const int c = tid + NTHR * i; pa[i] = ap(c >> 3) + (c & 7) * 8; oka[i] = ap.ok(c >> 3); }
#pragma unroll
  for (int i = 0; i < CB; ++i) { const int c = tid + NTHR * i; pb[i] = bp(c >> 3) + (c & 7) * 8; }
  u32x4 ra[CA], rb[CB];
  auto gload = [&](int kt) {
    const bf16_t* ab = ap.base + (size_t)kt * a_kstep; const bf16_t* bb = bp.base + (size_t)kt * b_kstep;
#pragma unroll
    for (int i = 0; i < CA; ++i) ra[i] = *(const u32x4*)(ab + pa[i]);
#pragma unroll
    for (int i = 0; i < CB; ++i) rb[i] = *(const u32x4*)(bb + pb[i]);
  };
  auto sstore = [&](int buf) {
    bf16_t* As = smem + buf * L::STAGE; bf16_t* Bs = As + L::A_ELEMS;
#pragma unroll
    for (int i = 0; i < CA; ++i) { const int c = tid + NTHR * i; *(u32x4*)(As + (c >> 3) * LDT + (c & 7) * 8) = oka[i] ? ra[i] : (u32x4){0u, 0u, 0u, 0u}; }
#pragma unroll
    for (int i = 0; i < CB; ++i) { const int c = tid + NTHR * i; *(u32x4*)(Bs + (c >> 3) * LDT + (c & 7) * 8) = rb[i]; }
  };
  gload(0); sstore(0); gload(nk > 1 ? 1 : 0); __syncthreads();
#pragma unroll 1
  for (int kt = 0; kt < nk; ++kt) {
    const int buf = kt & 1;
    sstore(buf ^ 1);
    gload(kt + 2 < nk ? kt + 2 : nk - 1);
    __builtin_amdgcn_sched_barrier(0);
    const bf16_t* As = smem + buf * L::STAGE + (wm * 16 * MI + l15) * LDT + quad * 8;
    const bf16_t* Bs = smem + buf * L::STAGE + L::A_ELEMS + (wn * 16 * NJ + l15) * LDT + quad * 8;
#pragma unroll
    for (int ks = 0; ks < 2; ++ks) {
      if (MI * NJ >= 32 && ks == 1) asm volatile("" ::: "memory");
      bf16x8 b[NJ];
#pragma unroll
      for (int j = 0; j < NJ; ++j) b[j] = *(const bf16x8*)(Bs + j * 16 * LDT + ks * 32);
#pragma unroll
      for (int i = 0; i < MI; ++i) {
        const bf16x8 a = *(const bf16x8*)(As + i * 16 * LDT + ks * 32);
#pragma unroll
        for (int j = 0; j < NJ; ++j) acc[i][j] = SWAP ? mfma16(b[j], a, acc[i][j]) : mfma16(a, b[j], acc[i][j]);
      }
    }
    __syncthreads();
  }
}
template <int MI, int NJ> DI void zero_acc(f32x4 (&acc)[MI][NJ]) {
#pragma unroll
  for (int i = 0; i < MI; ++i)
#pragma unroll
    for (int j = 0; j < NJ; ++j) acc[i][j] = (f32x4){0.f, 0.f, 0.f, 0.f};
}
struct RowPtr { const bf16_t* base; size_t ld; DI unsigned operator()(int r) const { return (unsigned)r * (unsigned)ld; } DI bool ok(int) const { return true; } };


template <class F> DI void xcd_tiles(int MPX, int NT, F&& body) {
  const int xcd = blockIdx.x & 7, slot = blockIdx.x >> 3, nslots = gridDim.x >> 3, total = MPX * NT;
  for (int li = slot; li < total; li += nslots) {
    const int mg = li / (8 * NT), rem = li - mg * 8 * NT;
    const int gsz = (MPX - mg * 8) < 8 ? (MPX - mg * 8) : 8;
    const int tn = rem / gsz, mi = rem - tn * gsz;
    body(xcd * MPX + mg * 8 + mi, tn);
  }
}

DI int map_col(int map, int n) {
  if (map == 0) return n;
  if (map == 1) {
    if (n < 896) return n;
    if (n < 1024) return 1024 + (n - 896);
    if (n < 1152) return 896 + (n - 1024);
    if (n < 1280) return n;
    if (n < 2816) return 1304 + (n - 1280);
    if (n < 3200) return 2848 + (n - 2816);
    if (n < 3456) return 3232 + (n - 3200);
    const int c = n - 3456;
    if (c < 24) return 1280 + c;
    if (c < 32) return 2840 + (c - 24);
    if (c < 64) return 3488 + (c - 32);
    return -1;
  }
  if (map == 2) { const int j = n >> 8, c = n & 255; return c < 128 ? j * 128 + c : DFF_ + j * 128 + (c - 128); }
  if (map == 3) { return n < 512 ? (n >> 6) * 128 + (n & 63) : ((n - 512) >> 6) * 128 + 64 + ((n - 512) & 63); }
  return n;
}
struct WJob { const float* src; const float* scale; bf16_t* dst; int K, N, ld, map, off; };
DI void prep_weight_tile(const WJob& j, int tile, float* lds) {
  const int ntn = j.N >> 6, tk = tile / ntn, tn = tile % ntn, tid = TIDX();
  const int n4 = (tid & 15) * 4; const int sc = map_col(j.map, tn * 64 + n4);
  f32x4 v[4];
#pragma unroll
  for (int i = 0; i < 4; ++i) {
    const int kk = (tid >> 4) + 32 * i, k = tk * 128 + kk;
    v[i] = sc >= 0 ? *(const f32x4*)(j.src + (size_t)k * j.ld + j.off + sc) : (f32x4){0.f, 0.f, 0.f, 0.f};
    if (j.scale) v[i] = v[i] * j.scale[k];
  }
#pragma unroll
  for (int i = 0; i < 4; ++i) {
    const int kk = (tid >> 4) + 32 * i;
#pragma unroll
    for (int e = 0; e < 4; ++e) lds[kk * 65 + n4 + e] = v[i][e];
  }
  __syncthreads();
  const int nn = tid >> 3, k0 = (tid & 7) * 16;
  unsigned w[8];
#pragma unroll
  for (int e = 0; e < 8; ++e) w[e] = pk2(lds[(k0 + 2 * e) * 65 + nn], lds[(k0 + 2 * e + 1) * 65 + nn]);
  bf16_t* d = j.dst + (size_t)(tn * 64 + nn) * j.K + tk * 128 + k0;
  *(u32x4*)d = (u32x4){w[0], w[1], w[2], w[3]}; *(u32x4*)(d + 8) = (u32x4){w[4], w[5], w[6], w[7]};
  __syncthreads();
}
DI WJob get_wjob(const Params& p, int layer, int id) {
  bf16_t* wl = (bf16_t*)(p.ws + O_W) + (size_t)layer * W_LAYER; WJob j; j.scale = nullptr; j.map = 0; j.off = 0;
  switch (id) {
    case 0: j.src = p.w_in + (size_t)layer * 1024 * NIN_; j.dst = wl + W_IN; j.K = 1024; j.N = 3584; j.ld = NIN_; j.map = 1; break;
    case 1: j.src = p.w_in + (size_t)layer * 1024 * NIN_; j.dst = wl + W_G; j.K = 1024; j.N = 3072; j.ld = NIN_; j.off = 3520; break;
    case 2: j.src = p.w1_k + (size_t)layer * 2048 * 256; j.dst = wl + W_1K; j.K = 2048; j.N = 256; j.ld = 256; break;
    case 3: j.src = p.w1_v + (size_t)layer * 2048 * 256; j.dst = wl + W_1V; j.K = 2048; j.N = 256; j.ld = 256; break;
    case 4: j.src = p.w2_k + (size_t)layer * 256 * 64; j.dst = wl + W_2K; j.K = 256; j.N = 64; j.ld = 64; break;
    case 5: j.src = p.w2_v + (size_t)layer * 256 * 64; j.dst = wl + W_2V; j.K = 256; j.N = 64; j.ld = 64; break;
    case 6: j.src = p.w_uq + (size_t)layer * 384 * 768; j.dst = wl + W_UQ; j.K = 384; j.N = 768; j.ld = 768; j.scale = p.q_norm + layer * 384; break;
    case 7: j.src = p.w_ukv + (size_t)layer * 256 * 1024; j.dst = wl + W_UKV; j.K = 256; j.N = 1024; j.ld = 1024; j.scale = p.kv_norm + layer * 256; j.map = 3; break;
    case 8: j.src = p.wbr_nsa + (size_t)layer * 512 * 1024; j.dst = wl + W_BN; j.K = 512; j.N = 1024; j.ld = 1024; break;
    case 9: j.src = p.wbr_fox + (size_t)layer * 512 * 1024; j.dst = wl + W_BF; j.K = 512; j.N = 1024; j.ld = 1024; break;
    case 10: j.src = p.wbr_mla + (size_t)layer * 512 * 1024; j.dst = wl + W_BM; j.K = 512; j.N = 1024; j.ld = 1024; break;
    case 11: j.src = p.w_out + (size_t)layer * 1024 * 1024; j.dst = wl + W_OUT; j.K = 1024; j.N = 1024; j.ld = 1024; break;
    case 12: j.src = p.w_up + (size_t)layer * 1024 * 5632; j.dst = wl + W_UP; j.K = 1024; j.N = 5632; j.ld = 5632; j.map = 2; break;
    default: j.src = p.w_down + (size_t)layer * 2816 * 1024; j.dst = wl + W_DN; j.K = 2816; j.N = 1024; j.ld = 1024; break;
  }
  return j;
}
constexpr int WTILES_LAYER = (int)(W_LAYER / 8192);
constexpr int P0_XITEMS = T_ / 64;
constexpr int P0_ROPE_ITEMS = T_ / NTHR;
constexpr int P0_ITEMS = 2 * WTILES_LAYER + 64 + P0_ROPE_ITEMS + P0_XITEMS;

DI void xg_rows(const float* x, const float* g, bf16_t* xg, float* ssq, int row0) {
  const int lane = TIDX() & 63, wid = TIDX() >> 6;
  for (int rr = 0; rr < 8; ++rr) {
    const int t = row0 + wid * 8 + rr; const float* xr = x + (size_t)t * D_; float s = 0.f;
#pragma unroll
    for (int c = 0; c < 4; ++c) {
      const int k = c * 256 + lane * 4; const f32x4 v = *(const f32x4*)(xr + k), gv = *(const f32x4*)(g + k);
      s += v[0] * v[0] + v[1] * v[1] + v[2] * v[2] + v[3] * v[3];
      *(u32x2*)(xg + (size_t)t * D_ + k) = (u32x2){pk2(v[0] * gv[0], v[1] * gv[1]), pk2(v[2] * gv[2], v[3] * gv[3])};
    }
#pragma unroll
    for (int o = 32; o >= 1; o >>= 1) s += __shfl_xor(s, o);
    if (lane < 16) ssq[(size_t)t * 16 + lane] = lane == 0 ? s : 0.f;
  }
}
DI void phase_prep(const Params& p, unsigned char* smem) {
  for (int it = blockIdx.x; it < P0_ITEMS; it += gridDim.x) {
    int i = it;
    if (i < 2 * WTILES_LAYER) {
      const int layer = i / WTILES_LAYER; int t = i % WTILES_LAYER; int id = 0;
      for (;; ++id) { const WJob j = get_wjob(p, layer, id); const int nt = (j.K >> 7) * (j.N >> 6); if (t < nt) { prep_weight_tile(j, t, (float*)smem); break; } t -= nt; }
      continue;
    }
    i -= 2 * WTILES_LAYER;
    if (i < 64) {
      const int lk = i >> 4, pc = i & 15, layer = lk >> 1, kv = lk & 1, c = TIDX() & 255, hf = TIDX() >> 8;
      const float* pe = (kv ? p.pe_v : p.pe_k) + (size_t)layer * 2048 + pc * 128 + hf * 64; const float* w1 = (kv ? p.w1_v : p.w1_k) + (size_t)layer * 2048 * 256 + (size_t)(pc * 128 + hf * 64) * 256;
      float sacc = 0.f;
#pragma unroll 8
      for (int kk = 0; kk < 64; ++kk) sacc += pe[kk] * w1[(size_t)kk * 256 + c];
      float* lds = (float*)smem;
      if (hf) lds[c] = sacc;
      __syncthreads();
      if (!hf) ((float*)(p.ws + O_BIAS1))[(lk * 16 + pc) * 256 + c] = sacc + lds[c];
      __syncthreads();
      continue;
    }
    i -= 64;
    if (i < P0_ROPE_ITEMS) {
      const int t = i * NTHR + TIDX(); const float fp = (float)p.pos[t];
      float* r8 = (float*)(p.ws + O_ROPE8) + (size_t)t * 16; float* r16 = (float*)(p.ws + O_ROPE16) + (size_t)t * 32;
      for (int f = 0; f < 24; ++f) {
        const int half = f < 8 ? 8 : 16, idx = f < 8 ? f : f - 8;
        const float inv = exp2f(-(float)idx / (float)half * 18.931568569324174f);
        const float ang = fp * inv;
        const double rev = (double)ang * 0.15915494309189535; const float fr = (float)(rev - floor(rev));
        const float sn = __builtin_amdgcn_sinf(fr), cs = __builtin_amdgcn_cosf(fr);
        if (f < 8) { r8[2 * idx] = cs; r8[2 * idx + 1] = sn; } else { r16[2 * idx] = cs; r16[2 * idx + 1] = sn; }
      }
      continue;
    }
    i -= P0_ROPE_ITEMS;
    xg_rows(p.x, p.mix_norm, (bf16_t*)(p.ws + O_XG), (float*)(p.ws + O_SSQ), i * 64);
  }
}

DI void store4(bf16_t* dst, const f32x4& v, float s) { *(u32x2*)dst = (u32x2){pk2(v[0] * s, v[1] * s), pk2(v[2] * s, v[3] * s)}; }
constexpr int STG_LD = 72, STG_WAVE = 128 * 72;
DI void stage4(bf16_t* stg, int row, int col, const f32x4& v, float s) { *(u32x2*)(stg + row * STG_LD + col) = (u32x2){pk2(v[0] * s, v[1] * s), pk2(v[2] * s, v[3] * s)}; }
template <int ROWS, int COLS, int LD> DI void stage_out(const bf16_t* stg, bf16_t* dst, size_t ld, int lane) {
  asm volatile("s_waitcnt lgkmcnt(0)" ::: "memory");
  constexpr int CPR = COLS / 8, IT = ROWS * CPR / 64;
#pragma unroll
  for (int it = 0; it < IT; ++it) {
    const int idx = it * 64 + lane, r = idx / CPR, c = idx % CPR;
    __builtin_nontemporal_store(*(const u32x4*)(stg + r * LD + c * 8), (u32x4*)(dst + (size_t)r * ld + c * 8));
  }
}
template <bool SWAP> DI void inproj_tile(const Params& p, int layer, int tm, int tn, bf16_t* smem) {
  const bf16_t* wl = (const bf16_t*)(p.ws + O_W) + (size_t)layer * W_LAYER;
  f32x4 acc[8][4]; zero_acc<8, 4>(acc);
  RowPtr ap{(const bf16_t*)(p.ws + O_XG) + (size_t)tm * 256 * D_, (size_t)D_}, bp{wl + W_IN + (size_t)tn * 256 * D_, (size_t)D_};
  gemm_main<8, 4, SWAP>(acc, ap, 64, bp, 64, 16, smem);
  const int lane = TIDX() & 63, wid = TIDX() >> 6, wm = wid >> 2, wn = wid & 3, l15 = lane & 15, quad = lane >> 4;
  const float* ssq = (const float*)(p.ws + O_SSQ);
  bf16_t* stg = smem + wid * STG_WAVE;
  const int trow0 = tm * 256 + wm * 128;
  if constexpr (!SWAP) {
    bf16_t* dst; int hh, hd;
    if (tn == 4) { dst = (bf16_t*)(p.ws + (wn < 2 ? O_VSLCT : O_VWINT)); hh = 2; hd = wn & 1; } else { dst = (bf16_t*)(p.ws + O_FOXVT); hh = 8; hd = (tn - 9) * 4 + wn; }
    constexpr int VLD = 136;
#pragma unroll
    for (int i = 0; i < 8; ++i) {
      const int t0 = trow0 + i * 16 + quad * 4;
      float rs[4];
#pragma unroll
      for (int r = 0; r < 4; ++r) rs[r] = rstd_from16(ssq + (size_t)(t0 + r) * 16, 1.f / 1024.f);
#pragma unroll
      for (int j = 0; j < 4; ++j)
        *(u32x2*)(stg + (j * 16 + l15) * VLD + i * 16 + quad * 4) = (u32x2){pk2(acc[i][j][0] * rs[0], acc[i][j][1] * rs[1]), pk2(acc[i][j][2] * rs[2], acc[i][j][3] * rs[3])};
    }
    const int b = trow0 >> 12, s0 = trow0 & 4095;
    stage_out<64, 128, VLD>(stg, dst + ((size_t)(b * hh + hd) * 64) * S_ + s0, (size_t)S_, lane);
  } else {
    const int slab = tn * 4 + wn;
    if (slab == 54) {
#pragma unroll
      for (int i = 0; i < 8; ++i) {
        const int t = trow0 + i * 16 + l15; const float rs = rstd_from16(ssq + (size_t)t * 16, 1.f / 1024.f);
        float* gt = (float*)(p.ws + O_GATES) + (size_t)t * 24; float* lf = (float*)(p.ws + O_LOGF) + (size_t)t * 8;
#pragma unroll
        for (int r = 0; r < 4; ++r) gt[quad * 4 + r] = sigmoidf_(acc[i][0][r] * rs);
        if (quad < 2) {
#pragma unroll
          for (int r = 0; r < 4; ++r) gt[16 + quad * 4 + r] = sigmoidf_(acc[i][1][r] * rs);
        } else {
#pragma unroll
          for (int r = 0; r < 4; ++r) { const int h = (quad - 2) * 4 + r; const float xx = acc[i][1][r] * rs + p.b_forget[layer * 8 + h]; lf[h] = fminf(xx, 0.f) - log1pf(__expf(-fabsf(xx))); }
        }
        const float* rp = (const float*)(p.ws + O_ROPE16) + (size_t)t * 32 + quad * 8; float o1[4], o2[4];
#pragma unroll
        for (int r = 0; r < 4; ++r) { const float cs = rp[2 * r], sn = rp[2 * r + 1], x1 = acc[i][2][r] * rs, x2 = acc[i][3][r] * rs; o1[r] = x1 * cs - x2 * sn; o2[r] = x2 * cs + x1 * sn; }
        bf16_t* kp = (bf16_t*)(p.ws + O_MLAKPE) + (size_t)t * 32 + quad * 4;
        *(u32x2*)kp = (u32x2){pk2(o1[0], o1[1]), pk2(o1[2], o1[3])}; *(u32x2*)(kp + 16) = (u32x2){pk2(o2[0], o2[1]), pk2(o2[2], o2[3])};
      }
    } else if (slab != 55) {
      bf16_t* dbuf; int dld, dcol, kind = 0; float qs = 1.f; int cslot = 0;
      if (slab < 8) { dbuf = (bf16_t*)(p.ws + O_NSAQ); dld = 512; dcol = slab * 64; qs = QS64_; }
      else if (slab < 12) { dbuf = (bf16_t*)(p.ws + O_KVCMP); dld = 256; dcol = (slab - 8) * 64; }
      else if (slab < 16) { dbuf = (bf16_t*)(p.ws + (slab < 14 ? O_KSLC : O_KWIN)); dld = 128; dcol = (slab & 1) * 64; kind = 1; }
      else if (slab < 28) { dbuf = (bf16_t*)(p.ws + O_FOXQ); dld = 512; dcol = (slab - 20) * 64; qs = QS64_; }
      else if (slab < 36) { dbuf = (bf16_t*)(p.ws + O_FOXK); dld = 512; dcol = (slab - 28) * 64; }
      else if (slab < 50) { dbuf = (bf16_t*)(p.ws + O_CQ); dld = 384; dcol = (slab - 44) * 64; kind = 2; cslot = slab - 44; }
      else { dbuf = (bf16_t*)(p.ws + O_CKV); dld = 256; dcol = (slab - 50) * 64; kind = 2; cslot = 8 + slab - 50; }
#pragma unroll
      for (int i = 0; i < 8; ++i) {
        const int row = i * 16 + l15, t = trow0 + row; const float rs = rstd_from16(ssq + (size_t)t * 16, 1.f / 1024.f) * qs;
        if (kind == 1) {
          const float* rp = (const float*)(p.ws + O_ROPE8) + (size_t)t * 16 + (quad & 1) * 8;
          f32x4 v, o;
#pragma unroll
          for (int r = 0; r < 4; ++r) { v[r] = acc[i][0][r] * rs; o[r] = __shfl_xor(v[r], 32); }
#pragma unroll
          for (int r = 0; r < 4; ++r) { const float cs = rp[2 * r], sn = rp[2 * r + 1]; v[r] = quad < 2 ? v[r] * cs - o[r] * sn : v[r] * cs + o[r] * sn; }
          stage4(stg, row, quad * 4, v, 1.f);
        } else stage4(stg, row, quad * 4, acc[i][0], rs);
#pragma unroll
        for (int j = 1; j < 4; ++j) stage4(stg, row, j * 16 + quad * 4, acc[i][j], rs);
        if (kind == 2) {
          float s = 0.f;
#pragma unroll
          for (int j = 0; j < 4; ++j) { const f32x4 a = acc[i][j] * rs; s += a[0] * a[0] + a[1] * a[1] + a[2] * a[2] + a[3] * a[3]; }
          s += __shfl_xor(s, 16); s += __shfl_xor(s, 32);
          if (quad == 0) ((float*)(p.ws + O_CSSQ))[(size_t)t * 16 + cslot] = s;
        }
      }
      stage_out<128, 64, STG_LD>(stg, dbuf + (size_t)trow0 * dld + dcol, (size_t)dld, lane);
    }
  }
  __syncthreads();
}
DI void phase_inproj(const Params& p, int layer, unsigned char* smem) {
  xcd_tiles(16, 14, [&](int tm, int tn) {
    const bool vt = (tn == 4 || tn == 9 || tn == 10);
    if (vt) inproj_tile<false>(p, layer, tm, tn, (bf16_t*)smem); else inproj_tile<true>(p, layer, tm, tn, (bf16_t*)smem);
  });
}

template <int KIND> DI void mlaup_tile(const Params& p, int layer, int tm, int tn, bf16_t* smem) {
  const bf16_t* wl = (const bf16_t*)(p.ws + O_W) + (size_t)layer * W_LAYER;
  f32x4 acc[8][4]; zero_acc<8, 4>(acc);
  constexpr int K = KIND == 0 ? 384 : 256;
  RowPtr ap{KIND == 0 ? (const bf16_t*)(p.ws + O_CQ) + (size_t)tm * 256 * 384 : (const bf16_t*)(p.ws + O_CKV) + (size_t)tm * 256 * 256, (size_t)K};
  RowPtr bp{KIND == 0 ? wl + W_UQ + (size_t)tn * 256 * 384 : wl + W_UKV + (size_t)(tn - 3) * 256 * 256, (size_t)K};
  gemm_main<8, 4, KIND != 2>(acc, ap, 64, bp, 64, K / 64, smem);
  const int lane = TIDX() & 63, wid = TIDX() >> 6, wm = wid >> 2, wn = wid & 3, l15 = lane & 15, quad = lane >> 4;
  const float* cssq = (const float*)(p.ws + O_CSSQ);
  bf16_t* stg = smem + wid * STG_WAVE; const int trow0 = tm * 256 + wm * 128;
  if constexpr (KIND == 2) {
    bf16_t* dst = (bf16_t*)(p.ws + O_MLAVT); const int h = (tn - 5) * 4 + wn;
    constexpr int VLD = 136;
#pragma unroll
    for (int i = 0; i < 8; ++i) {
      asm volatile("" ::: "memory");
      const int t0 = trow0 + i * 16 + quad * 4; float rs[4];
#pragma unroll
      for (int r = 0; r < 4; ++r) { const float* c = cssq + (size_t)(t0 + r) * 16 + 8; rs[r] = rsqrtf((c[0] + c[1] + c[2] + c[3]) * (1.f / 256.f) + EPS_); }
#pragma unroll
      for (int j = 0; j < 4; ++j)
        *(u32x2*)(stg + (j * 16 + l15) * VLD + i * 16 + quad * 4) = (u32x2){pk2(acc[i][j][0] * rs[0], acc[i][j][1] * rs[1]), pk2(acc[i][j][2] * rs[2], acc[i][j][3] * rs[3])};
    }
    stage_out<64, 128, VLD>(stg, dst + ((size_t)((trow0 >> 12) * 8 + h) * 64) * S_ + (trow0 & 4095), (size_t)S_, lane);
  } else if constexpr (KIND == 1) {
#pragma unroll
    for (int i = 0; i < 8; ++i) {
      asm volatile("" ::: "memory");
      const int row = i * 16 + l15, t = trow0 + row; const float* c = cssq + (size_t)t * 16;
      const float rs = rsqrtf((c[8] + c[9] + c[10] + c[11]) * (1.f / 256.f) + EPS_);
#pragma unroll
      for (int j = 0; j < 4; ++j) stage4(stg, row, j * 16 + quad * 4, acc[i][j], rs);
    }
    stage_out<128, 64, STG_LD>(stg, (bf16_t*)(p.ws + O_MLAKN) + (size_t)trow0 * 512 + (tn - 3) * 256 + wn * 64, (size_t)512, lane);
  } else {
    const int n0 = tn * 256 + wn * 64, ph = n0 % 96;
#pragma unroll
    for (int i = 0; i < 8; ++i) {
      asm volatile("" ::: "memory");
      const int row = i * 16 + l15, t = trow0 + row; const float* c = cssq + (size_t)t * 16;
      const float rs = rsqrtf((c[0] + c[1] + c[2] + c[3] + c[4] + c[5]) * (1.f / 384.f) + EPS_) * QS96_;
      f32x4 v0 = acc[i][0] * rs, v1 = acc[i][1] * rs, v2 = acc[i][2] * rs, v3 = acc[i][3] * rs;
      if (ph != 0) {
        const float* rp = (const float*)(p.ws + O_ROPE16) + (size_t)t * 32 + quad * 8;
        const f32x4 x1 = ph == 64 ? v0 : v2, x2 = ph == 64 ? v1 : v3; f32x4 o1, o2;
#pragma unroll
        for (int r = 0; r < 4; ++r) { const float cs = rp[2 * r], sn = rp[2 * r + 1]; o1[r] = x1[r] * cs - x2[r] * sn; o2[r] = x2[r] * cs + x1[r] * sn; }
        if (ph == 64) { v0 = o1; v1 = o2; } else { v2 = o1; v3 = o2; }
      }
      stage4(stg, row, quad * 4, v0, 1.f); stage4(stg, row, 16 + quad * 4, v1, 1.f); stage4(stg, row, 32 + quad * 4, v2, 1.f); stage4(stg, row, 48 + quad * 4, v3, 1.f);
    }
    stage_out<128, 64, STG_LD>(stg, (bf16_t*)(p.ws + O_MLAQ) + (size_t)trow0 * 768 + n0, (size_t)768, lane);
  }
  __syncthreads();
}
struct CmpRowPtr { const bf16_t* base; int r0;
  DI unsigned operator()(int r) const { int R = r0 + r; if (R >= 4080) R = 0; const int b = R / 510, rem = R - b * 510, n = rem >> 1, g = rem & 1; return (unsigned)(b * S_ + 16 * n) * 256u + g * 64; }
  DI bool ok(int r) const { return r0 + r < 4080; } };
DI void compress_item(const Params& p, int layer, int item, bf16_t* smem) {
  const int kv = item >> 4, tm = item & 15;
  const bf16_t* wl = (const bf16_t*)(p.ws + O_W) + (size_t)layer * W_LAYER;
  f32x4 acc[8][4]; zero_acc<8, 4>(acc);
  CmpRowPtr ap{(const bf16_t*)(p.ws + O_KVCMP) + kv * 128, tm * 256};
  RowPtr bp{wl + (kv ? W_1V : W_1K), (size_t)2048};
  gemm_main<8, 4, true>(acc, ap, 256, bp, 64, 32, smem);
  const int lane = TIDX() & 63, wid = TIDX() >> 6, wm = wid >> 2, wn = wid & 3, l15 = lane & 15, quad = lane >> 4;
  constexpr int LDH = 264; bf16_t* H = smem;
  const float* b1 = (const float*)(p.ws + O_BIAS1) + (size_t)(layer * 2 + kv) * 16 * 256;
#pragma unroll
  for (int j = 0; j < 4; ++j) {
    asm volatile("" ::: "memory");
    f32x4 bv = {0.f, 0.f, 0.f, 0.f};
    for (int pc = 0; pc < 16; ++pc) bv += *(const f32x4*)(b1 + pc * 256 + wn * 64 + j * 16 + quad * 4);
#pragma unroll
    for (int i = 0; i < 8; ++i) {
      const int row = wm * 128 + i * 16 + l15, col = wn * 64 + j * 16 + quad * 4;
      *(u32x2*)(H + row * LDH + col) = (u32x2){pk2(gelu_tanh(acc[i][j][0] + bv[0]), gelu_tanh(acc[i][j][1] + bv[1])), pk2(gelu_tanh(acc[i][j][2] + bv[2]), gelu_tanh(acc[i][j][3] + bv[3]))};
    }
  }
  __syncthreads();
  f32x4 a2[2][4];
#pragma unroll
  for (int i = 0; i < 2; ++i)
#pragma unroll
    for (int j = 0; j < 4; ++j) a2[i][j] = (f32x4){0.f, 0.f, 0.f, 0.f};
  const bf16_t* w2 = wl + (kv ? W_2V : W_2K);
#pragma unroll
  for (int ks = 0; ks < 8; ++ks) {
    bf16x8 a[2], b[4];
#pragma unroll
    for (int i = 0; i < 2; ++i) a[i] = *(const bf16x8*)(H + (wid * 32 + i * 16 + l15) * LDH + ks * 32 + quad * 8);
#pragma unroll
    for (int j = 0; j < 4; ++j) b[j] = *(const bf16x8*)(w2 + (size_t)(j * 16 + l15) * 256 + ks * 32 + quad * 8);
#pragma unroll
    for (int i = 0; i < 2; ++i)
#pragma unroll
      for (int j = 0; j < 4; ++j) a2[i][j] = mfma16(a[i], b[j], a2[i][j]);
  }
  bf16_t* kc = (bf16_t*)(p.ws + O_KC); bf16_t* vct = (bf16_t*)(p.ws + O_VCT);
#pragma unroll
  for (int i = 0; i < 2; ++i)
#pragma unroll
    for (int r = 0; r < 4; ++r) {
      const int R = tm * 256 + wid * 32 + i * 16 + quad * 4 + r;
      if (R < 4080) {
        const int b = R / 510, rem = R - b * 510, n = rem >> 1, g = rem & 1;
#pragma unroll
        for (int j = 0; j < 4; ++j) {
          const int d = j * 16 + l15; const bf16_t v = f2bf(a2[i][j][r]);
          if (kv == 0) kc[((size_t)(b * 2 + g) * 256 + n) * 64 + d] = v; else vct[((size_t)(b * 2 + g) * 64 + d) * 256 + n] = v;
        }
      }
    }
  __syncthreads();
}
DI void foxscan_item(const Params& p, int item, float* lds) {
  const int b = item >> 3, h = item & 7, tid = TIDX();
  const float* lf = (const float*)(p.ws + O_LOGF) + (size_t)b * S_ * 8 + h; float v[8]; float s = 0.f;
#pragma unroll
  for (int i = 0; i < 8; ++i) { s += lf[(size_t)(tid * 8 + i) * 8]; v[i] = s; }
  lds[tid] = s; __syncthreads();
  float off = 0.f;
  for (int i = 0; i < tid; ++i) off += lds[i];
  float* F2 = (float*)(p.ws + O_F2) + (size_t)(b * 8 + h) * S_ + tid * 8;
#pragma unroll
  for (int i = 0; i < 8; ++i) F2[i] = -(off + v[i]) * LOG2E_;
  __syncthreads();
}
DI void phase_b(const Params& p, int layer, unsigned char* smem) {
  for (int it = blockIdx.x; it < 96; it += gridDim.x) {
    if (it < 32) compress_item(p, layer, it, (bf16_t*)smem);
    else foxscan_item(p, it - 32, (float*)smem);
  }
  xcd_tiles(16, 7, [&](int tm, int tn) {
    if (tn >= 5) mlaup_tile<2>(p, layer, tm, tn, (bf16_t*)smem); else if (tn >= 3) mlaup_tile<1>(p, layer, tm, tn, (bf16_t*)smem); else mlaup_tile<0>(p, layer, tm, tn, (bf16_t*)smem);
  });
}

constexpr int KC_LD = 72, VC_LD = 264;
DI void cmp_item(const Params& p, int item, unsigned char* smem_) {
  const int b = item >> 6, g = (item >> 5) & 1, tt = item & 31, t0 = tt * 128;
  const int tid = TIDX(), lane = tid & 63, wid = tid >> 6, l15 = lane & 15, quad = lane >> 4;
  bf16_t* kcs = (bf16_t*)smem_;
  bf16_t* vcs = kcs + 256 * KC_LD;
  float* imps = (float*)smem_;
  const int nmax = (t0 + 96) >> 4;
  const int nsub = (nmax >> 4) + 1;
  {
    const bf16_t* kcg = (const bf16_t*)(p.ws + O_KC) + (size_t)(b * 2 + g) * 256 * 64; const bf16_t* vcg = (const bf16_t*)(p.ws + O_VCT) + (size_t)(b * 2 + g) * 64 * 256;
    const int nrows = ((nsub + 1) & ~1) * 16;
    for (int e = tid; e < nrows * 8; e += NTHR) {
      const int n = e >> 3, dc = (e & 7) * 8;
      *(u32x4*)(kcs + n * KC_LD + dc) = n < 255 ? *(const u32x4*)(kcg + (size_t)n * 64 + dc) : (u32x4){0u, 0u, 0u, 0u};
    }
    const int ncs = nrows >> 3;
    for (int e = tid; e < 64 * ncs; e += NTHR) {
      const int d = e / ncs, nc = (e - d * ncs) * 8;
      u32x4 v = *(const u32x4*)(vcg + (size_t)d * 256 + nc);
      if (nc + 8 > 255) v[3] &= 0x0000ffffu;
      *(u32x4*)(vcs + d * VC_LD + nc) = v;
    }
  }
  __syncthreads();
  const int tq = t0 + wid * 16 + l15;
  const size_t trow = (size_t)b * S_ + tq;
  float impa[16], p3a[16];
#pragma unroll
  for (int s = 0; s < 16; ++s) { impa[s] = 0.f; p3a[s] = 0.f; }
  const float* gts = (const float*)(p.ws + O_GATES) + trow * 24;
#pragma unroll 1
  for (int r4 = 0; r4 < 4; ++r4) {
    const int head = g * 4 + r4;
    const bf16_t* qp = (const bf16_t*)(p.ws + O_NSAQ) + trow * 512 + head * 64 + quad * 8;
    const bf16x8 q0 = *(const bf16x8*)qp, q1 = *(const bf16x8*)(qp + 32);
    auto score = [&](int s) -> f32x4 {
      const bf16_t* kr = kcs + (s * 16 + l15) * KC_LD + quad * 8;
      f32x4 a = {0.f, 0.f, 0.f, 0.f};
      a = mfma16(*(const bf16x8*)kr, q0, a); a = mfma16(*(const bf16x8*)(kr + 32), q1, a);
#pragma unroll
      for (int r = 0; r < 4; ++r) { const int n = s * 16 + quad * 4 + r; a[r] = (16 * n + 31 <= tq) ? a[r] : -INFINITY; }
      return a;
    };
    float mx = -INFINITY;
#pragma unroll 1
    for (int s = 0; s < nsub; ++s) { const f32x4 a = score(s); mx = fmaxf(mx, fmaxf(fmaxf(a[0], a[1]), fmaxf(a[2], a[3]))); }
    mx = fmaxf(mx, __shfl_xor(mx, 16)); mx = fmaxf(mx, __shfl_xor(mx, 32));
    if (mx == -INFINITY) mx = 0.f;
    float sum = 0.f;
#pragma unroll 1
    for (int s = 0; s < nsub; ++s) { const f32x4 a = score(s); sum += (ex2(a[0] - mx) + ex2(a[1] - mx)) + (ex2(a[2] - mx) + ex2(a[3] - mx)); }
    sum += __shfl_xor(sum, 16); sum += __shfl_xor(sum, 32);
    const float inv = 1.f / fmaxf(sum, 1e-30f);
    f32x4 oacc[4];
#pragma unroll
    for (int j = 0; j < 4; ++j) oacc[j] = (f32x4){0.f, 0.f, 0.f, 0.f};
#pragma unroll
    for (int c = 0; c < 8; ++c) {
      asm volatile("" ::: "memory");
      if (2 * c < nsub) {
        f32x4 pa = score(2 * c), pb = {-INFINITY, -INFINITY, -INFINITY, -INFINITY};
        if (2 * c + 1 < nsub) pb = score(2 * c + 1);
#pragma unroll
        for (int r = 0; r < 4; ++r) { pa[r] = ex2(pa[r] - mx) * inv; pb[r] = ex2(pb[r] - mx) * inv; }
        impa[2 * c] += pa[0] + pa[1] + pa[2] + 0.5f * pa[3]; p3a[2 * c] += pa[3];
        impa[2 * c + 1] += pb[0] + pb[1] + pb[2] + 0.5f * pb[3]; p3a[2 * c + 1] += pb[3];
        const u32x4 pw = {pk2(pa[0], pa[1]), pk2(pa[2], pa[3]), pk2(pb[0], pb[1]), pk2(pb[2], pb[3])};
        const bf16x8 pf = __builtin_bit_cast(bf16x8, pw);
#pragma unroll
        for (int j = 0; j < 4; ++j) {
          const bf16_t* vr = vcs + (j * 16 + l15) * VC_LD + c * 32 + quad * 4;
          const u32x2 lo = *(const u32x2*)vr, hi = *(const u32x2*)(vr + 16);
          const u32x4 vw = {lo[0], lo[1], hi[0], hi[1]};
          oacc[j] = mfma16(__builtin_bit_cast(bf16x8, vw), pf, oacc[j]);
        }
      }
    }
    const float g0 = gts[head * 3 + 0];
    bf16_t* op = (bf16_t*)(p.ws + O_ONSA) + trow * 512 + head * 64 + quad * 4;
#pragma unroll
    for (int j = 0; j < 4; ++j) store4(op + j * 16, oacc[j], g0);
  }
  __syncthreads();
  float* myimp = imps + wid * 1024 + l15 * 64;
  const int cur = tq >> 6;
#pragma unroll
  for (int s = 0; s < 16; ++s) {
    const float up = __shfl(p3a[s], (lane + 48) & 63);
    const float up0 = s ? __shfl(p3a[s ? s - 1 : 0], (lane + 48) & 63) : 0.f;
    const float prev = quad ? up : up0;
    float v = impa[s] + 0.5f * prev;
    const int j = 4 * s + quad;
    if (j == 0 || j == cur || j == cur - 1) v = 1e9f; else if (j > cur) v = -1e9f;
    myimp[j] = v;
  }
  __syncthreads();
  u64* sel = (u64*)(p.ws + O_SEL) + (size_t)(b * 2 + g) * S_ + t0 + wid * 16;
#pragma unroll 1
  for (int q = 0; q < 16; ++q) {
    const float mine = imps[wid * 1024 + q * 64 + lane]; int rank = 0;
#pragma unroll
    for (int i = 0; i < 64; ++i) { const float v = __uint_as_float(__builtin_amdgcn_readlane(__float_as_uint(mine), i)); rank += (v > mine || (v == mine && i < lane)) ? 1 : 0; }
    const u64 m = __ballot(rank < 16);
    if (lane == 0) sel[q] = m;
  }
  __syncthreads();
}
constexpr int PC_ITEMS = NB_ * 2 * 32;
DI void phase_c(const Params& p, unsigned char* smem) { for (int it = blockIdx.x; it < PC_ITEMS; it += gridDim.x) cmp_item(p, it, smem); }

enum { M_FOX = 0, M_MLA = 1, M_WIN = 2, M_SLC = 3 };
template <int MODE> struct ACfg { static constexpr int DQK = MODE == M_MLA ? 96 : 64, KLD = DQK + 8, NKC = DQK / 8 * 64, KCH = (NKC + NTHR - 1) / NTHR, K_ELEMS = 64 * KLD, V_ELEMS = 64 * 72, STAGE = K_ELEMS + V_ELEMS + 128; };
struct AState { f32x16 o[2]; f32x16 mr; float m, l; };

template <int MODE>
DI void flash_pass(AState& st, const bf16x8* qf, u64 tmask, u64 wmask,
                   const bf16_t* kbase, size_t kld, const bf16_t* kpe, const bf16_t* vtbase, const float* fbias,
                   int tq, u64 mysel, bf16_t* smem) {
  typedef ACfg<MODE> C;
  typedef std::integral_constant<int, 0> S0; typedef std::integral_constant<int, 1> S1;
  const int tid = TIDX(), lane = tid & 63, l31 = lane & 31, half = lane >> 5;
  u32x4 rk[2][C::KCH], rv[2]; float rf[2] = {0.f, 0.f};
  auto gload = [&](int j, auto setc) {
    constexpr int S = decltype(setc)::value;
    const int k0 = j * 64;
#pragma unroll
    for (int i = 0; i < C::KCH; ++i) {
      const int c0 = tid + NTHR * i, c = c0 < C::NKC ? c0 : C::NKC - 1;
      if constexpr (MODE == M_MLA) {
        const int key = c / 12, dc = c % 12;
        const bf16_t* src = dc < 8 ? kbase + (size_t)(k0 + key) * kld + dc * 8 : kpe + (size_t)(k0 + key) * 32 + (dc - 8) * 8;
        rk[S][i] = *(const u32x4*)src;
      } else { const int key = c >> 3, dc = c & 7; rk[S][i] = *(const u32x4*)(kbase + (size_t)(k0 + key) * kld + dc * 8); }
    }
    { const int d = tid >> 3, kc = tid & 7; rv[S] = *(const u32x4*)(vtbase + (size_t)d * S_ + k0 + kc * 8); }
    if constexpr (MODE == M_FOX) rf[S] = fbias[k0 + (tid & 63)];
  };
  auto sstore = [&](int stg, auto setc) {
    constexpr int S = decltype(setc)::value;
    bf16_t* Ks = smem + stg * C::STAGE; bf16_t* Vs = Ks + C::K_ELEMS;
#pragma unroll
    for (int i = 0; i < C::KCH; ++i) {
      const int c = tid + NTHR * i;
      if (c < C::NKC) {
        if constexpr (MODE == M_MLA) { const int key = c / 12, dc = c % 12; *(u32x4*)(Ks + key * C::KLD + dc * 8) = rk[S][i]; }
        else { const int key = c >> 3, dc = c & 7; *(u32x4*)(Ks + key * C::KLD + dc * 8) = rk[S][i]; }
      }
    }
    {
      const int d = tid >> 3, kc = tid & 7, cgp = kc >> 1, a = kc & 1;
      bf16_t* dst = Vs + d * 72 + cgp * 16 + 4 * a;
      *(u32x2*)dst = (u32x2){rv[S][0], rv[S][1]}; *(u32x2*)(dst + 8) = (u32x2){rv[S][2], rv[S][3]};
    }
    if constexpr (MODE == M_FOX) { if (tid < 64) ((float*)(Vs + C::V_ELEMS))[tid] = rf[S]; }
  };
  const int tmin = __builtin_amdgcn_readfirstlane(tq - l31), tmax = tmin + 31;
  auto compute = [&](int j, int stg) {
    bool active = (wmask >> j) & 1;
    if constexpr (MODE == M_SLC) active = active && __any((mysel >> j) & 1);
    if (active) {
      const bf16_t* Ks = smem + stg * C::STAGE; const bf16_t* Vs = Ks + C::K_ELEMS;
      f32x16 s0 = st.mr, s1 = st.mr;
      const bf16_t* kr = Ks + l31 * C::KLD + half * 8;
#pragma unroll
      for (int ks = 0; ks < C::DQK / 16; ++ks) {
        s0 = mfma32(*(const bf16x8*)(kr + ks * 16), qf[ks], s0);
        s1 = mfma32(*(const bf16x8*)(kr + 32 * C::KLD + ks * 16), qf[ks], s1);
      }
      const int k0 = j * 64;
      if constexpr (MODE == M_FOX) {
        const float* fb = (const float*)(Vs + C::V_ELEMS) + 4 * half;
#pragma unroll
        for (int g4 = 0; g4 < 4; ++g4) {
          const f32x4 b0 = *(const f32x4*)(fb + 8 * g4), b1 = *(const f32x4*)(fb + 32 + 8 * g4);
#pragma unroll
          for (int r = 0; r < 4; ++r) { s0[4 * g4 + r] += b0[r]; s1[4 * g4 + r] += b1[r]; }
        }
      }
      bool need = k0 + 63 > tmin;
      if constexpr (MODE == M_WIN) need = need || (k0 <= tmax - 512);
      if constexpr (MODE == M_SLC) {
        if (!need) {
          const bool rsel = ((mysel >> j) & 1) != 0;
          if (!__all(rsel)) {
#pragma unroll
            for (int r = 0; r < 16; ++r) { s0[r] = rsel ? s0[r] : -INFINITY; s1[r] = rsel ? s1[r] : -INFINITY; }
          }
        }
      }
      if (need) {
        const bool rowok = MODE == M_SLC ? ((mysel >> j) & 1) != 0 : true;
#pragma unroll
        for (int r = 0; r < 16; ++r) {
          const int key = k0 + (r & 3) + 8 * (r >> 2) + 4 * half;
          bool ok0 = rowok && key <= tq, ok1 = rowok && key + 32 <= tq;
          if constexpr (MODE == M_WIN) { ok0 = ok0 && (tq - key < 512); ok1 = ok1 && (tq - key - 32 < 512); }
          s0[r] = ok0 ? s0[r] : -INFINITY; s1[r] = ok1 ? s1[r] : -INFINITY;
        }
      }
      int im = (int)0x80000000;
#pragma unroll
      for (int r = 0; r < 16; ++r) im = max(im, max(__float_as_int(s0[r]), __float_as_int(s1[r])));
      im = max(im, __shfl_xor(im, 32));
      constexpr int TBITS = 0x41200000;
      if (__any(im > TBITS)) {
        const float d = im > TBITS ? __int_as_float(im) : 0.f;
        const float a = ex2(-d);
#pragma unroll
        for (int r = 0; r < 16; ++r) { s0[r] -= d; s1[r] -= d; st.o[0][r] *= a; st.o[1][r] *= a; }
        st.l *= a; st.m += d;
#pragma unroll
        for (int r = 0; r < 16; ++r) st.mr[r] = -st.m;
      }
      float sum = 0.f;
#pragma unroll
      for (int r = 0; r < 16; ++r) { s0[r] = ex2(s0[r]); s1[r] = ex2(s1[r]); sum += s0[r] + s1[r]; }
      st.l += sum;
      const bf16_t* vr = Vs + l31 * 72 + half * 8;
#pragma unroll
      for (int c = 0; c < 4; ++c) {
        u32x4 pw;
        if (c < 2) pw = (u32x4){pk2(s0[8 * c + 0], s0[8 * c + 1]), pk2(s0[8 * c + 2], s0[8 * c + 3]), pk2(s0[8 * c + 4], s0[8 * c + 5]), pk2(s0[8 * c + 6], s0[8 * c + 7])};
        else pw = (u32x4){pk2(s1[8 * (c - 2) + 0], s1[8 * (c - 2) + 1]), pk2(s1[8 * (c - 2) + 2], s1[8 * (c - 2) + 3]), pk2(s1[8 * (c - 2) + 4], s1[8 * (c - 2) + 5]), pk2(s1[8 * (c - 2) + 6], s1[8 * (c - 2) + 7])};
        const bf16x8 pf = __builtin_bit_cast(bf16x8, pw);
        st.o[0] = mfma32(*(const bf16x8*)(vr + c * 16), pf, st.o[0]);
        st.o[1] = mfma32(*(const bf16x8*)(vr + 32 * 72 + c * 16), pf, st.o[1]);
      }
    }
  };
  u64 tm = tmask;
  if (tm == 0) return;
  auto pop = [&]() -> int { if (!tm) return -1; const int j = __builtin_ctzll(tm); tm &= tm - 1; return j; };
  int t0 = pop(), t1 = pop(), t2 = pop(), t3 = pop();
  gload(t0, S0{}); gload(t1 >= 0 ? t1 : t0, S1{});
  sstore(0, S0{}); sstore(1, S1{});
  gload(t2 >= 0 ? t2 : t0, S0{}); gload(t3 >= 0 ? t3 : t0, S1{});
  __syncthreads();
  int stg = 0;
  auto step = [&](auto setc) -> bool {
    const int t4 = pop();
    sstore(stg == 0 ? 2 : stg - 1, setc);
    gload(t4 >= 0 ? t4 : t0, setc);
    __builtin_amdgcn_sched_barrier(0);
    compute(t0, stg);
    __syncthreads();
    if (t1 < 0) return true;
    t0 = t1; t1 = t2; t2 = t3; t3 = t4; stg = stg == 2 ? 0 : stg + 1;
    return false;
  };
  for (;;) {
    if (step(S0{})) break;
    if (step(S1{})) break;
  }
}
DI void astate_init(AState& s) {
#pragma unroll
  for (int r = 0; r < 16; ++r) { s.o[0][r] = 0.f; s.o[1][r] = 0.f; }
#pragma unroll
  for (int r = 0; r < 16; ++r) s.mr[r] = 0.f;
  s.m = 0.f; s.l = 0.f;
}
DI u64 lowbits(int n) { return n >= 64 ? ~0ull : ((1ull << n) - 1ull); }

template <int MODE> DI void dense_attn_item(const Params& p, int b, int h, int qt, bf16_t* smem) {
  const int lane = TIDX() & 63, wid = TIDX() >> 6, l31 = lane & 31, half = lane >> 5;
  const int t0 = qt * 256, tq = t0 + wid * 32 + l31; const size_t trow = (size_t)b * S_ + tq;
  constexpr int NQ = ACfg<MODE>::DQK / 16;
  bf16x8 qf[NQ];
  const bf16_t* qp = MODE == M_FOX ? (const bf16_t*)(p.ws + O_FOXQ) + trow * 512 + h * 64 : (const bf16_t*)(p.ws + O_MLAQ) + trow * 768 + h * 96;
#pragma unroll
  for (int ks = 0; ks < NQ; ++ks) qf[ks] = *(const bf16x8*)(qp + ks * 16 + half * 8);
  AState st; astate_init(st);
  const u64 tmask = lowbits(4 * qt + 4), wmask = lowbits(((t0 + wid * 32 + 31) >> 6) + 1);
  if constexpr (MODE == M_FOX)
    flash_pass<M_FOX>(st, qf, tmask, wmask, (const bf16_t*)(p.ws + O_FOXK) + (size_t)b * S_ * 512 + h * 64, 512, nullptr,
                      (const bf16_t*)(p.ws + O_FOXVT) + (size_t)(b * 8 + h) * 64 * S_, (const float*)(p.ws + O_F2) + (size_t)(b * 8 + h) * S_, tq, 0ull, smem);
  else
    flash_pass<M_MLA>(st, qf, tmask, wmask, (const bf16_t*)(p.ws + O_MLAKN) + (size_t)b * S_ * 512 + h * 64, 512, (const bf16_t*)(p.ws + O_MLAKPE) + (size_t)b * S_ * 32,
                      (const bf16_t*)(p.ws + O_MLAVT) + (size_t)(b * 8 + h) * 64 * S_, nullptr, tq, 0ull, smem);
  const float l = st.l + __shfl_xor(st.l, 32), inv = 1.f / fmaxf(l, 1e-30f);
  bf16_t* op = (bf16_t*)qp;
#pragma unroll
  for (int dt = 0; dt < 2; ++dt)
#pragma unroll
    for (int g4 = 0; g4 < 4; ++g4) {
      const int d = dt * 32 + g4 * 8 + half * 4;
      *(u32x2*)(op + d) = (u32x2){pk2(st.o[dt][4 * g4] * inv, st.o[dt][4 * g4 + 1] * inv), pk2(st.o[dt][4 * g4 + 2] * inv, st.o[dt][4 * g4 + 3] * inv)};
    }
}
DI void nsa_attn_item(const Params& p, int b, int g, int qt, bf16_t* smem) {
  const int lane = TIDX() & 63, wid = TIDX() >> 6, l31 = lane & 31, half = lane >> 5;
  const int t0 = qt * 64, tw0 = t0 + (wid >> 2) * 32, tq = tw0 + l31, head = g * 4 + (wid & 3); const size_t trow = (size_t)b * S_ + tq;
  bf16x8 qf[4];
  const bf16_t* qp = (const bf16_t*)(p.ws + O_NSAQ) + trow * 512 + head * 64;
#pragma unroll
  for (int ks = 0; ks < 4; ++ks) qf[ks] = *(const bf16x8*)(qp + ks * 16 + half * 8);
  {
    const float* rp = (const float*)(p.ws + O_ROPE8) + trow * 16;
    u32x4 me = __builtin_bit_cast(u32x4, qf[0]), ot;
#pragma unroll
    for (int e = 0; e < 4; ++e) ot[e] = __shfl_xor(me[e], 32);
    unsigned res[4];
#pragma unroll
    for (int e = 0; e < 4; ++e) {
      float o2[2];
#pragma unroll
      for (int u = 0; u < 2; ++u) {
        const int f = 2 * e + u; const float cs = rp[2 * f], sn = rp[2 * f + 1];
        const float a = bf2f((bf16_t)(u ? me[e] >> 16 : me[e] & 0xffffu)), o = bf2f((bf16_t)(u ? ot[e] >> 16 : ot[e] & 0xffffu));
        o2[u] = half == 0 ? a * cs - o * sn : a * cs + o * sn;
      }
      res[e] = pk2(o2[0], o2[1]);
    }
    qf[0] = __builtin_bit_cast(bf16x8, (u32x4){res[0], res[1], res[2], res[3]});
  }
  const float* gts = (const float*)(p.ws + O_GATES) + trow * 24 + head * 3;
  const int cur = t0 >> 6;
  f32x16 res[2];
  {
    AState st; astate_init(st);
    const int first = t0 >= 511 ? (t0 - 511) >> 6 : 0, firstw = tw0 >= 511 ? (tw0 - 511) >> 6 : 0;
    const u64 tmask = lowbits(cur + 1) & ~lowbits(first), wmask = lowbits(cur + 1) & ~lowbits(firstw);
    flash_pass<M_WIN>(st, qf, tmask, wmask, (const bf16_t*)(p.ws + O_KWIN) + (size_t)b * S_ * 128 + g * 64, 128, nullptr,
                      (const bf16_t*)(p.ws + O_VWINT) + (size_t)(b * 2 + g) * 64 * S_, nullptr, tq, 0ull, smem);
    const float l = st.l + __shfl_xor(st.l, 32), sc = gts[2] / fmaxf(l, 1e-30f);
#pragma unroll
    for (int r = 0; r < 16; ++r) { res[0][r] = st.o[0][r] * sc; res[1][r] = st.o[1][r] * sc; }
  }
  {
    AState st; astate_init(st);
    const u64* selp = (const u64*)(p.ws + O_SEL) + (size_t)(b * 2 + g) * S_;
    const u64 mysel = selp[tq];
    const u64 m64 = selp[t0 + lane];
    unsigned lo = (unsigned)m64, hi = (unsigned)(m64 >> 32);
#pragma unroll
    for (int o = 32; o >= 1; o >>= 1) { lo |= __shfl_xor(lo, o); hi |= __shfl_xor(hi, o); }
    const u64 um = (((u64)(unsigned)__builtin_amdgcn_readfirstlane(hi) << 32) | (u64)(unsigned)__builtin_amdgcn_readfirstlane(lo)) & lowbits(cur + 1);
    flash_pass<M_SLC>(st, qf, um, um, (const bf16_t*)(p.ws + O_KSLC) + (size_t)b * S_ * 128 + g * 64, 128, nullptr,
                      (const bf16_t*)(p.ws + O_VSLCT) + (size_t)(b * 2 + g) * 64 * S_, nullptr, tq, mysel, smem);
    const float l = st.l + __shfl_xor(st.l, 32), sc = gts[1] / fmaxf(l, 1e-30f);
#pragma unroll
    for (int r = 0; r < 16; ++r) { res[0][r] += st.o[0][r] * sc; res[1][r] += st.o[1][r] * sc; }
  }
  bf16_t* op = (bf16_t*)(p.ws + O_ONSA) + trow * 512 + head * 64;
#pragma unroll
  for (int dt = 0; dt < 2; ++dt)
#pragma unroll
    for (int g4 = 0; g4 < 4; ++g4) {
      const int d = dt * 32 + g4 * 8 + half * 4;
      const u32x2 oc = *(const u32x2*)(op + d);
      const float c0 = bf2f((bf16_t)(oc[0] & 0xffffu)), c1 = bf2f((bf16_t)(oc[0] >> 16)), c2 = bf2f((bf16_t)(oc[1] & 0xffffu)), c3 = bf2f((bf16_t)(oc[1] >> 16));
      *(u32x2*)(op + d) = (u32x2){pk2(res[dt][4 * g4] + c0, res[dt][4 * g4 + 1] + c1), pk2(res[dt][4 * g4 + 2] + c2, res[dt][4 * g4 + 3] + c3)};
    }
}
constexpr int PD_ITEMS = 16 * 192;
DI void phase_d(const Params& p, unsigned char* smem) {
  for (int it = blockIdx.x; it < PD_ITEMS; it += gridDim.x) {
    const int r = it / 192, w = it % 192, qt = 15 - r;
    if (w < 64) dense_attn_item<M_MLA>(p, w >> 3, w & 7, qt, (bf16_t*)smem);
    else if (w < 128) dense_attn_item<M_FOX>(p, (w - 64) >> 3, (w - 64) & 7, qt, (bf16_t*)smem);
    else { const int i = w - 128, bg = i & 15, q4 = i >> 4; nsa_attn_item(p, bg >> 1, bg & 1, qt * 4 + q4, (bf16_t*)smem); }
  }
}

DI void merge_tile(const Params& p, int layer, int tm, int tn, bf16_t* smem) {
  typedef GemmLds<8, 2> L;
  const bf16_t* wl = (const bf16_t*)(p.ws + O_W) + (size_t)layer * W_LAYER;
  const int tid = TIDX(), lane = tid & 63, wid = tid >> 6, wm = wid >> 2, wn = wid & 3, l15 = lane & 15, quad = lane >> 4;
  f32x4 mg[8][2]; zero_acc<8, 2>(mg);
  f32x4 acc[8][2]; zero_acc<8, 2>(acc);
  unsigned* gsp = (unsigned*)((unsigned char*)smem + 2 * L::STAGE * 2) + tid;
  const bf16_t* la; const bf16_t* lb; unsigned lald, lbld; int laks, lnk;
  auto get_seg = [&](int sg) {
    const int br = sg >> 1;
    if ((sg & 1) == 0) { la = (const bf16_t*)(p.ws + O_XG) + (size_t)tm * 256 * D_; lald = D_; laks = 64; lb = wl + W_G + ((size_t)br * 1024 + tn * 128) * D_; lbld = D_; lnk = 16; }
    else {
      lald = br == 2 ? 768u : 512u; laks = br == 2 ? 96 : 64; lnk = 8; lbld = 512u;
      la = (const bf16_t*)(p.ws + (br == 0 ? O_ONSA : br == 1 ? O_FOXQ : O_MLAQ)) + (size_t)tm * 256 * lald;
      lb = wl + (br == 0 ? W_BN : br == 1 ? W_BF : W_BM) + (size_t)tn * 128 * 512;
    }
  };
  unsigned pa0, pb0; u32x4 ra[4], rb[2];
  auto set_offsets = [&]() { pa0 = (unsigned)(tid >> 3) * lald + (tid & 7) * 8; pb0 = (unsigned)(tid >> 3) * lbld + (tid & 7) * 8; };
  int ls = 0, lkt = 0;
  get_seg(0); set_offsets();
  auto gload_next = [&]() {
    const bf16_t* ab = la + (size_t)lkt * laks; const bf16_t* bb = lb + (size_t)lkt * 64;
#pragma unroll
    for (int i = 0; i < 4; ++i) ra[i] = *(const u32x4*)(ab + pa0 + (size_t)i * 64 * lald);
#pragma unroll
    for (int i = 0; i < 2; ++i) rb[i] = *(const u32x4*)(bb + pb0 + (size_t)i * 64 * lbld);
    if (++lkt == lnk) {
      if (ls + 1 < 6) { ++ls; lkt = 0; get_seg(ls); set_offsets(); } else lkt = lnk - 1;
    }
  };
  auto sstore = [&](int buf) {
    bf16_t* As = smem + buf * L::STAGE; bf16_t* Bs = As + L::A_ELEMS;
#pragma unroll
    for (int i = 0; i < 4; ++i) { const int c = tid + NTHR * i; *(u32x4*)(As + (c >> 3) * LDT + (c & 7) * 8) = ra[i]; }
#pragma unroll
    for (int i = 0; i < 2; ++i) { const int c = tid + NTHR * i; *(u32x4*)(Bs + (c >> 3) * LDT + (c & 7) * 8) = rb[i]; }
  };
  gload_next(); sstore(0); gload_next(); __syncthreads();
  int buf = 0;
#pragma unroll 1
  for (int sg = 0; sg < 6; ++sg) {
    const int nk = (sg & 1) ? 8 : 16;
#pragma unroll 1
    for (int kt = 0; kt < nk; ++kt) {
      sstore(buf ^ 1);
      gload_next();
      __builtin_amdgcn_sched_barrier(0);
      const bf16_t* As = smem + buf * L::STAGE + (wm * 128 + l15) * LDT + quad * 8;
      const bf16_t* Bs = smem + buf * L::STAGE + L::A_ELEMS + (wn * 32 + l15) * LDT + quad * 8;
#pragma unroll
      for (int ks = 0; ks < 2; ++ks) {
        if (ks == 1) asm volatile("" ::: "memory");
        bf16x8 b[2];
#pragma unroll
        for (int j = 0; j < 2; ++j) b[j] = *(const bf16x8*)(Bs + j * 16 * LDT + ks * 32);
#pragma unroll
        for (int i = 0; i < 8; ++i) {
          const bf16x8 a = *(const bf16x8*)(As + i * 16 * LDT + ks * 32);
#pragma unroll
          for (int j = 0; j < 2; ++j) acc[i][j] = mfma16(b[j], a, acc[i][j]);
        }
      }
      __syncthreads();
      buf ^= 1;
    }
    if ((sg & 1) == 0) {
      const int t2 = TIDX(), row0 = tm * 256 + ((t2 >> 8) & 1) * 128 + (t2 & 15);
#pragma unroll
      for (int i = 0; i < 8; ++i) {
        asm volatile("" ::: "memory");
        const float rs = rstd_from16((const float*)(p.ws + O_SSQ) + (size_t)(row0 + i * 16) * 16, 1.f / 1024.f);
#pragma unroll
        for (int j = 0; j < 2; ++j) {
          unsigned w = 0;
#pragma unroll
          for (int r = 0; r < 4; ++r) w |= (unsigned)__float2int_rn(sigmoidf_(acc[i][j][r] * rs) * 255.f) << (8 * r);
          gsp[(i * 2 + j) * NTHR] = w;
        }
      }
    } else {
#pragma unroll
      for (int i = 0; i < 8; ++i)
#pragma unroll
        for (int j = 0; j < 2; ++j) {
          asm volatile("" ::: "memory");
          const unsigned w = gsp[(i * 2 + j) * NTHR];
#pragma unroll
          for (int r = 0; r < 4; ++r) mg[i][j][r] += (float)((w >> (8 * r)) & 0xffu) * (1.f / 255.f) * acc[i][j][r];
        }
    }
    zero_acc<8, 2>(acc);
  }
  const int t3 = TIDX(), lane3 = t3 & 63, wid3 = t3 >> 6;
  bf16_t* stg = smem + wid3 * (128 * 40);
#pragma unroll
  for (int i = 0; i < 8; ++i)
#pragma unroll
    for (int j = 0; j < 2; ++j) *(u32x2*)(stg + (i * 16 + (lane3 & 15)) * 40 + j * 16 + (lane3 >> 4) * 4) = (u32x2){pk2(mg[i][j][0], mg[i][j][1]), pk2(mg[i][j][2], mg[i][j][3])};
  stage_out<128, 32, 40>(stg, (bf16_t*)(p.ws + O_MERGED) + (size_t)(tm * 256 + (wid3 >> 2) * 128) * D_ + tn * 128 + (wid3 & 3) * 32, (size_t)D_, lane3);
  __syncthreads();
}
DI void phase_e(const Params& p, int layer, unsigned char* smem) {
  xcd_tiles(16, 8, [&](int tm, int tn) { merge_tile(p, layer, tm, tn, (bf16_t*)smem); });
}

DI void resid_tile(const Params& p, const bf16_t* A, int K, const bf16_t* W, const float* xold, const float* gnext, int tm, int tn, bf16_t* smem) {
  f32x4 acc[8][4]; zero_acc<8, 4>(acc);
  RowPtr ap{A + (size_t)tm * 256 * K, (size_t)K}, bp{W + (size_t)tn * 256 * K, (size_t)K};
  gemm_main<8, 4, true>(acc, ap, 64, bp, 64, K / 64, smem);
  const int lane = TIDX() & 63, wid = TIDX() >> 6, wm = wid >> 2, wn = wid & 3, l15 = lane & 15, quad = lane >> 4;
  bf16_t* stg = smem + wid * STG_WAVE;
#pragma unroll
  for (int i = 0; i < 8; ++i) {
    const int t = tm * 256 + wm * 128 + i * 16 + l15, c0 = tn * 256 + wn * 64 + quad * 4; float s = 0.f;
#pragma unroll
    for (int j = 0; j < 4; ++j) {
      const size_t off = (size_t)t * D_ + c0 + j * 16;
      const f32x4 xn = *(const f32x4*)(xold + off) + acc[i][j];
      *(f32x4*)(p.out + off) = xn;
      s += xn[0] * xn[0] + xn[1] * xn[1] + xn[2] * xn[2] + xn[3] * xn[3];
      if (gnext) { const f32x4 gv = *(const f32x4*)(gnext + c0 + j * 16); *(u32x2*)(stg + (i * 16 + l15) * STG_LD + j * 16 + quad * 4) = (u32x2){pk2(xn[0] * gv[0], xn[1] * gv[1]), pk2(xn[2] * gv[2], xn[3] * gv[3])}; }
    }
    s += __shfl_xor(s, 16); s += __shfl_xor(s, 32);
    if (quad == 0) ((float*)(p.ws + O_SSQ))[(size_t)t * 16 + tn * 4 + wn] = s;
  }
  if (gnext) stage_out<128, 64, STG_LD>(stg, (bf16_t*)(p.ws + O_XG) + (size_t)(tm * 256 + wm * 128) * D_ + tn * 256 + wn * 64, (size_t)D_, lane);
  __syncthreads();
}
DI void phase_f(const Params& p, int layer, unsigned char* smem) {
  const bf16_t* wl = (const bf16_t*)(p.ws + O_W) + (size_t)layer * W_LAYER;
  xcd_tiles(16, 4, [&](int tm, int tn) { resid_tile(p, (const bf16_t*)(p.ws + O_MERGED), 1024, wl + W_OUT, layer == 0 ? p.x : p.out, p.ffn_norm + layer * D_, tm, tn, (bf16_t*)smem); });
}
DI void phase_h(const Params& p, int layer, unsigned char* smem) {
  const bf16_t* wl = (const bf16_t*)(p.ws + O_W) + (size_t)layer * W_LAYER;
  xcd_tiles(16, 4, [&](int tm, int tn) { resid_tile(p, (const bf16_t*)(p.ws + O_ACT), DFF_, wl + W_DN, p.out, layer == 0 ? p.mix_norm + D_ : nullptr, tm, tn, (bf16_t*)smem); });
}

struct UpRowPtr { const bf16_t* base; int s0;
  DI unsigned operator()(int r) const { const int s = s0 + r; return (unsigned)((s < 0 || s >= S_) ? 0 : s) * (unsigned)D_; }
  DI bool ok(int r) const { const int s = s0 + r; return s >= 0 && s < S_; } };
constexpr int PG_MT = 17;
DI void ffnup_tile(const Params& p, int layer, int b, int mt, int tn, bf16_t* smem) {
  const bf16_t* wl = (const bf16_t*)(p.ws + O_W) + (size_t)layer * W_LAYER;
  f32x4 acc[8][4]; zero_acc<8, 4>(acc);
  const int s0 = 254 * mt - 2;
  UpRowPtr ap{(const bf16_t*)(p.ws + O_XG) + (size_t)b * S_ * D_, s0}; RowPtr bp{wl + W_UP + (size_t)tn * 256 * D_, (size_t)D_};
  gemm_main<8, 4, true>(acc, ap, 64, bp, 64, 16, smem);
  const int tid = TIDX(), lane = tid & 63, wid = tid >> 6, wm = wid >> 2, wn = wid & 3, l15 = lane & 15, quad = lane >> 4;
  constexpr int LDU = 136; bf16_t* U = smem; bf16_t* V = smem + 256 * LDU;
  {
    bf16_t* dstb = (wn < 2 ? U : V) + (wn & 1) * 64 + quad * 4;
#pragma unroll
    for (int i = 0; i < 8; ++i) {
      const int row = wm * 128 + i * 16 + l15, s = s0 + row;
      const float rs = (s >= 0 && s < S_) ? rstd_from16((const float*)(p.ws + O_SSQ) + ((size_t)b * S_ + s) * 16, 1.f / 1024.f) : 0.f;
#pragma unroll
      for (int j = 0; j < 4; ++j) store4(dstb + row * LDU + j * 16, acc[i][j], rs);
    }
  }
  __syncthreads();
  {
    const int cc = tid & 15, cg0 = tn * 128 + cc * 8;
    const float* cw = p.conv_w + (size_t)layer * 3 * DFF_ + cg0; const float* cbp = p.conv_b + (size_t)layer * DFF_ + cg0;
    float w0[8], w1[8], w2[8], cb[8];
#pragma unroll
    for (int e = 0; e < 8; ++e) { w0[e] = cw[e]; w1[e] = cw[DFF_ + e]; w2[e] = cw[2 * DFF_ + e]; cb[e] = cbp[e]; }
    bf16_t* act = (bf16_t*)(p.ws + O_ACT);
#pragma unroll 2
    for (int it = 0; it < 8; ++it) {
      const int row = it * 32 + (tid >> 4), s = s0 + row;
      if (row >= 2 && s < S_) {
        const u32x4 u0 = *(const u32x4*)(U + (row - 2) * LDU + cc * 8), u1 = *(const u32x4*)(U + (row - 1) * LDU + cc * 8), u2 = *(const u32x4*)(U + row * LDU + cc * 8), vv = *(const u32x4*)(V + row * LDU + cc * 8);
        unsigned o[4];
#pragma unroll
        for (int e = 0; e < 4; ++e) {
          float r2[2];
#pragma unroll
          for (int h = 0; h < 2; ++h) {
            const int k = 2 * e + h;
            const float a0 = bf2f((bf16_t)(h ? u0[e] >> 16 : u0[e] & 0xffffu)), a1 = bf2f((bf16_t)(h ? u1[e] >> 16 : u1[e] & 0xffffu)), a2 = bf2f((bf16_t)(h ? u2[e] >> 16 : u2[e] & 0xffffu)), vx = bf2f((bf16_t)(h ? vv[e] >> 16 : vv[e] & 0xffffu));
            const float uc = w0[k] * a0 + w1[k] * a1 + w2[k] * a2 + cb[k];
            r2[h] = uc * sigmoidf_(uc) * vx;
          }
          o[e] = pk2(r2[0], r2[1]);
        }
        __builtin_nontemporal_store((u32x4){o[0], o[1], o[2], o[3]}, (u32x4*)(act + ((size_t)b * S_ + s) * DFF_ + cg0));
      }
    }
  }
  __syncthreads();
}
DI void phase_g(const Params& p, int layer, unsigned char* smem) {
  xcd_tiles(PG_MT, 22, [&](int tmg, int tn) { ffnup_tile(p, layer, tmg / PG_MT, tmg % PG_MT, tn, (bf16_t*)smem); });
}

DI void phase_final(const Params& p) {
  const int lane = TIDX() & 63, wid = TIDX() >> 6;
  for (int it = blockIdx.x; it < T_ / 8; it += gridDim.x) {
    const int t = it * 8 + wid; const float rs = rstd_from16((const float*)(p.ws + O_SSQ) + (size_t)t * 16, 1.f / 1024.f);
    float* xr = p.out + (size_t)t * D_;
#pragma unroll
    for (int c = 0; c < 4; ++c) { const int k = c * 256 + lane * 4; const f32x4 v = *(const f32x4*)(xr + k), gv = *(const f32x4*)(p.final_norm + k); *(f32x4*)(xr + k) = v * rs * gv; }
  }
}

#define XB_TMO      128
#define XB_XCNT(j)  (256  + 64 * (j))
#define XB_XSUB(j)  (1280 + 64 * (j))
#define XB_XGEN(j)  (2304 + 64 * (j))
#define XB_TOP      3328
#define XB_TOPGEN   3392
#define XCD_BAR_WORDS 3456
#define XB_SPIN_CAP (1u << 22)
#define LAS __attribute__((address_space(3)))
DI unsigned xb_ld(unsigned* p)              { return __hip_atomic_load(p, __ATOMIC_RELAXED, __HIP_MEMORY_SCOPE_AGENT); }
DI unsigned xb_add(unsigned* p, unsigned v) { return __hip_atomic_fetch_add(p, v, __ATOMIC_RELAXED, __HIP_MEMORY_SCOPE_AGENT); }
DI unsigned xb_xcc_id() { return (unsigned)__builtin_amdgcn_s_getreg((3 << 11) | 20) & 0xFu; }
#define XB_SPIN(cond, bar) do { unsigned _sp = 0; while (cond) { __builtin_amdgcn_s_sleep(1); \
    if ((++_sp & 255u) == 0u) { if (xb_ld(&(bar)[XB_TMO])) break; if (_sp > XB_SPIN_CAP) { atomicAdd(&(bar)[XB_TMO], 1u); break; } } } } while (0)
struct XcdBarrier { unsigned* bar; unsigned x; volatile LAS unsigned* st; };
DI XcdBarrier xcd_barrier_post(unsigned* bar, volatile LAS unsigned* st) {
  XcdBarrier b; b.bar = bar; b.x = xb_xcc_id(); b.st = st;
  if (threadIdx.x == 0) (void)xb_add(&bar[XB_XCNT(b.x)], 1u);
  return b;
}
DI void xcd_barrier_complete(unsigned* bar, unsigned x, unsigned& nloc, unsigned& nx) {
  const unsigned G = gridDim.x * gridDim.y * gridDim.z;
  unsigned sum, cnt, mine, sp = 0u;
  for (;;) {
    sum = 0u; cnt = 0u; mine = 0u;
#pragma unroll
    for (unsigned j = 0; j < 16; ++j) { const unsigned c = xb_ld(&bar[XB_XCNT(j)]); sum += c; cnt += (c > 0u) ? 1u : 0u; mine = (j == x) ? c : mine; }
    if (sum == G) break;
    __builtin_amdgcn_s_sleep(1);
    if ((++sp & 255u) == 0u) { if (xb_ld(&bar[XB_TMO])) break; if (sp > XB_SPIN_CAP) { atomicAdd(&bar[XB_TMO], 1u); break; } }
  }
  nloc = mine > 0u ? mine : 1u; nx = cnt > 0u ? cnt : 1u;
}
DI void xcd_barrier(const XcdBarrier& b) {
  asm volatile("s_waitcnt vmcnt(0)" ::: "memory");
  __syncthreads();
  if (threadIdx.x == 0) {
    unsigned* bar = b.bar;
    __builtin_amdgcn_s_waitcnt(0);
    unsigned nloc = b.st[0], nx = b.st[1];
    if (nloc == 0u) { xcd_barrier_complete(bar, b.x, nloc, nx); b.st[0] = nloc; b.st[1] = nx; }
    const unsigned old = xb_add(&bar[XB_XSUB(b.x)], 1u);
    const unsigned gen = old / nloc;
    if (old + 1u == (gen + 1u) * nloc) {
      __builtin_amdgcn_fence(__ATOMIC_RELEASE, "agent");
      asm volatile("s_waitcnt vmcnt(0)" ::: "memory");
      const unsigned og = xb_add(&bar[XB_TOP], 1u);
      const unsigned tg = og / nx;
      if (og + 1u == (tg + 1u) * nx) xb_add(&bar[XB_TOPGEN], 1u);
      else XB_SPIN(xb_ld(&bar[XB_TOPGEN]) == tg, bar);
      __builtin_amdgcn_fence(__ATOMIC_ACQUIRE, "agent");
      xb_add(&bar[XB_XGEN(b.x)], 1u);
      asm volatile("s_waitcnt vmcnt(0)" ::: "memory");
    } else {
      XB_SPIN(xb_ld(&bar[XB_XGEN(b.x)]) == gen, bar);
      __builtin_amdgcn_fence(__ATOMIC_ACQUIRE, "agent");
      asm volatile("s_waitcnt vmcnt(0)" ::: "memory");
    }
  }
  __syncthreads();
}
DI void run_phase(const Params& p, int ph, unsigned char* smem) {
  if (ph == 0) { phase_prep(p, smem); return; }
  if (ph == 17) { phase_final(p); return; }
  const int layer = (ph - 1) >> 3, s = (ph - 1) & 7;
#ifdef PROBE_DUP
  if ((PROBE_DUP >> s) & 1) {
    switch (s) { case 0: phase_inproj(p, layer, smem); break; case 1: phase_b(p, layer, smem); break; case 2: phase_c(p, smem); break; case 4: phase_e(p, layer, smem); break; case 6: phase_g(p, layer, smem); break; default: break; }
    __syncthreads();
  }
#endif
  switch (s) {
    case 0: phase_inproj(p, layer, smem); break;
    case 1: phase_b(p, layer, smem); break;
    case 2: phase_c(p, smem); break;
    case 3: phase_d(p, smem); break;
    case 4: phase_e(p, layer, smem); break;
    case 5: phase_f(p, layer, smem); break;
    case 6: phase_g(p, layer, smem); break;
    default: phase_h(p, layer, smem); break;
  }
}
constexpr int N_PHASES = 18;

#if ONE_LAUNCH
template <int PH> DI void run_all(const Params& p, unsigned char* smem, cg::grid_group& grid, const XcdBarrier& xb) {
  run_phase(p, PH, smem);
  if constexpr (PH + 1 < N_PHASES) {
    if constexpr (PH == 0) grid.sync(); else xcd_barrier(xb);
    run_all<PH + 1>(p, smem, grid, xb);
  }
}
__global__ void __launch_bounds__(NTHR, 2) mega_kernel(Params p) {
  __shared__ __attribute__((aligned(16))) unsigned char smem[SMEM_BYTES];
  __shared__ uint4 xb_words;
  if (threadIdx.x == 0) xb_words = make_uint4(0u, 0u, 0u, 0u);
  __syncthreads();
  const XcdBarrier xb = xcd_barrier_post((unsigned*)(p.ws + O_BAR), (volatile LAS unsigned*)&xb_words);
  cg::grid_group grid = cg::this_grid();
  run_all<0>(p, smem, grid, xb);
}
#else
template <int PH> __global__ void __launch_bounds__(NTHR, 2) phase_kernel(Params p) {
  __shared__ __attribute__((aligned(16))) unsigned char smem[SMEM_BYTES];
  run_phase(p, PH, smem);
}
template <int PH> static void launch_phases(const Params& p, hipStream_t stream) {
  hipLaunchKernelGGL((phase_kernel<PH>), dim3(256), dim3(NTHR), 0, stream, p);
  if constexpr (PH + 1 < N_PHASES) launch_phases<PH + 1>(p, stream);
}
#endif

extern "C" void kernel_launch(void* const* d_in, const int* in_sizes, int n_in, void* d_out, int out_size, void* d_ws, size_t ws_size, hipStream_t stream) {
  if (ws_size < O_END || n_in < 25) { fprintf(stderr, "workspace too small: %zu < %zu\n", ws_size, (size_t)O_END); return; }
  Params p{};
  p.x = (const float*)d_in[0]; p.pos = (const int*)d_in[1]; p.mix_norm = (const float*)d_in[2]; p.w_in = (const float*)d_in[3]; p.b_forget = (const float*)d_in[4];
  p.pe_k = (const float*)d_in[5]; p.w1_k = (const float*)d_in[6]; p.w2_k = (const float*)d_in[7]; p.pe_v = (const float*)d_in[8]; p.w1_v = (const float*)d_in[9]; p.w2_v = (const float*)d_in[10];
  p.q_norm = (const float*)d_in[11]; p.w_uq = (const float*)d_in[12]; p.kv_norm = (const float*)d_in[13]; p.w_ukv = (const float*)d_in[14];
  p.wbr_nsa = (const float*)d_in[15]; p.wbr_fox = (const float*)d_in[16]; p.wbr_mla = (const float*)d_in[17]; p.w_out = (const float*)d_in[18];
  p.ffn_norm = (const float*)d_in[19]; p.w_up = (const float*)d_in[20]; p.conv_w = (const float*)d_in[21]; p.conv_b = (const float*)d_in[22]; p.w_down = (const float*)d_in[23]; p.final_norm = (const float*)d_in[24];
  p.out = (float*)d_out; p.ws = (unsigned char*)d_ws;
#if ONE_LAUNCH
  static int grid_blocks = 0;
  if (!grid_blocks) {
    int dev = 0, cus = 0, per_cu = 0;
    hipGetDevice(&dev); hipDeviceGetAttribute(&cus, hipDeviceAttributeMultiprocessorCount, dev);
    hipOccupancyMaxActiveBlocksPerMultiprocessor(&per_cu, mega_kernel, NTHR, 0);
    if (per_cu > 1) per_cu = 1;
    grid_blocks = cus * per_cu;
  }
  hipMemsetAsync(p.ws + O_BAR, 0, XCD_BAR_WORDS * 4, stream);
  void* args[] = {&p};
  hipError_t e = hipLaunchCooperativeKernel((void*)mega_kernel, dim3(grid_blocks), dim3(NTHR), args, 0, stream);
  if (e != hipSuccess) fprintf(stderr, "cooperative launch failed: %s (grid %d)\n", hipGetErrorString(e), grid_blocks);
#else
  launch_phases<0>(p, stream);
#endif
}
```

```cpp
#include <hip/hip_runtime.h>
#include <hip/hip_cooperative_groups.h>
#include <stdint.h>
#include <stdio.h>
#include <type_traits>
namespace cg = cooperative_groups;

#ifndef ONE_LAUNCH
#define ONE_LAUNCH 1

#endif

#define DI __device__ __forceinline__
typedef unsigned short bf16_t;
typedef short bf16x8 __attribute__((ext_vector_type(8)));
typedef float f32x4 __attribute__((ext_vector_type(4)));
typedef float f32x16 __attribute__((ext_vector_type(16)));
typedef float f32x2 __attribute__((ext_vector_type(2)));
typedef __bf16 bfx2 __attribute__((ext_vector_type(2)));
typedef unsigned u32x4 __attribute__((ext_vector_type(4)));
typedef unsigned u32x2 __attribute__((ext_vector_type(2)));
typedef unsigned long long u64;

constexpr int T_ = 32768, S_ = 4096, NB_ = 8, D_ = 1024, DFF_ = 2816, NIN_ = 6592;
constexpr float EPS_ = 1e-6f;
constexpr float LOG2E_ = 1.4426950408889634f;
constexpr float QS64_ = 0.125f * LOG2E_;
constexpr float QS96_ = 0.10206207261596577f * LOG2E_;

constexpr size_t W_IN = 0;
constexpr size_t W_G = W_IN + (size_t)3584 * 1024;
constexpr size_t W_1K = W_G + (size_t)3072 * 1024;
constexpr size_t W_1V = W_1K + (size_t)256 * 2048;
constexpr size_t W_2K = W_1V + (size_t)256 * 2048;
constexpr size_t W_2V = W_2K + (size_t)64 * 256;
constexpr size_t W_UQ = W_2V + (size_t)64 * 256;
constexpr size_t W_UKV = W_UQ + (size_t)768 * 384;
constexpr size_t W_BN = W_UKV + (size_t)1024 * 256;
constexpr size_t W_BF = W_BN + (size_t)1024 * 512;
constexpr size_t W_BM = W_BF + (size_t)1024 * 512;
constexpr size_t W_OUT = W_BM + (size_t)1024 * 512;
constexpr size_t W_UP = W_OUT + (size_t)1024 * 1024;
constexpr size_t W_DN = W_UP + (size_t)5632 * 1024;
constexpr size_t W_LAYER = W_DN + (size_t)1024 * 2816;

constexpr size_t al256(size_t x) { return (x + 255) & ~(size_t)255; }
constexpr size_t O_BAR = 0;
constexpr size_t O_W = 16384;
constexpr size_t O_BIAS1 = al256(O_W + 2 * W_LAYER * 2);
constexpr size_t O_ROPE8 = al256(O_BIAS1 + 2 * 2 * 16 * 256 * 4);
constexpr size_t O_ROPE16 = al256(O_ROPE8 + (size_t)T_ * 16 * 4);
constexpr size_t O_XG = al256(O_ROPE16 + (size_t)T_ * 32 * 4);
constexpr size_t O_SSQ = al256(O_XG + (size_t)T_ * 1024 * 2);
constexpr size_t O_CSSQ = al256(O_SSQ + (size_t)T_ * 16 * 4);
constexpr size_t O_NSAQ = al256(O_CSSQ + (size_t)T_ * 16 * 4);
constexpr size_t O_KVCMP = O_NSAQ + (size_t)T_ * 512 * 2;
constexpr size_t O_KSLC = O_KVCMP + (size_t)T_ * 256 * 2;
constexpr size_t O_KWIN = O_KSLC + (size_t)T_ * 128 * 2;
constexpr size_t O_MERGED = O_NSAQ;
constexpr size_t O_VSLCT = O_KWIN + (size_t)T_ * 128 * 2;
constexpr size_t O_VWINT = O_VSLCT + (size_t)T_ * 128 * 2;
constexpr size_t O_FOXQ = O_VWINT + (size_t)T_ * 128 * 2;
constexpr size_t O_FOXK = O_FOXQ + (size_t)T_ * 512 * 2;
constexpr size_t O_FOXVT = O_FOXK + (size_t)T_ * 512 * 2;
constexpr size_t O_MLAQ = O_FOXVT + (size_t)T_ * 512 * 2;
constexpr size_t O_MLAKN = O_MLAQ + (size_t)T_ * 768 * 2;
constexpr size_t O_ACT = O_FOXQ;
constexpr size_t O_MLAVT = O_MLAKN + (size_t)T_ * 512 * 2;
constexpr size_t O_MLAKPE = O_MLAVT + (size_t)T_ * 512 * 2;
constexpr size_t O_ONSA = O_MLAKPE + (size_t)T_ * 32 * 2;
constexpr size_t O_CQ = O_ONSA;
constexpr size_t O_CKV = O_CQ + (size_t)T_ * 384 * 2;
constexpr size_t O_CEND = O_CKV + (size_t)T_ * 256 * 2;
constexpr size_t O_GATES = al256(O_CEND > O_ONSA + (size_t)T_ * 512 * 2 ? O_CEND : O_ONSA + (size_t)T_ * 512 * 2);
constexpr size_t O_LOGF = al256(O_GATES + (size_t)T_ * 24 * 4);
constexpr size_t O_F2 = al256(O_LOGF + (size_t)T_ * 8 * 4);
constexpr size_t O_KC = al256(O_F2 + (size_t)T_ * 8 * 4);
constexpr size_t O_VCT = al256(O_KC + (size_t)NB_ * 2 * 256 * 64 * 2);
constexpr size_t O_SEL = al256(O_VCT + (size_t)NB_ * 2 * 256 * 64 * 2);
constexpr size_t O_END = al256(O_SEL + (size_t)NB_ * 2 * S_ * 8);

struct Params {
  const float* x; const int* pos; const float* mix_norm; const float* w_in; const float* b_forget;
  const float* pe_k; const float* w1_k; const float* w2_k; const float* pe_v; const float* w1_v; const float* w2_v;
  const float* q_norm; const float* w_uq; const float* kv_norm; const float* w_ukv;
  const float* wbr_nsa; const float* wbr_fox; const float* wbr_mla; const float* w_out;
  const float* ffn_norm; const float* w_up; const float* conv_w; const float* conv_b; const float* w_down; const float* final_norm;
  float* out; unsigned char* ws;
};

constexpr int NTHR = 512;
constexpr int SMEM_BYTES = 147456;

DI int TIDX() { int t = (int)threadIdx.x; asm volatile("" : "+v"(t)); return t; }
DI unsigned pk2(float lo, float hi) { f32x2 v = {lo, hi}; return __builtin_bit_cast(unsigned, __builtin_convertvector(v, bfx2)); }
DI bf16_t f2bf(float x) { return (bf16_t)(pk2(x, 0.f) & 0xffffu); }
DI float bf2f(bf16_t h) { return __uint_as_float(((unsigned)h) << 16); }
DI float sigmoidf_(float x) { return 1.f / (1.f + __expf(-x)); }
DI float gelu_tanh(float x) { const float u = 0.7978845608028654f * (x + 0.044715f * x * x * x); return x / (1.f + __expf(-2.f * u)); }
DI float ex2(float x) { return __builtin_amdgcn_exp2f(x); }
DI f32x16 mfma32(bf16x8 a, bf16x8 b, f32x16 c) { return __builtin_amdgcn_mfma_f32_32x32x16_bf16(a, b, c, 0, 0, 0); }
DI f32x4 mfma16(bf16x8 a, bf16x8 b, f32x4 c) { return __builtin_amdgcn_mfma_f32_16x16x32_bf16(a, b, c, 0, 0, 0); }
DI float rstd_from16(const float* p, float inv_n) {
  const f32x4 a = *(const f32x4*)p, b = *(const f32x4*)(p + 4), c = *(const f32x4*)(p + 8), d = *(const f32x4*)(p + 12);
  const float s = ((a[0] + a[1]) + (a[2] + a[3])) + ((b[0] + b[1]) + (b[2] + b[3])) + ((c[0] + c[1]) + (c[2] + c[3])) + ((d[0] + d[1]) + (d[2] + d[3]));
  return rsqrtf(s * inv_n + EPS_);
}

constexpr int LDT = 72;
template <int MI, int NJ> struct GemmLds { static constexpr int BM = 32 * MI, BN = 64 * NJ, A_ELEMS = BM * LDT, B_ELEMS = BN * LDT, STAGE = A_ELEMS + B_ELEMS; };

template <int MI, int NJ, bool SWAP, class AP, class BP>
DI void gemm_main(f32x4 (&acc)[MI][NJ], const AP& ap, int a_kstep, const BP& bp, int b_kstep, int nk, bf16_t* smem) {
  typedef GemmLds<MI, NJ> L;
  constexpr int CA = MI / 2, CB = NJ;
  const int tid = TIDX(), lane = tid & 63, wid = tid >> 6, wm = wid >> 2, wn = wid & 3, l15 = lane & 15, quad = lane >> 4;
  unsigned pa[CA], pb[CB]; bool oka[CA];
#pragma unroll
  for (int i = 0; i < CA; ++i) { const int c = tid + NTHR * i; pa[i] = ap(c >> 3) + (c & 7) * 8; oka[i] = ap.ok(c >> 3); }
#pragma unroll
  for (int i = 0; i < CB; ++i) { const int c = tid + NTHR * i; pb[i] = bp(c >> 3) + (c & 7) * 8; }
  u32x4 ra[CA], rb[CB];
  auto gload = [&](int kt) {
    const bf16_t* ab = ap.base + (size_t)kt * a_kstep; const bf16_t* bb = bp.base + (size_t)kt * b_kstep;
#pragma unroll
    for (int i = 0; i < CA; ++i) ra[i] = *(const u32x4*)(ab + pa[i]);
#pragma unroll
    for (int i = 0; i < CB; ++i) rb[i] = *(const u32x4*)(bb + pb[i]);
  };
  auto sstore = [&](int buf) {
    bf16_t* As = smem + buf * L::STAGE; bf16_t* Bs = As + L::A_ELEMS;
#pragma unroll
    for (int i = 0; i < CA; ++i) { const int c = tid + NTHR * i; *(u32x4*)(As + (c >> 3) * LDT + (c & 7) * 8) = oka[i] ? ra[i] : (u32x4){0u, 0u, 0u, 0u}; }
#pragma unroll
    for (int i = 0; i < CB; ++i) { const int c = tid + NTHR * i; *(u32x4*)(Bs + (c >> 3) * LDT + (c & 7) * 8) = rb[i]; }
  };
  gload(0); sstore(0); gload(nk > 1 ? 1 : 0); __syncthreads();
#pragma unroll 1
  for (int kt = 0; kt < nk; ++kt) {
    const int buf = kt & 1;
    sstore(buf ^ 1);
    gload(kt + 2 < nk ? kt + 2 : nk - 1);
    __builtin_amdgcn_sched_barrier(0);
    const bf16_t* As = smem + buf * L::STAGE + (wm * 16 * MI + l15) * LDT + quad * 8;
    const bf16_t* Bs = smem + buf * L::STAGE + L::A_ELEMS + (wn * 16 * NJ + l15) * LDT + quad * 8;
#pragma unroll
    for (int ks = 0; ks < 2; ++ks) {
      if (MI * NJ >= 32 && ks == 1) asm volatile("" ::: "memory");
      bf16x8 b[NJ];
#pragma unroll
      for (int j = 0; j < NJ; ++j) b[j] = *(const bf16x8*)(Bs + j * 16 * LDT + ks * 32);
#pragma unroll
      for (int i = 0; i < MI; ++i) {
        const bf16x8 a = *(const bf16x8*)(As + i * 16 * LDT + ks * 32);
#pragma unroll
        for (int j = 0; j < NJ; ++j) acc[i][j] = SWAP ? mfma16(b[j], a, acc[i][j]) : mfma16(a, b[j], acc[i][j]);
      }
    }
    __syncthreads();
  }
}
template <int MI, int NJ> DI void zero_acc(f32x4 (&acc)[MI][NJ]) {
#pragma unroll
  for (int i = 0; i < MI; ++i)
#pragma unroll
    for (int j = 0; j < NJ; ++j) acc[i][j] = (f32x4){0.f, 0.f, 0.f, 0.f};
}
struct RowPtr { const bf16_t* base; size_t ld; DI unsigned operator()(int r) const { return (unsigned)r * (unsigned)ld; } DI bool ok(int) const { return true; } };


template <class F> DI void xcd_tiles(int MPX, int NT, F&& body) {
  const int xcd = blockIdx.x & 7, slot = blockIdx.x >> 3, nslots = gridDim.x >> 3, total = MPX * NT;
  for (int li = slot; li < total; li += nslots) {
    const int mg = li / (8 * NT), rem = li - mg * 8 * NT;
    const int gsz = (MPX - mg * 8) < 8 ? (MPX - mg * 8) : 8;
    const int tn = rem / gsz, mi = rem - tn * gsz;
    body(xcd * MPX + mg * 8 + mi, tn);
  }
}

DI int map_col(int map, int n) {
  if (map == 0) return n;
  if (map == 1) {
    if (n < 896) return n;
    if (n < 1024) return 1024 + (n - 896);
    if (n < 1152) return 896 + (n - 1024);
    if (n < 1280) return n;
    if (n < 2816) return 1304 + (n - 1280);
    if (n < 3200) return 2848 + (n - 2816);
    if (n < 3456) return 3232 + (n - 3200);
    const int c = n - 3456;
    if (c < 24) return 1280 + c;
    if (c < 32) return 2840 + (c - 24);
    if (c < 64) return 3488 + (c - 32);
    return -1;
  }
  if (map == 2) { const int j = n >> 8, c = n & 255; return c < 128 ? j * 128 + c : DFF_ + j * 128 + (c - 128); }
  if (map == 3) { return n < 512 ? (n >> 6) * 128 + (n & 63) : ((n - 512) >> 6) * 128 + 64 + ((n - 512) & 63); }
  return n;
}
struct WJob { const float* src; const float* scale; bf16_t* dst; int K, N, ld, map, off; };
DI void prep_weight_tile(const WJob& j, int tile, float* lds) {
  const int ntn = j.N >> 6, tk = tile / ntn, tn = tile % ntn, tid = TIDX();
  const int n4 = (tid & 15) * 4; const int sc = map_col(j.map, tn * 64 + n4);
  f32x4 v[4];
#pragma unroll
  for (int i = 0; i < 4; ++i) {
    const int kk = (tid >> 4) + 32 * i, k = tk * 128 + kk;
    v[i] = sc >= 0 ? *(const f32x4*)(j.src + (size_t)k * j.ld + j.off + sc) : (f32x4){0.f, 0.f, 0.f, 0.f};
    if (j.scale) v[i] = v[i] * j.scale[k];
  }
#pragma unroll
  for (int i = 0; i < 4; ++i) {
    const int kk = (tid >> 4) + 32 * i;
#pragma unroll
    for (int e = 0; e < 4; ++e) lds[kk * 65 + n4 + e] = v[i][e];
  }
  __syncthreads();
  const int nn = tid >> 3, k0 = (tid & 7) * 16;
  unsigned w[8];
#pragma unroll
  for (int e = 0; e < 8; ++e) w[e] = pk2(lds[(k0 + 2 * e) * 65 + nn], lds[(k0 + 2 * e + 1) * 65 + nn]);
  bf16_t* d = j.dst + (size_t)(tn * 64 + nn) * j.K + tk * 128 + k0;
  *(u32x4*)d = (u32x4){w[0], w[1], w[2], w[3]}; *(u32x4*)(d + 8) = (u32x4){w[4], w[5], w[6], w[7]};
  __syncthreads();
}
DI WJob get_wjob(const Params& p, int layer, int id) {
  bf16_t* wl = (bf16_t*)(p.ws + O_W) + (size_t)layer * W_LAYER; WJob j; j.scale = nullptr; j.map = 0; j.off = 0;
  switch (id) {
    case 0: j.src = p.w_in + (size_t)layer * 1024 * NIN_; j.dst = wl + W_IN; j.K = 1024; j.N = 3584; j.ld = NIN_; j.map = 1; break;
    case 1: j.src = p.w_in + (size_t)layer * 1024 * NIN_; j.dst = wl + W_G; j.K = 1024; j.N = 3072; j.ld = NIN_; j.off = 3520; break;
    case 2: j.src = p.w1_k + (size_t)layer * 2048 * 256; j.dst = wl + W_1K; j.K = 2048; j.N = 256; j.ld = 256; break;
    case 3: j.src = p.w1_v + (size_t)layer * 2048 * 256; j.dst = wl + W_1V; j.K = 2048; j.N = 256; j.ld = 256; break;
    case 4: j.src = p.w2_k + (size_t)layer * 256 * 64; j.dst = wl + W_2K; j.K = 256; j.N = 64; j.ld = 64; break;
    case 5: j.src = p.w2_v + (size_t)layer * 256 * 64; j.dst = wl + W_2V; j.K = 256; j.N = 64; j.ld = 64; break;
    case 6: j.src = p.w_uq + (size_t)layer * 384 * 768; j.dst = wl + W_UQ; j.K = 384; j.N = 768; j.ld = 768; j.scale = p.q_norm + layer * 384; break;
    case 7: j.src = p.w_ukv + (size_t)layer * 256 * 1024; j.dst = wl + W_UKV; j.K = 256; j.N = 1024; j.ld = 1024; j.scale = p.kv_norm + layer * 256; j.map = 3; break;
    case 8: j.src = p.wbr_nsa + (size_t)layer * 512 * 1024; j.dst = wl + W_BN; j.K = 512; j.N = 1024; j.ld = 1024; break;
    case 9: j.src = p.wbr_fox + (size_t)layer * 512 * 1024; j.dst = wl + W_BF; j.K = 512; j.N = 1024; j.ld = 1024; break;
    case 10: j.src = p.wbr_mla + (size_t)layer * 512 * 1024; j.dst = wl + W_BM; j.K = 512; j.N = 1024; j.ld = 1024; break;
    case 11: j.src = p.w_out + (size_t)layer * 1024 * 1024; j.dst = wl + W_OUT; j.K = 1024; j.N = 1024; j.ld = 1024; break;
    case 12: j.src = p.w_up + (size_t)layer * 1024 * 5632; j.dst = wl + W_UP; j.K = 1024; j.N = 5632; j.ld = 5632; j.map = 2; break;
    default: j.src = p.w_down + (size_t)layer * 2816 * 1024; j.dst = wl + W_DN; j.K = 2816; j.N = 1024; j.ld = 1024; break;
  }
  return j;
}
constexpr int WTILES_LAYER = (int)(W_LAYER / 8192);
constexpr int P0_XITEMS = T_ / 64;
constexpr int P0_ROPE_ITEMS = T_ / NTHR;
constexpr int P0_ITEMS = 2 * WTILES_LAYER + 64 + P0_ROPE_ITEMS + P0_XITEMS;

DI void xg_rows(const float* x, const float* g, bf16_t* xg, float* ssq, int row0) {
  const int lane = TIDX() & 63, wid = TIDX() >> 6;
  for (int rr = 0; rr < 8; ++rr) {
    const int t = row0 + wid * 8 + rr; const float* xr = x + (size_t)t * D_; float s = 0.f;
#pragma unroll
    for (int c = 0; c < 4; ++c) {
      const int k = c * 256 + lane * 4; const f32x4 v = *(const f32x4*)(xr + k), gv = *(const f32x4*)(g + k);
      s += v[0] * v[0] + v[1] * v[1] + v[2] * v[2] + v[3] * v[3];
      *(u32x2*)(xg + (size_t)t * D_ + k) = (u32x2){pk2(v[0] * gv[0], v[1] * gv[1]), pk2(v[2] * gv[2], v[3] * gv[3])};
    }
#pragma unroll
    for (int o = 32; o >= 1; o >>= 1) s += __shfl_xor(s, o);
    if (lane < 16) ssq[(size_t)t * 16 + lane] = lane == 0 ? s : 0.f;
  }
}
DI void phase_prep(const Params& p, unsigned char* smem) {
  for (int it = blockIdx.x; it < P0_ITEMS; it += gridDim.x) {
    int i = it;
    if (i < 2 * WTILES_LAYER) {
      const int layer = i / WTILES_LAYER; int t = i % WTILES_LAYER; int id = 0;
      for (;; ++id) { const WJob j = get_wjob(p, layer, id); const int nt = (j.K >> 7) * (j.N >> 6); if (t < nt) { prep_weight_tile(j, t, (float*)smem); break; } t -= nt; }
      continue;
    }
    i -= 2 * WTILES_LAYER;
    if (i < 64) {
      const int lk = i >> 4, pc = i & 15, layer = lk >> 1, kv = lk & 1, c = TIDX() & 255, hf = TIDX() >> 8;
      const float* pe = (kv ? p.pe_v : p.pe_k) + (size_t)layer * 2048 + pc * 128 + hf * 64; const float* w1 = (kv ? p.w1_v : p.w1_k) + (size_t)layer * 2048 * 256 + (size_t)(pc * 128 + hf * 64) * 256;
      float sacc = 0.f;
#pragma unroll 8
      for (int kk = 0; kk < 64; ++kk) sacc += pe[kk] * w1[(size_t)kk * 256 + c];
      float* lds = (float*)smem;
      if (hf) lds[c] = sacc;
      __syncthreads();
      if (!hf) ((float*)(p.ws + O_BIAS1))[(lk * 16 + pc) * 256 + c] = sacc + lds[c];
      __syncthreads();
      continue;
    }
    i -= 64;
    if (i < P0_ROPE_ITEMS) {
      const int t = i * NTHR + TIDX(); const float fp = (float)p.pos[t];
      float* r8 = (float*)(p.ws + O_ROPE8) + (size_t)t * 16; float* r16 = (float*)(p.ws + O_ROPE16) + (size_t)t * 32;
      for (int f = 0; f < 24; ++f) {
        const int half = f < 8 ? 8 : 16, idx = f < 8 ? f : f - 8;
        const float inv = exp2f(-(float)idx / (float)half * 18.931568569324174f);
        const float ang = fp * inv;
        const double rev = (double)ang * 0.15915494309189535; const float fr = (float)(rev - floor(rev));
        const float sn = __builtin_amdgcn_sinf(fr), cs = __builtin_amdgcn_cosf(fr);
        if (f < 8) { r8[2 * idx] = cs; r8[2 * idx + 1] = sn; } else { r16[2 * idx] = cs; r16[2 * idx + 1] = sn; }
      }
      continue;
    }
    i -= P0_ROPE_ITEMS;
    xg_rows(p.x, p.mix_norm, (bf16_t*)(p.ws + O_XG), (float*)(p.ws + O_SSQ), i * 64);
  }
}

DI void store4(bf16_t* dst, const f32x4& v, float s) { *(u32x2*)dst = (u32x2){pk2(v[0] * s, v[1] * s), pk2(v[2] * s, v[3] * s)}; }
constexpr int STG_LD = 72, STG_WAVE = 128 * 72;
DI void stage4(bf16_t* stg, int row, int col, const f32x4& v, float s) { *(u32x2*)(stg + row * STG_LD + col) = (u32x2){pk2(v[0] * s, v[1] * s), pk2(v[2] * s, v[3] * s)}; }
template <int ROWS, int COLS, int LD> DI void stage_out(const bf16_t* stg, bf16_t* dst, size_t ld, int lane) {
  asm volatile("s_waitcnt lgkmcnt(0)" ::: "memory");
  constexpr int CPR = COLS / 8, IT = ROWS * CPR / 64;
#pragma unroll
  for (int it = 0; it < IT; ++it) {
    const int idx = it * 64 + lane, r = idx / CPR, c = idx % CPR;
    __builtin_nontemporal_store(*(const u32x4*)(stg + r * LD + c * 8), (u32x4*)(dst + (size_t)r * ld + c * 8));
  }
}
template <bool SWAP> DI void inproj_tile(const Params& p, int layer, int tm, int tn, bf16_t* smem) {
  const bf16_t* wl = (const bf16_t*)(p.ws + O_W) + (size_t)layer * W_LAYER;
  f32x4 acc[8][4]; zero_acc<8, 4>(acc);
  RowPtr ap{(const bf16_t*)(p.ws + O_XG) + (size_t)tm * 256 * D_, (size_t)D_}, bp{wl + W_IN + (size_t)tn * 256 * D_, (size_t)D_};
  gemm_main<8, 4, SWAP>(acc, ap, 64, bp, 64, 16, smem);
  const int lane = TIDX() & 63, wid = TIDX() >> 6, wm = wid >> 2, wn = wid & 3, l15 = lane & 15, quad = lane >> 4;
  const float* ssq = (const float*)(p.ws + O_SSQ);
  bf16_t* stg = smem + wid * STG_WAVE;
  const int trow0 = tm * 256 + wm * 128;
  if constexpr (!SWAP) {
    bf16_t* dst; int hh, hd;
    if (tn == 4) { dst = (bf16_t*)(p.ws + (wn < 2 ? O_VSLCT : O_VWINT)); hh = 2; hd = wn & 1; } else { dst = (bf16_t*)(p.ws + O_FOXVT); hh = 8; hd = (tn - 9) * 4 + wn; }
    constexpr int VLD = 136;
#pragma unroll
    for (int i = 0; i < 8; ++i) {
      const int t0 = trow0 + i * 16 + quad * 4;
      float rs[4];
#pragma unroll
      for (int r = 0; r < 4; ++r) rs[r] = rstd_from16(ssq + (size_t)(t0 + r) * 16, 1.f / 1024.f);
#pragma unroll
      for (int j = 0; j < 4; ++j)
        *(u32x2*)(stg + (j * 16 + l15) * VLD + i * 16 + quad * 4) = (u32x2){pk2(acc[i][j][0] * rs[0], acc[i][j][1] * rs[1]), pk2(acc[i][j][2] * rs[2], acc[i][j][3] * rs[3])};
    }
    const int b = trow0 >> 12, s0 = trow0 & 4095;
    stage_out<64, 128, VLD>(stg, dst + ((size_t)(b * hh + hd) * 64) * S_ + s0, (size_t)S_, lane);
  } else {
    const int slab = tn * 4 + wn;
    if (slab == 54) {
#pragma unroll
      for (int i = 0; i < 8; ++i) {
        const int t = trow0 + i * 16 + l15; const float rs = rstd_from16(ssq + (size_t)t * 16, 1.f / 1024.f);
        float* gt = (float*)(p.ws + O_GATES) + (size_t)t * 24; float* lf = (float*)(p.ws + O_LOGF) + (size_t)t * 8;
#pragma unroll
        for (int r = 0; r < 4; ++r) gt[quad * 4 + r] = sigmoidf_(acc[i][0][r] * rs);
        if (quad < 2) {
#pragma unroll
          for (int r = 0; r < 4; ++r) gt[16 + quad * 4 + r] = sigmoidf_(acc[i][1][r] * rs);
        } else {
#pragma unroll
          for (int r = 0; r < 4; ++r) { const int h = (quad - 2) * 4 + r; const float xx = acc[i][1][r] * rs + p.b_forget[layer * 8 + h]; lf[h] = fminf(xx, 0.f) - log1pf(__expf(-fabsf(xx))); }
        }
        const float* rp = (const float*)(p.ws + O_ROPE16) + (size_t)t * 32 + quad * 8; float o1[4], o2[4];
#pragma unroll
        for (int r = 0; r < 4; ++r) { const float cs = rp[2 * r], sn = rp[2 * r + 1], x1 = acc[i][2][r] * rs, x2 = acc[i][3][r] * rs; o1[r] = x1 * cs - x2 * sn; o2[r] = x2 * cs + x1 * sn; }
        bf16_t* kp = (bf16_t*)(p.ws + O_MLAKPE) + (size_t)t * 32 + quad * 4;
        *(u32x2*)kp = (u32x2){pk2(o1[0], o1[1]), pk2(o1[2], o1[3])}; *(u32x2*)(kp + 16) = (u32x2){pk2(o2[0], o2[1]), pk2(o2[2], o2[3])};
      }
    } else if (slab != 55) {
      bf16_t* dbuf; int dld, dcol, kind = 0; float qs = 1.f; int cslot = 0;
      if (slab < 8) { dbuf = (bf16_t*)(p.ws + O_NSAQ); dld = 512; dcol = slab * 64; qs = QS64_; }
      else if (slab < 12) { dbuf = (bf16_t*)(p.ws + O_KVCMP); dld = 256; dcol = (slab - 8) * 64; }
      else if (slab < 16) { dbuf = (bf16_t*)(p.ws + (slab < 14 ? O_KSLC : O_KWIN)); dld = 128; dcol = (slab & 1) * 64; kind = 1; }
      else if (slab < 28) { dbuf = (bf16_t*)(p.ws + O_FOXQ); dld = 512; dcol = (slab - 20) * 64; qs = QS64_; }
      else if (slab < 36) { dbuf = (bf16_t*)(p.ws + O_FOXK); dld = 512; dcol = (slab - 28) * 64; }
      else if (slab < 50) { dbuf = (bf16_t*)(p.ws + O_CQ); dld = 384; dcol = (slab - 44) * 64; kind = 2; cslot = slab - 44; }
      else { dbuf = (bf16_t*)(p.ws + O_CKV); dld = 256; dcol = (slab - 50) * 64; kind = 2; cslot = 8 + slab - 50; }
#pragma unroll
      for (int i = 0; i < 8; ++i) {
        const int row = i * 16 + l15, t = trow0 + row; const float rs = rstd_from16(ssq + (size_t)t * 16, 1.f / 1024.f) * qs;
        if (kind == 1) {
          const float* rp = (const float*)(p.ws + O_ROPE8) + (size_t)t * 16 + (quad & 1) * 8;
          f32x4 v, o;
#pragma unroll
          for (int r = 0; r < 4; ++r) { v[r] = acc[i][0][r] * rs; o[r] = __shfl_xor(v[r], 32); }
#pragma unroll
          for (int r = 0; r < 4; ++r) { const float cs = rp[2 * r], sn = rp[2 * r + 1]; v[r] = quad < 2 ? v[r] * cs - o[r] * sn : v[r] * cs + o[r] * sn; }
          stage4(stg, row, quad * 4, v, 1.f);
        } else stage4(stg, row, quad * 4, acc[i][0], rs);
#pragma unroll
        for (int j = 1; j < 4; ++j) stage4(stg, row, j * 16 + quad * 4, acc[i][j], rs);
        if (kind == 2) {
          float s = 0.f;
#pragma unroll
          for (int j = 0; j < 4; ++j) { const f32x4 a = acc[i][j] * rs; s += a[0] * a[0] + a[1] * a[1] + a[2] * a[2] + a[3] * a[3]; }
          s += __shfl_xor(s, 16); s += __shfl_xor(s, 32);
          if (quad == 0) ((float*)(p.ws + O_CSSQ))[(size_t)t * 16 + cslot] = s;
        }
      }
      stage_out<128, 64, STG_LD>(stg, dbuf + (size_t)trow0 * dld + dcol, (size_t)dld, lane);
    }
  }
  __syncthreads();
}
DI void phase_inproj(const Params& p, int layer, unsigned char* smem) {
  xcd_tiles(16, 14, [&](int tm, int tn) {
    const bool vt = (tn == 4 || tn == 9 || tn == 10);
    if (vt) inproj_tile<false>(p, layer, tm, tn, (bf16_t*)smem); else inproj_tile<true>(p, layer, tm, tn, (bf16_t*)smem);
  });
}

template <int KIND> DI void mlaup_tile(const Params& p, int layer, int tm, int tn, bf16_t* smem) {
  const bf16_t* wl = (const bf16_t*)(p.ws + O_W) + (size_t)layer * W_LAYER;
  f32x4 acc[8][4]; zero_acc<8, 4>(acc);
  constexpr int K = KIND == 0 ? 384 : 256;
  RowPtr ap{KIND == 0 ? (const bf16_t*)(p.ws + O_CQ) + (size_t)tm * 256 * 384 : (const bf16_t*)(p.ws + O_CKV) + (size_t)tm * 256 * 256, (size_t)K};
  RowPtr bp{KIND == 0 ? wl + W_UQ + (size_t)tn * 256 * 384 : wl + W_UKV + (size_t)(tn - 3) * 256 * 256, (size_t)K};
  gemm_main<8, 4, KIND != 2>(acc, ap, 64, bp, 64, K / 64, smem);
  const int lane = TIDX() & 63, wid = TIDX() >> 6, wm = wid >> 2, wn = wid & 3, l15 = lane & 15, quad = lane >> 4;
  const float* cssq = (const float*)(p.ws + O_CSSQ);
  bf16_t* stg = smem + wid * STG_WAVE; const int trow0 = tm * 256 + wm * 128;
  if constexpr (KIND == 2) {
    bf16_t* dst = (bf16_t*)(p.ws + O_MLAVT); const int h = (tn - 5) * 4 + wn;
    constexpr int VLD = 136;
#pragma unroll
    for (int i = 0; i < 8; ++i) {
      asm volatile("" ::: "memory");
      const int t0 = trow0 + i * 16 + quad * 4; float rs[4];
#pragma unroll
      for (int r = 0; r < 4; ++r) { const float* c = cssq + (size_t)(t0 + r) * 16 + 8; rs[r] = rsqrtf((c[0] + c[1] + c[2] + c[3]) * (1.f / 256.f) + EPS_); }
#pragma unroll
      for (int j = 0; j < 4; ++j)
        *(u32x2*)(stg + (j * 16 + l15) * VLD + i * 16 + quad * 4) = (u32x2){pk2(acc[i][j][0] * rs[0], acc[i][j][1] * rs[1]), pk2(acc[i][j][2] * rs[2], acc[i][j][3] * rs[3])};
    }
    stage_out<64, 128, VLD>(stg, dst + ((size_t)((trow0 >> 12) * 8 + h) * 64) * S_ + (trow0 & 4095), (size_t)S_, lane);
  } else if constexpr (KIND == 1) {
#pragma unroll
    for (int i = 0; i < 8; ++i) {
      asm volatile("" ::: "memory");
      const int row = i * 16 + l15, t = trow0 + row; const float* c = cssq + (size_t)t * 16;
      const float rs = rsqrtf((c[8] + c[9] + c[10] + c[11]) * (1.f / 256.f) + EPS_);
#pragma unroll
      for (int j = 0; j < 4; ++j) stage4(stg, row, j * 16 + quad * 4, acc[i][j], rs);
    }
    stage_out<128, 64, STG_LD>(stg, (bf16_t*)(p.ws + O_MLAKN) + (size_t)trow0 * 512 + (tn - 3) * 256 + wn * 64, (size_t)512, lane);
  } else {
    const int n0 = tn * 256 + wn * 64, ph = n0 % 96;
#pragma unroll
    for (int i = 0; i < 8; ++i) {
      asm volatile("" ::: "memory");
      const int row = i * 16 + l15, t = trow0 + row; const float* c = cssq + (size_t)t * 16;
      const float rs = rsqrtf((c[0] + c[1] + c[2] + c[3] + c[4] + c[5]) * (1.f / 384.f) + EPS_) * QS96_;
      f32x4 v0 = acc[i][0] * rs, v1 = acc[i][1] * rs, v2 = acc[i][2] * rs, v3 = acc[i][3] * rs;
      if (ph != 0) {
        const float* rp = (const float*)(p.ws + O_ROPE16) + (size_t)t * 32 + quad * 8;
        const f32x4 x1 = ph == 64 ? v0 : v2, x2 = ph == 64 ? v1 : v3; f32x4 o1, o2;
#pragma unroll
        for (int r = 0; r < 4; ++r) { const float cs = rp[2 * r], sn = rp[2 * r + 1]; o1[r] = x1[r] * cs - x2[r] * sn; o2[r] = x2[r] * cs + x1[r] * sn; }
        if (ph == 64) { v0 = o1; v1 = o2; } else { v2 = o1; v3 = o2; }
      }
      stage4(stg, row, quad * 4, v0, 1.f); stage4(stg, row, 16 + quad * 4, v1, 1.f); stage4(stg, row, 32 + quad * 4, v2, 1.f); stage4(stg, row, 48 + quad * 4, v3, 1.f);
    }
    stage_out<128, 64, STG_LD>(stg, (bf16_t*)(p.ws + O_MLAQ) + (size_t)trow0 * 768 + n0, (size_t)768, lane);
  }
  __syncthreads();
}
struct CmpRowPtr { const bf16_t* base; int r0;
  DI unsigned operator()(int r) const { int R = r0 + r; if (R >= 4080) R = 0; const int b = R / 510, rem = R - b * 510, n = rem >> 1, g = rem & 1; return (unsigned)(b * S_ + 16 * n) * 256u + g * 64; }
  DI bool ok(int r) const { return r0 + r < 4080; } };
DI void compress_item(const Params& p, int layer, int item, bf16_t* smem) {
  const int kv = item >> 5, tm = item & 31;
  const bf16_t* wl = (const bf16_t*)(p.ws + O_W) + (size_t)layer * W_LAYER;
  f32x4 acc[4][4]; zero_acc<4, 4>(acc);
  CmpRowPtr ap{(const bf16_t*)(p.ws + O_KVCMP) + kv * 128, tm * 128};
  RowPtr bp{wl + (kv ? W_1V : W_1K), (size_t)2048};
  gemm_main<4, 4, true>(acc, ap, 256, bp, 64, 32, smem);
  const int lane = TIDX() & 63, wid = TIDX() >> 6, wm = wid >> 2, wn = wid & 3, l15 = lane & 15, quad = lane >> 4;
  constexpr int LDH = 264; bf16_t* H = smem;
  const float* b1 = (const float*)(p.ws + O_BIAS1) + (size_t)(layer * 2 + kv) * 16 * 256;
#pragma unroll
  for (int j = 0; j < 4; ++j) {
    asm volatile("" ::: "memory");
    f32x4 bv = {0.f, 0.f, 0.f, 0.f};
    for (int pc = 0; pc < 16; ++pc) bv += *(const f32x4*)(b1 + pc * 256 + wn * 64 + j * 16 + quad * 4);
#pragma unroll
    for (int i = 0; i < 4; ++i) {
      const int row = wm * 64 + i * 16 + l15, col = wn * 64 + j * 16 + quad * 4;
      *(u32x2*)(H + row * LDH + col) = (u32x2){pk2(gelu_tanh(acc[i][j][0] + bv[0]), gelu_tanh(acc[i][j][1] + bv[1])), pk2(gelu_tanh(acc[i][j][2] + bv[2]), gelu_tanh(acc[i][j][3] + bv[3]))};
    }
  }
  __syncthreads();
  f32x4 a2[4];
#pragma unroll
  for (int j = 0; j < 4; ++j) a2[j] = (f32x4){0.f, 0.f, 0.f, 0.f};
  const bf16_t* w2 = wl + (kv ? W_2V : W_2K);
#pragma unroll
  for (int ks = 0; ks < 8; ++ks) {
    const bf16x8 a = *(const bf16x8*)(H + (wid * 16 + l15) * LDH + ks * 32 + quad * 8);
#pragma unroll
    for (int j = 0; j < 4; ++j) a2[j] = mfma16(a, *(const bf16x8*)(w2 + (size_t)(j * 16 + l15) * 256 + ks * 32 + quad * 8), a2[j]);
  }
  bf16_t* kc = (bf16_t*)(p.ws + O_KC); bf16_t* vct = (bf16_t*)(p.ws + O_VCT);
#pragma unroll
  for (int r = 0; r < 4; ++r) {
    const int R = tm * 128 + wid * 16 + quad * 4 + r;
    if (R < 4080) {
      const int b = R / 510, rem = R - b * 510, n = rem >> 1, g = rem & 1;
#pragma unroll
      for (int j = 0; j < 4; ++j) {
        const int d = j * 16 + l15; const bf16_t v = f2bf(a2[j][r]);
        if (kv == 0) kc[((size_t)(b * 2 + g) * 256 + n) * 64 + d] = v; else vct[((size_t)(b * 2 + g) * 64 + d) * 256 + n] = v;
      }
    }
  }
  __syncthreads();
}
DI void foxscan_item(const Params& p, int item, float* lds) {
  const int b = item >> 3, h = item & 7, tid = TIDX();
  const float* lf = (const float*)(p.ws + O_LOGF) + (size_t)b * S_ * 8 + h; float v[8]; float s = 0.f;
#pragma unroll
  for (int i = 0; i < 8; ++i) { s += lf[(size_t)(tid * 8 + i) * 8]; v[i] = s; }
  lds[tid] = s; __syncthreads();
  float off = 0.f;
  for (int i = 0; i < tid; ++i) off += lds[i];
  float* F2 = (float*)(p.ws + O_F2) + (size_t)(b * 8 + h) * S_ + tid * 8;
#pragma unroll
  for (int i = 0; i < 8; ++i) F2[i] = -(off + v[i]) * LOG2E_;
  __syncthreads();
}
DI void phase_b(const Params& p, int layer, unsigned char* smem) {
  if (blockIdx.x < 64) { compress_item(p, layer, blockIdx.x, (bf16_t*)smem); return; }
  for (int it = blockIdx.x - 64; it < 64; it += gridDim.x - 64) foxscan_item(p, it, (float*)smem);
  {
    const int xcd = blockIdx.x & 7, slot = (blockIdx.x >> 3) - 8, nslots = (gridDim.x >> 3) - 8;
    for (int li = slot; li < 16 * 7; li += nslots) {
      const int mg = li / 56, rem = li - mg * 56, tn = rem >> 3, tm = xcd * 16 + mg * 8 + (rem & 7);
      if (tn >= 5) mlaup_tile<2>(p, layer, tm, tn, (bf16_t*)smem); else if (tn >= 3) mlaup_tile<1>(p, layer, tm, tn, (bf16_t*)smem); else mlaup_tile<0>(p, layer, tm, tn, (bf16_t*)smem);
    }
  }
}

constexpr int KC_LD = 72, VC_LD = 264;
DI void cmp_item(const Params& p, int item, unsigned char* smem_) {
  const int b = item >> 6, g = (item >> 5) & 1, tt = item & 31, t0 = tt * 128;
  const int tid = TIDX(), lane = tid & 63, wid = tid >> 6, l15 = lane & 15, quad = lane >> 4;
  bf16_t* kcs = (bf16_t*)smem_;
  bf16_t* vcs = kcs + 256 * KC_LD;
  float* imps = (float*)smem_;
  const int nmax = (t0 + 96) >> 4;
  const int nsub = (nmax >> 4) + 1;
  {
    const bf16_t* kcg = (const bf16_t*)(p.ws + O_KC) + (size_t)(b * 2 + g) * 256 * 64; const bf16_t* vcg = (const bf16_t*)(p.ws + O_VCT) + (size_t)(b * 2 + g) * 64 * 256;
    const int nrows = ((nsub + 1) & ~1) * 16;
    for (int e = tid; e < nrows * 8; e += NTHR) {
      const int n = e >> 3, dc = (e & 7) * 8;
      *(u32x4*)(kcs + n * KC_LD + dc) = n < 255 ? *(const u32x4*)(kcg + (size_t)n * 64 + dc) : (u32x4){0u, 0u, 0u, 0u};
    }
    const int ncs = nrows >> 3;
    for (int e = tid; e < 64 * ncs; e += NTHR) {
      const int d = e / ncs, nc = (e - d * ncs) * 8;
      u32x4 v = *(const u32x4*)(vcg + (size_t)d * 256 + nc);
      if (nc + 8 > 255) v[3] &= 0x0000ffffu;
      *(u32x4*)(vcs + d * VC_LD + nc) = v;
    }
  }
  __syncthreads();
  const int tq = t0 + wid * 16 + l15;
  const size_t trow = (size_t)b * S_ + tq;
  float impa[16], p3a[16];
#pragma unroll
  for (int s = 0; s < 16; ++s) { impa[s] = 0.f; p3a[s] = 0.f; }
  const float* gts = (const float*)(p.ws + O_GATES) + trow * 24;
#pragma unroll 1
  for (int r4 = 0; r4 < 4; ++r4) {
    const int head = g * 4 + r4;
    const bf16_t* qp = (const bf16_t*)(p.ws + O_NSAQ) + trow * 512 + head * 64 + quad * 8;
    const bf16x8 q0 = *(const bf16x8*)qp, q1 = *(const bf16x8*)(qp + 32);
    auto score = [&](int s) -> f32x4 {
      const bf16_t* kr = kcs + (s * 16 + l15) * KC_LD + quad * 8;
      f32x4 a = {0.f, 0.f, 0.f, 0.f};
      a = mfma16(*(const bf16x8*)kr, q0, a); a = mfma16(*(const bf16x8*)(kr + 32), q1, a);
#pragma unroll
      for (int r = 0; r < 4; ++r) { const int n = s * 16 + quad * 4 + r; a[r] = (16 * n + 31 <= tq) ? a[r] : -INFINITY; }
      return a;
    };
    float mx = -INFINITY;
#pragma unroll 1
    for (int s = 0; s < nsub; ++s) { const f32x4 a = score(s); mx = fmaxf(mx, fmaxf(fmaxf(a[0], a[1]), fmaxf(a[2], a[3]))); }
    mx = fmaxf(mx, __shfl_xor(mx, 16)); mx = fmaxf(mx, __shfl_xor(mx, 32));
    if (mx == -INFINITY) mx = 0.f;
    float sum = 0.f;
#pragma unroll 1
    for (int s = 0; s < nsub; ++s) { const f32x4 a = score(s); sum += (ex2(a[0] - mx) + ex2(a[1] - mx)) + (ex2(a[2] - mx) + ex2(a[3] - mx)); }
    sum += __shfl_xor(sum, 16); sum += __shfl_xor(sum, 32);
    const float inv = 1.f / fmaxf(sum, 1e-30f);
    f32x4 oacc[4];
#pragma unroll
    for (int j = 0; j < 4; ++j) oacc[j] = (f32x4){0.f, 0.f, 0.f, 0.f};
#pragma unroll
    for (int c = 0; c < 8; ++c) {
      asm volatile("" ::: "memory");
      if (2 * c < nsub) {
        f32x4 pa = score(2 * c), pb = {-INFINITY, -INFINITY, -INFINITY, -INFINITY};
        if (2 * c + 1 < nsub) pb = score(2 * c + 1);
#pragma unroll
        for (int r = 0; r < 4; ++r) { pa[r] = ex2(pa[r] - mx) * inv; pb[r] = ex2(pb[r] - mx) * inv; }
        impa[2 * c] += pa[0] + pa[1] + pa[2] + 0.5f * pa[3]; p3a[2 * c] += pa[3];
        impa[2 * c + 1] += pb[0] + pb[1] + pb[2] + 0.5f * pb[3]; p3a[2 * c + 1] += pb[3];
        const u32x4 pw = {pk2(pa[0], pa[1]), pk2(pa[2], pa[3]), pk2(pb[0], pb[1]), pk2(pb[2], pb[3])};
        const bf16x8 pf = __builtin_bit_cast(bf16x8, pw);
#pragma unroll
        for (int j = 0; j < 4; ++j) {
          const bf16_t* vr = vcs + (j * 16 + l15) * VC_LD + c * 32 + quad * 4;
          const u32x2 lo = *(const u32x2*)vr, hi = *(const u32x2*)(vr + 16);
          const u32x4 vw = {lo[0], lo[1], hi[0], hi[1]};
          oacc[j] = mfma16(__builtin_bit_cast(bf16x8, vw), pf, oacc[j]);
        }
      }
    }
    const float g0 = gts[head * 3 + 0];
    bf16_t* op = (bf16_t*)(p.ws + O_ONSA) + trow * 512 + head * 64 + quad * 4;
#pragma unroll
    for (int j = 0; j < 4; ++j) store4(op + j * 16, oacc[j], g0);
  }
  __syncthreads();
  float* myimp = imps + wid * 1024 + l15 * 64;
  const int cur = tq >> 6;
#pragma unroll
  for (int s = 0; s < 16; ++s) {
    const float up = __shfl(p3a[s], (lane + 48) & 63);
    const float up0 = s ? __shfl(p3a[s ? s - 1 : 0], (lane + 48) & 63) : 0.f;
    const float prev = quad ? up : up0;
    float v = impa[s] + 0.5f * prev;
    const int j = 4 * s + quad;
    if (j == 0 || j == cur || j == cur - 1) v = 1e9f; else if (j > cur) v = -1e9f;
    myimp[j] = v;
  }
  __syncthreads();
  u64* sel = (u64*)(p.ws + O_SEL) + (size_t)(b * 2 + g) * S_ + t0 + wid * 16;
#pragma unroll 1
  for (int q = 0; q < 16; ++q) {
    const float mine = imps[wid * 1024 + q * 64 + lane]; int rank = 0;
#pragma unroll
    for (int i = 0; i < 64; ++i) { const float v = __uint_as_float(__builtin_amdgcn_readlane(__float_as_uint(mine), i)); rank += (v > mine || (v == mine && i < lane)) ? 1 : 0; }
    const u64 m = __ballot(rank < 16);
    if (lane == 0) sel[q] = m;
  }
  __syncthreads();
}
constexpr int PC_ITEMS = NB_ * 2 * 32;
DI void phase_c(const Params& p, unsigned char* smem) { for (int it = blockIdx.x; it < PC_ITEMS; it += gridDim.x) cmp_item(p, it, smem); }

enum { M_FOX = 0, M_MLA = 1, M_WIN = 2, M_SLC = 3 };
template <int MODE> struct ACfg { static constexpr int DQK = MODE == M_MLA ? 96 : 64, KLD = DQK + 8, NKC = DQK / 8 * 64, KCH = (NKC + NTHR - 1) / NTHR, K_ELEMS = 64 * KLD, V_ELEMS = 64 * 72, STAGE = K_ELEMS + V_ELEMS + 128; };
struct AState { f32x16 o[2]; f32x16 mr; float m, l; };

template <int MODE>
DI void flash_pass(AState& st, const bf16x8* qf, u64 tmask, u64 wmask,
                   const bf16_t* kbase, size_t kld, const bf16_t* kpe, const bf16_t* vtbase, const float* fbias,
                   int tq, u64 mysel, bf16_t* smem) {
  typedef ACfg<MODE> C;
  typedef std::integral_constant<int, 0> S0; typedef std::integral_constant<int, 1> S1;
  const int tid = TIDX(), lane = tid & 63, l31 = lane & 31, half = lane >> 5;
  u32x4 rk[2][C::KCH], rv[2]; float rf[2] = {0.f, 0.f};
  auto gload = [&](int j, auto setc) {
    constexpr int S = decltype(setc)::value;
    const int k0 = j * 64;
#pragma unroll
    for (int i = 0; i < C::KCH; ++i) {
      const int c0 = tid + NTHR * i, c = c0 < C::NKC ? c0 : C::NKC - 1;
      if constexpr (MODE == M_MLA) {
        const int key = c / 12, dc = c % 12;
        const bf16_t* src = dc < 8 ? kbase + (size_t)(k0 + key) * kld + dc * 8 : kpe + (size_t)(k0 + key) * 32 + (dc - 8) * 8;
        rk[S][i] = *(const u32x4*)src;
      } else { const int key = c >> 3, dc = c & 7; rk[S][i] = *(const u32x4*)(kbase + (size_t)(k0 + key) * kld + dc * 8); }
    }
    { const int d = tid >> 3, kc = tid & 7; rv[S] = *(const u32x4*)(vtbase + (size_t)d * S_ + k0 + kc * 8); }
    if constexpr (MODE == M_FOX) rf[S] = fbias[k0 + (tid & 63)];
  };
  auto sstore = [&](int stg, auto setc) {
    constexpr int S = decltype(setc)::value;
    bf16_t* Ks = smem + stg * C::STAGE; bf16_t* Vs = Ks + C::K_ELEMS;
#pragma unroll
    for (int i = 0; i < C::KCH; ++i) {
      const int c = tid + NTHR * i;
      if (c < C::NKC) {
        if constexpr (MODE == M_MLA) { const int key = c / 12, dc = c % 12; *(u32x4*)(Ks + key * C::KLD + dc * 8) = rk[S][i]; }
        else { const int key = c >> 3, dc = c & 7; *(u32x4*)(Ks + key * C::KLD + dc * 8) = rk[S][i]; }
      }
    }
    {
      const int d = tid >> 3, kc = tid & 7, cgp = kc >> 1, a = kc & 1;
      bf16_t* dst = Vs + d * 72 + cgp * 16 + 4 * a;
      *(u32x2*)dst = (u32x2){rv[S][0], rv[S][1]}; *(u32x2*)(dst + 8) = (u32x2){rv[S][2], rv[S][3]};
    }
    if constexpr (MODE == M_FOX) { if (tid < 64) ((float*)(Vs + C::V_ELEMS))[tid] = rf[S]; }
  };
  const int tmin = __builtin_amdgcn_readfirstlane(tq - l31), tmax = tmin + 31;
  auto compute = [&](int j, int stg) {
    bool active = (wmask >> j) & 1;
    if constexpr (MODE == M_SLC) active = active && __any((mysel >> j) & 1);
    if (active) {
      const bf16_t* Ks = smem + stg * C::STAGE; const bf16_t* Vs = Ks + C::K_ELEMS;
      f32x16 s0 = st.mr, s1 = st.mr;
      const bf16_t* kr = Ks + l31 * C::KLD + half * 8;
#pragma unroll
      for (int ks = 0; ks < C::DQK / 16; ++ks) {
        s0 = mfma32(*(const bf16x8*)(kr + ks * 16), qf[ks], s0);
        s1 = mfma32(*(const bf16x8*)(kr + 32 * C::KLD + ks * 16), qf[ks], s1);
      }
      const int k0 = j * 64;
      if constexpr (MODE == M_FOX) {
        const float* fb = (const float*)(Vs + C::V_ELEMS) + 4 * half;
#pragma unroll
        for (int g4 = 0; g4 < 4; ++g4) {
          const f32x4 b0 = *(const f32x4*)(fb + 8 * g4), b1 = *(const f32x4*)(fb + 32 + 8 * g4);
#pragma unroll
          for (int r = 0; r < 4; ++r) { s0[4 * g4 + r] += b0[r]; s1[4 * g4 + r] += b1[r]; }
        }
      }
      bool need = k0 + 63 > tmin;
      if constexpr (MODE == M_WIN) need = need || (k0 <= tmax - 512);
      if constexpr (MODE == M_SLC) {
        if (!need) {
          const bool rsel = ((mysel >> j) & 1) != 0;
          if (!__all(rsel)) {
#pragma unroll
            for (int r = 0; r < 16; ++r) { s0[r] = rsel ? s0[r] : -INFINITY; s1[r] = rsel ? s1[r] : -INFINITY; }
          }
        }
      }
      if (need) {
        const bool rowok = MODE == M_SLC ? ((mysel >> j) & 1) != 0 : true;
#pragma unroll
        for (int r = 0; r < 16; ++r) {
          const int key = k0 + (r & 3) + 8 * (r >> 2) + 4 * half;
          bool ok0 = rowok && key <= tq, ok1 = rowok && key + 32 <= tq;
          if constexpr (MODE == M_WIN) { ok0 = ok0 && (tq - key < 512); ok1 = ok1 && (tq - key - 32 < 512); }
          s0[r] = ok0 ? s0[r] : -INFINITY; s1[r] = ok1 ? s1[r] : -INFINITY;
        }
      }
      int im = (int)0x80000000;
#pragma unroll
      for (int r = 0; r < 16; ++r) im = max(im, max(__float_as_int(s0[r]), __float_as_int(s1[r])));
      im = max(im, __shfl_xor(im, 32));
      constexpr int TBITS = 0x41200000;
      f32x16 e0, e1;
#pragma unroll
      for (int r = 0; r < 16; ++r) { e0[r] = ex2(s0[r]); e1[r] = ex2(s1[r]); }
      if (__any(im > TBITS)) {
        const float d = im > TBITS ? __int_as_float(im) : 0.f;
        const float a = ex2(-d);
#pragma unroll
        for (int r = 0; r < 16; ++r) { e0[r] = ex2(s0[r] - d); e1[r] = ex2(s1[r] - d); st.o[0][r] *= a; st.o[1][r] *= a; }
        st.l *= a; st.m += d;
#pragma unroll
        for (int r = 0; r < 16; ++r) st.mr[r] = -st.m;
      }
      float sum = 0.f;
#pragma unroll
      for (int r = 0; r < 16; ++r) { s0[r] = e0[r]; s1[r] = e1[r]; sum += e0[r] + e1[r]; }
      st.l += sum;
      const bf16_t* vr = Vs + l31 * 72 + half * 8;
#pragma unroll
      for (int c = 0; c < 4; ++c) {
        u32x4 pw;
        if (c < 2) pw = (u32x4){pk2(s0[8 * c + 0], s0[8 * c + 1]), pk2(s0[8 * c + 2], s0[8 * c + 3]), pk2(s0[8 * c + 4], s0[8 * c + 5]), pk2(s0[8 * c + 6], s0[8 * c + 7])};
        else pw = (u32x4){pk2(s1[8 * (c - 2) + 0], s1[8 * (c - 2) + 1]), pk2(s1[8 * (c - 2) + 2], s1[8 * (c - 2) + 3]), pk2(s1[8 * (c - 2) + 4], s1[8 * (c - 2) + 5]), pk2(s1[8 * (c - 2) + 6], s1[8 * (c - 2) + 7])};
        const bf16x8 pf = __builtin_bit_cast(bf16x8, pw);
        st.o[0] = mfma32(*(const bf16x8*)(vr + c * 16), pf, st.o[0]);
        st.o[1] = mfma32(*(const bf16x8*)(vr + 32 * 72 + c * 16), pf, st.o[1]);
      }
    }
  };
  u64 tm = tmask;
  if (tm == 0) return;
  auto pop = [&]() -> int { if (!tm) return -1; const int j = __builtin_ctzll(tm); tm &= tm - 1; return j; };
  int t0 = pop(), t1 = pop(), t2 = pop(), t3 = pop();
  gload(t0, S0{}); gload(t1 >= 0 ? t1 : t0, S1{});
  sstore(0, S0{}); sstore(1, S1{});
  gload(t2 >= 0 ? t2 : t0, S0{}); gload(t3 >= 0 ? t3 : t0, S1{});
  __syncthreads();
  int stg = 0;
  auto step = [&](auto setc) -> bool {
    const int t4 = pop();
    sstore(stg == 0 ? 2 : stg - 1, setc);
    gload(t4 >= 0 ? t4 : t0, setc);
    __builtin_amdgcn_sched_barrier(0);
    compute(t0, stg);
    __syncthreads();
    if (t1 < 0) return true;
    t0 = t1; t1 = t2; t2 = t3; t3 = t4; stg = stg == 2 ? 0 : stg + 1;
    return false;
  };
  for (;;) {
    if (step(S0{})) break;
    if (step(S1{})) break;
  }
}
DI void astate_init(AState& s) {
#pragma unroll
  for (int r = 0; r < 16; ++r) { s.o[0][r] = 0.f; s.o[1][r] = 0.f; }
#pragma unroll
  for (int r = 0; r < 16; ++r) s.mr[r] = 0.f;
  s.m = 0.f; s.l = 0.f;
}
DI u64 lowbits(int n) { return n >= 64 ? ~0ull : ((1ull << n) - 1ull); }

template <int MODE> DI void dense_attn_item(const Params& p, int b, int h, int qt, bf16_t* smem) {
  const int lane = TIDX() & 63, wid = TIDX() >> 6, l31 = lane & 31, half = lane >> 5;
  const int t0 = qt * 256, tq = t0 + wid * 32 + l31; const size_t trow = (size_t)b * S_ + tq;
  constexpr int NQ = ACfg<MODE>::DQK / 16;
  bf16x8 qf[NQ];
  const bf16_t* qp = MODE == M_FOX ? (const bf16_t*)(p.ws + O_FOXQ) + trow * 512 + h * 64 : (const bf16_t*)(p.ws + O_MLAQ) + trow * 768 + h * 96;
#pragma unroll
  for (int ks = 0; ks < NQ; ++ks) qf[ks] = *(const bf16x8*)(qp + ks * 16 + half * 8);
  AState st; astate_init(st);
  const u64 tmask = lowbits(4 * qt + 4), wmask = lowbits(((t0 + wid * 32 + 31) >> 6) + 1);
  if constexpr (MODE == M_FOX)
    flash_pass<M_FOX>(st, qf, tmask, wmask, (const bf16_t*)(p.ws + O_FOXK) + (size_t)b * S_ * 512 + h * 64, 512, nullptr,
                      (const bf16_t*)(p.ws + O_FOXVT) + (size_t)(b * 8 + h) * 64 * S_, (const float*)(p.ws + O_F2) + (size_t)(b * 8 + h) * S_, tq, 0ull, smem);
  else
    flash_pass<M_MLA>(st, qf, tmask, wmask, (const bf16_t*)(p.ws + O_MLAKN) + (size_t)b * S_ * 512 + h * 64, 512, (const bf16_t*)(p.ws + O_MLAKPE) + (size_t)b * S_ * 32,
                      (const bf16_t*)(p.ws + O_MLAVT) + (size_t)(b * 8 + h) * 64 * S_, nullptr, tq, 0ull, smem);
  const float l = st.l + __shfl_xor(st.l, 32), inv = 1.f / fmaxf(l, 1e-30f);
  bf16_t* op = (bf16_t*)qp;
#pragma unroll
  for (int dt = 0; dt < 2; ++dt)
#pragma unroll
    for (int g4 = 0; g4 < 4; ++g4) {
      const int d = dt * 32 + g4 * 8 + half * 4;
      *(u32x2*)(op + d) = (u32x2){pk2(st.o[dt][4 * g4] * inv, st.o[dt][4 * g4 + 1] * inv), pk2(st.o[dt][4 * g4 + 2] * inv, st.o[dt][4 * g4 + 3] * inv)};
    }
}
DI void nsa_attn_item(const Params& p, int b, int g, int qt, bf16_t* smem) {
  const int lane = TIDX() & 63, wid = TIDX() >> 6, l31 = lane & 31, half = lane >> 5;
  const int t0 = qt * 64, tw0 = t0 + (wid >> 2) * 32, tq = tw0 + l31, head = g * 4 + (wid & 3); const size_t trow = (size_t)b * S_ + tq;
  bf16x8 qf[4];
  const bf16_t* qp = (const bf16_t*)(p.ws + O_NSAQ) + trow * 512 + head * 64;
#pragma unroll
  for (int ks = 0; ks < 4; ++ks) qf[ks] = *(const bf16x8*)(qp + ks * 16 + half * 8);
  {
    const float* rp = (const float*)(p.ws + O_ROPE8) + trow * 16;
    u32x4 me = __builtin_bit_cast(u32x4, qf[0]), ot;
#pragma unroll
    for (int e = 0; e < 4; ++e) ot[e] = __shfl_xor(me[e], 32);
    unsigned res[4];
#pragma unroll
    for (int e = 0; e < 4; ++e) {
      float o2[2];
#pragma unroll
      for (int u = 0; u < 2; ++u) {
        const int f = 2 * e + u; const float cs = rp[2 * f], sn = rp[2 * f + 1];
        const float a = bf2f((bf16_t)(u ? me[e] >> 16 : me[e] & 0xffffu)), o = bf2f((bf16_t)(u ? ot[e] >> 16 : ot[e] & 0xffffu));
        o2[u] = half == 0 ? a * cs - o * sn : a * cs + o * sn;
      }
      res[e] = pk2(o2[0], o2[1]);
    }
    qf[0] = __builtin_bit_cast(bf16x8, (u32x4){res[0], res[1], res[2], res[3]});
  }
  const float* gts = (const float*)(p.ws + O_GATES) + trow * 24 + head * 3;
  const int cur = t0 >> 6;
  f32x16 res[2];
  {
    AState st; astate_init(st);
    const int first = t0 >= 511 ? (t0 - 511) >> 6 : 0, firstw = tw0 >= 511 ? (tw0 - 511) >> 6 : 0;
    const u64 tmask = lowbits(cur + 1) & ~lowbits(first), wmask = lowbits(cur + 1) & ~lowbits(firstw);
    flash_pass<M_WIN>(st, qf, tmask, wmask, (const bf16_t*)(p.ws + O_KWIN) + (size_t)b * S_ * 128 + g * 64, 128, nullptr,
                      (const bf16_t*)(p.ws + O_VWINT) + (size_t)(b * 2 + g) * 64 * S_, nullptr, tq, 0ull, smem);
    const float l = st.l + __shfl_xor(st.l, 32), sc = gts[2] / fmaxf(l, 1e-30f);
#pragma unroll
    for (int r = 0; r < 16; ++r) { res[0][r] = st.o[0][r] * sc; res[1][r] = st.o[1][r] * sc; }
  }
  {
    AState st; astate_init(st);
    const u64* selp = (const u64*)(p.ws + O_SEL) + (size_t)(b * 2 + g) * S_;
    const u64 mysel = selp[tq];
    const u64 m64 = selp[t0 + lane];
    unsigned lo = (unsigned)m64, hi = (unsigned)(m64 >> 32);
#pragma unroll
    for (int o = 32; o >= 1; o >>= 1) { lo |= __shfl_xor(lo, o); hi |= __shfl_xor(hi, o); }
    const u64 um = (((u64)(unsigned)__builtin_amdgcn_readfirstlane(hi) << 32) | (u64)(unsigned)__builtin_amdgcn_readfirstlane(lo)) & lowbits(cur + 1);
    flash_pass<M_SLC>(st, qf, um, um, (const bf16_t*)(p.ws + O_KSLC) + (size_t)b * S_ * 128 + g * 64, 128, nullptr,
                      (const bf16_t*)(p.ws + O_VSLCT) + (size_t)(b * 2 + g) * 64 * S_, nullptr, tq, mysel, smem);
    const float l = st.l + __shfl_xor(st.l, 32), sc = gts[1] / fmaxf(l, 1e-30f);
#pragma unroll
    for (int r = 0; r < 16; ++r) { res[0][r] += st.o[0][r] * sc; res[1][r] += st.o[1][r] * sc; }
  }
  bf16_t* op = (bf16_t*)(p.ws + O_ONSA) + trow * 512 + head * 64;
#pragma unroll
  for (int dt = 0; dt < 2; ++dt)
#pragma unroll
    for (int g4 = 0; g4 < 4; ++g4) {
      const int d = dt * 32 + g4 * 8 + half * 4;
      const u32x2 oc = *(const u32x2*)(op + d);
      const float c0 = bf2f((bf16_t)(oc[0] & 0xffffu)), c1 = bf2f((bf16_t)(oc[0] >> 16)), c2 = bf2f((bf16_t)(oc[1] & 0xffffu)), c3 = bf2f((bf16_t)(oc[1] >> 16));
      *(u32x2*)(op + d) = (u32x2){pk2(res[dt][4 * g4] + c0, res[dt][4 * g4 + 1] + c1), pk2(res[dt][4 * g4 + 2] + c2, res[dt][4 * g4 + 3] + c3)};
    }
}
constexpr int PD_ITEMS = 16 * 192;
DI void phase_d(const Params& p, unsigned char* smem) {
  for (int it = blockIdx.x; it < PD_ITEMS; it += gridDim.x) {
    const int r = it / 192, w = it % 192, qt = 15 - r;
    if (w < 64) dense_attn_item<M_MLA>(p, w >> 3, w & 7, qt, (bf16_t*)smem);
    else if (w < 128) dense_attn_item<M_FOX>(p, (w - 64) >> 3, (w - 64) & 7, qt, (bf16_t*)smem);
    else { const int i = w - 128, bg = i & 15, q4 = i >> 4; nsa_attn_item(p, bg >> 1, bg & 1, qt * 4 + q4, (bf16_t*)smem); }
  }
}

DI void merge_tile(const Params& p, int layer, int tm, int tn, bf16_t* smem) {
  typedef GemmLds<8, 2> L;
  const bf16_t* wl = (const bf16_t*)(p.ws + O_W) + (size_t)layer * W_LAYER;
  const int tid = TIDX(), lane = tid & 63, wid = tid >> 6, wm = wid >> 2, wn = wid & 3, l15 = lane & 15, quad = lane >> 4;
  f32x4 mg[8][2]; zero_acc<8, 2>(mg);
  f32x4 acc[8][2]; zero_acc<8, 2>(acc);
  unsigned* gsp = (unsigned*)((unsigned char*)smem + 2 * L::STAGE * 2) + tid;
  const bf16_t* la; const bf16_t* lb; unsigned lald, lbld; int laks, lnk;
  auto get_seg = [&](int sg) {
    const int br = sg >> 1;
    if ((sg & 1) == 0) { la = (const bf16_t*)(p.ws + O_XG) + (size_t)tm * 256 * D_; lald = D_; laks = 64; lb = wl + W_G + ((size_t)br * 1024 + tn * 128) * D_; lbld = D_; lnk = 16; }
    else {
      lald = br == 2 ? 768u : 512u; laks = br == 2 ? 96 : 64; lnk = 8; lbld = 512u;
      la = (const bf16_t*)(p.ws + (br == 0 ? O_ONSA : br == 1 ? O_FOXQ : O_MLAQ)) + (size_t)tm * 256 * lald;
      lb = wl + (br == 0 ? W_BN : br == 1 ? W_BF : W_BM) + (size_t)tn * 128 * 512;
    }
  };
  unsigned pa0, pb0; u32x4 ra[4], rb[2];
  auto set_offsets = [&]() { pa0 = (unsigned)(tid >> 3) * lald + (tid & 7) * 8; pb0 = (unsigned)(tid >> 3) * lbld + (tid & 7) * 8; };
  int ls = 0, lkt = 0;
  get_seg(0); set_offsets();
  auto gload_next = [&]() {
    const bf16_t* ab = la + (size_t)lkt * laks; const bf16_t* bb = lb + (size_t)lkt * 64;
#pragma unroll
    for (int i = 0; i < 4; ++i) ra[i] = *(const u32x4*)(ab + pa0 + (size_t)i * 64 * lald);
#pragma unroll
    for (int i = 0; i < 2; ++i) rb[i] = *(const u32x4*)(bb + pb0 + (size_t)i * 64 * lbld);
    if (++lkt == lnk) {
      if (ls + 1 < 6) { ++ls; lkt = 0; get_seg(ls); set_offsets(); } else lkt = lnk - 1;
    }
  };
  auto sstore = [&](int buf) {
    bf16_t* As = smem + buf * L::STAGE; bf16_t* Bs = As + L::A_ELEMS;
#pragma unroll
    for (int i = 0; i < 4; ++i) { const int c = tid + NTHR * i; *(u32x4*)(As + (c >> 3) * LDT + (c & 7) * 8) = ra[i]; }
#pragma unroll
    for (int i = 0; i < 2; ++i) { const int c = tid + NTHR * i; *(u32x4*)(Bs + (c >> 3) * LDT + (c & 7) * 8) = rb[i]; }
  };
  gload_next(); sstore(0); gload_next(); __syncthreads();
  int buf = 0;
#pragma unroll 1
  for (int sg = 0; sg < 6; ++sg) {
    const int nk = (sg & 1) ? 8 : 16;
#pragma unroll 1
    for (int kt = 0; kt < nk; ++kt) {
      sstore(buf ^ 1);
      gload_next();
      __builtin_amdgcn_sched_barrier(0);
      const bf16_t* As = smem + buf * L::STAGE + (wm * 128 + l15) * LDT + quad * 8;
      const bf16_t* Bs = smem + buf * L::STAGE + L::A_ELEMS + (wn * 32 + l15) * LDT + quad * 8;
#pragma unroll
      for (int ks = 0; ks < 2; ++ks) {
        if (ks == 1) asm volatile("" ::: "memory");
        bf16x8 b[2];
#pragma unroll
        for (int j = 0; j < 2; ++j) b[j] = *(const bf16x8*)(Bs + j * 16 * LDT + ks * 32);
#pragma unroll
        for (int i = 0; i < 8; ++i) {
          const bf16x8 a = *(const bf16x8*)(As + i * 16 * LDT + ks * 32);
#pragma unroll
          for (int j = 0; j < 2; ++j) acc[i][j] = mfma16(b[j], a, acc[i][j]);
        }
      }
      __syncthreads();
      buf ^= 1;
    }
    if ((sg & 1) == 0) {
      const int t2 = TIDX(), row0 = tm * 256 + ((t2 >> 8) & 1) * 128 + (t2 & 15);
#pragma unroll
      for (int i = 0; i < 8; ++i) {
        asm volatile("" ::: "memory");
        const float rs = rstd_from16((const float*)(p.ws + O_SSQ) + (size_t)(row0 + i * 16) * 16, 1.f / 1024.f);
#pragma unroll
        for (int j = 0; j < 2; ++j) {
          unsigned w = 0;
#pragma unroll
          for (int r = 0; r < 4; ++r) w |= (unsigned)__float2int_rn(sigmoidf_(acc[i][j][r] * rs) * 255.f) << (8 * r);
          gsp[(i * 2 + j) * NTHR] = w;
        }
      }
    } else {
#pragma unroll
      for (int i = 0; i < 8; ++i)
#pragma unroll
        for (int j = 0; j < 2; ++j) {
          asm volatile("" ::: "memory");
          const unsigned w = gsp[(i * 2 + j) * NTHR];
#pragma unroll
          for (int r = 0; r < 4; ++r) mg[i][j][r] += (float)((w >> (8 * r)) & 0xffu) * (1.f / 255.f) * acc[i][j][r];
        }
    }
    zero_acc<8, 2>(acc);
  }
  const int t3 = TIDX(), lane3 = t3 & 63, wid3 = t3 >> 6;
  bf16_t* stg = smem + wid3 * (128 * 40);
#pragma unroll
  for (int i = 0; i < 8; ++i)
#pragma unroll
    for (int j = 0; j < 2; ++j) *(u32x2*)(stg + (i * 16 + (lane3 & 15)) * 40 + j * 16 + (lane3 >> 4) * 4) = (u32x2){pk2(mg[i][j][0], mg[i][j][1]), pk2(mg[i][j][2], mg[i][j][3])};
  stage_out<128, 32, 40>(stg, (bf16_t*)(p.ws + O_MERGED) + (size_t)(tm * 256 + (wid3 >> 2) * 128) * D_ + tn * 128 + (wid3 & 3) * 32, (size_t)D_, lane3);
  __syncthreads();
}
DI void phase_e(const Params& p, int layer, unsigned char* smem) {
  xcd_tiles(16, 8, [&](int tm, int tn) { merge_tile(p, layer, tm, tn, (bf16_t*)smem); });
}

DI void resid_tile(const Params& p, const bf16_t* A, int K, const bf16_t* W, const float* xold, const float* gnext, int tm, int tn, bf16_t* smem) {
  f32x4 acc[8][4]; zero_acc<8, 4>(acc);
  RowPtr ap{A + (size_t)tm * 256 * K, (size_t)K}, bp{W + (size_t)tn * 256 * K, (size_t)K};
  gemm_main<8, 4, true>(acc, ap, 64, bp, 64, K / 64, smem);
  const int lane = TIDX() & 63, wid = TIDX() >> 6, wm = wid >> 2, wn = wid & 3, l15 = lane & 15, quad = lane >> 4;
  bf16_t* stg = smem + wid * STG_WAVE;
#pragma unroll
  for (int i = 0; i < 8; ++i) {
    const int t = tm * 256 + wm * 128 + i * 16 + l15, c0 = tn * 256 + wn * 64 + quad * 4; float s = 0.f;
#pragma unroll
    for (int j = 0; j < 4; ++j) {
      const size_t off = (size_t)t * D_ + c0 + j * 16;
      const f32x4 xn = *(const f32x4*)(xold + off) + acc[i][j];
      *(f32x4*)(p.out + off) = xn;
      s += xn[0] * xn[0] + xn[1] * xn[1] + xn[2] * xn[2] + xn[3] * xn[3];
      if (gnext) { const f32x4 gv = *(const f32x4*)(gnext + c0 + j * 16); *(u32x2*)(stg + (i * 16 + l15) * STG_LD + j * 16 + quad * 4) = (u32x2){pk2(xn[0] * gv[0], xn[1] * gv[1]), pk2(xn[2] * gv[2], xn[3] * gv[3])}; }
    }
    s += __shfl_xor(s, 16); s += __shfl_xor(s, 32);
    if (quad == 0) ((float*)(p.ws + O_SSQ))[(size_t)t * 16 + tn * 4 + wn] = s;
  }
  if (gnext) stage_out<128, 64, STG_LD>(stg, (bf16_t*)(p.ws + O_XG) + (size_t)(tm * 256 + wm * 128) * D_ + tn * 256 + wn * 64, (size_t)D_, lane);
  __syncthreads();
}
DI void phase_f(const Params& p, int layer, unsigned char* smem) {
  const bf16_t* wl = (const bf16_t*)(p.ws + O_W) + (size_t)layer * W_LAYER;
  xcd_tiles(16, 4, [&](int tm, int tn) { resid_tile(p, (const bf16_t*)(p.ws + O_MERGED), 1024, wl + W_OUT, layer == 0 ? p.x : p.out, p.ffn_norm + layer * D_, tm, tn, (bf16_t*)smem); });
}
DI void phase_h(const Params& p, int layer, unsigned char* smem) {
  const bf16_t* wl = (const bf16_t*)(p.ws + O_W) + (size_t)layer * W_LAYER;
  xcd_tiles(16, 4, [&](int tm, int tn) { resid_tile(p, (const bf16_t*)(p.ws + O_ACT), DFF_, wl + W_DN, p.out, layer == 0 ? p.mix_norm + D_ : nullptr, tm, tn, (bf16_t*)smem); });
}

struct UpRowPtr { const bf16_t* base; int s0;
  DI unsigned operator()(int r) const { const int s = s0 + r; return (unsigned)((s < 0 || s >= S_) ? 0 : s) * (unsigned)D_; }
  DI bool ok(int r) const { const int s = s0 + r; return s >= 0 && s < S_; } };
constexpr int PG_MT = 17;
DI void ffnup_tile(const Params& p, int layer, int b, int mt, int tn, bf16_t* smem) {
  const bf16_t* wl = (const bf16_t*)(p.ws + O_W) + (size_t)layer * W_LAYER;
  f32x4 acc[8][4]; zero_acc<8, 4>(acc);
  const int s0 = 254 * mt - 2;
  UpRowPtr ap{(const bf16_t*)(p.ws + O_XG) + (size_t)b * S_ * D_, s0}; RowPtr bp{wl + W_UP + (size_t)tn * 256 * D_, (size_t)D_};
  gemm_main<8, 4, true>(acc, ap, 64, bp, 64, 16, smem);
  const int tid = TIDX(), lane = tid & 63, wid = tid >> 6, wm = wid >> 2, wn = wid & 3, l15 = lane & 15, quad = lane >> 4;
  constexpr int LDU = 136; bf16_t* U = smem; bf16_t* V = smem + 256 * LDU;
  {
    bf16_t* dstb = (wn < 2 ? U : V) + (wn & 1) * 64 + quad * 4;
#pragma unroll
    for (int i = 0; i < 8; ++i) {
      const int row = wm * 128 + i * 16 + l15, s = s0 + row;
      const float rs = (s >= 0 && s < S_) ? rstd_from16((const float*)(p.ws + O_SSQ) + ((size_t)b * S_ + s) * 16, 1.f / 1024.f) : 0.f;
#pragma unroll
      for (int j = 0; j < 4; ++j) store4(dstb + row * LDU + j * 16, acc[i][j], rs);
    }
  }
  __syncthreads();
  {
    const int cc = tid & 15, cg0 = tn * 128 + cc * 8;
    const float* cw = p.conv_w + (size_t)layer * 3 * DFF_ + cg0; const float* cbp = p.conv_b + (size_t)layer * DFF_ + cg0;
    float w0[8], w1[8], w2[8], cb[8];
#pragma unroll
    for (int e = 0; e < 8; ++e) { w0[e] = cw[e]; w1[e] = cw[DFF_ + e]; w2[e] = cw[2 * DFF_ + e]; cb[e] = cbp[e]; }
    bf16_t* act = (bf16_t*)(p.ws + O_ACT);
#pragma unroll 2
    for (int it = 0; it < 8; ++it) {
      const int row = it * 32 + (tid >> 4), s = s0 + row;
      if (row >= 2 && s < S_) {
        const u32x4 u0 = *(const u32x4*)(U + (row - 2) * LDU + cc * 8), u1 = *(const u32x4*)(U + (row - 1) * LDU + cc * 8), u2 = *(const u32x4*)(U + row * LDU + cc * 8), vv = *(const u32x4*)(V + row * LDU + cc * 8);
        unsigned o[4];
#pragma unroll
        for (int e = 0; e < 4; ++e) {
          float r2[2];
#pragma unroll
          for (int h = 0; h < 2; ++h) {
            const int k = 2 * e + h;
            const float a0 = bf2f((bf16_t)(h ? u0[e] >> 16 : u0[e] & 0xffffu)), a1 = bf2f((bf16_t)(h ? u1[e] >> 16 : u1[e] & 0xffffu)), a2 = bf2f((bf16_t)(h ? u2[e] >> 16 : u2[e] & 0xffffu)), vx = bf2f((bf16_t)(h ? vv[e] >> 16 : vv[e] & 0xffffu));
            const float uc = w0[k] * a0 + w1[k] * a1 + w2[k] * a2 + cb[k];
            r2[h] = uc * sigmoidf_(uc) * vx;
          }
          o[e] = pk2(r2[0], r2[1]);
        }
        __builtin_nontemporal_store((u32x4){o[0], o[1], o[2], o[3]}, (u32x4*)(act + ((size_t)b * S_ + s) * DFF_ + cg0));
      }
    }
  }
  __syncthreads();
}
DI void phase_g(const Params& p, int layer, unsigned char* smem) {
  xcd_tiles(PG_MT, 22, [&](int tmg, int tn) { ffnup_tile(p, layer, tmg / PG_MT, tmg % PG_MT, tn, (bf16_t*)smem); });
}

DI void phase_final(const Params& p) {
  const int lane = TIDX() & 63, wid = TIDX() >> 6;
  for (int it = blockIdx.x; it < T_ / 8; it += gridDim.x) {
    const int t = it * 8 + wid; const float rs = rstd_from16((const float*)(p.ws + O_SSQ) + (size_t)t * 16, 1.f / 1024.f);
    float* xr = p.out + (size_t)t * D_;
#pragma unroll
    for (int c = 0; c < 4; ++c) { const int k = c * 256 + lane * 4; const f32x4 v = *(const f32x4*)(xr + k), gv = *(const f32x4*)(p.final_norm + k); *(f32x4*)(xr + k) = v * rs * gv; }
  }
}

#define XB_TMO      128
#define XB_XCNT(j)  (256  + 64 * (j))
#define XB_XSUB(j)  (1280 + 64 * (j))
#define XB_XGEN(j)  (2304 + 64 * (j))
#define XB_TOP      3328
#define XB_TOPGEN   3392
#define XCD_BAR_WORDS 3456
#define XB_SPIN_CAP (1u << 22)
#define LAS __attribute__((address_space(3)))
DI unsigned xb_ld(unsigned* p)              { return __hip_atomic_load(p, __ATOMIC_RELAXED, __HIP_MEMORY_SCOPE_AGENT); }
DI unsigned xb_add(unsigned* p, unsigned v) { return __hip_atomic_fetch_add(p, v, __ATOMIC_RELAXED, __HIP_MEMORY_SCOPE_AGENT); }
DI unsigned xb_xcc_id() { return (unsigned)__builtin_amdgcn_s_getreg((3 << 11) | 20) & 0xFu; }
#define XB_SPIN(cond, bar) do { unsigned _sp = 0; while (cond) { __builtin_amdgcn_s_sleep(1); \
    if ((++_sp & 255u) == 0u) { if (xb_ld(&(bar)[XB_TMO])) break; if (_sp > XB_SPIN_CAP) { atomicAdd(&(bar)[XB_TMO], 1u); break; } } } } while (0)
struct XcdBarrier { unsigned* bar; unsigned x; volatile LAS unsigned* st; };
DI XcdBarrier xcd_barrier_post(unsigned* bar, volatile LAS unsigned* st) {
  XcdBarrier b; b.bar = bar; b.x = xb_xcc_id(); b.st = st;
  if (threadIdx.x == 0) (void)xb_add(&bar[XB_XCNT(b.x)], 1u);
  return b;
}
DI void xcd_barrier_complete(unsigned* bar, unsigned x, unsigned& nloc, unsigned& nx) {
  const unsigned G = gridDim.x * gridDim.y * gridDim.z;
  unsigned sum, cnt, mine, sp = 0u;
  for (;;) {
    sum = 0u; cnt = 0u; mine = 0u;
#pragma unroll
    for (unsigned j = 0; j < 16; ++j) { const unsigned c = xb_ld(&bar[XB_XCNT(j)]); sum += c; cnt += (c > 0u) ? 1u : 0u; mine = (j == x) ? c : mine; }
    if (sum == G) break;
    __builtin_amdgcn_s_sleep(1);
    if ((++sp & 255u) == 0u) { if (xb_ld(&bar[XB_TMO])) break; if (sp > XB_SPIN_CAP) { atomicAdd(&bar[XB_TMO], 1u); break; } }
  }
  nloc = mine > 0u ? mine : 1u; nx = cnt > 0u ? cnt : 1u;
}
DI void xcd_barrier(const XcdBarrier& b) {
  asm volatile("s_waitcnt vmcnt(0)" ::: "memory");
  __syncthreads();
  if (threadIdx.x == 0) {
    unsigned* bar = b.bar;
    __builtin_amdgcn_s_waitcnt(0);
    unsigned nloc = b.st[0], nx = b.st[1];
    if (nloc == 0u) { xcd_barrier_complete(bar, b.x, nloc, nx); b.st[0] = nloc; b.st[1] = nx; }
    const unsigned old = xb_add(&bar[XB_XSUB(b.x)], 1u);
    const unsigned gen = old / nloc;
    if (old + 1u == (gen + 1u) * nloc) {
      __builtin_amdgcn_fence(__ATOMIC_RELEASE, "agent");
      asm volatile("s_waitcnt vmcnt(0)" ::: "memory");
      const unsigned og = xb_add(&bar[XB_TOP], 1u);
      const unsigned tg = og / nx;
      if (og + 1u == (tg + 1u) * nx) xb_add(&bar[XB_TOPGEN], 1u);
      else XB_SPIN(xb_ld(&bar[XB_TOPGEN]) == tg, bar);
      __builtin_amdgcn_fence(__ATOMIC_ACQUIRE, "agent");
      xb_add(&bar[XB_XGEN(b.x)], 1u);
      asm volatile("s_waitcnt vmcnt(0)" ::: "memory");
    } else {
      XB_SPIN(xb_ld(&bar[XB_XGEN(b.x)]) == gen, bar);
      __builtin_amdgcn_fence(__ATOMIC_ACQUIRE, "agent");
      asm volatile("s_waitcnt vmcnt(0)" ::: "memory");
    }
  }
  __syncthreads();
}
DI void run_phase(const Params& p, int ph, unsigned char* smem) {
  if (ph == 0) { phase_prep(p, smem); return; }
  if (ph == 17) { phase_final(p); return; }
  const int layer = (ph - 1) >> 3, s = (ph - 1) & 7;
#ifdef PROBE_DUP
  if ((PROBE_DUP >> s) & 1) {
    switch (s) { case 0: phase_inproj(p, layer, smem); break; case 1: phase_b(p, layer, smem); break; case 2: phase_c(p, smem); break; case 4: phase_e(p, layer, smem); break; case 6: phase_g(p, layer, smem); break; default: break; }
    __syncthreads();
  }
#endif
  switch (s) {
    case 0: phase_inproj(p, layer, smem); break;
    case 1: phase_b(p, layer, smem); break;
    case 2: phase_c(p, smem); break;
    case 3: phase_d(p, smem); break;
    case 4: phase_e(p, layer, smem); break;
    case 5: phase_f(p, layer, smem); break;
    case 6: phase_g(p, layer, smem); break;
    default: phase_h(p, layer, smem); break;
  }
}
constexpr int N_PHASES = 18;

#if ONE_LAUNCH
template <int PH> DI void run_all(const Params& p, unsigned char* smem, cg::grid_group& grid, const XcdBarrier& xb) {
  run_phase(p, PH, smem);
  if constexpr (PH + 1 < N_PHASES) {
    if constexpr (PH == 0) grid.sync(); else xcd_barrier(xb);
    run_all<PH + 1>(p, smem, grid, xb);
  }
}
__global__ void __launch_bounds__(NTHR, 2) mega_kernel(Params p) {
  __shared__ __attribute__((aligned(16))) unsigned char smem[SMEM_BYTES];
  __shared__ uint4 xb_words;
  if (threadIdx.x == 0) xb_words = make_uint4(0u, 0u, 0u, 0u);
  __syncthreads();
  const XcdBarrier xb = xcd_barrier_post((unsigned*)(p.ws + O_BAR), (volatile LAS unsigned*)&xb_words);
  cg::grid_group grid = cg::this_grid();
  run_all<0>(p, smem, grid, xb);
}
#else
template <int PH> __global__ void __launch_bounds__(NTHR, 2) phase_kernel(Params p) {
  __shared__ __attribute__((aligned(16))) unsigned char smem[SMEM_BYTES];
  run_phase(p, PH, smem);
}
template <int PH> static void launch_phases(const Params& p, hipStream_t stream) {
  hipLaunchKernelGGL((phase_kernel<PH>), dim3(256), dim3(NTHR), 0, stream, p);
  if constexpr (PH + 1 < N_PHASES) launch_phases<PH + 1>(p, stream);
}
#endif

extern "C" void kernel_launch(void* const* d_in, const int* in_sizes, int n_in, void* d_out, int out_size, void* d_ws, size_t ws_size, hipStream_t stream) {
  if (ws_size < O_END || n_in < 25) { fprintf(stderr, "workspace too small: %zu < %zu\n", ws_size, (size_t)O_END); return; }
  Params p{};
  p.x = (const float*)d_in[0]; p.pos = (const int*)d_in[1]; p.mix_norm = (const float*)d_in[2]; p.w_in = (const float*)d_in[3]; p.b_forget = (const float*)d_in[4];
  p.pe_k = (const float*)d_in[5]; p.w1_k = (const float*)d_in[6]; p.w2_k = (const float*)d_in[7]; p.pe_v = (const float*)d_in[8]; p.w1_v = (const float*)d_in[9]; p.w2_v = (const float*)d_in[10];
  p.q_norm = (const float*)d_in[11]; p.w_uq = (const float*)d_in[12]; p.kv_norm = (const float*)d_in[13]; p.w_ukv = (const float*)d_in[14];
  p.wbr_nsa = (const float*)d_in[15]; p.wbr_fox = (const float*)d_in[16]; p.wbr_mla = (const float*)d_in[17]; p.w_out = (const float*)d_in[18];
  p.ffn_norm = (const float*)d_in[19]; p.w_up = (const float*)d_in[20]; p.conv_w = (const float*)d_in[21]; p.conv_b = (const float*)d_in[22]; p.w_down = (const float*)d_in[23]; p.final_norm = (const float*)d_in[24];
  p.out = (float*)d_out; p.ws = (unsigned char*)d_ws;
#if ONE_LAUNCH
  static int grid_blocks = 0;
  if (!grid_blocks) {
    int dev = 0, cus = 0, per_cu = 0;
    hipGetDevice(&dev); hipDeviceGetAttribute(&cus, hipDeviceAttributeMultiprocessorCount, dev);
    hipOccupancyMaxActiveBlocksPerMultiprocessor(&per_cu, mega_kernel, NTHR, 0);
    if (per_cu > 1) per_cu = 1;
    grid_blocks = cus * per_cu;
  }
  hipMemsetAsync(p.ws + O_BAR, 0, XCD_BAR_WORDS * 4, stream);
  void* args[] = {&p};
  hipError_t e = hipLaunchCooperativeKernel((void*)mega_kernel, dim3(grid_blocks), dim3(NTHR), args, 0, stream);
  if (e != hipSuccess) fprintf(stderr, "cooperative launch failed: %s (grid %d)\n", hipGetErrorString(e), grid_blocks);
#else
  launch_phases<0>(p, stream);
#endif
}
```

```cpp
#include <hip/hip_runtime.h>
#include <hip/hip_cooperative_groups.h>
#include <stdint.h>
#include <stdio.h>
#include <type_traits>
namespace cg = cooperative_groups;

#ifndef ONE_LAUNCH
#define ONE_LAUNCH 1

#endif

#define DI __device__ __forceinline__
typedef unsigned short bf16_t;
typedef short bf16x8 __attribute__((ext_vector_type(8)));
typedef float f32x4 __attribute__((ext_vector_type(4)));
typedef float f32x16 __attribute__((ext_vector_type(16)));
typedef float f32x2 __attribute__((ext_vector_type(2)));
typedef __bf16 bfx2 __attribute__((ext_vector_type(2)));
typedef unsigned u32x4 __attribute__((ext_vector_type(4)));
typedef unsigned u32x2 __attribute__((ext_vector_type(2)));
typedef unsigned long long u64;

constexpr int T_ = 32768, S_ = 4096, NB_ = 8, D_ = 1024, DFF_ = 2816, NIN_ = 6592;
constexpr float EPS_ = 1e-6f;
constexpr float LOG2E_ = 1.4426950408889634f;
constexpr float QS64_ = 0.125f * LOG2E_;
constexpr float QS96_ = 0.10206207261596577f * LOG2E_;

constexpr size_t W_IN = 0;
constexpr size_t W_G = W_IN + (size_t)3584 * 1024;
constexpr size_t W_1K = W_G + (size_t)3072 * 1024;
constexpr size_t W_1V = W_1K + (size_t)256 * 2048;
constexpr size_t W_2K = W_1V + (size_t)256 * 2048;
constexpr size_t W_2V = W_2K + (size_t)64 * 256;
constexpr size_t W_UQ = W_2V + (size_t)64 * 256;
constexpr size_t W_UKV = W_UQ + (size_t)768 * 384;
constexpr size_t W_BN = W_UKV + (size_t)1024 * 256;
constexpr size_t W_BF = W_BN + (size_t)1024 * 512;
constexpr size_t W_BM = W_BF + (size_t)1024 * 512;
constexpr size_t W_OUT = W_BM + (size_t)1024 * 512;
constexpr size_t W_UP = W_OUT + (size_t)1024 * 1024;
constexpr size_t W_DN = W_UP + (size_t)5632 * 1024;
constexpr size_t W_LAYER = W_DN + (size_t)1024 * 2816;

constexpr size_t al256(size_t x) { return (x + 255) & ~(size_t)255; }
constexpr size_t O_BAR = 0;
constexpr size_t O_W = 16384;
constexpr size_t O_BIAS1 = al256(O_W + 2 * W_LAYER * 2);
constexpr size_t O_ROPE8 = al256(O_BIAS1 + 2 * 2 * 16 * 256 * 4);
constexpr size_t O_ROPE16 = al256(O_ROPE8 + (size_t)T_ * 16 * 4);
constexpr size_t O_XG = al256(O_ROPE16 + (size_t)T_ * 32 * 4);
constexpr size_t O_SSQ = al256(O_XG + (size_t)T_ * 1024 * 2);
constexpr size_t O_CSSQ = al256(O_SSQ + (size_t)T_ * 16 * 4);
constexpr size_t O_NSAQ = al256(O_CSSQ + (size_t)T_ * 16 * 4);
constexpr size_t O_KVCMP = O_NSAQ + (size_t)T_ * 512 * 2;
constexpr size_t O_KSLC = O_KVCMP + (size_t)T_ * 256 * 2;
constexpr size_t O_KWIN = O_KSLC + (size_t)T_ * 128 * 2;
constexpr size_t O_MERGED = O_NSAQ;
constexpr size_t O_VSLCT = O_KWIN + (size_t)T_ * 128 * 2;
constexpr size_t O_VWINT = O_VSLCT + (size_t)T_ * 128 * 2;
constexpr size_t O_FOXQ = O_VWINT + (size_t)T_ * 128 * 2;
constexpr size_t O_FOXK = O_FOXQ + (size_t)T_ * 512 * 2;
constexpr size_t O_FOXVT = O_FOXK + (size_t)T_ * 512 * 2;
constexpr size_t O_MLAQ = O_FOXVT + (size_t)T_ * 512 * 2;
constexpr size_t O_MLAKN = O_MLAQ + (size_t)T_ * 768 * 2;
constexpr size_t O_ACT = O_FOXQ;
constexpr size_t O_MLAVT = O_MLAKN + (size_t)T_ * 512 * 2;
constexpr size_t O_MLAKPE = O_MLAVT + (size_t)T_ * 512 * 2;
constexpr size_t O_ONSA = O_MLAKPE + (size_t)T_ * 32 * 2;
constexpr size_t O_CQ = O_ONSA;
constexpr size_t O_CKV = O_CQ + (size_t)T_ * 384 * 2;
constexpr size_t O_CEND = O_CKV + (size_t)T_ * 256 * 2;
constexpr size_t O_GATES = al256(O_CEND > O_ONSA + (size_t)T_ * 512 * 2 ? O_CEND : O_ONSA + (size_t)T_ * 512 * 2);
constexpr size_t O_LOGF = al256(O_GATES + (size_t)T_ * 24 * 4);
constexpr size_t O_F2 = al256(O_LOGF + (size_t)T_ * 8 * 4);
constexpr size_t O_KC = al256(O_F2 + (size_t)T_ * 8 * 4);
constexpr size_t O_VCT = al256(O_KC + (size_t)NB_ * 2 * 256 * 64 * 2);
constexpr size_t O_SEL = al256(O_VCT + (size_t)NB_ * 2 * 256 * 64 * 2);
constexpr size_t O_END = al256(O_SEL + (size_t)NB_ * 2 * S_ * 8);

struct Params {
  const float* x; const int* pos; const float* mix_norm; const float* w_in; const float* b_forget;
  const float* pe_k; const float* w1_k; const float* w2_k; const float* pe_v; const float* w1_v; const float* w2_v;
  const float* q_norm; const float* w_uq; const float* kv_norm; const float* w_ukv;
  const float* wbr_nsa; const float* wbr_fox; const float* wbr_mla; const float* w_out;
  const float* ffn_norm; const float* w_up; const float* conv_w; const float* conv_b; const float* w_down; const float* final_norm;
  float* out; unsigned char* ws;
};

constexpr int NTHR = 512;
constexpr int SMEM_BYTES = 147456;

DI int TIDX() { int t = (int)threadIdx.x; asm volatile("" : "+v"(t)); return t; }
DI unsigned pk2(float lo, float hi) { f32x2 v = {lo, hi}; return __builtin_bit_cast(unsigned, __builtin_convertvector(v, bfx2)); }
DI bf16_t f2bf(float x) { return (bf16_t)(pk2(x, 0.f) & 0xffffu); }
DI float bf2f(bf16_t h) { return __uint_as_float(((unsigned)h) << 16); }
DI float sigmoidf_(float x) { return 1.f / (1.f + __expf(-x)); }
DI float gelu_tanh(float x) { const float u = 0.7978845608028654f * (x + 0.044715f * x * x * x); return x / (1.f + __expf(-2.f * u)); }
DI float ex2(float x) { return __builtin_amdgcn_exp2f(x); }
DI f32x16 mfma32(bf16x8 a, bf16x8 b, f32x16 c) { return __builtin_amdgcn_mfma_f32_32x32x16_bf16(a, b, c, 0, 0, 0); }
DI f32x4 mfma16(bf16x8 a, bf16x8 b, f32x4 c) { return __builtin_amdgcn_mfma_f32_16x16x32_bf16(a, b, c, 0, 0, 0); }
DI float rstd_from16(const float* p, float inv_n) {
  const f32x4 a = *(const f32x4*)p, b = *(const f32x4*)(p + 4), c = *(const f32x4*)(p + 8), d = *(const f32x4*)(p + 12);
  const float s = ((a[0] + a[1]) + (a[2] + a[3])) + ((b[0] + b[1]) + (b[2] + b[3])) + ((c[0] + c[1]) + (c[2] + c[3])) + ((d[0] + d[1]) + (d[2] + d[3]));
  return rsqrtf(s * inv_n + EPS_);
}

constexpr int LDT = 72;
template <int MI, int NJ> struct GemmLds { static constexpr int BM = 32 * MI, BN = 64 * NJ, A_ELEMS = BM * LDT, B_ELEMS = BN * LDT, STAGE = A_ELEMS + B_ELEMS; };

template <int MI, int NJ, bool SWAP, class AP, class BP>
DI void gemm_main(f32x4 (&acc)[MI][NJ], const AP& ap, int a_kstep, const BP& bp, int b_kstep, int nk, bf16_t* smem) {
  typedef GemmLds<MI, NJ> L;
  constexpr int CA = MI / 2, CB = NJ;
  const int tid = TIDX(), lane = tid & 63, wid = tid >> 6, wm = wid >> 2, wn = wid & 3, l15 = lane & 15, quad = lane >> 4;
  unsigned pa[CA], pb[CB]; bool oka[CA];
#pragma unroll
  for (int i = 0; i < CA; ++i) { const int c = tid + NTHR * i; pa[i] = ap(c >> 3) + (c & 7) * 8; oka[i] = ap.ok(c >> 3); }
#pragma unroll
  for (int i = 0; i < CB; ++i) { const int c = tid + NTHR * i; pb[i] = bp(c >> 3) + (c & 7) * 8; }
  u32x4 ra[CA], rb[CB];
  auto gload = [&](int kt) {
    const bf16_t* ab = ap.base + (size_t)kt * a_kstep; const bf16_t* bb = bp.base + (size_t)kt * b_kstep;
#pragma unroll
    for (int i = 0; i < CA; ++i) ra[i] = *(const u32x4*)(ab + pa[i]);
#pragma unroll
    for (int i = 0; i < CB; ++i) rb[i] = *(const u32x4*)(bb + pb[i]);
  };
  auto sstore = [&](int buf) {
    bf16_t* As = smem + buf * L::STAGE; bf16_t* Bs = As + L::A_ELEMS;
#pragma unroll
    for (int i = 0; i < CA; ++i) { const int c = tid + NTHR * i; *(u32x4*)(As + (c >> 3) * LDT + (c & 7) * 8) = oka[i] ? ra[i] : (u32x4){0u, 0u, 0u, 0u}; }
#pragma unroll
    for (int i = 0; i < CB; ++i) { const int c = tid + NTHR * i; *(u32x4*)(Bs + (c >> 3) * LDT + (c & 7) * 8) = rb[i]; }
  };
  gload(0); sstore(0); gload(nk > 1 ? 1 : 0); __syncthreads();
#pragma unroll 1
  for (int kt = 0; kt < nk; ++kt) {
    const int buf = kt & 1;
    sstore(buf ^ 1);
    gload(kt + 2 < nk ? kt + 2 : nk - 1);
    __builtin_amdgcn_sched_barrier(0);
    const bf16_t* As = smem + buf * L::STAGE + (wm * 16 * MI + l15) * LDT + quad * 8;
    const bf16_t* Bs = smem + buf * L::STAGE + L::A_ELEMS + (wn * 16 * NJ + l15) * LDT + quad * 8;
#pragma unroll
    for (int ks = 0; ks < 2; ++ks) {
      if (MI * NJ >= 32 && ks == 1) asm volatile("" ::: "memory");
      bf16x8 b[NJ];
#pragma unroll
      for (int j = 0; j < NJ; ++j) b[j] = *(const bf16x8*)(Bs + j * 16 * LDT + ks * 32);
#pragma unroll
      for (int i = 0; i < MI; ++i) {
        const bf16x8 a = *(const bf16x8*)(As + i * 16 * LDT + ks * 32);
#pragma unroll
        for (int j = 0; j < NJ; ++j) acc[i][j] = SWAP ? mfma16(b[j], a, acc[i][j]) : mfma16(a, b[j], acc[i][j]);
      }
    }
    __syncthreads();
  }
}
template <int MI, int NJ> DI void zero_acc(f32x4 (&acc)[MI][NJ]) {
#pragma unroll
  for (int i = 0; i < MI; ++i)
#pragma unroll
    for (int j = 0; j < NJ; ++j) acc[i][j] = (f32x4){0.f, 0.f, 0.f, 0.f};
}
struct RowPtr { const bf16_t* base; size_t ld; DI unsigned operator()(int r) const { return (unsigned)r * (unsigned)ld; } DI bool ok(int) const { return true; } };


template <class F> DI void xcd_tiles(int MPX, int NT, F&& body) {
  const int xcd = blockIdx.x & 7, slot = blockIdx.x >> 3, nslots = gridDim.x >> 3, total = MPX * NT;
  for (int li = slot; li < total; li += nslots) {
    const int mg = li / (8 * NT), rem = li - mg * 8 * NT;
    const int gsz = (MPX - mg * 8) < 8 ? (MPX - mg * 8) : 8;
    const int tn = rem / gsz, mi = rem - tn * gsz;
    body(xcd * MPX + mg * 8 + mi, tn);
  }
}

DI int map_col(int map, int n) {
  if (map == 0) return n;
  if (map == 1) {
    if (n < 896) return n;
    if (n < 1024) return 1024 + (n - 896);
    if (n < 1152) return 896 + (n - 1024);
    if (n < 1280) return n;
    if (n < 2816) return 1304 + (n - 1280);
    if (n < 3200) return 2848 + (n - 2816);
    if (n < 3456) return 3232 + (n - 3200);
    const int c = n - 3456;
    if (c < 24) return 1280 + c;
    if (c < 32) return 2840 + (c - 24);
    if (c < 64) return 3488 + (c - 32);
    return -1;
  }
  if (map == 2) { const int j = n >> 8, c = n & 255; return c < 128 ? j * 128 + c : DFF_ + j * 128 + (c - 128); }
  if (map == 3) { return n < 512 ? (n >> 6) * 128 + (n & 63) : ((n - 512) >> 6) * 128 + 64 + ((n - 512) & 63); }
  return n;
}
struct WJob { const float* src; const float* scale; bf16_t* dst; int K, N, ld, map, off; };
DI void prep_weight_tile(const WJob& j, int tile, float* lds) {
  const int ntn = j.N >> 6, tk = tile / ntn, tn = tile % ntn, tid = TIDX();
  const int n4 = (tid & 15) * 4; const int sc = map_col(j.map, tn * 64 + n4);
  f32x4 v[4];
#pragma unroll
  for (int i = 0; i < 4; ++i) {
    const int kk = (tid >> 4) + 32 * i, k = tk * 128 + kk;
    v[i] = sc >= 0 ? *(const f32x4*)(j.src + (size_t)k * j.ld + j.off + sc) : (f32x4){0.f, 0.f, 0.f, 0.f};
    if (j.scale) v[i] = v[i] * j.scale[k];
  }
#pragma unroll
  for (int i = 0; i < 4; ++i) {
    const int kk = (tid >> 4) + 32 * i;
#pragma unroll
    for (int e = 0; e < 4; ++e) lds[kk * 65 + n4 + e] = v[i][e];
  }
  __syncthreads();
  const int nn = tid >> 3, k0 = (tid & 7) * 16;
  unsigned w[8];
#pragma unroll
  for (int e = 0; e < 8; ++e) w[e] = pk2(lds[(k0 + 2 * e) * 65 + nn], lds[(k0 + 2 * e + 1) * 65 + nn]);
  bf16_t* d = j.dst + (size_t)(tn * 64 + nn) * j.K + tk * 128 + k0;
  *(u32x4*)d = (u32x4){w[0], w[1], w[2], w[3]}; *(u32x4*)(d + 8) = (u32x4){w[4], w[5], w[6], w[7]};
  __syncthreads();
}
DI WJob get_wjob(const Params& p, int layer, int id) {
  bf16_t* wl = (bf16_t*)(p.ws + O_W) + (size_t)layer * W_LAYER; WJob j; j.scale = nullptr; j.map = 0; j.off = 0;
  switch (id) {
    case 0: j.src = p.w_in + (size_t)layer * 1024 * NIN_; j.dst = wl + W_IN; j.K = 1024; j.N = 3584; j.ld = NIN_; j.map = 1; break;
    case 1: j.src = p.w_in + (size_t)layer * 1024 * NIN_; j.dst = wl + W_G; j.K = 1024; j.N = 3072; j.ld = NIN_; j.off = 3520; break;
    case 2: j.src = p.w1_k + (size_t)layer * 2048 * 256; j.dst = wl + W_1K; j.K = 2048; j.N = 256; j.ld = 256; break;
    case 3: j.src = p.w1_v + (size_t)layer * 2048 * 256; j.dst = wl + W_1V; j.K = 2048; j.N = 256; j.ld = 256; break;
    case 4: j.src = p.w2_k + (size_t)layer * 256 * 64; j.dst = wl + W_2K; j.K = 256; j.N = 64; j.ld = 64; break;
    case 5: j.src = p.w2_v + (size_t)layer * 256 * 64; j.dst = wl + W_2V; j.K = 256; j.N = 64; j.ld = 64; break;
    case 6: j.src = p.w_uq + (size_t)layer * 384 * 768; j.dst = wl + W_UQ; j.K = 384; j.N = 768; j.ld = 768; j.scale = p.q_norm + layer * 384; break;
    case 7: j.src = p.w_ukv + (size_t)layer * 256 * 1024; j.dst = wl + W_UKV; j.K = 256; j.N = 1024; j.ld = 1024; j.scale = p.kv_norm + layer * 256; j.map = 3; break;
    case 8: j.src = p.wbr_nsa + (size_t)layer * 512 * 1024; j.dst = wl + W_BN; j.K = 512; j.N = 1024; j.ld = 1024; break;
    case 9: j.src = p.wbr_fox + (size_t)layer * 512 * 1024; j.dst = wl + W_BF; j.K = 512; j.N = 1024; j.ld = 1024; break;
    case 10: j.src = p.wbr_mla + (size_t)layer * 512 * 1024; j.dst = wl + W_BM; j.K = 512; j.N = 1024; j.ld = 1024; break;
    case 11: j.src = p.w_out + (size_t)layer * 1024 * 1024; j.dst = wl + W_OUT; j.K = 1024; j.N = 1024; j.ld = 1024; break;
    case 12: j.src = p.w_up + (size_t)layer * 1024 * 5632; j.dst = wl + W_UP; j.K = 1024; j.N = 5632; j.ld = 5632; j.map = 2; break;
    default: j.src = p.w_down + (size_t)layer * 2816 * 1024; j.dst = wl + W_DN; j.K = 2816; j.N = 1024; j.ld = 1024; break;
  }
  return j;
}
constexpr int WTILES_LAYER = (int)(W_LAYER / 8192);
constexpr int P0_XITEMS = T_ / 64;
constexpr int P0_ROPE_ITEMS = T_ / NTHR;
constexpr int P0_ITEMS = 2 * WTILES_LAYER + 64 + P0_ROPE_ITEMS + P0_XITEMS;

DI void xg_rows(const float* x, const float* g, bf16_t* xg, float* ssq, int row0) {
  const int lane = TIDX() & 63, wid = TIDX() >> 6;
  for (int rr = 0; rr < 8; ++rr) {
    const int t = row0 + wid * 8 + rr; const float* xr = x + (size_t)t * D_; float s = 0.f;
#pragma unroll
    for (int c = 0; c < 4; ++c) {
      const int k = c * 256 + lane * 4; const f32x4 v = *(const f32x4*)(xr + k), gv = *(const f32x4*)(g + k);
      s += v[0] * v[0] + v[1] * v[1] + v[2] * v[2] + v[3] * v[3];
      *(u32x2*)(xg + (size_t)t * D_ + k) = (u32x2){pk2(v[0] * gv[0], v[1] * gv[1]), pk2(v[2] * gv[2], v[3] * gv[3])};
    }
#pragma unroll
    for (int o = 32; o >= 1; o >>= 1) s += __shfl_xor(s, o);
    if (lane < 16) ssq[(size_t)t * 16 + lane] = lane == 0 ? s : 0.f;
  }
}
DI void phase_prep(const Params& p, unsigned char* smem) {
  for (int it = blockIdx.x; it < P0_ITEMS; it += gridDim.x) {
    int i = it;
    if (i < 2 * WTILES_LAYER) {
      const int layer = i / WTILES_LAYER; int t = i % WTILES_LAYER; int id = 0;
      for (;; ++id) { const WJob j = get_wjob(p, layer, id); const int nt = (j.K >> 7) * (j.N >> 6); if (t < nt) { prep_weight_tile(j, t, (float*)smem); break; } t -= nt; }
      continue;
    }
    i -= 2 * WTILES_LAYER;
    if (i < 64) {
      const int lk = i >> 4, pc = i & 15, layer = lk >> 1, kv = lk & 1, c = TIDX() & 255, hf = TIDX() >> 8;
      const float* pe = (kv ? p.pe_v : p.pe_k) + (size_t)layer * 2048 + pc * 128 + hf * 64; const float* w1 = (kv ? p.w1_v : p.w1_k) + (size_t)layer * 2048 * 256 + (size_t)(pc * 128 + hf * 64) * 256;
      float sacc = 0.f;
#pragma unroll 8
      for (int kk = 0; kk < 64; ++kk) sacc += pe[kk] * w1[(size_t)kk * 256 + c];
      float* lds = (float*)smem;
      if (hf) lds[c] = sacc;
      __syncthreads();
      if (!hf) ((float*)(p.ws + O_BIAS1))[(lk * 16 + pc) * 256 + c] = sacc + lds[c];
      __syncthreads();
      continue;
    }
    i -= 64;
    if (i < P0_ROPE_ITEMS) {
      const int t = i * NTHR + TIDX(); const float fp = (float)p.pos[t];
      float* r8 = (float*)(p.ws + O_ROPE8) + (size_t)t * 16; float* r16 = (float*)(p.ws + O_ROPE16) + (size_t)t * 32;
      for (int f = 0; f < 24; ++f) {
        const int half = f < 8 ? 8 : 16, idx = f < 8 ? f : f - 8;
        const float inv = exp2f(-(float)idx / (float)half * 18.931568569324174f);
        const float ang = fp * inv;
        const double rev = (double)ang * 0.15915494309189535; const float fr = (float)(rev - floor(rev));
        const float sn = __builtin_amdgcn_sinf(fr), cs = __builtin_amdgcn_cosf(fr);
        if (f < 8) { r8[2 * idx] = cs; r8[2 * idx + 1] = sn; } else { r16[2 * idx] = cs; r16[2 * idx + 1] = sn; }
      }
      continue;
    }
    i -= P0_ROPE_ITEMS;
    xg_rows(p.x, p.mix_norm, (bf16_t*)(p.ws + O_XG), (float*)(p.ws + O_SSQ), i * 64);
  }
}

DI void store4(bf16_t* dst, const f32x4& v, float s) { *(u32x2*)dst = (u32x2){pk2(v[0] * s, v[1] * s), pk2(v[2] * s, v[3] * s)}; }
constexpr int STG_LD = 72, STG_WAVE = 128 * 72;
DI void stage4(bf16_t* stg, int row, int col, const f32x4& v, float s) { *(u32x2*)(stg + row * STG_LD + col) = (u32x2){pk2(v[0] * s, v[1] * s), pk2(v[2] * s, v[3] * s)}; }
template <int ROWS, int COLS, int LD> DI void stage_out(const bf16_t* stg, bf16_t* dst, size_t ld, int lane) {
  asm volatile("s_waitcnt lgkmcnt(0)" ::: "memory");
  constexpr int CPR = COLS / 8, IT = ROWS * CPR / 64;
#pragma unroll
  for (int it = 0; it < IT; ++it) {
    const int idx = it * 64 + lane, r = idx / CPR, c = idx % CPR;
    __builtin_nontemporal_store(*(const u32x4*)(stg + r * LD + c * 8), (u32x4*)(dst + (size_t)r * ld + c * 8));
  }
}
template <bool SWAP> DI void inproj_tile(const Params& p, int layer, int tm, int tn, bf16_t* smem) {
  const bf16_t* wl = (const bf16_t*)(p.ws + O_W) + (size_t)layer * W_LAYER;
  f32x4 acc[8][4]; zero_acc<8, 4>(acc);
  RowPtr ap{(const bf16_t*)(p.ws + O_XG) + (size_t)tm * 256 * D_, (size_t)D_}, bp{wl + W_IN + (size_t)tn * 256 * D_, (size_t)D_};
  gemm_main<8, 4, SWAP>(acc, ap, 64, bp, 64, 16, smem);
  const int lane = TIDX() & 63, wid = TIDX() >> 6, wm = wid >> 2, wn = wid & 3, l15 = lane & 15, quad = lane >> 4;
  const float* ssq = (const float*)(p.ws + O_SSQ);
  bf16_t* stg = smem + wid * STG_WAVE;
  const int trow0 = tm * 256 + wm * 128;
  if constexpr (!SWAP) {
    bf16_t* dst; int hh, hd;
    if (tn == 4) { dst = (bf16_t*)(p.ws + (wn < 2 ? O_VSLCT : O_VWINT)); hh = 2; hd = wn & 1; } else { dst = (bf16_t*)(p.ws + O_FOXVT); hh = 8; hd = (tn - 9) * 4 + wn; }
    constexpr int VLD = 136;
#pragma unroll
    for (int i = 0; i < 8; ++i) {
      const int t0 = trow0 + i * 16 + quad * 4;
      float rs[4];
#pragma unroll
      for (int r = 0; r < 4; ++r) rs[r] = rstd_from16(ssq + (size_t)(t0 + r) * 16, 1.f / 1024.f);
#pragma unroll
      for (int j = 0; j < 4; ++j)
        *(u32x2*)(stg + (j * 16 + l15) * VLD + i * 16 + quad * 4) = (u32x2){pk2(acc[i][j][0] * rs[0], acc[i][j][1] * rs[1]), pk2(acc[i][j][2] * rs[2], acc[i][j][3] * rs[3])};
    }
    const int b = trow0 >> 12, s0 = trow0 & 4095;
    stage_out<64, 128, VLD>(stg, dst + ((size_t)(b * hh + hd) * 64) * S_ + s0, (size_t)S_, lane);
  } else {
    const int slab = tn * 4 + wn;
    if (slab == 54) {
#pragma unroll
      for (int i = 0; i < 8; ++i) {
        const int t = trow0 + i * 16 + l15; const float rs = rstd_from16(ssq + (size_t)t * 16, 1.f / 1024.f);
        float* gt = (float*)(p.ws + O_GATES) + (size_t)t * 24; float* lf = (float*)(p.ws + O_LOGF) + (size_t)t * 8;
#pragma unroll
        for (int r = 0; r < 4; ++r) gt[quad * 4 + r] = sigmoidf_(acc[i][0][r] * rs);
        if (quad < 2) {
#pragma unroll
          for (int r = 0; r < 4; ++r) gt[16 + quad * 4 + r] = sigmoidf_(acc[i][1][r] * rs);
        } else {
#pragma unroll
          for (int r = 0; r < 4; ++r) { const int h = (quad - 2) * 4 + r; const float xx = acc[i][1][r] * rs + p.b_forget[layer * 8 + h]; lf[h] = fminf(xx, 0.f) - log1pf(__expf(-fabsf(xx))); }
        }
        const float* rp = (const float*)(p.ws + O_ROPE16) + (size_t)t * 32 + quad * 8; float o1[4], o2[4];
#pragma unroll
        for (int r = 0; r < 4; ++r) { const float cs = rp[2 * r], sn = rp[2 * r + 1], x1 = acc[i][2][r] * rs, x2 = acc[i][3][r] * rs; o1[r] = x1 * cs - x2 * sn; o2[r] = x2 * cs + x1 * sn; }
        bf16_t* kp = (bf16_t*)(p.ws + O_MLAKPE) + (size_t)t * 32 + quad * 4;
        *(u32x2*)kp = (u32x2){pk2(o1[0], o1[1]), pk2(o1[2], o1[3])}; *(u32x2*)(kp + 16) = (u32x2){pk2(o2[0], o2[1]), pk2(o2[2], o2[3])};
      }
    } else if (slab != 55) {
      bf16_t* dbuf; int dld, dcol, kind = 0; float qs = 1.f; int cslot = 0;
      if (slab < 8) { dbuf = (bf16_t*)(p.ws + O_NSAQ); dld = 512; dcol = slab * 64; qs = QS64_; }
      else if (slab < 12) { dbuf = (bf16_t*)(p.ws + O_KVCMP); dld = 256; dcol = (slab - 8) * 64; }
      else if (slab < 16) { dbuf = (bf16_t*)(p.ws + (slab < 14 ? O_KSLC : O_KWIN)); dld = 128; dcol = (slab & 1) * 64; kind = 1; }
      else if (slab < 28) { dbuf = (bf16_t*)(p.ws + O_FOXQ); dld = 512; dcol = (slab - 20) * 64; qs = QS64_; }
      else if (slab < 36) { dbuf = (bf16_t*)(p.ws + O_FOXK); dld = 512; dcol = (slab - 28) * 64; }
      else if (slab < 50) { dbuf = (bf16_t*)(p.ws + O_CQ); dld = 384; dcol = (slab - 44) * 64; kind = 2; cslot = slab - 44; }
      else { dbuf = (bf16_t*)(p.ws + O_CKV); dld = 256; dcol = (slab - 50) * 64; kind = 2; cslot = 8 + slab - 50; }
#pragma unroll
      for (int i = 0; i < 8; ++i) {
        const int row = i * 16 + l15, t = trow0 + row; const float rs = rstd_from16(ssq + (size_t)t * 16, 1.f / 1024.f) * qs;
        if (kind == 1) {
          const float* rp = (const float*)(p.ws + O_ROPE8) + (size_t)t * 16 + (quad & 1) * 8;
          f32x4 v, o;
#pragma unroll
          for (int r = 0; r < 4; ++r) { v[r] = acc[i][0][r] * rs; o[r] = __shfl_xor(v[r], 32); }
#pragma unroll
          for (int r = 0; r < 4; ++r) { const float cs = rp[2 * r], sn = rp[2 * r + 1]; v[r] = quad < 2 ? v[r] * cs - o[r] * sn : v[r] * cs + o[r] * sn; }
          stage4(stg, row, quad * 4, v, 1.f);
        } else stage4(stg, row, quad * 4, acc[i][0], rs);
#pragma unroll
        for (int j = 1; j < 4; ++j) stage4(stg, row, j * 16 + quad * 4, acc[i][j], rs);
        if (kind == 2) {
          float s = 0.f;
#pragma unroll
          for (int j = 0; j < 4; ++j) { const f32x4 a = acc[i][j] * rs; s += a[0] * a[0] + a[1] * a[1] + a[2] * a[2] + a[3] * a[3]; }
          s += __shfl_xor(s, 16); s += __shfl_xor(s, 32);
          if (quad == 0) ((float*)(p.ws + O_CSSQ))[(size_t)t * 16 + cslot] = s;
        }
      }
      stage_out<128, 64, STG_LD>(stg, dbuf + (size_t)trow0 * dld + dcol, (size_t)dld, lane);
    }
  }
  __syncthreads();
}
DI void phase_inproj(const Params& p, int layer, unsigned char* smem) {
  xcd_tiles(16, 14, [&](int tm, int tn) {
    const bool vt = (tn == 4 || tn == 9 || tn == 10);
    if (vt) inproj_tile<false>(p, layer, tm, tn, (bf16_t*)smem); else inproj_tile<true>(p, layer, tm, tn, (bf16_t*)smem);
  });
}

template <int KIND> DI void mlaup_tile(const Params& p, int layer, int tm, int tn, bf16_t* smem) {
  const bf16_t* wl = (const bf16_t*)(p.ws + O_W) + (size_t)layer * W_LAYER;
  f32x4 acc[8][4]; zero_acc<8, 4>(acc);
  constexpr int K = KIND == 0 ? 384 : 256;
  RowPtr ap{KIND == 0 ? (const bf16_t*)(p.ws + O_CQ) + (size_t)tm * 256 * 384 : (const bf16_t*)(p.ws + O_CKV) + (size_t)tm * 256 * 256, (size_t)K};
  RowPtr bp{KIND == 0 ? wl + W_UQ + (size_t)tn * 256 * 384 : wl + W_UKV + (size_t)(tn - 3) * 256 * 256, (size_t)K};
  gemm_main<8, 4, KIND != 2>(acc, ap, 64, bp, 64, K / 64, smem);
  const int lane = TIDX() & 63, wid = TIDX() >> 6, wm = wid >> 2, wn = wid & 3, l15 = lane & 15, quad = lane >> 4;
  const float* cssq = (const float*)(p.ws + O_CSSQ);
  bf16_t* stg = smem + wid * STG_WAVE; const int trow0 = tm * 256 + wm * 128;
  if constexpr (KIND == 2) {
    bf16_t* dst = (bf16_t*)(p.ws + O_MLAVT); const int h = (tn - 5) * 4 + wn;
    constexpr int VLD = 136;
#pragma unroll
    for (int i = 0; i < 8; ++i) {
      asm volatile("" ::: "memory");
      const int t0 = trow0 + i * 16 + quad * 4; float rs[4];
#pragma unroll
      for (int r = 0; r < 4; ++r) { const float* c = cssq + (size_t)(t0 + r) * 16 + 8; rs[r] = rsqrtf((c[0] + c[1] + c[2] + c[3]) * (1.f / 256.f) + EPS_); }
#pragma unroll
      for (int j = 0; j < 4; ++j)
        *(u32x2*)(stg + (j * 16 + l15) * VLD + i * 16 + quad * 4) = (u32x2){pk2(acc[i][j][0] * rs[0], acc[i][j][1] * rs[1]), pk2(acc[i][j][2] * rs[2], acc[i][j][3] * rs[3])};
    }
    stage_out<64, 128, VLD>(stg, dst + ((size_t)((trow0 >> 12) * 8 + h) * 64) * S_ + (trow0 & 4095), (size_t)S_, lane);
  } else if constexpr (KIND == 1) {
#pragma unroll
    for (int i = 0; i < 8; ++i) {
      asm volatile("" ::: "memory");
      const int row = i * 16 + l15, t = trow0 + row; const float* c = cssq + (size_t)t * 16;
      const float rs = rsqrtf((c[8] + c[9] + c[10] + c[11]) * (1.f / 256.f) + EPS_);
#pragma unroll
      for (int j = 0; j < 4; ++j) stage4(stg, row, j * 16 + quad * 4, acc[i][j], rs);
    }
    stage_out<128, 64, STG_LD>(stg, (bf16_t*)(p.ws + O_MLAKN) + (size_t)trow0 * 512 + (tn - 3) * 256 + wn * 64, (size_t)512, lane);
  } else {
    const int n0 = tn * 256 + wn * 64, ph = n0 % 96;
#pragma unroll
    for (int i = 0; i < 8; ++i) {
      asm volatile("" ::: "memory");
      const int row = i * 16 + l15, t = trow0 + row; const float* c = cssq + (size_t)t * 16;
      const float rs = rsqrtf((c[0] + c[1] + c[2] + c[3] + c[4] + c[5]) * (1.f / 384.f) + EPS_) * QS96_;
      f32x4 v0 = acc[i][0] * rs, v1 = acc[i][1] * rs, v2 = acc[i][2] * rs, v3 = acc[i][3] * rs;
      if (ph != 0) {
        const float* rp = (const float*)(p.ws + O_ROPE16) + (size_t)t * 32 + quad * 8;
        const f32x4 x1 = ph == 64 ? v0 : v2, x2 = ph == 64 ? v1 : v3; f32x4 o1, o2;
#pragma unroll
        for (int r = 0; r < 4; ++r) { const float cs = rp[2 * r], sn = rp[2 * r + 1]; o1[r] = x1[r] * cs - x2[r] * sn; o2[r] = x2[r] * cs + x1[r] * sn; }
        if (ph == 64) { v0 = o1; v1 = o2; } else { v2 = o1; v3 = o2; }
      }
      stage4(stg, row, quad * 4, v0, 1.f); stage4(stg, row, 16 + quad * 4, v1, 1.f); stage4(stg, row, 32 + quad * 4, v2, 1.f); stage4(stg, row, 48 + quad * 4, v3, 1.f);
    }
    stage_out<128, 64, STG_LD>(stg, (bf16_t*)(p.ws + O_MLAQ) + (size_t)trow0 * 768 + n0, (size_t)768, lane);
  }
  __syncthreads();
}
struct CmpRowPtr { const bf16_t* base; int r0;
  DI unsigned operator()(int r) const { int R = r0 + r; if (R >= 4080) R = 0; const int b = R / 510, rem = R - b * 510, n = rem >> 1, g = rem & 1; return (unsigned)(b * S_ + 16 * n) * 256u + g * 64; }
  DI bool ok(int r) const { return r0 + r < 4080; } };
DI void compress_item(const Params& p, int layer, int item, bf16_t* smem) {
  const int kv = item >> 5, tm = item & 31;
  const bf16_t* wl = (const bf16_t*)(p.ws + O_W) + (size_t)layer * W_LAYER;
  f32x4 acc[4][4]; zero_acc<4, 4>(acc);
  CmpRowPtr ap{(const bf16_t*)(p.ws + O_KVCMP) + kv * 128, tm * 128};
  RowPtr bp{wl + (kv ? W_1V : W_1K), (size_t)2048};
  gemm_main<4, 4, true>(acc, ap, 256, bp, 64, 32, smem);
  const int lane = TIDX() & 63, wid = TIDX() >> 6, wm = wid >> 2, wn = wid & 3, l15 = lane & 15, quad = lane >> 4;
  constexpr int LDH = 264; bf16_t* H = smem;
  const float* b1 = (const float*)(p.ws + O_BIAS1) + (size_t)(layer * 2 + kv) * 16 * 256;
#pragma unroll
  for (int j = 0; j < 4; ++j) {
    asm volatile("" ::: "memory");
    f32x4 bv = {0.f, 0.f, 0.f, 0.f};
    for (int pc = 0; pc < 16; ++pc) bv += *(const f32x4*)(b1 + pc * 256 + wn * 64 + j * 16 + quad * 4);
#pragma unroll
    for (int i = 0; i < 4; ++i) {
      const int row = wm * 64 + i * 16 + l15, col = wn * 64 + j * 16 + quad * 4;
      *(u32x2*)(H + row * LDH + col) = (u32x2){pk2(gelu_tanh(acc[i][j][0] + bv[0]), gelu_tanh(acc[i][j][1] + bv[1])), pk2(gelu_tanh(acc[i][j][2] + bv[2]), gelu_tanh(acc[i][j][3] + bv[3]))};
    }
  }
  __syncthreads();
  f32x4 a2[4];
#pragma unroll
  for (int j = 0; j < 4; ++j) a2[j] = (f32x4){0.f, 0.f, 0.f, 0.f};
  const bf16_t* w2 = wl + (kv ? W_2V : W_2K);
#pragma unroll
  for (int ks = 0; ks < 8; ++ks) {
    const bf16x8 a = *(const bf16x8*)(H + (wid * 16 + l15) * LDH + ks * 32 + quad * 8);
#pragma unroll
    for (int j = 0; j < 4; ++j) a2[j] = mfma16(a, *(const bf16x8*)(w2 + (size_t)(j * 16 + l15) * 256 + ks * 32 + quad * 8), a2[j]);
  }
  bf16_t* kc = (bf16_t*)(p.ws + O_KC); bf16_t* vct = (bf16_t*)(p.ws + O_VCT);
#pragma unroll
  for (int r = 0; r < 4; ++r) {
    const int R = tm * 128 + wid * 16 + quad * 4 + r;
    if (R < 4080) {
      const int b = R / 510, rem = R - b * 510, n = rem >> 1, g = rem & 1;
#pragma unroll
      for (int j = 0; j < 4; ++j) {
        const int d = j * 16 + l15; const bf16_t v = f2bf(a2[j][r]);
        if (kv == 0) kc[((size_t)(b * 2 + g) * 256 + n) * 64 + d] = v; else vct[((size_t)(b * 2 + g) * 64 + d) * 256 + n] = v;
      }
    }
  }
  __syncthreads();
}
DI void foxscan_item(const Params& p, int item, float* lds) {
  const int b = item >> 3, h = item & 7, tid = TIDX();
  const float* lf = (const float*)(p.ws + O_LOGF) + (size_t)b * S_ * 8 + h; float v[8]; float s = 0.f;
#pragma unroll
  for (int i = 0; i < 8; ++i) { s += lf[(size_t)(tid * 8 + i) * 8]; v[i] = s; }
  lds[tid] = s; __syncthreads();
  float off = 0.f;
  for (int i = 0; i < tid; ++i) off += lds[i];
  float* F2 = (float*)(p.ws + O_F2) + (size_t)(b * 8 + h) * S_ + tid * 8;
#pragma unroll
  for (int i = 0; i < 8; ++i) F2[i] = -(off + v[i]) * LOG2E_;
  __syncthreads();
}
DI void phase_b(const Params& p, int layer, unsigned char* smem) {
  if (blockIdx.x < 64) { compress_item(p, layer, blockIdx.x, (bf16_t*)smem); return; }
  for (int it = blockIdx.x - 64; it < 64; it += gridDim.x - 64) foxscan_item(p, it, (float*)smem);
  {
    const int xcd = blockIdx.x & 7, slot = (blockIdx.x >> 3) - 8, nslots = (gridDim.x >> 3) - 8;
    for (int li = slot; li < 16 * 7; li += nslots) {
      const int mg = li / 56, rem = li - mg * 56, tn = rem >> 3, tm = xcd * 16 + mg * 8 + (rem & 7);
      if (tn >= 5) mlaup_tile<2>(p, layer, tm, tn, (bf16_t*)smem); else if (tn >= 3) mlaup_tile<1>(p, layer, tm, tn, (bf16_t*)smem); else mlaup_tile<0>(p, layer, tm, tn, (bf16_t*)smem);
    }
  }
}

constexpr int KC_LD = 72, VC_LD = 264;
DI void cmp_item(const Params& p, int item, unsigned char* smem_) {
  const int b = item >> 6, g = (item >> 5) & 1, tt = item & 31, t0 = tt * 128;
  const int tid = TIDX(), lane = tid & 63, wid = tid >> 6, l15 = lane & 15, quad = lane >> 4;
  bf16_t* kcs = (bf16_t*)smem_;
  bf16_t* vcs = kcs + 256 * KC_LD;
  float* imps = (float*)smem_;
  const int nmax = (t0 + 96) >> 4;
  const int nsub = (nmax >> 4) + 1;
  {
    const bf16_t* kcg = (const bf16_t*)(p.ws + O_KC) + (size_t)(b * 2 + g) * 256 * 64; const bf16_t* vcg = (const bf16_t*)(p.ws + O_VCT) + (size_t)(b * 2 + g) * 64 * 256;
    const int nrows = ((nsub + 1) & ~1) * 16;
    for (int e = tid; e < nrows * 8; e += NTHR) {
      const int n = e >> 3, dc = (e & 7) * 8;
      *(u32x4*)(kcs + n * KC_LD + dc) = n < 255 ? *(const u32x4*)(kcg + (size_t)n * 64 + dc) : (u32x4){0u, 0u, 0u, 0u};
    }
    const int ncs = nrows >> 3;
    for (int e = tid; e < 64 * ncs; e += NTHR) {
      const int d = e / ncs, nc = (e - d * ncs) * 8;
      u32x4 v = *(const u32x4*)(vcg + (size_t)d * 256 + nc);
      if (nc + 8 > 255) v[3] &= 0x0000ffffu;
      *(u32x4*)(vcs + d * VC_LD + nc) = v;
    }
  }
  __syncthreads();
  const int tq = t0 + wid * 16 + l15;
  const size_t trow = (size_t)b * S_ + tq;
  float impa[16], p3a[16];
#pragma unroll
  for (int s = 0; s < 16; ++s) { impa[s] = 0.f; p3a[s] = 0.f; }
  const float* gts = (const float*)(p.ws + O_GATES) + trow * 24;
#pragma unroll 1
  for (int r4 = 0; r4 < 4; ++r4) {
    const int head = g * 4 + r4;
    const bf16_t* qp = (const bf16_t*)(p.ws + O_NSAQ) + trow * 512 + head * 64 + quad * 8;
    const bf16x8 q0 = *(const bf16x8*)qp, q1 = *(const bf16x8*)(qp + 32);
    auto score = [&](int s) -> f32x4 {
      const bf16_t* kr = kcs + (s * 16 + l15) * KC_LD + quad * 8;
      f32x4 a = {0.f, 0.f, 0.f, 0.f};
      a = mfma16(*(const bf16x8*)kr, q0, a); a = mfma16(*(const bf16x8*)(kr + 32), q1, a);
#pragma unroll
      for (int r = 0; r < 4; ++r) { const int n = s * 16 + quad * 4 + r; a[r] = (16 * n + 31 <= tq) ? a[r] : -INFINITY; }
      return a;
    };
    float mx = -INFINITY;
#pragma unroll 1
    for (int s = 0; s < nsub; ++s) { const f32x4 a = score(s); mx = fmaxf(mx, fmaxf(fmaxf(a[0], a[1]), fmaxf(a[2], a[3]))); }
    mx = fmaxf(mx, __shfl_xor(mx, 16)); mx = fmaxf(mx, __shfl_xor(mx, 32));
    if (mx == -INFINITY) mx = 0.f;
    float sum = 0.f;
#pragma unroll 1
    for (int s = 0; s < nsub; ++s) { const f32x4 a = score(s); sum += (ex2(a[0] - mx) + ex2(a[1] - mx)) + (ex2(a[2] - mx) + ex2(a[3] - mx)); }
    sum += __shfl_xor(sum, 16); sum += __shfl_xor(sum, 32);
    const float inv = 1.f / fmaxf(sum, 1e-30f);
    f32x4 oacc[4];
#pragma unroll
    for (int j = 0; j < 4; ++j) oacc[j] = (f32x4){0.f, 0.f, 0.f, 0.f};
#pragma unroll
    for (int c = 0; c < 8; ++c) {
      asm volatile("" ::: "memory");
      if (2 * c < nsub) {
        f32x4 pa = score(2 * c), pb = {-INFINITY, -INFINITY, -INFINITY, -INFINITY};
        if (2 * c + 1 < nsub) pb = score(2 * c + 1);
#pragma unroll
        for (int r = 0; r < 4; ++r) { pa[r] = ex2(pa[r] - mx) * inv; pb[r] = ex2(pb[r] - mx) * inv; }
        impa[2 * c] += pa[0] + pa[1] + pa[2] + 0.5f * pa[3]; p3a[2 * c] += pa[3];
        impa[2 * c + 1] += pb[0] + pb[1] + pb[2] + 0.5f * pb[3]; p3a[2 * c + 1] += pb[3];
        const u32x4 pw = {pk2(pa[0], pa[1]), pk2(pa[2], pa[3]), pk2(pb[0], pb[1]), pk2(pb[2], pb[3])};
        const bf16x8 pf = __builtin_bit_cast(bf16x8, pw);
#pragma unroll
        for (int j = 0; j < 4; ++j) {
          const bf16_t* vr = vcs + (j * 16 + l15) * VC_LD + c * 32 + quad * 4;
          const u32x2 lo = *(const u32x2*)vr, hi = *(const u32x2*)(vr + 16);
          const u32x4 vw = {lo[0], lo[1], hi[0], hi[1]};
          oacc[j] = mfma16(__builtin_bit_cast(bf16x8, vw), pf, oacc[j]);
        }
      }
    }
    const float g0 = gts[head * 3 + 0];
    bf16_t* op = (bf16_t*)(p.ws + O_ONSA) + trow * 512 + head * 64 + quad * 4;
#pragma unroll
    for (int j = 0; j < 4; ++j) store4(op + j * 16, oacc[j], g0);
  }
  __syncthreads();
  float* myimp = imps + wid * 1024 + l15 * 64;
  const int cur = tq >> 6;
#pragma unroll
  for (int s = 0; s < 16; ++s) {
    const float up = __shfl(p3a[s], (lane + 48) & 63);
    const float up0 = s ? __shfl(p3a[s ? s - 1 : 0], (lane + 48) & 63) : 0.f;
    const float prev = quad ? up : up0;
    float v = impa[s] + 0.5f * prev;
    const int j = 4 * s + quad;
    if (j == 0 || j == cur || j == cur - 1) v = 1e9f; else if (j > cur) v = -1e9f;
    myimp[j] = v;
  }
  __syncthreads();
  u64* sel = (u64*)(p.ws + O_SEL) + (size_t)(b * 2 + g) * S_ + t0 + wid * 16;
#pragma unroll 1
  for (int q = 0; q < 16; ++q) {
    const float mine = imps[wid * 1024 + q * 64 + lane]; int rank = 0;
#pragma unroll
    for (int i = 0; i < 64; ++i) { const float v = __uint_as_float(__builtin_amdgcn_readlane(__float_as_uint(mine), i)); rank += (v > mine || (v == mine && i < lane)) ? 1 : 0; }
    const u64 m = __ballot(rank < 16);
    if (lane == 0) sel[q] = m;
  }
  __syncthreads();
}
constexpr int PC_ITEMS = NB_ * 2 * 32;
DI void phase_c(const Params& p, unsigned char* smem) {
  for (int it = blockIdx.x; it < PC_ITEMS; it += gridDim.x) cmp_item(p, ((it / (int)gridDim.x) & 1) ? ((it & ~31) | (31 - (it & 31))) : it, smem);
}

enum { M_FOX = 0, M_MLA = 1, M_WIN = 2, M_SLC = 3 };
template <int MODE> struct ACfg { static constexpr int DQK = MODE == M_MLA ? 96 : 64, KLD = DQK + 8, NKC = DQK / 8 * 64, KCH = (NKC + NTHR - 1) / NTHR, K_ELEMS = 64 * KLD, V_ELEMS = 64 * 72, STAGE = K_ELEMS + V_ELEMS + 128; };
struct AState { f32x16 o[2]; f32x16 mr; float m, l; };

template <int MODE>
DI void flash_pass(AState& st, const bf16x8* qf, u64 tmask, u64 wmask,
                   const bf16_t* kbase, size_t kld, const bf16_t* kpe, const bf16_t* vtbase, const float* fbias,
                   int tq, u64 mysel, bf16_t* smem) {
  typedef ACfg<MODE> C;
  typedef std::integral_constant<int, 0> S0; typedef std::integral_constant<int, 1> S1;
  const int tid = TIDX(), lane = tid & 63, l31 = lane & 31, half = lane >> 5;
  u32x4 rk[2][C::KCH], rv[2]; float rf[2] = {0.f, 0.f};
  auto gload = [&](int j, auto setc) {
    constexpr int S = decltype(setc)::value;
    const int k0 = j * 64;
#pragma unroll
    for (int i = 0; i < C::KCH; ++i) {
      const int c0 = tid + NTHR * i, c = c0 < C::NKC ? c0 : C::NKC - 1;
      if constexpr (MODE == M_MLA) {
        const int key = c / 12, dc = c % 12;
        const bf16_t* src = dc < 8 ? kbase + (size_t)(k0 + key) * kld + dc * 8 : kpe + (size_t)(k0 + key) * 32 + (dc - 8) * 8;
        rk[S][i] = *(const u32x4*)src;
      } else { const int key = c >> 3, dc = c & 7; rk[S][i] = *(const u32x4*)(kbase + (size_t)(k0 + key) * kld + dc * 8); }
    }
    { const int d = tid >> 3, kc = tid & 7; rv[S] = *(const u32x4*)(vtbase + (size_t)d * S_ + k0 + kc * 8); }
    if constexpr (MODE == M_FOX) rf[S] = fbias[k0 + (tid & 63)];
  };
  auto sstore = [&](int stg, auto setc) {
    constexpr int S = decltype(setc)::value;
    bf16_t* Ks = smem + stg * C::STAGE; bf16_t* Vs = Ks + C::K_ELEMS;
#pragma unroll
    for (int i = 0; i < C::KCH; ++i) {
      const int c = tid + NTHR * i;
      if (c < C::NKC) {
        if constexpr (MODE == M_MLA) { const int key = c / 12, dc = c % 12; *(u32x4*)(Ks + key * C::KLD + dc * 8) = rk[S][i]; }
        else { const int key = c >> 3, dc = c & 7; *(u32x4*)(Ks + key * C::KLD + dc * 8) = rk[S][i]; }
      }
    }
    {
      const int d = tid >> 3, kc = tid & 7, cgp = kc >> 1, a = kc & 1;
      bf16_t* dst = Vs + d * 72 + cgp * 16 + 4 * a;
      *(u32x2*)dst = (u32x2){rv[S][0], rv[S][1]}; *(u32x2*)(dst + 8) = (u32x2){rv[S][2], rv[S][3]};
    }
    if constexpr (MODE == M_FOX) { if (tid < 64) ((float*)(Vs + C::V_ELEMS))[tid] = rf[S]; }
  };
  const int tmin = __builtin_amdgcn_readfirstlane(tq - l31), tmax = tmin + 31;
  auto compute = [&](int j, int stg) {
    bool active = (wmask >> j) & 1;
    if constexpr (MODE == M_SLC) active = active && __any((mysel >> j) & 1);
    if (active) {
      const bf16_t* Ks = smem + stg * C::STAGE; const bf16_t* Vs = Ks + C::K_ELEMS;
      f32x16 s0 = st.mr, s1 = st.mr;
      const bf16_t* kr = Ks + l31 * C::KLD + half * 8;
#pragma unroll
      for (int ks = 0; ks < C::DQK / 16; ++ks) {
        s0 = mfma32(*(const bf16x8*)(kr + ks * 16), qf[ks], s0);
        s1 = mfma32(*(const bf16x8*)(kr + 32 * C::KLD + ks * 16), qf[ks], s1);
      }
      const int k0 = j * 64;
      if constexpr (MODE == M_FOX) {
        const float* fb = (const float*)(Vs + C::V_ELEMS) + 4 * half;
#pragma unroll
        for (int g4 = 0; g4 < 4; ++g4) {
          const f32x4 b0 = *(const f32x4*)(fb + 8 * g4), b1 = *(const f32x4*)(fb + 32 + 8 * g4);
#pragma unroll
          for (int r = 0; r < 4; ++r) { s0[4 * g4 + r] += b0[r]; s1[4 * g4 + r] += b1[r]; }
        }
      }
      bool need = k0 + 63 > tmin;
      if constexpr (MODE == M_WIN) need = need || (k0 <= tmax - 512);
      if constexpr (MODE == M_SLC) {
        if (!need) {
          const bool rsel = ((mysel >> j) & 1) != 0;
          if (!__all(rsel)) {
#pragma unroll
            for (int r = 0; r < 16; ++r) { s0[r] = rsel ? s0[r] : -INFINITY; s1[r] = rsel ? s1[r] : -INFINITY; }
          }
        }
      }
      if (need) {
        const bool rowok = MODE == M_SLC ? ((mysel >> j) & 1) != 0 : true;
#pragma unroll
        for (int r = 0; r < 16; ++r) {
          const int key = k0 + (r & 3) + 8 * (r >> 2) + 4 * half;
          bool ok0 = rowok && key <= tq, ok1 = rowok && key + 32 <= tq;
          if constexpr (MODE == M_WIN) { ok0 = ok0 && (tq - key < 512); ok1 = ok1 && (tq - key - 32 < 512); }
          s0[r] = ok0 ? s0[r] : -INFINITY; s1[r] = ok1 ? s1[r] : -INFINITY;
        }
      }
      int im = (int)0x80000000;
#pragma unroll
      for (int r = 0; r < 16; ++r) im = max(im, max(__float_as_int(s0[r]), __float_as_int(s1[r])));
      im = max(im, __shfl_xor(im, 32));
      constexpr int TBITS = 0x41200000;
      f32x16 e0, e1;
#pragma unroll
      for (int r = 0; r < 16; ++r) { e0[r] = ex2(s0[r]); e1[r] = ex2(s1[r]); }
      if (__any(im > TBITS)) {
        const float d = im > TBITS ? __int_as_float(im) : 0.f;
        const float a = ex2(-d);
#pragma unroll
        for (int r = 0; r < 16; ++r) { e0[r] = ex2(s0[r] - d); e1[r] = ex2(s1[r] - d); st.o[0][r] *= a; st.o[1][r] *= a; }
        st.l *= a; st.m += d;
#pragma unroll
        for (int r = 0; r < 16; ++r) st.mr[r] = -st.m;
      }
      float sum = 0.f;
#pragma unroll
      for (int r = 0; r < 16; ++r) { s0[r] = e0[r]; s1[r] = e1[r]; sum += e0[r] + e1[r]; }
      st.l += sum;
      const bf16_t* vr = Vs + l31 * 72 + half * 8;
#pragma unroll
      for (int c = 0; c < 4; ++c) {
        u32x4 pw;
        if (c < 2) pw = (u32x4){pk2(s0[8 * c + 0], s0[8 * c + 1]), pk2(s0[8 * c + 2], s0[8 * c + 3]), pk2(s0[8 * c + 4], s0[8 * c + 5]), pk2(s0[8 * c + 6], s0[8 * c + 7])};
        else pw = (u32x4){pk2(s1[8 * (c - 2) + 0], s1[8 * (c - 2) + 1]), pk2(s1[8 * (c - 2) + 2], s1[8 * (c - 2) + 3]), pk2(s1[8 * (c - 2) + 4], s1[8 * (c - 2) + 5]), pk2(s1[8 * (c - 2) + 6], s1[8 * (c - 2) + 7])};
        const bf16x8 pf = __builtin_bit_cast(bf16x8, pw);
        st.o[0] = mfma32(*(const bf16x8*)(vr + c * 16), pf, st.o[0]);
        st.o[1] = mfma32(*(const bf16x8*)(vr + 32 * 72 + c * 16), pf, st.o[1]);
      }
    }
  };
  u64 tm = tmask;
  if (tm == 0) return;
  auto pop = [&]() -> int { if (!tm) return -1; const int j = __builtin_ctzll(tm); tm &= tm - 1; return j; };
  int t0 = pop(), t1 = pop(), t2 = pop(), t3 = pop();
  gload(t0, S0{}); gload(t1 >= 0 ? t1 : t0, S1{});
  sstore(0, S0{}); sstore(1, S1{});
  gload(t2 >= 0 ? t2 : t0, S0{}); gload(t3 >= 0 ? t3 : t0, S1{});
  __syncthreads();
  int stg = 0;
  auto step = [&](auto setc) -> bool {
    const int t4 = pop();
    sstore(stg == 0 ? 2 : stg - 1, setc);
    gload(t4 >= 0 ? t4 : t0, setc);
    __builtin_amdgcn_sched_barrier(0);
    compute(t0, stg);
    __syncthreads();
    if (t1 < 0) return true;
    t0 = t1; t1 = t2; t2 = t3; t3 = t4; stg = stg == 2 ? 0 : stg + 1;
    return false;
  };
  for (;;) {
    if (step(S0{})) break;
    if (step(S1{})) break;
  }
}
DI void astate_init(AState& s) {
#pragma unroll
  for (int r = 0; r < 16; ++r) { s.o[0][r] = 0.f; s.o[1][r] = 0.f; }
#pragma unroll
  for (int r = 0; r < 16; ++r) s.mr[r] = 0.f;
  s.m = 0.f; s.l = 0.f;
}
DI u64 lowbits(int n) { return n >= 64 ? ~0ull : ((1ull << n) - 1ull); }

template <int MODE> DI void dense_attn_item(const Params& p, int b, int h, int qt, bf16_t* smem) {
  const int lane = TIDX() & 63, wid = TIDX() >> 6, l31 = lane & 31, half = lane >> 5;
  const int t0 = qt * 256, tq = t0 + wid * 32 + l31; const size_t trow = (size_t)b * S_ + tq;
  constexpr int NQ = ACfg<MODE>::DQK / 16;
  bf16x8 qf[NQ];
  const bf16_t* qp = MODE == M_FOX ? (const bf16_t*)(p.ws + O_FOXQ) + trow * 512 + h * 64 : (const bf16_t*)(p.ws + O_MLAQ) + trow * 768 + h * 96;
#pragma unroll
  for (int ks = 0; ks < NQ; ++ks) qf[ks] = *(const bf16x8*)(qp + ks * 16 + half * 8);
  AState st; astate_init(st);
  const u64 tmask = lowbits(4 * qt + 4), wmask = lowbits(((t0 + wid * 32 + 31) >> 6) + 1);
  if constexpr (MODE == M_FOX)
    flash_pass<M_FOX>(st, qf, tmask, wmask, (const bf16_t*)(p.ws + O_FOXK) + (size_t)b * S_ * 512 + h * 64, 512, nullptr,
                      (const bf16_t*)(p.ws + O_FOXVT) + (size_t)(b * 8 + h) * 64 * S_, (const float*)(p.ws + O_F2) + (size_t)(b * 8 + h) * S_, tq, 0ull, smem);
  else
    flash_pass<M_MLA>(st, qf, tmask, wmask, (const bf16_t*)(p.ws + O_MLAKN) + (size_t)b * S_ * 512 + h * 64, 512, (const bf16_t*)(p.ws + O_MLAKPE) + (size_t)b * S_ * 32,
                      (const bf16_t*)(p.ws + O_MLAVT) + (size_t)(b * 8 + h) * 64 * S_, nullptr, tq, 0ull, smem);
  const float l = st.l + __shfl_xor(st.l, 32), inv = 1.f / fmaxf(l, 1e-30f);
  bf16_t* op = (bf16_t*)qp;
#pragma unroll
  for (int dt = 0; dt < 2; ++dt)
#pragma unroll
    for (int g4 = 0; g4 < 4; ++g4) {
      const int d = dt * 32 + g4 * 8 + half * 4;
      *(u32x2*)(op + d) = (u32x2){pk2(st.o[dt][4 * g4] * inv, st.o[dt][4 * g4 + 1] * inv), pk2(st.o[dt][4 * g4 + 2] * inv, st.o[dt][4 * g4 + 3] * inv)};
    }
}
DI void nsa_attn_item(const Params& p, int b, int g, int qt, bf16_t* smem) {
  const int lane = TIDX() & 63, wid = TIDX() >> 6, l31 = lane & 31, half = lane >> 5;
  const int t0 = qt * 64, tw0 = t0 + (wid >> 2) * 32, tq = tw0 + l31, head = g * 4 + (wid & 3); const size_t trow = (size_t)b * S_ + tq;
  bf16x8 qf[4];
  const bf16_t* qp = (const bf16_t*)(p.ws + O_NSAQ) + trow * 512 + head * 64;
#pragma unroll
  for (int ks = 0; ks < 4; ++ks) qf[ks] = *(const bf16x8*)(qp + ks * 16 + half * 8);
  {
    const float* rp = (const float*)(p.ws + O_ROPE8) + trow * 16;
    u32x4 me = __builtin_bit_cast(u32x4, qf[0]), ot;
#pragma unroll
    for (int e = 0; e < 4; ++e) ot[e] = __shfl_xor(me[e], 32);
    unsigned res[4];
#pragma unroll
    for (int e = 0; e < 4; ++e) {
      float o2[2];
#pragma unroll
      for (int u = 0; u < 2; ++u) {
        const int f = 2 * e + u; const float cs = rp[2 * f], sn = rp[2 * f + 1];
        const float a = bf2f((bf16_t)(u ? me[e] >> 16 : me[e] & 0xffffu)), o = bf2f((bf16_t)(u ? ot[e] >> 16 : ot[e] & 0xffffu));
        o2[u] = half == 0 ? a * cs - o * sn : a * cs + o * sn;
      }
      res[e] = pk2(o2[0], o2[1]);
    }
    qf[0] = __builtin_bit_cast(bf16x8, (u32x4){res[0], res[1], res[2], res[3]});
  }
  const float* gts = (const float*)(p.ws + O_GATES) + trow * 24 + head * 3;
  const int cur = t0 >> 6;
  f32x16 res[2];
  {
    AState st; astate_init(st);
    const int first = t0 >= 511 ? (t0 - 511) >> 6 : 0, firstw = tw0 >= 511 ? (tw0 - 511) >> 6 : 0;
    const u64 tmask = lowbits(cur + 1) & ~lowbits(first), wmask = lowbits(cur + 1) & ~lowbits(firstw);
    flash_pass<M_WIN>(st, qf, tmask, wmask, (const bf16_t*)(p.ws + O_KWIN) + (size_t)b * S_ * 128 + g * 64, 128, nullptr,
                      (const bf16_t*)(p.ws + O_VWINT) + (size_t)(b * 2 + g) * 64 * S_, nullptr, tq, 0ull, smem);
    const float l = st.l + __shfl_xor(st.l, 32), sc = gts[2] / fmaxf(l, 1e-30f);
#pragma unroll
    for (int r = 0; r < 16; ++r) { res[0][r] = st.o[0][r] * sc; res[1][r] = st.o[1][r] * sc; }
  }
  {
    AState st; astate_init(st);
    const u64* selp = (const u64*)(p.ws + O_SEL) + (size_t)(b * 2 + g) * S_;
    const u64 mysel = selp[tq];
    const u64 m64 = selp[t0 + lane];
    unsigned lo = (unsigned)m64, hi = (unsigned)(m64 >> 32);
#pragma unroll
    for (int o = 32; o >= 1; o >>= 1) { lo |= __shfl_xor(lo, o); hi |= __shfl_xor(hi, o); }
    const u64 um = (((u64)(unsigned)__builtin_amdgcn_readfirstlane(hi) << 32) | (u64)(unsigned)__builtin_amdgcn_readfirstlane(lo)) & lowbits(cur + 1);
    flash_pass<M_SLC>(st, qf, um, um, (const bf16_t*)(p.ws + O_KSLC) + (size_t)b * S_ * 128 + g * 64, 128, nullptr,
                      (const bf16_t*)(p.ws + O_VSLCT) + (size_t)(b * 2 + g) * 64 * S_, nullptr, tq, mysel, smem);
    const float l = st.l + __shfl_xor(st.l, 32), sc = gts[1] / fmaxf(l, 1e-30f);
#pragma unroll
    for (int r = 0; r < 16; ++r) { res[0][r] += st.o[0][r] * sc; res[1][r] += st.o[1][r] * sc; }
  }
  bf16_t* op = (bf16_t*)(p.ws + O_ONSA) + trow * 512 + head * 64;
#pragma unroll
  for (int dt = 0; dt < 2; ++dt)
#pragma unroll
    for (int g4 = 0; g4 < 4; ++g4) {
      const int d = dt * 32 + g4 * 8 + half * 4;
      const u32x2 oc = *(const u32x2*)(op + d);
      const float c0 = bf2f((bf16_t)(oc[0] & 0xffffu)), c1 = bf2f((bf16_t)(oc[0] >> 16)), c2 = bf2f((bf16_t)(oc[1] & 0xffffu)), c3 = bf2f((bf16_t)(oc[1] >> 16));
      *(u32x2*)(op + d) = (u32x2){pk2(res[dt][4 * g4] + c0, res[dt][4 * g4 + 1] + c1), pk2(res[dt][4 * g4 + 2] + c2, res[dt][4 * g4 + 3] + c3)};
    }
}
constexpr int PD_ITEMS = 16 * 192;
DI void phase_d(const Params& p, unsigned char* smem) {
  for (int it = blockIdx.x; it < PD_ITEMS; it += gridDim.x) {
    const int r = it / 192, w = it % 192, qt = 15 - r;
    if (w < 64) dense_attn_item<M_MLA>(p, w >> 3, w & 7, qt, (bf16_t*)smem);
    else if (w < 128) dense_attn_item<M_FOX>(p, (w - 64) >> 3, (w - 64) & 7, qt, (bf16_t*)smem);
    else { const int i = w - 128, bg = i & 15, q4 = i >> 4; nsa_attn_item(p, bg >> 1, bg & 1, qt * 4 + q4, (bf16_t*)smem); }
  }
}

DI void merge_tile(const Params& p, int layer, int tm, int tn, bf16_t* smem) {
  typedef GemmLds<8, 2> L;
  const bf16_t* wl = (const bf16_t*)(p.ws + O_W) + (size_t)layer * W_LAYER;
  const int tid = TIDX(), lane = tid & 63, wid = tid >> 6, wm = wid >> 2, wn = wid & 3, l15 = lane & 15, quad = lane >> 4;
  f32x4 mg[8][2]; zero_acc<8, 2>(mg);
  f32x4 acc[8][2]; zero_acc<8, 2>(acc);
  unsigned* gsp = (unsigned*)((unsigned char*)smem + 2 * L::STAGE * 2) + tid;
  const bf16_t* la; const bf16_t* lb; unsigned lald, lbld; int laks, lnk;
  auto get_seg = [&](int sg) {
    const int br = sg >> 1;
    if ((sg & 1) == 0) { la = (const bf16_t*)(p.ws + O_XG) + (size_t)tm * 256 * D_; lald = D_; laks = 64; lb = wl + W_G + ((size_t)br * 1024 + tn * 128) * D_; lbld = D_; lnk = 16; }
    else {
      lald = br == 2 ? 768u : 512u; laks = br == 2 ? 96 : 64; lnk = 8; lbld = 512u;
      la = (const bf16_t*)(p.ws + (br == 0 ? O_ONSA : br == 1 ? O_FOXQ : O_MLAQ)) + (size_t)tm * 256 * lald;
      lb = wl + (br == 0 ? W_BN : br == 1 ? W_BF : W_BM) + (size_t)tn * 128 * 512;
    }
  };
  unsigned pa0, pb0; u32x4 ra[4], rb[2];
  auto set_offsets = [&]() { pa0 = (unsigned)(tid >> 3) * lald + (tid & 7) * 8; pb0 = (unsigned)(tid >> 3) * lbld + (tid & 7) * 8; };
  int ls = 0, lkt = 0;
  get_seg(0); set_offsets();
  auto gload_next = [&]() {
    const bf16_t* ab = la + (size_t)lkt * laks; const bf16_t* bb = lb + (size_t)lkt * 64;
#pragma unroll
    for (int i = 0; i < 4; ++i) ra[i] = *(const u32x4*)(ab + pa0 + (size_t)i * 64 * lald);
#pragma unroll
    for (int i = 0; i < 2; ++i) rb[i] = *(const u32x4*)(bb + pb0 + (size_t)i * 64 * lbld);
    if (++lkt == lnk) {
      if (ls + 1 < 6) { ++ls; lkt = 0; get_seg(ls); set_offsets(); } else lkt = lnk - 1;
    }
  };
  auto sstore = [&](int buf) {
    bf16_t* As = smem + buf * L::STAGE; bf16_t* Bs = As + L::A_ELEMS;
#pragma unroll
    for (int i = 0; i < 4; ++i) { const int c = tid + NTHR * i; *(u32x4*)(As + (c >> 3) * LDT + (c & 7) * 8) = ra[i]; }
#pragma unroll
    for (int i = 0; i < 2; ++i) { const int c = tid + NTHR * i; *(u32x4*)(Bs + (c >> 3) * LDT + (c & 7) * 8) = rb[i]; }
  };
  gload_next(); sstore(0); gload_next(); __syncthreads();
  int buf = 0;
#pragma unroll 1
  for (int sg = 0; sg < 6; ++sg) {
    const int nk = (sg & 1) ? 8 : 16;
#pragma unroll 1
    for (int kt = 0; kt < nk; ++kt) {
      sstore(buf ^ 1);
      gload_next();
      __builtin_amdgcn_sched_barrier(0);
      const bf16_t* As = smem + buf * L::STAGE + (wm * 128 + l15) * LDT + quad * 8;
      const bf16_t* Bs = smem + buf * L::STAGE + L::A_ELEMS + (wn * 32 + l15) * LDT + quad * 8;
#pragma unroll
      for (int ks = 0; ks < 2; ++ks) {
        if (ks == 1) asm volatile("" ::: "memory");
        bf16x8 b[2];
#pragma unroll
        for (int j = 0; j < 2; ++j) b[j] = *(const bf16x8*)(Bs + j * 16 * LDT + ks * 32);
#pragma unroll
        for (int i = 0; i < 8; ++i) {
          const bf16x8 a = *(const bf16x8*)(As + i * 16 * LDT + ks * 32);
#pragma unroll
          for (int j = 0; j < 2; ++j) acc[i][j] = mfma16(b[j], a, acc[i][j]);
        }
      }
      __syncthreads();
      buf ^= 1;
    }
    if ((sg & 1) == 0) {
      const int t2 = TIDX(), row0 = tm * 256 + ((t2 >> 8) & 1) * 128 + (t2 & 15);
#pragma unroll
      for (int i = 0; i < 8; ++i) {
        asm volatile("" ::: "memory");
        const float rs = rstd_from16((const float*)(p.ws + O_SSQ) + (size_t)(row0 + i * 16) * 16, 1.f / 1024.f);
#pragma unroll
        for (int j = 0; j < 2; ++j) {
          unsigned w = 0;
#pragma unroll
          for (int r = 0; r < 4; ++r) w |= (unsigned)__float2int_rn(sigmoidf_(acc[i][j][r] * rs) * 255.f) << (8 * r);
          gsp[(i * 2 + j) * NTHR] = w;
        }
      }
    } else {
#pragma unroll
      for (int i = 0; i < 8; ++i)
#pragma unroll
        for (int j = 0; j < 2; ++j) {
          asm volatile("" ::: "memory");
          const unsigned w = gsp[(i * 2 + j) * NTHR];
#pragma unroll
          for (int r = 0; r < 4; ++r) mg[i][j][r] += (float)((w >> (8 * r)) & 0xffu) * (1.f / 255.f) * acc[i][j][r];
        }
    }
    zero_acc<8, 2>(acc);
  }
  const int t3 = TIDX(), lane3 = t3 & 63, wid3 = t3 >> 6;
  bf16_t* stg = smem + wid3 * (128 * 40);
#pragma unroll
  for (int i = 0; i < 8; ++i)
#pragma unroll
    for (int j = 0; j < 2; ++j) *(u32x2*)(stg + (i * 16 + (lane3 & 15)) * 40 + j * 16 + (lane3 >> 4) * 4) = (u32x2){pk2(mg[i][j][0], mg[i][j][1]), pk2(mg[i][j][2], mg[i][j][3])};
  stage_out<128, 32, 40>(stg, (bf16_t*)(p.ws + O_MERGED) + (size_t)(tm * 256 + (wid3 >> 2) * 128) * D_ + tn * 128 + (wid3 & 3) * 32, (size_t)D_, lane3);
  __syncthreads();
}
DI void phase_e(const Params& p, int layer, unsigned char* smem) {
  xcd_tiles(16, 8, [&](int tm, int tn) { merge_tile(p, layer, tm, tn, (bf16_t*)smem); });
}

DI void resid_tile(const Params& p, const bf16_t* A, int K, const bf16_t* W, const float* xold, const float* gnext, int tm, int tn, bf16_t* smem) {
  f32x4 acc[8][4]; zero_acc<8, 4>(acc);
  RowPtr ap{A + (size_t)tm * 256 * K, (size_t)K}, bp{W + (size_t)tn * 256 * K, (size_t)K};
  gemm_main<8, 4, true>(acc, ap, 64, bp, 64, K / 64, smem);
  const int lane = TIDX() & 63, wid = TIDX() >> 6, wm = wid >> 2, wn = wid & 3, l15 = lane & 15, quad = lane >> 4;
  bf16_t* stg = smem + wid * STG_WAVE;
#pragma unroll
  for (int i = 0; i < 8; ++i) {
    const int t = tm * 256 + wm * 128 + i * 16 + l15, c0 = tn * 256 + wn * 64 + quad * 4; float s = 0.f;
#pragma unroll
    for (int j = 0; j < 4; ++j) {
      const size_t off = (size_t)t * D_ + c0 + j * 16;
      const f32x4 xn = *(const f32x4*)(xold + off) + acc[i][j];
      *(f32x4*)(p.out + off) = xn;
      s += xn[0] * xn[0] + xn[1] * xn[1] + xn[2] * xn[2] + xn[3] * xn[3];
      if (gnext) { const f32x4 gv = *(const f32x4*)(gnext + c0 + j * 16); *(u32x2*)(stg + (i * 16 + l15) * STG_LD + j * 16 + quad * 4) = (u32x2){pk2(xn[0] * gv[0], xn[1] * gv[1]), pk2(xn[2] * gv[2], xn[3] * gv[3])}; }
    }
    s += __shfl_xor(s, 16); s += __shfl_xor(s, 32);
    if (quad == 0) ((float*)(p.ws + O_SSQ))[(size_t)t * 16 + tn * 4 + wn] = s;
  }
  if (gnext) stage_out<128, 64, STG_LD>(stg, (bf16_t*)(p.ws + O_XG) + (size_t)(tm * 256 + wm * 128) * D_ + tn * 256 + wn * 64, (size_t)D_, lane);
  __syncthreads();
}
DI void phase_f(const Params& p, int layer, unsigned char* smem) {
  const bf16_t* wl = (const bf16_t*)(p.ws + O_W) + (size_t)layer * W_LAYER;
  xcd_tiles(16, 4, [&](int tm, int tn) { resid_tile(p, (const bf16_t*)(p.ws + O_MERGED), 1024, wl + W_OUT, layer == 0 ? p.x : p.out, p.ffn_norm + layer * D_, tm, tn, (bf16_t*)smem); });
}
DI void phase_h(const Params& p, int layer, unsigned char* smem) {
  const bf16_t* wl = (const bf16_t*)(p.ws + O_W) + (size_t)layer * W_LAYER;
  xcd_tiles(16, 4, [&](int tm, int tn) { resid_tile(p, (const bf16_t*)(p.ws + O_ACT), DFF_, wl + W_DN, p.out, layer == 0 ? p.mix_norm + D_ : nullptr, tm, tn, (bf16_t*)smem); });
}

struct UpRowPtr { const bf16_t* base; int s0;
  DI unsigned operator()(int r) const { const int s = s0 + r; return (unsigned)((s < 0 || s >= S_) ? 0 : s) * (unsigned)D_; }
  DI bool ok(int r) const { const int s = s0 + r; return s >= 0 && s < S_; } };
constexpr int PG_MT = 17;
DI void ffnup_tile(const Params& p, int layer, int b, int mt, int tn, bf16_t* smem) {
  const bf16_t* wl = (const bf16_t*)(p.ws + O_W) + (size_t)layer * W_LAYER;
  f32x4 acc[8][4]; zero_acc<8, 4>(acc);
  const int s0 = 254 * mt - 2;
  UpRowPtr ap{(const bf16_t*)(p.ws + O_XG) + (size_t)b * S_ * D_, s0}; RowPtr bp{wl + W_UP + (size_t)tn * 256 * D_, (size_t)D_};
  gemm_main<8, 4, true>(acc, ap, 64, bp, 64, 16, smem);
  const int tid = TIDX(), lane = tid & 63, wid = tid >> 6, wm = wid >> 2, wn = wid & 3, l15 = lane & 15, quad = lane >> 4;
  constexpr int LDU = 136; bf16_t* U = smem; bf16_t* V = smem + 256 * LDU;
  {
    bf16_t* dstb = (wn < 2 ? U : V) + (wn & 1) * 64 + quad * 4;
#pragma unroll
    for (int i = 0; i < 8; ++i) {
      const int row = wm * 128 + i * 16 + l15, s = s0 + row;
      const float rs = (s >= 0 && s < S_) ? rstd_from16((const float*)(p.ws + O_SSQ) + ((size_t)b * S_ + s) * 16, 1.f / 1024.f) : 0.f;
#pragma unroll
      for (int j = 0; j < 4; ++j) store4(dstb + row * LDU + j * 16, acc[i][j], rs);
    }
  }
  __syncthreads();
  {
    const int cc = tid & 15, cg0 = tn * 128 + cc * 8;
    const float* cw = p.conv_w + (size_t)layer * 3 * DFF_ + cg0; const float* cbp = p.conv_b + (size_t)layer * DFF_ + cg0;
    float w0[8], w1[8], w2[8], cb[8];
#pragma unroll
    for (int e = 0; e < 8; ++e) { w0[e] = cw[e]; w1[e] = cw[DFF_ + e]; w2[e] = cw[2 * DFF_ + e]; cb[e] = cbp[e]; }
    bf16_t* act = (bf16_t*)(p.ws + O_ACT);
#pragma unroll 2
    for (int it = 0; it < 8; ++it) {
      const int row = it * 32 + (tid >> 4), s = s0 + row;
      if (row >= 2 && s < S_) {
        const u32x4 u0 = *(const u32x4*)(U + (row - 2) * LDU + cc * 8), u1 = *(const u32x4*)(U + (row - 1) * LDU + cc * 8), u2 = *(const u32x4*)(U + row * LDU + cc * 8), vv = *(const u32x4*)(V + row * LDU + cc * 8);
        unsigned o[4];
#pragma unroll
        for (int e = 0; e < 4; ++e) {
          float r2[2];
#pragma unroll
          for (int h = 0; h < 2; ++h) {
            const int k = 2 * e + h;
            const float a0 = bf2f((bf16_t)(h ? u0[e] >> 16 : u0[e] & 0xffffu)), a1 = bf2f((bf16_t)(h ? u1[e] >> 16 : u1[e] & 0xffffu)), a2 = bf2f((bf16_t)(h ? u2[e] >> 16 : u2[e] & 0xffffu)), vx = bf2f((bf16_t)(h ? vv[e] >> 16 : vv[e] & 0xffffu));
            const float uc = w0[k] * a0 + w1[k] * a1 + w2[k] * a2 + cb[k];
            r2[h] = uc * sigmoidf_(uc) * vx;
          }
          o[e] = pk2(r2[0], r2[1]);
        }
        __builtin_nontemporal_store((u32x4){o[0], o[1], o[2], o[3]}, (u32x4*)(act + ((size_t)b * S_ + s) * DFF_ + cg0));
      }
    }
  }
  __syncthreads();
}
DI void phase_g(const Params& p, int layer, unsigned char* smem) {
  xcd_tiles(PG_MT, 22, [&](int tmg, int tn) { ffnup_tile(p, layer, tmg / PG_MT, tmg % PG_MT, tn, (bf16_t*)smem); });
}

DI void phase_final(const Params& p) {
  const int lane = TIDX() & 63, wid = TIDX() >> 6;
  for (int it = blockIdx.x; it < T_ / 8; it += gridDim.x) {
    const int t = it * 8 + wid; const float rs = rstd_from16((const float*)(p.ws + O_SSQ) + (size_t)t * 16, 1.f / 1024.f);
    float* xr = p.out + (size_t)t * D_;
#pragma unroll
    for (int c = 0; c < 4; ++c) { const int k = c * 256 + lane * 4; const f32x4 v = *(const f32x4*)(xr + k), gv = *(const f32x4*)(p.final_norm + k); *(f32x4*)(xr + k) = v * rs * gv; }
  }
}

#define XB_TMO      128
#define XB_XCNT(j)  (256  + 64 * (j))
#define XB_XSUB(j)  (1280 + 64 * (j))
#define XB_XGEN(j)  (2304 + 64 * (j))
#define XB_TOP      3328
#define XB_TOPGEN   3392
#define XCD_BAR_WORDS 3456
#define XB_SPIN_CAP (1u << 22)
#define LAS __attribute__((address_space(3)))
DI unsigned xb_ld(unsigned* p)              { return __hip_atomic_load(p, __ATOMIC_RELAXED, __HIP_MEMORY_SCOPE_AGENT); }
DI unsigned xb_add(unsigned* p, unsigned v) { return __hip_atomic_fetch_add(p, v, __ATOMIC_RELAXED, __HIP_MEMORY_SCOPE_AGENT); }
DI unsigned xb_xcc_id() { return (unsigned)__builtin_amdgcn_s_getreg((3 << 11) | 20) & 0xFu; }
#define XB_SPIN(cond, bar) do { unsigned _sp = 0; while (cond) { __builtin_amdgcn_s_sleep(1); \
    if ((++_sp & 255u) == 0u) { if (xb_ld(&(bar)[XB_TMO])) break; if (_sp > XB_SPIN_CAP) { atomicAdd(&(bar)[XB_TMO], 1u); break; } } } } while (0)
struct XcdBarrier { unsigned* bar; unsigned x; volatile LAS unsigned* st; };
DI XcdBarrier xcd_barrier_post(unsigned* bar, volatile LAS unsigned* st) {
  XcdBarrier b; b.bar = bar; b.x = xb_xcc_id(); b.st = st;
  if (threadIdx.x == 0) (void)xb_add(&bar[XB_XCNT(b.x)], 1u);
  return b;
}
DI void xcd_barrier_complete(unsigned* bar, unsigned x, unsigned& nloc, unsigned& nx) {
  const unsigned G = gridDim.x * gridDim.y * gridDim.z;
  unsigned sum, cnt, mine, sp = 0u;
  for (;;) {
    sum = 0u; cnt = 0u; mine = 0u;
#pragma unroll
    for (unsigned j = 0; j < 16; ++j) { const unsigned c = xb_ld(&bar[XB_XCNT(j)]); sum += c; cnt += (c > 0u) ? 1u : 0u; mine = (j == x) ? c : mine; }
    if (sum == G) break;
    __builtin_amdgcn_s_sleep(1);
    if ((++sp & 255u) == 0u) { if (xb_ld(&bar[XB_TMO])) break; if (sp > XB_SPIN_CAP) { atomicAdd(&bar[XB_TMO], 1u); break; } }
  }
  nloc = mine > 0u ? mine : 1u; nx = cnt > 0u ? cnt : 1u;
}
DI void xcd_barrier(const XcdBarrier& b) {
  asm volatile("s_waitcnt vmcnt(0)" ::: "memory");
  __syncthreads();
  if (threadIdx.x == 0) {
    unsigned* bar = b.bar;
    __builtin_amdgcn_s_waitcnt(0);
    unsigned nloc = b.st[0], nx = b.st[1];
    if (nloc == 0u) { xcd_barrier_complete(bar, b.x, nloc, nx); b.st[0] = nloc; b.st[1] = nx; }
    const unsigned old = xb_add(&bar[XB_XSUB(b.x)], 1u);
    const unsigned gen = old / nloc;
    if (old + 1u == (gen + 1u) * nloc) {
      __builtin_amdgcn_fence(__ATOMIC_RELEASE, "agent");
      asm volatile("s_waitcnt vmcnt(0)" ::: "memory");
      const unsigned og = xb_add(&bar[XB_TOP], 1u);
      const unsigned tg = og / nx;
      if (og + 1u == (tg + 1u) * nx) xb_add(&bar[XB_TOPGEN], 1u);
      else XB_SPIN(xb_ld(&bar[XB_TOPGEN]) == tg, bar);
      __builtin_amdgcn_fence(__ATOMIC_ACQUIRE, "agent");
      xb_add(&bar[XB_XGEN(b.x)], 1u);
      asm volatile("s_waitcnt vmcnt(0)" ::: "memory");
    } else {
      XB_SPIN(xb_ld(&bar[XB_XGEN(b.x)]) == gen, bar);
      __builtin_amdgcn_fence(__ATOMIC_ACQUIRE, "agent");
      asm volatile("s_waitcnt vmcnt(0)" ::: "memory");
    }
  }
  __syncthreads();
}
DI void run_phase(const Params& p, int ph, unsigned char* smem) {
  if (ph == 0) { phase_prep(p, smem); return; }
  if (ph == 17) { phase_final(p); return; }
  const int layer = (ph - 1) >> 3, s = (ph - 1) & 7;
#ifdef PROBE_DUP
  if ((PROBE_DUP >> s) & 1) {
    switch (s) { case 0: phase_inproj(p, layer, smem); break; case 1: phase_b(p, layer, smem); break; case 2: phase_c(p, smem); break; case 4: phase_e(p, layer, smem); break; case 6: phase_g(p, layer, smem); break; default: break; }
    __syncthreads();
  }
#endif
  switch (s) {
    case 0: phase_inproj(p, layer, smem); break;
    case 1: phase_b(p, layer, smem); break;
    case 2: phase_c(p, smem); break;
    case 3: phase_d(p, smem); break;
    case 4: phase_e(p, layer, smem); break;
    case 5: phase_f(p, layer, smem); break;
    case 6: phase_g(p, layer, smem); break;
    default: phase_h(p, layer, smem); break;
  }
}
constexpr int N_PHASES = 18;

#if ONE_LAUNCH
template <int PH> DI void run_all(const Params& p, unsigned char* smem, cg::grid_group& grid, const XcdBarrier& xb) {
  run_phase(p, PH, smem);
  if constexpr (PH + 1 < N_PHASES) {
    if constexpr (PH == 0) grid.sync(); else xcd_barrier(xb);
    run_all<PH + 1>(p, smem, grid, xb);
  }
}
__global__ void __launch_bounds__(NTHR, 2) mega_kernel(Params p) {
  __shared__ __attribute__((aligned(16))) unsigned char smem[SMEM_BYTES];
  __shared__ uint4 xb_words;
  if (threadIdx.x == 0) xb_words = make_uint4(0u, 0u, 0u, 0u);
  __syncthreads();
  const XcdBarrier xb = xcd_barrier_post((unsigned*)(p.ws + O_BAR), (volatile LAS unsigned*)&xb_words);
  cg::grid_group grid = cg::this_grid();
  run_all<0>(p, smem, grid, xb);
}
#else
template <int PH> __global__ void __launch_bounds__(NTHR, 2) phase_kernel(Params p) {
  __shared__ __attribute__((aligned(16))) unsigned char smem[SMEM_BYTES];
  run_phase(p, PH, smem);
}
template <int PH> static void launch_phases(const Params& p, hipStream_t stream) {
  hipLaunchKernelGGL((phase_kernel<PH>), dim3(256), dim3(NTHR), 0, stream, p);
  if constexpr (PH + 1 < N_PHASES) launch_phases<PH + 1>(p, stream);
}
#endif

extern "C" void kernel_launch(void* const* d_in, const int* in_sizes, int n_in, void* d_out, int out_size, void* d_ws, size_t ws_size, hipStream_t stream) {
  if (ws_size < O_END || n_in < 25) { fprintf(stderr, "workspace too small: %zu < %zu\n", ws_size, (size_t)O_END); return; }
  Params p{};
  p.x = (const float*)d_in[0]; p.pos = (const int*)d_in[1]; p.mix_norm = (const float*)d_in[2]; p.w_in = (const float*)d_in[3]; p.b_forget = (const float*)d_in[4];
  p.pe_k = (const float*)d_in[5]; p.w1_k = (const float*)d_in[6]; p.w2_k = (const float*)d_in[7]; p.pe_v = (const float*)d_in[8]; p.w1_v = (const float*)d_in[9]; p.w2_v = (const float*)d_in[10];
  p.q_norm = (const float*)d_in[11]; p.w_uq = (const float*)d_in[12]; p.kv_norm = (const float*)d_in[13]; p.w_ukv = (const float*)d_in[14];
  p.wbr_nsa = (const float*)d_in[15]; p.wbr_fox = (const float*)d_in[16]; p.wbr_mla = (const float*)d_in[17]; p.w_out = (const float*)d_in[18];
  p.ffn_norm = (const float*)d_in[19]; p.w_up = (const float*)d_in[20]; p.conv_w = (const float*)d_in[21]; p.conv_b = (const float*)d_in[22]; p.w_down = (const float*)d_in[23]; p.final_norm = (const float*)d_in[24];
  p.out = (float*)d_out; p.ws = (unsigned char*)d_ws;
#if ONE_LAUNCH
  static int grid_blocks = 0;
  if (!grid_blocks) {
    int dev = 0, cus = 0, per_cu = 0;
    hipGetDevice(&dev); hipDeviceGetAttribute(&cus, hipDeviceAttributeMultiprocessorCount, dev);
    hipOccupancyMaxActiveBlocksPerMultiprocessor(&per_cu, mega_kernel, NTHR, 0);
    if (per_cu > 1) per_cu = 1;
    grid_blocks = cus * per_cu;
  }
  hipMemsetAsync(p.ws + O_BAR, 0, XCD_BAR_WORDS * 4, stream);
  void* args[] = {&p};
  hipError_t e = hipLaunchCooperativeKernel((void*)mega_kernel, dim3(grid_blocks), dim3(NTHR), args, 0, stream);
  if (e != hipSuccess) fprintf(stderr, "cooperative launch failed: %s (grid %d)\n", hipGetErrorString(e), grid_blocks);
#else
  launch_phases<0>(p, stream);
#endif
}
```

```cpp
#include <hip/hip_runtime.h>
#include <hip/hip_cooperative_groups.h>
#include <stdint.h>
#include <stdio.h>
#include <type_traits>
namespace cg = cooperative_groups;

#ifndef ONE_LAUNCH
#define ONE_LAUNCH 1

#endif

#define DI __device__ __forceinline__
typedef unsigned short bf16_t;
typedef short bf16x8 __attribute__((ext_vector_type(8)));
typedef float f32x4 __attribute__((ext_vector_type(4)));
typedef float f32x16 __attribute__((ext_vector_type(16)));
typedef float f32x2 __attribute__((ext_vector_type(2)));
typedef __bf16 bfx2 __attribute__((ext_vector_type(2)));
typedef unsigned u32x4 __attribute__((ext_vector_type(4)));
typedef unsigned u32x2 __attribute__((ext_vector_type(2)));
typedef unsigned long long u64;

constexpr int T_ = 32768, S_ = 4096, NB_ = 8, D_ = 1024, DFF_ = 2816, NIN_ = 6592;
constexpr float EPS_ = 1e-6f;
constexpr float LOG2E_ = 1.4426950408889634f;
constexpr float QS64_ = 0.125f * LOG2E_;
constexpr float QS96_ = 0.10206207261596577f * LOG2E_;

constexpr size_t W_IN = 0;
constexpr size_t W_G = W_IN + (size_t)3584 * 1024;
constexpr size_t W_1K = W_G + (size_t)3072 * 1024;
constexpr size_t W_1V = W_1K + (size_t)256 * 2048;
constexpr size_t W_2K = W_1V + (size_t)256 * 2048;
constexpr size_t W_2V = W_2K + (size_t)64 * 256;
constexpr size_t W_UQ = W_2V + (size_t)64 * 256;
constexpr size_t W_UKV = W_UQ + (size_t)768 * 384;
constexpr size_t W_BN = W_UKV + (size_t)1024 * 256;
constexpr size_t W_BF = W_BN + (size_t)1024 * 512;
constexpr size_t W_BM = W_BF + (size_t)1024 * 512;
constexpr size_t W_OUT = W_BM + (size_t)1024 * 512;
constexpr size_t W_UP = W_OUT + (size_t)1024 * 1024;
constexpr size_t W_DN = W_UP + (size_t)5632 * 1024;
constexpr size_t W_LAYER = W_DN + (size_t)1024 * 2816;

constexpr size_t al256(size_t x) { return (x + 255) & ~(size_t)255; }
constexpr size_t O_BAR = 0;
constexpr size_t O_W = 16384;
constexpr size_t O_BIAS1 = al256(O_W + 2 * W_LAYER * 2);
constexpr size_t O_ROPE8 = al256(O_BIAS1 + 2 * 2 * 16 * 256 * 4);
constexpr size_t O_ROPE16 = al256(O_ROPE8 + (size_t)T_ * 16 * 4);
constexpr size_t O_XG = al256(O_ROPE16 + (size_t)T_ * 32 * 4);
constexpr size_t O_SSQ = al256(O_XG + (size_t)T_ * 1024 * 2);
constexpr size_t O_CSSQ = al256(O_SSQ + (size_t)T_ * 16 * 4);
constexpr size_t O_NSAQ = al256(O_CSSQ + (size_t)T_ * 16 * 4);
constexpr size_t O_KVCMP = O_NSAQ + (size_t)T_ * 512 * 2;
constexpr size_t O_KSLC = O_KVCMP + (size_t)T_ * 256 * 2;
constexpr size_t O_KWIN = O_KSLC + (size_t)T_ * 128 * 2;
constexpr size_t O_MERGED = O_NSAQ;
constexpr size_t O_VSLCT = O_KWIN + (size_t)T_ * 128 * 2;
constexpr size_t O_VWINT = O_VSLCT + (size_t)T_ * 128 * 2;
constexpr size_t O_FOXQ = O_VWINT + (size_t)T_ * 128 * 2;
constexpr size_t O_FOXK = O_FOXQ + (size_t)T_ * 512 * 2;
constexpr size_t O_FOXVT = O_FOXK + (size_t)T_ * 512 * 2;
constexpr size_t O_MLAQ = O_FOXVT + (size_t)T_ * 512 * 2;
constexpr size_t O_MLAKN = O_MLAQ + (size_t)T_ * 768 * 2;
constexpr size_t O_ACT = O_FOXQ;
constexpr size_t O_MLAVT = O_MLAKN + (size_t)T_ * 512 * 2;
constexpr size_t O_MLAKPE = O_MLAVT + (size_t)T_ * 512 * 2;
constexpr size_t O_ONSA = O_MLAKPE + (size_t)T_ * 32 * 2;
constexpr size_t O_CQ = O_ONSA;
constexpr size_t O_CKV = O_CQ + (size_t)T_ * 384 * 2;
constexpr size_t O_CEND = O_CKV + (size_t)T_ * 256 * 2;
constexpr size_t O_GATES = al256(O_CEND > O_ONSA + (size_t)T_ * 512 * 2 ? O_CEND : O_ONSA + (size_t)T_ * 512 * 2);
constexpr size_t O_LOGF = al256(O_GATES + (size_t)T_ * 24 * 4);
constexpr size_t O_F2 = al256(O_LOGF + (size_t)T_ * 8 * 4);
constexpr size_t O_KC = al256(O_F2 + (size_t)T_ * 8 * 4);
constexpr size_t O_VCT = al256(O_KC + (size_t)NB_ * 2 * 256 * 64 * 2);
constexpr size_t O_SEL = al256(O_VCT + (size_t)NB_ * 2 * 256 * 64 * 2);
constexpr size_t O_END = al256(O_SEL + (size_t)NB_ * 2 * S_ * 8);

struct Params {
  const float* x; const int* pos; const float* mix_norm; const float* w_in; const float* b_forget;
  const float* pe_k; const float* w1_k; const float* w2_k; const float* pe_v; const float* w1_v; const float* w2_v;
  const float* q_norm; const float* w_uq; const float* kv_norm; const float* w_ukv;
  const float* wbr_nsa; const float* wbr_fox; const float* wbr_mla; const float* w_out;
  const float* ffn_norm; const float* w_up; const float* conv_w; const float* conv_b; const float* w_down; const float* final_norm;
  float* out; unsigned char* ws;
};

constexpr int NTHR = 512;
constexpr int SMEM_BYTES = 147456;

DI int TIDX() { int t = (int)threadIdx.x; asm volatile("" : "+v"(t)); return t; }
DI unsigned pk2(float lo, float hi) { f32x2 v = {lo, hi}; return __builtin_bit_cast(unsigned, __builtin_convertvector(v, bfx2)); }
DI bf16_t f2bf(float x) { return (bf16_t)(pk2(x, 0.f) & 0xffffu); }
DI float bf2f(bf16_t h) { return __uint_as_float(((unsigned)h) << 16); }
DI float sigmoidf_(float x) { return 1.f / (1.f + __expf(-x)); }
DI float gelu_tanh(float x) { const float u = 0.7978845608028654f * (x + 0.044715f * x * x * x); return x / (1.f + __expf(-2.f * u)); }
DI float ex2(float x) { return __builtin_amdgcn_exp2f(x); }
DI f32x16 mfma32(bf16x8 a, bf16x8 b, f32x16 c) { return __builtin_amdgcn_mfma_f32_32x32x16_bf16(a, b, c, 0, 0, 0); }
DI f32x4 mfma16(bf16x8 a, bf16x8 b, f32x4 c) { return __builtin_amdgcn_mfma_f32_16x16x32_bf16(a, b, c, 0, 0, 0); }
DI float rstd_from16(const float* p, float inv_n) {
  const f32x4 a = *(const f32x4*)p, b = *(const f32x4*)(p + 4), c = *(const f32x4*)(p + 8), d = *(const f32x4*)(p + 12);
  const float s = ((a[0] + a[1]) + (a[2] + a[3])) + ((b[0] + b[1]) + (b[2] + b[3])) + ((c[0] + c[1]) + (c[2] + c[3])) + ((d[0] + d[1]) + (d[2] + d[3]));
  return rsqrtf(s * inv_n + EPS_);
}

constexpr int LDT = 72;
template <int MI, int NJ> struct GemmLds { static constexpr int BM = 32 * MI, BN = 64 * NJ, A_ELEMS = BM * LDT, B_ELEMS = BN * LDT, STAGE = A_ELEMS + B_ELEMS; };

template <int MI, int NJ, bool SWAP, class AP, class BP>
DI void gemm_main(f32x4 (&acc)[MI][NJ], const AP& ap, int a_kstep, const BP& bp, int b_kstep, int nk, bf16_t* smem) {
  typedef GemmLds<MI, NJ> L;
  constexpr int CA = MI / 2, CB = NJ;
  const int tid = TIDX(), lane = tid & 63, wid = tid >> 6, wm = wid >> 2, wn = wid & 3, l15 = lane & 15, quad = lane >> 4;
  unsigned pa[CA], pb[CB]; bool oka[CA];
#pragma unroll
  for (int i = 0; i < CA; ++i) { const int c = tid + NTHR * i; pa[i] = ap(c >> 3) + (c & 7) * 8; oka[i] = ap.ok(c >> 3); }
#pragma unroll
  for (int i = 0; i < CB; ++i) { const int c = tid + NTHR * i; pb[i] = bp(c >> 3) + (c & 7) * 8; }
  u32x4 ra[CA], rb[CB];
  auto gload = [&](int kt) {
    const bf16_t* ab = ap.base + (size_t)kt * a_kstep; const bf16_t* bb = bp.base + (size_t)kt * b_kstep;
#pragma unroll
    for (int i = 0; i < CA; ++i) ra[i] = *(const u32x4*)(ab + pa[i]);
#pragma unroll
    for (int i = 0; i < CB; ++i) rb[i] = *(const u32x4*)(bb + pb[i]);
  };
  auto sstore = [&](int buf) {
    bf16_t* As = smem + buf * L::STAGE; bf16_t* Bs = As + L::A_ELEMS;
#pragma unroll
    for (int i = 0; i < CA; ++i) { const int c = tid + NTHR * i; *(u32x4*)(As + (c >> 3) * LDT + (c & 7) * 8) = oka[i] ? ra[i] : (u32x4){0u, 0u, 0u, 0u}; }
#pragma unroll
    for (int i = 0; i < CB; ++i) { const int c = tid + NTHR * i; *(u32x4*)(Bs + (c >> 3) * LDT + (c & 7) * 8) = rb[i]; }
  };
  gload(0); sstore(0); gload(nk > 1 ? 1 : 0); __syncthreads();
#pragma unroll 1
  for (int kt = 0; kt < nk; ++kt) {
    const int buf = kt & 1;
    sstore(buf ^ 1);
    gload(kt + 2 < nk ? kt + 2 : nk - 1);
    __builtin_amdgcn_sched_barrier(0);
    const bf16_t* As = smem + buf * L::STAGE + (wm * 16 * MI + l15) * LDT + quad * 8;
    const bf16_t* Bs = smem + buf * L::STAGE + L::A_ELEMS + (wn * 16 * NJ + l15) * LDT + quad * 8;
#pragma unroll
    for (int ks = 0; ks < 2; ++ks) {
      if (MI * NJ >= 32 && ks == 1) asm volatile("" ::: "memory");
      bf16x8 b[NJ];
#pragma unroll
      for (int j = 0; j < NJ; ++j) b[j] = *(const bf16x8*)(Bs + j * 16 * LDT + ks * 32);
#pragma unroll
      for (int i = 0; i < MI; ++i) {
        const bf16x8 a = *(const bf16x8*)(As + i * 16 * LDT + ks * 32);
#pragma unroll
        for (int j = 0; j < NJ; ++j) acc[i][j] = SWAP ? mfma16(b[j], a, acc[i][j]) : mfma16(a, b[j], acc[i][j]);
      }
    }
    __syncthreads();
  }
}
template <int MI, int NJ> DI void zero_acc(f32x4 (&acc)[MI][NJ]) {
#pragma unroll
  for (int i = 0; i < MI; ++i)
#pragma unroll
    for (int j = 0; j < NJ; ++j) acc[i][j] = (f32x4){0.f, 0.f, 0.f, 0.f};
}
struct RowPtr { const bf16_t* base; size_t ld; DI unsigned operator()(int r) const { return (unsigned)r * (unsigned)ld; } DI bool ok(int) const { return true; } };


template <class F> DI void xcd_tiles(int MPX, int NT, F&& body) {
  const int xcd = blockIdx.x & 7, slot = blockIdx.x >> 3, nslots = gridDim.x >> 3, total = MPX * NT;
  for (int li = slot; li < total; li += nslots) {
    const int mg = li / (8 * NT), rem = li - mg * 8 * NT;
    const int gsz = (MPX - mg * 8) < 8 ? (MPX - mg * 8) : 8;
    const int tn = rem / gsz, mi = rem - tn * gsz;
    body(xcd * MPX + mg * 8 + mi, tn);
  }
}

DI int map_col(int map, int n) {
  if (map == 0) return n;
  if (map == 1) {
    if (n < 896) return n;
    if (n < 1024) return 1024 + (n - 896);
    if (n < 1152) return 896 + (n - 1024);
    if (n < 1280) return n;
    if (n < 2816) return 1304 + (n - 1280);
    if (n < 3200) return 2848 + (n - 2816);
    if (n < 3456) return 3232 + (n - 3200);
    const int c = n - 3456;
    if (c < 24) return 1280 + c;
    if (c < 32) return 2840 + (c - 24);
    if (c < 64) return 3488 + (c - 32);
    return -1;
  }
  if (map == 2) { const int j = n >> 8, c = n & 255; return c < 128 ? j * 128 + c : DFF_ + j * 128 + (c - 128); }
  if (map == 3) { return n < 512 ? (n >> 6) * 128 + (n & 63) : ((n - 512) >> 6) * 128 + 64 + ((n - 512) & 63); }
  return n;
}
struct WJob { const float* src; const float* scale; bf16_t* dst; int K, N, ld, map, off; };
DI void prep_weight_tile(const WJob& j, int tile, float* lds) {
  const int ntn = j.N >> 6, tk = tile / ntn, tn = tile % ntn, tid = TIDX();
  const int n4 = (tid & 15) * 4; const int sc = map_col(j.map, tn * 64 + n4);
  f32x4 v[4];
#pragma unroll
  for (int i = 0; i < 4; ++i) {
    const int kk = (tid >> 4) + 32 * i, k = tk * 128 + kk;
    v[i] = sc >= 0 ? *(const f32x4*)(j.src + (size_t)k * j.ld + j.off + sc) : (f32x4){0.f, 0.f, 0.f, 0.f};
    if (j.scale) v[i] = v[i] * j.scale[k];
  }
#pragma unroll
  for (int i = 0; i < 4; ++i) {
    const int kk = (tid >> 4) + 32 * i;
#pragma unroll
    for (int e = 0; e < 4; ++e) lds[kk * 65 + n4 + e] = v[i][e];
  }
  __syncthreads();
  const int nn = tid >> 3, k0 = (tid & 7) * 16;
  unsigned w[8];
#pragma unroll
  for (int e = 0; e < 8; ++e) w[e] = pk2(lds[(k0 + 2 * e) * 65 + nn], lds[(k0 + 2 * e + 1) * 65 + nn]);
  bf16_t* d = j.dst + (size_t)(tn * 64 + nn) * j.K + tk * 128 + k0;
  *(u32x4*)d = (u32x4){w[0], w[1], w[2], w[3]}; *(u32x4*)(d + 8) = (u32x4){w[4], w[5], w[6], w[7]};
  __syncthreads();
}
DI WJob get_wjob(const Params& p, int layer, int id) {
  bf16_t* wl = (bf16_t*)(p.ws + O_W) + (size_t)layer * W_LAYER; WJob j; j.scale = nullptr; j.map = 0; j.off = 0;
  switch (id) {
    case 0: j.src = p.w_in + (size_t)layer * 1024 * NIN_; j.dst = wl + W_IN; j.K = 1024; j.N = 3584; j.ld = NIN_; j.map = 1; break;
    case 1: j.src = p.w_in + (size_t)layer * 1024 * NIN_; j.dst = wl + W_G; j.K = 1024; j.N = 3072; j.ld = NIN_; j.off = 3520; break;
    case 2: j.src = p.w1_k + (size_t)layer * 2048 * 256; j.dst = wl + W_1K; j.K = 2048; j.N = 256; j.ld = 256; break;
    case 3: j.src = p.w1_v + (size_t)layer * 2048 * 256; j.dst = wl + W_1V; j.K = 2048; j.N = 256; j.ld = 256; break;
    case 4: j.src = p.w2_k + (size_t)layer * 256 * 64; j.dst = wl + W_2K; j.K = 256; j.N = 64; j.ld = 64; break;
    case 5: j.src = p.w2_v + (size_t)layer * 256 * 64; j.dst = wl + W_2V; j.K = 256; j.N = 64; j.ld = 64; break;
    case 6: j.src = p.w_uq + (size_t)layer * 384 * 768; j.dst = wl + W_UQ; j.K = 384; j.N = 768; j.ld = 768; j.scale = p.q_norm + layer * 384; break;
    case 7: j.src = p.w_ukv + (size_t)layer * 256 * 1024; j.dst = wl + W_UKV; j.K = 256; j.N = 1024; j.ld = 1024; j.scale = p.kv_norm + layer * 256; j.map = 3; break;
    case 8: j.src = p.wbr_nsa + (size_t)layer * 512 * 1024; j.dst = wl + W_BN; j.K = 512; j.N = 1024; j.ld = 1024; break;
    case 9: j.src = p.wbr_fox + (size_t)layer * 512 * 1024; j.dst = wl + W_BF; j.K = 512; j.N = 1024; j.ld = 1024; break;
    case 10: j.src = p.wbr_mla + (size_t)layer * 512 * 1024; j.dst = wl + W_BM; j.K = 512; j.N = 1024; j.ld = 1024; break;
    case 11: j.src = p.w_out + (size_t)layer * 1024 * 1024; j.dst = wl + W_OUT; j.K = 1024; j.N = 1024; j.ld = 1024; break;
    case 12: j.src = p.w_up + (size_t)layer * 1024 * 5632; j.dst = wl + W_UP; j.K = 1024; j.N = 5632; j.ld = 5632; j.map = 2; break;
    default: j.src = p.w_down + (size_t)layer * 2816 * 1024; j.dst = wl + W_DN; j.K = 2816; j.N = 1024; j.ld = 1024; break;
  }
  return j;
}
constexpr int WTILES_LAYER = (int)(W_LAYER / 8192);
constexpr int P0_XITEMS = T_ / 64;
constexpr int P0_ROPE_ITEMS = T_ / NTHR;
constexpr int P0_ITEMS = 2 * WTILES_LAYER + 64 + P0_ROPE_ITEMS + P0_XITEMS;

DI void xg_rows(const float* x, const float* g, bf16_t* xg, float* ssq, int row0) {
  const int lane = TIDX() & 63, wid = TIDX() >> 6;
  for (int rr = 0; rr < 8; ++rr) {
    const int t = row0 + wid * 8 + rr; const float* xr = x + (size_t)t * D_; float s = 0.f;
#pragma unroll
    for (int c = 0; c < 4; ++c) {
      const int k = c * 256 + lane * 4; const f32x4 v = *(const f32x4*)(xr + k), gv = *(const f32x4*)(g + k);
      s += v[0] * v[0] + v[1] * v[1] + v[2] * v[2] + v[3] * v[3];
      *(u32x2*)(xg + (size_t)t * D_ + k) = (u32x2){pk2(v[0] * gv[0], v[1] * gv[1]), pk2(v[2] * gv[2], v[3] * gv[3])};
    }
#pragma unroll
    for (int o = 32; o >= 1; o >>= 1) s += __shfl_xor(s, o);
    if (lane < 16) ssq[(size_t)t * 16 + lane] = lane == 0 ? s : 0.f;
  }
}
DI void phase_prep(const Params& p, unsigned char* smem) {
  for (int it = blockIdx.x; it < P0_ITEMS; it += gridDim.x) {
    int i = it;
    if (i < 2 * WTILES_LAYER) {
      const int layer = i / WTILES_LAYER; int t = i % WTILES_LAYER; int id = 0;
      for (;; ++id) { const WJob j = get_wjob(p, layer, id); const int nt = (j.K >> 7) * (j.N >> 6); if (t < nt) { prep_weight_tile(j, t, (float*)smem); break; } t -= nt; }
      continue;
    }
    i -= 2 * WTILES_LAYER;
    if (i < 64) {
      const int lk = i >> 4, pc = i & 15, layer = lk >> 1, kv = lk & 1, c = TIDX() & 255, hf = TIDX() >> 8;
      const float* pe = (kv ? p.pe_v : p.pe_k) + (size_t)layer * 2048 + pc * 128 + hf * 64; const float* w1 = (kv ? p.w1_v : p.w1_k) + (size_t)layer * 2048 * 256 + (size_t)(pc * 128 + hf * 64) * 256;
      float sacc = 0.f;
#pragma unroll 8
      for (int kk = 0; kk < 64; ++kk) sacc += pe[kk] * w1[(size_t)kk * 256 + c];
      float* lds = (float*)smem;
      if (hf) lds[c] = sacc;
      __syncthreads();
      if (!hf) ((float*)(p.ws + O_BIAS1))[(lk * 16 + pc) * 256 + c] = sacc + lds[c];
      __syncthreads();
      continue;
    }
    i -= 64;
    if (i < P0_ROPE_ITEMS) {
      const int t = i * NTHR + TIDX(); const float fp = (float)p.pos[t];
      float* r8 = (float*)(p.ws + O_ROPE8) + (size_t)t * 16; float* r16 = (float*)(p.ws + O_ROPE16) + (size_t)t * 32;
      for (int f = 0; f < 24; ++f) {
        const int half = f < 8 ? 8 : 16, idx = f < 8 ? f : f - 8;
        const float inv = exp2f(-(float)idx / (float)half * 18.931568569324174f);
        const float ang = fp * inv;
        const double rev = (double)ang * 0.15915494309189535; const float fr = (float)(rev - floor(rev));
        const float sn = __builtin_amdgcn_sinf(fr), cs = __builtin_amdgcn_cosf(fr);
        if (f < 8) { r8[2 * idx] = cs; r8[2 * idx + 1] = sn; } else { r16[2 * idx] = cs; r16[2 * idx + 1] = sn; }
      }
      continue;
    }
    i -= P0_ROPE_ITEMS;
    xg_rows(p.x, p.mix_norm, (bf16_t*)(p.ws + O_XG), (float*)(p.ws + O_SSQ), i * 64);
  }
}

DI void store4(bf16_t* dst, const f32x4& v, float s) { *(u32x2*)dst = (u32x2){pk2(v[0] * s, v[1] * s), pk2(v[2] * s, v[3] * s)}; }
constexpr int STG_LD = 72, STG_WAVE = 128 * 72;
DI void stage4(bf16_t* stg, int row, int col, const f32x4& v, float s) { *(u32x2*)(stg + row * STG_LD + col) = (u32x2){pk2(v[0] * s, v[1] * s), pk2(v[2] * s, v[3] * s)}; }
template <int ROWS, int COLS, int LD> DI void stage_out(const bf16_t* stg, bf16_t* dst, size_t ld, int lane) {
  asm volatile("s_waitcnt lgkmcnt(0)" ::: "memory");
  constexpr int CPR = COLS / 8, IT = ROWS * CPR / 64;
#pragma unroll
  for (int it = 0; it < IT; ++it) {
    const int idx = it * 64 + lane, r = idx / CPR, c = idx % CPR;
    __builtin_nontemporal_store(*(const u32x4*)(stg + r * LD + c * 8), (u32x4*)(dst + (size_t)r * ld + c * 8));
  }
}
template <bool SWAP> DI void inproj_tile(const Params& p, int layer, int tm, int tn, bf16_t* smem) {
  const bf16_t* wl = (const bf16_t*)(p.ws + O_W) + (size_t)layer * W_LAYER;
  f32x4 acc[8][4]; zero_acc<8, 4>(acc);
  RowPtr ap{(const bf16_t*)(p.ws + O_XG) + (size_t)tm * 256 * D_, (size_t)D_}, bp{wl + W_IN + (size_t)tn * 256 * D_, (size_t)D_};
  gemm_main<8, 4, SWAP>(acc, ap, 64, bp, 64, 16, smem);
  const int lane = TIDX() & 63, wid = TIDX() >> 6, wm = wid >> 2, wn = wid & 3, l15 = lane & 15, quad = lane >> 4;
  const float* ssq = (const float*)(p.ws + O_SSQ);
  bf16_t* stg = smem + wid * STG_WAVE;
  const int trow0 = tm * 256 + wm * 128;
  if constexpr (!SWAP) {
    bf16_t* dst; int hh, hd;
    if (tn == 4) { dst = (bf16_t*)(p.ws + (wn < 2 ? O_VSLCT : O_VWINT)); hh = 2; hd = wn & 1; } else { dst = (bf16_t*)(p.ws + O_FOXVT); hh = 8; hd = (tn - 9) * 4 + wn; }
    constexpr int VLD = 136;
#pragma unroll
    for (int i = 0; i < 8; ++i) {
      const int t0 = trow0 + i * 16 + quad * 4;
      float rs[4];
#pragma unroll
      for (int r = 0; r < 4; ++r) rs[r] = rstd_from16(ssq + (size_t)(t0 + r) * 16, 1.f / 1024.f);
#pragma unroll
      for (int j = 0; j < 4; ++j)
        *(u32x2*)(stg + (j * 16 + l15) * VLD + i * 16 + quad * 4) = (u32x2){pk2(acc[i][j][0] * rs[0], acc[i][j][1] * rs[1]), pk2(acc[i][j][2] * rs[2], acc[i][j][3] * rs[3])};
    }
    const int b = trow0 >> 12, s0 = trow0 & 4095;
    stage_out<64, 128, VLD>(stg, dst + ((size_t)(b * hh + hd) * 64) * S_ + s0, (size_t)S_, lane);
  } else {
    const int slab = tn * 4 + wn;
    if (slab == 54) {
#pragma unroll
      for (int i = 0; i < 8; ++i) {
        const int t = trow0 + i * 16 + l15; const float rs = rstd_from16(ssq + (size_t)t * 16, 1.f / 1024.f);
        float* gt = (float*)(p.ws + O_GATES) + (size_t)t * 24; float* lf = (float*)(p.ws + O_LOGF) + (size_t)t * 8;
#pragma unroll
        for (int r = 0; r < 4; ++r) gt[quad * 4 + r] = sigmoidf_(acc[i][0][r] * rs);
        if (quad < 2) {
#pragma unroll
          for (int r = 0; r < 4; ++r) gt[16 + quad * 4 + r] = sigmoidf_(acc[i][1][r] * rs);
        } else {
#pragma unroll
          for (int r = 0; r < 4; ++r) { const int h = (quad - 2) * 4 + r; const float xx = acc[i][1][r] * rs + p.b_forget[layer * 8 + h]; lf[h] = fminf(xx, 0.f) - log1pf(__expf(-fabsf(xx))); }
        }
        const float* rp = (const float*)(p.ws + O_ROPE16) + (size_t)t * 32 + quad * 8; float o1[4], o2[4];
#pragma unroll
        for (int r = 0; r < 4; ++r) { const float cs = rp[2 * r], sn = rp[2 * r + 1], x1 = acc[i][2][r] * rs, x2 = acc[i][3][r] * rs; o1[r] = x1 * cs - x2 * sn; o2[r] = x2 * cs + x1 * sn; }
        bf16_t* kp = (bf16_t*)(p.ws + O_MLAKPE) + (size_t)t * 32 + quad * 4;
        *(u32x2*)kp = (u32x2){pk2(o1[0], o1[1]), pk2(o1[2], o1[3])}; *(u32x2*)(kp + 16) = (u32x2){pk2(o2[0], o2[1]), pk2(o2[2], o2[3])};
      }
    } else if (slab != 55) {
      bf16_t* dbuf; int dld, dcol, kind = 0; float qs = 1.f; int cslot = 0;
      if (slab < 8) { dbuf = (bf16_t*)(p.ws + O_NSAQ); dld = 512; dcol = slab * 64; qs = QS64_; }
      else if (slab < 12) { dbuf = (bf16_t*)(p.ws + O_KVCMP); dld = 256; dcol = (slab - 8) * 64; }
      else if (slab < 16) { dbuf = (bf16_t*)(p.ws + (slab < 14 ? O_KSLC : O_KWIN)); dld = 128; dcol = (slab & 1) * 64; kind = 1; }
      else if (slab < 28) { dbuf = (bf16_t*)(p.ws + O_FOXQ); dld = 512; dcol = (slab - 20) * 64; qs = QS64_; }
      else if (slab < 36) { dbuf = (bf16_t*)(p.ws + O_FOXK); dld = 512; dcol = (slab - 28) * 64; }
      else if (slab < 50) { dbuf = (bf16_t*)(p.ws + O_CQ); dld = 384; dcol = (slab - 44) * 64; kind = 2; cslot = slab - 44; }
      else { dbuf = (bf16_t*)(p.ws + O_CKV); dld = 256; dcol = (slab - 50) * 64; kind = 2; cslot = 8 + slab - 50; }
#pragma unroll
      for (int i = 0; i < 8; ++i) {
        const int row = i * 16 + l15, t = trow0 + row; const float rs = rstd_from16(ssq + (size_t)t * 16, 1.f / 1024.f) * qs;
        if (kind == 1) {
          const float* rp = (const float*)(p.ws + O_ROPE8) + (size_t)t * 16 + (quad & 1) * 8;
          f32x4 v, o;
#pragma unroll
          for (int r = 0; r < 4; ++r) { v[r] = acc[i][0][r] * rs; o[r] = __shfl_xor(v[r], 32); }
#pragma unroll
          for (int r = 0; r < 4; ++r) { const float cs = rp[2 * r], sn = rp[2 * r + 1]; v[r] = quad < 2 ? v[r] * cs - o[r] * sn : v[r] * cs + o[r] * sn; }
          stage4(stg, row, quad * 4, v, 1.f);
        } else stage4(stg, row, quad * 4, acc[i][0], rs);
#pragma unroll
        for (int j = 1; j < 4; ++j) stage4(stg, row, j * 16 + quad * 4, acc[i][j], rs);
        if (kind == 2) {
          float s = 0.f;
#pragma unroll
          for (int j = 0; j < 4; ++j) { const f32x4 a = acc[i][j] * rs; s += a[0] * a[0] + a[1] * a[1] + a[2] * a[2] + a[3] * a[3]; }
          s += __shfl_xor(s, 16); s += __shfl_xor(s, 32);
          if (quad == 0) ((float*)(p.ws + O_CSSQ))[(size_t)t * 16 + cslot] = s;
        }
      }
      stage_out<128, 64, STG_LD>(stg, dbuf + (size_t)trow0 * dld + dcol, (size_t)dld, lane);
    }
  }
  __syncthreads();
}
DI void phase_inproj(const Params& p, int layer, unsigned char* smem) {
  xcd_tiles(16, 14, [&](int tm, int tn) {
    const bool vt = (tn == 4 || tn == 9 || tn == 10);
    if (vt) inproj_tile<false>(p, layer, tm, tn, (bf16_t*)smem); else inproj_tile<true>(p, layer, tm, tn, (bf16_t*)smem);
  });
}

template <int KIND> DI void mlaup_tile(const Params& p, int layer, int tm, int tn, bf16_t* smem) {
  const bf16_t* wl = (const bf16_t*)(p.ws + O_W) + (size_t)layer * W_LAYER;
  f32x4 acc[8][4]; zero_acc<8, 4>(acc);
  constexpr int K = KIND == 0 ? 384 : 256;
  RowPtr ap{KIND == 0 ? (const bf16_t*)(p.ws + O_CQ) + (size_t)tm * 256 * 384 : (const bf16_t*)(p.ws + O_CKV) + (size_t)tm * 256 * 256, (size_t)K};
  RowPtr bp{KIND == 0 ? wl + W_UQ + (size_t)tn * 256 * 384 : wl + W_UKV + (size_t)(tn - 3) * 256 * 256, (size_t)K};
  gemm_main<8, 4, KIND != 2>(acc, ap, 64, bp, 64, K / 64, smem);
  const int lane = TIDX() & 63, wid = TIDX() >> 6, wm = wid >> 2, wn = wid & 3, l15 = lane & 15, quad = lane >> 4;
  const float* cssq = (const float*)(p.ws + O_CSSQ);
  bf16_t* stg = smem + wid * STG_WAVE; const int trow0 = tm * 256 + wm * 128;
  if constexpr (KIND == 2) {
    bf16_t* dst = (bf16_t*)(p.ws + O_MLAVT); const int h = (tn - 5) * 4 + wn;
    constexpr int VLD = 136;
#pragma unroll
    for (int i = 0; i < 8; ++i) {
      asm volatile("" ::: "memory");
      const int t0 = trow0 + i * 16 + quad * 4; float rs[4];
#pragma unroll
      for (int r = 0; r < 4; ++r) { const float* c = cssq + (size_t)(t0 + r) * 16 + 8; rs[r] = rsqrtf((c[0] + c[1] + c[2] + c[3]) * (1.f / 256.f) + EPS_); }
#pragma unroll
      for (int j = 0; j < 4; ++j)
        *(u32x2*)(stg + (j * 16 + l15) * VLD + i * 16 + quad * 4) = (u32x2){pk2(acc[i][j][0] * rs[0], acc[i][j][1] * rs[1]), pk2(acc[i][j][2] * rs[2], acc[i][j][3] * rs[3])};
    }
    stage_out<64, 128, VLD>(stg, dst + ((size_t)((trow0 >> 12) * 8 + h) * 64) * S_ + (trow0 & 4095), (size_t)S_, lane);
  } else if constexpr (KIND == 1) {
#pragma unroll
    for (int i = 0; i < 8; ++i) {
      asm volatile("" ::: "memory");
      const int row = i * 16 + l15, t = trow0 + row; const float* c = cssq + (size_t)t * 16;
      const float rs = rsqrtf((c[8] + c[9] + c[10] + c[11]) * (1.f / 256.f) + EPS_);
#pragma unroll
      for (int j = 0; j < 4; ++j) stage4(stg, row, j * 16 + quad * 4, acc[i][j], rs);
    }
    stage_out<128, 64, STG_LD>(stg, (bf16_t*)(p.ws + O_MLAKN) + (size_t)trow0 * 512 + (tn - 3) * 256 + wn * 64, (size_t)512, lane);
  } else {
    const int n0 = tn * 256 + wn * 64, ph = n0 % 96;
#pragma unroll
    for (int i = 0; i < 8; ++i) {
      asm volatile("" ::: "memory");
      const int row = i * 16 + l15, t = trow0 + row; const float* c = cssq + (size_t)t * 16;
      const float rs = rsqrtf((c[0] + c[1] + c[2] + c[3] + c[4] + c[5]) * (1.f / 384.f) + EPS_) * QS96_;
      f32x4 v0 = acc[i][0] * rs, v1 = acc[i][1] * rs, v2 = acc[i][2] * rs, v3 = acc[i][3] * rs;
      if (ph != 0) {
        const float* rp = (const float*)(p.ws + O_ROPE16) + (size_t)t * 32 + quad * 8;
        const f32x4 x1 = ph == 64 ? v0 : v2, x2 = ph == 64 ? v1 : v3; f32x4 o1, o2;
#pragma unroll
        for (int r = 0; r < 4; ++r) { const float cs = rp[2 * r], sn = rp[2 * r + 1]; o1[r] = x1[r] * cs - x2[r] * sn; o2[r] = x2[r] * cs + x1[r] * sn; }
        if (ph == 64) { v0 = o1; v1 = o2; } else { v2 = o1; v3 = o2; }
      }
      stage4(stg, row, quad * 4, v0, 1.f); stage4(stg, row, 16 + quad * 4, v1, 1.f); stage4(stg, row, 32 + quad * 4, v2, 1.f); stage4(stg, row, 48 + quad * 4, v3, 1.f);
    }
    stage_out<128, 64, STG_LD>(stg, (bf16_t*)(p.ws + O_MLAQ) + (size_t)trow0 * 768 + n0, (size_t)768, lane);
  }
  __syncthreads();
}
struct CmpRowPtr { const bf16_t* base; int r0;
  DI unsigned operator()(int r) const { int R = r0 + r; if (R >= 4080) R = 0; const int b = R / 510, rem = R - b * 510, n = rem >> 1, g = rem & 1; return (unsigned)(b * S_ + 16 * n) * 256u + g * 64; }
  DI bool ok(int r) const { return r0 + r < 4080; } };
DI void compress_item(const Params& p, int layer, int item, bf16_t* smem) {
  const int kv = item >> 5, tm = item & 31;
  const bf16_t* wl = (const bf16_t*)(p.ws + O_W) + (size_t)layer * W_LAYER;
  f32x4 acc[4][4]; zero_acc<4, 4>(acc);
  CmpRowPtr ap{(const bf16_t*)(p.ws + O_KVCMP) + kv * 128, tm * 128};
  RowPtr bp{wl + (kv ? W_1V : W_1K), (size_t)2048};
  gemm_main<4, 4, true>(acc, ap, 256, bp, 64, 32, smem);
  const int lane = TIDX() & 63, wid = TIDX() >> 6, wm = wid >> 2, wn = wid & 3, l15 = lane & 15, quad = lane >> 4;
  constexpr int LDH = 264; bf16_t* H = smem;
  const float* b1 = (const float*)(p.ws + O_BIAS1) + (size_t)(layer * 2 + kv) * 16 * 256;
#pragma unroll
  for (int j = 0; j < 4; ++j) {
    asm volatile("" ::: "memory");
    f32x4 bv = {0.f, 0.f, 0.f, 0.f};
    for (int pc = 0; pc < 16; ++pc) bv += *(const f32x4*)(b1 + pc * 256 + wn * 64 + j * 16 + quad * 4);
#pragma unroll
    for (int i = 0; i < 4; ++i) {
      const int row = wm * 64 + i * 16 + l15, col = wn * 64 + j * 16 + quad * 4;
      *(u32x2*)(H + row * LDH + col) = (u32x2){pk2(gelu_tanh(acc[i][j][0] + bv[0]), gelu_tanh(acc[i][j][1] + bv[1])), pk2(gelu_tanh(acc[i][j][2] + bv[2]), gelu_tanh(acc[i][j][3] + bv[3]))};
    }
  }
  __syncthreads();
  f32x4 a2[4];
#pragma unroll
  for (int j = 0; j < 4; ++j) a2[j] = (f32x4){0.f, 0.f, 0.f, 0.f};
  const bf16_t* w2 = wl + (kv ? W_2V : W_2K);
#pragma unroll
  for (int ks = 0; ks < 8; ++ks) {
    const bf16x8 a = *(const bf16x8*)(H + (wid * 16 + l15) * LDH + ks * 32 + quad * 8);
#pragma unroll
    for (int j = 0; j < 4; ++j) a2[j] = mfma16(a, *(const bf16x8*)(w2 + (size_t)(j * 16 + l15) * 256 + ks * 32 + quad * 8), a2[j]);
  }
  bf16_t* kc = (bf16_t*)(p.ws + O_KC); bf16_t* vct = (bf16_t*)(p.ws + O_VCT);
#pragma unroll
  for (int r = 0; r < 4; ++r) {
    const int R = tm * 128 + wid * 16 + quad * 4 + r;
    if (R < 4080) {
      const int b = R / 510, rem = R - b * 510, n = rem >> 1, g = rem & 1;
#pragma unroll
      for (int j = 0; j < 4; ++j) {
        const int d = j * 16 + l15; const bf16_t v = f2bf(a2[j][r]);
        if (kv == 0) kc[((size_t)(b * 2 + g) * 256 + n) * 64 + d] = v; else vct[((size_t)(b * 2 + g) * 64 + d) * 256 + n] = v;
      }
    }
  }
  __syncthreads();
}
DI void foxscan_item(const Params& p, int item, float* lds) {
  const int b = item >> 3, h = item & 7, tid = TIDX();
  const float* lf = (const float*)(p.ws + O_LOGF) + (size_t)b * S_ * 8 + h; float v[8]; float s = 0.f;
#pragma unroll
  for (int i = 0; i < 8; ++i) { s += lf[(size_t)(tid * 8 + i) * 8]; v[i] = s; }
  lds[tid] = s; __syncthreads();
  float off = 0.f;
  for (int i = 0; i < tid; ++i) off += lds[i];
  float* F2 = (float*)(p.ws + O_F2) + (size_t)(b * 8 + h) * S_ + tid * 8;
#pragma unroll
  for (int i = 0; i < 8; ++i) F2[i] = -(off + v[i]) * LOG2E_;
  __syncthreads();
}
DI void phase_b(const Params& p, int layer, unsigned char* smem) {
  if (blockIdx.x < 64) { compress_item(p, layer, blockIdx.x, (bf16_t*)smem); return; }
  for (int it = blockIdx.x - 64; it < 64; it += gridDim.x - 64) foxscan_item(p, it, (float*)smem);
  {
    const int xcd = blockIdx.x & 7, slot = (blockIdx.x >> 3) - 8, nslots = (gridDim.x >> 3) - 8;
    for (int li = slot; li < 16 * 7; li += nslots) {
      const int mg = li / 56, rem = li - mg * 56, tn = rem >> 3, tm = xcd * 16 + mg * 8 + (rem & 7);
      if (tn >= 5) mlaup_tile<2>(p, layer, tm, tn, (bf16_t*)smem); else if (tn >= 3) mlaup_tile<1>(p, layer, tm, tn, (bf16_t*)smem); else mlaup_tile<0>(p, layer, tm, tn, (bf16_t*)smem);
    }
  }
}

constexpr int KC_LD = 72, VC_LD = 264;
DI void cmp_item(const Params& p, int item, unsigned char* smem_) {
  const int b = item >> 6, g = (item >> 5) & 1, tt = item & 31, t0 = tt * 128;
  const int tid = TIDX(), lane = tid & 63, wid = tid >> 6, l15 = lane & 15, quad = lane >> 4;
  bf16_t* kcs = (bf16_t*)smem_;
  bf16_t* vcs = kcs + 256 * KC_LD;
  float* imps = (float*)smem_;
  const int nmax = (t0 + 96) >> 4;
  const int nsub = (nmax >> 4) + 1;
  {
    const bf16_t* kcg = (const bf16_t*)(p.ws + O_KC) + (size_t)(b * 2 + g) * 256 * 64; const bf16_t* vcg = (const bf16_t*)(p.ws + O_VCT) + (size_t)(b * 2 + g) * 64 * 256;
    const int nrows = ((nsub + 1) & ~1) * 16;
    for (int e = tid; e < nrows * 8; e += NTHR) {
      const int n = e >> 3, dc = (e & 7) * 8;
      *(u32x4*)(kcs + n * KC_LD + dc) = n < 255 ? *(const u32x4*)(kcg + (size_t)n * 64 + dc) : (u32x4){0u, 0u, 0u, 0u};
    }
    const int ncs = nrows >> 3;
    for (int e = tid; e < 64 * ncs; e += NTHR) {
      const int d = e / ncs, nc = (e - d * ncs) * 8;
      u32x4 v = *(const u32x4*)(vcg + (size_t)d * 256 + nc);
      if (nc + 8 > 255) v[3] &= 0x0000ffffu;
      *(u32x4*)(vcs + d * VC_LD + nc) = v;
    }
  }
  __syncthreads();
  const int tq = t0 + wid * 16 + l15;
  const size_t trow = (size_t)b * S_ + tq;
  float impa[16], p3a[16];
#pragma unroll
  for (int s = 0; s < 16; ++s) { impa[s] = 0.f; p3a[s] = 0.f; }
  const float* gts = (const float*)(p.ws + O_GATES) + trow * 24;
#pragma unroll 1
  for (int r4 = 0; r4 < 4; ++r4) {
    const int head = g * 4 + r4;
    const bf16_t* qp = (const bf16_t*)(p.ws + O_NSAQ) + trow * 512 + head * 64 + quad * 8;
    const bf16x8 q0 = *(const bf16x8*)qp, q1 = *(const bf16x8*)(qp + 32);
    auto score = [&](int s) -> f32x4 {
      const bf16_t* kr = kcs + (s * 16 + l15) * KC_LD + quad * 8;
      f32x4 a = {0.f, 0.f, 0.f, 0.f};
      a = mfma16(*(const bf16x8*)kr, q0, a); a = mfma16(*(const bf16x8*)(kr + 32), q1, a);
#pragma unroll
      for (int r = 0; r < 4; ++r) { const int n = s * 16 + quad * 4 + r; a[r] = (16 * n + 31 <= tq) ? a[r] : -INFINITY; }
      return a;
    };
    float mx = -INFINITY;
#pragma unroll 1
    for (int s = 0; s < nsub; ++s) { const f32x4 a = score(s); mx = fmaxf(mx, fmaxf(fmaxf(a[0], a[1]), fmaxf(a[2], a[3]))); }
    mx = fmaxf(mx, __shfl_xor(mx, 16)); mx = fmaxf(mx, __shfl_xor(mx, 32));
    if (mx == -INFINITY) mx = 0.f;
    float sum = 0.f;
#pragma unroll 1
    for (int s = 0; s < nsub; ++s) { const f32x4 a = score(s); sum += (ex2(a[0] - mx) + ex2(a[1] - mx)) + (ex2(a[2] - mx) + ex2(a[3] - mx)); }
    sum += __shfl_xor(sum, 16); sum += __shfl_xor(sum, 32);
    const float inv = 1.f / fmaxf(sum, 1e-30f);
    f32x4 oacc[4];
#pragma unroll
    for (int j = 0; j < 4; ++j) oacc[j] = (f32x4){0.f, 0.f, 0.f, 0.f};
#pragma unroll
    for (int c = 0; c < 8; ++c) {
      asm volatile("" ::: "memory");
      if (2 * c < nsub) {
        f32x4 pa = score(2 * c), pb = {-INFINITY, -INFINITY, -INFINITY, -INFINITY};
        if (2 * c + 1 < nsub) pb = score(2 * c + 1);
#pragma unroll
        for (int r = 0; r < 4; ++r) { pa[r] = ex2(pa[r] - mx) * inv; pb[r] = ex2(pb[r] - mx) * inv; }
        impa[2 * c] += pa[0] + pa[1] + pa[2] + 0.5f * pa[3]; p3a[2 * c] += pa[3];
        impa[2 * c + 1] += pb[0] + pb[1] + pb[2] + 0.5f * pb[3]; p3a[2 * c + 1] += pb[3];
        const u32x4 pw = {pk2(pa[0], pa[1]), pk2(pa[2], pa[3]), pk2(pb[0], pb[1]), pk2(pb[2], pb[3])};
        const bf16x8 pf = __builtin_bit_cast(bf16x8, pw);
#pragma unroll
        for (int j = 0; j < 4; ++j) {
          const bf16_t* vr = vcs + (j * 16 + l15) * VC_LD + c * 32 + quad * 4;
          const u32x2 lo = *(const u32x2*)vr, hi = *(const u32x2*)(vr + 16);
          const u32x4 vw = {lo[0], lo[1], hi[0], hi[1]};
          oacc[j] = mfma16(__builtin_bit_cast(bf16x8, vw), pf, oacc[j]);
        }
      }
    }
    const float g0 = gts[head * 3 + 0];
    bf16_t* op = (bf16_t*)(p.ws + O_ONSA) + trow * 512 + head * 64 + quad * 4;
#pragma unroll
    for (int j = 0; j < 4; ++j) store4(op + j * 16, oacc[j], g0);
  }
  __syncthreads();
  float* myimp = imps + wid * 1024 + l15 * 64;
  const int cur = tq >> 6;
#pragma unroll
  for (int s = 0; s < 16; ++s) {
    const float up = __shfl(p3a[s], (lane + 48) & 63);
    const float up0 = s ? __shfl(p3a[s ? s - 1 : 0], (lane + 48) & 63) : 0.f;
    const float prev = quad ? up : up0;
    float v = impa[s] + 0.5f * prev;
    const int j = 4 * s + quad;
    if (j == 0 || j == cur || j == cur - 1) v = 1e9f; else if (j > cur) v = -1e9f;
    myimp[j] = v;
  }
  __syncthreads();
  u64* sel = (u64*)(p.ws + O_SEL) + (size_t)(b * 2 + g) * S_ + t0 + wid * 16;
#pragma unroll 1
  for (int q = 0; q < 16; ++q) {
    const float mine = imps[wid * 1024 + q * 64 + lane]; int rank = 0;
#pragma unroll
    for (int i = 0; i < 64; ++i) { const float v = __uint_as_float(__builtin_amdgcn_readlane(__float_as_uint(mine), i)); rank += (v > mine || (v == mine && i < lane)) ? 1 : 0; }
    const u64 m = __ballot(rank < 16);
    if (lane == 0) sel[q] = m;
  }
  __syncthreads();
}
constexpr int PC_ITEMS = NB_ * 2 * 32;
DI void phase_c(const Params& p, unsigned char* smem) {
  for (int it = blockIdx.x; it < PC_ITEMS; it += gridDim.x) cmp_item(p, ((it / (int)gridDim.x) & 1) ? ((it & ~31) | (31 - (it & 31))) : it, smem);
}

enum { M_FOX = 0, M_MLA = 1, M_WIN = 2, M_SLC = 3 };
template <int MODE> struct ACfg { static constexpr int DQK = MODE == M_MLA ? 96 : 64, KLD = DQK + 8, NKC = DQK / 8 * 64, KCH = (NKC + NTHR - 1) / NTHR, K_ELEMS = 64 * KLD, V_ELEMS = 64 * 72, STAGE = K_ELEMS + V_ELEMS + 128; };
struct AState { f32x16 o[2]; f32x16 mr; float m, l; };

template <int MODE>
DI void flash_pass(AState& st, const bf16x8* qf, u64 tmask, u64 wmask,
                   const bf16_t* kbase, size_t kld, const bf16_t* kpe, const bf16_t* vtbase, const float* fbias,
                   int tq, u64 mysel, bf16_t* smem) {
  typedef ACfg<MODE> C;
  typedef std::integral_constant<int, 0> S0; typedef std::integral_constant<int, 1> S1;
  const int tid = TIDX(), lane = tid & 63, l31 = lane & 31, half = lane >> 5;
  u32x4 rk[2][C::KCH], rv[2]; float rf[2] = {0.f, 0.f};
  auto gload = [&](int j, auto setc) {
    constexpr int S = decltype(setc)::value;
    const int k0 = j * 64;
#pragma unroll
    for (int i = 0; i < C::KCH; ++i) {
      const int c0 = tid + NTHR * i, c = c0 < C::NKC ? c0 : C::NKC - 1;
      if constexpr (MODE == M_MLA) {
        const int key = c / 12, dc = c % 12;
        const bf16_t* src = dc < 8 ? kbase + (size_t)(k0 + key) * kld + dc * 8 : kpe + (size_t)(k0 + key) * 32 + (dc - 8) * 8;
        rk[S][i] = *(const u32x4*)src;
      } else { const int key = c >> 3, dc = c & 7; rk[S][i] = *(const u32x4*)(kbase + (size_t)(k0 + key) * kld + dc * 8); }
    }
    { const int d = tid >> 3, kc = tid & 7; rv[S] = *(const u32x4*)(vtbase + (size_t)d * S_ + k0 + kc * 8); }
    if constexpr (MODE == M_FOX) rf[S] = fbias[k0 + (tid & 63)];
  };
  auto sstore = [&](int stg, auto setc) {
    constexpr int S = decltype(setc)::value;
    bf16_t* Ks = smem + stg * C::STAGE; bf16_t* Vs = Ks + C::K_ELEMS;
#pragma unroll
    for (int i = 0; i < C::KCH; ++i) {
      const int c = tid + NTHR * i;
      if (c < C::NKC) {
        if constexpr (MODE == M_MLA) { const int key = c / 12, dc = c % 12; *(u32x4*)(Ks + key * C::KLD + dc * 8) = rk[S][i]; }
        else { const int key = c >> 3, dc = c & 7; *(u32x4*)(Ks + key * C::KLD + dc * 8) = rk[S][i]; }
      }
    }
    {
      const int d = tid >> 3, kc = tid & 7, cgp = kc >> 1, a = kc & 1;
      bf16_t* dst = Vs + d * 72 + cgp * 16 + 4 * a;
      *(u32x2*)dst = (u32x2){rv[S][0], rv[S][1]}; *(u32x2*)(dst + 8) = (u32x2){rv[S][2], rv[S][3]};
    }
    if constexpr (MODE == M_FOX) { if (tid < 64) ((float*)(Vs + C::V_ELEMS))[tid] = rf[S]; }
  };
  const int tmin = __builtin_amdgcn_readfirstlane(tq - l31), tmax = tmin + 31;
  auto compute = [&](int j, int stg) {
    bool active = (wmask >> j) & 1;
    if constexpr (MODE == M_SLC) active = active && __any((mysel >> j) & 1);
    if (active) {
      const bf16_t* Ks = smem + stg * C::STAGE; const bf16_t* Vs = Ks + C::K_ELEMS;
      f32x16 s0 = st.mr, s1 = st.mr;
      const bf16_t* kr = Ks + l31 * C::KLD + half * 8;
#pragma unroll
      for (int ks = 0; ks < C::DQK / 16; ++ks) {
        s0 = mfma32(*(const bf16x8*)(kr + ks * 16), qf[ks], s0);
        s1 = mfma32(*(const bf16x8*)(kr + 32 * C::KLD + ks * 16), qf[ks], s1);
      }
      const int k0 = j * 64;
      if constexpr (MODE == M_FOX) {
        const float* fb = (const float*)(Vs + C::V_ELEMS) + 4 * half;
#pragma unroll
        for (int g4 = 0; g4 < 4; ++g4) {
          const f32x4 b0 = *(const f32x4*)(fb + 8 * g4), b1 = *(const f32x4*)(fb + 32 + 8 * g4);
#pragma unroll
          for (int r = 0; r < 4; ++r) { s0[4 * g4 + r] += b0[r]; s1[4 * g4 + r] += b1[r]; }
        }
      }
      bool need = k0 + 63 > tmin;
      if constexpr (MODE == M_WIN) need = need || (k0 <= tmax - 512);
      if constexpr (MODE == M_SLC) {
        if (!need) {
          const bool rsel = ((mysel >> j) & 1) != 0;
          if (!__all(rsel)) {
#pragma unroll
            for (int r = 0; r < 16; ++r) { s0[r] = rsel ? s0[r] : -INFINITY; s1[r] = rsel ? s1[r] : -INFINITY; }
          }
        }
      }
      if (need) {
        const bool rowok = MODE == M_SLC ? ((mysel >> j) & 1) != 0 : true;
#pragma unroll
        for (int r = 0; r < 16; ++r) {
          const int key = k0 + (r & 3) + 8 * (r >> 2) + 4 * half;
          bool ok0 = rowok && key <= tq, ok1 = rowok && key + 32 <= tq;
          if constexpr (MODE == M_WIN) { ok0 = ok0 && (tq - key < 512); ok1 = ok1 && (tq - key - 32 < 512); }
          s0[r] = ok0 ? s0[r] : -INFINITY; s1[r] = ok1 ? s1[r] : -INFINITY;
        }
      }
      int im = (int)0x80000000;
#pragma unroll
      for (int r = 0; r < 16; ++r) im = max(im, max(__float_as_int(s0[r]), __float_as_int(s1[r])));
      im = max(im, __shfl_xor(im, 32));
      constexpr int TBITS = 0x41200000;
      f32x16 e0, e1;
#pragma unroll
      for (int r = 0; r < 16; ++r) { e0[r] = ex2(s0[r]); e1[r] = ex2(s1[r]); }
      if (__any(im > TBITS)) {
        const float d = im > TBITS ? __int_as_float(im) : 0.f;
        const float a = ex2(-d);
#pragma unroll
        for (int r = 0; r < 16; ++r) { e0[r] = ex2(s0[r] - d); e1[r] = ex2(s1[r] - d); st.o[0][r] *= a; st.o[1][r] *= a; }
        st.l *= a; st.m += d;
#pragma unroll
        for (int r = 0; r < 16; ++r) st.mr[r] = -st.m;
      }
      float sum = 0.f;
#pragma unroll
      for (int r = 0; r < 16; ++r) { s0[r] = e0[r]; s1[r] = e1[r]; sum += e0[r] + e1[r]; }
      st.l += sum;
      const bf16_t* vr = Vs + l31 * 72 + half * 8;
#pragma unroll
      for (int c = 0; c < 4; ++c) {
        u32x4 pw;
        if (c < 2) pw = (u32x4){pk2(s0[8 * c + 0], s0[8 * c + 1]), pk2(s0[8 * c + 2], s0[8 * c + 3]), pk2(s0[8 * c + 4], s0[8 * c + 5]), pk2(s0[8 * c + 6], s0[8 * c + 7])};
        else pw = (u32x4){pk2(s1[8 * (c - 2) + 0], s1[8 * (c - 2) + 1]), pk2(s1[8 * (c - 2) + 2], s1[8 * (c - 2) + 3]), pk2(s1[8 * (c - 2) + 4], s1[8 * (c - 2) + 5]), pk2(s1[8 * (c - 2) + 6], s1[8 * (c - 2) + 7])};
        const bf16x8 pf = __builtin_bit_cast(bf16x8, pw);
        st.o[0] = mfma32(*(const bf16x8*)(vr + c * 16), pf, st.o[0]);
        st.o[1] = mfma32(*(const bf16x8*)(vr + 32 * 72 + c * 16), pf, st.o[1]);
      }
    }
  };
  u64 tm = tmask;
  if (tm == 0) return;
  auto pop = [&]() -> int { if (!tm) return -1; const int j = __builtin_ctzll(tm); tm &= tm - 1; return j; };
  int t0 = pop(), t1 = pop(), t2 = pop(), t3 = pop();
  gload(t0, S0{}); gload(t1 >= 0 ? t1 : t0, S1{});
  sstore(0, S0{}); sstore(1, S1{});
  gload(t2 >= 0 ? t2 : t0, S0{}); gload(t3 >= 0 ? t3 : t0, S1{});
  __syncthreads();
  int stg = 0;
  auto step = [&](auto setc) -> bool {
    const int t4 = pop();
    sstore(stg == 0 ? 2 : stg - 1, setc);
    gload(t4 >= 0 ? t4 : t0, setc);
    __builtin_amdgcn_sched_barrier(0);
    compute(t0, stg);
    __syncthreads();
    if (t1 < 0) return true;
    t0 = t1; t1 = t2; t2 = t3; t3 = t4; stg = stg == 2 ? 0 : stg + 1;
    return false;
  };
  for (;;) {
    if (step(S0{})) break;
    if (step(S1{})) break;
  }
}
DI void astate_init(AState& s) {
#pragma unroll
  for (int r = 0; r < 16; ++r) { s.o[0][r] = 0.f; s.o[1][r] = 0.f; }
#pragma unroll
  for (int r = 0; r < 16; ++r) s.mr[r] = 0.f;
  s.m = 0.f; s.l = 0.f;
}
DI u64 lowbits(int n) { return n >= 64 ? ~0ull : ((1ull << n) - 1ull); }

template <int MODE> DI void dense_attn_item(const Params& p, int b, int h, int qt, bf16_t* smem) {
  const int lane = TIDX() & 63, wid = TIDX() >> 6, l31 = lane & 31, half = lane >> 5;
  const int t0 = qt * 256, tq = t0 + wid * 32 + l31; const size_t trow = (size_t)b * S_ + tq;
  constexpr int NQ = ACfg<MODE>::DQK / 16;
  bf16x8 qf[NQ];
  const bf16_t* qp = MODE == M_FOX ? (const bf16_t*)(p.ws + O_FOXQ) + trow * 512 + h * 64 : (const bf16_t*)(p.ws + O_MLAQ) + trow * 768 + h * 96;
#pragma unroll
  for (int ks = 0; ks < NQ; ++ks) qf[ks] = *(const bf16x8*)(qp + ks * 16 + half * 8);
  AState st; astate_init(st);
  const u64 tmask = lowbits(4 * qt + 4), wmask = lowbits(((t0 + wid * 32 + 31) >> 6) + 1);
  if constexpr (MODE == M_FOX)
    flash_pass<M_FOX>(st, qf, tmask, wmask, (const bf16_t*)(p.ws + O_FOXK) + (size_t)b * S_ * 512 + h * 64, 512, nullptr,
                      (const bf16_t*)(p.ws + O_FOXVT) + (size_t)(b * 8 + h) * 64 * S_, (const float*)(p.ws + O_F2) + (size_t)(b * 8 + h) * S_, tq, 0ull, smem);
  else
    flash_pass<M_MLA>(st, qf, tmask, wmask, (const bf16_t*)(p.ws + O_MLAKN) + (size_t)b * S_ * 512 + h * 64, 512, (const bf16_t*)(p.ws + O_MLAKPE) + (size_t)b * S_ * 32,
                      (const bf16_t*)(p.ws + O_MLAVT) + (size_t)(b * 8 + h) * 64 * S_, nullptr, tq, 0ull, smem);
  const float l = st.l + __shfl_xor(st.l, 32), inv = 1.f / fmaxf(l, 1e-30f);
  bf16_t* op = (bf16_t*)qp;
#pragma unroll
  for (int dt = 0; dt < 2; ++dt)
#pragma unroll
    for (int g4 = 0; g4 < 4; ++g4) {
      const int d = dt * 32 + g4 * 8 + half * 4;
      *(u32x2*)(op + d) = (u32x2){pk2(st.o[dt][4 * g4] * inv, st.o[dt][4 * g4 + 1] * inv), pk2(st.o[dt][4 * g4 + 2] * inv, st.o[dt][4 * g4 + 3] * inv)};
    }
}
DI void nsa_attn_item(const Params& p, int b, int g, int qt, bf16_t* smem) {
  const int lane = TIDX() & 63, wid = TIDX() >> 6, l31 = lane & 31, half = lane >> 5;
  const int t0 = qt * 64, tw0 = t0 + (wid >> 2) * 32, tq = tw0 + l31, head = g * 4 + (wid & 3); const size_t trow = (size_t)b * S_ + tq;
  bf16x8 qf[4];
  const bf16_t* qp = (const bf16_t*)(p.ws + O_NSAQ) + trow * 512 + head * 64;
#pragma unroll
  for (int ks = 0; ks < 4; ++ks) qf[ks] = *(const bf16x8*)(qp + ks * 16 + half * 8);
  {
    const float* rp = (const float*)(p.ws + O_ROPE8) + trow * 16;
    u32x4 me = __builtin_bit_cast(u32x4, qf[0]), ot;
#pragma unroll
    for (int e = 0; e < 4; ++e) ot[e] = __shfl_xor(me[e], 32);
    unsigned res[4];
#pragma unroll
    for (int e = 0; e < 4; ++e) {
      float o2[2];
#pragma unroll
      for (int u = 0; u < 2; ++u) {
        const int f = 2 * e + u; const float cs = rp[2 * f], sn = rp[2 * f + 1];
        const float a = bf2f((bf16_t)(u ? me[e] >> 16 : me[e] & 0xffffu)), o = bf2f((bf16_t)(u ? ot[e] >> 16 : ot[e] & 0xffffu));
        o2[u] = half == 0 ? a * cs - o * sn : a * cs + o * sn;
      }
      res[e] = pk2(o2[0], o2[1]);
    }
    qf[0] = __builtin_bit_cast(bf16x8, (u32x4){res[0], res[1], res[2], res[3]});
  }
  const float* gts = (const float*)(p.ws + O_GATES) + trow * 24 + head * 3;
  const int cur = t0 >> 6;
  f32x16 res[2];
  {
    AState st; astate_init(st);
    const int first = t0 >= 511 ? (t0 - 511) >> 6 : 0, firstw = tw0 >= 511 ? (tw0 - 511) >> 6 : 0;
    const u64 tmask = lowbits(cur + 1) & ~lowbits(first), wmask = lowbits(cur + 1) & ~lowbits(firstw);
    flash_pass<M_WIN>(st, qf, tmask, wmask, (const bf16_t*)(p.ws + O_KWIN) + (size_t)b * S_ * 128 + g * 64, 128, nullptr,
                      (const bf16_t*)(p.ws + O_VWINT) + (size_t)(b * 2 + g) * 64 * S_, nullptr, tq, 0ull, smem);
    const float l = st.l + __shfl_xor(st.l, 32), sc = gts[2] / fmaxf(l, 1e-30f);
#pragma unroll
    for (int r = 0; r < 16; ++r) { res[0][r] = st.o[0][r] * sc; res[1][r] = st.o[1][r] * sc; }
  }
  {
    AState st; astate_init(st);
    const u64* selp = (const u64*)(p.ws + O_SEL) + (size_t)(b * 2 + g) * S_;
    const u64 mysel = selp[tq];
    const u64 m64 = selp[t0 + lane];
    unsigned lo = (unsigned)m64, hi = (unsigned)(m64 >> 32);
#pragma unroll
    for (int o = 32; o >= 1; o >>= 1) { lo |= __shfl_xor(lo, o); hi |= __shfl_xor(hi, o); }
    const u64 um = (((u64)(unsigned)__builtin_amdgcn_readfirstlane(hi) << 32) | (u64)(unsigned)__builtin_amdgcn_readfirstlane(lo)) & lowbits(cur + 1);
    flash_pass<M_SLC>(st, qf, um, um, (const bf16_t*)(p.ws + O_KSLC) + (size_t)b * S_ * 128 + g * 64, 128, nullptr,
                      (const bf16_t*)(p.ws + O_VSLCT) + (size_t)(b * 2 + g) * 64 * S_, nullptr, tq, mysel, smem);
    const float l = st.l + __shfl_xor(st.l, 32), sc = gts[1] / fmaxf(l, 1e-30f);
#pragma unroll
    for (int r = 0; r < 16; ++r) { res[0][r] += st.o[0][r] * sc; res[1][r] += st.o[1][r] * sc; }
  }
  bf16_t* op = (bf16_t*)(p.ws + O_ONSA) + trow * 512 + head * 64;
#pragma unroll
  for (int dt = 0; dt < 2; ++dt)
#pragma unroll
    for (int g4 = 0; g4 < 4; ++g4) {
      const int d = dt * 32 + g4 * 8 + half * 4;
      const u32x2 oc = *(const u32x2*)(op + d);
      const float c0 = bf2f((bf16_t)(oc[0] & 0xffffu)), c1 = bf2f((bf16_t)(oc[0] >> 16)), c2 = bf2f((bf16_t)(oc[1] & 0xffffu)), c3 = bf2f((bf16_t)(oc[1] >> 16));
      *(u32x2*)(op + d) = (u32x2){pk2(res[dt][4 * g4] + c0, res[dt][4 * g4 + 1] + c1), pk2(res[dt][4 * g4 + 2] + c2, res[dt][4 * g4 + 3] + c3)};
    }
}
constexpr int PD_ITEMS = 16 * 192;
DI void phase_d(const Params& p, int layer, unsigned char* smem) {
  unsigned* qctr = (unsigned*)(p.ws + O_BAR) + 130 + layer;
  int* s_it = (int*)(smem + SMEM_BYTES - 16);
  for (;;) {
    if (TIDX() == 0) *s_it = (int)atomicAdd(qctr, 1u);
    __syncthreads();
    const int it = *s_it;
    __syncthreads();
    if (it >= PD_ITEMS) break;
    const int r = it / 192, w = it % 192, qt = 15 - r;
    if (w < 64) dense_attn_item<M_MLA>(p, w >> 3, w & 7, qt, (bf16_t*)smem);
    else if (w < 128) dense_attn_item<M_FOX>(p, (w - 64) >> 3, (w - 64) & 7, qt, (bf16_t*)smem);
    else { const int i = w - 128, bg = i & 15, q4 = i >> 4; nsa_attn_item(p, bg >> 1, bg & 1, qt * 4 + q4, (bf16_t*)smem); }
  }
}

DI void merge_tile(const Params& p, int layer, int tm, int tn, bf16_t* smem) {
  typedef GemmLds<8, 2> L;
  const bf16_t* wl = (const bf16_t*)(p.ws + O_W) + (size_t)layer * W_LAYER;
  const int tid = TIDX(), lane = tid & 63, wid = tid >> 6, wm = wid >> 2, wn = wid & 3, l15 = lane & 15, quad = lane >> 4;
  f32x4 mg[8][2]; zero_acc<8, 2>(mg);
  f32x4 acc[8][2]; zero_acc<8, 2>(acc);
  unsigned* gsp = (unsigned*)((unsigned char*)smem + 2 * L::STAGE * 2) + tid;
  const bf16_t* la; const bf16_t* lb; unsigned lald, lbld; int laks, lnk;
  auto get_seg = [&](int sg) {
    const int br = sg >> 1;
    if ((sg & 1) == 0) { la = (const bf16_t*)(p.ws + O_XG) + (size_t)tm * 256 * D_; lald = D_; laks = 64; lb = wl + W_G + ((size_t)br * 1024 + tn * 128) * D_; lbld = D_; lnk = 16; }
    else {
      lald = br == 2 ? 768u : 512u; laks = br == 2 ? 96 : 64; lnk = 8; lbld = 512u;
      la = (const bf16_t*)(p.ws + (br == 0 ? O_ONSA : br == 1 ? O_FOXQ : O_MLAQ)) + (size_t)tm * 256 * lald;
      lb = wl + (br == 0 ? W_BN : br == 1 ? W_BF : W_BM) + (size_t)tn * 128 * 512;
    }
  };
  unsigned pa0, pb0; u32x4 ra[4], rb[2];
  auto set_offsets = [&]() { pa0 = (unsigned)(tid >> 3) * lald + (tid & 7) * 8; pb0 = (unsigned)(tid >> 3) * lbld + (tid & 7) * 8; };
  int ls = 0, lkt = 0;
  get_seg(0); set_offsets();
  auto gload_next = [&]() {
    const bf16_t* ab = la + (size_t)lkt * laks; const bf16_t* bb = lb + (size_t)lkt * 64;
#pragma unroll
    for (int i = 0; i < 4; ++i) ra[i] = *(const u32x4*)(ab + pa0 + (size_t)i * 64 * lald);
#pragma unroll
    for (int i = 0; i < 2; ++i) rb[i] = *(const u32x4*)(bb + pb0 + (size_t)i * 64 * lbld);
    if (++lkt == lnk) {
      if (ls + 1 < 6) { ++ls; lkt = 0; get_seg(ls); set_offsets(); } else lkt = lnk - 1;
    }
  };
  auto sstore = [&](int buf) {
    bf16_t* As = smem + buf * L::STAGE; bf16_t* Bs = As + L::A_ELEMS;
#pragma unroll
    for (int i = 0; i < 4; ++i) { const int c = tid + NTHR * i; *(u32x4*)(As + (c >> 3) * LDT + (c & 7) * 8) = ra[i]; }
#pragma unroll
    for (int i = 0; i < 2; ++i) { const int c = tid + NTHR * i; *(u32x4*)(Bs + (c >> 3) * LDT + (c & 7) * 8) = rb[i]; }
  };
  gload_next(); sstore(0); gload_next(); __syncthreads();
  int buf = 0;
#pragma unroll 1
  for (int sg = 0; sg < 6; ++sg) {
    const int nk = (sg & 1) ? 8 : 16;
#pragma unroll 1
    for (int kt = 0; kt < nk; ++kt) {
      sstore(buf ^ 1);
      gload_next();
      __builtin_amdgcn_sched_barrier(0);
      const bf16_t* As = smem + buf * L::STAGE + (wm * 128 + l15) * LDT + quad * 8;
      const bf16_t* Bs = smem + buf * L::STAGE + L::A_ELEMS + (wn * 32 + l15) * LDT + quad * 8;
#pragma unroll
      for (int ks = 0; ks < 2; ++ks) {
        if (ks == 1) asm volatile("" ::: "memory");
        bf16x8 b[2];
#pragma unroll
        for (int j = 0; j < 2; ++j) b[j] = *(const bf16x8*)(Bs + j * 16 * LDT + ks * 32);
#pragma unroll
        for (int i = 0; i < 8; ++i) {
          const bf16x8 a = *(const bf16x8*)(As + i * 16 * LDT + ks * 32);
#pragma unroll
          for (int j = 0; j < 2; ++j) acc[i][j] = mfma16(b[j], a, acc[i][j]);
        }
      }
      __syncthreads();
      buf ^= 1;
    }
    if ((sg & 1) == 0) {
      const int t2 = TIDX(), row0 = tm * 256 + ((t2 >> 8) & 1) * 128 + (t2 & 15);
#pragma unroll
      for (int i = 0; i < 8; ++i) {
        asm volatile("" ::: "memory");
        const float rs = rstd_from16((const float*)(p.ws + O_SSQ) + (size_t)(row0 + i * 16) * 16, 1.f / 1024.f);
#pragma unroll
        for (int j = 0; j < 2; ++j) {
          unsigned w = 0;
#pragma unroll
          for (int r = 0; r < 4; ++r) w |= (unsigned)__float2int_rn(sigmoidf_(acc[i][j][r] * rs) * 255.f) << (8 * r);
          gsp[(i * 2 + j) * NTHR] = w;
        }
      }
    } else {
#pragma unroll
      for (int i = 0; i < 8; ++i)
#pragma unroll
        for (int j = 0; j < 2; ++j) {
          asm volatile("" ::: "memory");
          const unsigned w = gsp[(i * 2 + j) * NTHR];
#pragma unroll
          for (int r = 0; r < 4; ++r) mg[i][j][r] += (float)((w >> (8 * r)) & 0xffu) * (1.f / 255.f) * acc[i][j][r];
        }
    }
    zero_acc<8, 2>(acc);
  }
  const int t3 = TIDX(), lane3 = t3 & 63, wid3 = t3 >> 6;
  bf16_t* stg = smem + wid3 * (128 * 40);
#pragma unroll
  for (int i = 0; i < 8; ++i)
#pragma unroll
    for (int j = 0; j < 2; ++j) *(u32x2*)(stg + (i * 16 + (lane3 & 15)) * 40 + j * 16 + (lane3 >> 4) * 4) = (u32x2){pk2(mg[i][j][0], mg[i][j][1]), pk2(mg[i][j][2], mg[i][j][3])};
  stage_out<128, 32, 40>(stg, (bf16_t*)(p.ws + O_MERGED) + (size_t)(tm * 256 + (wid3 >> 2) * 128) * D_ + tn * 128 + (wid3 & 3) * 32, (size_t)D_, lane3);
  __syncthreads();
}
DI void phase_e(const Params& p, int layer, unsigned char* smem) {
  xcd_tiles(16, 8, [&](int tm, int tn) { merge_tile(p, layer, tm, tn, (bf16_t*)smem); });
}

DI void resid_tile(const Params& p, const bf16_t* A, int K, const bf16_t* W, const float* xold, const float* gnext, int tm, int tn, bf16_t* smem) {
  f32x4 acc[8][4]; zero_acc<8, 4>(acc);
  RowPtr ap{A + (size_t)tm * 256 * K, (size_t)K}, bp{W + (size_t)tn * 256 * K, (size_t)K};
  gemm_main<8, 4, true>(acc, ap, 64, bp, 64, K / 64, smem);
  const int lane = TIDX() & 63, wid = TIDX() >> 6, wm = wid >> 2, wn = wid & 3, l15 = lane & 15, quad = lane >> 4;
  bf16_t* stg = smem + wid * STG_WAVE;
#pragma unroll
  for (int i = 0; i < 8; ++i) {
    const int t = tm * 256 + wm * 128 + i * 16 + l15, c0 = tn * 256 + wn * 64 + quad * 4; float s = 0.f;
#pragma unroll
    for (int j = 0; j < 4; ++j) {
      const size_t off = (size_t)t * D_ + c0 + j * 16;
      const f32x4 xn = *(const f32x4*)(xold + off) + acc[i][j];
      *(f32x4*)(p.out + off) = xn;
      s += xn[0] * xn[0] + xn[1] * xn[1] + xn[2] * xn[2] + xn[3] * xn[3];
      if (gnext) { const f32x4 gv = *(const f32x4*)(gnext + c0 + j * 16); *(u32x2*)(stg + (i * 16 + l15) * STG_LD + j * 16 + quad * 4) = (u32x2){pk2(xn[0] * gv[0], xn[1] * gv[1]), pk2(xn[2] * gv[2], xn[3] * gv[3])}; }
    }
    s += __shfl_xor(s, 16); s += __shfl_xor(s, 32);
    if (quad == 0) ((float*)(p.ws + O_SSQ))[(size_t)t * 16 + tn * 4 + wn] = s;
  }
  if (gnext) stage_out<128, 64, STG_LD>(stg, (bf16_t*)(p.ws + O_XG) + (size_t)(tm * 256 + wm * 128) * D_ + tn * 256 + wn * 64, (size_t)D_, lane);
  __syncthreads();
}
DI void phase_f(const Params& p, int layer, unsigned char* smem) {
  const bf16_t* wl = (const bf16_t*)(p.ws + O_W) + (size_t)layer * W_LAYER;
  xcd_tiles(16, 4, [&](int tm, int tn) { resid_tile(p, (const bf16_t*)(p.ws + O_MERGED), 1024, wl + W_OUT, layer == 0 ? p.x : p.out, p.ffn_norm + layer * D_, tm, tn, (bf16_t*)smem); });
}
DI void phase_h(const Params& p, int layer, unsigned char* smem) {
  const bf16_t* wl = (const bf16_t*)(p.ws + O_W) + (size_t)layer * W_LAYER;
  xcd_tiles(16, 4, [&](int tm, int tn) { resid_tile(p, (const bf16_t*)(p.ws + O_ACT), DFF_, wl + W_DN, p.out, layer == 0 ? p.mix_norm + D_ : nullptr, tm, tn, (bf16_t*)smem); });
}

struct UpRowPtr { const bf16_t* base; int s0;
  DI unsigned operator()(int r) const { const int s = s0 + r; return (unsigned)((s < 0 || s >= S_) ? 0 : s) * (unsigned)D_; }
  DI bool ok(int r) const { const int s = s0 + r; return s >= 0 && s < S_; } };
constexpr int PG_MT = 17;
DI void ffnup_tile(const Params& p, int layer, int b, int mt, int tn, bf16_t* smem) {
  const bf16_t* wl = (const bf16_t*)(p.ws + O_W) + (size_t)layer * W_LAYER;
  f32x4 acc[8][4]; zero_acc<8, 4>(acc);
  const int s0 = 254 * mt - 2;
  UpRowPtr ap{(const bf16_t*)(p.ws + O_XG) + (size_t)b * S_ * D_, s0}; RowPtr bp{wl + W_UP + (size_t)tn * 256 * D_, (size_t)D_};
  gemm_main<8, 4, true>(acc, ap, 64, bp, 64, 16, smem);
  const int tid = TIDX(), lane = tid & 63, wid = tid >> 6, wm = wid >> 2, wn = wid & 3, l15 = lane & 15, quad = lane >> 4;
  constexpr int LDU = 136; bf16_t* U = smem; bf16_t* V = smem + 256 * LDU;
  {
    bf16_t* dstb = (wn < 2 ? U : V) + (wn & 1) * 64 + quad * 4;
#pragma unroll
    for (int i = 0; i < 8; ++i) {
      const int row = wm * 128 + i * 16 + l15, s = s0 + row;
      const float rs = (s >= 0 && s < S_) ? rstd_from16((const float*)(p.ws + O_SSQ) + ((size_t)b * S_ + s) * 16, 1.f / 1024.f) : 0.f;
#pragma unroll
      for (int j = 0; j < 4; ++j) store4(dstb + row * LDU + j * 16, acc[i][j], rs);
    }
  }
  __syncthreads();
  {
    const int cc = tid & 15, cg0 = tn * 128 + cc * 8;
    const float* cw = p.conv_w + (size_t)layer * 3 * DFF_ + cg0; const float* cbp = p.conv_b + (size_t)layer * DFF_ + cg0;
    float w0[8], w1[8], w2[8], cb[8];
#pragma unroll
    for (int e = 0; e < 8; ++e) { w0[e] = cw[e]; w1[e] = cw[DFF_ + e]; w2[e] = cw[2 * DFF_ + e]; cb[e] = cbp[e]; }
    bf16_t* act = (bf16_t*)(p.ws + O_ACT);
#pragma unroll 2
    for (int it = 0; it < 8; ++it) {
      const int row = it * 32 + (tid >> 4), s = s0 + row;
      if (row >= 2 && s < S_) {
        const u32x4 u0 = *(const u32x4*)(U + (row - 2) * LDU + cc * 8), u1 = *(const u32x4*)(U + (row - 1) * LDU + cc * 8), u2 = *(const u32x4*)(U + row * LDU + cc * 8), vv = *(const u32x4*)(V + row * LDU + cc * 8);
        unsigned o[4];
#pragma unroll
        for (int e = 0; e < 4; ++e) {
          float r2[2];
#pragma unroll
          for (int h = 0; h < 2; ++h) {
            const int k = 2 * e + h;
            const float a0 = bf2f((bf16_t)(h ? u0[e] >> 16 : u0[e] & 0xffffu)), a1 = bf2f((bf16_t)(h ? u1[e] >> 16 : u1[e] & 0xffffu)), a2 = bf2f((bf16_t)(h ? u2[e] >> 16 : u2[e] & 0xffffu)), vx = bf2f((bf16_t)(h ? vv[e] >> 16 : vv[e] & 0xffffu));
            const float uc = w0[k] * a0 + w1[k] * a1 + w2[k] * a2 + cb[k];
            r2[h] = uc * sigmoidf_(uc) * vx;
          }
          o[e] = pk2(r2[0], r2[1]);
        }
        __builtin_nontemporal_store((u32x4){o[0], o[1], o[2], o[3]}, (u32x4*)(act + ((size_t)b * S_ + s) * DFF_ + cg0));
      }
    }
  }
  __syncthreads();
}
DI void phase_g(const Params& p, int layer, unsigned char* smem) {
  xcd_tiles(PG_MT, 22, [&](int tmg, int tn) { ffnup_tile(p, layer, tmg / PG_MT, tmg % PG_MT, tn, (bf16_t*)smem); });
}

DI void phase_final(const Params& p) {
  const int lane = TIDX() & 63, wid = TIDX() >> 6;
  for (int it = blockIdx.x; it < T_ / 8; it += gridDim.x) {
    const int t = it * 8 + wid; const float rs = rstd_from16((const float*)(p.ws + O_SSQ) + (size_t)t * 16, 1.f / 1024.f);
    float* xr = p.out + (size_t)t * D_;
#pragma unroll
    for (int c = 0; c < 4; ++c) { const int k = c * 256 + lane * 4; const f32x4 v = *(const f32x4*)(xr + k), gv = *(const f32x4*)(p.final_norm + k); *(f32x4*)(xr + k) = v * rs * gv; }
  }
}

#define XB_TMO      128
#define XB_XCNT(j)  (256  + 64 * (j))
#define XB_XSUB(j)  (1280 + 64 * (j))
#define XB_XGEN(j)  (2304 + 64 * (j))
#define XB_TOP      3328
#define XB_TOPGEN   3392
#define XCD_BAR_WORDS 3456
#define XB_SPIN_CAP (1u << 22)
#define LAS __attribute__((address_space(3)))
DI unsigned xb_ld(unsigned* p)              { return __hip_atomic_load(p, __ATOMIC_RELAXED, __HIP_MEMORY_SCOPE_AGENT); }
DI unsigned xb_add(unsigned* p, unsigned v) { return __hip_atomic_fetch_add(p, v, __ATOMIC_RELAXED, __HIP_MEMORY_SCOPE_AGENT); }
DI unsigned xb_xcc_id() { return (unsigned)__builtin_amdgcn_s_getreg((3 << 11) | 20) & 0xFu; }
#define XB_SPIN(cond, bar) do { unsigned _sp = 0; while (cond) { __builtin_amdgcn_s_sleep(1); \
    if ((++_sp & 255u) == 0u) { if (xb_ld(&(bar)[XB_TMO])) break; if (_sp > XB_SPIN_CAP) { atomicAdd(&(bar)[XB_TMO], 1u); break; } } } } while (0)
struct XcdBarrier { unsigned* bar; unsigned x; volatile LAS unsigned* st; };
DI XcdBarrier xcd_barrier_post(unsigned* bar, volatile LAS unsigned* st) {
  XcdBarrier b; b.bar = bar; b.x = xb_xcc_id(); b.st = st;
  if (threadIdx.x == 0) (void)xb_add(&bar[XB_XCNT(b.x)], 1u);
  return b;
}
DI void xcd_barrier_complete(unsigned* bar, unsigned x, unsigned& nloc, unsigned& nx) {
  const unsigned G = gridDim.x * gridDim.y * gridDim.z;
  unsigned sum, cnt, mine, sp = 0u;
  for (;;) {
    sum = 0u; cnt = 0u; mine = 0u;
#pragma unroll
    for (unsigned j = 0; j < 16; ++j) { const unsigned c = xb_ld(&bar[XB_XCNT(j)]); sum += c; cnt += (c > 0u) ? 1u : 0u; mine = (j == x) ? c : mine; }
    if (sum == G) break;
    __builtin_amdgcn_s_sleep(1);
    if ((++sp & 255u) == 0u) { if (xb_ld(&bar[XB_TMO])) break; if (sp > XB_SPIN_CAP) { atomicAdd(&bar[XB_TMO], 1u); break; } }
  }
  nloc = mine > 0u ? mine : 1u; nx = cnt > 0u ? cnt : 1u;
}
DI void xcd_barrier(const XcdBarrier& b) {
  asm volatile("s_waitcnt vmcnt(0)" ::: "memory");
  __syncthreads();
  if (threadIdx.x == 0) {
    unsigned* bar = b.bar;
    __builtin_amdgcn_s_waitcnt(0);
    unsigned nloc = b.st[0], nx = b.st[1];
    if (nloc == 0u) { xcd_barrier_complete(bar, b.x, nloc, nx); b.st[0] = nloc; b.st[1] = nx; }
    const unsigned old = xb_add(&bar[XB_XSUB(b.x)], 1u);
    const unsigned gen = old / nloc;
    if (old + 1u == (gen + 1u) * nloc) {
      __builtin_amdgcn_fence(__ATOMIC_RELEASE, "agent");
      asm volatile("s_waitcnt vmcnt(0)" ::: "memory");
      const unsigned og = xb_add(&bar[XB_TOP], 1u);
      const unsigned tg = og / nx;
      if (og + 1u == (tg + 1u) * nx) xb_add(&bar[XB_TOPGEN], 1u);
      else XB_SPIN(xb_ld(&bar[XB_TOPGEN]) == tg, bar);
      __builtin_amdgcn_fence(__ATOMIC_ACQUIRE, "agent");
      xb_add(&bar[XB_XGEN(b.x)], 1u);
      asm volatile("s_waitcnt vmcnt(0)" ::: "memory");
    } else {
      XB_SPIN(xb_ld(&bar[XB_XGEN(b.x)]) == gen, bar);
      __builtin_amdgcn_fence(__ATOMIC_ACQUIRE, "agent");
      asm volatile("s_waitcnt vmcnt(0)" ::: "memory");
    }
  }
  __syncthreads();
}
DI void run_phase(const Params& p, int ph, unsigned char* smem) {
  if (ph == 0) { phase_prep(p, smem); return; }
  if (ph == 17) { phase_final(p); return; }
  const int layer = (ph - 1) >> 3, s = (ph - 1) & 7;
#ifdef PROBE_DUP
  if ((PROBE_DUP >> s) & 1) {
    switch (s) { case 0: phase_inproj(p, layer, smem); break; case 1: phase_b(p, layer, smem); break; case 2: phase_c(p, smem); break; case 4: phase_e(p, layer, smem); break; case 6: phase_g(p, layer, smem); break; default: break; }
    __syncthreads();
  }
#endif
  switch (s) {
    case 0: phase_inproj(p, layer, smem); break;
    case 1: phase_b(p, layer, smem); break;
    case 2: phase_c(p, smem); break;
    case 3: phase_d(p, layer, smem); break;
    case 4: phase_e(p, layer, smem); break;
    case 5: phase_f(p, layer, smem); break;
    case 6: phase_g(p, layer, smem); break;
    default: phase_h(p, layer, smem); break;
  }
}
constexpr int N_PHASES = 18;

#if ONE_LAUNCH
template <int PH> DI void run_all(const Params& p, unsigned char* smem, cg::grid_group& grid, const XcdBarrier& xb) {
  run_phase(p, PH, smem);
  if constexpr (PH + 1 < N_PHASES) {
    if constexpr (PH == 0) grid.sync(); else xcd_barrier(xb);
    run_all<PH + 1>(p, smem, grid, xb);
  }
}
__global__ void __launch_bounds__(NTHR, 2) mega_kernel(Params p) {
  __shared__ __attribute__((aligned(16))) unsigned char smem[SMEM_BYTES];
  __shared__ uint4 xb_words;
  if (threadIdx.x == 0) xb_words = make_uint4(0u, 0u, 0u, 0u);
  __syncthreads();
  const XcdBarrier xb = xcd_barrier_post((unsigned*)(p.ws + O_BAR), (volatile LAS unsigned*)&xb_words);
  cg::grid_group grid = cg::this_grid();
  run_all<0>(p, smem, grid, xb);
}
#else
template <int PH> __global__ void __launch_bounds__(NTHR, 2) phase_kernel(Params p) {
  __shared__ __attribute__((aligned(16))) unsigned char smem[SMEM_BYTES];
  run_phase(p, PH, smem);
}
template <int PH> static void launch_phases(const Params& p, hipStream_t stream) {
  hipLaunchKernelGGL((phase_kernel<PH>), dim3(256), dim3(NTHR), 0, stream, p);
  if constexpr (PH + 1 < N_PHASES) launch_phases<PH + 1>(p, stream);
}
#endif

extern "C" void kernel_launch(void* const* d_in, const int* in_sizes, int n_in, void* d_out, int out_size, void* d_ws, size_t ws_size, hipStream_t stream) {
  if (ws_size < O_END || n_in < 25) { fprintf(stderr, "workspace too small: %zu < %zu\n", ws_size, (size_t)O_END); return; }
  Params p{};
  p.x = (const float*)d_in[0]; p.pos = (const int*)d_in[1]; p.mix_norm = (const float*)d_in[2]; p.w_in = (const float*)d_in[3]; p.b_forget = (const float*)d_in[4];
  p.pe_k = (const float*)d_in[5]; p.w1_k = (const float*)d_in[6]; p.w2_k = (const float*)d_in[7]; p.pe_v = (const float*)d_in[8]; p.w1_v = (const float*)d_in[9]; p.w2_v = (const float*)d_in[10];
  p.q_norm = (const float*)d_in[11]; p.w_uq = (const float*)d_in[12]; p.kv_norm = (const float*)d_in[13]; p.w_ukv = (const float*)d_in[14];
  p.wbr_nsa = (const float*)d_in[15]; p.wbr_fox = (const float*)d_in[16]; p.wbr_mla = (const float*)d_in[17]; p.w_out = (const float*)d_in[18];
  p.ffn_norm = (const float*)d_in[19]; p.w_up = (const float*)d_in[20]; p.conv_w = (const float*)d_in[21]; p.conv_b = (const float*)d_in[22]; p.w_down = (const float*)d_in[23]; p.final_norm = (const float*)d_in[24];
  p.out = (float*)d_out; p.ws = (unsigned char*)d_ws;
  hipMemsetAsync(p.ws + O_BAR, 0, XCD_BAR_WORDS * 4, stream);
#if ONE_LAUNCH
  static int grid_blocks = 0;
  if (!grid_blocks) {
    int dev = 0, cus = 0, per_cu = 0;
    hipGetDevice(&dev); hipDeviceGetAttribute(&cus, hipDeviceAttributeMultiprocessorCount, dev);
    hipOccupancyMaxActiveBlocksPerMultiprocessor(&per_cu, mega_kernel, NTHR, 0);
    if (per_cu > 1) per_cu = 1;
    grid_blocks = cus * per_cu;
  }
  void* args[] = {&p};
  hipError_t e = hipLaunchCooperativeKernel((void*)mega_kernel, dim3(grid_blocks), dim3(NTHR), args, 0, stream);
  if (e != hipSuccess) fprintf(stderr, "cooperative launch failed: %s (grid %d)\n", hipGetErrorString(e), grid_blocks);
#else
  launch_phases<0>(p, stream);
#endif
}
```

```cpp
#include <hip/hip_runtime.h>
#include <hip/hip_cooperative_groups.h>
#include <stdint.h>
#include <stdio.h>
#include <type_traits>
namespace cg = cooperative_groups;

#ifndef ONE_LAUNCH
#define ONE_LAUNCH 1

#endif

#define DI __device__ __forceinline__
typedef unsigned short bf16_t;
typedef short bf16x8 __attribute__((ext_vector_type(8)));
typedef float f32x4 __attribute__((ext_vector_type(4)));
typedef float f32x16 __attribute__((ext_vector_type(16)));
typedef float f32x2 __attribute__((ext_vector_type(2)));
typedef __bf16 bfx2 __attribute__((ext_vector_type(2)));
typedef unsigned u32x4 __attribute__((ext_vector_type(4)));
typedef unsigned u32x2 __attribute__((ext_vector_type(2)));
typedef unsigned long long u64;

constexpr int T_ = 32768, S_ = 4096, NB_ = 8, D_ = 1024, DFF_ = 2816, NIN_ = 6592;
constexpr float EPS_ = 1e-6f;
constexpr float LOG2E_ = 1.4426950408889634f;
constexpr float QS64_ = 0.125f * LOG2E_;
constexpr float QS96_ = 0.10206207261596577f * LOG2E_;

constexpr size_t W_IN = 0;
constexpr size_t W_G = W_IN + (size_t)3584 * 1024;
constexpr size_t W_1K = W_G + (size_t)3072 * 1024;
constexpr size_t W_1V = W_1K + (size_t)256 * 2048;
constexpr size_t W_2K = W_1V + (size_t)256 * 2048;
constexpr size_t W_2V = W_2K + (size_t)64 * 256;
constexpr size_t W_UQ = W_2V + (size_t)64 * 256;
constexpr size_t W_UKV = W_UQ + (size_t)768 * 384;
constexpr size_t W_BN = W_UKV + (size_t)1024 * 256;
constexpr size_t W_BF = W_BN + (size_t)1024 * 512;
constexpr size_t W_BM = W_BF + (size_t)1024 * 512;
constexpr size_t W_OUT = W_BM + (size_t)1024 * 512;
constexpr size_t W_UP = W_OUT + (size_t)1024 * 1024;
constexpr size_t W_DN = W_UP + (size_t)5632 * 1024;
constexpr size_t W_LAYER = W_DN + (size_t)1024 * 2816;

constexpr size_t al256(size_t x) { return (x + 255) & ~(size_t)255; }
constexpr size_t O_BAR = 0;
constexpr size_t O_W = 16384;
constexpr size_t O_BIAS1 = al256(O_W + 2 * W_LAYER * 2);
constexpr size_t O_ROPE8 = al256(O_BIAS1 + 2 * 2 * 16 * 256 * 4);
constexpr size_t O_ROPE16 = al256(O_ROPE8 + (size_t)T_ * 16 * 4);
constexpr size_t O_XG = al256(O_ROPE16 + (size_t)T_ * 32 * 4);
constexpr size_t O_SSQ = al256(O_XG + (size_t)T_ * 1024 * 2);
constexpr size_t O_CSSQ = al256(O_SSQ + (size_t)T_ * 16 * 4);
constexpr size_t O_NSAQ = al256(O_CSSQ + (size_t)T_ * 16 * 4);
constexpr size_t O_KVCMP = O_NSAQ + (size_t)T_ * 512 * 2;
constexpr size_t O_KSLC = O_KVCMP + (size_t)T_ * 256 * 2;
constexpr size_t O_KWIN = O_KSLC + (size_t)T_ * 128 * 2;
constexpr size_t O_MERGED = O_NSAQ;
constexpr size_t O_VSLCT = O_KWIN + (size_t)T_ * 128 * 2;
constexpr size_t O_VWINT = O_VSLCT + (size_t)T_ * 128 * 2;
constexpr size_t O_FOXQ = O_VWINT + (size_t)T_ * 128 * 2;
constexpr size_t O_FOXK = O_FOXQ + (size_t)T_ * 512 * 2;
constexpr size_t O_FOXVT = O_FOXK + (size_t)T_ * 512 * 2;
constexpr size_t O_MLAQ = O_FOXVT + (size_t)T_ * 512 * 2;
constexpr size_t O_MLAKN = O_MLAQ + (size_t)T_ * 768 * 2;
constexpr size_t O_ACT = O_FOXQ;
constexpr size_t O_MLAVT = O_MLAKN + (size_t)T_ * 512 * 2;
constexpr size_t O_MLAKPE = O_MLAVT + (size_t)T_ * 512 * 2;
constexpr size_t O_ONSA = O_MLAKPE + (size_t)T_ * 32 * 2;
constexpr size_t O_CQ = O_ONSA;
constexpr size_t O_CKV = O_CQ + (size_t)T_ * 384 * 2;
constexpr size_t O_CEND = O_CKV + (size_t)T_ * 256 * 2;
constexpr size_t O_GATES = al256(O_CEND > O_ONSA + (size_t)T_ * 512 * 2 ? O_CEND : O_ONSA + (size_t)T_ * 512 * 2);
constexpr size_t O_LOGF = al256(O_GATES + (size_t)T_ * 24 * 4);
constexpr size_t O_F2 = al256(O_LOGF + (size_t)T_ * 8 * 4);
constexpr size_t O_KC = al256(O_F2 + (size_t)T_ * 8 * 4);
constexpr size_t O_VCT = al256(O_KC + (size_t)NB_ * 2 * 256 * 64 * 2);
constexpr size_t O_SEL = al256(O_VCT + (size_t)NB_ * 2 * 256 * 64 * 2);
constexpr size_t O_END = al256(O_SEL + (size_t)NB_ * 2 * S_ * 8);

struct Params {
  const float* x; const int* pos; const float* mix_norm; const float* w_in; const float* b_forget;
  const float* pe_k; const float* w1_k; const float* w2_k; const float* pe_v; const float* w1_v; const float* w2_v;
  const float* q_norm; const float* w_uq; const float* kv_norm; const float* w_ukv;
  const float* wbr_nsa; const float* wbr_fox; const float* wbr_mla; const float* w_out;
  const float* ffn_norm; const float* w_up; const float* conv_w; const float* conv_b; const float* w_down; const float* final_norm;
  float* out; unsigned char* ws;
};

constexpr int NTHR = 512;
constexpr int SMEM_BYTES = 147456;

DI int TIDX() { int t = (int)threadIdx.x; asm volatile("" : "+v"(t)); return t; }
DI unsigned pk2(float lo, float hi) { f32x2 v = {lo, hi}; return __builtin_bit_cast(unsigned, __builtin_convertvector(v, bfx2)); }
DI bf16_t f2bf(float x) { return (bf16_t)(pk2(x, 0.f) & 0xffffu); }
DI float bf2f(bf16_t h) { return __uint_as_float(((unsigned)h) << 16); }
DI float sigmoidf_(float x) { return 1.f / (1.f + __expf(-x)); }
DI float gelu_tanh(float x) { const float u = 0.7978845608028654f * (x + 0.044715f * x * x * x); return x / (1.f + __expf(-2.f * u)); }
DI float ex2(float x) { return __builtin_amdgcn_exp2f(x); }
DI f32x16 mfma32(bf16x8 a, bf16x8 b, f32x16 c) { return __builtin_amdgcn_mfma_f32_32x32x16_bf16(a, b, c, 0, 0, 0); }
DI f32x4 mfma16(bf16x8 a, bf16x8 b, f32x4 c) { return __builtin_amdgcn_mfma_f32_16x16x32_bf16(a, b, c, 0, 0, 0); }
DI float rstd_from16(const float* p, float inv_n) {
  const f32x4 a = *(const f32x4*)p, b = *(const f32x4*)(p + 4), c = *(const f32x4*)(p + 8), d = *(const f32x4*)(p + 12);
  const float s = ((a[0] + a[1]) + (a[2] + a[3])) + ((b[0] + b[1]) + (b[2] + b[3])) + ((c[0] + c[1]) + (c[2] + c[3])) + ((d[0] + d[1]) + (d[2] + d[3]));
  return rsqrtf(s * inv_n + EPS_);
}

constexpr int LDT = 72;
template <int MI, int NJ> struct GemmLds { static constexpr int BM = 32 * MI, BN = 64 * NJ, A_ELEMS = BM * LDT, B_ELEMS = BN * LDT, STAGE = A_ELEMS + B_ELEMS; };

template <int MI, int NJ, bool SWAP, class AP, class BP>
DI void gemm_main(f32x4 (&acc)[MI][NJ], const AP& ap, int a_kstep, const BP& bp, int b_kstep, int nk, bf16_t* smem, int mi_cnt = MI) {
  typedef GemmLds<MI, NJ> L;
  constexpr int CA = MI / 2, CB = NJ;
  const int tid = TIDX(), lane = tid & 63, wid = tid >> 6, wm = wid >> 2, wn = wid & 3, l15 = lane & 15, quad = lane >> 4;
  unsigned pa[CA], pb[CB]; bool oka[CA];
#pragma unroll
  for (int i = 0; i < CA; ++i) { const int c = tid + NTHR * i; pa[i] = ap(c >> 3) + (c & 7) * 8; oka[i] = ap.ok(c >> 3); }
#pragma unroll
  for (int i = 0; i < CB; ++i) { const int c = tid + NTHR * i; pb[i] = bp(c >> 3) + (c & 7) * 8; }
  u32x4 ra[CA], rb[CB];
  auto gload = [&](int kt) {
    const bf16_t* ab = ap.base + (size_t)kt * a_kstep; const bf16_t* bb = bp.base + (size_t)kt * b_kstep;
#pragma unroll
    for (int i = 0; i < CA; ++i) ra[i] = *(const u32x4*)(ab + pa[i]);
#pragma unroll
    for (int i = 0; i < CB; ++i) rb[i] = *(const u32x4*)(bb + pb[i]);
  };
  auto sstore = [&](int buf) {
    bf16_t* As = smem + buf * L::STAGE; bf16_t* Bs = As + L::A_ELEMS;
#pragma unroll
    for (int i = 0; i < CA; ++i) { const int c = tid + NTHR * i; *(u32x4*)(As + (c >> 3) * LDT + (c & 7) * 8) = oka[i] ? ra[i] : (u32x4){0u, 0u, 0u, 0u}; }
#pragma unroll
    for (int i = 0; i < CB; ++i) { const int c = tid + NTHR * i; *(u32x4*)(Bs + (c >> 3) * LDT + (c & 7) * 8) = rb[i]; }
  };
  gload(0); sstore(0); gload(nk > 1 ? 1 : 0); __syncthreads();
#pragma unroll 1
  for (int kt = 0; kt < nk; ++kt) {
    const int buf = kt & 1;
    sstore(buf ^ 1);
    gload(kt + 2 < nk ? kt + 2 : nk - 1);
    __builtin_amdgcn_sched_barrier(0);
    const bf16_t* As = smem + buf * L::STAGE + (wm * 16 * MI + l15) * LDT + quad * 8;
    const bf16_t* Bs = smem + buf * L::STAGE + L::A_ELEMS + (wn * 16 * NJ + l15) * LDT + quad * 8;
#pragma unroll
    for (int ks = 0; ks < 2; ++ks) {
      if (MI * NJ >= 32 && ks == 1) asm volatile("" ::: "memory");
      bf16x8 b[NJ];
#pragma unroll
      for (int j = 0; j < NJ; ++j) b[j] = *(const bf16x8*)(Bs + j * 16 * LDT + ks * 32);
#pragma unroll
      for (int i = 0; i < MI; ++i) {
        if (i < mi_cnt) {
          const bf16x8 a = *(const bf16x8*)(As + i * 16 * LDT + ks * 32);
#pragma unroll
          for (int j = 0; j < NJ; ++j) acc[i][j] = SWAP ? mfma16(b[j], a, acc[i][j]) : mfma16(a, b[j], acc[i][j]);
        }
      }
    }
    __syncthreads();
  }
}
template <int MI, int NJ> DI void zero_acc(f32x4 (&acc)[MI][NJ]) {
#pragma unroll
  for (int i = 0; i < MI; ++i)
#pragma unroll
    for (int j = 0; j < NJ; ++j) acc[i][j] = (f32x4){0.f, 0.f, 0.f, 0.f};
}
struct RowPtr { const bf16_t* base; size_t ld; DI unsigned operator()(int r) const { return (unsigned)r * (unsigned)ld; } DI bool ok(int) const { return true; } };


template <class F> DI void xcd_tiles(int MPX, int NT, F&& body) {
  const int xcd = blockIdx.x & 7, slot = blockIdx.x >> 3, nslots = gridDim.x >> 3, total = MPX * NT;
  for (int li = slot; li < total; li += nslots) {
    const int mg = li / (8 * NT), rem = li - mg * 8 * NT;
    const int gsz = (MPX - mg * 8) < 8 ? (MPX - mg * 8) : 8;
    const int tn = rem / gsz, mi = rem - tn * gsz;
    body(xcd * MPX + mg * 8 + mi, tn);
  }
}

DI int map_col(int map, int n) {
  if (map == 0) return n;
  if (map == 1) {
    if (n < 896) return n;
    if (n < 1024) return 1024 + (n - 896);
    if (n < 1152) return 896 + (n - 1024);
    if (n < 1280) return n;
    if (n < 2816) return 1304 + (n - 1280);
    if (n < 3200) return 2848 + (n - 2816);
    if (n < 3456) return 3232 + (n - 3200);
    const int c = n - 3456;
    if (c < 24) return 1280 + c;
    if (c < 32) return 2840 + (c - 24);
    if (c < 64) return 3488 + (c - 32);
    return -1;
  }
  if (map == 2) { const int j = n >> 8, c = n & 255; return c < 128 ? j * 128 + c : DFF_ + j * 128 + (c - 128); }
  if (map == 3) { return n < 512 ? (n >> 6) * 128 + (n & 63) : ((n - 512) >> 6) * 128 + 64 + ((n - 512) & 63); }
  return n;
}
struct WJob { const float* src; const float* scale; bf16_t* dst; int K, N, ld, map, off; };
DI void prep_weight_tile(const WJob& j, int tile, float* lds) {
  const int ntn = j.N >> 6, tk = tile / ntn, tn = tile % ntn, tid = TIDX();
  const int n4 = (tid & 15) * 4; const int sc = map_col(j.map, tn * 64 + n4);
  f32x4 v[4];
#pragma unroll
  for (int i = 0; i < 4; ++i) {
    const int kk = (tid >> 4) + 32 * i, k = tk * 128 + kk;
    v[i] = sc >= 0 ? *(const f32x4*)(j.src + (size_t)k * j.ld + j.off + sc) : (f32x4){0.f, 0.f, 0.f, 0.f};
    if (j.scale) v[i] = v[i] * j.scale[k];
  }
#pragma unroll
  for (int i = 0; i < 4; ++i) {
    const int kk = (tid >> 4) + 32 * i;
#pragma unroll
    for (int e = 0; e < 4; ++e) lds[kk * 65 + n4 + e] = v[i][e];
  }
  __syncthreads();
  const int nn = tid >> 3, k0 = (tid & 7) * 16;
  unsigned w[8];
#pragma unroll
  for (int e = 0; e < 8; ++e) w[e] = pk2(lds[(k0 + 2 * e) * 65 + nn], lds[(k0 + 2 * e + 1) * 65 + nn]);
  bf16_t* d = j.dst + (size_t)(tn * 64 + nn) * j.K + tk * 128 + k0;
  *(u32x4*)d = (u32x4){w[0], w[1], w[2], w[3]}; *(u32x4*)(d + 8) = (u32x4){w[4], w[5], w[6], w[7]};
  __syncthreads();
}
DI WJob get_wjob(const Params& p, int layer, int id) {
  bf16_t* wl = (bf16_t*)(p.ws + O_W) + (size_t)layer * W_LAYER; WJob j; j.scale = nullptr; j.map = 0; j.off = 0;
  switch (id) {
    case 0: j.src = p.w_in + (size_t)layer * 1024 * NIN_; j.dst = wl + W_IN; j.K = 1024; j.N = 3584; j.ld = NIN_; j.map = 1; break;
    case 1: j.src = p.w_in + (size_t)layer * 1024 * NIN_; j.dst = wl + W_G; j.K = 1024; j.N = 3072; j.ld = NIN_; j.off = 3520; break;
    case 2: j.src = p.w1_k + (size_t)layer * 2048 * 256; j.dst = wl + W_1K; j.K = 2048; j.N = 256; j.ld = 256; break;
    case 3: j.src = p.w1_v + (size_t)layer * 2048 * 256; j.dst = wl + W_1V; j.K = 2048; j.N = 256; j.ld = 256; break;
    case 4: j.src = p.w2_k + (size_t)layer * 256 * 64; j.dst = wl + W_2K; j.K = 256; j.N = 64; j.ld = 64; break;
    case 5: j.src = p.w2_v + (size_t)layer * 256 * 64; j.dst = wl + W_2V; j.K = 256; j.N = 64; j.ld = 64; break;
    case 6: j.src = p.w_uq + (size_t)layer * 384 * 768; j.dst = wl + W_UQ; j.K = 384; j.N = 768; j.ld = 768; j.scale = p.q_norm + layer * 384; break;
    case 7: j.src = p.w_ukv + (size_t)layer * 256 * 1024; j.dst = wl + W_UKV; j.K = 256; j.N = 1024; j.ld = 1024; j.scale = p.kv_norm + layer * 256; j.map = 3; break;
    case 8: j.src = p.wbr_nsa + (size_t)layer * 512 * 1024; j.dst = wl + W_BN; j.K = 512; j.N = 1024; j.ld = 1024; break;
    case 9: j.src = p.wbr_fox + (size_t)layer * 512 * 1024; j.dst = wl + W_BF; j.K = 512; j.N = 1024; j.ld = 1024; break;
    case 10: j.src = p.wbr_mla + (size_t)layer * 512 * 1024; j.dst = wl + W_BM; j.K = 512; j.N = 1024; j.ld = 1024; break;
    case 11: j.src = p.w_out + (size_t)layer * 1024 * 1024; j.dst = wl + W_OUT; j.K = 1024; j.N = 1024; j.ld = 1024; break;
    case 12: j.src = p.w_up + (size_t)layer * 1024 * 5632; j.dst = wl + W_UP; j.K = 1024; j.N = 5632; j.ld = 5632; j.map = 2; break;
    default: j.src = p.w_down + (size_t)layer * 2816 * 1024; j.dst = wl + W_DN; j.K = 2816; j.N = 1024; j.ld = 1024; break;
  }
  return j;
}
constexpr int WTILES_LAYER = (int)(W_LAYER / 8192);
constexpr int P0_XITEMS = T_ / 64;
constexpr int P0_ROPE_ITEMS = T_ / NTHR;
constexpr int P0_ITEMS = 2 * WTILES_LAYER + 64 + P0_ROPE_ITEMS + P0_XITEMS;

DI void xg_rows(const float* x, const float* g, bf16_t* xg, float* ssq, int row0) {
  const int lane = TIDX() & 63, wid = TIDX() >> 6;
  for (int rr = 0; rr < 8; ++rr) {
    const int t = row0 + wid * 8 + rr; const float* xr = x + (size_t)t * D_; float s = 0.f;
#pragma unroll
    for (int c = 0; c < 4; ++c) {
      const int k = c * 256 + lane * 4; const f32x4 v = *(const f32x4*)(xr + k), gv = *(const f32x4*)(g + k);
      s += v[0] * v[0] + v[1] * v[1] + v[2] * v[2] + v[3] * v[3];
      *(u32x2*)(xg + (size_t)t * D_ + k) = (u32x2){pk2(v[0] * gv[0], v[1] * gv[1]), pk2(v[2] * gv[2], v[3] * gv[3])};
    }
#pragma unroll
    for (int o = 32; o >= 1; o >>= 1) s += __shfl_xor(s, o);
    if (lane < 16) ssq[(size_t)t * 16 + lane] = lane == 0 ? s : 0.f;
  }
}
DI void phase_prep(const Params& p, unsigned char* smem) {
  for (int it = blockIdx.x; it < P0_ITEMS; it += gridDim.x) {
    int i = it;
    if (i < 2 * WTILES_LAYER) {
      const int layer = i / WTILES_LAYER; int t = i % WTILES_LAYER; int id = 0;
      for (;; ++id) { const WJob j = get_wjob(p, layer, id); const int nt = (j.K >> 7) * (j.N >> 6); if (t < nt) { prep_weight_tile(j, t, (float*)smem); break; } t -= nt; }
      continue;
    }
    i -= 2 * WTILES_LAYER;
    if (i < 64) {
      const int lk = i >> 4, pc = i & 15, layer = lk >> 1, kv = lk & 1, c = TIDX() & 255, hf = TIDX() >> 8;
      const float* pe = (kv ? p.pe_v : p.pe_k) + (size_t)layer * 2048 + pc * 128 + hf * 64; const float* w1 = (kv ? p.w1_v : p.w1_k) + (size_t)layer * 2048 * 256 + (size_t)(pc * 128 + hf * 64) * 256;
      float sacc = 0.f;
#pragma unroll 8
      for (int kk = 0; kk < 64; ++kk) sacc += pe[kk] * w1[(size_t)kk * 256 + c];
      float* lds = (float*)smem;
      if (hf) lds[c] = sacc;
      __syncthreads();
      if (!hf) ((float*)(p.ws + O_BIAS1))[(lk * 16 + pc) * 256 + c] = sacc + lds[c];
      __syncthreads();
      continue;
    }
    i -= 64;
    if (i < P0_ROPE_ITEMS) {
      const int t = i * NTHR + TIDX(); const float fp = (float)p.pos[t];
      float* r8 = (float*)(p.ws + O_ROPE8) + (size_t)t * 16; float* r16 = (float*)(p.ws + O_ROPE16) + (size_t)t * 32;
      for (int f = 0; f < 24; ++f) {
        const int half = f < 8 ? 8 : 16, idx = f < 8 ? f : f - 8;
        const float inv = exp2f(-(float)idx / (float)half * 18.931568569324174f);
        const float ang = fp * inv;
        const double rev = (double)ang * 0.15915494309189535; const float fr = (float)(rev - floor(rev));
        const float sn = __builtin_amdgcn_sinf(fr), cs = __builtin_amdgcn_cosf(fr);
        if (f < 8) { r8[2 * idx] = cs; r8[2 * idx + 1] = sn; } else { r16[2 * idx] = cs; r16[2 * idx + 1] = sn; }
      }
      continue;
    }
    i -= P0_ROPE_ITEMS;
    xg_rows(p.x, p.mix_norm, (bf16_t*)(p.ws + O_XG), (float*)(p.ws + O_SSQ), i * 64);
  }
}

DI void store4(bf16_t* dst, const f32x4& v, float s) { *(u32x2*)dst = (u32x2){pk2(v[0] * s, v[1] * s), pk2(v[2] * s, v[3] * s)}; }
constexpr int STG_LD = 72, STG_WAVE = 128 * 72;
DI void stage4(bf16_t* stg, int row, int col, const f32x4& v, float s) { *(u32x2*)(stg + row * STG_LD + col) = (u32x2){pk2(v[0] * s, v[1] * s), pk2(v[2] * s, v[3] * s)}; }
template <int ROWS, int COLS, int LD> DI void stage_out(const bf16_t* stg, bf16_t* dst, size_t ld, int lane) {
  asm volatile("s_waitcnt lgkmcnt(0)" ::: "memory");
  constexpr int CPR = COLS / 8, IT = ROWS * CPR / 64;
#pragma unroll
  for (int it = 0; it < IT; ++it) {
    const int idx = it * 64 + lane, r = idx / CPR, c = idx % CPR;
    __builtin_nontemporal_store(*(const u32x4*)(stg + r * LD + c * 8), (u32x4*)(dst + (size_t)r * ld + c * 8));
  }
}
template <bool SWAP> DI void inproj_tile(const Params& p, int layer, int tm, int tn, bf16_t* smem) {
  const bf16_t* wl = (const bf16_t*)(p.ws + O_W) + (size_t)layer * W_LAYER;
  f32x4 acc[8][4]; zero_acc<8, 4>(acc);
  RowPtr ap{(const bf16_t*)(p.ws + O_XG) + (size_t)tm * 256 * D_, (size_t)D_}, bp{wl + W_IN + (size_t)tn * 256 * D_, (size_t)D_};
  gemm_main<8, 4, SWAP>(acc, ap, 64, bp, 64, 16, smem);
  const int lane = TIDX() & 63, wid = TIDX() >> 6, wm = wid >> 2, wn = wid & 3, l15 = lane & 15, quad = lane >> 4;
  const float* ssq = (const float*)(p.ws + O_SSQ);
  bf16_t* stg = smem + wid * STG_WAVE;
  const int trow0 = tm * 256 + wm * 128;
  if constexpr (!SWAP) {
    bf16_t* dst; int hh, hd;
    if (tn == 4) { dst = (bf16_t*)(p.ws + (wn < 2 ? O_VSLCT : O_VWINT)); hh = 2; hd = wn & 1; } else { dst = (bf16_t*)(p.ws + O_FOXVT); hh = 8; hd = (tn - 9) * 4 + wn; }
    constexpr int VLD = 136;
#pragma unroll
    for (int i = 0; i < 8; ++i) {
      const int t0 = trow0 + i * 16 + quad * 4;
      float rs[4];
#pragma unroll
      for (int r = 0; r < 4; ++r) rs[r] = rstd_from16(ssq + (size_t)(t0 + r) * 16, 1.f / 1024.f);
#pragma unroll
      for (int j = 0; j < 4; ++j)
        *(u32x2*)(stg + (j * 16 + l15) * VLD + i * 16 + quad * 4) = (u32x2){pk2(acc[i][j][0] * rs[0], acc[i][j][1] * rs[1]), pk2(acc[i][j][2] * rs[2], acc[i][j][3] * rs[3])};
    }
    const int b = trow0 >> 12, s0 = trow0 & 4095;
    stage_out<64, 128, VLD>(stg, dst + ((size_t)(b * hh + hd) * 64) * S_ + s0, (size_t)S_, lane);
  } else {
    const int slab = tn * 4 + wn;
    if (slab == 54) {
#pragma unroll
      for (int i = 0; i < 8; ++i) {
        const int t = trow0 + i * 16 + l15; const float rs = rstd_from16(ssq + (size_t)t * 16, 1.f / 1024.f);
        float* gt = (float*)(p.ws + O_GATES) + (size_t)t * 24; float* lf = (float*)(p.ws + O_LOGF) + (size_t)t * 8;
#pragma unroll
        for (int r = 0; r < 4; ++r) gt[quad * 4 + r] = sigmoidf_(acc[i][0][r] * rs);
        if (quad < 2) {
#pragma unroll
          for (int r = 0; r < 4; ++r) gt[16 + quad * 4 + r] = sigmoidf_(acc[i][1][r] * rs);
        } else {
#pragma unroll
          for (int r = 0; r < 4; ++r) { const int h = (quad - 2) * 4 + r; const float xx = acc[i][1][r] * rs + p.b_forget[layer * 8 + h]; lf[h] = fminf(xx, 0.f) - log1pf(__expf(-fabsf(xx))); }
        }
        const float* rp = (const float*)(p.ws + O_ROPE16) + (size_t)t * 32 + quad * 8; float o1[4], o2[4];
#pragma unroll
        for (int r = 0; r < 4; ++r) { const float cs = rp[2 * r], sn = rp[2 * r + 1], x1 = acc[i][2][r] * rs, x2 = acc[i][3][r] * rs; o1[r] = x1 * cs - x2 * sn; o2[r] = x2 * cs + x1 * sn; }
        bf16_t* kp = (bf16_t*)(p.ws + O_MLAKPE) + (size_t)t * 32 + quad * 4;
        *(u32x2*)kp = (u32x2){pk2(o1[0], o1[1]), pk2(o1[2], o1[3])}; *(u32x2*)(kp + 16) = (u32x2){pk2(o2[0], o2[1]), pk2(o2[2], o2[3])};
      }
    } else if (slab != 55) {
      bf16_t* dbuf; int dld, dcol, kind = 0; float qs = 1.f; int cslot = 0;
      if (slab < 8) { dbuf = (bf16_t*)(p.ws + O_NSAQ); dld = 512; dcol = slab * 64; qs = QS64_; }
      else if (slab < 12) { dbuf = (bf16_t*)(p.ws + O_KVCMP); dld = 256; dcol = (slab - 8) * 64; }
      else if (slab < 16) { dbuf = (bf16_t*)(p.ws + (slab < 14 ? O_KSLC : O_KWIN)); dld = 128; dcol = (slab & 1) * 64; kind = 1; }
      else if (slab < 28) { dbuf = (bf16_t*)(p.ws + O_FOXQ); dld = 512; dcol = (slab - 20) * 64; qs = QS64_; }
      else if (slab < 36) { dbuf = (bf16_t*)(p.ws + O_FOXK); dld = 512; dcol = (slab - 28) * 64; }
      else if (slab < 50) { dbuf = (bf16_t*)(p.ws + O_CQ); dld = 384; dcol = (slab - 44) * 64; kind = 2; cslot = slab - 44; }
      else { dbuf = (bf16_t*)(p.ws + O_CKV); dld = 256; dcol = (slab - 50) * 64; kind = 2; cslot = 8 + slab - 50; }
#pragma unroll
      for (int i = 0; i < 8; ++i) {
        const int row = i * 16 + l15, t = trow0 + row; const float rs = rstd_from16(ssq + (size_t)t * 16, 1.f / 1024.f) * qs;
        if (kind == 1) {
          const float* rp = (const float*)(p.ws + O_ROPE8) + (size_t)t * 16 + (quad & 1) * 8;
          f32x4 v, o;
#pragma unroll
          for (int r = 0; r < 4; ++r) { v[r] = acc[i][0][r] * rs; o[r] = __shfl_xor(v[r], 32); }
#pragma unroll
          for (int r = 0; r < 4; ++r) { const float cs = rp[2 * r], sn = rp[2 * r + 1]; v[r] = quad < 2 ? v[r] * cs - o[r] * sn : v[r] * cs + o[r] * sn; }
          stage4(stg, row, quad * 4, v, 1.f);
        } else stage4(stg, row, quad * 4, acc[i][0], rs);
#pragma unroll
        for (int j = 1; j < 4; ++j) stage4(stg, row, j * 16 + quad * 4, acc[i][j], rs);
        if (kind == 2) {
          float s = 0.f;
#pragma unroll
          for (int j = 0; j < 4; ++j) { const f32x4 a = acc[i][j] * rs; s += a[0] * a[0] + a[1] * a[1] + a[2] * a[2] + a[3] * a[3]; }
          s += __shfl_xor(s, 16); s += __shfl_xor(s, 32);
          if (quad == 0) ((float*)(p.ws + O_CSSQ))[(size_t)t * 16 + cslot] = s;
        }
      }
      stage_out<128, 64, STG_LD>(stg, dbuf + (size_t)trow0 * dld + dcol, (size_t)dld, lane);
    }
  }
  __syncthreads();
}
DI void phase_inproj(const Params& p, int layer, unsigned char* smem) {
  xcd_tiles(16, 14, [&](int tm, int tn) {
    const bool vt = (tn == 4 || tn == 9 || tn == 10);
    if (vt) inproj_tile<false>(p, layer, tm, tn, (bf16_t*)smem); else inproj_tile<true>(p, layer, tm, tn, (bf16_t*)smem);
  });
}

template <int KIND> DI void mlaup_tile(const Params& p, int layer, int tm, int tn, bf16_t* smem) {
  const bf16_t* wl = (const bf16_t*)(p.ws + O_W) + (size_t)layer * W_LAYER;
  f32x4 acc[8][4]; zero_acc<8, 4>(acc);
  constexpr int K = KIND == 0 ? 384 : 256;
  RowPtr ap{KIND == 0 ? (const bf16_t*)(p.ws + O_CQ) + (size_t)tm * 256 * 384 : (const bf16_t*)(p.ws + O_CKV) + (size_t)tm * 256 * 256, (size_t)K};
  RowPtr bp{KIND == 0 ? wl + W_UQ + (size_t)tn * 256 * 384 : wl + W_UKV + (size_t)(tn - 3) * 256 * 256, (size_t)K};
  gemm_main<8, 4, KIND != 2>(acc, ap, 64, bp, 64, K / 64, smem);
  const int lane = TIDX() & 63, wid = TIDX() >> 6, wm = wid >> 2, wn = wid & 3, l15 = lane & 15, quad = lane >> 4;
  const float* cssq = (const float*)(p.ws + O_CSSQ);
  bf16_t* stg = smem + wid * STG_WAVE; const int trow0 = tm * 256 + wm * 128;
  if constexpr (KIND == 2) {
    bf16_t* dst = (bf16_t*)(p.ws + O_MLAVT); const int h = (tn - 5) * 4 + wn;
    constexpr int VLD = 136;
#pragma unroll
    for (int i = 0; i < 8; ++i) {
      asm volatile("" ::: "memory");
      const int t0 = trow0 + i * 16 + quad * 4; float rs[4];
#pragma unroll
      for (int r = 0; r < 4; ++r) { const float* c = cssq + (size_t)(t0 + r) * 16 + 8; rs[r] = rsqrtf((c[0] + c[1] + c[2] + c[3]) * (1.f / 256.f) + EPS_); }
#pragma unroll
      for (int j = 0; j < 4; ++j)
        *(u32x2*)(stg + (j * 16 + l15) * VLD + i * 16 + quad * 4) = (u32x2){pk2(acc[i][j][0] * rs[0], acc[i][j][1] * rs[1]), pk2(acc[i][j][2] * rs[2], acc[i][j][3] * rs[3])};
    }
    stage_out<64, 128, VLD>(stg, dst + ((size_t)((trow0 >> 12) * 8 + h) * 64) * S_ + (trow0 & 4095), (size_t)S_, lane);
  } else if constexpr (KIND == 1) {
#pragma unroll
    for (int i = 0; i < 8; ++i) {
      asm volatile("" ::: "memory");
      const int row = i * 16 + l15, t = trow0 + row; const float* c = cssq + (size_t)t * 16;
      const float rs = rsqrtf((c[8] + c[9] + c[10] + c[11]) * (1.f / 256.f) + EPS_);
#pragma unroll
      for (int j = 0; j < 4; ++j) stage4(stg, row, j * 16 + quad * 4, acc[i][j], rs);
    }
    stage_out<128, 64, STG_LD>(stg, (bf16_t*)(p.ws + O_MLAKN) + (size_t)trow0 * 512 + (tn - 3) * 256 + wn * 64, (size_t)512, lane);
  } else {
    const int n0 = tn * 256 + wn * 64, ph = n0 % 96;
#pragma unroll
    for (int i = 0; i < 8; ++i) {
      asm volatile("" ::: "memory");
      const int row = i * 16 + l15, t = trow0 + row; const float* c = cssq + (size_t)t * 16;
      const float rs = rsqrtf((c[0] + c[1] + c[2] + c[3] + c[4] + c[5]) * (1.f / 384.f) + EPS_) * QS96_;
      f32x4 v0 = acc[i][0] * rs, v1 = acc[i][1] * rs, v2 = acc[i][2] * rs, v3 = acc[i][3] * rs;
      if (ph != 0) {
        const float* rp = (const float*)(p.ws + O_ROPE16) + (size_t)t * 32 + quad * 8;
        const f32x4 x1 = ph == 64 ? v0 : v2, x2 = ph == 64 ? v1 : v3; f32x4 o1, o2;
#pragma unroll
        for (int r = 0; r < 4; ++r) { const float cs = rp[2 * r], sn = rp[2 * r + 1]; o1[r] = x1[r] * cs - x2[r] * sn; o2[r] = x2[r] * cs + x1[r] * sn; }
        if (ph == 64) { v0 = o1; v1 = o2; } else { v2 = o1; v3 = o2; }
      }
      stage4(stg, row, quad * 4, v0, 1.f); stage4(stg, row, 16 + quad * 4, v1, 1.f); stage4(stg, row, 32 + quad * 4, v2, 1.f); stage4(stg, row, 48 + quad * 4, v3, 1.f);
    }
    stage_out<128, 64, STG_LD>(stg, (bf16_t*)(p.ws + O_MLAQ) + (size_t)trow0 * 768 + n0, (size_t)768, lane);
  }
  __syncthreads();
}
struct CmpRowPtr { const bf16_t* base; int r0;
  DI unsigned operator()(int r) const { int R = r0 + r; if (R >= 4080) R = 0; const int b = R / 510, rem = R - b * 510, n = rem >> 1, g = rem & 1; return (unsigned)(b * S_ + 16 * n) * 256u + g * 64; }
  DI bool ok(int r) const { return r0 + r < 4080; } };
DI void compress_item(const Params& p, int layer, int item, bf16_t* smem) {
  const int kv = item >> 5, tm = item & 31;
  const bf16_t* wl = (const bf16_t*)(p.ws + O_W) + (size_t)layer * W_LAYER;
  f32x4 acc[4][4]; zero_acc<4, 4>(acc);
  CmpRowPtr ap{(const bf16_t*)(p.ws + O_KVCMP) + kv * 128, tm * 128};
  RowPtr bp{wl + (kv ? W_1V : W_1K), (size_t)2048};
  gemm_main<4, 4, true>(acc, ap, 256, bp, 64, 32, smem);
  const int lane = TIDX() & 63, wid = TIDX() >> 6, wm = wid >> 2, wn = wid & 3, l15 = lane & 15, quad = lane >> 4;
  constexpr int LDH = 264; bf16_t* H = smem;
  const float* b1 = (const float*)(p.ws + O_BIAS1) + (size_t)(layer * 2 + kv) * 16 * 256;
#pragma unroll
  for (int j = 0; j < 4; ++j) {
    asm volatile("" ::: "memory");
    f32x4 bv = {0.f, 0.f, 0.f, 0.f};
    for (int pc = 0; pc < 16; ++pc) bv += *(const f32x4*)(b1 + pc * 256 + wn * 64 + j * 16 + quad * 4);
#pragma unroll
    for (int i = 0; i < 4; ++i) {
      const int row = wm * 64 + i * 16 + l15, col = wn * 64 + j * 16 + quad * 4;
      *(u32x2*)(H + row * LDH + col) = (u32x2){pk2(gelu_tanh(acc[i][j][0] + bv[0]), gelu_tanh(acc[i][j][1] + bv[1])), pk2(gelu_tanh(acc[i][j][2] + bv[2]), gelu_tanh(acc[i][j][3] + bv[3]))};
    }
  }
  __syncthreads();
  f32x4 a2[4];
#pragma unroll
  for (int j = 0; j < 4; ++j) a2[j] = (f32x4){0.f, 0.f, 0.f, 0.f};
  const bf16_t* w2 = wl + (kv ? W_2V : W_2K);
#pragma unroll
  for (int ks = 0; ks < 8; ++ks) {
    const bf16x8 a = *(const bf16x8*)(H + (wid * 16 + l15) * LDH + ks * 32 + quad * 8);
#pragma unroll
    for (int j = 0; j < 4; ++j) a2[j] = mfma16(a, *(const bf16x8*)(w2 + (size_t)(j * 16 + l15) * 256 + ks * 32 + quad * 8), a2[j]);
  }
  bf16_t* kc = (bf16_t*)(p.ws + O_KC); bf16_t* vct = (bf16_t*)(p.ws + O_VCT);
#pragma unroll
  for (int r = 0; r < 4; ++r) {
    const int R = tm * 128 + wid * 16 + quad * 4 + r;
    if (R < 4080) {
      const int b = R / 510, rem = R - b * 510, n = rem >> 1, g = rem & 1;
#pragma unroll
      for (int j = 0; j < 4; ++j) {
        const int d = j * 16 + l15; const bf16_t v = f2bf(a2[j][r]);
        if (kv == 0) kc[((size_t)(b * 2 + g) * 256 + n) * 64 + d] = v; else vct[((size_t)(b * 2 + g) * 64 + d) * 256 + n] = v;
      }
    }
  }
  __syncthreads();
}
DI void foxscan_item(const Params& p, int item, float* lds) {
  const int b = item >> 3, h = item & 7, tid = TIDX();
  const float* lf = (const float*)(p.ws + O_LOGF) + (size_t)b * S_ * 8 + h; float v[8]; float s = 0.f;
#pragma unroll
  for (int i = 0; i < 8; ++i) { s += lf[(size_t)(tid * 8 + i) * 8]; v[i] = s; }
  lds[tid] = s; __syncthreads();
  float off = 0.f;
  for (int i = 0; i < tid; ++i) off += lds[i];
  float* F2 = (float*)(p.ws + O_F2) + (size_t)(b * 8 + h) * S_ + tid * 8;
#pragma unroll
  for (int i = 0; i < 8; ++i) F2[i] = -(off + v[i]) * LOG2E_;
  __syncthreads();
}
DI void phase_b(const Params& p, int layer, unsigned char* smem) {
  if (blockIdx.x < 64) { compress_item(p, layer, blockIdx.x, (bf16_t*)smem); return; }
  for (int it = blockIdx.x - 64; it < 64; it += gridDim.x - 64) foxscan_item(p, it, (float*)smem);
  {
    const int xcd = blockIdx.x & 7, slot = (blockIdx.x >> 3) - 8, nslots = (gridDim.x >> 3) - 8;
    for (int li = slot; li < 16 * 7; li += nslots) {
      const int mg = li / 56, rem = li - mg * 56, tn = rem >> 3, tm = xcd * 16 + mg * 8 + (rem & 7);
      if (tn >= 5) mlaup_tile<2>(p, layer, tm, tn, (bf16_t*)smem); else if (tn >= 3) mlaup_tile<1>(p, layer, tm, tn, (bf16_t*)smem); else mlaup_tile<0>(p, layer, tm, tn, (bf16_t*)smem);
    }
  }
}

constexpr int KC_LD = 72, VC_LD = 264;
DI void cmp_item(const Params& p, int item, unsigned char* smem_) {
  const int b = item >> 6, g = (item >> 5) & 1, tt = item & 31, t0 = tt * 128;
  const int tid = TIDX(), lane = tid & 63, wid = tid >> 6, l15 = lane & 15, quad = lane >> 4;
  bf16_t* kcs = (bf16_t*)smem_;
  bf16_t* vcs = kcs + 256 * KC_LD;
  float* imps = (float*)smem_;
  const int nmax = (t0 + 96) >> 4;
  const int nsub = (nmax >> 4) + 1;
  {
    const bf16_t* kcg = (const bf16_t*)(p.ws + O_KC) + (size_t)(b * 2 + g) * 256 * 64; const bf16_t* vcg = (const bf16_t*)(p.ws + O_VCT) + (size_t)(b * 2 + g) * 64 * 256;
    const int nrows = ((nsub + 1) & ~1) * 16;
    for (int e = tid; e < nrows * 8; e += NTHR) {
      const int n = e >> 3, dc = (e & 7) * 8;
      *(u32x4*)(kcs + n * KC_LD + dc) = n < 255 ? *(const u32x4*)(kcg + (size_t)n * 64 + dc) : (u32x4){0u, 0u, 0u, 0u};
    }
    const int ncs = nrows >> 3;
    for (int e = tid; e < 64 * ncs; e += NTHR) {
      const int d = e / ncs, nc = (e - d * ncs) * 8;
      u32x4 v = *(const u32x4*)(vcg + (size_t)d * 256 + nc);
      if (nc + 8 > 255) v[3] &= 0x0000ffffu;
      *(u32x4*)(vcs + d * VC_LD + nc) = v;
    }
  }
  __syncthreads();
  const int tq = t0 + wid * 16 + l15;
  const size_t trow = (size_t)b * S_ + tq;
  float impa[16], p3a[16];
#pragma unroll
  for (int s = 0; s < 16; ++s) { impa[s] = 0.f; p3a[s] = 0.f; }
  const float* gts = (const float*)(p.ws + O_GATES) + trow * 24;
#pragma unroll 1
  for (int r4 = 0; r4 < 4; ++r4) {
    const int head = g * 4 + r4;
    const bf16_t* qp = (const bf16_t*)(p.ws + O_NSAQ) + trow * 512 + head * 64 + quad * 8;
    const bf16x8 q0 = *(const bf16x8*)qp, q1 = *(const bf16x8*)(qp + 32);
    auto score = [&](int s) -> f32x4 {
      const bf16_t* kr = kcs + (s * 16 + l15) * KC_LD + quad * 8;
      f32x4 a = {0.f, 0.f, 0.f, 0.f};
      a = mfma16(*(const bf16x8*)kr, q0, a); a = mfma16(*(const bf16x8*)(kr + 32), q1, a);
#pragma unroll
      for (int r = 0; r < 4; ++r) { const int n = s * 16 + quad * 4 + r; a[r] = (16 * n + 31 <= tq) ? a[r] : -INFINITY; }
      return a;
    };
    float mx = -INFINITY;
#pragma unroll 1
    for (int s = 0; s < nsub; ++s) { const f32x4 a = score(s); mx = fmaxf(mx, fmaxf(fmaxf(a[0], a[1]), fmaxf(a[2], a[3]))); }
    mx = fmaxf(mx, __shfl_xor(mx, 16)); mx = fmaxf(mx, __shfl_xor(mx, 32));
    if (mx == -INFINITY) mx = 0.f;
    float sum = 0.f;
#pragma unroll 1
    for (int s = 0; s < nsub; ++s) { const f32x4 a = score(s); sum += (ex2(a[0] - mx) + ex2(a[1] - mx)) + (ex2(a[2] - mx) + ex2(a[3] - mx)); }
    sum += __shfl_xor(sum, 16); sum += __shfl_xor(sum, 32);
    const float inv = 1.f / fmaxf(sum, 1e-30f);
    f32x4 oacc[4];
#pragma unroll
    for (int j = 0; j < 4; ++j) oacc[j] = (f32x4){0.f, 0.f, 0.f, 0.f};
#pragma unroll
    for (int c = 0; c < 8; ++c) {
      asm volatile("" ::: "memory");
      if (2 * c < nsub) {
        f32x4 pa = score(2 * c), pb = {-INFINITY, -INFINITY, -INFINITY, -INFINITY};
        if (2 * c + 1 < nsub) pb = score(2 * c + 1);
#pragma unroll
        for (int r = 0; r < 4; ++r) { pa[r] = ex2(pa[r] - mx) * inv; pb[r] = ex2(pb[r] - mx) * inv; }
        impa[2 * c] += pa[0] + pa[1] + pa[2] + 0.5f * pa[3]; p3a[2 * c] += pa[3];
        impa[2 * c + 1] += pb[0] + pb[1] + pb[2] + 0.5f * pb[3]; p3a[2 * c + 1] += pb[3];
        const u32x4 pw = {pk2(pa[0], pa[1]), pk2(pa[2], pa[3]), pk2(pb[0], pb[1]), pk2(pb[2], pb[3])};
        const bf16x8 pf = __builtin_bit_cast(bf16x8, pw);
#pragma unroll
        for (int j = 0; j < 4; ++j) {
          const bf16_t* vr = vcs + (j * 16 + l15) * VC_LD + c * 32 + quad * 4;
          const u32x2 lo = *(const u32x2*)vr, hi = *(const u32x2*)(vr + 16);
          const u32x4 vw = {lo[0], lo[1], hi[0], hi[1]};
          oacc[j] = mfma16(__builtin_bit_cast(bf16x8, vw), pf, oacc[j]);
        }
      }
    }
    const float g0 = gts[head * 3 + 0];
    bf16_t* op = (bf16_t*)(p.ws + O_ONSA) + trow * 512 + head * 64 + quad * 4;
#pragma unroll
    for (int j = 0; j < 4; ++j) store4(op + j * 16, oacc[j], g0);
  }
  __syncthreads();
  float* myimp = imps + wid * 1024 + l15 * 64;
  const int cur = tq >> 6;
#pragma unroll
  for (int s = 0; s < 16; ++s) {
    const float up = __shfl(p3a[s], (lane + 48) & 63);
    const float up0 = s ? __shfl(p3a[s ? s - 1 : 0], (lane + 48) & 63) : 0.f;
    const float prev = quad ? up : up0;
    float v = impa[s] + 0.5f * prev;
    const int j = 4 * s + quad;
    if (j == 0 || j == cur || j == cur - 1) v = 1e9f; else if (j > cur) v = -1e9f;
    myimp[j] = v;
  }
  __syncthreads();
  u64* sel = (u64*)(p.ws + O_SEL) + (size_t)(b * 2 + g) * S_ + t0 + wid * 16;
#pragma unroll 1
  for (int q = 0; q < 16; ++q) {
    const float mine = imps[wid * 1024 + q * 64 + lane]; int rank = 0;
#pragma unroll
    for (int i = 0; i < 64; ++i) { const float v = __uint_as_float(__builtin_amdgcn_readlane(__float_as_uint(mine), i)); rank += (v > mine || (v == mine && i < lane)) ? 1 : 0; }
    const u64 m = __ballot(rank < 16);
    if (lane == 0) sel[q] = m;
  }
  __syncthreads();
}
constexpr int PC_ITEMS = NB_ * 2 * 32;
DI void phase_c(const Params& p, unsigned char* smem) {
  for (int it = blockIdx.x; it < PC_ITEMS; it += gridDim.x) cmp_item(p, ((it / (int)gridDim.x) & 1) ? ((it & ~31) | (31 - (it & 31))) : it, smem);
}

enum { M_FOX = 0, M_MLA = 1, M_WIN = 2, M_SLC = 3 };
template <int MODE> struct ACfg { static constexpr int DQK = MODE == M_MLA ? 96 : 64, KLD = DQK + 8, NKC = DQK / 8 * 64, KCH = (NKC + NTHR - 1) / NTHR, K_ELEMS = 64 * KLD, V_ELEMS = 64 * 72, STAGE = K_ELEMS + V_ELEMS + 128; };
struct AState { f32x16 o[2]; f32x16 mr; float m, l; };

template <int MODE>
DI void flash_pass(AState& st, const bf16x8* qf, u64 tmask, u64 wmask,
                   const bf16_t* kbase, size_t kld, const bf16_t* kpe, const bf16_t* vtbase, const float* fbias,
                   int tq, u64 mysel, bf16_t* smem) {
  typedef ACfg<MODE> C;
  typedef std::integral_constant<int, 0> S0; typedef std::integral_constant<int, 1> S1;
  const int tid = TIDX(), lane = tid & 63, l31 = lane & 31, half = lane >> 5;
  u32x4 rk[2][C::KCH], rv[2]; float rf[2] = {0.f, 0.f};
  auto gload = [&](int j, auto setc) {
    constexpr int S = decltype(setc)::value;
    const int k0 = j * 64;
#pragma unroll
    for (int i = 0; i < C::KCH; ++i) {
      const int c0 = tid + NTHR * i, c = c0 < C::NKC ? c0 : C::NKC - 1;
      if constexpr (MODE == M_MLA) {
        const int key = c / 12, dc = c % 12;
        const bf16_t* src = dc < 8 ? kbase + (size_t)(k0 + key) * kld + dc * 8 : kpe + (size_t)(k0 + key) * 32 + (dc - 8) * 8;
        rk[S][i] = *(const u32x4*)src;
      } else { const int key = c >> 3, dc = c & 7; rk[S][i] = *(const u32x4*)(kbase + (size_t)(k0 + key) * kld + dc * 8); }
    }
    { const int d = tid >> 3, kc = tid & 7; rv[S] = *(const u32x4*)(vtbase + (size_t)d * S_ + k0 + kc * 8); }
    if constexpr (MODE == M_FOX) rf[S] = fbias[k0 + (tid & 63)];
  };
  auto sstore = [&](int stg, auto setc) {
    constexpr int S = decltype(setc)::value;
    bf16_t* Ks = smem + stg * C::STAGE; bf16_t* Vs = Ks + C::K_ELEMS;
#pragma unroll
    for (int i = 0; i < C::KCH; ++i) {
      const int c = tid + NTHR * i;
      if (c < C::NKC) {
        if constexpr (MODE == M_MLA) { const int key = c / 12, dc = c % 12; *(u32x4*)(Ks + key * C::KLD + dc * 8) = rk[S][i]; }
        else { const int key = c >> 3, dc = c & 7; *(u32x4*)(Ks + key * C::KLD + dc * 8) = rk[S][i]; }
      }
    }
    {
      const int d = tid >> 3, kc = tid & 7, cgp = kc >> 1, a = kc & 1;
      bf16_t* dst = Vs + d * 72 + cgp * 16 + 4 * a;
      *(u32x2*)dst = (u32x2){rv[S][0], rv[S][1]}; *(u32x2*)(dst + 8) = (u32x2){rv[S][2], rv[S][3]};
    }
    if constexpr (MODE == M_FOX) { if (tid < 64) ((float*)(Vs + C::V_ELEMS))[tid] = rf[S]; }
  };
  const int tmin = __builtin_amdgcn_readfirstlane(tq - l31), tmax = tmin + 31;
  auto compute = [&](int j, int stg) {
    bool active = (wmask >> j) & 1;
    if constexpr (MODE == M_SLC) active = active && __any((mysel >> j) & 1);
    if (active) {
      const bf16_t* Ks = smem + stg * C::STAGE; const bf16_t* Vs = Ks + C::K_ELEMS;
      f32x16 s0 = st.mr, s1 = st.mr;
      const bf16_t* kr = Ks + l31 * C::KLD + half * 8;
#pragma unroll
      for (int ks = 0; ks < C::DQK / 16; ++ks) {
        s0 = mfma32(*(const bf16x8*)(kr + ks * 16), qf[ks], s0);
        s1 = mfma32(*(const bf16x8*)(kr + 32 * C::KLD + ks * 16), qf[ks], s1);
      }
      const int k0 = j * 64;
      if constexpr (MODE == M_FOX) {
        const float* fb = (const float*)(Vs + C::V_ELEMS) + 4 * half;
#pragma unroll
        for (int g4 = 0; g4 < 4; ++g4) {
          const f32x4 b0 = *(const f32x4*)(fb + 8 * g4), b1 = *(const f32x4*)(fb + 32 + 8 * g4);
#pragma unroll
          for (int r = 0; r < 4; ++r) { s0[4 * g4 + r] += b0[r]; s1[4 * g4 + r] += b1[r]; }
        }
      }
      bool need = k0 + 63 > tmin;
      if constexpr (MODE == M_WIN) need = need || (k0 <= tmax - 512);
      if constexpr (MODE == M_SLC) {
        if (!need) {
          const bool rsel = ((mysel >> j) & 1) != 0;
          if (!__all(rsel)) {
#pragma unroll
            for (int r = 0; r < 16; ++r) { s0[r] = rsel ? s0[r] : -INFINITY; s1[r] = rsel ? s1[r] : -INFINITY; }
          }
        }
      }
      if (need) {
        const bool rowok = MODE == M_SLC ? ((mysel >> j) & 1) != 0 : true;
#pragma unroll
        for (int r = 0; r < 16; ++r) {
          const int key = k0 + (r & 3) + 8 * (r >> 2) + 4 * half;
          bool ok0 = rowok && key <= tq, ok1 = rowok && key + 32 <= tq;
          if constexpr (MODE == M_WIN) { ok0 = ok0 && (tq - key < 512); ok1 = ok1 && (tq - key - 32 < 512); }
          s0[r] = ok0 ? s0[r] : -INFINITY; s1[r] = ok1 ? s1[r] : -INFINITY;
        }
      }
      int im = (int)0x80000000;
#pragma unroll
      for (int r = 0; r < 16; ++r) im = max(im, max(__float_as_int(s0[r]), __float_as_int(s1[r])));
      im = max(im, __shfl_xor(im, 32));
      constexpr int TBITS = 0x41200000;
      f32x16 e0, e1;
#pragma unroll
      for (int r = 0; r < 16; ++r) { e0[r] = ex2(s0[r]); e1[r] = ex2(s1[r]); }
      if (__any(im > TBITS)) {
        const float d = im > TBITS ? __int_as_float(im) : 0.f;
        const float a = ex2(-d);
#pragma unroll
        for (int r = 0; r < 16; ++r) { e0[r] = ex2(s0[r] - d); e1[r] = ex2(s1[r] - d); st.o[0][r] *= a; st.o[1][r] *= a; }
        st.l *= a; st.m += d;
#pragma unroll
        for (int r = 0; r < 16; ++r) st.mr[r] = -st.m;
      }
      float sum = 0.f;
#pragma unroll
      for (int r = 0; r < 16; ++r) { s0[r] = e0[r]; s1[r] = e1[r]; sum += e0[r] + e1[r]; }
      st.l += sum;
      const bf16_t* vr = Vs + l31 * 72 + half * 8;
#pragma unroll
      for (int c = 0; c < 4; ++c) {
        u32x4 pw;
        if (c < 2) pw = (u32x4){pk2(s0[8 * c + 0], s0[8 * c + 1]), pk2(s0[8 * c + 2], s0[8 * c + 3]), pk2(s0[8 * c + 4], s0[8 * c + 5]), pk2(s0[8 * c + 6], s0[8 * c + 7])};
        else pw = (u32x4){pk2(s1[8 * (c - 2) + 0], s1[8 * (c - 2) + 1]), pk2(s1[8 * (c - 2) + 2], s1[8 * (c - 2) + 3]), pk2(s1[8 * (c - 2) + 4], s1[8 * (c - 2) + 5]), pk2(s1[8 * (c - 2) + 6], s1[8 * (c - 2) + 7])};
        const bf16x8 pf = __builtin_bit_cast(bf16x8, pw);
        st.o[0] = mfma32(*(const bf16x8*)(vr + c * 16), pf, st.o[0]);
        st.o[1] = mfma32(*(const bf16x8*)(vr + 32 * 72 + c * 16), pf, st.o[1]);
      }
    }
  };
  u64 tm = tmask;
  if (tm == 0) return;
  auto pop = [&]() -> int { if (!tm) return -1; const int j = __builtin_ctzll(tm); tm &= tm - 1; return j; };
  int t0 = pop(), t1 = pop(), t2 = pop(), t3 = pop();
  gload(t0, S0{}); gload(t1 >= 0 ? t1 : t0, S1{});
  sstore(0, S0{}); sstore(1, S1{});
  gload(t2 >= 0 ? t2 : t0, S0{}); gload(t3 >= 0 ? t3 : t0, S1{});
  __syncthreads();
  int stg = 0;
  auto step = [&](auto setc) -> bool {
    const int t4 = pop();
    sstore(stg == 0 ? 2 : stg - 1, setc);
    gload(t4 >= 0 ? t4 : t0, setc);
    __builtin_amdgcn_sched_barrier(0);
    compute(t0, stg);
    __syncthreads();
    if (t1 < 0) return true;
    t0 = t1; t1 = t2; t2 = t3; t3 = t4; stg = stg == 2 ? 0 : stg + 1;
    return false;
  };
  for (;;) {
    if (step(S0{})) break;
    if (step(S1{})) break;
  }
}
DI void astate_init(AState& s) {
#pragma unroll
  for (int r = 0; r < 16; ++r) { s.o[0][r] = 0.f; s.o[1][r] = 0.f; }
#pragma unroll
  for (int r = 0; r < 16; ++r) s.mr[r] = 0.f;
  s.m = 0.f; s.l = 0.f;
}
DI u64 lowbits(int n) { return n >= 64 ? ~0ull : ((1ull << n) - 1ull); }

template <int MODE> DI void dense_attn_item(const Params& p, int b, int h, int qt, bf16_t* smem) {
  const int lane = TIDX() & 63, wid = TIDX() >> 6, l31 = lane & 31, half = lane >> 5;
  const int t0 = qt * 256, tq = t0 + wid * 32 + l31; const size_t trow = (size_t)b * S_ + tq;
  constexpr int NQ = ACfg<MODE>::DQK / 16;
  bf16x8 qf[NQ];
  const bf16_t* qp = MODE == M_FOX ? (const bf16_t*)(p.ws + O_FOXQ) + trow * 512 + h * 64 : (const bf16_t*)(p.ws + O_MLAQ) + trow * 768 + h * 96;
#pragma unroll
  for (int ks = 0; ks < NQ; ++ks) qf[ks] = *(const bf16x8*)(qp + ks * 16 + half * 8);
  AState st; astate_init(st);
  const u64 tmask = lowbits(4 * qt + 4), wmask = lowbits(((t0 + wid * 32 + 31) >> 6) + 1);
  if constexpr (MODE == M_FOX)
    flash_pass<M_FOX>(st, qf, tmask, wmask, (const bf16_t*)(p.ws + O_FOXK) + (size_t)b * S_ * 512 + h * 64, 512, nullptr,
                      (const bf16_t*)(p.ws + O_FOXVT) + (size_t)(b * 8 + h) * 64 * S_, (const float*)(p.ws + O_F2) + (size_t)(b * 8 + h) * S_, tq, 0ull, smem);
  else
    flash_pass<M_MLA>(st, qf, tmask, wmask, (const bf16_t*)(p.ws + O_MLAKN) + (size_t)b * S_ * 512 + h * 64, 512, (const bf16_t*)(p.ws + O_MLAKPE) + (size_t)b * S_ * 32,
                      (const bf16_t*)(p.ws + O_MLAVT) + (size_t)(b * 8 + h) * 64 * S_, nullptr, tq, 0ull, smem);
  const float l = st.l + __shfl_xor(st.l, 32), inv = 1.f / fmaxf(l, 1e-30f);
  bf16_t* op = (bf16_t*)qp;
#pragma unroll
  for (int dt = 0; dt < 2; ++dt)
#pragma unroll
    for (int g4 = 0; g4 < 4; ++g4) {
      const int d = dt * 32 + g4 * 8 + half * 4;
      *(u32x2*)(op + d) = (u32x2){pk2(st.o[dt][4 * g4] * inv, st.o[dt][4 * g4 + 1] * inv), pk2(st.o[dt][4 * g4 + 2] * inv, st.o[dt][4 * g4 + 3] * inv)};
    }
}
DI void nsa_attn_item(const Params& p, int b, int g, int qt, bf16_t* smem) {
  const int lane = TIDX() & 63, wid = TIDX() >> 6, l31 = lane & 31, half = lane >> 5;
  const int t0 = qt * 64, tw0 = t0 + (wid >> 2) * 32, tq = tw0 + l31, head = g * 4 + (wid & 3); const size_t trow = (size_t)b * S_ + tq;
  bf16x8 qf[4];
  const bf16_t* qp = (const bf16_t*)(p.ws + O_NSAQ) + trow * 512 + head * 64;
#pragma unroll
  for (int ks = 0; ks < 4; ++ks) qf[ks] = *(const bf16x8*)(qp + ks * 16 + half * 8);
  {
    const float* rp = (const float*)(p.ws + O_ROPE8) + trow * 16;
    u32x4 me = __builtin_bit_cast(u32x4, qf[0]), ot;
#pragma unroll
    for (int e = 0; e < 4; ++e) ot[e] = __shfl_xor(me[e], 32);
    unsigned res[4];
#pragma unroll
    for (int e = 0; e < 4; ++e) {
      float o2[2];
#pragma unroll
      for (int u = 0; u < 2; ++u) {
        const int f = 2 * e + u; const float cs = rp[2 * f], sn = rp[2 * f + 1];
        const float a = bf2f((bf16_t)(u ? me[e] >> 16 : me[e] & 0xffffu)), o = bf2f((bf16_t)(u ? ot[e] >> 16 : ot[e] & 0xffffu));
        o2[u] = half == 0 ? a * cs - o * sn : a * cs + o * sn;
      }
      res[e] = pk2(o2[0], o2[1]);
    }
    qf[0] = __builtin_bit_cast(bf16x8, (u32x4){res[0], res[1], res[2], res[3]});
  }
  const float* gts = (const float*)(p.ws + O_GATES) + trow * 24 + head * 3;
  const int cur = t0 >> 6;
  f32x16 res[2];
  {
    AState st; astate_init(st);
    const int first = t0 >= 511 ? (t0 - 511) >> 6 : 0, firstw = tw0 >= 511 ? (tw0 - 511) >> 6 : 0;
    const u64 tmask = lowbits(cur + 1) & ~lowbits(first), wmask = lowbits(cur + 1) & ~lowbits(firstw);
    flash_pass<M_WIN>(st, qf, tmask, wmask, (const bf16_t*)(p.ws + O_KWIN) + (size_t)b * S_ * 128 + g * 64, 128, nullptr,
                      (const bf16_t*)(p.ws + O_VWINT) + (size_t)(b * 2 + g) * 64 * S_, nullptr, tq, 0ull, smem);
    const float l = st.l + __shfl_xor(st.l, 32), sc = gts[2] / fmaxf(l, 1e-30f);
#pragma unroll
    for (int r = 0; r < 16; ++r) { res[0][r] = st.o[0][r] * sc; res[1][r] = st.o[1][r] * sc; }
  }
  {
    AState st; astate_init(st);
    const u64* selp = (const u64*)(p.ws + O_SEL) + (size_t)(b * 2 + g) * S_;
    const u64 mysel = selp[tq];
    const u64 m64 = selp[t0 + lane];
    unsigned lo = (unsigned)m64, hi = (unsigned)(m64 >> 32);
#pragma unroll
    for (int o = 32; o >= 1; o >>= 1) { lo |= __shfl_xor(lo, o); hi |= __shfl_xor(hi, o); }
    const u64 um = (((u64)(unsigned)__builtin_amdgcn_readfirstlane(hi) << 32) | (u64)(unsigned)__builtin_amdgcn_readfirstlane(lo)) & lowbits(cur + 1);
    flash_pass<M_SLC>(st, qf, um, um, (const bf16_t*)(p.ws + O_KSLC) + (size_t)b * S_ * 128 + g * 64, 128, nullptr,
                      (const bf16_t*)(p.ws + O_VSLCT) + (size_t)(b * 2 + g) * 64 * S_, nullptr, tq, mysel, smem);
    const float l = st.l + __shfl_xor(st.l, 32), sc = gts[1] / fmaxf(l, 1e-30f);
#pragma unroll
    for (int r = 0; r < 16; ++r) { res[0][r] += st.o[0][r] * sc; res[1][r] += st.o[1][r] * sc; }
  }
  bf16_t* op = (bf16_t*)(p.ws + O_ONSA) + trow * 512 + head * 64;
#pragma unroll
  for (int dt = 0; dt < 2; ++dt)
#pragma unroll
    for (int g4 = 0; g4 < 4; ++g4) {
      const int d = dt * 32 + g4 * 8 + half * 4;
      const u32x2 oc = *(const u32x2*)(op + d);
      const float c0 = bf2f((bf16_t)(oc[0] & 0xffffu)), c1 = bf2f((bf16_t)(oc[0] >> 16)), c2 = bf2f((bf16_t)(oc[1] & 0xffffu)), c3 = bf2f((bf16_t)(oc[1] >> 16));
      *(u32x2*)(op + d) = (u32x2){pk2(res[dt][4 * g4] + c0, res[dt][4 * g4 + 1] + c1), pk2(res[dt][4 * g4 + 2] + c2, res[dt][4 * g4 + 3] + c3)};
    }
}
constexpr int PD_ITEMS = 16 * 192;
DI void phase_d(const Params& p, int layer, unsigned char* smem) {
  unsigned* qctr = (unsigned*)(p.ws + O_BAR) + 130 + layer;
  int* s_it = (int*)(smem + SMEM_BYTES - 16);
  for (;;) {
    if (TIDX() == 0) *s_it = (int)atomicAdd(qctr, 1u);
    __syncthreads();
    const int it = *s_it;
    __syncthreads();
    if (it >= PD_ITEMS) break;
    const int r = it / 192, w = it % 192, qt = 15 - r;
    if (w < 64) dense_attn_item<M_MLA>(p, w >> 3, w & 7, qt, (bf16_t*)smem);
    else if (w < 128) dense_attn_item<M_FOX>(p, (w - 64) >> 3, (w - 64) & 7, qt, (bf16_t*)smem);
    else { const int i = w - 128, bg = i & 15, q4 = i >> 4; nsa_attn_item(p, bg >> 1, bg & 1, qt * 4 + q4, (bf16_t*)smem); }
  }
}

DI void merge_tile(const Params& p, int layer, int tm, int tn, bf16_t* smem) {
  typedef GemmLds<8, 2> L;
  const bf16_t* wl = (const bf16_t*)(p.ws + O_W) + (size_t)layer * W_LAYER;
  const int tid = TIDX(), lane = tid & 63, wid = tid >> 6, wm = wid >> 2, wn = wid & 3, l15 = lane & 15, quad = lane >> 4;
  f32x4 mg[8][2]; zero_acc<8, 2>(mg);
  f32x4 acc[8][2]; zero_acc<8, 2>(acc);
  unsigned* gsp = (unsigned*)((unsigned char*)smem + 2 * L::STAGE * 2) + tid;
  const bf16_t* la; const bf16_t* lb; unsigned lald, lbld; int laks, lnk;
  auto get_seg = [&](int sg) {
    const int br = sg >> 1;
    if ((sg & 1) == 0) { la = (const bf16_t*)(p.ws + O_XG) + (size_t)tm * 256 * D_; lald = D_; laks = 64; lb = wl + W_G + ((size_t)br * 1024 + tn * 128) * D_; lbld = D_; lnk = 16; }
    else {
      lald = br == 2 ? 768u : 512u; laks = br == 2 ? 96 : 64; lnk = 8; lbld = 512u;
      la = (const bf16_t*)(p.ws + (br == 0 ? O_ONSA : br == 1 ? O_FOXQ : O_MLAQ)) + (size_t)tm * 256 * lald;
      lb = wl + (br == 0 ? W_BN : br == 1 ? W_BF : W_BM) + (size_t)tn * 128 * 512;
    }
  };
  unsigned pa0, pb0; u32x4 ra[4], rb[2];
  auto set_offsets = [&]() { pa0 = (unsigned)(tid >> 3) * lald + (tid & 7) * 8; pb0 = (unsigned)(tid >> 3) * lbld + (tid & 7) * 8; };
  int ls = 0, lkt = 0;
  get_seg(0); set_offsets();
  auto gload_next = [&]() {
    const bf16_t* ab = la + (size_t)lkt * laks; const bf16_t* bb = lb + (size_t)lkt * 64;
#pragma unroll
    for (int i = 0; i < 4; ++i) ra[i] = *(const u32x4*)(ab + pa0 + (size_t)i * 64 * lald);
#pragma unroll
    for (int i = 0; i < 2; ++i) rb[i] = *(const u32x4*)(bb + pb0 + (size_t)i * 64 * lbld);
    if (++lkt == lnk) {
      if (ls + 1 < 6) { ++ls; lkt = 0; get_seg(ls); set_offsets(); } else lkt = lnk - 1;
    }
  };
  auto sstore = [&](int buf) {
    bf16_t* As = smem + buf * L::STAGE; bf16_t* Bs = As + L::A_ELEMS;
#pragma unroll
    for (int i = 0; i < 4; ++i) { const int c = tid + NTHR * i; *(u32x4*)(As + (c >> 3) * LDT + (c & 7) * 8) = ra[i]; }
#pragma unroll
    for (int i = 0; i < 2; ++i) { const int c = tid + NTHR * i; *(u32x4*)(Bs + (c >> 3) * LDT + (c & 7) * 8) = rb[i]; }
  };
  gload_next(); sstore(0); gload_next(); __syncthreads();
  int buf = 0;
#pragma unroll 1
  for (int sg = 0; sg < 6; ++sg) {
    const int nk = (sg & 1) ? 8 : 16;
#pragma unroll 1
    for (int kt = 0; kt < nk; ++kt) {
      sstore(buf ^ 1);
      gload_next();
      __builtin_amdgcn_sched_barrier(0);
      const bf16_t* As = smem + buf * L::STAGE + (wm * 128 + l15) * LDT + quad * 8;
      const bf16_t* Bs = smem + buf * L::STAGE + L::A_ELEMS + (wn * 32 + l15) * LDT + quad * 8;
#pragma unroll
      for (int ks = 0; ks < 2; ++ks) {
        if (ks == 1) asm volatile("" ::: "memory");
        bf16x8 b[2];
#pragma unroll
        for (int j = 0; j < 2; ++j) b[j] = *(const bf16x8*)(Bs + j * 16 * LDT + ks * 32);
#pragma unroll
        for (int i = 0; i < 8; ++i) {
          const bf16x8 a = *(const bf16x8*)(As + i * 16 * LDT + ks * 32);
#pragma unroll
          for (int j = 0; j < 2; ++j) acc[i][j] = mfma16(b[j], a, acc[i][j]);
        }
      }
      __syncthreads();
      buf ^= 1;
    }
    if ((sg & 1) == 0) {
      const int t2 = TIDX(), row0 = tm * 256 + ((t2 >> 8) & 1) * 128 + (t2 & 15);
#pragma unroll
      for (int i = 0; i < 8; ++i) {
        asm volatile("" ::: "memory");
        const float rs = rstd_from16((const float*)(p.ws + O_SSQ) + (size_t)(row0 + i * 16) * 16, 1.f / 1024.f);
#pragma unroll
        for (int j = 0; j < 2; ++j) {
          unsigned w = 0;
#pragma unroll
          for (int r = 0; r < 4; ++r) w |= (unsigned)__float2int_rn(sigmoidf_(acc[i][j][r] * rs) * 255.f) << (8 * r);
          gsp[(i * 2 + j) * NTHR] = w;
        }
      }
    } else {
#pragma unroll
      for (int i = 0; i < 8; ++i)
#pragma unroll
        for (int j = 0; j < 2; ++j) {
          asm volatile("" ::: "memory");
          const unsigned w = gsp[(i * 2 + j) * NTHR];
#pragma unroll
          for (int r = 0; r < 4; ++r) mg[i][j][r] += (float)((w >> (8 * r)) & 0xffu) * (1.f / 255.f) * acc[i][j][r];
        }
    }
    zero_acc<8, 2>(acc);
  }
  const int t3 = TIDX(), lane3 = t3 & 63, wid3 = t3 >> 6;
  bf16_t* stg = smem + wid3 * (128 * 40);
#pragma unroll
  for (int i = 0; i < 8; ++i)
#pragma unroll
    for (int j = 0; j < 2; ++j) *(u32x2*)(stg + (i * 16 + (lane3 & 15)) * 40 + j * 16 + (lane3 >> 4) * 4) = (u32x2){pk2(mg[i][j][0], mg[i][j][1]), pk2(mg[i][j][2], mg[i][j][3])};
  stage_out<128, 32, 40>(stg, (bf16_t*)(p.ws + O_MERGED) + (size_t)(tm * 256 + (wid3 >> 2) * 128) * D_ + tn * 128 + (wid3 & 3) * 32, (size_t)D_, lane3);
  __syncthreads();
}
DI void phase_e(const Params& p, int layer, unsigned char* smem) {
  xcd_tiles(16, 8, [&](int tm, int tn) { merge_tile(p, layer, tm, tn, (bf16_t*)smem); });
}

DI void resid_tile(const Params& p, const bf16_t* A, int K, const bf16_t* W, const float* xold, const float* gnext, int tm, int tn, bf16_t* smem) {
  f32x4 acc[8][4]; zero_acc<8, 4>(acc);
  RowPtr ap{A + (size_t)tm * 256 * K, (size_t)K}, bp{W + (size_t)tn * 256 * K, (size_t)K};
  gemm_main<8, 4, true>(acc, ap, 64, bp, 64, K / 64, smem);
  const int lane = TIDX() & 63, wid = TIDX() >> 6, wm = wid >> 2, wn = wid & 3, l15 = lane & 15, quad = lane >> 4;
  bf16_t* stg = smem + wid * STG_WAVE;
#pragma unroll
  for (int i = 0; i < 8; ++i) {
    const int t = tm * 256 + wm * 128 + i * 16 + l15, c0 = tn * 256 + wn * 64 + quad * 4; float s = 0.f;
#pragma unroll
    for (int j = 0; j < 4; ++j) {
      const size_t off = (size_t)t * D_ + c0 + j * 16;
      const f32x4 xn = *(const f32x4*)(xold + off) + acc[i][j];
      *(f32x4*)(p.out + off) = xn;
      s += xn[0] * xn[0] + xn[1] * xn[1] + xn[2] * xn[2] + xn[3] * xn[3];
      if (gnext) { const f32x4 gv = *(const f32x4*)(gnext + c0 + j * 16); *(u32x2*)(stg + (i * 16 + l15) * STG_LD + j * 16 + quad * 4) = (u32x2){pk2(xn[0] * gv[0], xn[1] * gv[1]), pk2(xn[2] * gv[2], xn[3] * gv[3])}; }
    }
    s += __shfl_xor(s, 16); s += __shfl_xor(s, 32);
    if (quad == 0) ((float*)(p.ws + O_SSQ))[(size_t)t * 16 + tn * 4 + wn] = s;
  }
  if (gnext) stage_out<128, 64, STG_LD>(stg, (bf16_t*)(p.ws + O_XG) + (size_t)(tm * 256 + wm * 128) * D_ + tn * 256 + wn * 64, (size_t)D_, lane);
  __syncthreads();
}
DI void phase_f(const Params& p, int layer, unsigned char* smem) {
  const bf16_t* wl = (const bf16_t*)(p.ws + O_W) + (size_t)layer * W_LAYER;
  xcd_tiles(16, 4, [&](int tm, int tn) { resid_tile(p, (const bf16_t*)(p.ws + O_MERGED), 1024, wl + W_OUT, layer == 0 ? p.x : p.out, p.ffn_norm + layer * D_, tm, tn, (bf16_t*)smem); });
}
DI void phase_h(const Params& p, int layer, unsigned char* smem) {
  const bf16_t* wl = (const bf16_t*)(p.ws + O_W) + (size_t)layer * W_LAYER;
  xcd_tiles(16, 4, [&](int tm, int tn) { resid_tile(p, (const bf16_t*)(p.ws + O_ACT), DFF_, wl + W_DN, p.out, layer == 0 ? p.mix_norm + D_ : nullptr, tm, tn, (bf16_t*)smem); });
}

struct UpRowPtr { const bf16_t* base; int s0;
  DI unsigned operator()(int r) const { const int s = s0 + r; return (unsigned)((s < 0 || s >= S_) ? 0 : s) * (unsigned)D_; }
  DI bool ok(int r) const { const int s = s0 + r; return s >= 0 && s < S_; } };
constexpr int PG_MT = 17;
DI void ffnup_tile(const Params& p, int layer, int b, int mt, int tn, bf16_t* smem) {
  const bf16_t* wl = (const bf16_t*)(p.ws + O_W) + (size_t)layer * W_LAYER;
  f32x4 acc[8][4]; zero_acc<8, 4>(acc);
  const int s0 = 254 * mt - 2;
  UpRowPtr ap{(const bf16_t*)(p.ws + O_XG) + (size_t)b * S_ * D_, s0}; RowPtr bp{wl + W_UP + (size_t)tn * 256 * D_, (size_t)D_};
  if (s0 + 256 > S_) {
    const int nvalid = S_ - s0 - (TIDX() >> 8) * 128;
    const int cnt = __builtin_amdgcn_readfirstlane(nvalid <= 0 ? 0 : (nvalid >= 128 ? 8 : (nvalid + 15) >> 4));
    gemm_main<8, 4, true>(acc, ap, 64, bp, 64, 16, smem, cnt);
  } else gemm_main<8, 4, true>(acc, ap, 64, bp, 64, 16, smem);
  const int tid = TIDX(), lane = tid & 63, wid = tid >> 6, wm = wid >> 2, wn = wid & 3, l15 = lane & 15, quad = lane >> 4;
  constexpr int LDU = 136; bf16_t* U = smem; bf16_t* V = smem + 256 * LDU;
  {
    bf16_t* dstb = (wn < 2 ? U : V) + (wn & 1) * 64 + quad * 4;
#pragma unroll
    for (int i = 0; i < 8; ++i) {
      const int row = wm * 128 + i * 16 + l15, s = s0 + row;
      const float rs = (s >= 0 && s < S_) ? rstd_from16((const float*)(p.ws + O_SSQ) + ((size_t)b * S_ + s) * 16, 1.f / 1024.f) : 0.f;
#pragma unroll
      for (int j = 0; j < 4; ++j) store4(dstb + row * LDU + j * 16, acc[i][j], rs);
    }
  }
  __syncthreads();
  {
    const int cc = tid & 15, cg0 = tn * 128 + cc * 8;
    const float* cw = p.conv_w + (size_t)layer * 3 * DFF_ + cg0; const float* cbp = p.conv_b + (size_t)layer * DFF_ + cg0;
    float w0[8], w1[8], w2[8], cb[8];
#pragma unroll
    for (int e = 0; e < 8; ++e) { w0[e] = cw[e]; w1[e] = cw[DFF_ + e]; w2[e] = cw[2 * DFF_ + e]; cb[e] = cbp[e]; }
    bf16_t* act = (bf16_t*)(p.ws + O_ACT);
#pragma unroll 2
    for (int it = 0; it < 8; ++it) {
      const int row = it * 32 + (tid >> 4), s = s0 + row;
      if (row >= 2 && s < S_) {
        const u32x4 u0 = *(const u32x4*)(U + (row - 2) * LDU + cc * 8), u1 = *(const u32x4*)(U + (row - 1) * LDU + cc * 8), u2 = *(const u32x4*)(U + row * LDU + cc * 8), vv = *(const u32x4*)(V + row * LDU + cc * 8);
        unsigned o[4];
#pragma unroll
        for (int e = 0; e < 4; ++e) {
          float r2[2];
#pragma unroll
          for (int h = 0; h < 2; ++h) {
            const int k = 2 * e + h;
            const float a0 = bf2f((bf16_t)(h ? u0[e] >> 16 : u0[e] & 0xffffu)), a1 = bf2f((bf16_t)(h ? u1[e] >> 16 : u1[e] & 0xffffu)), a2 = bf2f((bf16_t)(h ? u2[e] >> 16 : u2[e] & 0xffffu)), vx = bf2f((bf16_t)(h ? vv[e] >> 16 : vv[e] & 0xffffu));
            const float uc = w0[k] * a0 + w1[k] * a1 + w2[k] * a2 + cb[k];
            r2[h] = uc * sigmoidf_(uc) * vx;
          }
          o[e] = pk2(r2[0], r2[1]);
        }
        __builtin_nontemporal_store((u32x4){o[0], o[1], o[2], o[3]}, (u32x4*)(act + ((size_t)b * S_ + s) * DFF_ + cg0));
      }
    }
  }
  __syncthreads();
}
DI void phase_g(const Params& p, int layer, unsigned char* smem) {
  xcd_tiles(PG_MT, 22, [&](int tmg, int tn) { ffnup_tile(p, layer, tmg / PG_MT, tmg % PG_MT, tn, (bf16_t*)smem); });
}

DI void phase_final(const Params& p) {
  const int lane = TIDX() & 63, wid = TIDX() >> 6;
  for (int it = blockIdx.x; it < T_ / 8; it += gridDim.x) {
    const int t = it * 8 + wid; const float rs = rstd_from16((const float*)(p.ws + O_SSQ) + (size_t)t * 16, 1.f / 1024.f);
    float* xr = p.out + (size_t)t * D_;
#pragma unroll
    for (int c = 0; c < 4; ++c) { const int k = c * 256 + lane * 4; const f32x4 v = *(const f32x4*)(xr + k), gv = *(const f32x4*)(p.final_norm + k); *(f32x4*)(xr + k) = v * rs * gv; }
  }
}

#define XB_TMO      128
#define XB_XCNT(j)  (256  + 64 * (j))
#define XB_XSUB(j)  (1280 + 64 * (j))
#define XB_XGEN(j)  (2304 + 64 * (j))
#define XB_TOP      3328
#define XB_TOPGEN   3392
#define XCD_BAR_WORDS 3456
#define XB_SPIN_CAP (1u << 22)
#define LAS __attribute__((address_space(3)))
DI unsigned xb_ld(unsigned* p)              { return __hip_atomic_load(p, __ATOMIC_RELAXED, __HIP_MEMORY_SCOPE_AGENT); }
DI unsigned xb_add(unsigned* p, unsigned v) { return __hip_atomic_fetch_add(p, v, __ATOMIC_RELAXED, __HIP_MEMORY_SCOPE_AGENT); }
DI unsigned xb_xcc_id() { return (unsigned)__builtin_amdgcn_s_getreg((3 << 11) | 20) & 0xFu; }
#define XB_SPIN(cond, bar) do { unsigned _sp = 0; while (cond) { __builtin_amdgcn_s_sleep(1); \
    if ((++_sp & 255u) == 0u) { if (xb_ld(&(bar)[XB_TMO])) break; if (_sp > XB_SPIN_CAP) { atomicAdd(&(bar)[XB_TMO], 1u); break; } } } } while (0)
struct XcdBarrier { unsigned* bar; unsigned x; volatile LAS unsigned* st; };
DI XcdBarrier xcd_barrier_post(unsigned* bar, volatile LAS unsigned* st) {
  XcdBarrier b; b.bar = bar; b.x = xb_xcc_id(); b.st = st;
  if (threadIdx.x == 0) (void)xb_add(&bar[XB_XCNT(b.x)], 1u);
  return b;
}
DI void xcd_barrier_complete(unsigned* bar, unsigned x, unsigned& nloc, unsigned& nx) {
  const unsigned G = gridDim.x * gridDim.y * gridDim.z;
  unsigned sum, cnt, mine, sp = 0u;
  for (;;) {
    sum = 0u; cnt = 0u; mine = 0u;
#pragma unroll
    for (unsigned j = 0; j < 16; ++j) { const unsigned c = xb_ld(&bar[XB_XCNT(j)]); sum += c; cnt += (c > 0u) ? 1u : 0u; mine = (j == x) ? c : mine; }
    if (sum == G) break;
    __builtin_amdgcn_s_sleep(1);
    if ((++sp & 255u) == 0u) { if (xb_ld(&bar[XB_TMO])) break; if (sp > XB_SPIN_CAP) { atomicAdd(&bar[XB_TMO], 1u); break; } }
  }
  nloc = mine > 0u ? mine : 1u; nx = cnt > 0u ? cnt : 1u;
}
DI void xcd_barrier(const XcdBarrier& b) {
  asm volatile("s_waitcnt vmcnt(0)" ::: "memory");
  __syncthreads();
  if (threadIdx.x == 0) {
    unsigned* bar = b.bar;
    __builtin_amdgcn_s_waitcnt(0);
    unsigned nloc = b.st[0], nx = b.st[1];
    if (nloc == 0u) { xcd_barrier_complete(bar, b.x, nloc, nx); b.st[0] = nloc; b.st[1] = nx; }
    const unsigned old = xb_add(&bar[XB_XSUB(b.x)], 1u);
    const unsigned gen = old / nloc;
    if (old + 1u == (gen + 1u) * nloc) {
      __builtin_amdgcn_fence(__ATOMIC_RELEASE, "agent");
      asm volatile("s_waitcnt vmcnt(0)" ::: "memory");
      const unsigned og = xb_add(&bar[XB_TOP], 1u);
      const unsigned tg = og / nx;
      if (og + 1u == (tg + 1u) * nx) xb_add(&bar[XB_TOPGEN], 1u);
      else XB_SPIN(xb_ld(&bar[XB_TOPGEN]) == tg, bar);
      __builtin_amdgcn_fence(__ATOMIC_ACQUIRE, "agent");
      xb_add(&bar[XB_XGEN(b.x)], 1u);
      asm volatile("s_waitcnt vmcnt(0)" ::: "memory");
    } else {
      XB_SPIN(xb_ld(&bar[XB_XGEN(b.x)]) == gen, bar);
      __builtin_amdgcn_fence(__ATOMIC_ACQUIRE, "agent");
      asm volatile("s_waitcnt vmcnt(0)" ::: "memory");
    }
  }
  __syncthreads();
}
DI void run_phase(const Params& p, int ph, unsigned char* smem) {
  if (ph == 0) { phase_prep(p, smem); return; }
  if (ph == 17) { phase_final(p); return; }
  const int layer = (ph - 1) >> 3, s = (ph - 1) & 7;
#ifdef PROBE_DUP
  if ((PROBE_DUP >> s) & 1) {
    switch (s) { case 0: phase_inproj(p, layer, smem); break; case 1: phase_b(p, layer, smem); break; case 2: phase_c(p, smem); break; case 4: phase_e(p, layer, smem); break; case 6: phase_g(p, layer, smem); break; default: break; }
    __syncthreads();
  }
#endif
  switch (s) {
    case 0: phase_inproj(p, layer, smem); break;
    case 1: phase_b(p, layer, smem); break;
    case 2: phase_c(p, smem); break;
    case 3: phase_d(p, layer, smem); break;
    case 4: phase_e(p, layer, smem); break;
    case 5: phase_f(p, layer, smem); break;
    case 6: phase_g(p, layer, smem); break;
    default: phase_h(p, layer, smem); break;
  }
}
constexpr int N_PHASES = 18;

#if ONE_LAUNCH
template <int PH> DI void run_all(const Params& p, unsigned char* smem, cg::grid_group& grid, const XcdBarrier& xb) {
  run_phase(p, PH, smem);
  if constexpr (PH + 1 < N_PHASES) {
    if constexpr (PH == 0) grid.sync(); else xcd_barrier(xb);
    run_all<PH + 1>(p, smem, grid, xb);
  }
}
__global__ void __launch_bounds__(NTHR, 2) mega_kernel(Params p) {
  __shared__ __attribute__((aligned(16))) unsigned char smem[SMEM_BYTES];
  __shared__ uint4 xb_words;
  if (threadIdx.x == 0) xb_words = make_uint4(0u, 0u, 0u, 0u);
  __syncthreads();
  const XcdBarrier xb = xcd_barrier_post((unsigned*)(p.ws + O_BAR), (volatile LAS unsigned*)&xb_words);
  cg::grid_group grid = cg::this_grid();
  run_all<0>(p, smem, grid, xb);
}
#else
template <int PH> __global__ void __launch_bounds__(NTHR, 2) phase_kernel(Params p) {
  __shared__ __attribute__((aligned(16))) unsigned char smem[SMEM_BYTES];
  run_phase(p, PH, smem);
}
template <int PH> static void launch_phases(const Params& p, hipStream_t stream) {
  hipLaunchKernelGGL((phase_kernel<PH>), dim3(256), dim3(NTHR), 0, stream, p);
  if constexpr (PH + 1 < N_PHASES) launch_phases<PH + 1>(p, stream);
}
#endif

extern "C" void kernel_launch(void* const* d_in, const int* in_sizes, int n_in, void* d_out, int out_size, void* d_ws, size_t ws_size, hipStream_t stream) {
  if (ws_size < O_END || n_in < 25) { fprintf(stderr, "workspace too small: %zu < %zu\n", ws_size, (size_t)O_END); return; }
  Params p{};
  p.x = (const float*)d_in[0]; p.pos = (const int*)d_in[1]; p.mix_norm = (const float*)d_in[2]; p.w_in = (const float*)d_in[3]; p.b_forget = (const float*)d_in[4];
  p.pe_k = (const float*)d_in[5]; p.w1_k = (const float*)d_in[6]; p.w2_k = (const float*)d_in[7]; p.pe_v = (const float*)d_in[8]; p.w1_v = (const float*)d_in[9]; p.w2_v = (const float*)d_in[10];
  p.q_norm = (const float*)d_in[11]; p.w_uq = (const float*)d_in[12]; p.kv_norm = (const float*)d_in[13]; p.w_ukv = (const float*)d_in[14];
  p.wbr_nsa = (const float*)d_in[15]; p.wbr_fox = (const float*)d_in[16]; p.wbr_mla = (const float*)d_in[17]; p.w_out = (const float*)d_in[18];
  p.ffn_norm = (const float*)d_in[19]; p.w_up = (const float*)d_in[20]; p.conv_w = (const float*)d_in[21]; p.conv_b = (const float*)d_in[22]; p.w_down = (const float*)d_in[23]; p.final_norm = (const float*)d_in[24];
  p.out = (float*)d_out; p.ws = (unsigned char*)d_ws;
  hipMemsetAsync(p.ws + O_BAR, 0, XCD_BAR_WORDS * 4, stream);
#if ONE_LAUNCH
  static int grid_blocks = 0;
  if (!grid_blocks) {
    int dev = 0, cus = 0, per_cu = 0;
    hipGetDevice(&dev); hipDeviceGetAttribute(&cus, hipDeviceAttributeMultiprocessorCount, dev);
    hipOccupancyMaxActiveBlocksPerMultiprocessor(&per_cu, mega_kernel, NTHR, 0);
    if (per_cu > 1) per_cu = 1;
    grid_blocks = cus * per_cu;
  }
  void* args[] = {&p};
  hipError_t e = hipLaunchCooperativeKernel((void*)mega_kernel, dim3(grid_blocks), dim3(NTHR), args, 0, stream);
  if (e != hipSuccess) fprintf(stderr, "cooperative launch failed: %s (grid %d)\n", hipGetErrorString(e), grid_blocks);
#else
  launch_phases<0>(p, stream);
#endif
}
```
